# Optimizing an MI355X kernel written in HIP

```python
import math
import jax, jax.numpy as jnp
from jax import lax
import numpy as np

D_MODEL = 1024
BATCH = 16
SEQ = 2048
DEPTH = 2

HEAD_DIM = 64
BRANCH_W = 512
N_BRANCH = 3
MOBA_HEADS = BRANCH_W // HEAD_DIM
MOBA_BLOCK = 256
MOBA_TOPK = 3
RWKV_HEADS = BRANCH_W // HEAD_DIM
RWKV_HEAD = HEAD_DIM
LORA_DECAY = 64
LORA_AAA = 64
LORA_GATE = 160
LORA_MV = 32
RWKV_GN_EPS = 64e-5
DSA_HEADS = BRANCH_W // HEAD_DIM
DSA_KV_RANK = 256
IDX_HEADS = 8
IDX_DIM = 32
DSA_TOPK_MAX = 256
REL_BUCKETS = 32
REL_MAX_DIST = 128
D_FF = ((8 * D_MODEL + 3 * 256 - 1) // (3 * 256)) * 256
NORM_EPS = 1e-6
Q_BLOCK = 16

RWKV_SPLITS = (BRANCH_W, LORA_DECAY, BRANCH_W, BRANCH_W, LORA_AAA, LORA_GATE)
DSA_SPLITS = (BRANCH_W, DSA_KV_RANK, IDX_HEADS * IDX_DIM, IDX_DIM, IDX_HEADS)
RWKV_IN = sum(RWKV_SPLITS)
DSA_IN = sum(DSA_SPLITS)
REGION_SPLITS = (3 * BRANCH_W, RWKV_IN, DSA_IN, N_BRANCH * D_MODEL)
D_IN = sum(REGION_SPLITS)

kernel_name = 'hybrid_moba_rwkv7_dsa_gated_block'


def _split(t, widths):
    idx = np.cumsum(widths)[:-1].tolist()
    return jnp.split(t, idx, axis=-1)


def rms_norm(x, g):
    xf = x.astype(jnp.float32)
    y = xf * lax.rsqrt(jnp.mean(xf * xf, axis=-1, keepdims=True) + NORM_EPS)
    return (y * g.astype(jnp.float32)).astype(x.dtype)


def token_shift(t):
    return jnp.pad(t, ((0, 0), (1, 0), (0, 0)))[:, :-1]


def rel_bucket(dist):
    n = jnp.maximum(dist, 0)
    max_exact = REL_BUCKETS // 2
    nf = jnp.maximum(n, 1).astype(jnp.float32)
    large = max_exact + (jnp.log(nf / max_exact) / math.log(REL_MAX_DIST / max_exact)
                         * (REL_BUCKETS - max_exact)).astype(jnp.int32)
    large = jnp.minimum(large, REL_BUCKETS - 1)
    return jnp.where(n < max_exact, n, large)


def moba_attention(q, k, v, rel_tab):
    B, S, H, Dh = q.shape
    f32 = jnp.float32
    nb = -(-S // MOBA_BLOCK)
    sp = nb * MOBA_BLOCK
    pad = ((0, 0), (0, sp - S), (0, 0), (0, 0))
    qh = jnp.transpose(q, (0, 2, 1, 3))
    kb = jnp.pad(k, pad).transpose(0, 2, 1, 3).reshape(B, H, nb, MOBA_BLOCK, Dh)
    vb = jnp.pad(v, pad).transpose(0, 2, 1, 3).reshape(B, H, nb, MOBA_BLOCK, Dh)
    scale = Dh ** -0.5
    tab_t = rel_tab.T
    n_sel = min(MOBA_TOPK, nb - 1)
    own = jnp.arange(S) // MOBA_BLOCK
    h_idx = jnp.arange(H)[:, None, None]
    b_idx = jnp.arange(B)[:, None, None, None]
    hb_idx = jnp.arange(H)[None, :, None, None]
    if n_sel > 0:
        kmean = jnp.mean(kb.astype(f32), axis=3)
        gate = jnp.einsum('bhsd,bhnd->bhsn', qh.astype(f32), kmean)
        past = jnp.arange(nb)[None, :] < own[:, None]
        gate = jnp.where(past, gate, -jnp.inf)
        _, sel = lax.top_k(gate, n_sel)
        sel_valid = jnp.arange(n_sel)[None, :] < own[:, None]

    def step(c):
        t0 = c * Q_BLOCK
        tq = t0 + jnp.arange(Q_BLOCK)
        qc = lax.dynamic_slice_in_dim(qh, t0, Q_BLOCK, axis=2)
        blk = t0 // MOBA_BLOCK
        k_own = lax.dynamic_index_in_dim(kb, blk, axis=2, keepdims=False)
        v_own = lax.dynamic_index_in_dim(vb, blk, axis=2, keepdims=False)
        dist_own = tq[:, None] - (blk * MOBA_BLOCK + jnp.arange(MOBA_BLOCK))[None, :]
        lo = jnp.einsum('bhqd,bhkd->bhqk', qc, k_own, preferred_element_type=f32) * scale
        lo = jnp.where(dist_own >= 0, lo + tab_t[:, rel_bucket(dist_own)], -jnp.inf)
        if n_sel > 0:
            sc = lax.dynamic_slice_in_dim(sel, t0, Q_BLOCK, axis=2)
            valid = lax.dynamic_slice_in_dim(sel_valid, t0, Q_BLOCK, axis=0)
            npk = n_sel * MOBA_BLOCK
            kg = kb[b_idx, hb_idx, sc].reshape(B, H, Q_BLOCK, npk, Dh)
            vg = vb[b_idx, hb_idx, sc].reshape(B, H, Q_BLOCK, npk, Dh)
            kpos = (sc[..., None] * MOBA_BLOCK + jnp.arange(MOBA_BLOCK)).reshape(B, H, Q_BLOCK, npk)
            dist = tq[None, None, :, None] - kpos
            lp = jnp.einsum('bhqd,bhqkd->bhqk', qc, kg, preferred_element_type=f32) * scale
            lp = lp + tab_t[h_idx, rel_bucket(dist)]
            validk = jnp.repeat(valid, MOBA_BLOCK, axis=1)
            lp = jnp.where(validk[None, None], lp, -jnp.inf)
            p = jax.nn.softmax(jnp.concatenate([lp, lo], axis=-1), axis=-1).astype(v.dtype)
            out = (jnp.einsum('bhqk,bhqkd->bhqd', p[..., :npk], vg)
                   + jnp.einsum('bhqk,bhkd->bhqd', p[..., npk:], v_own))
        else:
            p = jax.nn.softmax(lo, axis=-1).astype(v.dtype)
            out = jnp.einsum('bhqk,bhkd->bhqd', p, v_own)
        return out

    outs = lax.map(step, jnp.arange(S // Q_BLOCK))
    return outs.transpose(1, 0, 3, 2, 4).reshape(B, S, H * Dh)


def dsa_attention(q, k, v, q_idx, k_idx, w_idx, rel_tab):
    B, S, H, Dh = q.shape
    f32 = jnp.float32
    n_keep = min(DSA_TOPK_MAX, S // 4)
    scale = Dh ** -0.5
    b_idx = jnp.arange(B)[:, None, None]
    key_pos = jnp.arange(S)

    def step(c):
        t0 = c * Q_BLOCK
        tq = t0 + jnp.arange(Q_BLOCK)
        qi = lax.dynamic_slice_in_dim(q_idx, t0, Q_BLOCK, axis=1)
        wi = lax.dynamic_slice_in_dim(w_idx, t0, Q_BLOCK, axis=1).astype(f32)
        isc = jnp.einsum('bqhd,bsd->bqhs', qi, k_idx, preferred_element_type=f32)
        isc = jnp.einsum('bqhs,bqh->bqs', jax.nn.relu(isc), wi)
        isc = jnp.where(key_pos[None, None, :] <= tq[None, :, None], isc, -jnp.inf)
        _, sel = lax.top_k(isc, n_keep)
        valid = jnp.arange(n_keep)[None, :] <= tq[:, None]
        kg = k[b_idx, sel]
        vg = v[b_idx, sel]
        qc = lax.dynamic_slice_in_dim(q, t0, Q_BLOCK, axis=1)
        lg = jnp.einsum('bqhd,bqkhd->bqhk', qc, kg, preferred_element_type=f32) * scale
        bias = rel_tab[rel_bucket(tq[None, :, None] - sel)]
        lg = jnp.where(valid[None, :, None, :], lg + jnp.moveaxis(bias, -1, 2), -jnp.inf)
        p = jax.nn.softmax(lg, axis=-1).astype(v.dtype)
        return jnp.einsum('bqhk,bqkhd->bqhd', p, vg)

    outs = lax.map(step, jnp.arange(S // Q_BLOCK))
    return outs.transpose(1, 0, 2, 3, 4).reshape(B, S, H * Dh)


def wkv7_scan(r, decay, k, v, kk, a):
    B, S, H, N = r.shape

    def step(state, inp):
        r_t, w_t, k_t, v_t, kk_t, a_t = inp
        sa = jnp.einsum('bhvk,bhk->bhv', state, -kk_t)
        state = (state * w_t[:, :, None, :] + sa[..., None] * (kk_t * a_t)[:, :, None, :]
                 + v_t[..., None] * k_t[:, :, None, :])
        return state, jnp.einsum('bhvk,bhk->bhv', state, r_t)

    xs = tuple(jnp.moveaxis(t, 1, 0) for t in (r, decay, k, v, kk, a))
    _, out = lax.scan(step, jnp.zeros((B, H, N, N), jnp.float32), xs)
    return jnp.moveaxis(out, 0, 1)


def rwkv7_time_mix(p, mu, w0, w2, a0, a2, g2, k_k, k_a, r_k, ln_w, ln_b, v_first, vres):
    B, S, _ = p.shape
    p = p.astype(jnp.float32)
    p = p + (token_shift(p) - p) * mu
    r, wd, k, v, ad, gd = _split(p, RWKV_SPLITS)
    w = -jax.nn.softplus(-(w0 + jnp.tanh(wd) @ w2)) - 0.5
    decay = jnp.exp(-jnp.exp(w))
    a = jax.nn.sigmoid(a0 + ad @ a2)
    g = jax.nn.sigmoid(gd) @ g2
    if vres is None:
        v_first = v
    else:
        v0, va, vb = vres
        v = v + (v_first - v) * jax.nn.sigmoid(v0 + (v @ va) @ vb)
    hs = lambda t: t.reshape(B, S, RWKV_HEADS, RWKV_HEAD)
    kk = hs(k * k_k)
    kk = kk / jnp.maximum(jnp.sqrt(jnp.sum(kk * kk, axis=-1, keepdims=True)), 1e-12)
    k = k * (1.0 + (a - 1.0) * k_a)
    r, k, v, a, decay = hs(r), hs(k), hs(v), hs(a), hs(decay)
    o = wkv7_scan(r, decay, k, v, kk, a)
    mean = jnp.mean(o, axis=-1, keepdims=True)
    var = jnp.mean(jnp.square(o - mean), axis=-1, keepdims=True)
    gn_w = ln_w.astype(jnp.float32).reshape(RWKV_HEADS, RWKV_HEAD)
    gn_b = ln_b.astype(jnp.float32).reshape(RWKV_HEADS, RWKV_HEAD)
    o = (o - mean) * lax.rsqrt(var + RWKV_GN_EPS) * gn_w + gn_b
    o = o + jnp.sum(r * k * r_k, axis=-1, keepdims=True) * v
    return o.reshape(B, S, BRANCH_W) * g, v_first


def setup_inputs(seed: int = 0) -> dict:
    key = jax.random.key(seed)
    ks = jax.random.split(key, 26)
    L = DEPTH
    nrm = lambda k, shape, s: s * jax.random.normal(k, shape, jnp.float32)
    return {
        'x': nrm(ks[0], (BATCH, SEQ, D_MODEL), 1.0),
        'w_in': nrm(ks[1], (L, D_MODEL, D_IN), D_MODEL ** -0.5),
        'norm_mix': 1.0 + nrm(ks[2], (L, D_MODEL), 0.05),
        'norm_ffn': 1.0 + nrm(ks[3], (L, D_MODEL), 0.05),
        'qk_norm': 1.0 + nrm(ks[4], (L, 4, HEAD_DIM), 0.05),
        'rel_bias': nrm(ks[5], (REL_BUCKETS, MOBA_HEADS + DSA_HEADS), 0.5),
        'rwkv_mu': jax.random.uniform(ks[6], (L, RWKV_IN), jnp.float32),
        'rwkv_w0': jnp.linspace(-6.0, -1.0, BRANCH_W, dtype=jnp.float32)[None, :] + nrm(ks[7], (L, BRANCH_W), 0.1),
        'rwkv_w2': nrm(ks[8], (L, LORA_DECAY, BRANCH_W), 0.5 * LORA_DECAY ** -0.5),
        'rwkv_a0': nrm(ks[9], (L, BRANCH_W), 0.1),
        'rwkv_a2': nrm(ks[10], (L, LORA_AAA, BRANCH_W), LORA_AAA ** -0.5),
        'rwkv_g2': nrm(ks[11], (L, LORA_GATE, BRANCH_W), LORA_GATE ** -0.5),
        'rwkv_kk': 0.85 + nrm(ks[12], (L, BRANCH_W), 0.05),
        'rwkv_ka': 1.0 + nrm(ks[13], (L, BRANCH_W), 0.05),
        'rwkv_rk': nrm(ks[14], (L, RWKV_HEADS, RWKV_HEAD), 0.1),
        'rwkv_ln_w': 1.0 + nrm(ks[15], (L, BRANCH_W), 0.05),
        'rwkv_ln_b': nrm(ks[16], (L, BRANCH_W), 0.02),
        'rwkv_v0': nrm(ks[17], (L - 1, BRANCH_W), 0.1),
        'rwkv_va': nrm(ks[18], (L - 1, BRANCH_W, LORA_MV), BRANCH_W ** -0.5),
        'rwkv_vb': nrm(ks[19], (L - 1, LORA_MV, BRANCH_W), LORA_MV ** -0.5),
        'dsa_kv_norm': 1.0 + nrm(ks[20], (L, DSA_KV_RANK), 0.05),
        'dsa_kv_up': nrm(ks[21], (L, DSA_KV_RANK, 2 * BRANCH_W), DSA_KV_RANK ** -0.5),
        'w_branch': nrm(ks[22], (L, N_BRANCH, BRANCH_W, D_MODEL), BRANCH_W ** -0.5),
        'w_o': nrm(ks[23], (L, D_MODEL, D_MODEL), D_MODEL ** -0.5),
        'w_ffn_in': nrm(ks[24], (L, D_MODEL, 2 * D_FF), D_MODEL ** -0.5),
        'w_ffn_out': nrm(ks[25], (L, D_FF, D_MODEL), D_FF ** -0.5),
    }


def reference(x, w_in, norm_mix, norm_ffn, qk_norm, rel_bias, rwkv_mu, rwkv_w0, rwkv_w2, rwkv_a0,
              rwkv_a2, rwkv_g2, rwkv_kk, rwkv_ka, rwkv_rk, rwkv_ln_w, rwkv_ln_b, rwkv_v0, rwkv_va,
              rwkv_vb, dsa_kv_norm, dsa_kv_up, w_branch, w_o, w_ffn_in, w_ffn_out):
    B, S, D = x.shape
    moba_tab = rel_bias[:, :MOBA_HEADS]
    dsa_tab = rel_bias[:, MOBA_HEADS:]
    heads = lambda t, n: t.reshape(B, S, n, HEAD_DIM)
    v_first = None
    for l in range(DEPTH):
        h = rms_norm(x, norm_mix[l])
        p = h @ w_in[l]
        p_moba, p_rwkv, p_dsa, p_gate = _split(p, REGION_SPLITS)
        mq, mk, mv = _split(p_moba, (BRANCH_W, BRANCH_W, BRANCH_W))
        mq = rms_norm(heads(mq, MOBA_HEADS), qk_norm[l, 0])
        mk = rms_norm(heads(mk, MOBA_HEADS), qk_norm[l, 1])
        o_moba = moba_attention(mq, mk, heads(mv, MOBA_HEADS), moba_tab)
        vres = None if l == 0 else (rwkv_v0[l - 1], rwkv_va[l - 1], rwkv_vb[l - 1])
        o_rwkv, v_first = rwkv7_time_mix(p_rwkv, rwkv_mu[l], rwkv_w0[l], rwkv_w2[l], rwkv_a0[l],
                                         rwkv_a2[l], rwkv_g2[l], rwkv_kk[l], rwkv_ka[l], rwkv_rk[l],
                                         rwkv_ln_w[l], rwkv_ln_b[l], v_first, vres)
        dq, dc, diq, dik, diw = _split(p_dsa, DSA_SPLITS)
        dk, dv = _split(rms_norm(dc, dsa_kv_norm[l]) @ dsa_kv_up[l], (BRANCH_W, BRANCH_W))
        dq = rms_norm(heads(dq, DSA_HEADS), qk_norm[l, 2])
        dk = rms_norm(heads(dk, DSA_HEADS), qk_norm[l, 3])
        o_dsa = dsa_attention(dq, dk, heads(dv, DSA_HEADS), diq.reshape(B, S, IDX_HEADS, IDX_DIM),
                              dik, diw, dsa_tab)
        o = jnp.stack([o_moba, o_rwkv.astype(x.dtype), o_dsa], axis=2)
        y = jnp.einsum('bsnc,ncd->bsnd', o, w_branch[l])
        gate = jax.nn.sigmoid(p_gate.reshape(B, S, N_BRANCH, D))
        x = x + jnp.sum(gate * y, axis=2) @ w_o[l]
        fg, fu = _split(rms_norm(x, norm_ffn[l]) @ w_ffn_in[l], (D_FF, D_FF))
        x = x + (jax.nn.silu(fg) * fu) @ w_ffn_out[l]
    return x
```

```cpp
#include <hip/hip_runtime.h>
#include <stdint.h>

#define DI __device__ __forceinline__
#define LAS __attribute__((address_space(3)))
typedef unsigned short bf16_t;
typedef short bf16x8 __attribute__((ext_vector_type(8)));
typedef float f32x2 __attribute__((ext_vector_type(2)));
typedef float f32x4 __attribute__((ext_vector_type(4)));
typedef float f32x16 __attribute__((ext_vector_type(16)));
typedef unsigned u32x2 __attribute__((ext_vector_type(2)));
typedef unsigned u32x4 __attribute__((ext_vector_type(4)));
typedef __bf16 bf2_t __attribute__((ext_vector_type(2)));

constexpr int NB = 16, SEQ = 2048, DM = 1024, NT = NB * SEQ, NH = 8, BW = 512;
constexpr int NCH = 4, SC = 512, TC = NB * SC;
constexpr int D_IN = 7496, DFF = 2816;
constexpr int C_MQ = 0, C_MK = 512, C_MV = 1024, C_RW = 1536, C_DS = 3360, C_GT = 4424;
constexpr int RAWLD = 1792;
constexpr float NORM_EPS = 1e-6f;
constexpr float LOG2E = 1.4426950408889634f;

constexpr size_t MiB = 1024 * 1024;
constexpr size_t WS_CTL = 0;
constexpr size_t WS_WB = 64 * 1024;
constexpr size_t WS_WV = WS_WB + 2 * MiB;
constexpr size_t WS_WD1 = WS_WV + 1 * MiB;
constexpr size_t WS_WKVK = WS_WD1 + 12 * MiB;
constexpr size_t WS_WKVV = WS_WKVK + MiB / 4;
constexpr size_t WS_WL = WS_WKVV + MiB / 4;
constexpr size_t WS_WBR = WS_WL + 2 * MiB;
constexpr size_t WS_WO = WS_WBR + 3 * MiB;
constexpr size_t WS_WF1 = WS_WO + 2 * MiB;
constexpr size_t WS_WF2 = WS_WF1 + 11 * MiB;
constexpr size_t WS_VFIRST = WS_WF2 + 6 * MiB;
constexpr size_t WS_STATE = WS_VFIRST + 32 * MiB;
constexpr size_t WS_H = WS_STATE + 2 * MiB;
constexpr size_t WS_IDXK = WS_H + 64 * MiB;
constexpr size_t WS_IDXW = WS_IDXK + 2 * MiB;
constexpr size_t WS_LEFT = WS_IDXW + 1 * MiB;
constexpr size_t WS_DCN = WS_LEFT + 2 * MiB;
constexpr size_t WS_KMEAN = WS_DCN + 16 * MiB;
constexpr size_t WS_CARRY = WS_KMEAN + MiB / 4;
constexpr size_t WS_MK = WS_CARRY + MiB / 4;
constexpr size_t WS_MVT = WS_MK + 32 * MiB;
constexpr size_t WS_DK = WS_MVT + 32 * MiB;
constexpr size_t WS_DVT = WS_DK + 32 * MiB;
constexpr size_t WS_MQ = WS_DVT + 32 * MiB;
constexpr size_t WS_DQ = WS_MQ + 8 * MiB;
constexpr size_t WS_IDXQ = WS_DQ + 8 * MiB;
constexpr size_t WS_RAW = WS_IDXQ + 4 * MiB;
constexpr size_t WS_LORAA = WS_RAW + 28 * MiB;
constexpr size_t WS_Y32 = WS_RAW;
constexpr size_t WS_GATES = WS_LORAA + 8 * MiB;
constexpr size_t WS_RR = WS_GATES + 48 * MiB;
constexpr size_t WS_KF = WS_RR + 8 * MiB;
constexpr size_t WS_VV = WS_KF + 8 * MiB;
constexpr size_t WS_KKB = WS_VV + 8 * MiB;
constexpr size_t WS_BBB = WS_KKB + 8 * MiB;
constexpr size_t WS_GG = WS_BBB + 8 * MiB;
constexpr size_t WS_DEC = WS_GG + 8 * MiB;
constexpr size_t WS_Y = WS_DEC;
constexpr size_t WS_OUT = WS_DEC + 16 * MiB;
constexpr size_t WS_V2 = WS_OUT + 16 * MiB;
constexpr size_t WS_SELB = WS_V2 + 8 * MiB;
constexpr size_t WS_ORW = WS_SELB + 2 * MiB;
constexpr size_t WS_END = WS_ORW + 8 * MiB;
constexpr size_t WS_ACT = WS_MK;
static_assert(WS_END <= 512 * MiB, "workspace map exceeds 512 MiB");
static_assert(WS_ACT + 176 * MiB <= WS_END, "ACT alias");

DI unsigned pk2(float a, float b) { f32x2 v = {a, b}; return __builtin_bit_cast(unsigned, __builtin_convertvector(v, bf2_t)); }
DI bf16_t f2bf(float a) { return (bf16_t)(pk2(a, 0.f) & 0xffffu); }
DI float bflo(unsigned u) { return __uint_as_float(u << 16); }
DI float bfhi(unsigned u) { return __uint_as_float(u & 0xffff0000u); }
DI float bf2f(bf16_t b) { return __uint_as_float((unsigned)b << 16); }
DI float fexp2(float x) { return __builtin_amdgcn_exp2f(x); }
DI float frcp(float x) { return __builtin_amdgcn_rcpf(x); }
DI float fsigmoid(float x) { return frcp(1.f + fexp2(-x * LOG2E)); }
DI float wave_sum(float v) {
#pragma unroll
    for (int o = 32; o >= 1; o >>= 1) v += __shfl_xor(v, o);
    return v;
}

#define XB_TMO      128
#define XB_XCNT(j)  (256  + 64 * (j))
#define XB_XSUB(j)  (1280 + 64 * (j))
#define XB_XGEN(j)  (2304 + 64 * (j))
#define XB_TOP      3328
#define XB_TOPGEN   3392
#define XCD_BAR_WORDS 3456
#define XB_SPIN_CAP (1u << 18)
__device__ __forceinline__ unsigned xb_ld(unsigned* p)              { return __hip_atomic_load(p, __ATOMIC_RELAXED, __HIP_MEMORY_SCOPE_AGENT); }
__device__ __forceinline__ unsigned xb_add(unsigned* p, unsigned v) { return __hip_atomic_fetch_add(p, v, __ATOMIC_RELAXED, __HIP_MEMORY_SCOPE_AGENT); }
__device__ __forceinline__ unsigned xb_xcc_id() { return (unsigned)__builtin_amdgcn_s_getreg((3 << 11) | 20) & 0xFu; }
#define XB_SPIN(cond, bar) do { unsigned _sp = 0; while (cond) { __builtin_amdgcn_s_sleep(1); \
    if ((++_sp & 255u) == 0u) { if (xb_ld(&(bar)[XB_TMO])) break; if (_sp > XB_SPIN_CAP) { atomicAdd(&(bar)[XB_TMO], 1u); break; } } } } while (0)
struct XcdBarrier { unsigned* bar; unsigned x; volatile LAS unsigned* st; };
__device__ __forceinline__ XcdBarrier xcd_barrier_post(unsigned* bar, volatile LAS unsigned* st) {
    XcdBarrier b; b.bar = bar; b.x = xb_xcc_id(); b.st = st;
    if (threadIdx.x == 0) (void)xb_add(&bar[XB_XCNT(b.x)], 1u);
    return b;
}
__device__ __forceinline__ void xcd_barrier_complete(unsigned* bar, unsigned x, unsigned& nloc, unsigned& nx) {
    const unsigned G = gridDim.x * gridDim.y * gridDim.z;
    unsigned sum, cnt, mine, sp = 0u;
    for (;;) {
        sum = 0u; cnt = 0u; mine = 0u;
#pragma unroll 1
        for (unsigned j = 0; j < 16; ++j) { const unsigned c = xb_ld(&bar[XB_XCNT(j)]); sum += c; cnt += (c > 0u) ? 1u : 0u; mine = (j == x) ? c : mine; }
        if (sum == G) break;
        __builtin_amdgcn_s_sleep(1);
        if ((++sp & 255u) == 0u) { if (xb_ld(&bar[XB_TMO])) break; if (sp > XB_SPIN_CAP) { atomicAdd(&bar[XB_TMO], 1u); break; } }
    }
    nloc = mine > 0u ? mine : 1u; nx = cnt > 0u ? cnt : 1u;
}
__device__ __forceinline__ void xcd_barrier(const XcdBarrier& b) {
    asm volatile("s_waitcnt vmcnt(0)" ::: "memory");
    __syncthreads();
    if (threadIdx.x == 0) {
        unsigned* bar = b.bar;
        __builtin_amdgcn_s_waitcnt(0);
        unsigned nloc = b.st[0], nx = b.st[1];
        if (nloc == 0u) { xcd_barrier_complete(bar, b.x, nloc, nx); b.st[0] = nloc; b.st[1] = nx; }
        const unsigned old = xb_add(&bar[XB_XSUB(b.x)], 1u);
        const unsigned gen = old / nloc;
        if (old + 1u == (gen + 1u) * nloc) {
            __builtin_amdgcn_fence(__ATOMIC_RELEASE, "agent");
            asm volatile("s_waitcnt vmcnt(0)" ::: "memory");
            const unsigned og = xb_add(&bar[XB_TOP], 1u);
            const unsigned tg = og / nx;
            if (og + 1u == (tg + 1u) * nx) xb_add(&bar[XB_TOPGEN], 1u);
            else XB_SPIN(xb_ld(&bar[XB_TOPGEN]) == tg, bar);
            __builtin_amdgcn_fence(__ATOMIC_ACQUIRE, "agent");
            xb_add(&bar[XB_XGEN(b.x)], 1u);
            asm volatile("s_waitcnt vmcnt(0)" ::: "memory");
        } else {
            XB_SPIN(xb_ld(&bar[XB_XGEN(b.x)]) == gen, bar);
            __builtin_amdgcn_fence(__ATOMIC_ACQUIRE, "agent");
            asm volatile("s_waitcnt vmcnt(0)" ::: "memory");
        }
    }
    __syncthreads();
}

DI int TID() { int t = threadIdx.x; asm volatile("" : "+v"(t)); return t; }
DI int BID() { int b = blockIdx.x; asm volatile("" : "+s"(b)); return b; }

namespace pg8 {
constexpr int BM = 256, BK = 64, HALF = 128, HTB = HALF * BK * 2, STAGE_BYTES = 8 * HTB, NXCD = 8, WGM = 8;
DI int lds_byte(int r, int c) { const int st = (r >> 4) * 2 + (c >> 5), rr = r & 15, cc = c & 31, ob = rr * 64 + cc * 2; return st * 1024 + (ob ^ (((ob >> 9) & 1) << 5)); }
DI void stage_rc(int b, int& R, int& C) { const int st = b / 1024, sb = b % 1024, swz = sb ^ (((sb >> 9) & 1) << 5); R = (st >> 1) * 16 + swz / 64; C = (st & 1) * 32 + (swz % 64) / 2; }
struct Unit { int pm, pn, z; };

DI bool order_xcd(int nM, int nN, int G, int c, int i, Unit& u) {
    const int nwg = nM * nN; const long L = (long)i * G + c; if (L >= nwg) return false;
    int wgid = (int)L; { const int q = nwg / NXCD, r = nwg % NXCD, xcd = wgid % NXCD, off = wgid / NXCD; wgid = (xcd < r ? xcd * (q + 1) : r * (q + 1) + (xcd - r) * q) + off; }
    const int nig = WGM * nN, gid = wgid / nig, fm = gid * WGM, gsz = (nM - fm) < WGM ? (nM - fm) : WGM;
    u.pm = fm + ((wgid % nig) % gsz); u.pn = (wgid % nig) / gsz; u.z = 0; return true;
}

template <class Epi, class Sched>
DI void gemm_phase(LAS unsigned char* lds, const int K, const Sched& S, const Epi& E) {
    const int tid = TID(), wid = __builtin_amdgcn_readfirstlane(tid >> 6), lane = tid & 63, wr = wid >> 2, wc = wid & 3, fr = lane & 15, fq = lane >> 4;
    const int nt = K / BK;
    unsigned voffA[2];
#pragma unroll
    for (int i = 0; i < 2; ++i) { int R, C; stage_rc(tid * 16 + i * 8192, R, C); voffA[i] = (unsigned)(R * K + C) * 2u; }
    const size_t kstep = (size_t)(BK * 2);
    const size_t hstep = (size_t)HALF * K * 2;
    const unsigned ldsw = (unsigned)wid * 1024u;
    const int aoff = lds_byte(wr * 64 + fr, fq * 8), boff = lds_byte(wc * 32 + fr, fq * 8);
#define PG8_SA(b, h) (((b) * 2 + (h)) * HTB)
#define PG8_SB(b, h) ((4 + (b) * 2 + (h)) * HTB)
#define PG8_STAGE(bufoff, gbase) do { _Pragma("unroll") for (int _i = 0; _i < 2; ++_i) \
        __builtin_amdgcn_global_load_lds((const unsigned*)((const char*)(gbase) + voffA[_i]), (LAS unsigned*)(lds + (bufoff) + ldsw + _i * 8192), 16, 0, 0); } while (0)
#define PG8_LDA(dst, b, h) do { _Pragma("unroll") for (int m = 0; m < 4; ++m) _Pragma("unroll") for (int k = 0; k < 2; ++k) dst[m][k] = *(const LAS bf16x8*)(lds + PG8_SA(b, h) + aoff + m * 2048 + k * 1024); } while (0)
#define PG8_LDB(dst, b, h) do { _Pragma("unroll") for (int n = 0; n < 2; ++n) _Pragma("unroll") for (int k = 0; k < 2; ++k) dst[n][k] = *(const LAS bf16x8*)(lds + PG8_SB(b, h) + boff + n * 2048 + k * 1024); } while (0)
#define PG8_MMA(ai, bj, At, Bt) do { __builtin_amdgcn_s_setprio(1); _Pragma("unroll") for (int m = 0; m < 4; ++m) _Pragma("unroll") for (int n = 0; n < 2; ++n) _Pragma("unroll") for (int k = 0; k < 2; ++k) \
        acc[ai][bj][m][n] = __builtin_amdgcn_mfma_f32_16x16x32_bf16(Bt[n][k], At[m][k], acc[ai][bj][m][n], 0, 0, 0); __builtin_amdgcn_s_setprio(0); } while (0)
#define PG8_WAIT_V(n) asm volatile("s_waitcnt vmcnt(" #n ")" ::: "memory")
#define PG8_WAIT_L(n) asm volatile("s_waitcnt lgkmcnt(" #n ")" ::: "memory")
#define PG8_BAR __builtin_amdgcn_s_barrier()
#define PG8_SCHED __builtin_amdgcn_sched_barrier(0)
    Unit cur, nxt; int ui = 0;
    if (!S.next(0, cur)) return;
    f32x4 acc[2][2][4][2];
#pragma unroll
    for (int a = 0; a < 2; ++a)
#pragma unroll
        for (int b = 0; b < 2; ++b)
#pragma unroll
            for (int m = 0; m < 4; ++m)
#pragma unroll
                for (int n = 0; n < 2; ++n) acc[a][b][m][n] = (f32x4){0.f, 0.f, 0.f, 0.f};
    bf16x8 At[4][2], B0[2][2], B1[2][2];
    const char* cA = S.aptr(cur); const char* cB = S.bptr(cur);
    PG8_STAGE(PG8_SB(0, 0), cB); PG8_STAGE(PG8_SA(0, 0), cA); PG8_STAGE(PG8_SB(0, 1), cB + hstep); PG8_STAGE(PG8_SA(0, 1), cA + hstep);
    if (wr == 1) PG8_BAR;
    PG8_WAIT_V(4); PG8_BAR;
    PG8_STAGE(PG8_SB(1, 0), cB + kstep); PG8_STAGE(PG8_SA(1, 0), cA + kstep); PG8_STAGE(PG8_SB(1, 1), cB + hstep + kstep);
    PG8_WAIT_V(6); PG8_BAR;
    for (;;) {
        const bool has_next = S.next(ui + 1, nxt);
        const char* nA = has_next ? S.aptr(nxt) : cA; const char* nB = has_next ? S.bptr(nxt) : cB;
#pragma unroll 1
        for (int t = 0; t < nt; t += 2) {
            const bool last = (t == nt - 2);
            const char* a1 = cA + (size_t)(t + 1) * kstep;
            const char* a2 = last ? nA : cA + (size_t)(t + 2) * kstep; const char* b2 = last ? nB : cB + (size_t)(t + 2) * kstep;
            const char* a3 = a2 + kstep; const char* b3 = b2 + kstep;
            PG8_LDB(B0, 0, 0); PG8_SCHED; PG8_LDA(At, 0, 0); PG8_STAGE(PG8_SA(1, 1), a1 + hstep);
            PG8_WAIT_L(8); PG8_BAR; PG8_WAIT_L(0); PG8_MMA(0, 0, At, B0); PG8_BAR; PG8_SCHED;
            PG8_LDB(B1, 0, 1); PG8_STAGE(PG8_SB(0, 0), b2);
            PG8_BAR; PG8_WAIT_L(0); PG8_MMA(0, 1, At, B1); PG8_BAR;
            PG8_LDA(At, 0, 1); PG8_STAGE(PG8_SA(0, 0), a2);
            PG8_BAR; PG8_WAIT_L(0); PG8_MMA(1, 0, At, B0); PG8_BAR; PG8_SCHED;
            PG8_STAGE(PG8_SB(0, 1), b2 + hstep);
            PG8_WAIT_V(6); PG8_BAR; PG8_MMA(1, 1, At, B1); PG8_BAR;
            PG8_LDB(B0, 1, 0); PG8_SCHED; PG8_LDA(At, 1, 0); PG8_STAGE(PG8_SA(0, 1), a2 + hstep);
            PG8_WAIT_L(8); PG8_BAR; PG8_WAIT_L(0); PG8_MMA(0, 0, At, B0); PG8_BAR; PG8_SCHED;
            PG8_LDB(B1, 1, 1); PG8_STAGE(PG8_SB(1, 0), b3);
            PG8_BAR; PG8_WAIT_L(0); PG8_MMA(0, 1, At, B1); PG8_BAR;
            PG8_LDA(At, 1, 1); PG8_STAGE(PG8_SA(1, 0), a3);
            PG8_BAR; PG8_WAIT_L(0); PG8_MMA(1, 0, At, B0); PG8_BAR; PG8_SCHED;
            PG8_STAGE(PG8_SB(1, 1), b3 + hstep);
            PG8_WAIT_V(6); PG8_BAR; PG8_MMA(1, 1, At, B1); PG8_BAR;
        }
        { int tz = TID(); asm volatile("" : "+v"(tz));
          const int wz = __builtin_amdgcn_readfirstlane(tz >> 6), lz = tz & 63; E(acc, cur, wz >> 2, wz & 3, lz & 15, lz >> 4); }
        if (!has_next) break;
#pragma unroll
        for (int a = 0; a < 2; ++a)
#pragma unroll
            for (int b = 0; b < 2; ++b)
#pragma unroll
                for (int m = 0; m < 4; ++m)
#pragma unroll
                    for (int n = 0; n < 2; ++n) acc[a][b][m][n] = (f32x4){0.f, 0.f, 0.f, 0.f};
        cur = nxt; cA = nA; cB = nB; ++ui;
    }
    PG8_WAIT_V(0);
    if (wr == 0) PG8_BAR;
    PG8_BAR;
#undef PG8_SA
#undef PG8_SB
#undef PG8_STAGE
#undef PG8_LDA
#undef PG8_LDB
#undef PG8_MMA
#undef PG8_WAIT_V
#undef PG8_WAIT_L
#undef PG8_BAR
#undef PG8_SCHED
}
}
using pg8::Unit;
typedef f32x4 AccT[2][2][4][2];

struct Params {
    const float* in[26];
    float* out;
    unsigned char* ws;
    int ph_lo, ph_hi;
};
enum { I_X = 0, I_WIN, I_NMIX, I_NFFN, I_QKN, I_REL, I_MU, I_W0, I_W2, I_A0, I_A2, I_G2, I_KK, I_KA, I_RK, I_LNW, I_LNB, I_V0, I_VA, I_VB, I_KVN, I_KVUP, I_WBR, I_WO, I_F1, I_F2 };

DI const Params* KP() { auto k = __builtin_amdgcn_kernarg_segment_ptr(); asm volatile("" : "+s"(k)); return (const Params*)k; }
template <class T> DI T* wsp(size_t off) { return (T*)(KP()->ws + off); }

DI int hn_col(int x) { const int pi = x & 255; return (x & ~255) + 64 * ((pi >> 5) & 3) + 32 * (pi >> 7) + (pi & 31); }
template <int MAP> DI int colmap(int r) {
    if (MAP == 0) {
        if (r < 512) return C_MK + hn_col(r);
        if (r < 768) return C_DS + 512 + (r - 512);
        const int pi = r - 768;
        if (pi < 32) return C_DS + 1024 + pi;
        if (pi < 40) return C_DS + 1056 + (pi - 32);
        if (pi >= 64 && pi < 96) return C_RW + 1792 + (pi - 64);
        return -1;
    }
    if (MAP == 1) return C_MV + r;
    if (MAP == 2) {
        if (r < 512) return C_MQ + hn_col(r);
        if (r < 1024) return C_DS + hn_col(r - 512);
        if (r < 1280) return C_DS + 768 + (r - 1024);
        if (r < 3072) return C_RW + (r - 1280);
        return C_GT + (r - 3072);
    }
    if (MAP == 3) return hn_col(r);
    if (MAP == 4) return 512 + r;
    if (MAP == 5) return r;
    if (MAP == 6) { const int pn = r >> 8, pi = r & 255; return ((pi >> 7) ? DFF : 0) + 128 * pn + (pi & 127); }
    return -1;
}
template <int MAP> DI void conv_t(LAS float* sm, bf16_t* dst, int nrows, int K, const float* src, int ld) {
    const int tid = TID(), tx = tid & 63, ty = tid >> 6;
    const int ntr = nrows / 64, ntk = K / 64, ntiles = ntr * ntk;
    for (int t = BID(); t < ntiles; t += gridDim.x) {
        const int r0 = (t / ntk) * 64, k0 = (t % ntk) * 64;
        const int col = colmap<MAP>(r0 + tx);
#pragma unroll
        for (int i = 0; i < 8; ++i) { const int kl = ty + 8 * i; sm[kl * 65 + tx] = (col >= 0) ? src[(size_t)(k0 + kl) * ld + col] : 0.f; }
        __syncthreads();
#pragma unroll
        for (int i = 0; i < 8; ++i) { const int rl = ty + 8 * i; dst[(size_t)(r0 + rl) * K + k0 + tx] = f2bf(sm[tx * 65 + rl]); }
        __syncthreads();
    }
}
DI void conv_lora(int l) {
    bf16_t* dst = wsp<bf16_t>(WS_WL);
    const float* w2 = KP()->in[I_W2] + (size_t)l * 64 * 512; const float* a2 = KP()->in[I_A2] + (size_t)l * 64 * 512; const float* g2 = KP()->in[I_G2] + (size_t)l * 160 * 512;
    const float* va = KP()->in[I_VA]; const float* vb = KP()->in[I_VB];
    const int n = 2048 * 512;
    for (int e = BID() * 512 + TID(); e < n; e += gridDim.x * 512) {
        const int r = e >> 9, k = e & 511; float v = 0.f;
        if (r < 512) { if (k < 64) v = w2[k * 512 + r]; }
        else if (r < 1024) { if (k >= 64 && k < 128) v = a2[(k - 64) * 512 + (r - 512)]; }
        else if (r < 1536) { if (k >= 128 && k < 288) v = g2[(k - 128) * 512 + (r - 1024)]; }
        else if (l == 1) { const int c = r - 1536; float s = 0.f;
#pragma unroll 8
            for (int j = 0; j < 32; ++j) s += va[k * 32 + j] * vb[j * 512 + c];
            v = s; }
        dst[e] = f2bf(v);
    }
}
DI void phase_conv(int l, LAS float* sm) {
    const float* win = KP()->in[I_WIN] + (size_t)l * DM * D_IN;
    conv_t<0>(sm, wsp<bf16_t>(WS_WB), 1024, 1024, win, D_IN);
    conv_t<1>(sm, wsp<bf16_t>(WS_WV), 512, 1024, win, D_IN);
    conv_t<2>(sm, wsp<bf16_t>(WS_WD1), 6144, 1024, win, D_IN);
    const float* kvup = KP()->in[I_KVUP] + (size_t)l * 256 * 1024;
    conv_t<3>(sm, wsp<bf16_t>(WS_WKVK), 512, 256, kvup, 1024);
    conv_t<4>(sm, wsp<bf16_t>(WS_WKVV), 512, 256, kvup, 1024);
    for (int i = 0; i < 3; ++i) conv_t<5>(sm, wsp<bf16_t>(WS_WBR) + (size_t)i * 1024 * 512, 1024, 512, KP()->in[I_WBR] + ((size_t)l * 3 + i) * 512 * 1024, 1024);
    conv_t<5>(sm, wsp<bf16_t>(WS_WO), 1024, 1024, KP()->in[I_WO] + (size_t)l * 1024 * 1024, 1024);
    conv_t<6>(sm, wsp<bf16_t>(WS_WF1), 5632, 1024, KP()->in[I_F1] + (size_t)l * 1024 * 5632, 5632);
    conv_t<5>(sm, wsp<bf16_t>(WS_WF2), 1024, 2816, KP()->in[I_F2] + (size_t)l * 2816 * 1024, 1024);
    conv_lora(l);
}

DI void phase_norm(const float* x, const float* g, bf16_t* h) {
    const int lane = TID() & 63, gw = BID() * 8 + (TID() >> 6), nw = gridDim.x * 8;
    f32x4 gv[4];
#pragma unroll
    for (int i = 0; i < 4; ++i) gv[i] = ((const f32x4*)g)[lane + 64 * i];
    for (int row = gw; row < NT; row += nw) {
        const f32x4* xr = (const f32x4*)(x + (size_t)row * DM);
        f32x4 v[4]; float ss = 0.f;
#pragma unroll
        for (int i = 0; i < 4; ++i) { v[i] = xr[lane + 64 * i]; ss += v[i][0] * v[i][0] + v[i][1] * v[i][1] + v[i][2] * v[i][2] + v[i][3] * v[i][3]; }
        ss = wave_sum(ss);
        const float rs = __builtin_amdgcn_rsqf(ss * (1.f / DM) + NORM_EPS);
#pragma unroll
        for (int i = 0; i < 4; ++i) {
            u32x2 o; o[0] = pk2(v[i][0] * rs * gv[i][0], v[i][1] * rs * gv[i][1]); o[1] = pk2(v[i][2] * rs * gv[i][2], v[i][3] * rs * gv[i][3]);
            *(u32x2*)(h + (size_t)row * DM + 4 * (lane + 64 * i)) = o;
        }
    }
}

struct SchedLin {
    int nM, nN, G, c; unsigned aoff, boff, a2off; int rowbytes, amode, cbase, pn2;
    DI bool next(int i, Unit& u) const { return pg8::order_xcd(nM, nN, G, c, i, u); }
    DI const char* aptr(const Unit& u) const { const int row0 = amode ? ((u.pm >> 1) * SEQ + cbase + (u.pm & 1) * 256) : u.pm * 256; return (const char*)KP()->ws + ((u.pn >= pn2) ? a2off : aoff) + (size_t)row0 * rowbytes; }
    DI const char* bptr(const Unit& u) const { return (const char*)KP()->ws + boff + (size_t)u.pn * 256 * rowbytes; }
};
DI SchedLin mk_sched(int nM, int nN, size_t aoff, size_t boff, int K, int amode = 0, int cbase = 0, size_t a2off = 0, int pn2 = 1 << 30) {
    SchedLin s; s.nM = nM; s.nN = nN; s.G = gridDim.x; s.c = BID(); s.aoff = (unsigned)aoff; s.boff = (unsigned)boff; s.rowbytes = K * 2; s.amode = amode; s.cbase = cbase; s.a2off = (unsigned)a2off; s.pn2 = pn2; return s;
}
struct SchedMerge {
    int G, c;
    DI bool next(int i, Unit& u) const { const int z = i % 3, tile = (i / 3) * G + c; if (tile >= 128) return false; u.pm = tile >> 2; u.pn = tile & 3; u.z = z; return true; }
    DI const char* aptr(const Unit& u) const { return (const char*)KP()->ws + (u.z == 0 ? WS_MQ : (u.z == 1 ? WS_ORW : WS_DQ)) + (size_t)u.pm * 256 * 1024; }
    DI const char* bptr(const Unit& u) const { return (const char*)KP()->ws + WS_WBR + (size_t)u.z * (1024 * 512 * 2) + (size_t)u.pn * 256 * 1024; }
};

DI void st_bf4(bf16_t* p, f32x4 v) { u32x2 o; o[0] = pk2(v[0], v[1]); o[1] = pk2(v[2], v[3]); *(u32x2*)p = o; }
DI f32x4 ld_bf4(const bf16_t* p) { const u32x2 u = *(const u32x2*)p; return (f32x4){bflo(u[0]), bfhi(u[0]), bflo(u[1]), bfhi(u[1])}; }
#define EPI_ROWS(ai, m) (128 * (ai) + 64 * wr + 16 * (m) + fr)
#define EPI_COLS(bj, n) (128 * (bj) + 32 * wc + 16 * (n) + 4 * fq)
#define FOR_AM _Pragma("unroll") for (int ai = 0; ai < 2; ++ai) _Pragma("unroll") for (int m = 0; m < 4; ++m)
#define FOR_BN _Pragma("unroll") for (int bj = 0; bj < 2; ++bj) _Pragma("unroll") for (int n = 0; n < 2; ++n)

DI void epi_headnorm(const AccT& acc, bf16_t* out, int ld, const float* gain, int wr, int wc, int fr, int fq) {
    f32x4 gv[2][2];
    FOR_BN gv[bj][n] = *(const f32x4*)(gain + 32 * bj + 16 * n + 4 * fq);
    FOR_AM {
        float ss = 0.f;
        FOR_BN { const f32x4 a = acc[ai][bj][m][n]; ss += a[0] * a[0] + a[1] * a[1] + a[2] * a[2] + a[3] * a[3]; }
        ss += __shfl_xor(ss, 16); ss += __shfl_xor(ss, 32);
        const float sc = __builtin_amdgcn_rsqf(ss * (1.f / 64.f) + NORM_EPS);
        bf16_t* rp = out + (size_t)EPI_ROWS(ai, m) * ld + 64 * wc + 4 * fq;
        FOR_BN st_bf4(rp + 32 * bj + 16 * n, acc[ai][bj][m][n] * sc * gv[bj][n]);
    }
}
DI void epi_store_bf16(const AccT& acc, bf16_t* out, int ld, int wr, int wc, int fr, int fq) {
    FOR_AM { bf16_t* rp = out + (size_t)EPI_ROWS(ai, m) * ld; FOR_BN st_bf4(rp + EPI_COLS(bj, n), acc[ai][bj][m][n]); }
}

struct EpiB {
    int l;
    DI void operator()(const AccT& acc, const Unit& u, int wr, int wc, int fr, int fq) const {
        const size_t row0 = (size_t)u.pm * 256;
        if (u.pn < 2) epi_headnorm(acc, wsp<bf16_t>(WS_MK) + row0 * 512 + u.pn * 256, 512, KP()->in[I_QKN] + l * 256 + 64, wr, wc, fr, fq);
        else if (u.pn == 2) epi_store_bf16(acc, wsp<bf16_t>(WS_DCN) + row0 * 256, 256, wr, wc, fr, fq);
        else {
            bf16_t* idxk = wsp<bf16_t>(WS_IDXK); float* idxw = wsp<float>(WS_IDXW); bf16_t* left = wsp<bf16_t>(WS_LEFT);
            FOR_AM { const size_t row = row0 + EPI_ROWS(ai, m);
                if (wc == 0) { st_bf4(idxk + row * 32 + 4 * fq, acc[ai][0][m][0]); st_bf4(idxk + row * 32 + 16 + 4 * fq, acc[ai][0][m][1]); }
                else if (wc == 1) { if (fq < 2) *(f32x4*)(idxw + row * 8 + 4 * fq) = acc[ai][0][m][0]; }
                else if (wc == 2) { st_bf4(left + row * 32 + 4 * fq, acc[ai][0][m][0]); st_bf4(left + row * 32 + 16 + 4 * fq, acc[ai][0][m][1]); }
            }
        }
    }
};
struct EpiVt {
    unsigned off;
    DI void operator()(const AccT& acc, const Unit& u, int wr, int wc, int fr, int fq) const {
        bf16_t* vt = wsp<bf16_t>(off);
        const int b = u.pn >> 3, s0 = (u.pn & 7) * 256;
        FOR_AM { bf16_t* rp = vt + ((size_t)b * 512 + u.pm * 256 + EPI_ROWS(ai, m)) * SEQ + s0; FOR_BN st_bf4(rp + EPI_COLS(bj, n), acc[ai][bj][m][n]); }
    }
};
struct EpiHN {
    int l;
    DI void operator()(const AccT& acc, const Unit& u, int wr, int wc, int fr, int fq) const { epi_headnorm(acc, wsp<bf16_t>(WS_DK) + (size_t)u.pm * 256 * 512 + u.pn * 256, 512, KP()->in[I_QKN] + l * 256 + 192, wr, wc, fr, fq); }
};
struct EpiD1 {
    int l;
    DI void operator()(const AccT& acc, const Unit& u, int wr, int wc, int fr, int fq) const {
        const size_t row0 = (size_t)u.pm * 256;
        if (u.pn < 2) epi_headnorm(acc, wsp<bf16_t>(WS_MQ) + row0 * 512 + u.pn * 256, 512, KP()->in[I_QKN] + l * 256, wr, wc, fr, fq);
        else if (u.pn < 4) epi_headnorm(acc, wsp<bf16_t>(WS_DQ) + row0 * 512 + (u.pn - 2) * 256, 512, KP()->in[I_QKN] + l * 256 + 128, wr, wc, fr, fq);
        else if (u.pn == 4) epi_store_bf16(acc, wsp<bf16_t>(WS_IDXQ) + row0 * 256, 256, wr, wc, fr, fq);
        else if (u.pn < 12) epi_store_bf16(acc, wsp<bf16_t>(WS_RAW) + row0 * RAWLD + (u.pn - 5) * 256, RAWLD, wr, wc, fr, fq);
        else {
            bf16_t* o = wsp<bf16_t>(WS_GATES) + row0 * 3072 + (u.pn - 12) * 256;
            FOR_AM { bf16_t* rp = o + (size_t)EPI_ROWS(ai, m) * 3072;
                FOR_BN { const f32x4 a = acc[ai][bj][m][n]; st_bf4(rp + EPI_COLS(bj, n), (f32x4){fsigmoid(a[0]), fsigmoid(a[1]), fsigmoid(a[2]), fsigmoid(a[3])}); } }
        }
    }
};
struct EpiLora {
    int l, cbase;
    DI void operator()(const AccT& acc, const Unit& u, int wr, int wc, int fr, int fq) const {
        const size_t row0 = (size_t)u.pm * 256; const int kind = u.pn >> 1, cb = (u.pn & 1) * 256;
        if (kind == 0) {
            float* dec = wsp<float>(WS_DEC); const float* w0 = KP()->in[I_W0] + l * 512;
            FOR_AM { const size_t row = row0 + EPI_ROWS(ai, m);
                FOR_BN { const int col = cb + EPI_COLS(bj, n); const f32x4 a = acc[ai][bj][m][n]; const f32x4 wv = *(const f32x4*)(w0 + col); f32x4 d;
#pragma unroll
                    for (int e = 0; e < 4; ++e) { const float x = -(wv[e] + a[e]);
                        const float sp = fmaxf(x, 0.f) + __builtin_amdgcn_logf(1.f + fexp2(-fabsf(x) * LOG2E)) * 0.6931471805599453f;
                        const float w = -sp - 0.5f; d[e] = fexp2(-fexp2(w * LOG2E) * LOG2E); }
                    *(f32x4*)(dec + row * 512 + col) = d; } }
        } else if (kind == 1) {
            bf16_t* kf = wsp<bf16_t>(WS_KF); const bf16_t* kkb = wsp<bf16_t>(WS_KKB); bf16_t* bbb = wsp<bf16_t>(WS_BBB);
            const float* a0 = KP()->in[I_A0] + l * 512; const float* ka = KP()->in[I_KA] + l * 512;
            FOR_AM { const size_t row = row0 + EPI_ROWS(ai, m);
                FOR_BN { const int col = cb + EPI_COLS(bj, n); const f32x4 a = acc[ai][bj][m][n];
                    const f32x4 av = *(const f32x4*)(a0 + col), kav = *(const f32x4*)(ka + col);
                    const f32x4 kp = ld_bf4(kf + row * 512 + col), kk = ld_bf4(kkb + row * 512 + col); f32x4 ko, bo;
#pragma unroll
                    for (int e = 0; e < 4; ++e) { const float s = fsigmoid(av[e] + a[e]); ko[e] = kp[e] * (1.f + (s - 1.f) * kav[e]); bo[e] = kk[e] * s; }
                    st_bf4(kf + row * 512 + col, ko); st_bf4(bbb + row * 512 + col, bo); } }
        } else if (kind == 2) {
            epi_store_bf16(acc, wsp<bf16_t>(WS_GG) + row0 * 512 + cb, 512, wr, wc, fr, fq);
        } else {
            const bf16_t* vv = wsp<bf16_t>(WS_VV); bf16_t* v2 = wsp<bf16_t>(WS_V2); const bf16_t* vfirst = wsp<bf16_t>(WS_VFIRST); const float* v0 = KP()->in[I_V0];
            FOR_AM { const size_t row = row0 + EPI_ROWS(ai, m); const size_t arow = (size_t)(row >> 9) * SEQ + cbase + (row & 511);
                FOR_BN { const int col = cb + EPI_COLS(bj, n); const f32x4 a = acc[ai][bj][m][n];
                    const f32x4 vp = ld_bf4(vv + row * 512 + col), vf = ld_bf4(vfirst + arow * 512 + col), v0v = *(const f32x4*)(v0 + col); f32x4 o;
#pragma unroll
                    for (int e = 0; e < 4; ++e) o[e] = vp[e] + (vf[e] - vp[e]) * fsigmoid(v0v[e] + a[e]);
                    st_bf4(v2 + row * 512 + col, o); } }
        }
    }
};
struct EpiMerge {
    DI void operator()(const AccT& acc, const Unit& u, int wr, int wc, int fr, int fq) const {
        float* y32 = wsp<float>(WS_Y32); bf16_t* y = wsp<bf16_t>(WS_Y); const bf16_t* gates = wsp<bf16_t>(WS_GATES);
        const size_t row0 = (size_t)u.pm * 256; const int c0 = u.pn * 256;
        FOR_AM { const size_t row = row0 + EPI_ROWS(ai, m);
            FOR_BN { const int col = c0 + EPI_COLS(bj, n);
                f32x4 v = acc[ai][bj][m][n] * ld_bf4(gates + row * 3072 + u.z * 1024 + col);
                float* yp = y32 + row * 1024 + col;
                if (u.z > 0) v += *(const f32x4*)yp;
                if (u.z < 2) *(f32x4*)yp = v; else st_bf4(y + row * 1024 + col, v);
            } }
    }
};
struct EpiRes {
    int first, amode, cbase;
    DI void operator()(const AccT& acc, const Unit& u, int wr, int wc, int fr, int fq) const {
        float* out = KP()->out; const float* res = first ? KP()->in[I_X] : (const float*)out;
        const size_t grow0 = amode ? ((size_t)(u.pm >> 1) * SEQ + cbase + (u.pm & 1) * 256) : (size_t)u.pm * 256; const int c0 = u.pn * 256;
        FOR_AM { const size_t row = grow0 + EPI_ROWS(ai, m);
            FOR_BN { const size_t o = row * DM + c0 + EPI_COLS(bj, n); *(f32x4*)(out + o) = *(const f32x4*)(res + o) + acc[ai][bj][m][n]; } }
    }
};
struct EpiSwiglu {
    DI void operator()(const AccT& acc, const Unit& u, int wr, int wc, int fr, int fq) const {
        bf16_t* act = wsp<bf16_t>(WS_ACT);
        FOR_AM { bf16_t* rp = act + ((size_t)u.pm * 256 + EPI_ROWS(ai, m)) * DFF + u.pn * 128 + 32 * wc + 4 * fq;
#pragma unroll
            for (int n = 0; n < 2; ++n) { const f32x4 g = acc[ai][0][m][n], up = acc[ai][1][m][n]; f32x4 o;
#pragma unroll
                for (int e = 0; e < 4; ++e) o[e] = g[e] * fsigmoid(g[e]) * up[e];
                st_bf4(rp + 16 * n, o); } }
    }
};

DI void phase_dcn(int l) {
    const int lane = TID() & 63, gw = BID() * 8 + (TID() >> 6), nw = gridDim.x * 8;
    bf16_t* dcn = wsp<bf16_t>(WS_DCN);
    const f32x4 g = *(const f32x4*)(KP()->in[I_KVN] + l * 256 + 4 * lane);
    for (int row = gw; row < NT; row += nw) {
        bf16_t* rp = dcn + (size_t)row * 256 + 4 * lane;
        const f32x4 v = ld_bf4(rp);
        const float ss = wave_sum(v[0] * v[0] + v[1] * v[1] + v[2] * v[2] + v[3] * v[3]);
        const float rs = __builtin_amdgcn_rsqf(ss * (1.f / 256.f) + NORM_EPS);
        st_bf4(rp, v * rs * g);
    }
}
DI void phase_kmean() {
    const int lane = TID() & 63, gw = BID() * 8 + (TID() >> 6), nw = gridDim.x * 8;
    const bf16_t* mk = wsp<bf16_t>(WS_MK); float* km = wsp<float>(WS_KMEAN);
    for (int it = gw; it < NB * NH * 8; it += nw) {
        const int n = it & 7, h = (it >> 3) & 7, b = it >> 6;
        const bf16_t* kp = mk + ((size_t)b * SEQ + n * 256) * 512 + h * 64 + lane;
        float s = 0.f;
#pragma unroll 8
        for (int k = 0; k < 256; ++k) s += bf2f(kp[(size_t)k * 512]);
        km[(size_t)it * 64 + lane] = s * (1.f / 256.f);
    }
}

DI void phase_rwkv_prep(int l, int c) {
    const int lane = TID() & 63, gw = BID() * 8 + (TID() >> 6), nw = gridDim.x * 8;
    const bf16_t* raw = wsp<bf16_t>(WS_RAW); const bf16_t* left = wsp<bf16_t>(WS_LEFT); bf16_t* carry = wsp<bf16_t>(WS_CARRY);
    bf16_t* rr = wsp<bf16_t>(WS_RR); bf16_t* kf = wsp<bf16_t>(WS_KF); bf16_t* vv = wsp<bf16_t>(WS_VV); bf16_t* kkb = wsp<bf16_t>(WS_KKB);
    bf16_t* la = wsp<bf16_t>(WS_LORAA); bf16_t* vfirst = wsp<bf16_t>(WS_VFIRST);
    const float* mu = KP()->in[I_MU] + l * 1824; const float* kkw = KP()->in[I_KK] + l * 512;
    for (int rc = gw; rc < TC; rc += nw) {
        const int b = rc >> 9, sl = rc & 511, s = c * SC + sl; const size_t ra = (size_t)b * SEQ + s;
        const bf16_t* cur = raw + (size_t)rc * RAWLD;
        const bf16_t* prv = (sl > 0) ? (cur - RAWLD) : (carry + (size_t)((((c + 1) & 1) * 16) + b) * RAWLD);
        const bool hp = s > 0;
        auto mix8 = [&](int j, float* o) {
            const u32x4 cu = *(const u32x4*)(cur + j); u32x4 pu = {0u, 0u, 0u, 0u}; if (hp) pu = *(const u32x4*)(prv + j);
            const f32x4 m0 = *(const f32x4*)(mu + j), m1 = *(const f32x4*)(mu + j + 4);
#pragma unroll
            for (int e = 0; e < 4; ++e) { const float c0 = bflo(cu[e]), c1 = bfhi(cu[e]), p0 = bflo(pu[e]), p1 = bfhi(pu[e]);
                const float ma = (2 * e < 4) ? m0[2 * e] : m1[2 * e - 4], mb = (2 * e + 1 < 4) ? m0[2 * e + 1] : m1[2 * e + 1 - 4];
                o[2 * e] = c0 + (p0 - c0) * ma; o[2 * e + 1] = c1 + (p1 - c1) * mb; }
        };
        auto mix1 = [&](int j) -> float { const float c0 = bf2f(cur[j]); const float p0 = hp ? bf2f(prv[j]) : 0.f; return c0 + (p0 - c0) * mu[j]; };
        float o[8];
        mix8(8 * lane, o);
        { u32x4 w; w[0] = pk2(o[0], o[1]); w[1] = pk2(o[2], o[3]); w[2] = pk2(o[4], o[5]); w[3] = pk2(o[6], o[7]); *(u32x4*)(rr + (size_t)rc * 512 + 8 * lane) = w; }
        mix8(576 + 8 * lane, o);
        { u32x4 w; w[0] = pk2(o[0], o[1]); w[1] = pk2(o[2], o[3]); w[2] = pk2(o[4], o[5]); w[3] = pk2(o[6], o[7]); *(u32x4*)(kf + (size_t)rc * 512 + 8 * lane) = w;
          const f32x4 k0 = *(const f32x4*)(kkw + 8 * lane), k1 = *(const f32x4*)(kkw + 8 * lane + 4);
          float q[8]; float ss = 0.f;
#pragma unroll
          for (int e = 0; e < 8; ++e) { q[e] = o[e] * (e < 4 ? k0[e] : k1[e - 4]); ss += q[e] * q[e]; }
          ss += __shfl_xor(ss, 1); ss += __shfl_xor(ss, 2); ss += __shfl_xor(ss, 4);
          const float inv = 1.f / fmaxf(sqrtf(ss), 1e-12f);
          w[0] = pk2(q[0] * inv, q[1] * inv); w[1] = pk2(q[2] * inv, q[3] * inv); w[2] = pk2(q[4] * inv, q[5] * inv); w[3] = pk2(q[6] * inv, q[7] * inv);
          *(u32x4*)(kkb + (size_t)rc * 512 + 8 * lane) = w; }
        mix8(1088 + 8 * lane, o);
        { u32x4 w; w[0] = pk2(o[0], o[1]); w[1] = pk2(o[2], o[3]); w[2] = pk2(o[4], o[5]); w[3] = pk2(o[6], o[7]); *(u32x4*)(vv + (size_t)rc * 512 + 8 * lane) = w;
          if (l == 0) *(u32x4*)(vfirst + ra * 512 + 8 * lane) = w; }
        bf16_t* lr = la + (size_t)rc * 512;
        { const float x = mix1(512 + lane); const float t = fexp2(2.f * x * LOG2E); lr[lane] = f2bf(1.f - 2.f * frcp(t + 1.f)); }
        lr[64 + lane] = f2bf(mix1(1600 + lane));
        lr[128 + lane] = f2bf(fsigmoid(mix1(1664 + lane)));
        lr[192 + lane] = f2bf(fsigmoid(mix1(1728 + lane)));
        if (lane < 32) { const float c0 = bf2f(left[ra * 32 + lane]); const float p0 = hp ? bf2f(left[(ra - 1) * 32 + lane]) : 0.f;
            lr[256 + lane] = f2bf(fsigmoid(c0 + (p0 - c0) * mu[1792 + lane])); }
        if (lane < 56) *(u32x2*)(lr + 288 + 4 * lane) = (u32x2){0u, 0u};
        if (sl == SC - 1) { bf16_t* cp = carry + (size_t)(((c & 1) * 16) + b) * RAWLD;
            for (int j = lane; j < RAWLD / 8; j += 64) *(u32x4*)(cp + 8 * j) = *(const u32x4*)(cur + 8 * j); }
    }
}

DI float dpp_ror_add(float x, int) { return x; }
DI void reduce4(float p0, float p1, float p2, float p3, float& s0, float& s1, float& s2, float& s3) {
    auto r = __builtin_amdgcn_permlane32_swap(__float_as_uint(p0), __float_as_uint(p2), false, false);
    const float u0 = __uint_as_float(r[0]) + __uint_as_float(r[1]);
    r = __builtin_amdgcn_permlane32_swap(__float_as_uint(p1), __float_as_uint(p3), false, false);
    const float u1 = __uint_as_float(r[0]) + __uint_as_float(r[1]);
    r = __builtin_amdgcn_permlane16_swap(__float_as_uint(u0), __float_as_uint(u1), false, false);
    float w = __uint_as_float(r[0]) + __uint_as_float(r[1]);
    w += __uint_as_float(__builtin_amdgcn_update_dpp(0, __float_as_uint(w), 0x128, 0xf, 0xf, false));
    w += __uint_as_float(__builtin_amdgcn_update_dpp(0, __float_as_uint(w), 0x124, 0xf, 0xf, false));
    w += __uint_as_float(__builtin_amdgcn_update_dpp(0, __float_as_uint(w), 0x122, 0xf, 0xf, false));
    w += __uint_as_float(__builtin_amdgcn_update_dpp(0, __float_as_uint(w), 0x121, 0xf, 0xf, false));
    s0 = __uint_as_float(__builtin_amdgcn_readlane(__float_as_uint(w), 0));
    s1 = __uint_as_float(__builtin_amdgcn_readlane(__float_as_uint(w), 16));
    s2 = __uint_as_float(__builtin_amdgcn_readlane(__float_as_uint(w), 32));
    s3 = __uint_as_float(__builtin_amdgcn_readlane(__float_as_uint(w), 48));
}
struct ScanIn { bf16_t kk, bb, k, r, v; float w; };
DI void phase_scan(int l, int c) {
    const int lane = TID() & 63, gw = BID() * 8 + (TID() >> 6), nw = gridDim.x * 8;
    const bf16_t* kkb = wsp<bf16_t>(WS_KKB); const bf16_t* bbb = wsp<bf16_t>(WS_BBB); const bf16_t* kfb = wsp<bf16_t>(WS_KF); const bf16_t* rrb = wsp<bf16_t>(WS_RR);
    const bf16_t* vsb = wsp<bf16_t>(l == 0 ? WS_VV : WS_V2); const float* dec = wsp<float>(WS_DEC); float* outb = wsp<float>(WS_OUT); float* state = wsp<float>(WS_STATE);
    for (int item = gw; item < NB * NH * 16; item += nw) {
        const int bh = item >> 4, rg = item & 15, b = bh >> 3, h = bh & 7, i0 = rg * 4;
        float* stp = state + ((size_t)bh * 64 + i0) * 64 + lane;
        float S0 = 0.f, S1 = 0.f, S2 = 0.f, S3 = 0.f;
        if (c > 0) { S0 = stp[0]; S1 = stp[64]; S2 = stp[128]; S3 = stp[192]; }
        const size_t e0 = (size_t)b * SC * 512 + h * 64 + lane;
        const size_t ev = (size_t)b * SC * 512 + h * 64 + i0 + (lane & 3);
        float* op = outb + (size_t)b * SC * 512 + h * 64 + i0 + (lane >> 4);
        ScanIn A[8], B[8];
#define SCAN_LOAD(X, g) do { _Pragma("unroll") for (int j = 0; j < 8; ++j) { const size_t o = (size_t)((g) * 8 + j) * 512; \
            X[j].kk = kkb[e0 + o]; X[j].bb = bbb[e0 + o]; X[j].k = kfb[e0 + o]; X[j].r = rrb[e0 + o]; X[j].w = dec[e0 + o]; X[j].v = vsb[ev + o]; } } while (0)
#define SCAN_STEP(X, g) do { _Pragma("unroll") for (int j = 0; j < 8; ++j) { \
            const float kk = bf2f(X[j].kk), bb = bf2f(X[j].bb), kx = bf2f(X[j].k), rx = bf2f(X[j].r), wx = X[j].w; const unsigned vu = (unsigned)X[j].v << 16; \
            const float v0 = __uint_as_float(__builtin_amdgcn_readlane(vu, 0)), v1 = __uint_as_float(__builtin_amdgcn_readlane(vu, 1)), v2 = __uint_as_float(__builtin_amdgcn_readlane(vu, 2)), v3 = __uint_as_float(__builtin_amdgcn_readlane(vu, 3)); \
            float a0, a1, a2, a3; reduce4(S0 * kk, S1 * kk, S2 * kk, S3 * kk, a0, a1, a2, a3); \
            S0 = S0 * wx + (v0 * kx - a0 * bb); S1 = S1 * wx + (v1 * kx - a1 * bb); S2 = S2 * wx + (v2 * kx - a2 * bb); S3 = S3 * wx + (v3 * kx - a3 * bb); \
            float o0, o1, o2, o3; reduce4(S0 * rx, S1 * rx, S2 * rx, S3 * rx, o0, o1, o2, o3); \
            const int q4 = lane >> 4; const float ov = q4 == 0 ? o0 : (q4 == 1 ? o1 : (q4 == 2 ? o2 : o3)); \
            if ((lane & 15) == 0) op[(size_t)((g) * 8 + j) * 512] = ov; } } while (0)
        SCAN_LOAD(A, 0);
        for (int g = 0; g < SC / 8; g += 2) {
            SCAN_LOAD(B, g + 1);
            SCAN_STEP(A, g);
            if (g + 2 < SC / 8) SCAN_LOAD(A, g + 2);
            SCAN_STEP(B, g + 1);
        }
#undef SCAN_LOAD
#undef SCAN_STEP
        stp[0] = S0; stp[64] = S1; stp[128] = S2; stp[192] = S3;
    }
}
DI void phase_rwkv_post(int l) {
    const int lane = TID() & 63, gw = BID() * 8 + (TID() >> 6), nw = gridDim.x * 8;
    const float* outb = wsp<float>(WS_OUT); const bf16_t* rrb = wsp<bf16_t>(WS_RR); const bf16_t* kfb = wsp<bf16_t>(WS_KF);
    const bf16_t* vsb = wsp<bf16_t>(l == 0 ? WS_VV : WS_V2); const bf16_t* ggb = wsp<bf16_t>(WS_GG); bf16_t* orw = wsp<bf16_t>(WS_ORW);
    const float* lnw = KP()->in[I_LNW] + l * 512; const float* lnb = KP()->in[I_LNB] + l * 512; const float* rk = KP()->in[I_RK] + l * 512;
    for (int it = gw; it < TC * NH; it += nw) {
        const int h = it & 7; const size_t e = (size_t)(it >> 3) * 512 + h * 64 + lane;
        const float o = outb[e];
        const float mean = wave_sum(o) * (1.f / 64.f); const float d = o - mean;
        const float var = wave_sum(d * d) * (1.f / 64.f);
        const float bonus = wave_sum(bf2f(rrb[e]) * bf2f(kfb[e]) * rk[h * 64 + lane]);
        float y = d * __builtin_amdgcn_rsqf(var + 64e-5f) * lnw[h * 64 + lane] + lnb[h * 64 + lane];
        y = (y + bonus * bf2f(vsb[e])) * bf2f(ggb[e]);
        orw[e] = f2bf(y);
    }
}

#define MFMA32(a, b, c) __builtin_amdgcn_mfma_f32_32x32x16_bf16((a), (b), (c), 0, 0, 0)
DI unsigned fkey(float v) { v = v + 0.f; const unsigned u = __float_as_uint(v); return (u & 0x80000000u) ? ~u : (u | 0x80000000u); }
DI void phase_dsa_select(int c) {
    const int lane = TID() & 63, gw = BID() * 8 + (TID() >> 6), nw = gridDim.x * 8;
    for (int item = gw; item < TC / 4; item += nw) {
        int lz = lane; asm volatile("" : "+v"(lz));
        const int hh = lz >> 5, r5 = lz & 31;
        const int rc0 = item * 4, b = rc0 >> 9, t0 = c * SC + (rc0 & 511);
        const int qq = ((r5 >> 2) & 1) + 2 * (r5 >> 4), hd = (r5 & 3) + 4 * ((r5 >> 3) & 1);
        const bf16_t* qp = wsp<bf16_t>(WS_IDXQ) + (size_t)(rc0 + qq) * 256 + hd * 32 + 8 * hh;
        const bf16x8 Af0 = *(const bf16x8*)qp, Af1 = *(const bf16x8*)(qp + 16);
        const float* wp = wsp<float>(WS_IDXW) + ((size_t)b * SEQ + t0 + hh) * 8;
        const f32x4 wa0 = *(const f32x4*)wp, wa1 = *(const f32x4*)(wp + 4), wb0 = *(const f32x4*)(wp + 16), wb1 = *(const f32x4*)(wp + 20);
        const int tA = t0 + hh, tB = t0 + hh + 2;
        const int ngrp = ((t0 + 3) >> 9) + 1;
        unsigned keyA[64], keyB[64];
        const bf16_t* kbase = wsp<bf16_t>(WS_IDXK) + ((size_t)b * SEQ + r5) * 32 + 8 * hh;
        int keyv = r5;
        unsigned kofs = 0u;
#pragma unroll
        for (int g = 0; g < 4; ++g) {
            if (g < ngrp) {
#pragma unroll
                for (int j = 0; j < 16; ++j) {
                    const int kt = g * 16 + j;
                    const bf16_t* kp = kbase + kofs;
                    const bf16x8 Bf0 = *(const bf16x8*)kp, Bf1 = *(const bf16x8*)(kp + 16);
                    f32x16 C = {0.f, 0.f, 0.f, 0.f, 0.f, 0.f, 0.f, 0.f, 0.f, 0.f, 0.f, 0.f, 0.f, 0.f, 0.f, 0.f};
                    C = MFMA32(Af0, Bf0, C); C = MFMA32(Af1, Bf1, C);
                    float va = 0.f, vb = 0.f;
#pragma unroll
                    for (int i = 0; i < 4; ++i) { va += fmaxf(C[i], 0.f) * wa0[i]; vb += fmaxf(C[8 + i], 0.f) * wb0[i]; }
#pragma unroll
                    for (int i = 0; i < 4; ++i) { va += fmaxf(C[4 + i], 0.f) * wa1[i]; vb += fmaxf(C[12 + i], 0.f) * wb1[i]; }
                    unsigned ka = (keyv <= tA) ? fkey(va) : 0u, kb = (keyv <= tB) ? fkey(vb) : 0u;
                    asm volatile("" : "+v"(ka), "+v"(kb), "+v"(keyv), "+v"(kofs));
                    keyA[kt] = ka; keyB[kt] = kb;
                    keyv += 32; kofs += 32 * 32;
                }
            } else {
#pragma unroll
                for (int j = 0; j < 16; ++j) { keyA[g * 16 + j] = 0u; keyB[g * 16 + j] = 0u; }
            }
        }
        unsigned KA = 0u, KB = 0u;
        if (t0 + 3 >= 256) {
            for (int bit = 31; bit >= 0; --bit) {
                const unsigned bm = 1u << bit;
                const unsigned cA = KA | bm, cB = KB | bm;
                int nA = 0, nB = 0;
#pragma unroll
                for (int g = 0; g < 4; ++g) {
                    if (g < ngrp) {
#pragma unroll
                        for (int j = 0; j < 16; ++j) { nA += (keyA[g * 16 + j] >= cA) ? 1 : 0; nB += (keyB[g * 16 + j] >= cB) ? 1 : 0; }
                    }
                }
#pragma unroll
                for (int o = 16; o >= 1; o >>= 1) { nA += __shfl_xor(nA, o); nB += __shfl_xor(nB, o); }
                if (nA >= 256) KA = cA;
                if (nB >= 256) KB = cB;
            }
        }
        int gA = 0, gB = 0;
#pragma unroll
        for (int kt = 0; kt < 64; ++kt) { gA += (keyA[kt] > KA) ? 1 : 0; gB += (keyB[kt] > KB) ? 1 : 0; }
#pragma unroll
        for (int o = 16; o >= 1; o >>= 1) { gA += __shfl_xor(gA, o); gB += __shfl_xor(gB, o); }
        const int needA = (KA == 0u) ? 0 : 256 - gA, needB = (KB == 0u) ? 0 : 256 - gB;
        asm volatile("" : "+v"(KA), "+v"(KB));
        int runA = 0, runB = 0, lsel = lz;
        unsigned w0 = 0u, w1 = 0u, w2 = 0u, w3 = 0u;
#pragma unroll
        for (int kt = 0; kt < 64; ++kt) {
            const bool eqA = keyA[kt] == KA, eqB = keyB[kt] == KB;
            const unsigned long long ea = __ballot(eqA), eb = __ballot(eqB);
            const int rkA = runA + (hh ? (int)__builtin_amdgcn_mbcnt_hi((unsigned)(ea >> 32), 0u) : (int)__builtin_amdgcn_mbcnt_lo((unsigned)ea, 0u));
            const int rkB = runB + (hh ? (int)__builtin_amdgcn_mbcnt_hi((unsigned)(eb >> 32), 0u) : (int)__builtin_amdgcn_mbcnt_lo((unsigned)eb, 0u));
            const bool sA = (keyA[kt] > KA) || (eqA && rkA < needA), sB = (keyB[kt] > KB) || (eqB && rkB < needB);
            runA += hh ? __builtin_popcount((unsigned)(ea >> 32)) : __builtin_popcount((unsigned)ea);
            runB += hh ? __builtin_popcount((unsigned)(eb >> 32)) : __builtin_popcount((unsigned)eb);
            const unsigned long long sa = __ballot(sA), sb = __ballot(sB);
            if (lsel == 0) { w0 = (unsigned)sa; w1 = (unsigned)(sa >> 32); w2 = (unsigned)sb; w3 = (unsigned)(sb >> 32); }
            lsel -= 1; asm volatile("" : "+v"(lsel));
            __builtin_amdgcn_sched_barrier(0);
        }
        unsigned* sp = wsp<unsigned>(WS_SELB) + (size_t)rc0 * 64 + lz;
        sp[0] = w0; sp[64] = w1; sp[128] = w2; sp[192] = w3;
    }
}

struct AttnSt { f32x16 O0, O1; float m, l; };
constexpr float C2 = 0.125f * LOG2E;
template <int MODE, bool FAR>
DI void attn_tile(AttnSt& st, const bf16x8 (&Qf)[4], const bf16_t* kbase, const bf16_t* vtbase, int key0, int tq, bool allowed, unsigned word, LAS const float* bt, int lane) {
    const int r5 = lane & 31, hh = lane >> 5;
    const int prow = (r5 & 19) | ((r5 & 4) << 1) | ((r5 & 8) >> 1);
    const bf16_t* kp = kbase + (size_t)(key0 + prow) * 512;
    bf16x8 Kf[4];
#pragma unroll
    for (int s = 0; s < 4; ++s) Kf[s] = *(const bf16x8*)(kp + 16 * s);
    f32x16 S = {0.f, 0.f, 0.f, 0.f, 0.f, 0.f, 0.f, 0.f, 0.f, 0.f, 0.f, 0.f, 0.f, 0.f, 0.f, 0.f};
#pragma unroll
    for (int s = 0; s < 4; ++s) S = MFMA32(Kf[s], Qf[s], S);
    bf16x8 Vf[2][2];
#pragma unroll
    for (int n = 0; n < 2; ++n)
#pragma unroll
        for (int s = 0; s < 2; ++s) Vf[n][s] = *(const bf16x8*)(vtbase + (size_t)(32 * n) * SEQ + key0 + 16 * s);
    float x[16]; bool ok[16];
    const float cfar = bt[127];
    float mx = -INFINITY;
#pragma unroll
    for (int i = 0; i < 16; ++i) {
        const int koff = 16 * (i >> 3) + 8 * hh + (i & 7);
        float bias;
        if (FAR) { bias = cfar; ok[i] = (MODE == 0) ? allowed : (((word >> koff) & 1u) != 0u); }
        else { const int dist = tq - (key0 + koff); ok[i] = (MODE == 0) ? (allowed && dist >= 0) : (((word >> koff) & 1u) != 0u); bias = bt[min(max(dist, 0), 127)]; }
        x[i] = ok[i] ? (S[i] * C2 + bias) : -INFINITY;
        mx = fmaxf(mx, x[i]);
    }
    mx = fmaxf(mx, __shfl_xor(mx, 32));
    const float mnew = fmaxf(st.m, mx);
    const float muse = (mnew == -INFINITY) ? 0.f : mnew;
    const float alpha = fexp2(st.m - muse);
    float ps = 0.f; float pv[16];
#pragma unroll
    for (int i = 0; i < 16; ++i) { pv[i] = ok[i] ? fexp2(x[i] - muse) : 0.f; ps += pv[i]; }
    st.l = st.l * alpha + ps; st.m = mnew;
#pragma unroll
    for (int i = 0; i < 16; ++i) { st.O0[i] *= alpha; st.O1[i] *= alpha; }
#pragma unroll
    for (int s = 0; s < 2; ++s) {
        u32x4 pw; pw[0] = pk2(pv[8 * s], pv[8 * s + 1]); pw[1] = pk2(pv[8 * s + 2], pv[8 * s + 3]); pw[2] = pk2(pv[8 * s + 4], pv[8 * s + 5]); pw[3] = pk2(pv[8 * s + 6], pv[8 * s + 7]);
        const bf16x8 Pf = __builtin_bit_cast(bf16x8, pw);
        st.O0 = MFMA32(Vf[0][s], Pf, st.O0); st.O1 = MFMA32(Vf[1][s], Pf, st.O1);
    }
}
template <int MODE>
DI void attn_item(int c, int b, int h, int qt, LAS const float* bt, int lane) {
    const int r5 = lane & 31, hh = lane >> 5;
    bf16_t* qbuf = wsp<bf16_t>(MODE == 0 ? WS_MQ : WS_DQ);
    const bf16_t* kb = wsp<bf16_t>(MODE == 0 ? WS_MK : WS_DK) + (size_t)b * SEQ * 512 + h * 64 + 8 * hh;
    const bf16_t* vtb = wsp<bf16_t>(MODE == 0 ? WS_MVT : WS_DVT) + ((size_t)b * 512 + h * 64 + r5) * SEQ + 8 * hh;
    const int rowc0 = b * SC + 32 * qt, t0 = c * SC + 32 * qt, tq = t0 + r5;
    bf16_t* qp = qbuf + (size_t)(rowc0 + r5) * 512 + h * 64;
    bf16x8 Qf[4];
#pragma unroll
    for (int s = 0; s < 4; ++s) Qf[s] = *(const bf16x8*)(qp + 16 * s + 8 * hh);
    AttnSt st; st.m = -INFINITY; st.l = 0.f;
#pragma unroll
    for (int i = 0; i < 16; ++i) { st.O0[i] = 0.f; st.O1[i] = 0.f; }
    if (MODE == 0) {
        const int own = t0 >> 8;
        unsigned bm = 0u;
        if (own > 0) {
            const float* km = wsp<float>(WS_KMEAN) + ((size_t)(b * 8 + h) * 8) * 64 + 8 * hh;
            float g[8];
#pragma unroll
            for (int n = 0; n < 8; ++n) {
                g[n] = -INFINITY;
                if (n < own) {
                    float part = 0.f;
#pragma unroll
                    for (int s = 0; s < 4; ++s) { const f32x4 k0 = *(const f32x4*)(km + n * 64 + 16 * s), k1 = *(const f32x4*)(km + n * 64 + 16 * s + 4);
#pragma unroll
                        for (int j = 0; j < 4; ++j) part += bf2f((bf16_t)Qf[s][j]) * k0[j] + bf2f((bf16_t)Qf[s][4 + j]) * k1[j]; }
                    g[n] = part + __shfl_xor(part, 32);
                }
            }
#pragma unroll
            for (int n = 0; n < 8; ++n) {
                if (n < own) { int rank = 0;
#pragma unroll
                    for (int m2 = 0; m2 < 8; ++m2) if (m2 != n && m2 < own) rank += ((g[m2] > g[n]) || (g[m2] == g[n] && m2 < n)) ? 1 : 0;
                    if (rank < 3) bm |= 1u << n; }
            }
        }
        for (int nb = 0; nb <= own; ++nb) {
            const bool isown = (nb == own);
            const bool allowed = isown || (((bm >> nb) & 1u) != 0u);
            if (!isown && __ballot(allowed) == 0ull) continue;
            const int kt0 = nb * 8, kt1 = isown ? ((t0 + 31) >> 5) : (nb * 8 + 7);
            for (int kt = kt0; kt <= kt1; ++kt) {
                const int key0 = kt * 32;
                if (t0 - (key0 + 31) >= 113) attn_tile<0, true>(st, Qf, kb, vtb, key0, tq, allowed, 0u, bt, lane);
                else attn_tile<0, false>(st, Qf, kb, vtb, key0, tq, allowed, 0u, bt, lane);
            }
        }
    } else {
        const unsigned* sp = wsp<unsigned>(WS_SELB) + (size_t)(rowc0 + r5) * 64;
        const int kt1 = (t0 + 31) >> 5;
        for (int kt = 0; kt <= kt1; ++kt) {
            const unsigned word = sp[kt];
            if (__ballot(word != 0u) == 0ull) continue;
            const int key0 = kt * 32;
            if (t0 - (key0 + 31) >= 113) attn_tile<1, true>(st, Qf, kb, vtb, key0, tq, true, word, bt, lane);
            else attn_tile<1, false>(st, Qf, kb, vtb, key0, tq, true, word, bt, lane);
        }
    }
    const float lt = st.l + __shfl_xor(st.l, 32);
    const float inv = 1.f / lt;
#pragma unroll
    for (int g4 = 0; g4 < 4; ++g4) {
        st_bf4(qp + 8 * g4 + 4 * hh, (f32x4){st.O0[4 * g4] * inv, st.O0[4 * g4 + 1] * inv, st.O0[4 * g4 + 2] * inv, st.O0[4 * g4 + 3] * inv});
        st_bf4(qp + 32 + 8 * g4 + 4 * hh, (f32x4){st.O1[4 * g4] * inv, st.O1[4 * g4 + 1] * inv, st.O1[4 * g4 + 2] * inv, st.O1[4 * g4 + 3] * inv});
    }
}
__device__ const unsigned char kBucket[128] = {0,1,2,3,4,5,6,7,8,9,10,11,12,13,14,15,16,16,16,17,17,18,18,18,19,19,19,20,20,20,20,21,21,21,21,22,22,22,22,22,23,23,23,23,23,23,24,24,24,24,24,24,25,25,25,25,25,25,25,26,26,26,26,26,26,26,26,27,27,27,27,27,27,27,27,27,27,28,28,28,28,28,28,28,28,28,28,29,29,29,29,29,29,29,29,29,29,29,29,30,30,30,30,30,30,30,30,30,30,30,30,30,30,31,31,31,31,31,31,31,31,31,31,31,31,31,31,31};
DI void phase_attn(int l, int c, LAS float* lds) {
    const int tid = TID(), lane = tid & 63, wave = tid >> 6;
    for (int e = tid; e < 2 * 8 * 128; e += 512) { const int d = e & 127, h = (e >> 7) & 7, mx = e >> 10; lds[e] = KP()->in[I_REL][kBucket[d] * 16 + mx * 8 + h] * LOG2E; }
    __syncthreads();
    const int nw = gridDim.x * 8;
    for (int it = BID() * 8 + wave; it < NB * NH * 16; it += nw) {
        const int bh = it >> 4, b = bh >> 3, h = bh & 7, qm = it & 15, qd = 15 - qm;
        attn_item<0>(c, b, h, qm, lds + h * 128, lane);
        attn_item<1>(c, b, h, qd, lds + 1024 + h * 128, lane);
    }
    phase_rwkv_post(l);
}

constexpr int LDS_BYTES = pg8::STAGE_BYTES + 256;
constexpr int PH_PER_LAYER = 36, N_PHASES = 2 * PH_PER_LAYER;
#ifndef MK_ONE_LAUNCH
#define MK_ONE_LAUNCH 0
#endif
__global__ void __launch_bounds__(512, 2) mega(Params p) {
    extern __shared__ __attribute__((aligned(16))) unsigned char lds_raw[];
    LAS unsigned char* lds = (LAS unsigned char*)lds_raw;
    volatile LAS unsigned* bst = (volatile LAS unsigned*)(lds + pg8::STAGE_BYTES);
    if (TID() < 4) bst[TID()] = 0u;
    __syncthreads();
    if (p.ph_hi - p.ph_lo > 1) (void)xcd_barrier_post((unsigned*)(KP()->ws + WS_CTL), bst);
#ifndef PH_ONLY
#define PH_ONLY -1
#endif
#define IN(k) (KP()->ph_lo <= (k) && (k) < KP()->ph_hi)
#define INT(tag, k) ((PH_ONLY < 0 || PH_ONLY == (tag)) && IN(k))
#define SEAM(k) do { if (IN(k) && IN((k) + 1)) { XcdBarrier bar_; bar_.bar = (unsigned*)(KP()->ws + WS_CTL); bar_.x = xb_xcc_id(); bar_.st = (volatile LAS unsigned*)(lds + pg8::STAGE_BYTES); xcd_barrier(bar_); } } while (0)
    for (int l = 0; l < 2; ++l) {
        const int pb = PH_PER_LAYER * l;
        if (INT(0, pb + 0)) phase_conv(l, (LAS float*)lds);
        SEAM(pb + 0);
        if (INT(1, pb + 1)) phase_norm(l == 0 ? KP()->in[I_X] : (const float*)KP()->out, KP()->in[I_NMIX] + l * DM, wsp<bf16_t>(WS_H));
        SEAM(pb + 1);
        if (INT(2, pb + 2)) {
            { const SchedLin S = mk_sched(128, 4, WS_H, WS_WB, 1024); const EpiB E{l}; pg8::gemm_phase(lds, 1024, S, E); }
            { const SchedLin S = mk_sched(2, 128, WS_WV, WS_H, 1024); const EpiVt E{(unsigned)WS_MVT}; pg8::gemm_phase(lds, 1024, S, E); }
        }
        SEAM(pb + 2);
        if (INT(3, pb + 3)) { phase_dcn(l); phase_kmean(); }
        SEAM(pb + 3);
        if (INT(4, pb + 4)) {
            { const SchedLin S = mk_sched(128, 2, WS_DCN, WS_WKVK, 256); const EpiHN E{l}; pg8::gemm_phase(lds, 256, S, E); }
            { const SchedLin S = mk_sched(2, 128, WS_WKVV, WS_DCN, 256); const EpiVt E{(unsigned)WS_DVT}; pg8::gemm_phase(lds, 256, S, E); }
        }
        SEAM(pb + 4);
        for (int c = 0; c < NCH; ++c) {
            const int pc = pb + 5 + 7 * c, cbase = c * SC;
            if (INT(5, pc + 0)) { const SchedLin S = mk_sched(32, 24, WS_H, WS_WD1, 1024, 1, cbase); const EpiD1 E{l}; pg8::gemm_phase(lds, 1024, S, E); }
            SEAM(pc + 0);
            if (INT(6, pc + 1)) { phase_rwkv_prep(l, c); phase_dsa_select(c); }
            SEAM(pc + 1);
            if (INT(7, pc + 2)) { const SchedLin S = mk_sched(32, l == 0 ? 6 : 8, WS_LORAA, WS_WL, 512, 0, 0, WS_VV, 6); const EpiLora E{l, cbase}; pg8::gemm_phase(lds, 512, S, E); }
            SEAM(pc + 2);
            if (INT(8, pc + 3)) phase_scan(l, c);
            SEAM(pc + 3);
            if (INT(9, pc + 4)) phase_attn(l, c, (LAS float*)lds);
            SEAM(pc + 4);
            if (INT(10, pc + 5)) { const SchedMerge S{(int)gridDim.x, (int)BID()}; const EpiMerge E{}; pg8::gemm_phase(lds, 512, S, E); }
            SEAM(pc + 5);
            if (INT(11, pc + 6)) { const SchedLin S = mk_sched(32, 4, WS_Y, WS_WO, 1024); const EpiRes E{l == 0 ? 1 : 0, 1, cbase}; pg8::gemm_phase(lds, 1024, S, E); }
            SEAM(pc + 6);
        }
        if (INT(33, pb + 33)) phase_norm(KP()->out, KP()->in[I_NFFN] + l * DM, wsp<bf16_t>(WS_H));
        SEAM(pb + 33);
        if (INT(34, pb + 34)) { const SchedLin S = mk_sched(128, 22, WS_H, WS_WF1, 1024); const EpiSwiglu E{}; pg8::gemm_phase(lds, 1024, S, E); }
        SEAM(pb + 34);
        if (INT(35, pb + 35)) { const SchedLin S = mk_sched(128, 4, WS_ACT, WS_WF2, DFF); const EpiRes E{0, 0, 0}; pg8::gemm_phase(lds, DFF, S, E); }
        SEAM(pb + 35);
    }
#undef IN
#undef INT
#undef SEAM
}

extern "C" void kernel_launch(void* const* d_in, const int* in_sizes, int n_in, void* d_out, int out_size, void* d_ws, size_t ws_size, hipStream_t stream) {
    static int grid = 0;
    if (grid == 0) {
        if (n_in != 26 || ws_size < WS_END) { grid = -1; return; }
        int dev = 0, cus = 0;
        if (hipGetDevice(&dev) != hipSuccess || hipDeviceGetAttribute(&cus, hipDeviceAttributeMultiprocessorCount, dev) != hipSuccess) { grid = -1; return; }
        if (hipFuncSetAttribute((const void*)mega, hipFuncAttributeMaxDynamicSharedMemorySize, LDS_BYTES) != hipSuccess) { grid = -1; return; }
        grid = cus;
    }
    if (grid < 0) return;
    (void)hipMemsetAsync((char*)d_ws + WS_CTL, 0, 64 * 1024, stream);
    Params p{};
    for (int i = 0; i < 26; ++i) p.in[i] = (const float*)d_in[i];
    p.out = (float*)d_out; p.ws = (unsigned char*)d_ws;
#if MK_ONE_LAUNCH
    p.ph_lo = 0; p.ph_hi = N_PHASES;
    hipLaunchKernelGGL(mega, dim3(grid), dim3(512), LDS_BYTES, stream, p);
#else
    for (int ph = 0; ph < N_PHASES; ++ph) { p.ph_lo = ph; p.ph_hi = ph + 1; hipLaunchKernelGGL(mega, dim3(grid), dim3(512), LDS_BYTES, stream, p); }
#endif
}
```

```cpp
#include <hip/hip_runtime.h>
#include <stdint.h>

#define DI __device__ __forceinline__
#define LAS __attribute__((address_space(3)))
typedef unsigned short bf16_t;
typedef short bf16x8 __attribute__((ext_vector_type(8)));
typedef float f32x2 __attribute__((ext_vector_type(2)));
typedef float f32x4 __attribute__((ext_vector_type(4)));
typedef float f32x16 __attribute__((ext_vector_type(16)));
typedef unsigned u32x2 __attribute__((ext_vector_type(2)));
typedef unsigned u32x4 __attribute__((ext_vector_type(4)));
typedef __bf16 bf2_t __attribute__((ext_vector_type(2)));

constexpr int NB = 16, SEQ = 2048, DM = 1024, NT = NB * SEQ, NH = 8, BW = 512;
constexpr int NCH = 4, SC = 512, TC = NB * SC;
constexpr int D_IN = 7496, DFF = 2816;
constexpr int C_MQ = 0, C_MK = 512, C_MV = 1024, C_RW = 1536, C_DS = 3360, C_GT = 4424;
constexpr int RAWLD = 1792;
constexpr float NORM_EPS = 1e-6f;
constexpr float LOG2E = 1.4426950408889634f;

constexpr size_t MiB = 1024 * 1024;
constexpr size_t WS_CTL = 0;
constexpr size_t WS_WB = 64 * 1024;
constexpr size_t WS_WV = WS_WB + 2 * MiB;
constexpr size_t WS_WD1 = WS_WV + 1 * MiB;
constexpr size_t WS_WKVK = WS_WD1 + 12 * MiB;
constexpr size_t WS_WKVV = WS_WKVK + MiB / 4;
constexpr size_t WS_WL = WS_WKVV + MiB / 4;
constexpr size_t WS_WBR = WS_WL + 2 * MiB;
constexpr size_t WS_WO = WS_WBR + 3 * MiB;
constexpr size_t WS_WF1 = WS_WO + 2 * MiB;
constexpr size_t WS_WF2 = WS_WF1 + 11 * MiB;
constexpr size_t WS_VFIRST = WS_WF2 + 6 * MiB;
constexpr size_t WS_STATE = WS_VFIRST + 32 * MiB;
constexpr size_t WS_H = WS_STATE + 2 * MiB;
constexpr size_t WS_IDXK = WS_H + 64 * MiB;
constexpr size_t WS_IDXW = WS_IDXK + 2 * MiB;
constexpr size_t WS_LEFT = WS_IDXW + 1 * MiB;
constexpr size_t WS_DCN = WS_LEFT + 2 * MiB;
constexpr size_t WS_KMEAN = WS_DCN + 16 * MiB;
constexpr size_t WS_CARRY = WS_KMEAN + MiB / 4;
constexpr size_t WS_MK = WS_CARRY + MiB / 4;
constexpr size_t WS_MVT = WS_MK + 32 * MiB;
constexpr size_t WS_DK = WS_MVT + 32 * MiB;
constexpr size_t WS_DVT = WS_DK + 32 * MiB;
constexpr size_t WS_MQ = WS_DVT + 32 * MiB;
constexpr size_t WS_DQ = WS_MQ + 8 * MiB;
constexpr size_t WS_IDXQ = WS_DQ + 8 * MiB;
constexpr size_t WS_RAW = WS_IDXQ + 4 * MiB;
constexpr size_t WS_LORAA = WS_RAW + 28 * MiB;
constexpr size_t WS_Y32 = WS_RAW;
constexpr size_t WS_GATES = WS_LORAA + 8 * MiB;
constexpr size_t WS_RR = WS_GATES + 48 * MiB;
constexpr size_t WS_KF = WS_RR + 8 * MiB;
constexpr size_t WS_VV = WS_KF + 8 * MiB;
constexpr size_t WS_KKB = WS_VV + 8 * MiB;
constexpr size_t WS_BBB = WS_KKB + 8 * MiB;
constexpr size_t WS_GG = WS_BBB + 8 * MiB;
constexpr size_t WS_DEC = WS_GG + 8 * MiB;
constexpr size_t WS_Y = WS_DEC;
constexpr size_t WS_OUT = WS_DEC + 16 * MiB;
constexpr size_t WS_V2 = WS_OUT + 16 * MiB;
constexpr size_t WS_SELB = WS_V2 + 8 * MiB;
constexpr size_t WS_ORW = WS_SELB + 2 * MiB;
constexpr size_t WS_END = WS_ORW + 8 * MiB;
constexpr size_t WS_ACT = WS_MK;
static_assert(WS_END <= 512 * MiB, "workspace map exceeds 512 MiB");
static_assert(WS_ACT + 176 * MiB <= WS_END, "ACT alias");

DI unsigned pk2(float a, float b) { f32x2 v = {a, b}; return __builtin_bit_cast(unsigned, __builtin_convertvector(v, bf2_t)); }
DI bf16_t f2bf(float a) { return (bf16_t)(pk2(a, 0.f) & 0xffffu); }
DI float bflo(unsigned u) { return __uint_as_float(u << 16); }
DI float bfhi(unsigned u) { return __uint_as_float(u & 0xffff0000u); }
DI float bf2f(bf16_t b) { return __uint_as_float((unsigned)b << 16); }
DI float fexp2(float x) { return __builtin_amdgcn_exp2f(x); }
DI float frcp(float x) { return __builtin_amdgcn_rcpf(x); }
DI float fsigmoid(float x) { return frcp(1.f + fexp2(-x * LOG2E)); }
DI float wave_sum(float v) {
#pragma unroll
    for (int o = 32; o >= 1; o >>= 1) v += __shfl_xor(v, o);
    return v;
}

#define XB_TMO      128
#define XB_XCNT(j)  (256  + 64 * (j))
#define XB_XSUB(j)  (1280 + 64 * (j))
#define XB_XGEN(j)  (2304 + 64 * (j))
#define XB_TOP      3328
#define XB_TOPGEN   3392
#define XCD_BAR_WORDS 3456
#define XB_SPIN_CAP (1u << 18)
__device__ __forceinline__ unsigned xb_ld(unsigned* p)              { return __hip_atomic_load(p, __ATOMIC_RELAXED, __HIP_MEMORY_SCOPE_AGENT); }
__device__ __forceinline__ unsigned xb_add(unsigned* p, unsigned v) { return __hip_atomic_fetch_add(p, v, __ATOMIC_RELAXED, __HIP_MEMORY_SCOPE_AGENT); }
__device__ __forceinline__ unsigned xb_xcc_id() { return (unsigned)__builtin_amdgcn_s_getreg((3 << 11) | 20) & 0xFu; }
#define XB_SPIN(cond, bar) do { unsigned _sp = 0; while (cond) { __builtin_amdgcn_s_sleep(1); \
    if ((++_sp & 255u) == 0u) { if (xb_ld(&(bar)[XB_TMO])) break; if (_sp > XB_SPIN_CAP) { atomicAdd(&(bar)[XB_TMO], 1u); break; } } } } while (0)
struct XcdBarrier { unsigned* bar; unsigned x; volatile LAS unsigned* st; };
__device__ __forceinline__ XcdBarrier xcd_barrier_post(unsigned* bar, volatile LAS unsigned* st) {
    XcdBarrier b; b.bar = bar; b.x = xb_xcc_id(); b.st = st;
    if (threadIdx.x == 0) (void)xb_add(&bar[XB_XCNT(b.x)], 1u);
    return b;
}
__device__ __forceinline__ void xcd_barrier_complete(unsigned* bar, unsigned x, unsigned& nloc, unsigned& nx) {
    const unsigned G = gridDim.x * gridDim.y * gridDim.z;
    unsigned sum, cnt, mine, sp = 0u;
    for (;;) {
        sum = 0u; cnt = 0u; mine = 0u;
#pragma unroll 1
        for (unsigned j = 0; j < 16; ++j) { const unsigned c = xb_ld(&bar[XB_XCNT(j)]); sum += c; cnt += (c > 0u) ? 1u : 0u; mine = (j == x) ? c : mine; }
        if (sum == G) break;
        __builtin_amdgcn_s_sleep(1);
        if ((++sp & 255u) == 0u) { if (xb_ld(&bar[XB_TMO])) break; if (sp > XB_SPIN_CAP) { atomicAdd(&bar[XB_TMO], 1u); break; } }
    }
    nloc = mine > 0u ? mine : 1u; nx = cnt > 0u ? cnt : 1u;
}
__device__ __forceinline__ void xcd_barrier(const XcdBarrier& b) {
    asm volatile("s_waitcnt vmcnt(0)" ::: "memory");
    __syncthreads();
    if (threadIdx.x == 0) {
        unsigned* bar = b.bar;
        __builtin_amdgcn_s_waitcnt(0);
        unsigned nloc = b.st[0], nx = b.st[1];
        if (nloc == 0u) { xcd_barrier_complete(bar, b.x, nloc, nx); b.st[0] = nloc; b.st[1] = nx; }
        const unsigned old = xb_add(&bar[XB_XSUB(b.x)], 1u);
        const unsigned gen = old / nloc;
        if (old + 1u == (gen + 1u) * nloc) {
            __builtin_amdgcn_fence(__ATOMIC_RELEASE, "agent");
            asm volatile("s_waitcnt vmcnt(0)" ::: "memory");
            const unsigned og = xb_add(&bar[XB_TOP], 1u);
            const unsigned tg = og / nx;
            if (og + 1u == (tg + 1u) * nx) xb_add(&bar[XB_TOPGEN], 1u);
            else XB_SPIN(xb_ld(&bar[XB_TOPGEN]) == tg, bar);
            __builtin_amdgcn_fence(__ATOMIC_ACQUIRE, "agent");
            xb_add(&bar[XB_XGEN(b.x)], 1u);
            asm volatile("s_waitcnt vmcnt(0)" ::: "memory");
        } else {
            XB_SPIN(xb_ld(&bar[XB_XGEN(b.x)]) == gen, bar);
            __builtin_amdgcn_fence(__ATOMIC_ACQUIRE, "agent");
            asm volatile("s_waitcnt vmcnt(0)" ::: "memory");
        }
    }
    __syncthreads();
}

DI int TID() { int t = threadIdx.x; asm volatile("" : "+v"(t)); return t; }
DI int BID() { int b = blockIdx.x; asm volatile("" : "+s"(b)); return b; }

namespace pg8 {
constexpr int BM = 256, BK = 64, HALF = 128, HTB = HALF * BK * 2, STAGE_BYTES = 8 * HTB, NXCD = 8, WGM = 8;
DI int lds_byte(int r, int c) { const int st = (r >> 4) * 2 + (c >> 5), rr = r & 15, cc = c & 31, ob = rr * 64 + cc * 2; return st * 1024 + (ob ^ (((ob >> 9) & 1) << 5)); }
DI void stage_rc(int b, int& R, int& C) { const int st = b / 1024, sb = b % 1024, swz = sb ^ (((sb >> 9) & 1) << 5); R = (st >> 1) * 16 + swz / 64; C = (st & 1) * 32 + (swz % 64) / 2; }
struct Unit { int pm, pn, z; };

DI bool order_xcd(int nM, int nN, int G, int c, int i, Unit& u) {
    const int nwg = nM * nN; const long L = (long)i * G + c; if (L >= nwg) return false;
    int wgid = (int)L; { const int q = nwg / NXCD, r = nwg % NXCD, xcd = wgid % NXCD, off = wgid / NXCD; wgid = (xcd < r ? xcd * (q + 1) : r * (q + 1) + (xcd - r) * q) + off; }
    const int nig = WGM * nN, gid = wgid / nig, fm = gid * WGM, gsz = (nM - fm) < WGM ? (nM - fm) : WGM;
    u.pm = fm + ((wgid % nig) % gsz); u.pn = (wgid % nig) / gsz; u.z = 0; return true;
}

template <class Epi, class Sched>
DI void gemm_phase(LAS unsigned char* lds, const int K, const Sched& S, const Epi& E) {
    const int tid = TID(), wid = __builtin_amdgcn_readfirstlane(tid >> 6), lane = tid & 63, wr = wid >> 2, wc = wid & 3, fr = lane & 15, fq = lane >> 4;
    const int nt = K / BK;
    unsigned voffA[2];
#pragma unroll
    for (int i = 0; i < 2; ++i) { int R, C; stage_rc(tid * 16 + i * 8192, R, C); voffA[i] = (unsigned)(R * K + C) * 2u; }
    const size_t kstep = (size_t)(BK * 2);
    const size_t hstep = (size_t)HALF * K * 2;
    const unsigned ldsw = (unsigned)wid * 1024u;
    const int aoff = lds_byte(wr * 64 + fr, fq * 8), boff = lds_byte(wc * 32 + fr, fq * 8);
#define PG8_SA(b, h) (((b) * 2 + (h)) * HTB)
#define PG8_SB(b, h) ((4 + (b) * 2 + (h)) * HTB)
#define PG8_STAGE(bufoff, gbase) do { _Pragma("unroll") for (int _i = 0; _i < 2; ++_i) \
        __builtin_amdgcn_global_load_lds((const unsigned*)((const char*)(gbase) + voffA[_i]), (LAS unsigned*)(lds + (bufoff) + ldsw + _i * 8192), 16, 0, 0); } while (0)
#define PG8_LDA(dst, b, h) do { _Pragma("unroll") for (int m = 0; m < 4; ++m) _Pragma("unroll") for (int k = 0; k < 2; ++k) dst[m][k] = *(const LAS bf16x8*)(lds + PG8_SA(b, h) + aoff + m * 2048 + k * 1024); } while (0)
#define PG8_LDB(dst, b, h) do { _Pragma("unroll") for (int n = 0; n < 2; ++n) _Pragma("unroll") for (int k = 0; k < 2; ++k) dst[n][k] = *(const LAS bf16x8*)(lds + PG8_SB(b, h) + boff + n * 2048 + k * 1024); } while (0)
#define PG8_MMA(ai, bj, At, Bt) do { __builtin_amdgcn_s_setprio(1); _Pragma("unroll") for (int m = 0; m < 4; ++m) _Pragma("unroll") for (int n = 0; n < 2; ++n) _Pragma("unroll") for (int k = 0; k < 2; ++k) \
        acc[ai][bj][m][n] = __builtin_amdgcn_mfma_f32_16x16x32_bf16(Bt[n][k], At[m][k], acc[ai][bj][m][n], 0, 0, 0); __builtin_amdgcn_s_setprio(0); } while (0)
#define PG8_WAIT_V(n) asm volatile("s_waitcnt vmcnt(" #n ")" ::: "memory")
#define PG8_WAIT_L(n) asm volatile("s_waitcnt lgkmcnt(" #n ")" ::: "memory")
#define PG8_BAR __builtin_amdgcn_s_barrier()
#define PG8_SCHED __builtin_amdgcn_sched_barrier(0)
    Unit cur, nxt; int ui = 0;
    if (!S.next(0, cur)) return;
    f32x4 acc[2][2][4][2];
#pragma unroll
    for (int a = 0; a < 2; ++a)
#pragma unroll
        for (int b = 0; b < 2; ++b)
#pragma unroll
            for (int m = 0; m < 4; ++m)
#pragma unroll
                for (int n = 0; n < 2; ++n) acc[a][b][m][n] = (f32x4){0.f, 0.f, 0.f, 0.f};
    bf16x8 At[4][2], B0[2][2], B1[2][2];
    const char* cA = S.aptr(cur); const char* cB = S.bptr(cur);
    PG8_STAGE(PG8_SB(0, 0), cB); PG8_STAGE(PG8_SA(0, 0), cA); PG8_STAGE(PG8_SB(0, 1), cB + hstep); PG8_STAGE(PG8_SA(0, 1), cA + hstep);
    if (wr == 1) PG8_BAR;
    PG8_WAIT_V(4); PG8_BAR;
    PG8_STAGE(PG8_SB(1, 0), cB + kstep); PG8_STAGE(PG8_SA(1, 0), cA + kstep); PG8_STAGE(PG8_SB(1, 1), cB + hstep + kstep);
    PG8_WAIT_V(6); PG8_BAR;
    for (;;) {
        const bool has_next = S.next(ui + 1, nxt);
        const char* nA = has_next ? S.aptr(nxt) : cA; const char* nB = has_next ? S.bptr(nxt) : cB;
#pragma unroll 1
        for (int t = 0; t < nt; t += 2) {
            const bool last = (t == nt - 2);
            const char* a1 = cA + (size_t)(t + 1) * kstep;
            const char* a2 = last ? nA : cA + (size_t)(t + 2) * kstep; const char* b2 = last ? nB : cB + (size_t)(t + 2) * kstep;
            const char* a3 = a2 + kstep; const char* b3 = b2 + kstep;
            PG8_LDB(B0, 0, 0); PG8_SCHED; PG8_LDA(At, 0, 0); PG8_STAGE(PG8_SA(1, 1), a1 + hstep);
            PG8_WAIT_L(8); PG8_BAR; PG8_WAIT_L(0); PG8_MMA(0, 0, At, B0); PG8_BAR; PG8_SCHED;
            PG8_LDB(B1, 0, 1); PG8_STAGE(PG8_SB(0, 0), b2);
            PG8_BAR; PG8_WAIT_L(0); PG8_MMA(0, 1, At, B1); PG8_BAR;
            PG8_LDA(At, 0, 1); PG8_STAGE(PG8_SA(0, 0), a2);
            PG8_BAR; PG8_WAIT_L(0); PG8_MMA(1, 0, At, B0); PG8_BAR; PG8_SCHED;
            PG8_STAGE(PG8_SB(0, 1), b2 + hstep);
            PG8_WAIT_V(6); PG8_BAR; PG8_MMA(1, 1, At, B1); PG8_BAR;
            PG8_LDB(B0, 1, 0); PG8_SCHED; PG8_LDA(At, 1, 0); PG8_STAGE(PG8_SA(0, 1), a2 + hstep);
            PG8_WAIT_L(8); PG8_BAR; PG8_WAIT_L(0); PG8_MMA(0, 0, At, B0); PG8_BAR; PG8_SCHED;
            PG8_LDB(B1, 1, 1); PG8_STAGE(PG8_SB(1, 0), b3);
            PG8_BAR; PG8_WAIT_L(0); PG8_MMA(0, 1, At, B1); PG8_BAR;
            PG8_LDA(At, 1, 1); PG8_STAGE(PG8_SA(1, 0), a3);
            PG8_BAR; PG8_WAIT_L(0); PG8_MMA(1, 0, At, B0); PG8_BAR; PG8_SCHED;
            PG8_STAGE(PG8_SB(1, 1), b3 + hstep);
            PG8_WAIT_V(6); PG8_BAR; PG8_MMA(1, 1, At, B1); PG8_BAR;
        }
        { int tz = TID(); asm volatile("" : "+v"(tz));
          const int wz = __builtin_amdgcn_readfirstlane(tz >> 6), lz = tz & 63; E(acc, cur, wz >> 2, wz & 3, lz & 15, lz >> 4); }
        if (!has_next) break;
#pragma unroll
        for (int a = 0; a < 2; ++a)
#pragma unroll
            for (int b = 0; b < 2; ++b)
#pragma unroll
                for (int m = 0; m < 4; ++m)
#pragma unroll
                    for (int n = 0; n < 2; ++n) acc[a][b][m][n] = (f32x4){0.f, 0.f, 0.f, 0.f};
        cur = nxt; cA = nA; cB = nB; ++ui;
    }
    PG8_WAIT_V(0);
    if (wr == 0) PG8_BAR;
    PG8_BAR;
#undef PG8_SA
#undef PG8_SB
#undef PG8_STAGE
#undef PG8_LDA
#undef PG8_LDB
#undef PG8_MMA
#undef PG8_WAIT_V
#undef PG8_WAIT_L
#undef PG8_BAR
#undef PG8_SCHED
}
}
using pg8::Unit;
typedef f32x4 AccT[2][2][4][2];

struct Params {
    const float* in[26];
    float* out;
    unsigned char* ws;
    int ph_lo, ph_hi;
};
enum { I_X = 0, I_WIN, I_NMIX, I_NFFN, I_QKN, I_REL, I_MU, I_W0, I_W2, I_A0, I_A2, I_G2, I_KK, I_KA, I_RK, I_LNW, I_LNB, I_V0, I_VA, I_VB, I_KVN, I_KVUP, I_WBR, I_WO, I_F1, I_F2 };

DI const Params* KP() { auto k = __builtin_amdgcn_kernarg_segment_ptr(); asm volatile("" : "+s"(k)); return (const Params*)k; }
template <class T> DI T* wsp(size_t off) { return (T*)(KP()->ws + off); }

DI int hn_col(int x) { const int pi = x & 255; return (x & ~255) + 64 * ((pi >> 5) & 3) + 32 * (pi >> 7) + (pi & 31); }
template <int MAP> DI int colmap(int r) {
    if (MAP == 0) {
        if (r < 512) return C_MK + hn_col(r);
        if (r < 768) return C_DS + 512 + (r - 512);
        const int pi = r - 768;
        if (pi < 32) return C_DS + 1024 + pi;
        if (pi < 40) return C_DS + 1056 + (pi - 32);
        if (pi >= 64 && pi < 96) return C_RW + 1792 + (pi - 64);
        return -1;
    }
    if (MAP == 1) return C_MV + r;
    if (MAP == 2) {
        if (r < 512) return C_MQ + hn_col(r);
        if (r < 1024) return C_DS + hn_col(r - 512);
        if (r < 1280) return C_DS + 768 + (r - 1024);
        if (r < 3072) return C_RW + (r - 1280);
        return C_GT + (r - 3072);
    }
    if (MAP == 3) return hn_col(r);
    if (MAP == 4) return 512 + r;
    if (MAP == 5) return r;
    if (MAP == 6) { const int pn = r >> 8, pi = r & 255; return ((pi >> 7) ? DFF : 0) + 128 * pn + (pi & 127); }
    return -1;
}
template <int MAP> DI void conv_t(LAS float* sm, bf16_t* dst, int nrows, int K, const float* src, int ld) {
    const int tid = TID(), tx = tid & 63, ty = tid >> 6;
    const int ntr = nrows / 64, ntk = K / 64, ntiles = ntr * ntk;
    for (int t = BID(); t < ntiles; t += gridDim.x) {
        const int r0 = (t / ntk) * 64, k0 = (t % ntk) * 64;
        const int col = colmap<MAP>(r0 + tx);
#pragma unroll
        for (int i = 0; i < 8; ++i) { const int kl = ty + 8 * i; sm[kl * 65 + tx] = (col >= 0) ? src[(size_t)(k0 + kl) * ld + col] : 0.f; }
        __syncthreads();
#pragma unroll
        for (int i = 0; i < 8; ++i) { const int rl = ty + 8 * i; dst[(size_t)(r0 + rl) * K + k0 + tx] = f2bf(sm[tx * 65 + rl]); }
        __syncthreads();
    }
}
DI void conv_lora(int l) {
    bf16_t* dst = wsp<bf16_t>(WS_WL);
    const float* w2 = KP()->in[I_W2] + (size_t)l * 64 * 512; const float* a2 = KP()->in[I_A2] + (size_t)l * 64 * 512; const float* g2 = KP()->in[I_G2] + (size_t)l * 160 * 512;
    const float* va = KP()->in[I_VA]; const float* vb = KP()->in[I_VB];
    const int n = 2048 * 512;
    for (int e = BID() * 512 + TID(); e < n; e += gridDim.x * 512) {
        const int r = e >> 9, k = e & 511; float v = 0.f;
        if (r < 512) { if (k < 64) v = w2[k * 512 + r]; }
        else if (r < 1024) { if (k >= 64 && k < 128) v = a2[(k - 64) * 512 + (r - 512)]; }
        else if (r < 1536) { if (k >= 128 && k < 288) v = g2[(k - 128) * 512 + (r - 1024)]; }
        else if (l == 1) { const int c = r - 1536; float s = 0.f;
#pragma unroll 8
            for (int j = 0; j < 32; ++j) s += va[k * 32 + j] * vb[j * 512 + c];
            v = s; }
        dst[e] = f2bf(v);
    }
}
DI void phase_conv(int l, LAS float* sm) {
    const float* win = KP()->in[I_WIN] + (size_t)l * DM * D_IN;
    conv_t<0>(sm, wsp<bf16_t>(WS_WB), 1024, 1024, win, D_IN);
    conv_t<1>(sm, wsp<bf16_t>(WS_WV), 512, 1024, win, D_IN);
    conv_t<2>(sm, wsp<bf16_t>(WS_WD1), 6144, 1024, win, D_IN);
    const float* kvup = KP()->in[I_KVUP] + (size_t)l * 256 * 1024;
    conv_t<3>(sm, wsp<bf16_t>(WS_WKVK), 512, 256, kvup, 1024);
    conv_t<4>(sm, wsp<bf16_t>(WS_WKVV), 512, 256, kvup, 1024);
    for (int i = 0; i < 3; ++i) conv_t<5>(sm, wsp<bf16_t>(WS_WBR) + (size_t)i * 1024 * 512, 1024, 512, KP()->in[I_WBR] + ((size_t)l * 3 + i) * 512 * 1024, 1024);
    conv_t<5>(sm, wsp<bf16_t>(WS_WO), 1024, 1024, KP()->in[I_WO] + (size_t)l * 1024 * 1024, 1024);
    conv_t<6>(sm, wsp<bf16_t>(WS_WF1), 5632, 1024, KP()->in[I_F1] + (size_t)l * 1024 * 5632, 5632);
    conv_t<5>(sm, wsp<bf16_t>(WS_WF2), 1024, 2816, KP()->in[I_F2] + (size_t)l * 2816 * 1024, 1024);
    conv_lora(l);
}

DI void phase_norm(const float* x, const float* g, bf16_t* h) {
    const int lane = TID() & 63, gw = BID() * 8 + (TID() >> 6), nw = gridDim.x * 8;
    f32x4 gv[4];
#pragma unroll
    for (int i = 0; i < 4; ++i) gv[i] = ((const f32x4*)g)[lane + 64 * i];
    for (int row = gw; row < NT; row += nw) {
        const f32x4* xr = (const f32x4*)(x + (size_t)row * DM);
        f32x4 v[4]; float ss = 0.f;
#pragma unroll
        for (int i = 0; i < 4; ++i) { v[i] = xr[lane + 64 * i]; ss += v[i][0] * v[i][0] + v[i][1] * v[i][1] + v[i][2] * v[i][2] + v[i][3] * v[i][3]; }
        ss = wave_sum(ss);
        const float rs = __builtin_amdgcn_rsqf(ss * (1.f / DM) + NORM_EPS);
#pragma unroll
        for (int i = 0; i < 4; ++i) {
            u32x2 o; o[0] = pk2(v[i][0] * rs * gv[i][0], v[i][1] * rs * gv[i][1]); o[1] = pk2(v[i][2] * rs * gv[i][2], v[i][3] * rs * gv[i][3]);
            *(u32x2*)(h + (size_t)row * DM + 4 * (lane + 64 * i)) = o;
        }
    }
}

struct SchedLin {
    int nM, nN, G, c; unsigned aoff, boff, a2off; int rowbytes, amode, cbase, pn2;
    DI bool next(int i, Unit& u) const { return pg8::order_xcd(nM, nN, G, c, i, u); }
    DI const char* aptr(const Unit& u) const { const int row0 = amode ? ((u.pm >> 1) * SEQ + cbase + (u.pm & 1) * 256) : u.pm * 256; return (const char*)KP()->ws + ((u.pn >= pn2) ? a2off : aoff) + (size_t)row0 * rowbytes; }
    DI const char* bptr(const Unit& u) const { return (const char*)KP()->ws + boff + (size_t)u.pn * 256 * rowbytes; }
};
DI SchedLin mk_sched(int nM, int nN, size_t aoff, size_t boff, int K, int amode = 0, int cbase = 0, size_t a2off = 0, int pn2 = 1 << 30) {
    SchedLin s; s.nM = nM; s.nN = nN; s.G = gridDim.x; s.c = BID(); s.aoff = (unsigned)aoff; s.boff = (unsigned)boff; s.rowbytes = K * 2; s.amode = amode; s.cbase = cbase; s.a2off = (unsigned)a2off; s.pn2 = pn2; return s;
}
struct SchedMerge {
    int G, c;
    DI bool next(int i, Unit& u) const { const int z = i % 3, tile = (i / 3) * G + c; if (tile >= 128) return false; u.pm = tile >> 2; u.pn = tile & 3; u.z = z; return true; }
    DI const char* aptr(const Unit& u) const { return (const char*)KP()->ws + (u.z == 0 ? WS_MQ : (u.z == 1 ? WS_ORW : WS_DQ)) + (size_t)u.pm * 256 * 1024; }
    DI const char* bptr(const Unit& u) const { return (const char*)KP()->ws + WS_WBR + (size_t)u.z * (1024 * 512 * 2) + (size_t)u.pn * 256 * 1024; }
};

DI void st_bf4(bf16_t* p, f32x4 v) { u32x2 o; o[0] = pk2(v[0], v[1]); o[1] = pk2(v[2], v[3]); *(u32x2*)p = o; }
DI f32x4 ld_bf4(const bf16_t* p) { const u32x2 u = *(const u32x2*)p; return (f32x4){bflo(u[0]), bfhi(u[0]), bflo(u[1]), bfhi(u[1])}; }
#define EPI_ROWS(ai, m) (128 * (ai) + 64 * wr + 16 * (m) + fr)
#define EPI_COLS(bj, n) (128 * (bj) + 32 * wc + 16 * (n) + 4 * fq)
#define FOR_AM _Pragma("unroll") for (int ai = 0; ai < 2; ++ai) _Pragma("unroll") for (int m = 0; m < 4; ++m)
#define FOR_BN _Pragma("unroll") for (int bj = 0; bj < 2; ++bj) _Pragma("unroll") for (int n = 0; n < 2; ++n)

DI void epi_headnorm(const AccT& acc, bf16_t* out, int ld, const float* gain, int wr, int wc, int fr, int fq) {
    f32x4 gv[2][2];
    FOR_BN gv[bj][n] = *(const f32x4*)(gain + 32 * bj + 16 * n + 4 * fq);
    FOR_AM {
        float ss = 0.f;
        FOR_BN { const f32x4 a = acc[ai][bj][m][n]; ss += a[0] * a[0] + a[1] * a[1] + a[2] * a[2] + a[3] * a[3]; }
        ss += __shfl_xor(ss, 16); ss += __shfl_xor(ss, 32);
        const float sc = __builtin_amdgcn_rsqf(ss * (1.f / 64.f) + NORM_EPS);
        bf16_t* rp = out + (size_t)EPI_ROWS(ai, m) * ld + 64 * wc + 4 * fq;
        FOR_BN st_bf4(rp + 32 * bj + 16 * n, acc[ai][bj][m][n] * sc * gv[bj][n]);
    }
}
DI void epi_store_bf16(const AccT& acc, bf16_t* out, int ld, int wr, int wc, int fr, int fq) {
    FOR_AM { bf16_t* rp = out + (size_t)EPI_ROWS(ai, m) * ld; FOR_BN st_bf4(rp + EPI_COLS(bj, n), acc[ai][bj][m][n]); }
}

struct EpiB {
    int l;
    DI void operator()(const AccT& acc, const Unit& u, int wr, int wc, int fr, int fq) const {
        const size_t row0 = (size_t)u.pm * 256;
        if (u.pn < 2) epi_headnorm(acc, wsp<bf16_t>(WS_MK) + row0 * 512 + u.pn * 256, 512, KP()->in[I_QKN] + l * 256 + 64, wr, wc, fr, fq);
        else if (u.pn == 2) epi_store_bf16(acc, wsp<bf16_t>(WS_DCN) + row0 * 256, 256, wr, wc, fr, fq);
        else {
            bf16_t* idxk = wsp<bf16_t>(WS_IDXK); float* idxw = wsp<float>(WS_IDXW); bf16_t* left = wsp<bf16_t>(WS_LEFT);
            FOR_AM { const size_t row = row0 + EPI_ROWS(ai, m);
                if (wc == 0) { st_bf4(idxk + row * 32 + 4 * fq, acc[ai][0][m][0]); st_bf4(idxk + row * 32 + 16 + 4 * fq, acc[ai][0][m][1]); }
                else if (wc == 1) { if (fq < 2) *(f32x4*)(idxw + row * 8 + 4 * fq) = acc[ai][0][m][0]; }
                else if (wc == 2) { st_bf4(left + row * 32 + 4 * fq, acc[ai][0][m][0]); st_bf4(left + row * 32 + 16 + 4 * fq, acc[ai][0][m][1]); }
            }
        }
    }
};
struct EpiVt {
    unsigned off;
    DI void operator()(const AccT& acc, const Unit& u, int wr, int wc, int fr, int fq) const {
        bf16_t* vt = wsp<bf16_t>(off);
        const int b = u.pn >> 3, s0 = (u.pn & 7) * 256;
        FOR_AM { bf16_t* rp = vt + ((size_t)b * 512 + u.pm * 256 + EPI_ROWS(ai, m)) * SEQ + s0; FOR_BN st_bf4(rp + EPI_COLS(bj, n), acc[ai][bj][m][n]); }
    }
};
struct EpiHN {
    int l;
    DI void operator()(const AccT& acc, const Unit& u, int wr, int wc, int fr, int fq) const { epi_headnorm(acc, wsp<bf16_t>(WS_DK) + (size_t)u.pm * 256 * 512 + u.pn * 256, 512, KP()->in[I_QKN] + l * 256 + 192, wr, wc, fr, fq); }
};
struct EpiD1 {
    int l;
    DI void operator()(const AccT& acc, const Unit& u, int wr, int wc, int fr, int fq) const {
        const size_t row0 = (size_t)u.pm * 256;
        if (u.pn < 2) epi_headnorm(acc, wsp<bf16_t>(WS_MQ) + row0 * 512 + u.pn * 256, 512, KP()->in[I_QKN] + l * 256, wr, wc, fr, fq);
        else if (u.pn < 4) epi_headnorm(acc, wsp<bf16_t>(WS_DQ) + row0 * 512 + (u.pn - 2) * 256, 512, KP()->in[I_QKN] + l * 256 + 128, wr, wc, fr, fq);
        else if (u.pn == 4) epi_store_bf16(acc, wsp<bf16_t>(WS_IDXQ) + row0 * 256, 256, wr, wc, fr, fq);
        else if (u.pn < 12) epi_store_bf16(acc, wsp<bf16_t>(WS_RAW) + row0 * RAWLD + (u.pn - 5) * 256, RAWLD, wr, wc, fr, fq);
        else {
            bf16_t* o = wsp<bf16_t>(WS_GATES) + row0 * 3072 + (u.pn - 12) * 256;
            FOR_AM { bf16_t* rp = o + (size_t)EPI_ROWS(ai, m) * 3072;
                FOR_BN { const f32x4 a = acc[ai][bj][m][n]; st_bf4(rp + EPI_COLS(bj, n), (f32x4){fsigmoid(a[0]), fsigmoid(a[1]), fsigmoid(a[2]), fsigmoid(a[3])}); } }
        }
    }
};
struct EpiLora {
    int l, cbase;
    DI void operator()(const AccT& acc, const Unit& u, int wr, int wc, int fr, int fq) const {
        const size_t row0 = (size_t)u.pm * 256; const int kind = u.pn >> 1, cb = (u.pn & 1) * 256;
        if (kind == 0) {
            float* dec = wsp<float>(WS_DEC); const float* w0 = KP()->in[I_W0] + l * 512;
            FOR_AM { const size_t row = row0 + EPI_ROWS(ai, m);
                FOR_BN { const int col = cb + EPI_COLS(bj, n); const f32x4 a = acc[ai][bj][m][n]; const f32x4 wv = *(const f32x4*)(w0 + col); f32x4 d;
#pragma unroll
                    for (int e = 0; e < 4; ++e) { const float x = -(wv[e] + a[e]);
                        const float sp = fmaxf(x, 0.f) + __builtin_amdgcn_logf(1.f + fexp2(-fabsf(x) * LOG2E)) * 0.6931471805599453f;
                        const float w = -sp - 0.5f; d[e] = fexp2(-fexp2(w * LOG2E) * LOG2E); }
                    *(f32x4*)(dec + row * 512 + col) = d; } }
        } else if (kind == 1) {
            bf16_t* kf = wsp<bf16_t>(WS_KF); const bf16_t* kkb = wsp<bf16_t>(WS_KKB); bf16_t* bbb = wsp<bf16_t>(WS_BBB);
            const float* a0 = KP()->in[I_A0] + l * 512; const float* ka = KP()->in[I_KA] + l * 512;
            FOR_AM { const size_t row = row0 + EPI_ROWS(ai, m);
                FOR_BN { const int col = cb + EPI_COLS(bj, n); const f32x4 a = acc[ai][bj][m][n];
                    const f32x4 av = *(const f32x4*)(a0 + col), kav = *(const f32x4*)(ka + col);
                    const f32x4 kp = ld_bf4(kf + row * 512 + col), kk = ld_bf4(kkb + row * 512 + col); f32x4 ko, bo;
#pragma unroll
                    for (int e = 0; e < 4; ++e) { const float s = fsigmoid(av[e] + a[e]); ko[e] = kp[e] * (1.f + (s - 1.f) * kav[e]); bo[e] = kk[e] * s; }
                    st_bf4(kf + row * 512 + col, ko); st_bf4(bbb + row * 512 + col, bo); } }
        } else if (kind == 2) {
            epi_store_bf16(acc, wsp<bf16_t>(WS_GG) + row0 * 512 + cb, 512, wr, wc, fr, fq);
        } else {
            const bf16_t* vv = wsp<bf16_t>(WS_VV); bf16_t* v2 = wsp<bf16_t>(WS_V2); const bf16_t* vfirst = wsp<bf16_t>(WS_VFIRST); const float* v0 = KP()->in[I_V0];
            FOR_AM { const size_t row = row0 + EPI_ROWS(ai, m); const size_t arow = (size_t)(row >> 9) * SEQ + cbase + (row & 511);
                FOR_BN { const int col = cb + EPI_COLS(bj, n); const f32x4 a = acc[ai][bj][m][n];
                    const f32x4 vp = ld_bf4(vv + row * 512 + col), vf = ld_bf4(vfirst + arow * 512 + col), v0v = *(const f32x4*)(v0 + col); f32x4 o;
#pragma unroll
                    for (int e = 0; e < 4; ++e) o[e] = vp[e] + (vf[e] - vp[e]) * fsigmoid(v0v[e] + a[e]);
                    st_bf4(v2 + row * 512 + col, o); } }
        }
    }
};
struct EpiMerge {
    DI void operator()(const AccT& acc, const Unit& u, int wr, int wc, int fr, int fq) const {
        float* y32 = wsp<float>(WS_Y32); bf16_t* y = wsp<bf16_t>(WS_Y); const bf16_t* gates = wsp<bf16_t>(WS_GATES);
        const size_t row0 = (size_t)u.pm * 256; const int c0 = u.pn * 256;
        FOR_AM { const size_t row = row0 + EPI_ROWS(ai, m);
            FOR_BN { const int col = c0 + EPI_COLS(bj, n);
                f32x4 v = acc[ai][bj][m][n] * ld_bf4(gates + row * 3072 + u.z * 1024 + col);
                float* yp = y32 + row * 1024 + col;
                if (u.z > 0) v += *(const f32x4*)yp;
                if (u.z < 2) *(f32x4*)yp = v; else st_bf4(y + row * 1024 + col, v);
            } }
    }
};
struct EpiRes {
    int first, amode, cbase;
    DI void operator()(const AccT& acc, const Unit& u, int wr, int wc, int fr, int fq) const {
        float* out = KP()->out; const float* res = first ? KP()->in[I_X] : (const float*)out;
        const size_t grow0 = amode ? ((size_t)(u.pm >> 1) * SEQ + cbase + (u.pm & 1) * 256) : (size_t)u.pm * 256; const int c0 = u.pn * 256;
        FOR_AM { const size_t row = grow0 + EPI_ROWS(ai, m);
            FOR_BN { const size_t o = row * DM + c0 + EPI_COLS(bj, n); *(f32x4*)(out + o) = *(const f32x4*)(res + o) + acc[ai][bj][m][n]; } }
    }
};
struct EpiSwiglu {
    DI void operator()(const AccT& acc, const Unit& u, int wr, int wc, int fr, int fq) const {
        bf16_t* act = wsp<bf16_t>(WS_ACT);
        FOR_AM { bf16_t* rp = act + ((size_t)u.pm * 256 + EPI_ROWS(ai, m)) * DFF + u.pn * 128 + 32 * wc + 4 * fq;
#pragma unroll
            for (int n = 0; n < 2; ++n) { const f32x4 g = acc[ai][0][m][n], up = acc[ai][1][m][n]; f32x4 o;
#pragma unroll
                for (int e = 0; e < 4; ++e) o[e] = g[e] * fsigmoid(g[e]) * up[e];
                st_bf4(rp + 16 * n, o); } }
    }
};

DI void phase_dcn(int l) {
    const int lane = TID() & 63, gw = BID() * 8 + (TID() >> 6), nw = gridDim.x * 8;
    bf16_t* dcn = wsp<bf16_t>(WS_DCN);
    const f32x4 g = *(const f32x4*)(KP()->in[I_KVN] + l * 256 + 4 * lane);
    for (int row = gw; row < NT; row += nw) {
        bf16_t* rp = dcn + (size_t)row * 256 + 4 * lane;
        const f32x4 v = ld_bf4(rp);
        const float ss = wave_sum(v[0] * v[0] + v[1] * v[1] + v[2] * v[2] + v[3] * v[3]);
        const float rs = __builtin_amdgcn_rsqf(ss * (1.f / 256.f) + NORM_EPS);
        st_bf4(rp, v * rs * g);
    }
}
DI void phase_kmean() {
    const int lane = TID() & 63, gw = BID() * 8 + (TID() >> 6), nw = gridDim.x * 8;
    const bf16_t* mk = wsp<bf16_t>(WS_MK); float* km = wsp<float>(WS_KMEAN);
    for (int it = gw; it < NB * NH * 8; it += nw) {
        const int n = it & 7, h = (it >> 3) & 7, b = it >> 6;
        const bf16_t* kp = mk + ((size_t)b * SEQ + n * 256) * 512 + h * 64 + lane;
        float s = 0.f;
#pragma unroll 8
        for (int k = 0; k < 256; ++k) s += bf2f(kp[(size_t)k * 512]);
        km[(size_t)it * 64 + lane] = s * (1.f / 256.f);
    }
}

DI void phase_rwkv_prep(int l, int c) {
    const int lane = TID() & 63, gw = BID() * 8 + (TID() >> 6), nw = gridDim.x * 8;
    const bf16_t* raw = wsp<bf16_t>(WS_RAW); const bf16_t* left = wsp<bf16_t>(WS_LEFT); bf16_t* carry = wsp<bf16_t>(WS_CARRY);
    bf16_t* rr = wsp<bf16_t>(WS_RR); bf16_t* kf = wsp<bf16_t>(WS_KF); bf16_t* vv = wsp<bf16_t>(WS_VV); bf16_t* kkb = wsp<bf16_t>(WS_KKB);
    bf16_t* la = wsp<bf16_t>(WS_LORAA); bf16_t* vfirst = wsp<bf16_t>(WS_VFIRST);
    const float* mu = KP()->in[I_MU] + l * 1824; const float* kkw = KP()->in[I_KK] + l * 512;
    for (int rc = gw; rc < TC; rc += nw) {
        const int b = rc >> 9, sl = rc & 511, s = c * SC + sl; const size_t ra = (size_t)b * SEQ + s;
        const bf16_t* cur = raw + (size_t)rc * RAWLD;
        const bf16_t* prv = (sl > 0) ? (cur - RAWLD) : (carry + (size_t)((((c + 1) & 1) * 16) + b) * RAWLD);
        const bool hp = s > 0;
        auto mix8 = [&](int j, float* o) {
            const u32x4 cu = *(const u32x4*)(cur + j); u32x4 pu = {0u, 0u, 0u, 0u}; if (hp) pu = *(const u32x4*)(prv + j);
            const f32x4 m0 = *(const f32x4*)(mu + j), m1 = *(const f32x4*)(mu + j + 4);
#pragma unroll
            for (int e = 0; e < 4; ++e) { const float c0 = bflo(cu[e]), c1 = bfhi(cu[e]), p0 = bflo(pu[e]), p1 = bfhi(pu[e]);
                const float ma = (2 * e < 4) ? m0[2 * e] : m1[2 * e - 4], mb = (2 * e + 1 < 4) ? m0[2 * e + 1] : m1[2 * e + 1 - 4];
                o[2 * e] = c0 + (p0 - c0) * ma; o[2 * e + 1] = c1 + (p1 - c1) * mb; }
        };
        auto mix1 = [&](int j) -> float { const float c0 = bf2f(cur[j]); const float p0 = hp ? bf2f(prv[j]) : 0.f; return c0 + (p0 - c0) * mu[j]; };
        float o[8];
        mix8(8 * lane, o);
        { u32x4 w; w[0] = pk2(o[0], o[1]); w[1] = pk2(o[2], o[3]); w[2] = pk2(o[4], o[5]); w[3] = pk2(o[6], o[7]); *(u32x4*)(rr + (size_t)rc * 512 + 8 * lane) = w; }
        mix8(576 + 8 * lane, o);
        { u32x4 w; w[0] = pk2(o[0], o[1]); w[1] = pk2(o[2], o[3]); w[2] = pk2(o[4], o[5]); w[3] = pk2(o[6], o[7]); *(u32x4*)(kf + (size_t)rc * 512 + 8 * lane) = w;
          const f32x4 k0 = *(const f32x4*)(kkw + 8 * lane), k1 = *(const f32x4*)(kkw + 8 * lane + 4);
          float q[8]; float ss = 0.f;
#pragma unroll
          for (int e = 0; e < 8; ++e) { q[e] = o[e] * (e < 4 ? k0[e] : k1[e - 4]); ss += q[e] * q[e]; }
          ss += __shfl_xor(ss, 1); ss += __shfl_xor(ss, 2); ss += __shfl_xor(ss, 4);
          const float inv = 1.f / fmaxf(sqrtf(ss), 1e-12f);
          w[0] = pk2(q[0] * inv, q[1] * inv); w[1] = pk2(q[2] * inv, q[3] * inv); w[2] = pk2(q[4] * inv, q[5] * inv); w[3] = pk2(q[6] * inv, q[7] * inv);
          *(u32x4*)(kkb + (size_t)rc * 512 + 8 * lane) = w; }
        mix8(1088 + 8 * lane, o);
        { u32x4 w; w[0] = pk2(o[0], o[1]); w[1] = pk2(o[2], o[3]); w[2] = pk2(o[4], o[5]); w[3] = pk2(o[6], o[7]); *(u32x4*)(vv + (size_t)rc * 512 + 8 * lane) = w;
          if (l == 0) *(u32x4*)(vfirst + ra * 512 + 8 * lane) = w; }
        bf16_t* lr = la + (size_t)rc * 512;
        { const float x = mix1(512 + lane); const float t = fexp2(2.f * x * LOG2E); lr[lane] = f2bf(1.f - 2.f * frcp(t + 1.f)); }
        lr[64 + lane] = f2bf(mix1(1600 + lane));
        lr[128 + lane] = f2bf(fsigmoid(mix1(1664 + lane)));
        lr[192 + lane] = f2bf(fsigmoid(mix1(1728 + lane)));
        if (lane < 32) { const float c0 = bf2f(left[ra * 32 + lane]); const float p0 = hp ? bf2f(left[(ra - 1) * 32 + lane]) : 0.f;
            lr[256 + lane] = f2bf(fsigmoid(c0 + (p0 - c0) * mu[1792 + lane])); }
        if (lane < 56) *(u32x2*)(lr + 288 + 4 * lane) = (u32x2){0u, 0u};
        if (sl == SC - 1) { bf16_t* cp = carry + (size_t)(((c & 1) * 16) + b) * RAWLD;
            for (int j = lane; j < RAWLD / 8; j += 64) *(u32x4*)(cp + 8 * j) = *(const u32x4*)(cur + 8 * j); }
    }
}

DI float dpp_ror_add(float x, int) { return x; }
DI void reduce4(float p0, float p1, float p2, float p3, float& s0, float& s1, float& s2, float& s3) {
    auto r = __builtin_amdgcn_permlane32_swap(__float_as_uint(p0), __float_as_uint(p2), false, false);
    const float u0 = __uint_as_float(r[0]) + __uint_as_float(r[1]);
    r = __builtin_amdgcn_permlane32_swap(__float_as_uint(p1), __float_as_uint(p3), false, false);
    const float u1 = __uint_as_float(r[0]) + __uint_as_float(r[1]);
    r = __builtin_amdgcn_permlane16_swap(__float_as_uint(u0), __float_as_uint(u1), false, false);
    float w = __uint_as_float(r[0]) + __uint_as_float(r[1]);
    w += __uint_as_float(__builtin_amdgcn_update_dpp(0, __float_as_uint(w), 0x128, 0xf, 0xf, false));
    w += __uint_as_float(__builtin_amdgcn_update_dpp(0, __float_as_uint(w), 0x124, 0xf, 0xf, false));
    w += __uint_as_float(__builtin_amdgcn_update_dpp(0, __float_as_uint(w), 0x122, 0xf, 0xf, false));
    w += __uint_as_float(__builtin_amdgcn_update_dpp(0, __float_as_uint(w), 0x121, 0xf, 0xf, false));
    s0 = __uint_as_float(__builtin_amdgcn_readlane(__float_as_uint(w), 0));
    s1 = __uint_as_float(__builtin_amdgcn_readlane(__float_as_uint(w), 16));
    s2 = __uint_as_float(__builtin_amdgcn_readlane(__float_as_uint(w), 32));
    s3 = __uint_as_float(__builtin_amdgcn_readlane(__float_as_uint(w), 48));
}
struct ScanIn { bf16_t kk, bb, k, r, v; float w; };
DI void phase_scan(int l, int c) {
    const int lane = TID() & 63, gw = BID() * 8 + (TID() >> 6), nw = gridDim.x * 8;
    const bf16_t* kkb = wsp<bf16_t>(WS_KKB); const bf16_t* bbb = wsp<bf16_t>(WS_BBB); const bf16_t* kfb = wsp<bf16_t>(WS_KF); const bf16_t* rrb = wsp<bf16_t>(WS_RR);
    const bf16_t* vsb = wsp<bf16_t>(l == 0 ? WS_VV : WS_V2); const float* dec = wsp<float>(WS_DEC); float* outb = wsp<float>(WS_OUT); float* state = wsp<float>(WS_STATE);
    for (int item = gw; item < NB * NH * 16; item += nw) {
        const int bh = item >> 4, rg = item & 15, b = bh >> 3, h = bh & 7, i0 = rg * 4;
        float* stp = state + ((size_t)bh * 64 + i0) * 64 + lane;
        float S0 = 0.f, S1 = 0.f, S2 = 0.f, S3 = 0.f;
        if (c > 0) { S0 = stp[0]; S1 = stp[64]; S2 = stp[128]; S3 = stp[192]; }
        const size_t e0 = (size_t)b * SC * 512 + h * 64 + lane;
        const size_t ev = (size_t)b * SC * 512 + h * 64 + i0 + (lane & 3);
        float* op = outb + (size_t)b * SC * 512 + h * 64 + i0 + (lane >> 4);
        ScanIn A[8], B[8];
#define SCAN_LOAD(X, g) do { _Pragma("unroll") for (int j = 0; j < 8; ++j) { const size_t o = (size_t)((g) * 8 + j) * 512; \
            X[j].kk = kkb[e0 + o]; X[j].bb = bbb[e0 + o]; X[j].k = kfb[e0 + o]; X[j].r = rrb[e0 + o]; X[j].w = dec[e0 + o]; X[j].v = vsb[ev + o]; } } while (0)
#define SCAN_STEP(X, g) do { _Pragma("unroll") for (int j = 0; j < 8; ++j) { \
            const float kk = bf2f(X[j].kk), bb = bf2f(X[j].bb), kx = bf2f(X[j].k), rx = bf2f(X[j].r), wx = X[j].w; const unsigned vu = (unsigned)X[j].v << 16; \
            const float v0 = __uint_as_float(__builtin_amdgcn_readlane(vu, 0)), v1 = __uint_as_float(__builtin_amdgcn_readlane(vu, 1)), v2 = __uint_as_float(__builtin_amdgcn_readlane(vu, 2)), v3 = __uint_as_float(__builtin_amdgcn_readlane(vu, 3)); \
            float a0, a1, a2, a3; reduce4(S0 * kk, S1 * kk, S2 * kk, S3 * kk, a0, a1, a2, a3); \
            S0 = S0 * wx + (v0 * kx - a0 * bb); S1 = S1 * wx + (v1 * kx - a1 * bb); S2 = S2 * wx + (v2 * kx - a2 * bb); S3 = S3 * wx + (v3 * kx - a3 * bb); \
            float o0, o1, o2, o3; reduce4(S0 * rx, S1 * rx, S2 * rx, S3 * rx, o0, o1, o2, o3); \
            const int q4 = lane >> 4; const float ov = q4 == 0 ? o0 : (q4 == 1 ? o1 : (q4 == 2 ? o2 : o3)); \
            if ((lane & 15) == 0) op[(size_t)((g) * 8 + j) * 512] = ov; } } while (0)
        SCAN_LOAD(A, 0);
        for (int g = 0; g < SC / 8; g += 2) {
            SCAN_LOAD(B, g + 1);
            SCAN_STEP(A, g);
            if (g + 2 < SC / 8) SCAN_LOAD(A, g + 2);
            SCAN_STEP(B, g + 1);
        }
#undef SCAN_LOAD
#undef SCAN_STEP
        stp[0] = S0; stp[64] = S1; stp[128] = S2; stp[192] = S3;
    }
}
DI void phase_rwkv_post(int l) {
    const int lane = TID() & 63, gw = BID() * 8 + (TID() >> 6), nw = gridDim.x * 8;
    const float* outb = wsp<float>(WS_OUT); const bf16_t* rrb = wsp<bf16_t>(WS_RR); const bf16_t* kfb = wsp<bf16_t>(WS_KF);
    const bf16_t* vsb = wsp<bf16_t>(l == 0 ? WS_VV : WS_V2); const bf16_t* ggb = wsp<bf16_t>(WS_GG); bf16_t* orw = wsp<bf16_t>(WS_ORW);
    const float* lnw = KP()->in[I_LNW] + l * 512; const float* lnb = KP()->in[I_LNB] + l * 512; const float* rk = KP()->in[I_RK] + l * 512;
    for (int it = gw; it < TC * NH; it += nw) {
        const int h = it & 7; const size_t e = (size_t)(it >> 3) * 512 + h * 64 + lane;
        const float o = outb[e];
        const float mean = wave_sum(o) * (1.f / 64.f); const float d = o - mean;
        const float var = wave_sum(d * d) * (1.f / 64.f);
        const float bonus = wave_sum(bf2f(rrb[e]) * bf2f(kfb[e]) * rk[h * 64 + lane]);
        float y = d * __builtin_amdgcn_rsqf(var + 64e-5f) * lnw[h * 64 + lane] + lnb[h * 64 + lane];
        y = (y + bonus * bf2f(vsb[e])) * bf2f(ggb[e]);
        orw[e] = f2bf(y);
    }
}

#define MFMA32(a, b, c) __builtin_amdgcn_mfma_f32_32x32x16_bf16((a), (b), (c), 0, 0, 0)
DI unsigned fkey(float v) { v = v + 0.f; const unsigned u = __float_as_uint(v); return (u & 0x80000000u) ? ~u : (u | 0x80000000u); }
DI void phase_dsa_select(int c) {
    const int lane = TID() & 63, gw = BID() * 8 + (TID() >> 6), nw = gridDim.x * 8;
    for (int item = gw; item < TC / 4; item += nw) {
        int lz = lane; asm volatile("" : "+v"(lz));
        const int hh = lz >> 5, r5 = lz & 31;
        const int rc0 = item * 4, b = rc0 >> 9, t0 = c * SC + (rc0 & 511);
        const int qq = ((r5 >> 2) & 1) + 2 * (r5 >> 4), hd = (r5 & 3) + 4 * ((r5 >> 3) & 1);
        const bf16_t* qp = wsp<bf16_t>(WS_IDXQ) + (size_t)(rc0 + qq) * 256 + hd * 32 + 8 * hh;
        const bf16x8 Af0 = *(const bf16x8*)qp, Af1 = *(const bf16x8*)(qp + 16);
        const float* wp = wsp<float>(WS_IDXW) + ((size_t)b * SEQ + t0 + hh) * 8;
        const f32x4 wa0 = *(const f32x4*)wp, wa1 = *(const f32x4*)(wp + 4), wb0 = *(const f32x4*)(wp + 16), wb1 = *(const f32x4*)(wp + 20);
        const int tA = t0 + hh, tB = t0 + hh + 2;
        const int ngrp = ((t0 + 3) >> 9) + 1;
        unsigned keyA[64], keyB[64];
        const bf16_t* kbase = wsp<bf16_t>(WS_IDXK) + ((size_t)b * SEQ + r5) * 32 + 8 * hh;
        int keyv = r5;
        unsigned kofs = 0u;
#pragma unroll
        for (int g = 0; g < 4; ++g) {
            if (g < ngrp) {
#pragma unroll
                for (int j = 0; j < 16; ++j) {
                    const int kt = g * 16 + j;
                    const bf16_t* kp = kbase + kofs;
                    const bf16x8 Bf0 = *(const bf16x8*)kp, Bf1 = *(const bf16x8*)(kp + 16);
                    f32x16 C = {0.f, 0.f, 0.f, 0.f, 0.f, 0.f, 0.f, 0.f, 0.f, 0.f, 0.f, 0.f, 0.f, 0.f, 0.f, 0.f};
                    C = MFMA32(Af0, Bf0, C); C = MFMA32(Af1, Bf1, C);
                    float va = 0.f, vb = 0.f;
#pragma unroll
                    for (int i = 0; i < 4; ++i) { va += fmaxf(C[i], 0.f) * wa0[i]; vb += fmaxf(C[8 + i], 0.f) * wb0[i]; }
#pragma unroll
                    for (int i = 0; i < 4; ++i) { va += fmaxf(C[4 + i], 0.f) * wa1[i]; vb += fmaxf(C[12 + i], 0.f) * wb1[i]; }
                    unsigned ka = (keyv <= tA) ? fkey(va) : 0u, kb = (keyv <= tB) ? fkey(vb) : 0u;
                    asm volatile("" : "+v"(ka), "+v"(kb), "+v"(keyv), "+v"(kofs));
                    keyA[kt] = ka; keyB[kt] = kb;
                    keyv += 32; kofs += 32 * 32;
                }
            } else {
#pragma unroll
                for (int j = 0; j < 16; ++j) { keyA[g * 16 + j] = 0u; keyB[g * 16 + j] = 0u; }
            }
        }
        unsigned KA = 0u, KB = 0u;
        if (t0 + 3 >= 256) {
            for (int bit = 31; bit >= 0; --bit) {
                const unsigned bm = 1u << bit;
                const unsigned cA = KA | bm, cB = KB | bm;
                int nA = 0, nB = 0;
#pragma unroll
                for (int g = 0; g < 4; ++g) {
                    if (g < ngrp) {
#pragma unroll
                        for (int j = 0; j < 16; ++j) { nA += (keyA[g * 16 + j] >= cA) ? 1 : 0; nB += (keyB[g * 16 + j] >= cB) ? 1 : 0; }
                    }
                }
#pragma unroll
                for (int o = 16; o >= 1; o >>= 1) { nA += __shfl_xor(nA, o); nB += __shfl_xor(nB, o); }
                if (nA >= 256) KA = cA;
                if (nB >= 256) KB = cB;
            }
        }
        int gA = 0, gB = 0;
#pragma unroll
        for (int kt = 0; kt < 64; ++kt) { gA += (keyA[kt] > KA) ? 1 : 0; gB += (keyB[kt] > KB) ? 1 : 0; }
#pragma unroll
        for (int o = 16; o >= 1; o >>= 1) { gA += __shfl_xor(gA, o); gB += __shfl_xor(gB, o); }
        const int needA = (KA == 0u) ? 0 : 256 - gA, needB = (KB == 0u) ? 0 : 256 - gB;
        asm volatile("" : "+v"(KA), "+v"(KB));
        int runA = 0, runB = 0, lsel = lz;
        unsigned w0 = 0u, w1 = 0u, w2 = 0u, w3 = 0u;
#pragma unroll
        for (int kt = 0; kt < 64; ++kt) {
            const bool eqA = keyA[kt] == KA, eqB = keyB[kt] == KB;
            const unsigned long long ea = __ballot(eqA), eb = __ballot(eqB);
            const int rkA = runA + (hh ? (int)__builtin_amdgcn_mbcnt_hi((unsigned)(ea >> 32), 0u) : (int)__builtin_amdgcn_mbcnt_lo((unsigned)ea, 0u));
            const int rkB = runB + (hh ? (int)__builtin_amdgcn_mbcnt_hi((unsigned)(eb >> 32), 0u) : (int)__builtin_amdgcn_mbcnt_lo((unsigned)eb, 0u));
            const bool sA = (keyA[kt] > KA) || (eqA && rkA < needA), sB = (keyB[kt] > KB) || (eqB && rkB < needB);
            runA += hh ? __builtin_popcount((unsigned)(ea >> 32)) : __builtin_popcount((unsigned)ea);
            runB += hh ? __builtin_popcount((unsigned)(eb >> 32)) : __builtin_popcount((unsigned)eb);
            const unsigned long long sa = __ballot(sA), sb = __ballot(sB);
            if (lsel == 0) { w0 = (unsigned)sa; w1 = (unsigned)(sa >> 32); w2 = (unsigned)sb; w3 = (unsigned)(sb >> 32); }
            lsel -= 1; asm volatile("" : "+v"(lsel));
            __builtin_amdgcn_sched_barrier(0);
        }
        unsigned* sp = wsp<unsigned>(WS_SELB) + (size_t)rc0 * 64 + lz;
        sp[0] = w0; sp[64] = w1; sp[128] = w2; sp[192] = w3;
    }
}

struct AttnSt { f32x16 O0, O1; float m, l; };
constexpr float C2 = 0.125f * LOG2E;
template <int MODE, bool FAR>
DI void attn_tile(AttnSt& st, const bf16x8 (&Qf)[4], const bf16_t* kbase, const bf16_t* vtbase, int key0, int tq, bool allowed, unsigned word, LAS const float* bt, int lane) {
    const int r5 = lane & 31, hh = lane >> 5;
    const int prow = (r5 & 19) | ((r5 & 4) << 1) | ((r5 & 8) >> 1);
    const bf16_t* kp = kbase + (size_t)(key0 + prow) * 512;
    bf16x8 Kf[4];
#pragma unroll
    for (int s = 0; s < 4; ++s) Kf[s] = *(const bf16x8*)(kp + 16 * s);
    f32x16 S = {0.f, 0.f, 0.f, 0.f, 0.f, 0.f, 0.f, 0.f, 0.f, 0.f, 0.f, 0.f, 0.f, 0.f, 0.f, 0.f};
#pragma unroll
    for (int s = 0; s < 4; ++s) S = MFMA32(Kf[s], Qf[s], S);
    bf16x8 Vf[2][2];
#pragma unroll
    for (int n = 0; n < 2; ++n)
#pragma unroll
        for (int s = 0; s < 2; ++s) Vf[n][s] = *(const bf16x8*)(vtbase + (size_t)(32 * n) * SEQ + key0 + 16 * s);
    float x[16]; bool ok[16];
    const float cfar = bt[127];
    float mx = -INFINITY;
#pragma unroll
    for (int i = 0; i < 16; ++i) {
        const int koff = 16 * (i >> 3) + 8 * hh + (i & 7);
        float bias;
        if (FAR) { bias = cfar; ok[i] = (MODE == 0) ? allowed : (((word >> koff) & 1u) != 0u); }
        else { const int dist = tq - (key0 + koff); ok[i] = (MODE == 0) ? (allowed && dist >= 0) : (((word >> koff) & 1u) != 0u); bias = bt[min(max(dist, 0), 127)]; }
        x[i] = ok[i] ? (S[i] * C2 + bias) : -INFINITY;
        mx = fmaxf(mx, x[i]);
    }
    mx = fmaxf(mx, __shfl_xor(mx, 32));
    const float mnew = fmaxf(st.m, mx);
    const float muse = (mnew == -INFINITY) ? 0.f : mnew;
    const float alpha = fexp2(st.m - muse);
    float ps = 0.f; float pv[16];
#pragma unroll
    for (int i = 0; i < 16; ++i) { pv[i] = ok[i] ? fexp2(x[i] - muse) : 0.f; ps += pv[i]; }
    st.l = st.l * alpha + ps; st.m = mnew;
#pragma unroll
    for (int i = 0; i < 16; ++i) { st.O0[i] *= alpha; st.O1[i] *= alpha; }
#pragma unroll
    for (int s = 0; s < 2; ++s) {
        u32x4 pw; pw[0] = pk2(pv[8 * s], pv[8 * s + 1]); pw[1] = pk2(pv[8 * s + 2], pv[8 * s + 3]); pw[2] = pk2(pv[8 * s + 4], pv[8 * s + 5]); pw[3] = pk2(pv[8 * s + 6], pv[8 * s + 7]);
        const bf16x8 Pf = __builtin_bit_cast(bf16x8, pw);
        st.O0 = MFMA32(Vf[0][s], Pf, st.O0); st.O1 = MFMA32(Vf[1][s], Pf, st.O1);
    }
}
template <int MODE>
DI void attn_item(int c, int b, int h, int qt, LAS const float* bt, int lane) {
    const int r5 = lane & 31, hh = lane >> 5;
    bf16_t* qbuf = wsp<bf16_t>(MODE == 0 ? WS_MQ : WS_DQ);
    const bf16_t* kb = wsp<bf16_t>(MODE == 0 ? WS_MK : WS_DK) + (size_t)b * SEQ * 512 + h * 64 + 8 * hh;
    const bf16_t* vtb = wsp<bf16_t>(MODE == 0 ? WS_MVT : WS_DVT) + ((size_t)b * 512 + h * 64 + r5) * SEQ + 8 * hh;
    const int rowc0 = b * SC + 32 * qt, t0 = c * SC + 32 * qt, tq = t0 + r5;
    bf16_t* qp = qbuf + (size_t)(rowc0 + r5) * 512 + h * 64;
    bf16x8 Qf[4];
#pragma unroll
    for (int s = 0; s < 4; ++s) Qf[s] = *(const bf16x8*)(qp + 16 * s + 8 * hh);
    AttnSt st; st.m = -INFINITY; st.l = 0.f;
#pragma unroll
    for (int i = 0; i < 16; ++i) { st.O0[i] = 0.f; st.O1[i] = 0.f; }
    if (MODE == 0) {
        const int own = t0 >> 8;
        unsigned bm = 0u;
        if (own > 0) {
            const float* km = wsp<float>(WS_KMEAN) + ((size_t)(b * 8 + h) * 8) * 64 + 8 * hh;
            float g[8];
#pragma unroll
            for (int n = 0; n < 8; ++n) {
                g[n] = -INFINITY;
                if (n < own) {
                    float part = 0.f;
#pragma unroll
                    for (int s = 0; s < 4; ++s) { const f32x4 k0 = *(const f32x4*)(km + n * 64 + 16 * s), k1 = *(const f32x4*)(km + n * 64 + 16 * s + 4);
#pragma unroll
                        for (int j = 0; j < 4; ++j) part += bf2f((bf16_t)Qf[s][j]) * k0[j] + bf2f((bf16_t)Qf[s][4 + j]) * k1[j]; }
                    g[n] = part + __shfl_xor(part, 32);
                }
            }
#pragma unroll
            for (int n = 0; n < 8; ++n) {
                if (n < own) { int rank = 0;
#pragma unroll
                    for (int m2 = 0; m2 < 8; ++m2) if (m2 != n && m2 < own) rank += ((g[m2] > g[n]) || (g[m2] == g[n] && m2 < n)) ? 1 : 0;
                    if (rank < 3) bm |= 1u << n; }
            }
        }
        for (int nb = 0; nb <= own; ++nb) {
            const bool isown = (nb == own);
            const bool allowed = isown || (((bm >> nb) & 1u) != 0u);
            if (!isown && __ballot(allowed) == 0ull) continue;
            const int kt0 = nb * 8, kt1 = isown ? ((t0 + 31) >> 5) : (nb * 8 + 7);
            for (int kt = kt0; kt <= kt1; ++kt) {
                const int key0 = kt * 32;
                if (t0 - (key0 + 31) >= 113) attn_tile<0, true>(st, Qf, kb, vtb, key0, tq, allowed, 0u, bt, lane);
                else attn_tile<0, false>(st, Qf, kb, vtb, key0, tq, allowed, 0u, bt, lane);
            }
        }
    } else {
        const unsigned* sp = wsp<unsigned>(WS_SELB) + (size_t)(rowc0 + r5) * 64;
        const int kt1 = (t0 + 31) >> 5;
        for (int kt = 0; kt <= kt1; ++kt) {
            const unsigned word = sp[kt];
            if (__ballot(word != 0u) == 0ull) continue;
            const int key0 = kt * 32;
            if (t0 - (key0 + 31) >= 113) attn_tile<1, true>(st, Qf, kb, vtb, key0, tq, true, word, bt, lane);
            else attn_tile<1, false>(st, Qf, kb, vtb, key0, tq, true, word, bt, lane);
        }
    }
    const float lt = st.l + __shfl_xor(st.l, 32);
    const float inv = 1.f / lt;
#pragma unroll
    for (int g4 = 0; g4 < 4; ++g4) {
        st_bf4(qp + 8 * g4 + 4 * hh, (f32x4){st.O0[4 * g4] * inv, st.O0[4 * g4 + 1] * inv, st.O0[4 * g4 + 2] * inv, st.O0[4 * g4 + 3] * inv});
        st_bf4(qp + 32 + 8 * g4 + 4 * hh, (f32x4){st.O1[4 * g4] * inv, st.O1[4 * g4 + 1] * inv, st.O1[4 * g4 + 2] * inv, st.O1[4 * g4 + 3] * inv});
    }
}
__device__ const unsigned char kBucket[128] = {0,1,2,3,4,5,6,7,8,9,10,11,12,13,14,15,16,16,16,17,17,18,18,18,19,19,19,20,20,20,20,21,21,21,21,22,22,22,22,22,23,23,23,23,23,23,24,24,24,24,24,24,25,25,25,25,25,25,25,26,26,26,26,26,26,26,26,27,27,27,27,27,27,27,27,27,27,28,28,28,28,28,28,28,28,28,28,29,29,29,29,29,29,29,29,29,29,29,29,30,30,30,30,30,30,30,30,30,30,30,30,30,30,31,31,31,31,31,31,31,31,31,31,31,31,31,31,31};
DI void phase_attn(int l, int c, LAS float* lds) {
    const int tid = TID(), lane = tid & 63, wave = tid >> 6;
    for (int e = tid; e < 2 * 8 * 128; e += 512) { const int d = e & 127, h = (e >> 7) & 7, mx = e >> 10; lds[e] = KP()->in[I_REL][kBucket[d] * 16 + mx * 8 + h] * LOG2E; }
    __syncthreads();
    const int nw = gridDim.x * 8;
    for (int it = BID() * 8 + wave; it < NB * NH * 16; it += nw) {
        const int bh = it >> 4, b = bh >> 3, h = bh & 7, qm = it & 15, qd = 15 - qm;
        attn_item<0>(c, b, h, qm, lds + h * 128, lane);
        attn_item<1>(c, b, h, qd, lds + 1024 + h * 128, lane);
    }
    phase_rwkv_post(l);
}

constexpr int LDS_BYTES = pg8::STAGE_BYTES + 256;
constexpr int PH_PER_LAYER = 36, N_PHASES = 2 * PH_PER_LAYER;
#ifndef MK_ONE_LAUNCH
#define MK_ONE_LAUNCH 1
#endif
__global__ void __launch_bounds__(512, 2) mega(Params p) {
    extern __shared__ __attribute__((aligned(16))) unsigned char lds_raw[];
    LAS unsigned char* lds = (LAS unsigned char*)lds_raw;
    volatile LAS unsigned* bst = (volatile LAS unsigned*)(lds + pg8::STAGE_BYTES);
    if (TID() < 4) bst[TID()] = 0u;
    __syncthreads();
    if (p.ph_hi - p.ph_lo > 1) (void)xcd_barrier_post((unsigned*)(KP()->ws + WS_CTL), bst);
#ifndef PH_ONLY
#define PH_ONLY -1
#endif
#define IN(k) (KP()->ph_lo <= (k) && (k) < KP()->ph_hi)
#define INT(tag, k) ((PH_ONLY < 0 || PH_ONLY == (tag)) && IN(k))
#define SEAM(k) do { if (IN(k) && IN((k) + 1)) { XcdBarrier bar_; bar_.bar = (unsigned*)(KP()->ws + WS_CTL); bar_.x = xb_xcc_id(); bar_.st = (volatile LAS unsigned*)(lds + pg8::STAGE_BYTES); xcd_barrier(bar_); } } while (0)
    for (int l = 0; l < 2; ++l) {
        const int pb = PH_PER_LAYER * l;
        if (INT(0, pb + 0)) phase_conv(l, (LAS float*)lds);
        SEAM(pb + 0);
        if (INT(1, pb + 1)) phase_norm(l == 0 ? KP()->in[I_X] : (const float*)KP()->out, KP()->in[I_NMIX] + l * DM, wsp<bf16_t>(WS_H));
        SEAM(pb + 1);
        if (INT(2, pb + 2)) {
            { const SchedLin S = mk_sched(128, 4, WS_H, WS_WB, 1024); const EpiB E{l}; pg8::gemm_phase(lds, 1024, S, E); }
            { const SchedLin S = mk_sched(2, 128, WS_WV, WS_H, 1024); const EpiVt E{(unsigned)WS_MVT}; pg8::gemm_phase(lds, 1024, S, E); }
        }
        SEAM(pb + 2);
        if (INT(3, pb + 3)) { phase_dcn(l); phase_kmean(); }
        SEAM(pb + 3);
        if (INT(4, pb + 4)) {
            { const SchedLin S = mk_sched(128, 2, WS_DCN, WS_WKVK, 256); const EpiHN E{l}; pg8::gemm_phase(lds, 256, S, E); }
            { const SchedLin S = mk_sched(2, 128, WS_WKVV, WS_DCN, 256); const EpiVt E{(unsigned)WS_DVT}; pg8::gemm_phase(lds, 256, S, E); }
        }
        SEAM(pb + 4);
        for (int c = 0; c < NCH; ++c) {
            const int pc = pb + 5 + 7 * c, cbase = c * SC;
            if (INT(5, pc + 0)) { const SchedLin S = mk_sched(32, 24, WS_H, WS_WD1, 1024, 1, cbase); const EpiD1 E{l}; pg8::gemm_phase(lds, 1024, S, E); }
            SEAM(pc + 0);
            if (INT(6, pc + 1)) { phase_rwkv_prep(l, c); phase_dsa_select(c); }
            SEAM(pc + 1);
            if (INT(7, pc + 2)) { const SchedLin S = mk_sched(32, l == 0 ? 6 : 8, WS_LORAA, WS_WL, 512, 0, 0, WS_VV, 6); const EpiLora E{l, cbase}; pg8::gemm_phase(lds, 512, S, E); }
            SEAM(pc + 2);
            if (INT(8, pc + 3)) phase_scan(l, c);
            SEAM(pc + 3);
            if (INT(9, pc + 4)) phase_attn(l, c, (LAS float*)lds);
            SEAM(pc + 4);
            if (INT(10, pc + 5)) { const SchedMerge S{(int)gridDim.x, (int)BID()}; const EpiMerge E{}; pg8::gemm_phase(lds, 512, S, E); }
            SEAM(pc + 5);
            if (INT(11, pc + 6)) { const SchedLin S = mk_sched(32, 4, WS_Y, WS_WO, 1024); const EpiRes E{l == 0 ? 1 : 0, 1, cbase}; pg8::gemm_phase(lds, 1024, S, E); }
            SEAM(pc + 6);
        }
        if (INT(33, pb + 33)) phase_norm(KP()->out, KP()->in[I_NFFN] + l * DM, wsp<bf16_t>(WS_H));
        SEAM(pb + 33);
        if (INT(34, pb + 34)) { const SchedLin S = mk_sched(128, 22, WS_H, WS_WF1, 1024); const EpiSwiglu E{}; pg8::gemm_phase(lds, 1024, S, E); }
        SEAM(pb + 34);
        if (INT(35, pb + 35)) { const SchedLin S = mk_sched(128, 4, WS_ACT, WS_WF2, DFF); const EpiRes E{0, 0, 0}; pg8::gemm_phase(lds, DFF, S, E); }
        SEAM(pb + 35);
    }
#undef IN
#undef INT
#undef SEAM
}

extern "C" void kernel_launch(void* const* d_in, const int* in_sizes, int n_in, void* d_out, int out_size, void* d_ws, size_t ws_size, hipStream_t stream) {
    static int grid = 0;
    if (grid == 0) {
        if (n_in != 26 || ws_size < WS_END) { grid = -1; return; }
        int dev = 0, cus = 0;
        if (hipGetDevice(&dev) != hipSuccess || hipDeviceGetAttribute(&cus, hipDeviceAttributeMultiprocessorCount, dev) != hipSuccess) { grid = -1; return; }
        if (hipFuncSetAttribute((const void*)mega, hipFuncAttributeMaxDynamicSharedMemorySize, LDS_BYTES) != hipSuccess) { grid = -1; return; }
        grid = cus;
    }
    if (grid < 0) return;
    (void)hipMemsetAsync((char*)d_ws + WS_CTL, 0, 64 * 1024, stream);
    Params p{};
    for (int i = 0; i < 26; ++i) p.in[i] = (const float*)d_in[i];
    p.out = (float*)d_out; p.ws = (unsigned char*)d_ws;
#if MK_ONE_LAUNCH
    p.ph_lo = 0; p.ph_hi = N_PHASES;
    hipLaunchKernelGGL(mega, dim3(grid), dim3(512), LDS_BYTES, stream, p);
#else
    for (int ph = 0; ph < N_PHASES; ++ph) { p.ph_lo = ph; p.ph_hi = ph + 1; hipLaunchKernelGGL(mega, dim3(grid), dim3(512), LDS_BYTES, stream, p); }
#endif
}
```

```cpp
#include <hip/hip_runtime.h>
#include <stdint.h>

#define DI __device__ __forceinline__
#define LAS __attribute__((address_space(3)))
typedef unsigned short bf16_t;
typedef short bf16x8 __attribute__((ext_vector_type(8)));
typedef float f32x2 __attribute__((ext_vector_type(2)));
typedef float f32x4 __attribute__((ext_vector_type(4)));
typedef float f32x16 __attribute__((ext_vector_type(16)));
typedef unsigned u32x2 __attribute__((ext_vector_type(2)));
typedef unsigned u32x4 __attribute__((ext_vector_type(4)));
typedef __bf16 bf2_t __attribute__((ext_vector_type(2)));

constexpr int NB = 16, SEQ = 2048, DM = 1024, NT = NB * SEQ, NH = 8, BW = 512;
constexpr int NCH = 4, SC = 512, TC = NB * SC;
constexpr int D_IN = 7496, DFF = 2816;
constexpr int C_MQ = 0, C_MK = 512, C_MV = 1024, C_RW = 1536, C_DS = 3360, C_GT = 4424;
constexpr int RAWLD = 1792;
constexpr float NORM_EPS = 1e-6f;
constexpr float LOG2E = 1.4426950408889634f;

constexpr size_t MiB = 1024 * 1024;
constexpr size_t WS_CTL = 0;
constexpr size_t WS_WB = 64 * 1024;
constexpr size_t WS_WV = WS_WB + 2 * MiB;
constexpr size_t WS_WD1 = WS_WV + 1 * MiB;
constexpr size_t WS_WKVK = WS_WD1 + 12 * MiB;
constexpr size_t WS_WKVV = WS_WKVK + MiB / 4;
constexpr size_t WS_WL = WS_WKVV + MiB / 4;
constexpr size_t WS_WBR = WS_WL + 2 * MiB;
constexpr size_t WS_WO = WS_WBR + 3 * MiB;
constexpr size_t WS_WF1 = WS_WO + 2 * MiB;
constexpr size_t WS_WF2 = WS_WF1 + 11 * MiB;
constexpr size_t WS_VFIRST = WS_WF2 + 6 * MiB;
constexpr size_t WS_STATE = WS_VFIRST + 32 * MiB;
constexpr size_t WS_H = WS_STATE + 2 * MiB;
constexpr size_t WS_IDXK = WS_H + 64 * MiB;
constexpr size_t WS_IDXW = WS_IDXK + 2 * MiB;
constexpr size_t WS_LEFT = WS_IDXW + 1 * MiB;
constexpr size_t WS_DCN = WS_LEFT + 2 * MiB;
constexpr size_t WS_KMEAN = WS_DCN + 16 * MiB;
constexpr size_t WS_CARRY = WS_KMEAN + MiB / 4;
constexpr size_t WS_MK = WS_CARRY + MiB / 4;
constexpr size_t WS_MVT = WS_MK + 32 * MiB;
constexpr size_t WS_DK = WS_MVT + 32 * MiB;
constexpr size_t WS_DVT = WS_DK + 32 * MiB;
constexpr size_t WS_MQ = WS_DVT + 32 * MiB;
constexpr size_t WS_DQ = WS_MQ + 8 * MiB;
constexpr size_t WS_IDXQ = WS_DQ + 8 * MiB;
constexpr size_t WS_RAW = WS_IDXQ + 4 * MiB;
constexpr size_t WS_LORAA = WS_RAW + 28 * MiB;
constexpr size_t WS_Y32 = WS_RAW;
constexpr size_t WS_GATES = WS_LORAA + 8 * MiB;
constexpr size_t WS_RR = WS_GATES + 48 * MiB;
constexpr size_t WS_KF = WS_RR + 8 * MiB;
constexpr size_t WS_VV = WS_KF + 8 * MiB;
constexpr size_t WS_KKB = WS_VV + 8 * MiB;
constexpr size_t WS_BBB = WS_KKB + 8 * MiB;
constexpr size_t WS_GG = WS_BBB + 8 * MiB;
constexpr size_t WS_DEC = WS_GG + 8 * MiB;
constexpr size_t WS_Y = WS_DEC;
constexpr size_t WS_OUT = WS_DEC + 16 * MiB;
constexpr size_t WS_V2 = WS_OUT + 16 * MiB;
constexpr size_t WS_SELB = WS_V2 + 8 * MiB;
constexpr size_t WS_ORW = WS_SELB + 2 * MiB;
constexpr size_t WS_END = WS_ORW + 8 * MiB;
constexpr size_t WS_ACT = WS_MK;
static_assert(WS_END <= 512 * MiB, "workspace map exceeds 512 MiB");
static_assert(WS_ACT + 176 * MiB <= WS_END, "ACT alias");

DI unsigned pk2(float a, float b) { f32x2 v = {a, b}; return __builtin_bit_cast(unsigned, __builtin_convertvector(v, bf2_t)); }
DI bf16_t f2bf(float a) { return (bf16_t)(pk2(a, 0.f) & 0xffffu); }
DI float bflo(unsigned u) { return __uint_as_float(u << 16); }
DI float bfhi(unsigned u) { return __uint_as_float(u & 0xffff0000u); }
DI float bf2f(bf16_t b) { return __uint_as_float((unsigned)b << 16); }
DI float fexp2(float x) { return __builtin_amdgcn_exp2f(x); }
DI float frcp(float x) { return __builtin_amdgcn_rcpf(x); }
DI float fsigmoid(float x) { return frcp(1.f + fexp2(-x * LOG2E)); }
DI float wave_sum(float v) {
#pragma unroll
    for (int o = 32; o >= 1; o >>= 1) v += __shfl_xor(v, o);
    return v;
}

#define XB_TMO      128
#define XB_XCNT(j)  (256  + 64 * (j))
#define XB_XSUB(j)  (1280 + 64 * (j))
#define XB_XGEN(j)  (2304 + 64 * (j))
#define XB_TOP      3328
#define XB_TOPGEN   3392
#define XCD_BAR_WORDS 3456
#define XB_SPIN_CAP (1u << 18)
__device__ __forceinline__ unsigned xb_ld(unsigned* p)              { return __hip_atomic_load(p, __ATOMIC_RELAXED, __HIP_MEMORY_SCOPE_AGENT); }
__device__ __forceinline__ unsigned xb_add(unsigned* p, unsigned v) { return __hip_atomic_fetch_add(p, v, __ATOMIC_RELAXED, __HIP_MEMORY_SCOPE_AGENT); }
__device__ __forceinline__ unsigned xb_xcc_id() { return (unsigned)__builtin_amdgcn_s_getreg((3 << 11) | 20) & 0xFu; }
#define XB_SPIN(cond, bar) do { unsigned _sp = 0; while (cond) { __builtin_amdgcn_s_sleep(1); \
    if ((++_sp & 255u) == 0u) { if (xb_ld(&(bar)[XB_TMO])) break; if (_sp > XB_SPIN_CAP) { atomicAdd(&(bar)[XB_TMO], 1u); break; } } } } while (0)
struct XcdBarrier { unsigned* bar; unsigned x; volatile LAS unsigned* st; };
__device__ __forceinline__ XcdBarrier xcd_barrier_post(unsigned* bar, volatile LAS unsigned* st) {
    XcdBarrier b; b.bar = bar; b.x = xb_xcc_id(); b.st = st;
    if (threadIdx.x == 0) (void)xb_add(&bar[XB_XCNT(b.x)], 1u);
    return b;
}
__device__ __forceinline__ void xcd_barrier_complete(unsigned* bar, unsigned x, unsigned& nloc, unsigned& nx) {
    const unsigned G = gridDim.x * gridDim.y * gridDim.z;
    unsigned sum, cnt, mine, sp = 0u;
    for (;;) {
        sum = 0u; cnt = 0u; mine = 0u;
#pragma unroll 1
        for (unsigned j = 0; j < 16; ++j) { const unsigned c = xb_ld(&bar[XB_XCNT(j)]); sum += c; cnt += (c > 0u) ? 1u : 0u; mine = (j == x) ? c : mine; }
        if (sum == G) break;
        __builtin_amdgcn_s_sleep(1);
        if ((++sp & 255u) == 0u) { if (xb_ld(&bar[XB_TMO])) break; if (sp > XB_SPIN_CAP) { atomicAdd(&bar[XB_TMO], 1u); break; } }
    }
    nloc = mine > 0u ? mine : 1u; nx = cnt > 0u ? cnt : 1u;
}
__device__ __forceinline__ void xcd_barrier(const XcdBarrier& b) {
    asm volatile("s_waitcnt vmcnt(0)" ::: "memory");
    __syncthreads();
    if (threadIdx.x == 0) {
        unsigned* bar = b.bar;
        __builtin_amdgcn_s_waitcnt(0);
        unsigned nloc = b.st[0], nx = b.st[1];
        if (nloc == 0u) { xcd_barrier_complete(bar, b.x, nloc, nx); b.st[0] = nloc; b.st[1] = nx; }
        const unsigned old = xb_add(&bar[XB_XSUB(b.x)], 1u);
        const unsigned gen = old / nloc;
        if (old + 1u == (gen + 1u) * nloc) {
            __builtin_amdgcn_fence(__ATOMIC_RELEASE, "agent");
            asm volatile("s_waitcnt vmcnt(0)" ::: "memory");
            const unsigned og = xb_add(&bar[XB_TOP], 1u);
            const unsigned tg = og / nx;
            if (og + 1u == (tg + 1u) * nx) xb_add(&bar[XB_TOPGEN], 1u);
            else XB_SPIN(xb_ld(&bar[XB_TOPGEN]) == tg, bar);
            __builtin_amdgcn_fence(__ATOMIC_ACQUIRE, "agent");
            xb_add(&bar[XB_XGEN(b.x)], 1u);
            asm volatile("s_waitcnt vmcnt(0)" ::: "memory");
        } else {
            XB_SPIN(xb_ld(&bar[XB_XGEN(b.x)]) == gen, bar);
            __builtin_amdgcn_fence(__ATOMIC_ACQUIRE, "agent");
            asm volatile("s_waitcnt vmcnt(0)" ::: "memory");
        }
    }
    __syncthreads();
}

DI int TID() { int t = threadIdx.x; asm volatile("" : "+v"(t)); return t; }
DI int BID() { int b = blockIdx.x; asm volatile("" : "+s"(b)); return b; }

namespace pg8 {
constexpr int BM = 256, BK = 64, HALF = 128, HTB = HALF * BK * 2, STAGE_BYTES = 8 * HTB, NXCD = 8, WGM = 8;
DI int lds_byte(int r, int c) { const int st = (r >> 4) * 2 + (c >> 5), rr = r & 15, cc = c & 31, ob = rr * 64 + cc * 2; return st * 1024 + (ob ^ (((ob >> 9) & 1) << 5)); }
DI void stage_rc(int b, int& R, int& C) { const int st = b / 1024, sb = b % 1024, swz = sb ^ (((sb >> 9) & 1) << 5); R = (st >> 1) * 16 + swz / 64; C = (st & 1) * 32 + (swz % 64) / 2; }
struct Unit { int pm, pn, z; };

DI bool order_xcd(int nM, int nN, int G, int c, int i, Unit& u) {
    const int nwg = nM * nN; const long L = (long)i * G + c; if (L >= nwg) return false;
    int wgid = (int)L; { const int q = nwg / NXCD, r = nwg % NXCD, xcd = wgid % NXCD, off = wgid / NXCD; wgid = (xcd < r ? xcd * (q + 1) : r * (q + 1) + (xcd - r) * q) + off; }
    const int nig = WGM * nN, gid = wgid / nig, fm = gid * WGM, gsz = (nM - fm) < WGM ? (nM - fm) : WGM;
    u.pm = fm + ((wgid % nig) % gsz); u.pn = (wgid % nig) / gsz; u.z = 0; return true;
}

template <class Epi, class Sched>
DI void gemm_phase(LAS unsigned char* lds, const int K, const Sched& S, const Epi& E) {
    const int tid = TID(), wid = __builtin_amdgcn_readfirstlane(tid >> 6), lane = tid & 63, wr = wid >> 2, wc = wid & 3, fr = lane & 15, fq = lane >> 4;
    const int nt = K / BK;
    unsigned voffA[2];
#pragma unroll
    for (int i = 0; i < 2; ++i) { int R, C; stage_rc(tid * 16 + i * 8192, R, C); voffA[i] = (unsigned)(R * K + C) * 2u; }
    const size_t kstep = (size_t)(BK * 2);
    const size_t hstep = (size_t)HALF * K * 2;
    const unsigned ldsw = (unsigned)wid * 1024u;
    const int aoff = lds_byte(wr * 64 + fr, fq * 8), boff = lds_byte(wc * 32 + fr, fq * 8);
#define PG8_SA(b, h) (((b) * 2 + (h)) * HTB)
#define PG8_SB(b, h) ((4 + (b) * 2 + (h)) * HTB)
#define PG8_STAGE(bufoff, gbase) do { _Pragma("unroll") for (int _i = 0; _i < 2; ++_i) \
        __builtin_amdgcn_global_load_lds((const unsigned*)((const char*)(gbase) + voffA[_i]), (LAS unsigned*)(lds + (bufoff) + ldsw + _i * 8192), 16, 0, 0); } while (0)
#define PG8_LDA(dst, b, h) do { _Pragma("unroll") for (int m = 0; m < 4; ++m) _Pragma("unroll") for (int k = 0; k < 2; ++k) dst[m][k] = *(const LAS bf16x8*)(lds + PG8_SA(b, h) + aoff + m * 2048 + k * 1024); } while (0)
#define PG8_LDB(dst, b, h) do { _Pragma("unroll") for (int n = 0; n < 2; ++n) _Pragma("unroll") for (int k = 0; k < 2; ++k) dst[n][k] = *(const LAS bf16x8*)(lds + PG8_SB(b, h) + boff + n * 2048 + k * 1024); } while (0)
#define PG8_MMA(ai, bj, At, Bt) do { __builtin_amdgcn_s_setprio(1); _Pragma("unroll") for (int m = 0; m < 4; ++m) _Pragma("unroll") for (int n = 0; n < 2; ++n) _Pragma("unroll") for (int k = 0; k < 2; ++k) \
        acc[ai][bj][m][n] = __builtin_amdgcn_mfma_f32_16x16x32_bf16(Bt[n][k], At[m][k], acc[ai][bj][m][n], 0, 0, 0); __builtin_amdgcn_s_setprio(0); } while (0)
#define PG8_WAIT_V(n) asm volatile("s_waitcnt vmcnt(" #n ")" ::: "memory")
#define PG8_WAIT_L(n) asm volatile("s_waitcnt lgkmcnt(" #n ")" ::: "memory")
#define PG8_BAR __builtin_amdgcn_s_barrier()
#define PG8_SCHED __builtin_amdgcn_sched_barrier(0)
    Unit cur, nxt; int ui = 0;
    if (!S.next(0, cur)) return;
    f32x4 acc[2][2][4][2];
#pragma unroll
    for (int a = 0; a < 2; ++a)
#pragma unroll
        for (int b = 0; b < 2; ++b)
#pragma unroll
            for (int m = 0; m < 4; ++m)
#pragma unroll
                for (int n = 0; n < 2; ++n) acc[a][b][m][n] = (f32x4){0.f, 0.f, 0.f, 0.f};
    bf16x8 At[4][2], B0[2][2], B1[2][2];
    const char* cA = S.aptr(cur); const char* cB = S.bptr(cur);
    PG8_STAGE(PG8_SB(0, 0), cB); PG8_STAGE(PG8_SA(0, 0), cA); PG8_STAGE(PG8_SB(0, 1), cB + hstep); PG8_STAGE(PG8_SA(0, 1), cA + hstep);
    if (wr == 1) PG8_BAR;
    PG8_WAIT_V(4); PG8_BAR;
    PG8_STAGE(PG8_SB(1, 0), cB + kstep); PG8_STAGE(PG8_SA(1, 0), cA + kstep); PG8_STAGE(PG8_SB(1, 1), cB + hstep + kstep);
    PG8_WAIT_V(6); PG8_BAR;
    for (;;) {
        const bool has_next = S.next(ui + 1, nxt);
        const char* nA = has_next ? S.aptr(nxt) : cA; const char* nB = has_next ? S.bptr(nxt) : cB;
#pragma unroll 1
        for (int t = 0; t < nt; t += 2) {
            const bool last = (t == nt - 2);
            const char* a1 = cA + (size_t)(t + 1) * kstep;
            const char* a2 = last ? nA : cA + (size_t)(t + 2) * kstep; const char* b2 = last ? nB : cB + (size_t)(t + 2) * kstep;
            const char* a3 = a2 + kstep; const char* b3 = b2 + kstep;
            PG8_LDB(B0, 0, 0); PG8_SCHED; PG8_LDA(At, 0, 0); PG8_STAGE(PG8_SA(1, 1), a1 + hstep);
            PG8_WAIT_L(8); PG8_BAR; PG8_WAIT_L(0); PG8_MMA(0, 0, At, B0); PG8_BAR; PG8_SCHED;
            PG8_LDB(B1, 0, 1); PG8_STAGE(PG8_SB(0, 0), b2);
            PG8_BAR; PG8_WAIT_L(0); PG8_MMA(0, 1, At, B1); PG8_BAR;
            PG8_LDA(At, 0, 1); PG8_STAGE(PG8_SA(0, 0), a2);
            PG8_BAR; PG8_WAIT_L(0); PG8_MMA(1, 0, At, B0); PG8_BAR; PG8_SCHED;
            PG8_STAGE(PG8_SB(0, 1), b2 + hstep);
            PG8_WAIT_V(6); PG8_BAR; PG8_MMA(1, 1, At, B1); PG8_BAR;
            PG8_LDB(B0, 1, 0); PG8_SCHED; PG8_LDA(At, 1, 0); PG8_STAGE(PG8_SA(0, 1), a2 + hstep);
            PG8_WAIT_L(8); PG8_BAR; PG8_WAIT_L(0); PG8_MMA(0, 0, At, B0); PG8_BAR; PG8_SCHED;
            PG8_LDB(B1, 1, 1); PG8_STAGE(PG8_SB(1, 0), b3);
            PG8_BAR; PG8_WAIT_L(0); PG8_MMA(0, 1, At, B1); PG8_BAR;
            PG8_LDA(At, 1, 1); PG8_STAGE(PG8_SA(1, 0), a3);
            PG8_BAR; PG8_WAIT_L(0); PG8_MMA(1, 0, At, B0); PG8_BAR; PG8_SCHED;
            PG8_STAGE(PG8_SB(1, 1), b3 + hstep);
            PG8_WAIT_V(6); PG8_BAR; PG8_MMA(1, 1, At, B1); PG8_BAR;
        }
        { int tz = TID(); asm volatile("" : "+v"(tz));
          const int wz = __builtin_amdgcn_readfirstlane(tz >> 6), lz = tz & 63; E(acc, cur, wz >> 2, wz & 3, lz & 15, lz >> 4); }
        if (!has_next) break;
#pragma unroll
        for (int a = 0; a < 2; ++a)
#pragma unroll
            for (int b = 0; b < 2; ++b)
#pragma unroll
                for (int m = 0; m < 4; ++m)
#pragma unroll
                    for (int n = 0; n < 2; ++n) acc[a][b][m][n] = (f32x4){0.f, 0.f, 0.f, 0.f};
        cur = nxt; cA = nA; cB = nB; ++ui;
    }
    PG8_WAIT_V(0);
    if (wr == 0) PG8_BAR;
    PG8_BAR;
#undef PG8_SA
#undef PG8_SB
#undef PG8_STAGE
#undef PG8_LDA
#undef PG8_LDB
#undef PG8_MMA
#undef PG8_WAIT_V
#undef PG8_WAIT_L
#undef PG8_BAR
#undef PG8_SCHED
}
}
using pg8::Unit;
typedef f32x4 AccT[2][2][4][2];

struct Params {
    const float* in[26];
    float* out;
    unsigned char* ws;
    int ph_lo, ph_hi;
};
enum { I_X = 0, I_WIN, I_NMIX, I_NFFN, I_QKN, I_REL, I_MU, I_W0, I_W2, I_A0, I_A2, I_G2, I_KK, I_KA, I_RK, I_LNW, I_LNB, I_V0, I_VA, I_VB, I_KVN, I_KVUP, I_WBR, I_WO, I_F1, I_F2 };

DI const Params* KP() { auto k = __builtin_amdgcn_kernarg_segment_ptr(); asm volatile("" : "+s"(k)); return (const Params*)k; }
template <class T> DI T* wsp(size_t off) { return (T*)(KP()->ws + off); }

DI int hn_col(int x) { const int pi = x & 255; return (x & ~255) + 64 * ((pi >> 5) & 3) + 32 * (pi >> 7) + (pi & 31); }
template <int MAP> DI int colmap(int r) {
    if (MAP == 0) {
        if (r < 512) return C_MK + hn_col(r);
        if (r < 768) return C_DS + 512 + (r - 512);
        const int pi = r - 768;
        if (pi < 32) return C_DS + 1024 + pi;
        if (pi < 40) return C_DS + 1056 + (pi - 32);
        if (pi >= 64 && pi < 96) return C_RW + 1792 + (pi - 64);
        return -1;
    }
    if (MAP == 1) return C_MV + r;
    if (MAP == 2) {
        if (r < 512) return C_MQ + hn_col(r);
        if (r < 1024) return C_DS + hn_col(r - 512);
        if (r < 1280) return C_DS + 768 + (r - 1024);
        if (r < 3072) return C_RW + (r - 1280);
        return C_GT + (r - 3072);
    }
    if (MAP == 3) return hn_col(r);
    if (MAP == 4) return 512 + r;
    if (MAP == 5) return r;
    if (MAP == 6) { const int pn = r >> 8, pi = r & 255; return ((pi >> 7) ? DFF : 0) + 128 * pn + (pi & 127); }
    return -1;
}
template <int MAP> DI void conv_t(LAS float* sm, bf16_t* dst, int nrows, int K, const float* src, int ld) {
    const int tid = TID(), tx = tid & 63, ty = tid >> 6;
    const int ntr = nrows / 64, ntk = K / 64, ntiles = ntr * ntk;
    for (int t = BID(); t < ntiles; t += gridDim.x) {
        const int r0 = (t / ntk) * 64, k0 = (t % ntk) * 64;
        const int col = colmap<MAP>(r0 + tx);
#pragma unroll
        for (int i = 0; i < 8; ++i) { const int kl = ty + 8 * i; sm[kl * 65 + tx] = (col >= 0) ? src[(size_t)(k0 + kl) * ld + col] : 0.f; }
        __syncthreads();
#pragma unroll
        for (int i = 0; i < 8; ++i) { const int rl = ty + 8 * i; dst[(size_t)(r0 + rl) * K + k0 + tx] = f2bf(sm[tx * 65 + rl]); }
        __syncthreads();
    }
}
DI void conv_lora(int l) {
    bf16_t* dst = wsp<bf16_t>(WS_WL);
    const float* w2 = KP()->in[I_W2] + (size_t)l * 64 * 512; const float* a2 = KP()->in[I_A2] + (size_t)l * 64 * 512; const float* g2 = KP()->in[I_G2] + (size_t)l * 160 * 512;
    const float* va = KP()->in[I_VA]; const float* vb = KP()->in[I_VB];
    const int n = 2048 * 512;
    for (int e = BID() * 512 + TID(); e < n; e += gridDim.x * 512) {
        const int r = e >> 9, k = e & 511; float v = 0.f;
        if (r < 512) { if (k < 64) v = w2[k * 512 + r]; }
        else if (r < 1024) { if (k >= 64 && k < 128) v = a2[(k - 64) * 512 + (r - 512)]; }
        else if (r < 1536) { if (k >= 128 && k < 288) v = g2[(k - 128) * 512 + (r - 1024)]; }
        else if (l == 1) { const int c = r - 1536; float s = 0.f;
#pragma unroll 8
            for (int j = 0; j < 32; ++j) s += va[k * 32 + j] * vb[j * 512 + c];
            v = s; }
        dst[e] = f2bf(v);
    }
}
DI void phase_conv(int l, LAS float* sm) {
    const float* win = KP()->in[I_WIN] + (size_t)l * DM * D_IN;
    conv_t<0>(sm, wsp<bf16_t>(WS_WB), 1024, 1024, win, D_IN);
    conv_t<1>(sm, wsp<bf16_t>(WS_WV), 512, 1024, win, D_IN);
    conv_t<2>(sm, wsp<bf16_t>(WS_WD1), 6144, 1024, win, D_IN);
    const float* kvup = KP()->in[I_KVUP] + (size_t)l * 256 * 1024;
    conv_t<3>(sm, wsp<bf16_t>(WS_WKVK), 512, 256, kvup, 1024);
    conv_t<4>(sm, wsp<bf16_t>(WS_WKVV), 512, 256, kvup, 1024);
    for (int i = 0; i < 3; ++i) conv_t<5>(sm, wsp<bf16_t>(WS_WBR) + (size_t)i * 1024 * 512, 1024, 512, KP()->in[I_WBR] + ((size_t)l * 3 + i) * 512 * 1024, 1024);
    conv_t<5>(sm, wsp<bf16_t>(WS_WO), 1024, 1024, KP()->in[I_WO] + (size_t)l * 1024 * 1024, 1024);
    conv_t<6>(sm, wsp<bf16_t>(WS_WF1), 5632, 1024, KP()->in[I_F1] + (size_t)l * 1024 * 5632, 5632);
    conv_t<5>(sm, wsp<bf16_t>(WS_WF2), 1024, 2816, KP()->in[I_F2] + (size_t)l * 2816 * 1024, 1024);
    conv_lora(l);
}

DI void phase_norm(const float* x, const float* g, bf16_t* h) {
    const int lane = TID() & 63, gw = BID() * 8 + (TID() >> 6), nw = gridDim.x * 8;
    f32x4 gv[4];
#pragma unroll
    for (int i = 0; i < 4; ++i) gv[i] = ((const f32x4*)g)[lane + 64 * i];
    for (int row = gw; row < NT; row += nw) {
        const f32x4* xr = (const f32x4*)(x + (size_t)row * DM);
        f32x4 v[4]; float ss = 0.f;
#pragma unroll
        for (int i = 0; i < 4; ++i) { v[i] = xr[lane + 64 * i]; ss += v[i][0] * v[i][0] + v[i][1] * v[i][1] + v[i][2] * v[i][2] + v[i][3] * v[i][3]; }
        ss = wave_sum(ss);
        const float rs = __builtin_amdgcn_rsqf(ss * (1.f / DM) + NORM_EPS);
#pragma unroll
        for (int i = 0; i < 4; ++i) {
            u32x2 o; o[0] = pk2(v[i][0] * rs * gv[i][0], v[i][1] * rs * gv[i][1]); o[1] = pk2(v[i][2] * rs * gv[i][2], v[i][3] * rs * gv[i][3]);
            *(u32x2*)(h + (size_t)row * DM + 4 * (lane + 64 * i)) = o;
        }
    }
}

struct SchedLin {
    int nM, nN, G, c; unsigned aoff, boff, a2off; int rowbytes, amode, cbase, pn2;
    DI bool next(int i, Unit& u) const { return pg8::order_xcd(nM, nN, G, c, i, u); }
    DI const char* aptr(const Unit& u) const { const int row0 = amode ? ((u.pm >> 1) * SEQ + cbase + (u.pm & 1) * 256) : u.pm * 256; return (const char*)KP()->ws + ((u.pn >= pn2) ? a2off : aoff) + (size_t)row0 * rowbytes; }
    DI const char* bptr(const Unit& u) const { return (const char*)KP()->ws + boff + (size_t)u.pn * 256 * rowbytes; }
};
DI SchedLin mk_sched(int nM, int nN, size_t aoff, size_t boff, int K, int amode = 0, int cbase = 0, size_t a2off = 0, int pn2 = 1 << 30) {
    SchedLin s; s.nM = nM; s.nN = nN; s.G = gridDim.x; s.c = BID(); s.aoff = (unsigned)aoff; s.boff = (unsigned)boff; s.rowbytes = K * 2; s.amode = amode; s.cbase = cbase; s.a2off = (unsigned)a2off; s.pn2 = pn2; return s;
}
struct SchedMerge {
    int G, c;
    DI bool next(int i, Unit& u) const { const int z = i % 3, tile = (i / 3) * G + c; if (tile >= 128) return false; u.pm = tile >> 2; u.pn = tile & 3; u.z = z; return true; }
    DI const char* aptr(const Unit& u) const { return (const char*)KP()->ws + (u.z == 0 ? WS_MQ : (u.z == 1 ? WS_ORW : WS_DQ)) + (size_t)u.pm * 256 * 1024; }
    DI const char* bptr(const Unit& u) const { return (const char*)KP()->ws + WS_WBR + (size_t)u.z * (1024 * 512 * 2) + (size_t)u.pn * 256 * 1024; }
};

DI void st_bf4(bf16_t* p, f32x4 v) { u32x2 o; o[0] = pk2(v[0], v[1]); o[1] = pk2(v[2], v[3]); *(u32x2*)p = o; }
DI f32x4 ld_bf4(const bf16_t* p) { const u32x2 u = *(const u32x2*)p; return (f32x4){bflo(u[0]), bfhi(u[0]), bflo(u[1]), bfhi(u[1])}; }
#define EPI_ROWS(ai, m) (128 * (ai) + 64 * wr + 16 * (m) + fr)
#define EPI_COLS(bj, n) (128 * (bj) + 32 * wc + 16 * (n) + 4 * fq)
#define FOR_AM _Pragma("unroll") for (int ai = 0; ai < 2; ++ai) _Pragma("unroll") for (int m = 0; m < 4; ++m)
#define FOR_BN _Pragma("unroll") for (int bj = 0; bj < 2; ++bj) _Pragma("unroll") for (int n = 0; n < 2; ++n)

DI void epi_headnorm(const AccT& acc, bf16_t* out, int ld, const float* gain, int wr, int wc, int fr, int fq) {
    f32x4 gv[2][2];
    FOR_BN gv[bj][n] = *(const f32x4*)(gain + 32 * bj + 16 * n + 4 * fq);
    FOR_AM {
        float ss = 0.f;
        FOR_BN { const f32x4 a = acc[ai][bj][m][n]; ss += a[0] * a[0] + a[1] * a[1] + a[2] * a[2] + a[3] * a[3]; }
        ss += __shfl_xor(ss, 16); ss += __shfl_xor(ss, 32);
        const float sc = __builtin_amdgcn_rsqf(ss * (1.f / 64.f) + NORM_EPS);
        bf16_t* rp = out + (size_t)EPI_ROWS(ai, m) * ld + 64 * wc + 4 * fq;
        FOR_BN st_bf4(rp + 32 * bj + 16 * n, acc[ai][bj][m][n] * sc * gv[bj][n]);
    }
}
DI void epi_store_bf16(const AccT& acc, bf16_t* out, int ld, int wr, int wc, int fr, int fq) {
    FOR_AM { bf16_t* rp = out + (size_t)EPI_ROWS(ai, m) * ld; FOR_BN st_bf4(rp + EPI_COLS(bj, n), acc[ai][bj][m][n]); }
}

struct EpiB {
    int l;
    DI void operator()(const AccT& acc, const Unit& u, int wr, int wc, int fr, int fq) const {
        const size_t row0 = (size_t)u.pm * 256;
        if (u.pn < 2) epi_headnorm(acc, wsp<bf16_t>(WS_MK) + row0 * 512 + u.pn * 256, 512, KP()->in[I_QKN] + l * 256 + 64, wr, wc, fr, fq);
        else if (u.pn == 2) epi_store_bf16(acc, wsp<bf16_t>(WS_DCN) + row0 * 256, 256, wr, wc, fr, fq);
        else {
            bf16_t* idxk = wsp<bf16_t>(WS_IDXK); float* idxw = wsp<float>(WS_IDXW); bf16_t* left = wsp<bf16_t>(WS_LEFT);
            FOR_AM { const size_t row = row0 + EPI_ROWS(ai, m);
                if (wc == 0) { st_bf4(idxk + row * 32 + 4 * fq, acc[ai][0][m][0]); st_bf4(idxk + row * 32 + 16 + 4 * fq, acc[ai][0][m][1]); }
                else if (wc == 1) { if (fq < 2) *(f32x4*)(idxw + row * 8 + 4 * fq) = acc[ai][0][m][0]; }
                else if (wc == 2) { st_bf4(left + row * 32 + 4 * fq, acc[ai][0][m][0]); st_bf4(left + row * 32 + 16 + 4 * fq, acc[ai][0][m][1]); }
            }
        }
    }
};
struct EpiVt {
    unsigned off;
    DI void operator()(const AccT& acc, const Unit& u, int wr, int wc, int fr, int fq) const {
        bf16_t* vt = wsp<bf16_t>(off);
        const int b = u.pn >> 3, s0 = (u.pn & 7) * 256;
        FOR_AM { bf16_t* rp = vt + ((size_t)b * 512 + u.pm * 256 + EPI_ROWS(ai, m)) * SEQ + s0; FOR_BN st_bf4(rp + EPI_COLS(bj, n), acc[ai][bj][m][n]); }
    }
};
struct EpiHN {
    int l;
    DI void operator()(const AccT& acc, const Unit& u, int wr, int wc, int fr, int fq) const { epi_headnorm(acc, wsp<bf16_t>(WS_DK) + (size_t)u.pm * 256 * 512 + u.pn * 256, 512, KP()->in[I_QKN] + l * 256 + 192, wr, wc, fr, fq); }
};
struct EpiD1 {
    int l;
    DI void operator()(const AccT& acc, const Unit& u, int wr, int wc, int fr, int fq) const {
        const size_t row0 = (size_t)u.pm * 256;
        if (u.pn < 2) epi_headnorm(acc, wsp<bf16_t>(WS_MQ) + row0 * 512 + u.pn * 256, 512, KP()->in[I_QKN] + l * 256, wr, wc, fr, fq);
        else if (u.pn < 4) epi_headnorm(acc, wsp<bf16_t>(WS_DQ) + row0 * 512 + (u.pn - 2) * 256, 512, KP()->in[I_QKN] + l * 256 + 128, wr, wc, fr, fq);
        else if (u.pn == 4) epi_store_bf16(acc, wsp<bf16_t>(WS_IDXQ) + row0 * 256, 256, wr, wc, fr, fq);
        else if (u.pn < 12) epi_store_bf16(acc, wsp<bf16_t>(WS_RAW) + row0 * RAWLD + (u.pn - 5) * 256, RAWLD, wr, wc, fr, fq);
        else {
            bf16_t* o = wsp<bf16_t>(WS_GATES) + row0 * 3072 + (u.pn - 12) * 256;
            FOR_AM { bf16_t* rp = o + (size_t)EPI_ROWS(ai, m) * 3072;
                FOR_BN { const f32x4 a = acc[ai][bj][m][n]; st_bf4(rp + EPI_COLS(bj, n), (f32x4){fsigmoid(a[0]), fsigmoid(a[1]), fsigmoid(a[2]), fsigmoid(a[3])}); } }
        }
    }
};
struct EpiLora {
    int l, cbase;
    DI void operator()(const AccT& acc, const Unit& u, int wr, int wc, int fr, int fq) const {
        const size_t row0 = (size_t)u.pm * 256; const int kind = u.pn >> 1, cb = (u.pn & 1) * 256;
        if (kind == 0) {
            float* dec = wsp<float>(WS_DEC); const float* w0 = KP()->in[I_W0] + l * 512;
            FOR_AM { const size_t row = row0 + EPI_ROWS(ai, m);
                FOR_BN { const int col = cb + EPI_COLS(bj, n); const f32x4 a = acc[ai][bj][m][n]; const f32x4 wv = *(const f32x4*)(w0 + col); f32x4 d;
#pragma unroll
                    for (int e = 0; e < 4; ++e) { const float x = -(wv[e] + a[e]);
                        const float sp = fmaxf(x, 0.f) + __builtin_amdgcn_logf(1.f + fexp2(-fabsf(x) * LOG2E)) * 0.6931471805599453f;
                        const float w = -sp - 0.5f; d[e] = fexp2(-fexp2(w * LOG2E) * LOG2E); }
                    *(f32x4*)(dec + row * 512 + col) = d; } }
        } else if (kind == 1) {
            bf16_t* kf = wsp<bf16_t>(WS_KF); const bf16_t* kkb = wsp<bf16_t>(WS_KKB); bf16_t* bbb = wsp<bf16_t>(WS_BBB);
            const float* a0 = KP()->in[I_A0] + l * 512; const float* ka = KP()->in[I_KA] + l * 512;
            FOR_AM { const size_t row = row0 + EPI_ROWS(ai, m);
                f32x4 kp[2][2], kk[2][2];
                FOR_BN { const int col = cb + EPI_COLS(bj, n); kp[bj][n] = ld_bf4(kf + row * 512 + col); kk[bj][n] = ld_bf4(kkb + row * 512 + col); }
                FOR_BN { const int col = cb + EPI_COLS(bj, n); const f32x4 a = acc[ai][bj][m][n];
                    const f32x4 av = *(const f32x4*)(a0 + col), kav = *(const f32x4*)(ka + col); f32x4 ko, bo;
#pragma unroll
                    for (int e = 0; e < 4; ++e) { const float s = fsigmoid(av[e] + a[e]); ko[e] = kp[bj][n][e] * (1.f + (s - 1.f) * kav[e]); bo[e] = kk[bj][n][e] * s; }
                    st_bf4(kf + row * 512 + col, ko); st_bf4(bbb + row * 512 + col, bo); } }
        } else if (kind == 2) {
            epi_store_bf16(acc, wsp<bf16_t>(WS_GG) + row0 * 512 + cb, 512, wr, wc, fr, fq);
        } else {
            const bf16_t* vv = wsp<bf16_t>(WS_VV); bf16_t* v2 = wsp<bf16_t>(WS_V2); const bf16_t* vfirst = wsp<bf16_t>(WS_VFIRST); const float* v0 = KP()->in[I_V0];
            FOR_AM { const size_t row = row0 + EPI_ROWS(ai, m); const size_t arow = (size_t)(row >> 9) * SEQ + cbase + (row & 511);
                f32x4 vp[2][2], vf[2][2];
                FOR_BN { const int col = cb + EPI_COLS(bj, n); vp[bj][n] = ld_bf4(vv + row * 512 + col); vf[bj][n] = ld_bf4(vfirst + arow * 512 + col); }
                FOR_BN { const int col = cb + EPI_COLS(bj, n); const f32x4 a = acc[ai][bj][m][n]; const f32x4 v0v = *(const f32x4*)(v0 + col); f32x4 o;
#pragma unroll
                    for (int e = 0; e < 4; ++e) o[e] = vp[bj][n][e] + (vf[bj][n][e] - vp[bj][n][e]) * fsigmoid(v0v[e] + a[e]);
                    st_bf4(v2 + row * 512 + col, o); } }
        }
    }
};
struct EpiMerge {
    DI void operator()(const AccT& acc, const Unit& u, int wr, int wc, int fr, int fq) const {
        float* y32 = wsp<float>(WS_Y32); bf16_t* y = wsp<bf16_t>(WS_Y); const bf16_t* gates = wsp<bf16_t>(WS_GATES);
        const size_t row0 = (size_t)u.pm * 256; const int c0 = u.pn * 256, z = u.z;
#pragma unroll
        for (int ai = 0; ai < 2; ++ai)
#pragma unroll
            for (int mp = 0; mp < 2; ++mp) {
                u32x2 g[2][2][2]; f32x4 yv[2][2][2];
#pragma unroll
                for (int mm = 0; mm < 2; ++mm) { const int m = 2 * mp + mm; const size_t row = row0 + EPI_ROWS(ai, m);
                    FOR_BN { const int col = c0 + EPI_COLS(bj, n); g[mm][bj][n] = *(const u32x2*)(gates + row * 3072 + z * 1024 + col);
                        yv[mm][bj][n] = (z > 0) ? *(const f32x4*)(y32 + row * 1024 + col) : (f32x4){0.f, 0.f, 0.f, 0.f}; } }
#pragma unroll
                for (int mm = 0; mm < 2; ++mm) { const int m = 2 * mp + mm; const size_t row = row0 + EPI_ROWS(ai, m);
                    FOR_BN { const int col = c0 + EPI_COLS(bj, n); const u32x2 gu = g[mm][bj][n];
                        const f32x4 v = acc[ai][bj][m][n] * (f32x4){bflo(gu[0]), bfhi(gu[0]), bflo(gu[1]), bfhi(gu[1])} + yv[mm][bj][n];
                        if (z < 2) *(f32x4*)(y32 + row * 1024 + col) = v; else st_bf4(y + row * 1024 + col, v); } }
            }
    }
};
struct EpiRes {
    int first, amode, cbase; unsigned dummy_off;
    DI void operator()(const AccT& acc, const Unit& u, int wr, int wc, int fr, int fq) const {
        float* out = KP()->out; const float* res = first ? KP()->in[I_X] : (const float*)out;
        if (dummy_off) out = wsp<float>(dummy_off);
        const size_t grow0 = amode ? ((size_t)(u.pm >> 1) * SEQ + cbase + (u.pm & 1) * 256) : (size_t)u.pm * 256; const int c0 = u.pn * 256;
#pragma unroll
        for (int ai = 0; ai < 2; ++ai)
#pragma unroll
            for (int mp = 0; mp < 2; ++mp) {
                f32x4 rv[2][2][2];
#pragma unroll
                for (int mm = 0; mm < 2; ++mm) { const size_t row = grow0 + EPI_ROWS(ai, 2 * mp + mm); FOR_BN rv[mm][bj][n] = *(const f32x4*)(res + row * DM + c0 + EPI_COLS(bj, n)); }
#pragma unroll
                for (int mm = 0; mm < 2; ++mm) { const int m = 2 * mp + mm; const size_t row = grow0 + EPI_ROWS(ai, m); FOR_BN *(f32x4*)(out + row * DM + c0 + EPI_COLS(bj, n)) = rv[mm][bj][n] + acc[ai][bj][m][n]; }
            }
    }
};
struct EpiSwiglu {
    DI void operator()(const AccT& acc, const Unit& u, int wr, int wc, int fr, int fq) const {
        bf16_t* act = wsp<bf16_t>(WS_ACT);
        FOR_AM { bf16_t* rp = act + ((size_t)u.pm * 256 + EPI_ROWS(ai, m)) * DFF + u.pn * 128 + 32 * wc + 4 * fq;
#pragma unroll
            for (int n = 0; n < 2; ++n) { const f32x4 g = acc[ai][0][m][n], up = acc[ai][1][m][n]; f32x4 o;
#pragma unroll
                for (int e = 0; e < 4; ++e) o[e] = g[e] * fsigmoid(g[e]) * up[e];
                st_bf4(rp + 16 * n, o); } }
    }
};

DI void phase_dcn(int l) {
    const int lane = TID() & 63, gw = BID() * 8 + (TID() >> 6), nw = gridDim.x * 8;
    bf16_t* dcn = wsp<bf16_t>(WS_DCN);
    const f32x4 g = *(const f32x4*)(KP()->in[I_KVN] + l * 256 + 4 * lane);
    for (int row = gw; row < NT; row += nw) {
        bf16_t* rp = dcn + (size_t)row * 256 + 4 * lane;
        const f32x4 v = ld_bf4(rp);
        const float ss = wave_sum(v[0] * v[0] + v[1] * v[1] + v[2] * v[2] + v[3] * v[3]);
        const float rs = __builtin_amdgcn_rsqf(ss * (1.f / 256.f) + NORM_EPS);
        st_bf4(rp, v * rs * g);
    }
}
DI void phase_kmean() {
    const int lane = TID() & 63, gw = BID() * 8 + (TID() >> 6), nw = gridDim.x * 8;
    const bf16_t* mk = wsp<bf16_t>(WS_MK); float* km = wsp<float>(WS_KMEAN);
    for (int it = gw; it < NB * NH * 8; it += nw) {
        const int n = it & 7, h = (it >> 3) & 7, b = it >> 6;
        const bf16_t* kp = mk + ((size_t)b * SEQ + n * 256) * 512 + h * 64 + lane;
        float s0 = 0.f, s1 = 0.f, s2 = 0.f, s3 = 0.f;
        for (int k = 0; k < 256; k += 32) {
            bf16_t v[32];
#pragma unroll
            for (int j = 0; j < 32; ++j) v[j] = kp[(size_t)(k + j) * 512];
#pragma unroll
            for (int j = 0; j < 32; j += 4) { s0 += bf2f(v[j]); s1 += bf2f(v[j + 1]); s2 += bf2f(v[j + 2]); s3 += bf2f(v[j + 3]); }
        }
        km[(size_t)it * 64 + lane] = ((s0 + s1) + (s2 + s3)) * (1.f / 256.f);
    }
}

DI void phase_rwkv_prep(int l, int c) {
    const int lane = TID() & 63, gw = BID() * 8 + (TID() >> 6), nw = gridDim.x * 8;
    const bf16_t* raw = wsp<bf16_t>(WS_RAW); const bf16_t* left = wsp<bf16_t>(WS_LEFT); bf16_t* carry = wsp<bf16_t>(WS_CARRY);
    bf16_t* rr = wsp<bf16_t>(WS_RR); bf16_t* kf = wsp<bf16_t>(WS_KF); bf16_t* vv = wsp<bf16_t>(WS_VV); bf16_t* kkb = wsp<bf16_t>(WS_KKB);
    bf16_t* la = wsp<bf16_t>(WS_LORAA); bf16_t* vfirst = wsp<bf16_t>(WS_VFIRST);
    const float* mu = KP()->in[I_MU] + l * 1824; const float* kkw = KP()->in[I_KK] + l * 512;
    for (int rc = gw; rc < TC; rc += nw) {
        const int b = rc >> 9, sl = rc & 511, s = c * SC + sl; const size_t ra = (size_t)b * SEQ + s;
        const bf16_t* cur = raw + (size_t)rc * RAWLD;
        const bf16_t* prv = (sl > 0) ? (cur - RAWLD) : (carry + (size_t)((((c + 1) & 1) * 16) + b) * RAWLD);
        const bool hp = s > 0;
        auto mix8 = [&](int j, float* o) {
            const u32x4 cu = *(const u32x4*)(cur + j); u32x4 pu = {0u, 0u, 0u, 0u}; if (hp) pu = *(const u32x4*)(prv + j);
            const f32x4 m0 = *(const f32x4*)(mu + j), m1 = *(const f32x4*)(mu + j + 4);
#pragma unroll
            for (int e = 0; e < 4; ++e) { const float c0 = bflo(cu[e]), c1 = bfhi(cu[e]), p0 = bflo(pu[e]), p1 = bfhi(pu[e]);
                const float ma = (2 * e < 4) ? m0[2 * e] : m1[2 * e - 4], mb = (2 * e + 1 < 4) ? m0[2 * e + 1] : m1[2 * e + 1 - 4];
                o[2 * e] = c0 + (p0 - c0) * ma; o[2 * e + 1] = c1 + (p1 - c1) * mb; }
        };
        auto mix1 = [&](int j) -> float { const float c0 = bf2f(cur[j]); const float p0 = hp ? bf2f(prv[j]) : 0.f; return c0 + (p0 - c0) * mu[j]; };
        float o[8];
        mix8(8 * lane, o);
        { u32x4 w; w[0] = pk2(o[0], o[1]); w[1] = pk2(o[2], o[3]); w[2] = pk2(o[4], o[5]); w[3] = pk2(o[6], o[7]); *(u32x4*)(rr + (size_t)rc * 512 + 8 * lane) = w; }
        mix8(576 + 8 * lane, o);
        { u32x4 w; w[0] = pk2(o[0], o[1]); w[1] = pk2(o[2], o[3]); w[2] = pk2(o[4], o[5]); w[3] = pk2(o[6], o[7]); *(u32x4*)(kf + (size_t)rc * 512 + 8 * lane) = w;
          const f32x4 k0 = *(const f32x4*)(kkw + 8 * lane), k1 = *(const f32x4*)(kkw + 8 * lane + 4);
          float q[8]; float ss = 0.f;
#pragma unroll
          for (int e = 0; e < 8; ++e) { q[e] = o[e] * (e < 4 ? k0[e] : k1[e - 4]); ss += q[e] * q[e]; }
          ss += __shfl_xor(ss, 1); ss += __shfl_xor(ss, 2); ss += __shfl_xor(ss, 4);
          const float inv = 1.f / fmaxf(sqrtf(ss), 1e-12f);
          w[0] = pk2(q[0] * inv, q[1] * inv); w[1] = pk2(q[2] * inv, q[3] * inv); w[2] = pk2(q[4] * inv, q[5] * inv); w[3] = pk2(q[6] * inv, q[7] * inv);
          *(u32x4*)(kkb + (size_t)rc * 512 + 8 * lane) = w; }
        mix8(1088 + 8 * lane, o);
        { u32x4 w; w[0] = pk2(o[0], o[1]); w[1] = pk2(o[2], o[3]); w[2] = pk2(o[4], o[5]); w[3] = pk2(o[6], o[7]); *(u32x4*)(vv + (size_t)rc * 512 + 8 * lane) = w;
          if (l == 0) *(u32x4*)(vfirst + ra * 512 + 8 * lane) = w; }
        bf16_t* lr = la + (size_t)rc * 512;
        { const float x = mix1(512 + lane); const float t = fexp2(2.f * x * LOG2E); lr[lane] = f2bf(1.f - 2.f * frcp(t + 1.f)); }
        lr[64 + lane] = f2bf(mix1(1600 + lane));
        lr[128 + lane] = f2bf(fsigmoid(mix1(1664 + lane)));
        lr[192 + lane] = f2bf(fsigmoid(mix1(1728 + lane)));
        if (lane < 32) { const float c0 = bf2f(left[ra * 32 + lane]); const float p0 = hp ? bf2f(left[(ra - 1) * 32 + lane]) : 0.f;
            lr[256 + lane] = f2bf(fsigmoid(c0 + (p0 - c0) * mu[1792 + lane])); }
        if (lane < 56) *(u32x2*)(lr + 288 + 4 * lane) = (u32x2){0u, 0u};
        if (sl == SC - 1) { bf16_t* cp = carry + (size_t)(((c & 1) * 16) + b) * RAWLD;
            for (int j = lane; j < RAWLD / 8; j += 64) *(u32x4*)(cp + 8 * j) = *(const u32x4*)(cur + 8 * j); }
    }
}

DI float dpp_ror_add(float x, int) { return x; }
DI void reduce4(float p0, float p1, float p2, float p3, float& s0, float& s1, float& s2, float& s3) {
    auto r = __builtin_amdgcn_permlane32_swap(__float_as_uint(p0), __float_as_uint(p2), false, false);
    const float u0 = __uint_as_float(r[0]) + __uint_as_float(r[1]);
    r = __builtin_amdgcn_permlane32_swap(__float_as_uint(p1), __float_as_uint(p3), false, false);
    const float u1 = __uint_as_float(r[0]) + __uint_as_float(r[1]);
    r = __builtin_amdgcn_permlane16_swap(__float_as_uint(u0), __float_as_uint(u1), false, false);
    float w = __uint_as_float(r[0]) + __uint_as_float(r[1]);
    w += __uint_as_float(__builtin_amdgcn_update_dpp(0, __float_as_uint(w), 0x128, 0xf, 0xf, false));
    w += __uint_as_float(__builtin_amdgcn_update_dpp(0, __float_as_uint(w), 0x124, 0xf, 0xf, false));
    w += __uint_as_float(__builtin_amdgcn_update_dpp(0, __float_as_uint(w), 0x122, 0xf, 0xf, false));
    w += __uint_as_float(__builtin_amdgcn_update_dpp(0, __float_as_uint(w), 0x121, 0xf, 0xf, false));
    s0 = __uint_as_float(__builtin_amdgcn_readlane(__float_as_uint(w), 0));
    s1 = __uint_as_float(__builtin_amdgcn_readlane(__float_as_uint(w), 16));
    s2 = __uint_as_float(__builtin_amdgcn_readlane(__float_as_uint(w), 32));
    s3 = __uint_as_float(__builtin_amdgcn_readlane(__float_as_uint(w), 48));
}
DI void reduce8(float p0, float p1, float p2, float p3, float q0, float q1, float q2, float q3, float& pw, float& s0, float& s1, float& s2, float& s3) {
    auto r = __builtin_amdgcn_permlane32_swap(__float_as_uint(p0), __float_as_uint(p2), false, false);
    auto t = __builtin_amdgcn_permlane32_swap(__float_as_uint(q0), __float_as_uint(q2), false, false);
    const float u0 = __uint_as_float(r[0]) + __uint_as_float(r[1]);
    const float x0 = __uint_as_float(t[0]) + __uint_as_float(t[1]);
    r = __builtin_amdgcn_permlane32_swap(__float_as_uint(p1), __float_as_uint(p3), false, false);
    t = __builtin_amdgcn_permlane32_swap(__float_as_uint(q1), __float_as_uint(q3), false, false);
    const float u1 = __uint_as_float(r[0]) + __uint_as_float(r[1]);
    const float x1 = __uint_as_float(t[0]) + __uint_as_float(t[1]);
    r = __builtin_amdgcn_permlane16_swap(__float_as_uint(u0), __float_as_uint(u1), false, false);
    t = __builtin_amdgcn_permlane16_swap(__float_as_uint(x0), __float_as_uint(x1), false, false);
    float w = __uint_as_float(r[0]) + __uint_as_float(r[1]);
    float y = __uint_as_float(t[0]) + __uint_as_float(t[1]);
    w += __uint_as_float(__builtin_amdgcn_update_dpp(0, __float_as_uint(w), 0x128, 0xf, 0xf, false));
    y += __uint_as_float(__builtin_amdgcn_update_dpp(0, __float_as_uint(y), 0x128, 0xf, 0xf, false));
    w += __uint_as_float(__builtin_amdgcn_update_dpp(0, __float_as_uint(w), 0x124, 0xf, 0xf, false));
    y += __uint_as_float(__builtin_amdgcn_update_dpp(0, __float_as_uint(y), 0x124, 0xf, 0xf, false));
    w += __uint_as_float(__builtin_amdgcn_update_dpp(0, __float_as_uint(w), 0x122, 0xf, 0xf, false));
    y += __uint_as_float(__builtin_amdgcn_update_dpp(0, __float_as_uint(y), 0x122, 0xf, 0xf, false));
    w += __uint_as_float(__builtin_amdgcn_update_dpp(0, __float_as_uint(w), 0x121, 0xf, 0xf, false));
    y += __uint_as_float(__builtin_amdgcn_update_dpp(0, __float_as_uint(y), 0x121, 0xf, 0xf, false));
    pw = w;
    s0 = __uint_as_float(__builtin_amdgcn_readlane(__float_as_uint(y), 0));
    s1 = __uint_as_float(__builtin_amdgcn_readlane(__float_as_uint(y), 16));
    s2 = __uint_as_float(__builtin_amdgcn_readlane(__float_as_uint(y), 32));
    s3 = __uint_as_float(__builtin_amdgcn_readlane(__float_as_uint(y), 48));
}
struct ScanIn { bf16_t kk, bb, k, r, v; float w; };
DI void phase_scan(int l, int c, int dummy = 0) {
    const int lane = TID() & 63, gw = BID() * 8 + (TID() >> 6), nw = gridDim.x * 8;
    const bf16_t* kkb = wsp<bf16_t>(WS_KKB); const bf16_t* bbb = wsp<bf16_t>(WS_BBB); const bf16_t* kfb = wsp<bf16_t>(WS_KF); const bf16_t* rrb = wsp<bf16_t>(WS_RR);
    const bf16_t* vsb = wsp<bf16_t>(l == 0 ? WS_VV : WS_V2); const float* dec = wsp<float>(WS_DEC); float* outb = wsp<float>(WS_OUT); float* state = wsp<float>(WS_STATE);
    for (int item = gw; item < NB * NH * 16; item += nw) {
        const int bh = item >> 4, rg = item & 15, b = bh >> 3, h = bh & 7, i0 = rg * 4;
        float* stp = state + ((size_t)bh * 64 + i0) * 64 + lane;
        float S0 = 0.f, S1 = 0.f, S2 = 0.f, S3 = 0.f;
        if (c > 0) { S0 = stp[0]; S1 = stp[64]; S2 = stp[128]; S3 = stp[192]; }
        const size_t e0 = (size_t)b * SC * 512 + h * 64 + lane;
        const size_t ev = (size_t)b * SC * 512 + h * 64 + i0 + (lane & 3);
        float* op = outb + (size_t)b * SC * 512 + h * 64 + i0 + (lane >> 4);
        ScanIn A[8], B[8];
#define SCAN_LOAD(X, g) do { _Pragma("unroll") for (int j = 0; j < 8; ++j) { const size_t o = (size_t)((g) * 8 + j) * 512; \
            X[j].kk = kkb[e0 + o]; X[j].bb = bbb[e0 + o]; X[j].k = kfb[e0 + o]; X[j].r = rrb[e0 + o]; X[j].w = dec[e0 + o]; X[j].v = vsb[ev + o]; } } while (0)
#define SCAN_STEP1(Xj, kknext, t) do { \
            const float bb = bf2f(Xj.bb), kx = bf2f(Xj.k), rx = bf2f(Xj.r), wx = Xj.w; const unsigned vu = (unsigned)Xj.v << 16; \
            const float v0 = __uint_as_float(__builtin_amdgcn_readlane(vu, 0)), v1 = __uint_as_float(__builtin_amdgcn_readlane(vu, 1)), v2 = __uint_as_float(__builtin_amdgcn_readlane(vu, 2)), v3 = __uint_as_float(__builtin_amdgcn_readlane(vu, 3)); \
            S0 = S0 * wx + (v0 * kx - a0 * bb); S1 = S1 * wx + (v1 * kx - a1 * bb); S2 = S2 * wx + (v2 * kx - a2 * bb); S3 = S3 * wx + (v3 * kx - a3 * bb); \
            float ov; const float kn = (kknext); \
            reduce8(S0 * rx, S1 * rx, S2 * rx, S3 * rx, S0 * kn, S1 * kn, S2 * kn, S3 * kn, ov, a0, a1, a2, a3); \
            if ((lane & 15) == 0) op[(size_t)(t) * 512] = ov; } while (0)
#define SCAN_GROUP(X, Y, g, lastg) do { _Pragma("unroll") for (int j = 0; j < 8; ++j) { \
            const float kkn = (j < 7) ? bf2f(X[j < 7 ? j + 1 : 7].kk) : ((lastg) ? 0.f : bf2f(Y[0].kk)); \
            SCAN_STEP1(X[j], kkn, (g) * 8 + j); } } while (0)
        SCAN_LOAD(A, 0);
        float a0, a1, a2, a3;
        { const float k0 = bf2f(A[0].kk); reduce4(S0 * k0, S1 * k0, S2 * k0, S3 * k0, a0, a1, a2, a3); }
#if DBL_PHASE == 11
        if (dummy == 2) {
            float acc_ = 0.f;
            for (int g = 0; g < SC / 8; g += 2) {
                SCAN_LOAD(B, g + 1);
#pragma unroll
                for (int j = 0; j < 8; ++j) acc_ += bf2f(A[j].kk) + bf2f(A[j].bb) + bf2f(A[j].k) + bf2f(A[j].r) + bf2f(A[j].v) + A[j].w;
                if (g + 2 < SC / 8) SCAN_LOAD(A, g + 2);
#pragma unroll
                for (int j = 0; j < 8; ++j) acc_ += bf2f(B[j].kk) + bf2f(B[j].bb) + bf2f(B[j].k) + bf2f(B[j].r) + bf2f(B[j].v) + B[j].w;
            }
            if (acc_ == 12345.678f) stp[0] = acc_;
            continue;
        }
#endif
#if DBL_PHASE == 12
        if (dummy == 3) {
#pragma unroll
            for (int j = 0; j < 8; ++j) { A[j].kk = (bf16_t)(0x3c00 + lane + j); A[j].bb = (bf16_t)(0x3b00 + lane); A[j].k = (bf16_t)(0x3d00 + j); A[j].r = (bf16_t)(0x3e00 + lane); A[j].v = (bf16_t)(0x3c80 + j); A[j].w = 0.9f; B[j] = A[j]; }
            op = wsp<float>(WS_RAW) + (size_t)item * 4 + (lane >> 4);
            for (int g = 0; g < SC / 8; g += 2) {
                SCAN_GROUP(A, B, 0, false);
                SCAN_GROUP(B, A, 0, false);
            }
            if (S0 + S1 + S2 + S3 == 12345.678f) stp[0] = S0;
            continue;
        }
#endif
        for (int g = 0; g < SC / 8; g += 2) {
            SCAN_LOAD(B, g + 1);
            SCAN_GROUP(A, B, g, false);
            const bool last = (g + 2 >= SC / 8);
            if (!last) SCAN_LOAD(A, g + 2);
            SCAN_GROUP(B, A, g + 1, last);
        }
#undef SCAN_STEP1
#undef SCAN_GROUP
#undef SCAN_LOAD
        if (!dummy) { stp[0] = S0; stp[64] = S1; stp[128] = S2; stp[192] = S3; }
    }
}
DI void phase_rwkv_post(int l) {
    const int lane = TID() & 63, gw = BID() * 8 + (TID() >> 6), nw = gridDim.x * 8;
    const float* outb = wsp<float>(WS_OUT); const bf16_t* rrb = wsp<bf16_t>(WS_RR); const bf16_t* kfb = wsp<bf16_t>(WS_KF);
    const bf16_t* vsb = wsp<bf16_t>(l == 0 ? WS_VV : WS_V2); const bf16_t* ggb = wsp<bf16_t>(WS_GG); bf16_t* orw = wsp<bf16_t>(WS_ORW);
    const float* lnw = KP()->in[I_LNW] + l * 512; const float* lnb = KP()->in[I_LNB] + l * 512; const float* rk = KP()->in[I_RK] + l * 512;
    for (int it = gw; it < TC * NH; it += nw) {
        const int h = it & 7; const size_t e = (size_t)(it >> 3) * 512 + h * 64 + lane;
        const float o = outb[e];
        const float mean = wave_sum(o) * (1.f / 64.f); const float d = o - mean;
        const float var = wave_sum(d * d) * (1.f / 64.f);
        const float bonus = wave_sum(bf2f(rrb[e]) * bf2f(kfb[e]) * rk[h * 64 + lane]);
        float y = d * __builtin_amdgcn_rsqf(var + 64e-5f) * lnw[h * 64 + lane] + lnb[h * 64 + lane];
        y = (y + bonus * bf2f(vsb[e])) * bf2f(ggb[e]);
        orw[e] = f2bf(y);
    }
}

#define MFMA32(a, b, c) __builtin_amdgcn_mfma_f32_32x32x16_bf16((a), (b), (c), 0, 0, 0)
DI unsigned fkey(float v) { v = v + 0.f; const unsigned u = __float_as_uint(v); return (u & 0x80000000u) ? ~u : (u | 0x80000000u); }
DI int half_sum(int x) {
    x += __builtin_amdgcn_update_dpp(0, x, 0x128, 0xf, 0xf, false);
    x += __builtin_amdgcn_update_dpp(0, x, 0x124, 0xf, 0xf, false);
    x += __builtin_amdgcn_update_dpp(0, x, 0x122, 0xf, 0xf, false);
    x += __builtin_amdgcn_update_dpp(0, x, 0x121, 0xf, 0xf, false);
    auto r = __builtin_amdgcn_permlane16_swap((unsigned)x, (unsigned)x, false, false);
    return (int)(r[0] + r[1]);
}
DI void phase_dsa_select(int c) {
    const int lane = TID() & 63, gw = BID() * 8 + (TID() >> 6), nw = gridDim.x * 8;
    for (int item = gw; item < TC / 4; item += nw) {
        int lz = lane; asm volatile("" : "+v"(lz));
        const int hh = lz >> 5, r5 = lz & 31;
        const int rc0 = item * 4, b = rc0 >> 9, t0 = c * SC + (rc0 & 511);
        const int qq = ((r5 >> 2) & 1) + 2 * (r5 >> 4), hd = (r5 & 3) + 4 * ((r5 >> 3) & 1);
        const bf16_t* qp = wsp<bf16_t>(WS_IDXQ) + (size_t)(rc0 + qq) * 256 + hd * 32 + 8 * hh;
        const bf16x8 Af0 = *(const bf16x8*)qp, Af1 = *(const bf16x8*)(qp + 16);
        const float* wp = wsp<float>(WS_IDXW) + ((size_t)b * SEQ + t0 + hh) * 8;
        const f32x4 wa0 = *(const f32x4*)wp, wa1 = *(const f32x4*)(wp + 4), wb0 = *(const f32x4*)(wp + 16), wb1 = *(const f32x4*)(wp + 20);
        const int tA = t0 + hh, tB = t0 + hh + 2;
        const int ngrp = ((t0 + 3) >> 9) + 1;
        unsigned keyA[64], keyB[64];
        const bf16_t* kbase = wsp<bf16_t>(WS_IDXK) + ((size_t)b * SEQ + r5) * 32 + 8 * hh;
        int keyv = r5;
        unsigned kofs = 0u;
        bf16x8 Bn0 = *(const bf16x8*)kbase, Bn1 = *(const bf16x8*)(kbase + 16);
#pragma unroll
        for (int g = 0; g < 4; ++g) {
            if (g < ngrp) {
#pragma unroll
                for (int j = 0; j < 16; ++j) {
                    const int kt = g * 16 + j;
                    const bf16x8 Bf0 = Bn0, Bf1 = Bn1;
                    { const unsigned nofs = (kt < 63) ? kofs + 32 * 32 : kofs; const bf16_t* kp = kbase + nofs; Bn0 = *(const bf16x8*)kp; Bn1 = *(const bf16x8*)(kp + 16); }
                    f32x16 C = {0.f, 0.f, 0.f, 0.f, 0.f, 0.f, 0.f, 0.f, 0.f, 0.f, 0.f, 0.f, 0.f, 0.f, 0.f, 0.f};
                    C = MFMA32(Af0, Bf0, C); C = MFMA32(Af1, Bf1, C);
                    float va = 0.f, vb = 0.f;
#pragma unroll
                    for (int i = 0; i < 4; ++i) { va += fmaxf(C[i], 0.f) * wa0[i]; vb += fmaxf(C[8 + i], 0.f) * wb0[i]; }
#pragma unroll
                    for (int i = 0; i < 4; ++i) { va += fmaxf(C[4 + i], 0.f) * wa1[i]; vb += fmaxf(C[12 + i], 0.f) * wb1[i]; }
                    unsigned ka = (keyv <= tA) ? fkey(va) : 0u, kb = (keyv <= tB) ? fkey(vb) : 0u;
                    asm volatile("" : "+v"(ka), "+v"(kb), "+v"(keyv), "+v"(kofs));
                    keyA[kt] = ka; keyB[kt] = kb;
                    keyv += 32; kofs += 32 * 32;
                }
            } else {
#pragma unroll
                for (int j = 0; j < 16; ++j) { keyA[g * 16 + j] = 0u; keyB[g * 16 + j] = 0u; }
            }
        }
        unsigned KA = 0u, KB = 0u;
        if (t0 + 3 >= 256) {
            for (int bit = 31; bit >= 0; --bit) {
                const unsigned bm = 1u << bit;
                const unsigned cA = KA | bm, cB = KB | bm;
                int nA = 0, nB = 0;
#pragma unroll
                for (int g = 0; g < 4; ++g) {
                    if (g < ngrp) {
#pragma unroll
                        for (int j = 0; j < 16; ++j) { nA += (keyA[g * 16 + j] >= cA) ? 1 : 0; nB += (keyB[g * 16 + j] >= cB) ? 1 : 0; }
                    }
                }
                nA = half_sum(nA); nB = half_sum(nB);
                if (nA >= 256) KA = cA;
                if (nB >= 256) KB = cB;
            }
        }
        int gA = 0, gB = 0;
#pragma unroll
        for (int kt = 0; kt < 64; ++kt) { gA += (keyA[kt] > KA) ? 1 : 0; gB += (keyB[kt] > KB) ? 1 : 0; }
        gA = half_sum(gA); gB = half_sum(gB);
        const int needA = (KA == 0u) ? 0 : 256 - gA, needB = (KB == 0u) ? 0 : 256 - gB;
        asm volatile("" : "+v"(KA), "+v"(KB));
        int runA = 0, runB = 0, lsel = lz;
        unsigned w0 = 0u, w1 = 0u, w2 = 0u, w3 = 0u;
#pragma unroll
        for (int kt = 0; kt < 64; ++kt) {
            const bool eqA = keyA[kt] == KA, eqB = keyB[kt] == KB;
            const unsigned long long ea = __ballot(eqA), eb = __ballot(eqB);
            const int rkA = runA + (hh ? (int)__builtin_amdgcn_mbcnt_hi((unsigned)(ea >> 32), 0u) : (int)__builtin_amdgcn_mbcnt_lo((unsigned)ea, 0u));
            const int rkB = runB + (hh ? (int)__builtin_amdgcn_mbcnt_hi((unsigned)(eb >> 32), 0u) : (int)__builtin_amdgcn_mbcnt_lo((unsigned)eb, 0u));
            const bool sA = (keyA[kt] > KA) || (eqA && rkA < needA), sB = (keyB[kt] > KB) || (eqB && rkB < needB);
            runA += hh ? __builtin_popcount((unsigned)(ea >> 32)) : __builtin_popcount((unsigned)ea);
            runB += hh ? __builtin_popcount((unsigned)(eb >> 32)) : __builtin_popcount((unsigned)eb);
            const unsigned long long sa = __ballot(sA), sb = __ballot(sB);
            if (lsel == 0) { w0 = (unsigned)sa; w1 = (unsigned)(sa >> 32); w2 = (unsigned)sb; w3 = (unsigned)(sb >> 32); }
            lsel -= 1; asm volatile("" : "+v"(lsel));
            __builtin_amdgcn_sched_barrier(0);
        }
        unsigned* sp = wsp<unsigned>(WS_SELB) + (size_t)rc0 * 64 + lz;
        sp[0] = w0; sp[64] = w1; sp[128] = w2; sp[192] = w3;
    }
}

struct AttnSt { f32x16 O0, O1; float m, l; };
constexpr float C2 = 0.125f * LOG2E;
DI void attn_load_kv(bf16x8 (&Kf)[4], bf16x8 (&Vf)[2][2], const bf16_t* kbase, const bf16_t* vtbase, int key0, int lane) {
    const int r5 = lane & 31;
    const int prow = (r5 & 19) | ((r5 & 4) << 1) | ((r5 & 8) >> 1);
    const bf16_t* kp = kbase + (size_t)(key0 + prow) * 512;
#pragma unroll
    for (int s = 0; s < 4; ++s) Kf[s] = *(const bf16x8*)(kp + 16 * s);
#pragma unroll
    for (int n = 0; n < 2; ++n)
#pragma unroll
        for (int s = 0; s < 2; ++s) Vf[n][s] = *(const bf16x8*)(vtbase + (size_t)(32 * n) * SEQ + key0 + 16 * s);
}
template <int MODE, bool FAR>
DI void attn_tile(AttnSt& st, const bf16x8 (&Qf)[4], const bf16x8 (&Kf)[4], const bf16x8 (&Vf)[2][2], int key0, int tq, bool allowed, unsigned word, LAS const float* bt, float ub, int lane) {
    const int hh = lane >> 5;
    f32x16 S = {0.f, 0.f, 0.f, 0.f, 0.f, 0.f, 0.f, 0.f, 0.f, 0.f, 0.f, 0.f, 0.f, 0.f, 0.f, 0.f};
#pragma unroll
    for (int s = 0; s < 4; ++s) S = MFMA32(Kf[s], Qf[s], S);
    const unsigned wsh = word >> (8 * hh);
    float ps = 0.f; float pv[16];
    if (FAR) {
        const float cb = (MODE == 0 && !allowed) ? -INFINITY : (bt[127] - ub);
#pragma unroll
        for (int i = 0; i < 16; ++i) {
            float p = fexp2(S[i] * C2 + cb);
            if (MODE == 1) p = __uint_as_float(__float_as_uint(p) & (unsigned)__builtin_amdgcn_sbfe((int)wsh, 16 * (i >> 3) + (i & 7), 1));
            pv[i] = p; ps += p;
        }
    } else {
#pragma unroll
        for (int i = 0; i < 16; ++i) {
            const int koff = 16 * (i >> 3) + 8 * hh + (i & 7);
            const int dist = tq - (key0 + koff);
            const bool ok = (MODE == 0) ? (allowed && dist >= 0) : (((wsh >> (16 * (i >> 3) + (i & 7))) & 1u) != 0u);
            const float p = fexp2(S[i] * C2 + (bt[min(max(dist, 0), 127)] - ub));
            pv[i] = ok ? p : 0.f; ps += pv[i];
        }
    }
    st.l += ps;
#pragma unroll
    for (int s = 0; s < 2; ++s) {
        u32x4 pw; pw[0] = pk2(pv[8 * s], pv[8 * s + 1]); pw[1] = pk2(pv[8 * s + 2], pv[8 * s + 3]); pw[2] = pk2(pv[8 * s + 4], pv[8 * s + 5]); pw[3] = pk2(pv[8 * s + 6], pv[8 * s + 7]);
        const bf16x8 Pf = __builtin_bit_cast(bf16x8, pw);
        st.O0 = MFMA32(Vf[0][s], Pf, st.O0); st.O1 = MFMA32(Vf[1][s], Pf, st.O1);
    }
}
constexpr int AT_ROW = 144, AT_KV = 64 * AT_ROW, AT_STAGE = 2 * AT_KV;
template <int MODE>
DI void attn_block(int c, int b, int h, int half, LAS unsigned char* stg, LAS unsigned* uni, LAS const float* bt, float kbound, float bmax, bool dummy) {
    const int tid = TID(), lane = tid & 63, wave = tid >> 6, r5 = lane & 31, hh = lane >> 5;
    bf16_t* qbuf = wsp<bf16_t>(MODE == 0 ? WS_MQ : WS_DQ);
    const int tb = c * SC + 256 * half, t0 = tb + 32 * wave, tq = t0 + r5, rowc0 = b * SC + 256 * half + 32 * wave;
    bf16_t* qp = qbuf + (size_t)(rowc0 + r5) * 512 + h * 64;
    bf16x8 Qf[4];
#pragma unroll
    for (int s = 0; s < 4; ++s) Qf[s] = *(const bf16x8*)(qp + 16 * s + 8 * hh);
    AttnSt st; st.m = 0.f; st.l = 0.f;
#pragma unroll
    for (int i = 0; i < 16; ++i) { st.O0[i] = 0.f; st.O1[i] = 0.f; }
    float ub;
    { float q2 = 0.f;
#pragma unroll
      for (int s = 0; s < 4; ++s)
#pragma unroll
          for (int j = 0; j < 8; ++j) { const float v = bf2f((bf16_t)Qf[s][j]); q2 += v * v; }
      q2 += __shfl_xor(q2, 32);
      ub = sqrtf(q2) * kbound * C2 + bmax; }
    const int ktl = (t0 + 31) >> 5;
    const int own = tb >> 8;
    unsigned bm = 0u, anyw = 0xffu;
    if (MODE == 0) {
        if (own > 0) {
            const float* km = wsp<float>(WS_KMEAN) + ((size_t)(b * 8 + h) * 8) * 64 + 8 * hh;
            float g[8];
#pragma unroll
            for (int n = 0; n < 8; ++n) {
                g[n] = -INFINITY;
                if (n < own) {
                    float part = 0.f;
#pragma unroll
                    for (int s = 0; s < 4; ++s) { const f32x4 k0 = *(const f32x4*)(km + n * 64 + 16 * s), k1 = *(const f32x4*)(km + n * 64 + 16 * s + 4);
#pragma unroll
                        for (int j = 0; j < 4; ++j) part += bf2f((bf16_t)Qf[s][j]) * k0[j] + bf2f((bf16_t)Qf[s][4 + j]) * k1[j]; }
                    g[n] = part + __shfl_xor(part, 32);
                }
            }
#pragma unroll
            for (int n = 0; n < 8; ++n) {
                if (n < own) { int rank = 0;
#pragma unroll
                    for (int m2 = 0; m2 < 8; ++m2) if (m2 != n && m2 < own) rank += ((g[m2] > g[n]) || (g[m2] == g[n] && m2 < n)) ? 1 : 0;
                    if (rank < 3) bm |= 1u << n; }
            }
        }
        anyw = 1u << own;
#pragma unroll
        for (int n = 0; n < 8; ++n) if (n < own && __ballot((bm >> n) & 1u) != 0ull) anyw |= 1u << n;
    }
    if (tid == 0) uni[0] = 0u;
    __syncthreads();
    if (lane == 0) __hip_atomic_fetch_or(uni, anyw, __ATOMIC_RELAXED, __HIP_MEMORY_SCOPE_WORKGROUP);
    __syncthreads();
    const unsigned anyb = MODE == 0 ? uni[0] : 0xffu;
    const int lrow = tid >> 3, lpart = tid & 7;
    const bf16_t* kg = wsp<bf16_t>(MODE == 0 ? WS_MK : WS_DK) + ((size_t)b * SEQ + lrow) * 512 + h * 64 + lpart * 8;
    const bf16_t* vg = wsp<bf16_t>(MODE == 0 ? WS_MVT : WS_DVT) + ((size_t)b * 512 + h * 64 + lrow) * SEQ + lpart * 8;
    const int lofs = lrow * AT_ROW + lpart * 16;
    const int prow = (r5 & 19) | ((r5 & 4) << 1) | ((r5 & 8) >> 1);
    const int kofs = prow * AT_ROW + 16 * hh, vofs = r5 * AT_ROW + 16 * hh;
    const unsigned* sp = wsp<unsigned>(WS_SELB) + (size_t)(rowc0 + r5) * 64;
    const int nst = (tb + 256) >> 6;
    int stp = 0;
    if (MODE == 0) { while (!((anyb >> (stp >> 2)) & 1u)) stp += 4; }
    u32x4 kreg = *(const u32x4*)(kg + (size_t)(stp * 64) * 512), vreg = *(const u32x4*)(vg + stp * 64);
    *(LAS u32x4*)(stg + lofs) = kreg; *(LAS u32x4*)(stg + AT_KV + lofs) = vreg;
    u32x2 wcur = {0u, 0u}, wnxt = {0u, 0u};
    if (MODE == 1) wcur = *(const u32x2*)(sp + 2 * stp);
    __syncthreads();
    int cur = 0;
    while (stp < nst) {
        int nx = stp + 1;
        if (MODE == 0) { while (nx < nst && !((anyb >> (nx >> 2)) & 1u)) nx += 4 - (nx & 3); }
        const bool more = nx < nst;
        if (more) { kreg = *(const u32x4*)(kg + (size_t)(nx * 64) * 512); vreg = *(const u32x4*)(vg + nx * 64); if (MODE == 1) wnxt = *(const u32x2*)(sp + 2 * nx); }
        LAS const unsigned char* ks = stg + cur * AT_STAGE; LAS const unsigned char* vs = ks + AT_KV;
#pragma unroll
        for (int u = 0; u < 2; ++u) {
            const int kt = 2 * stp + u, key0 = kt * 32, nb = kt >> 3;
            const bool waveon = (kt <= ktl) && (MODE == 1 || ((anyw >> nb) & 1u));
            if (waveon) {
                bf16x8 Kf[4], Vf[2][2];
#pragma unroll
                for (int s = 0; s < 4; ++s) Kf[s] = *(LAS const bf16x8*)(ks + 32 * u * AT_ROW + kofs + 32 * s);
#pragma unroll
                for (int n = 0; n < 2; ++n)
#pragma unroll
                    for (int s = 0; s < 2; ++s) Vf[n][s] = *(LAS const bf16x8*)(vs + 32 * n * AT_ROW + vofs + 64 * u + 32 * s);
                const unsigned word = (MODE == 1) ? wcur[u] : 0u;
                const bool allowed = (MODE == 0) ? ((nb == own) || (((bm >> nb) & 1u) != 0u)) : true;
                if (t0 - (key0 + 31) >= 113) attn_tile<MODE, true>(st, Qf, Kf, Vf, key0, tq, allowed, word, bt, ub, lane);
                else attn_tile<MODE, false>(st, Qf, Kf, Vf, key0, tq, allowed, word, bt, ub, lane);
            }
        }
        if (more) { LAS unsigned char* ws_ = stg + (cur ^ 1) * AT_STAGE; *(LAS u32x4*)(ws_ + lofs) = kreg; *(LAS u32x4*)(ws_ + AT_KV + lofs) = vreg; }
        __syncthreads();
        cur ^= 1; stp = nx; wcur = wnxt;
    }
    const float lt = st.l + __shfl_xor(st.l, 32);
    const float inv = 1.f / lt;
    if (dummy) qp = wsp<bf16_t>(WS_RAW + (MODE ? 8 * MiB : 0)) + (size_t)(rowc0 + r5) * 512 + h * 64;
#pragma unroll
    for (int g4 = 0; g4 < 4; ++g4) {
        st_bf4(qp + 8 * g4 + 4 * hh, (f32x4){st.O0[4 * g4] * inv, st.O0[4 * g4 + 1] * inv, st.O0[4 * g4 + 2] * inv, st.O0[4 * g4 + 3] * inv});
        st_bf4(qp + 32 + 8 * g4 + 4 * hh, (f32x4){st.O1[4 * g4] * inv, st.O1[4 * g4 + 1] * inv, st.O1[4 * g4 + 2] * inv, st.O1[4 * g4 + 3] * inv});
    }
    __syncthreads();
}
__device__ const unsigned char kBucket[128] = {0,1,2,3,4,5,6,7,8,9,10,11,12,13,14,15,16,16,16,17,17,18,18,18,19,19,19,20,20,20,20,21,21,21,21,22,22,22,22,22,23,23,23,23,23,23,24,24,24,24,24,24,25,25,25,25,25,25,25,26,26,26,26,26,26,26,26,27,27,27,27,27,27,27,27,27,27,28,28,28,28,28,28,28,28,28,28,29,29,29,29,29,29,29,29,29,29,29,29,30,30,30,30,30,30,30,30,30,30,30,30,30,30,31,31,31,31,31,31,31,31,31,31,31,31,31,31,31};
DI void phase_attn(int l, int c, LAS float* lds, bool dummy = false) {
    const int tid = TID();
    for (int e = tid; e < 2 * 8 * 128; e += 512) { const int d = e & 127, h = (e >> 7) & 7, mx = e >> 10; lds[e] = KP()->in[I_REL][kBucket[d] * 16 + mx * 8 + h] * LOG2E; }
    if (tid < 2) { const float* g = KP()->in[I_QKN] + l * 256 + (tid == 0 ? 64 : 192); float m = 0.f; for (int i = 0; i < 64; ++i) m = fmaxf(m, fabsf(g[i])); lds[2048 + tid] = 8.1f * m; }
    if (tid >= 64 && tid < 80) { const int mx = (tid - 64) >> 3, h = (tid - 64) & 7; float m = 0.f; for (int k = 0; k < 32; ++k) m = fmaxf(m, fabsf(KP()->in[I_REL][k * 16 + mx * 8 + h])); lds[2064 + (tid - 64)] = m * LOG2E; }
    __syncthreads();
    LAS unsigned char* stg = (LAS unsigned char*)lds + 16384; LAS unsigned* uni = (LAS unsigned*)((LAS unsigned char*)lds + 8192 + 256);
    for (int it = BID(); it < NB * NH * 2; it += gridDim.x) {
        const int bh = it >> 1, b = bh >> 3, h = bh & 7, hf = it & 1;
        attn_block<0>(c, b, h, hf, stg, uni, lds + h * 128, lds[2048], lds[2064 + h], dummy);
        attn_block<1>(c, b, h, hf ^ 1, stg, uni, lds + 1024 + h * 128, lds[2049], lds[2072 + h], dummy);
    }
    if (!dummy) phase_rwkv_post(l);
}

constexpr int LDS_BYTES = pg8::STAGE_BYTES + 256;
constexpr int PH_PER_LAYER = 36, N_PHASES = 2 * PH_PER_LAYER;
#ifndef DBL_PHASE
#define DBL_PHASE 0
#endif
#ifndef MK_ONE_LAUNCH
#define MK_ONE_LAUNCH 1
#endif
__global__ void __launch_bounds__(512, 2) mega(Params p) {
    extern __shared__ __attribute__((aligned(16))) unsigned char lds_raw[];
    LAS unsigned char* lds = (LAS unsigned char*)lds_raw;
    volatile LAS unsigned* bst = (volatile LAS unsigned*)(lds + pg8::STAGE_BYTES);
    if (TID() < 4) bst[TID()] = 0u;
    __syncthreads();
    if (p.ph_hi - p.ph_lo > 1) (void)xcd_barrier_post((unsigned*)(KP()->ws + WS_CTL), bst);
#ifndef PH_ONLY
#define PH_ONLY -1
#endif
#define IN(k) (KP()->ph_lo <= (k) && (k) < KP()->ph_hi)
#define INT(tag, k) ((PH_ONLY < 0 || PH_ONLY == (tag)) && IN(k))
#define SEAM(k) do { if (IN(k) && IN((k) + 1)) { XcdBarrier bar_; bar_.bar = (unsigned*)(KP()->ws + WS_CTL); bar_.x = xb_xcc_id(); bar_.st = (volatile LAS unsigned*)(lds + pg8::STAGE_BYTES); xcd_barrier(bar_); if (DBL_PHASE == 20) xcd_barrier(bar_); } } while (0)
    for (int l = 0; l < 2; ++l) {
        const int pb = PH_PER_LAYER * l;
        if (INT(0, pb + 0)) {
#if DBL_PHASE == 6
            phase_conv(l, (LAS float*)lds);
#endif
            phase_conv(l, (LAS float*)lds); }
        SEAM(pb + 0);
        if (INT(1, pb + 1)) {
#if DBL_PHASE == 7
            phase_norm(l == 0 ? KP()->in[I_X] : (const float*)KP()->out, KP()->in[I_NMIX] + l * DM, wsp<bf16_t>(WS_H));
#endif
            phase_norm(l == 0 ? KP()->in[I_X] : (const float*)KP()->out, KP()->in[I_NMIX] + l * DM, wsp<bf16_t>(WS_H)); }
        SEAM(pb + 1);
        if (INT(2, pb + 2)) {
            { const SchedLin S = mk_sched(128, 4, WS_H, WS_WB, 1024); const EpiB E{l}; pg8::gemm_phase(lds, 1024, S, E); }
            { const SchedLin S = mk_sched(2, 128, WS_WV, WS_H, 1024); const EpiVt E{(unsigned)WS_MVT}; pg8::gemm_phase(lds, 1024, S, E); }
#if DBL_PHASE == 9
            { const SchedLin S = mk_sched(128, 4, WS_H, WS_WB, 1024); const EpiB E{l}; pg8::gemm_phase(lds, 1024, S, E); }
            { const SchedLin S = mk_sched(2, 128, WS_WV, WS_H, 1024); const EpiVt E{(unsigned)WS_MVT}; pg8::gemm_phase(lds, 1024, S, E); }
#endif
        }
        SEAM(pb + 2);
        if (INT(3, pb + 3)) { phase_dcn(l); phase_kmean();
#if DBL_PHASE == 14
            phase_kmean();
#endif
        }
        SEAM(pb + 3);
        if (INT(4, pb + 4)) {
            { const SchedLin S = mk_sched(128, 2, WS_DCN, WS_WKVK, 256); const EpiHN E{l}; pg8::gemm_phase(lds, 256, S, E); }
            { const SchedLin S = mk_sched(2, 128, WS_WKVV, WS_DCN, 256); const EpiVt E{(unsigned)WS_DVT}; pg8::gemm_phase(lds, 256, S, E); }
        }
        SEAM(pb + 4);
        for (int c = 0; c < NCH; ++c) {
            const int pc = pb + 5 + 7 * c, cbase = c * SC;
            if (INT(5, pc + 0)) { const SchedLin S = mk_sched(32, 24, WS_H, WS_WD1, 1024, 1, cbase); const EpiD1 E{l}; pg8::gemm_phase(lds, 1024, S, E);
#if DBL_PHASE == 5
                pg8::gemm_phase(lds, 1024, S, E);
#endif
            }
            SEAM(pc + 0);
            if (INT(6, pc + 1)) {
#if DBL_PHASE == 4
                phase_rwkv_prep(l, c);
#endif
#if DBL_PHASE == 3
                phase_dsa_select(c);
#endif
                phase_rwkv_prep(l, c); phase_dsa_select(c); }
            SEAM(pc + 1);
            if (INT(7, pc + 2)) { const SchedLin S = mk_sched(32, l == 0 ? 6 : 8, WS_LORAA, WS_WL, 512, 0, 0, WS_VV, 6); const EpiLora E{l, cbase}; pg8::gemm_phase(lds, 512, S, E); }
            SEAM(pc + 2);
            if (INT(8, pc + 3)) {
#if DBL_PHASE == 2
                phase_scan(l, c, 1);
#endif
#if DBL_PHASE == 11
                phase_scan(l, c, 2);
#endif
#if DBL_PHASE == 12
                phase_scan(l, c, 3);
#endif
                phase_scan(l, c); }
            SEAM(pc + 3);
            if (INT(9, pc + 4)) {
#if DBL_PHASE == 1
                phase_attn(l, c, (LAS float*)lds, true); __syncthreads();
#endif
                phase_attn(l, c, (LAS float*)lds); }
            SEAM(pc + 4);
            if (INT(10, pc + 5)) { const SchedMerge S{(int)gridDim.x, (int)BID()}; const EpiMerge E{}; pg8::gemm_phase(lds, 512, S, E);
#if DBL_PHASE == 10
                pg8::gemm_phase(lds, 512, S, E);
#endif
            }
            SEAM(pc + 5);
            if (INT(11, pc + 6)) { const SchedLin S = mk_sched(32, 4, WS_Y, WS_WO, 1024); const EpiRes E{l == 0 ? 1 : 0, 1, cbase, 0u};
#if DBL_PHASE == 15
                { const EpiRes E2{l == 0 ? 1 : 0, 1, 0, (unsigned)WS_ACT}; pg8::gemm_phase(lds, 1024, S, E2); }
#endif
                pg8::gemm_phase(lds, 1024, S, E); }
            SEAM(pc + 6);
        }
        if (INT(33, pb + 33)) phase_norm(KP()->out, KP()->in[I_NFFN] + l * DM, wsp<bf16_t>(WS_H));
        SEAM(pb + 33);
        if (INT(34, pb + 34)) { const SchedLin S = mk_sched(128, 22, WS_H, WS_WF1, 1024); const EpiSwiglu E{}; pg8::gemm_phase(lds, 1024, S, E);
#if DBL_PHASE == 8
            pg8::gemm_phase(lds, 1024, S, E);
#endif
        }
        SEAM(pb + 34);
        if (INT(35, pb + 35)) { const SchedLin S = mk_sched(128, 4, WS_ACT, WS_WF2, DFF); const EpiRes E{0, 0, 0, 0u};
#if DBL_PHASE == 16
            { const EpiRes E2{0, 0, 0, (unsigned)(WS_ACT + 176 * MiB)}; pg8::gemm_phase(lds, DFF, S, E2); }
#endif
            pg8::gemm_phase(lds, DFF, S, E); }
        SEAM(pb + 35);
    }
#undef IN
#undef INT
#undef SEAM
}

extern "C" void kernel_launch(void* const* d_in, const int* in_sizes, int n_in, void* d_out, int out_size, void* d_ws, size_t ws_size, hipStream_t stream) {
    static int grid = 0;
    if (grid == 0) {
        if (n_in != 26 || ws_size < WS_END) { grid = -1; return; }
        int dev = 0, cus = 0;
        if (hipGetDevice(&dev) != hipSuccess || hipDeviceGetAttribute(&cus, hipDeviceAttributeMultiprocessorCount, dev) != hipSuccess) { grid = -1; return; }
        if (hipFuncSetAttribute((const void*)mega, hipFuncAttributeMaxDynamicSharedMemorySize, LDS_BYTES) != hipSuccess) { grid = -1; return; }
        grid = cus;
    }
    if (grid < 0) return;
    (void)hipMemsetAsync((char*)d_ws + WS_CTL, 0, 64 * 1024, stream);
    Params p{};
    for (int i = 0; i < 26; ++i) p.in[i] = (const float*)d_in[i];
    p.out = (float*)d_out; p.ws = (unsigned char*)d_ws;
#if MK_ONE_LAUNCH
    p.ph_lo = 0; p.ph_hi = N_PHASES;
    hipLaunchKernelGGL(mega, dim3(grid), dim3(512), LDS_BYTES, stream, p);
#else
    for (int ph = 0; ph < N_PHASES; ++ph) { p.ph_lo = ph; p.ph_hi = ph + 1; hipLaunchKernelGGL(mega, dim3(grid), dim3(512), LDS_BYTES, stream, p); }
#endif
}
```

```cpp
#include <hip/hip_runtime.h>
#include <stdint.h>

#define DI __device__ __forceinline__
#define LAS __attribute__((address_space(3)))
typedef unsigned short bf16_t;
typedef short bf16x8 __attribute__((ext_vector_type(8)));
typedef float f32x2 __attribute__((ext_vector_type(2)));
typedef float f32x4 __attribute__((ext_vector_type(4)));
typedef float f32x16 __attribute__((ext_vector_type(16)));
typedef unsigned u32x2 __attribute__((ext_vector_type(2)));
typedef unsigned u32x4 __attribute__((ext_vector_type(4)));
typedef __bf16 bf2_t __attribute__((ext_vector_type(2)));

constexpr int NB = 16, SEQ = 2048, DM = 1024, NT = NB * SEQ, NH = 8, BW = 512;
constexpr int NCH = 4, SC = 512, TC = NB * SC;
constexpr int D_IN = 7496, DFF = 2816;
constexpr int C_MQ = 0, C_MK = 512, C_MV = 1024, C_RW = 1536, C_DS = 3360, C_GT = 4424;
constexpr int RAWLD = 1792;
constexpr float NORM_EPS = 1e-6f;
constexpr float LOG2E = 1.4426950408889634f;

constexpr size_t MiB = 1024 * 1024;
constexpr size_t WS_CTL = 0;
constexpr size_t WS_WB = 64 * 1024;
constexpr size_t WS_WV = WS_WB + 2 * MiB;
constexpr size_t WS_WD1 = WS_WV + 1 * MiB;
constexpr size_t WS_WKVK = WS_WD1 + 12 * MiB;
constexpr size_t WS_WKVV = WS_WKVK + MiB / 4;
constexpr size_t WS_WL = WS_WKVV + MiB / 4;
constexpr size_t WS_WBR = WS_WL + 2 * MiB;
constexpr size_t WS_WO = WS_WBR + 3 * MiB;
constexpr size_t WS_WF1 = WS_WO + 2 * MiB;
constexpr size_t WS_WF2 = WS_WF1 + 11 * MiB;
constexpr size_t WS_VFIRST = WS_WF2 + 6 * MiB;
constexpr size_t WS_STATE = WS_VFIRST + 32 * MiB;
constexpr size_t WS_H = WS_STATE + 2 * MiB;
constexpr size_t WS_IDXK = WS_H + 64 * MiB;
constexpr size_t WS_IDXW = WS_IDXK + 2 * MiB;
constexpr size_t WS_LEFT = WS_IDXW + 1 * MiB;
constexpr size_t WS_KMEAN = WS_LEFT + 2 * MiB;
constexpr size_t WS_CARRY = WS_KMEAN + MiB / 4;
constexpr size_t WS_MK = WS_CARRY + MiB / 4;
constexpr size_t WS_MVT = WS_MK + 32 * MiB;
constexpr size_t WS_DK = WS_MVT + 32 * MiB;
constexpr size_t WS_DVT = WS_DK + 32 * MiB;
constexpr size_t WS_MQ = WS_DVT + 32 * MiB;
constexpr size_t WS_DQ = WS_MQ + 16 * MiB;
constexpr size_t WS_ORW = WS_DQ + 16 * MiB;
constexpr size_t WS_GATES = WS_ORW + 16 * MiB;
constexpr size_t PAR_O = 8 * MiB, PAR_G = 24 * MiB;
constexpr size_t WS_IDXQ = WS_GATES + 48 * MiB;
constexpr size_t WS_RAW = WS_IDXQ + 4 * MiB;
constexpr size_t WS_LORAA = WS_RAW + 28 * MiB;
constexpr size_t WS_RR = WS_LORAA + 8 * MiB;
constexpr size_t WS_KF = WS_RR + 8 * MiB;
constexpr size_t WS_VV = WS_KF + 8 * MiB;
constexpr size_t WS_KKB = WS_VV + 8 * MiB;
constexpr size_t WS_BBB = WS_KKB + 8 * MiB;
constexpr size_t WS_GG = WS_BBB + 8 * MiB;
constexpr size_t WS_DEC = WS_GG + 8 * MiB;
constexpr size_t WS_OUT = WS_DEC + 16 * MiB;
constexpr size_t WS_V2 = WS_OUT + 16 * MiB;
constexpr size_t WS_SELB = WS_V2 + 8 * MiB;
constexpr size_t WS_END = WS_SELB + 2 * MiB;
constexpr size_t WS_DCN = WS_RAW;
constexpr size_t WS_Y32 = WS_IDXQ;
constexpr size_t WS_Y = WS_Y32 + 64 * MiB;
static_assert(WS_Y + 32 * MiB <= WS_END, "y32 / y alias");
constexpr size_t WS_ACT = WS_MK;
static_assert(WS_END <= 512 * MiB, "workspace map exceeds 512 MiB");
static_assert(WS_ACT + 176 * MiB <= WS_END, "ACT alias");

DI unsigned pk2(float a, float b) { f32x2 v = {a, b}; return __builtin_bit_cast(unsigned, __builtin_convertvector(v, bf2_t)); }
DI bf16_t f2bf(float a) { return (bf16_t)(pk2(a, 0.f) & 0xffffu); }
DI float bflo(unsigned u) { return __uint_as_float(u << 16); }
DI float bfhi(unsigned u) { return __uint_as_float(u & 0xffff0000u); }
DI float bf2f(bf16_t b) { return __uint_as_float((unsigned)b << 16); }
DI float fexp2(float x) { return __builtin_amdgcn_exp2f(x); }
DI float frcp(float x) { return __builtin_amdgcn_rcpf(x); }
DI float fsigmoid(float x) { return frcp(1.f + fexp2(-x * LOG2E)); }
DI float wave_sum(float v) {
#pragma unroll
    for (int o = 32; o >= 1; o >>= 1) v += __shfl_xor(v, o);
    return v;
}

#define XB_TMO      128
#define XB_XCNT(j)  (256  + 64 * (j))
#define XB_XSUB(j)  (1280 + 64 * (j))
#define XB_XGEN(j)  (2304 + 64 * (j))
#define XB_TOP      3328
#define XB_TOPGEN   3392
#define XCD_BAR_WORDS 3456
#define XB_SPIN_CAP (1u << 18)
__device__ __forceinline__ unsigned xb_ld(unsigned* p)              { return __hip_atomic_load(p, __ATOMIC_RELAXED, __HIP_MEMORY_SCOPE_AGENT); }
__device__ __forceinline__ unsigned xb_add(unsigned* p, unsigned v) { return __hip_atomic_fetch_add(p, v, __ATOMIC_RELAXED, __HIP_MEMORY_SCOPE_AGENT); }
__device__ __forceinline__ unsigned xb_xcc_id() { return (unsigned)__builtin_amdgcn_s_getreg((3 << 11) | 20) & 0xFu; }
#define XB_SPIN(cond, bar) do { unsigned _sp = 0; while (cond) { __builtin_amdgcn_s_sleep(1); \
    if ((++_sp & 255u) == 0u) { if (xb_ld(&(bar)[XB_TMO])) break; if (_sp > XB_SPIN_CAP) { atomicAdd(&(bar)[XB_TMO], 1u); break; } } } } while (0)
struct XcdBarrier { unsigned* bar; unsigned x; volatile LAS unsigned* st; };
__device__ __forceinline__ XcdBarrier xcd_barrier_post(unsigned* bar, volatile LAS unsigned* st) {
    XcdBarrier b; b.bar = bar; b.x = xb_xcc_id(); b.st = st;
    if (threadIdx.x == 0) (void)xb_add(&bar[XB_XCNT(b.x)], 1u);
    return b;
}
__device__ __forceinline__ void xcd_barrier_complete(unsigned* bar, unsigned x, unsigned& nloc, unsigned& nx) {
    const unsigned G = gridDim.x * gridDim.y * gridDim.z;
    unsigned sum, cnt, mine, sp = 0u;
    for (;;) {
        sum = 0u; cnt = 0u; mine = 0u;
#pragma unroll 1
        for (unsigned j = 0; j < 16; ++j) { const unsigned c = xb_ld(&bar[XB_XCNT(j)]); sum += c; cnt += (c > 0u) ? 1u : 0u; mine = (j == x) ? c : mine; }
        if (sum == G) break;
        __builtin_amdgcn_s_sleep(1);
        if ((++sp & 255u) == 0u) { if (xb_ld(&bar[XB_TMO])) break; if (sp > XB_SPIN_CAP) { atomicAdd(&bar[XB_TMO], 1u); break; } }
    }
    nloc = mine > 0u ? mine : 1u; nx = cnt > 0u ? cnt : 1u;
}
__device__ __forceinline__ void xcd_barrier(const XcdBarrier& b) {
    asm volatile("s_waitcnt vmcnt(0)" ::: "memory");
    __syncthreads();
    if (threadIdx.x == 0) {
        unsigned* bar = b.bar;
        __builtin_amdgcn_s_waitcnt(0);
        unsigned nloc = b.st[0], nx = b.st[1];
        if (nloc == 0u) { xcd_barrier_complete(bar, b.x, nloc, nx); b.st[0] = nloc; b.st[1] = nx; }
        const unsigned old = xb_add(&bar[XB_XSUB(b.x)], 1u);
        const unsigned gen = old / nloc;
        if (old + 1u == (gen + 1u) * nloc) {
            __builtin_amdgcn_fence(__ATOMIC_RELEASE, "agent");
            asm volatile("s_waitcnt vmcnt(0)" ::: "memory");
            const unsigned og = xb_add(&bar[XB_TOP], 1u);
            const unsigned tg = og / nx;
            if (og + 1u == (tg + 1u) * nx) xb_add(&bar[XB_TOPGEN], 1u);
            else XB_SPIN(xb_ld(&bar[XB_TOPGEN]) == tg, bar);
            __builtin_amdgcn_fence(__ATOMIC_ACQUIRE, "agent");
            xb_add(&bar[XB_XGEN(b.x)], 1u);
            asm volatile("s_waitcnt vmcnt(0)" ::: "memory");
        } else {
            XB_SPIN(xb_ld(&bar[XB_XGEN(b.x)]) == gen, bar);
            __builtin_amdgcn_fence(__ATOMIC_ACQUIRE, "agent");
            asm volatile("s_waitcnt vmcnt(0)" ::: "memory");
        }
    }
    __syncthreads();
}

DI int TID() { int t = threadIdx.x; asm volatile("" : "+v"(t)); return t; }
DI int BID() { int b = blockIdx.x; asm volatile("" : "+s"(b)); return b; }

namespace pg8 {
constexpr int BM = 256, BK = 64, HALF = 128, HTB = HALF * BK * 2, STAGE_BYTES = 8 * HTB, NXCD = 8, WGM = 8;
DI int lds_byte(int r, int c) { const int st = (r >> 4) * 2 + (c >> 5), rr = r & 15, cc = c & 31, ob = rr * 64 + cc * 2; return st * 1024 + (ob ^ (((ob >> 9) & 1) << 5)); }
DI void stage_rc(int b, int& R, int& C) { const int st = b / 1024, sb = b % 1024, swz = sb ^ (((sb >> 9) & 1) << 5); R = (st >> 1) * 16 + swz / 64; C = (st & 1) * 32 + (swz % 64) / 2; }
struct Unit { int pm, pn, z; };

DI bool order_xcd(int nM, int nN, int G, int c, int i, Unit& u) {
    const int nwg = nM * nN; const long L = (long)i * G + c; if (L >= nwg) return false;
    int wgid = (int)L; { const int q = nwg / NXCD, r = nwg % NXCD, xcd = wgid % NXCD, off = wgid / NXCD; wgid = (xcd < r ? xcd * (q + 1) : r * (q + 1) + (xcd - r) * q) + off; }
    const int nig = WGM * nN, gid = wgid / nig, fm = gid * WGM, gsz = (nM - fm) < WGM ? (nM - fm) : WGM;
    u.pm = fm + ((wgid % nig) % gsz); u.pn = (wgid % nig) / gsz; u.z = 0; return true;
}

template <class Epi, class Sched>
DI void gemm_phase(LAS unsigned char* lds, const int K, const Sched& S, const Epi& E) {
    const int tid = TID(), wid = __builtin_amdgcn_readfirstlane(tid >> 6), lane = tid & 63, wr = wid >> 2, wc = wid & 3, fr = lane & 15, fq = lane >> 4;
    const int nt = K / BK;
    unsigned voffA[2];
#pragma unroll
    for (int i = 0; i < 2; ++i) { int R, C; stage_rc(tid * 16 + i * 8192, R, C); voffA[i] = (unsigned)(R * K + C) * 2u; }
    const size_t kstep = (size_t)(BK * 2);
    const size_t hstep = (size_t)HALF * K * 2;
    const unsigned ldsw = (unsigned)wid * 1024u;
    const int aoff = lds_byte(wr * 64 + fr, fq * 8), boff = lds_byte(wc * 32 + fr, fq * 8);
#define PG8_SA(b, h) (((b) * 2 + (h)) * HTB)
#define PG8_SB(b, h) ((4 + (b) * 2 + (h)) * HTB)
#define PG8_STAGE(bufoff, gbase) do { _Pragma("unroll") for (int _i = 0; _i < 2; ++_i) \
        __builtin_amdgcn_global_load_lds((const unsigned*)((const char*)(gbase) + voffA[_i]), (LAS unsigned*)(lds + (bufoff) + ldsw + _i * 8192), 16, 0, 0); } while (0)
#define PG8_LDA(dst, b, h) do { _Pragma("unroll") for (int m = 0; m < 4; ++m) _Pragma("unroll") for (int k = 0; k < 2; ++k) dst[m][k] = *(const LAS bf16x8*)(lds + PG8_SA(b, h) + aoff + m * 2048 + k * 1024); } while (0)
#define PG8_LDB(dst, b, h) do { _Pragma("unroll") for (int n = 0; n < 2; ++n) _Pragma("unroll") for (int k = 0; k < 2; ++k) dst[n][k] = *(const LAS bf16x8*)(lds + PG8_SB(b, h) + boff + n * 2048 + k * 1024); } while (0)
#define PG8_MMA(ai, bj, At, Bt) do { __builtin_amdgcn_s_setprio(1); _Pragma("unroll") for (int m = 0; m < 4; ++m) _Pragma("unroll") for (int n = 0; n < 2; ++n) _Pragma("unroll") for (int k = 0; k < 2; ++k) \
        acc[ai][bj][m][n] = __builtin_amdgcn_mfma_f32_16x16x32_bf16(Bt[n][k], At[m][k], acc[ai][bj][m][n], 0, 0, 0); __builtin_amdgcn_s_setprio(0); } while (0)
#define PG8_WAIT_V(n) asm volatile("s_waitcnt vmcnt(" #n ")" ::: "memory")
#define PG8_WAIT_L(n) asm volatile("s_waitcnt lgkmcnt(" #n ")" ::: "memory")
#define PG8_BAR __builtin_amdgcn_s_barrier()
#define PG8_SCHED __builtin_amdgcn_sched_barrier(0)
    Unit cur, nxt; int ui = 0;
    if (!S.next(0, cur)) return;
    f32x4 acc[2][2][4][2];
#pragma unroll
    for (int a = 0; a < 2; ++a)
#pragma unroll
        for (int b = 0; b < 2; ++b)
#pragma unroll
            for (int m = 0; m < 4; ++m)
#pragma unroll
                for (int n = 0; n < 2; ++n) acc[a][b][m][n] = (f32x4){0.f, 0.f, 0.f, 0.f};
    bf16x8 At[4][2], B0[2][2], B1[2][2];
    const char* cA = S.aptr(cur); const char* cB = S.bptr(cur);
    PG8_STAGE(PG8_SB(0, 0), cB); PG8_STAGE(PG8_SA(0, 0), cA); PG8_STAGE(PG8_SB(0, 1), cB + hstep); PG8_STAGE(PG8_SA(0, 1), cA + hstep);
    if (wr == 1) PG8_BAR;
    PG8_WAIT_V(4); PG8_BAR;
    PG8_STAGE(PG8_SB(1, 0), cB + kstep); PG8_STAGE(PG8_SA(1, 0), cA + kstep); PG8_STAGE(PG8_SB(1, 1), cB + hstep + kstep);
    PG8_WAIT_V(6); PG8_BAR;
    for (;;) {
        const bool has_next = S.next(ui + 1, nxt);
        const char* nA = has_next ? S.aptr(nxt) : cA; const char* nB = has_next ? S.bptr(nxt) : cB;
#pragma unroll 1
        for (int t = 0; t < nt; t += 2) {
            const bool last = (t == nt - 2);
            const char* a1 = cA + (size_t)(t + 1) * kstep;
            const char* a2 = last ? nA : cA + (size_t)(t + 2) * kstep; const char* b2 = last ? nB : cB + (size_t)(t + 2) * kstep;
            const char* a3 = a2 + kstep; const char* b3 = b2 + kstep;
            PG8_LDB(B0, 0, 0); PG8_SCHED; PG8_LDA(At, 0, 0); PG8_STAGE(PG8_SA(1, 1), a1 + hstep);
            PG8_WAIT_L(8); PG8_BAR; PG8_WAIT_L(0); PG8_MMA(0, 0, At, B0); PG8_BAR; PG8_SCHED;
            PG8_LDB(B1, 0, 1); PG8_STAGE(PG8_SB(0, 0), b2);
            PG8_BAR; PG8_WAIT_L(0); PG8_MMA(0, 1, At, B1); PG8_BAR;
            PG8_LDA(At, 0, 1); PG8_STAGE(PG8_SA(0, 0), a2);
            PG8_BAR; PG8_WAIT_L(0); PG8_MMA(1, 0, At, B0); PG8_BAR; PG8_SCHED;
            PG8_STAGE(PG8_SB(0, 1), b2 + hstep);
            PG8_WAIT_V(6); PG8_BAR; PG8_MMA(1, 1, At, B1); PG8_BAR;
            PG8_LDB(B0, 1, 0); PG8_SCHED; PG8_LDA(At, 1, 0); PG8_STAGE(PG8_SA(0, 1), a2 + hstep);
            PG8_WAIT_L(8); PG8_BAR; PG8_WAIT_L(0); PG8_MMA(0, 0, At, B0); PG8_BAR; PG8_SCHED;
            PG8_LDB(B1, 1, 1); PG8_STAGE(PG8_SB(1, 0), b3);
            PG8_BAR; PG8_WAIT_L(0); PG8_MMA(0, 1, At, B1); PG8_BAR;
            PG8_LDA(At, 1, 1); PG8_STAGE(PG8_SA(1, 0), a3);
            PG8_BAR; PG8_WAIT_L(0); PG8_MMA(1, 0, At, B0); PG8_BAR; PG8_SCHED;
            PG8_STAGE(PG8_SB(1, 1), b3 + hstep);
            PG8_WAIT_V(6); PG8_BAR; PG8_MMA(1, 1, At, B1); PG8_BAR;
        }
        { int tz = TID(); asm volatile("" : "+v"(tz));
          const int wz = __builtin_amdgcn_readfirstlane(tz >> 6), lz = tz & 63; E(acc, cur, wz >> 2, wz & 3, lz & 15, lz >> 4); }
        if (!has_next) break;
#pragma unroll
        for (int a = 0; a < 2; ++a)
#pragma unroll
            for (int b = 0; b < 2; ++b)
#pragma unroll
                for (int m = 0; m < 4; ++m)
#pragma unroll
                    for (int n = 0; n < 2; ++n) acc[a][b][m][n] = (f32x4){0.f, 0.f, 0.f, 0.f};
        cur = nxt; cA = nA; cB = nB; ++ui;
    }
    PG8_WAIT_V(0);
    if (wr == 0) PG8_BAR;
    PG8_BAR;
#undef PG8_SA
#undef PG8_SB
#undef PG8_STAGE
#undef PG8_LDA
#undef PG8_LDB
#undef PG8_MMA
#undef PG8_WAIT_V
#undef PG8_WAIT_L
#undef PG8_BAR
#undef PG8_SCHED
}
}
using pg8::Unit;
typedef f32x4 AccT[2][2][4][2];

struct Params {
    const float* in[26];
    float* out;
    unsigned char* ws;
    int ph_lo, ph_hi;
};
enum { I_X = 0, I_WIN, I_NMIX, I_NFFN, I_QKN, I_REL, I_MU, I_W0, I_W2, I_A0, I_A2, I_G2, I_KK, I_KA, I_RK, I_LNW, I_LNB, I_V0, I_VA, I_VB, I_KVN, I_KVUP, I_WBR, I_WO, I_F1, I_F2 };

DI const Params* KP() { auto k = __builtin_amdgcn_kernarg_segment_ptr(); asm volatile("" : "+s"(k)); return (const Params*)k; }
template <class T> DI T* wsp(size_t off) { return (T*)(KP()->ws + off); }

DI int hn_col(int x) { const int pi = x & 255; return (x & ~255) + 64 * ((pi >> 5) & 3) + 32 * (pi >> 7) + (pi & 31); }
template <int MAP> DI int colmap(int r) {
    if (MAP == 0) {
        if (r < 512) return C_MK + hn_col(r);
        if (r < 768) return C_DS + 512 + (r - 512);
        const int pi = r - 768;
        if (pi < 32) return C_DS + 1024 + pi;
        if (pi < 40) return C_DS + 1056 + (pi - 32);
        if (pi >= 64 && pi < 96) return C_RW + 1792 + (pi - 64);
        return -1;
    }
    if (MAP == 1) return C_MV + r;
    if (MAP == 2) {
        if (r < 512) return C_MQ + hn_col(r);
        if (r < 1024) return C_DS + hn_col(r - 512);
        if (r < 1280) return C_DS + 768 + (r - 1024);
        if (r < 3072) return C_RW + (r - 1280);
        return C_GT + (r - 3072);
    }
    if (MAP == 3) return hn_col(r);
    if (MAP == 4) return 512 + r;
    if (MAP == 5) return r;
    if (MAP == 6) { const int pn = r >> 8, pi = r & 255; return ((pi >> 7) ? DFF : 0) + 128 * pn + (pi & 127); }
    return -1;
}
template <int MAP> DI void conv_t(LAS float* sm, bf16_t* dst, int nrows, int K, const float* src, int ld) {
    const int tid = TID(), tx = tid & 63, ty = tid >> 6;
    const int ntr = nrows / 64, ntk = K / 64, ntiles = ntr * ntk;
    for (int t = BID(); t < ntiles; t += gridDim.x) {
        const int r0 = (t / ntk) * 64, k0 = (t % ntk) * 64;
        const int col = colmap<MAP>(r0 + tx);
#pragma unroll
        for (int i = 0; i < 8; ++i) { const int kl = ty + 8 * i; sm[kl * 65 + tx] = (col >= 0) ? src[(size_t)(k0 + kl) * ld + col] : 0.f; }
        __syncthreads();
#pragma unroll
        for (int i = 0; i < 8; ++i) { const int rl = ty + 8 * i; dst[(size_t)(r0 + rl) * K + k0 + tx] = f2bf(sm[tx * 65 + rl]); }
        __syncthreads();
    }
}
DI void conv_lora(int l) {
    bf16_t* dst = wsp<bf16_t>(WS_WL);
    const float* w2 = KP()->in[I_W2] + (size_t)l * 64 * 512; const float* a2 = KP()->in[I_A2] + (size_t)l * 64 * 512; const float* g2 = KP()->in[I_G2] + (size_t)l * 160 * 512;
    const float* va = KP()->in[I_VA]; const float* vb = KP()->in[I_VB];
    const int n = 2048 * 512;
    for (int e = BID() * 512 + TID(); e < n; e += gridDim.x * 512) {
        const int r = e >> 9, k = e & 511; float v = 0.f;
        if (r < 512) { if (k < 64) v = w2[k * 512 + r]; }
        else if (r < 1024) { if (k >= 64 && k < 128) v = a2[(k - 64) * 512 + (r - 512)]; }
        else if (r < 1536) { if (k >= 128 && k < 288) v = g2[(k - 128) * 512 + (r - 1024)]; }
        else if (l == 1) { const int c = r - 1536; float s = 0.f;
#pragma unroll 8
            for (int j = 0; j < 32; ++j) s += va[k * 32 + j] * vb[j * 512 + c];
            v = s; }
        dst[e] = f2bf(v);
    }
}
DI void phase_conv(int l, LAS float* sm) {
    const float* win = KP()->in[I_WIN] + (size_t)l * DM * D_IN;
    conv_t<0>(sm, wsp<bf16_t>(WS_WB), 1024, 1024, win, D_IN);
    conv_t<1>(sm, wsp<bf16_t>(WS_WV), 512, 1024, win, D_IN);
    conv_t<2>(sm, wsp<bf16_t>(WS_WD1), 6144, 1024, win, D_IN);
    const float* kvup = KP()->in[I_KVUP] + (size_t)l * 256 * 1024;
    conv_t<3>(sm, wsp<bf16_t>(WS_WKVK), 512, 256, kvup, 1024);
    conv_t<4>(sm, wsp<bf16_t>(WS_WKVV), 512, 256, kvup, 1024);
    for (int i = 0; i < 3; ++i) conv_t<5>(sm, wsp<bf16_t>(WS_WBR) + (size_t)i * 1024 * 512, 1024, 512, KP()->in[I_WBR] + ((size_t)l * 3 + i) * 512 * 1024, 1024);
    conv_t<5>(sm, wsp<bf16_t>(WS_WO), 1024, 1024, KP()->in[I_WO] + (size_t)l * 1024 * 1024, 1024);
    conv_t<6>(sm, wsp<bf16_t>(WS_WF1), 5632, 1024, KP()->in[I_F1] + (size_t)l * 1024 * 5632, 5632);
    conv_t<5>(sm, wsp<bf16_t>(WS_WF2), 1024, 2816, KP()->in[I_F2] + (size_t)l * 2816 * 1024, 1024);
    conv_lora(l);
}

DI void phase_norm(const float* x, const float* g, bf16_t* h) {
    const int lane = TID() & 63, gw = BID() * 8 + (TID() >> 6), nw = gridDim.x * 8;
    f32x4 gv[4];
#pragma unroll
    for (int i = 0; i < 4; ++i) gv[i] = ((const f32x4*)g)[lane + 64 * i];
    for (int row = gw; row < NT; row += nw) {
        const f32x4* xr = (const f32x4*)(x + (size_t)row * DM);
        f32x4 v[4]; float ss = 0.f;
#pragma unroll
        for (int i = 0; i < 4; ++i) { v[i] = xr[lane + 64 * i]; ss += v[i][0] * v[i][0] + v[i][1] * v[i][1] + v[i][2] * v[i][2] + v[i][3] * v[i][3]; }
        ss = wave_sum(ss);
        const float rs = __builtin_amdgcn_rsqf(ss * (1.f / DM) + NORM_EPS);
#pragma unroll
        for (int i = 0; i < 4; ++i) {
            u32x2 o; o[0] = pk2(v[i][0] * rs * gv[i][0], v[i][1] * rs * gv[i][1]); o[1] = pk2(v[i][2] * rs * gv[i][2], v[i][3] * rs * gv[i][3]);
            *(u32x2*)(h + (size_t)row * DM + 4 * (lane + 64 * i)) = o;
        }
    }
}

struct SchedLin {
    int nM, nN, G, c; unsigned aoff, boff, a2off; int rowbytes, amode, cbase, pn2;
    DI bool next(int i, Unit& u) const { return pg8::order_xcd(nM, nN, G, c, i, u); }
    DI const char* aptr(const Unit& u) const { const int row0 = amode ? ((u.pm >> 1) * SEQ + cbase + (u.pm & 1) * 256) : u.pm * 256; return (const char*)KP()->ws + ((u.pn >= pn2) ? a2off : aoff) + (size_t)row0 * rowbytes; }
    DI const char* bptr(const Unit& u) const { return (const char*)KP()->ws + boff + (size_t)u.pn * 256 * rowbytes; }
};
DI SchedLin mk_sched(int nM, int nN, size_t aoff, size_t boff, int K, int amode = 0, int cbase = 0, size_t a2off = 0, int pn2 = 1 << 30) {
    SchedLin s; s.nM = nM; s.nN = nN; s.G = gridDim.x; s.c = BID(); s.aoff = (unsigned)aoff; s.boff = (unsigned)boff; s.rowbytes = K * 2; s.amode = amode; s.cbase = cbase; s.a2off = (unsigned)a2off; s.pn2 = pn2; return s;
}
struct SchedMerge {
    int G, c;
    DI bool next(int i, Unit& u) const { const int z = i % 3, tile = (i / 3) * G + c; if (tile >= 256) return false; u.pm = tile >> 2; u.pn = tile & 3; u.z = z; return true; }
    DI const char* aptr(const Unit& u) const { return (const char*)KP()->ws + (u.z == 0 ? WS_MQ : (u.z == 1 ? WS_ORW : WS_DQ)) + (size_t)(u.pm >> 5) * PAR_O + (size_t)(u.pm & 31) * 256 * 1024; }
    DI const char* bptr(const Unit& u) const { return (const char*)KP()->ws + WS_WBR + (size_t)u.z * (1024 * 512 * 2) + (size_t)u.pn * 256 * 1024; }
};

DI void st_bf4(bf16_t* p, f32x4 v) { u32x2 o; o[0] = pk2(v[0], v[1]); o[1] = pk2(v[2], v[3]); *(u32x2*)p = o; }
DI f32x4 ld_bf4(const bf16_t* p) { const u32x2 u = *(const u32x2*)p; return (f32x4){bflo(u[0]), bfhi(u[0]), bflo(u[1]), bfhi(u[1])}; }
#define EPI_ROWS(ai, m) (128 * (ai) + 64 * wr + 16 * (m) + fr)
#define EPI_COLS(bj, n) (128 * (bj) + 32 * wc + 16 * (n) + 4 * fq)
#define FOR_AM _Pragma("unroll") for (int ai = 0; ai < 2; ++ai) _Pragma("unroll") for (int m = 0; m < 4; ++m)
#define FOR_BN _Pragma("unroll") for (int bj = 0; bj < 2; ++bj) _Pragma("unroll") for (int n = 0; n < 2; ++n)

DI void epi_headnorm(const AccT& acc, bf16_t* out, int ld, const float* gain, int wr, int wc, int fr, int fq) {
    f32x4 gv[2][2];
    FOR_BN gv[bj][n] = *(const f32x4*)(gain + 32 * bj + 16 * n + 4 * fq);
    FOR_AM {
        float ss = 0.f;
        FOR_BN { const f32x4 a = acc[ai][bj][m][n]; ss += a[0] * a[0] + a[1] * a[1] + a[2] * a[2] + a[3] * a[3]; }
        ss += __shfl_xor(ss, 16); ss += __shfl_xor(ss, 32);
        const float sc = __builtin_amdgcn_rsqf(ss * (1.f / 64.f) + NORM_EPS);
        bf16_t* rp = out + (size_t)EPI_ROWS(ai, m) * ld + 64 * wc + 4 * fq;
        FOR_BN st_bf4(rp + 32 * bj + 16 * n, acc[ai][bj][m][n] * sc * gv[bj][n]);
    }
}
DI void epi_store_bf16(const AccT& acc, bf16_t* out, int ld, int wr, int wc, int fr, int fq) {
    FOR_AM { bf16_t* rp = out + (size_t)EPI_ROWS(ai, m) * ld; FOR_BN st_bf4(rp + EPI_COLS(bj, n), acc[ai][bj][m][n]); }
}

struct EpiB {
    int l;
    DI void operator()(const AccT& acc, const Unit& u, int wr, int wc, int fr, int fq) const {
        const size_t row0 = (size_t)u.pm * 256;
        if (u.pn < 2) epi_headnorm(acc, wsp<bf16_t>(WS_MK) + row0 * 512 + u.pn * 256, 512, KP()->in[I_QKN] + l * 256 + 64, wr, wc, fr, fq);
        else if (u.pn == 2) epi_store_bf16(acc, wsp<bf16_t>(WS_DCN) + row0 * 256, 256, wr, wc, fr, fq);
        else {
            bf16_t* idxk = wsp<bf16_t>(WS_IDXK); float* idxw = wsp<float>(WS_IDXW); bf16_t* left = wsp<bf16_t>(WS_LEFT);
            FOR_AM { const size_t row = row0 + EPI_ROWS(ai, m);
                if (wc == 0) { st_bf4(idxk + row * 32 + 4 * fq, acc[ai][0][m][0]); st_bf4(idxk + row * 32 + 16 + 4 * fq, acc[ai][0][m][1]); }
                else if (wc == 1) { if (fq < 2) *(f32x4*)(idxw + row * 8 + 4 * fq) = acc[ai][0][m][0]; }
                else if (wc == 2) { st_bf4(left + row * 32 + 4 * fq, acc[ai][0][m][0]); st_bf4(left + row * 32 + 16 + 4 * fq, acc[ai][0][m][1]); }
            }
        }
    }
};
struct EpiVt {
    unsigned off;
    DI void operator()(const AccT& acc, const Unit& u, int wr, int wc, int fr, int fq) const {
        bf16_t* vt = wsp<bf16_t>(off);
        const int b = u.pn >> 3, s0 = (u.pn & 7) * 256;
        FOR_AM { bf16_t* rp = vt + ((size_t)b * 512 + u.pm * 256 + EPI_ROWS(ai, m)) * SEQ + s0; FOR_BN st_bf4(rp + EPI_COLS(bj, n), acc[ai][bj][m][n]); }
    }
};
struct EpiHN {
    int l;
    DI void operator()(const AccT& acc, const Unit& u, int wr, int wc, int fr, int fq) const { epi_headnorm(acc, wsp<bf16_t>(WS_DK) + (size_t)u.pm * 256 * 512 + u.pn * 256, 512, KP()->in[I_QKN] + l * 256 + 192, wr, wc, fr, fq); }
};
struct EpiD1 {
    int l, par;
    DI void operator()(const AccT& acc, const Unit& u, int wr, int wc, int fr, int fq) const {
        const size_t row0 = (size_t)u.pm * 256;
        if (u.pn < 2) epi_headnorm(acc, wsp<bf16_t>(WS_MQ + par * PAR_O) + row0 * 512 + u.pn * 256, 512, KP()->in[I_QKN] + l * 256, wr, wc, fr, fq);
        else if (u.pn < 4) epi_headnorm(acc, wsp<bf16_t>(WS_DQ + par * PAR_O) + row0 * 512 + (u.pn - 2) * 256, 512, KP()->in[I_QKN] + l * 256 + 128, wr, wc, fr, fq);
        else if (u.pn == 4) epi_store_bf16(acc, wsp<bf16_t>(WS_IDXQ) + row0 * 256, 256, wr, wc, fr, fq);
        else if (u.pn < 12) epi_store_bf16(acc, wsp<bf16_t>(WS_RAW) + row0 * RAWLD + (u.pn - 5) * 256, RAWLD, wr, wc, fr, fq);
        else {
            unsigned char* o = wsp<unsigned char>(WS_GATES + par * PAR_G) + row0 * 3072 + (u.pn - 12) * 256;
            FOR_AM { unsigned char* rp = o + (size_t)EPI_ROWS(ai, m) * 3072;
                FOR_BN { const f32x4 a = acc[ai][bj][m][n];
                    const unsigned q0 = (unsigned)(fsigmoid(a[0]) * 255.f + 0.5f), q1 = (unsigned)(fsigmoid(a[1]) * 255.f + 0.5f), q2 = (unsigned)(fsigmoid(a[2]) * 255.f + 0.5f), q3 = (unsigned)(fsigmoid(a[3]) * 255.f + 0.5f);
                    *(unsigned*)(rp + EPI_COLS(bj, n)) = q0 | (q1 << 8) | (q2 << 16) | (q3 << 24); } }
        }
    }
};
struct EpiLora {
    int l, cbase;
    DI void operator()(const AccT& acc, const Unit& u, int wr, int wc, int fr, int fq) const {
        const size_t row0 = (size_t)u.pm * 256; const int kind = u.pn >> 1, cb = (u.pn & 1) * 256;
        if (kind == 0) {
            float* dec = wsp<float>(WS_DEC); const float* w0 = KP()->in[I_W0] + l * 512;
            FOR_AM { const size_t row = row0 + EPI_ROWS(ai, m);
                FOR_BN { const int col = cb + EPI_COLS(bj, n); const f32x4 a = acc[ai][bj][m][n]; const f32x4 wv = *(const f32x4*)(w0 + col); f32x4 d;
#pragma unroll
                    for (int e = 0; e < 4; ++e) { const float x = -(wv[e] + a[e]);
                        const float sp = fmaxf(x, 0.f) + __builtin_amdgcn_logf(1.f + fexp2(-fabsf(x) * LOG2E)) * 0.6931471805599453f;
                        const float w = -sp - 0.5f; d[e] = fexp2(-fexp2(w * LOG2E) * LOG2E); }
                    *(f32x4*)(dec + row * 512 + col) = d; } }
        } else if (kind == 1) {
            bf16_t* kf = wsp<bf16_t>(WS_KF); const bf16_t* kkb = wsp<bf16_t>(WS_KKB); bf16_t* bbb = wsp<bf16_t>(WS_BBB);
            const float* a0 = KP()->in[I_A0] + l * 512; const float* ka = KP()->in[I_KA] + l * 512;
            FOR_AM { const size_t row = row0 + EPI_ROWS(ai, m);
                f32x4 kp[2][2], kk[2][2];
                FOR_BN { const int col = cb + EPI_COLS(bj, n); kp[bj][n] = ld_bf4(kf + row * 512 + col); kk[bj][n] = ld_bf4(kkb + row * 512 + col); }
                FOR_BN { const int col = cb + EPI_COLS(bj, n); const f32x4 a = acc[ai][bj][m][n];
                    const f32x4 av = *(const f32x4*)(a0 + col), kav = *(const f32x4*)(ka + col); f32x4 ko, bo;
#pragma unroll
                    for (int e = 0; e < 4; ++e) { const float s = fsigmoid(av[e] + a[e]); ko[e] = kp[bj][n][e] * (1.f + (s - 1.f) * kav[e]); bo[e] = kk[bj][n][e] * s; }
                    st_bf4(kf + row * 512 + col, ko); st_bf4(bbb + row * 512 + col, bo); } }
        } else if (kind == 2) {
            epi_store_bf16(acc, wsp<bf16_t>(WS_GG) + row0 * 512 + cb, 512, wr, wc, fr, fq);
        } else {
            const bf16_t* vv = wsp<bf16_t>(WS_VV); bf16_t* v2 = wsp<bf16_t>(WS_V2); const bf16_t* vfirst = wsp<bf16_t>(WS_VFIRST); const float* v0 = KP()->in[I_V0];
            FOR_AM { const size_t row = row0 + EPI_ROWS(ai, m); const size_t arow = (size_t)(row >> 9) * SEQ + cbase + (row & 511);
                f32x4 vp[2][2], vf[2][2];
                FOR_BN { const int col = cb + EPI_COLS(bj, n); vp[bj][n] = ld_bf4(vv + row * 512 + col); vf[bj][n] = ld_bf4(vfirst + arow * 512 + col); }
                FOR_BN { const int col = cb + EPI_COLS(bj, n); const f32x4 a = acc[ai][bj][m][n]; const f32x4 v0v = *(const f32x4*)(v0 + col); f32x4 o;
#pragma unroll
                    for (int e = 0; e < 4; ++e) o[e] = vp[bj][n][e] + (vf[bj][n][e] - vp[bj][n][e]) * fsigmoid(v0v[e] + a[e]);
                    st_bf4(v2 + row * 512 + col, o); } }
        }
    }
};
struct EpiMerge {
    DI void operator()(const AccT& acc, const Unit& u, int wr, int wc, int fr, int fq) const {
        float* y32 = wsp<float>(WS_Y32); bf16_t* y = wsp<bf16_t>(WS_Y); const unsigned char* gates = wsp<unsigned char>(WS_GATES + (size_t)(u.pm >> 5) * PAR_G);
        const size_t row0 = (size_t)u.pm * 256, grow0 = (size_t)(u.pm & 31) * 256; const int c0 = u.pn * 256, z = u.z;
#pragma unroll
        for (int ai = 0; ai < 2; ++ai)
#pragma unroll
            for (int mp = 0; mp < 2; ++mp) {
                unsigned g[2][2][2]; f32x4 yv[2][2][2];
#pragma unroll
                for (int mm = 0; mm < 2; ++mm) { const int m = 2 * mp + mm; const int rt = EPI_ROWS(ai, m);
                    FOR_BN { const int col = c0 + EPI_COLS(bj, n); g[mm][bj][n] = *(const unsigned*)(gates + (grow0 + rt) * 3072 + z * 1024 + col);
                        yv[mm][bj][n] = (z > 0) ? *(const f32x4*)(y32 + (row0 + rt) * 1024 + col) : (f32x4){0.f, 0.f, 0.f, 0.f}; } }
#pragma unroll
                for (int mm = 0; mm < 2; ++mm) { const int m = 2 * mp + mm; const size_t row = row0 + EPI_ROWS(ai, m);
                    FOR_BN { const int col = c0 + EPI_COLS(bj, n); const unsigned gu = g[mm][bj][n];
                        const f32x4 gf = (f32x4){(float)(gu & 255u), (float)((gu >> 8) & 255u), (float)((gu >> 16) & 255u), (float)(gu >> 24)} * (1.f / 255.f);
                        const f32x4 v = acc[ai][bj][m][n] * gf + yv[mm][bj][n];
                        if (z < 2) *(f32x4*)(y32 + row * 1024 + col) = v; else st_bf4(y + row * 1024 + col, v); } }
            }
    }
};
struct EpiRes {
    int first, amode, cbase; unsigned dummy_off;
    DI void operator()(const AccT& acc, const Unit& u, int wr, int wc, int fr, int fq) const {
        float* out = KP()->out; const float* res = first ? KP()->in[I_X] : (const float*)out;
        if (dummy_off) out = wsp<float>(dummy_off);
        const size_t grow0 = amode == 2 ? ((size_t)((u.pm & 31) >> 1) * SEQ + cbase + (u.pm >> 5) * SC + (u.pm & 1) * 256) : (amode ? ((size_t)(u.pm >> 1) * SEQ + cbase + (u.pm & 1) * 256) : (size_t)u.pm * 256); const int c0 = u.pn * 256;
#pragma unroll
        for (int ai = 0; ai < 2; ++ai)
#pragma unroll
            for (int mp = 0; mp < 2; ++mp) {
                f32x4 rv[2][2][2];
#pragma unroll
                for (int mm = 0; mm < 2; ++mm) { const size_t row = grow0 + EPI_ROWS(ai, 2 * mp + mm); FOR_BN rv[mm][bj][n] = *(const f32x4*)(res + row * DM + c0 + EPI_COLS(bj, n)); }
#pragma unroll
                for (int mm = 0; mm < 2; ++mm) { const int m = 2 * mp + mm; const size_t row = grow0 + EPI_ROWS(ai, m); FOR_BN *(f32x4*)(out + row * DM + c0 + EPI_COLS(bj, n)) = rv[mm][bj][n] + acc[ai][bj][m][n]; }
            }
    }
};
struct EpiSwiglu {
    DI void operator()(const AccT& acc, const Unit& u, int wr, int wc, int fr, int fq) const {
        bf16_t* act = wsp<bf16_t>(WS_ACT);
        FOR_AM { bf16_t* rp = act + ((size_t)u.pm * 256 + EPI_ROWS(ai, m)) * DFF + u.pn * 128 + 32 * wc + 4 * fq;
#pragma unroll
            for (int n = 0; n < 2; ++n) { const f32x4 g = acc[ai][0][m][n], up = acc[ai][1][m][n]; f32x4 o;
#pragma unroll
                for (int e = 0; e < 4; ++e) o[e] = g[e] * fsigmoid(g[e]) * up[e];
                st_bf4(rp + 16 * n, o); } }
    }
};

DI void phase_dcn(int l) {
    const int lane = TID() & 63, gw = BID() * 8 + (TID() >> 6), nw = gridDim.x * 8;
    bf16_t* dcn = wsp<bf16_t>(WS_DCN);
    const f32x4 g = *(const f32x4*)(KP()->in[I_KVN] + l * 256 + 4 * lane);
    for (int row = gw; row < NT; row += nw) {
        bf16_t* rp = dcn + (size_t)row * 256 + 4 * lane;
        const f32x4 v = ld_bf4(rp);
        const float ss = wave_sum(v[0] * v[0] + v[1] * v[1] + v[2] * v[2] + v[3] * v[3]);
        const float rs = __builtin_amdgcn_rsqf(ss * (1.f / 256.f) + NORM_EPS);
        st_bf4(rp, v * rs * g);
    }
}
DI void phase_kmean() {
    const int lane = TID() & 63, gw = BID() * 8 + (TID() >> 6), nw = gridDim.x * 8;
    const bf16_t* mk = wsp<bf16_t>(WS_MK); float* km = wsp<float>(WS_KMEAN);
    for (int it = gw; it < NB * NH * 8; it += nw) {
        const int n = it & 7, h = (it >> 3) & 7, b = it >> 6;
        const bf16_t* kp = mk + ((size_t)b * SEQ + n * 256) * 512 + h * 64 + lane;
        float s0 = 0.f, s1 = 0.f, s2 = 0.f, s3 = 0.f;
        for (int k = 0; k < 256; k += 32) {
            bf16_t v[32];
#pragma unroll
            for (int j = 0; j < 32; ++j) v[j] = kp[(size_t)(k + j) * 512];
#pragma unroll
            for (int j = 0; j < 32; j += 4) { s0 += bf2f(v[j]); s1 += bf2f(v[j + 1]); s2 += bf2f(v[j + 2]); s3 += bf2f(v[j + 3]); }
        }
        km[(size_t)it * 64 + lane] = ((s0 + s1) + (s2 + s3)) * (1.f / 256.f);
    }
}

DI void phase_rwkv_prep(int l, int c) {
    const int lane = TID() & 63, gw = BID() * 8 + (TID() >> 6), nw = gridDim.x * 8;
    const bf16_t* raw = wsp<bf16_t>(WS_RAW); const bf16_t* left = wsp<bf16_t>(WS_LEFT); bf16_t* carry = wsp<bf16_t>(WS_CARRY);
    bf16_t* rr = wsp<bf16_t>(WS_RR); bf16_t* kf = wsp<bf16_t>(WS_KF); bf16_t* vv = wsp<bf16_t>(WS_VV); bf16_t* kkb = wsp<bf16_t>(WS_KKB);
    bf16_t* la = wsp<bf16_t>(WS_LORAA); bf16_t* vfirst = wsp<bf16_t>(WS_VFIRST);
    const float* mu = KP()->in[I_MU] + l * 1824; const float* kkw = KP()->in[I_KK] + l * 512;
    for (int rc = gw; rc < TC; rc += nw) {
        const int b = rc >> 9, sl = rc & 511, s = c * SC + sl; const size_t ra = (size_t)b * SEQ + s;
        const bf16_t* cur = raw + (size_t)rc * RAWLD;
        const bf16_t* prv = (sl > 0) ? (cur - RAWLD) : (carry + (size_t)((((c + 1) & 1) * 16) + b) * RAWLD);
        const bool hp = s > 0;
        auto mix8 = [&](int j, float* o) {
            const u32x4 cu = *(const u32x4*)(cur + j); u32x4 pu = {0u, 0u, 0u, 0u}; if (hp) pu = *(const u32x4*)(prv + j);
            const f32x4 m0 = *(const f32x4*)(mu + j), m1 = *(const f32x4*)(mu + j + 4);
#pragma unroll
            for (int e = 0; e < 4; ++e) { const float c0 = bflo(cu[e]), c1 = bfhi(cu[e]), p0 = bflo(pu[e]), p1 = bfhi(pu[e]);
                const float ma = (2 * e < 4) ? m0[2 * e] : m1[2 * e - 4], mb = (2 * e + 1 < 4) ? m0[2 * e + 1] : m1[2 * e + 1 - 4];
                o[2 * e] = c0 + (p0 - c0) * ma; o[2 * e + 1] = c1 + (p1 - c1) * mb; }
        };
        auto mix1 = [&](int j) -> float { const float c0 = bf2f(cur[j]); const float p0 = hp ? bf2f(prv[j]) : 0.f; return c0 + (p0 - c0) * mu[j]; };
        float o[8];
        mix8(8 * lane, o);
        { u32x4 w; w[0] = pk2(o[0], o[1]); w[1] = pk2(o[2], o[3]); w[2] = pk2(o[4], o[5]); w[3] = pk2(o[6], o[7]); *(u32x4*)(rr + (size_t)rc * 512 + 8 * lane) = w; }
        mix8(576 + 8 * lane, o);
        { u32x4 w; w[0] = pk2(o[0], o[1]); w[1] = pk2(o[2], o[3]); w[2] = pk2(o[4], o[5]); w[3] = pk2(o[6], o[7]); *(u32x4*)(kf + (size_t)rc * 512 + 8 * lane) = w;
          const f32x4 k0 = *(const f32x4*)(kkw + 8 * lane), k1 = *(const f32x4*)(kkw + 8 * lane + 4);
          float q[8]; float ss = 0.f;
#pragma unroll
          for (int e = 0; e < 8; ++e) { q[e] = o[e] * (e < 4 ? k0[e] : k1[e - 4]); ss += q[e] * q[e]; }
          ss += __shfl_xor(ss, 1); ss += __shfl_xor(ss, 2); ss += __shfl_xor(ss, 4);
          const float inv = 1.f / fmaxf(sqrtf(ss), 1e-12f);
          w[0] = pk2(q[0] * inv, q[1] * inv); w[1] = pk2(q[2] * inv, q[3] * inv); w[2] = pk2(q[4] * inv, q[5] * inv); w[3] = pk2(q[6] * inv, q[7] * inv);
          *(u32x4*)(kkb + (size_t)rc * 512 + 8 * lane) = w; }
        mix8(1088 + 8 * lane, o);
        { u32x4 w; w[0] = pk2(o[0], o[1]); w[1] = pk2(o[2], o[3]); w[2] = pk2(o[4], o[5]); w[3] = pk2(o[6], o[7]); *(u32x4*)(vv + (size_t)rc * 512 + 8 * lane) = w;
          if (l == 0) *(u32x4*)(vfirst + ra * 512 + 8 * lane) = w; }
        bf16_t* lr = la + (size_t)rc * 512;
        { const float x = mix1(512 + lane); const float t = fexp2(2.f * x * LOG2E); lr[lane] = f2bf(1.f - 2.f * frcp(t + 1.f)); }
        lr[64 + lane] = f2bf(mix1(1600 + lane));
        lr[128 + lane] = f2bf(fsigmoid(mix1(1664 + lane)));
        lr[192 + lane] = f2bf(fsigmoid(mix1(1728 + lane)));
        if (lane < 32) { const float c0 = bf2f(left[ra * 32 + lane]); const float p0 = hp ? bf2f(left[(ra - 1) * 32 + lane]) : 0.f;
            lr[256 + lane] = f2bf(fsigmoid(c0 + (p0 - c0) * mu[1792 + lane])); }
        if (lane < 56) *(u32x2*)(lr + 288 + 4 * lane) = (u32x2){0u, 0u};
        if (sl == SC - 1) { bf16_t* cp = carry + (size_t)(((c & 1) * 16) + b) * RAWLD;
            for (int j = lane; j < RAWLD / 8; j += 64) *(u32x4*)(cp + 8 * j) = *(const u32x4*)(cur + 8 * j); }
    }
}

DI float dpp_ror_add(float x, int) { return x; }
DI void reduce4(float p0, float p1, float p2, float p3, float& s0, float& s1, float& s2, float& s3) {
    auto r = __builtin_amdgcn_permlane32_swap(__float_as_uint(p0), __float_as_uint(p2), false, false);
    const float u0 = __uint_as_float(r[0]) + __uint_as_float(r[1]);
    r = __builtin_amdgcn_permlane32_swap(__float_as_uint(p1), __float_as_uint(p3), false, false);
    const float u1 = __uint_as_float(r[0]) + __uint_as_float(r[1]);
    r = __builtin_amdgcn_permlane16_swap(__float_as_uint(u0), __float_as_uint(u1), false, false);
    float w = __uint_as_float(r[0]) + __uint_as_float(r[1]);
    w += __uint_as_float(__builtin_amdgcn_update_dpp(0, __float_as_uint(w), 0x128, 0xf, 0xf, false));
    w += __uint_as_float(__builtin_amdgcn_update_dpp(0, __float_as_uint(w), 0x124, 0xf, 0xf, false));
    w += __uint_as_float(__builtin_amdgcn_update_dpp(0, __float_as_uint(w), 0x122, 0xf, 0xf, false));
    w += __uint_as_float(__builtin_amdgcn_update_dpp(0, __float_as_uint(w), 0x121, 0xf, 0xf, false));
    s0 = __uint_as_float(__builtin_amdgcn_readlane(__float_as_uint(w), 0));
    s1 = __uint_as_float(__builtin_amdgcn_readlane(__float_as_uint(w), 16));
    s2 = __uint_as_float(__builtin_amdgcn_readlane(__float_as_uint(w), 32));
    s3 = __uint_as_float(__builtin_amdgcn_readlane(__float_as_uint(w), 48));
}
DI void reduce8(float p0, float p1, float p2, float p3, float q0, float q1, float q2, float q3, float& pw, float& s0, float& s1, float& s2, float& s3) {
    auto r = __builtin_amdgcn_permlane32_swap(__float_as_uint(p0), __float_as_uint(p2), false, false);
    auto t = __builtin_amdgcn_permlane32_swap(__float_as_uint(q0), __float_as_uint(q2), false, false);
    const float u0 = __uint_as_float(r[0]) + __uint_as_float(r[1]);
    const float x0 = __uint_as_float(t[0]) + __uint_as_float(t[1]);
    r = __builtin_amdgcn_permlane32_swap(__float_as_uint(p1), __float_as_uint(p3), false, false);
    t = __builtin_amdgcn_permlane32_swap(__float_as_uint(q1), __float_as_uint(q3), false, false);
    const float u1 = __uint_as_float(r[0]) + __uint_as_float(r[1]);
    const float x1 = __uint_as_float(t[0]) + __uint_as_float(t[1]);
    r = __builtin_amdgcn_permlane16_swap(__float_as_uint(u0), __float_as_uint(u1), false, false);
    t = __builtin_amdgcn_permlane16_swap(__float_as_uint(x0), __float_as_uint(x1), false, false);
    float w = __uint_as_float(r[0]) + __uint_as_float(r[1]);
    float y = __uint_as_float(t[0]) + __uint_as_float(t[1]);
    w += __uint_as_float(__builtin_amdgcn_update_dpp(0, __float_as_uint(w), 0x128, 0xf, 0xf, false));
    y += __uint_as_float(__builtin_amdgcn_update_dpp(0, __float_as_uint(y), 0x128, 0xf, 0xf, false));
    w += __uint_as_float(__builtin_amdgcn_update_dpp(0, __float_as_uint(w), 0x124, 0xf, 0xf, false));
    y += __uint_as_float(__builtin_amdgcn_update_dpp(0, __float_as_uint(y), 0x124, 0xf, 0xf, false));
    w += __uint_as_float(__builtin_amdgcn_update_dpp(0, __float_as_uint(w), 0x122, 0xf, 0xf, false));
    y += __uint_as_float(__builtin_amdgcn_update_dpp(0, __float_as_uint(y), 0x122, 0xf, 0xf, false));
    w += __uint_as_float(__builtin_amdgcn_update_dpp(0, __float_as_uint(w), 0x121, 0xf, 0xf, false));
    y += __uint_as_float(__builtin_amdgcn_update_dpp(0, __float_as_uint(y), 0x121, 0xf, 0xf, false));
    pw = w;
    s0 = __uint_as_float(__builtin_amdgcn_readlane(__float_as_uint(y), 0));
    s1 = __uint_as_float(__builtin_amdgcn_readlane(__float_as_uint(y), 16));
    s2 = __uint_as_float(__builtin_amdgcn_readlane(__float_as_uint(y), 32));
    s3 = __uint_as_float(__builtin_amdgcn_readlane(__float_as_uint(y), 48));
}
struct ScanIn { bf16_t kk, bb, k, r, v; float w; };
DI void phase_scan(int l, int c, int dummy = 0) {
    const int lane = TID() & 63, gw = BID() * 8 + (TID() >> 6), nw = gridDim.x * 8;
    const bf16_t* kkb = wsp<bf16_t>(WS_KKB); const bf16_t* bbb = wsp<bf16_t>(WS_BBB); const bf16_t* kfb = wsp<bf16_t>(WS_KF); const bf16_t* rrb = wsp<bf16_t>(WS_RR);
    const bf16_t* vsb = wsp<bf16_t>(l == 0 ? WS_VV : WS_V2); const float* dec = wsp<float>(WS_DEC); float* outb = wsp<float>(WS_OUT); float* state = wsp<float>(WS_STATE);
    for (int item = gw; item < NB * NH * 16; item += nw) {
        const int bh = item >> 4, rg = item & 15, b = bh >> 3, h = bh & 7, i0 = rg * 4;
        float* stp = state + ((size_t)bh * 64 + i0) * 64 + lane;
        float S0 = 0.f, S1 = 0.f, S2 = 0.f, S3 = 0.f;
        if (c > 0) { S0 = stp[0]; S1 = stp[64]; S2 = stp[128]; S3 = stp[192]; }
        const size_t e0 = (size_t)b * SC * 512 + h * 64 + lane;
        const size_t ev = (size_t)b * SC * 512 + h * 64 + i0 + (lane & 3);
        float* op = outb + (size_t)b * SC * 512 + h * 64 + i0 + (lane >> 4);
        ScanIn A[8], B[8];
#define SCAN_LOAD(X, g) do { _Pragma("unroll") for (int j = 0; j < 8; ++j) { const size_t o = (size_t)((g) * 8 + j) * 512; \
            X[j].kk = kkb[e0 + o]; X[j].bb = bbb[e0 + o]; X[j].k = kfb[e0 + o]; X[j].r = rrb[e0 + o]; X[j].w = dec[e0 + o]; X[j].v = vsb[ev + o]; } } while (0)
#define SCAN_STEP1(Xj, kknext, t) do { \
            const float bb = bf2f(Xj.bb), kx = bf2f(Xj.k), rx = bf2f(Xj.r), wx = Xj.w; const unsigned vu = (unsigned)Xj.v << 16; \
            const float v0 = __uint_as_float(__builtin_amdgcn_readlane(vu, 0)), v1 = __uint_as_float(__builtin_amdgcn_readlane(vu, 1)), v2 = __uint_as_float(__builtin_amdgcn_readlane(vu, 2)), v3 = __uint_as_float(__builtin_amdgcn_readlane(vu, 3)); \
            S0 = S0 * wx + (v0 * kx - a0 * bb); S1 = S1 * wx + (v1 * kx - a1 * bb); S2 = S2 * wx + (v2 * kx - a2 * bb); S3 = S3 * wx + (v3 * kx - a3 * bb); \
            float ov; const float kn = (kknext); \
            reduce8(S0 * rx, S1 * rx, S2 * rx, S3 * rx, S0 * kn, S1 * kn, S2 * kn, S3 * kn, ov, a0, a1, a2, a3); \
            if ((lane & 15) == 0) op[(size_t)(t) * 512] = ov; } while (0)
#define SCAN_GROUP(X, Y, g, lastg) do { _Pragma("unroll") for (int j = 0; j < 8; ++j) { \
            const float kkn = (j < 7) ? bf2f(X[j < 7 ? j + 1 : 7].kk) : ((lastg) ? 0.f : bf2f(Y[0].kk)); \
            SCAN_STEP1(X[j], kkn, (g) * 8 + j); } } while (0)
        SCAN_LOAD(A, 0);
        float a0, a1, a2, a3;
        { const float k0 = bf2f(A[0].kk); reduce4(S0 * k0, S1 * k0, S2 * k0, S3 * k0, a0, a1, a2, a3); }
#if DBL_PHASE == 11
        if (dummy == 2) {
            float acc_ = 0.f;
            for (int g = 0; g < SC / 8; g += 2) {
                SCAN_LOAD(B, g + 1);
#pragma unroll
                for (int j = 0; j < 8; ++j) acc_ += bf2f(A[j].kk) + bf2f(A[j].bb) + bf2f(A[j].k) + bf2f(A[j].r) + bf2f(A[j].v) + A[j].w;
                if (g + 2 < SC / 8) SCAN_LOAD(A, g + 2);
#pragma unroll
                for (int j = 0; j < 8; ++j) acc_ += bf2f(B[j].kk) + bf2f(B[j].bb) + bf2f(B[j].k) + bf2f(B[j].r) + bf2f(B[j].v) + B[j].w;
            }
            if (acc_ == 12345.678f) stp[0] = acc_;
            continue;
        }
#endif
#if DBL_PHASE == 12
        if (dummy == 3) {
#pragma unroll
            for (int j = 0; j < 8; ++j) { A[j].kk = (bf16_t)(0x3c00 + lane + j); A[j].bb = (bf16_t)(0x3b00 + lane); A[j].k = (bf16_t)(0x3d00 + j); A[j].r = (bf16_t)(0x3e00 + lane); A[j].v = (bf16_t)(0x3c80 + j); A[j].w = 0.9f; B[j] = A[j]; }
            op = wsp<float>(WS_RAW) + (size_t)item * 4 + (lane >> 4);
            for (int g = 0; g < SC / 8; g += 2) {
                SCAN_GROUP(A, B, 0, false);
                SCAN_GROUP(B, A, 0, false);
            }
            if (S0 + S1 + S2 + S3 == 12345.678f) stp[0] = S0;
            continue;
        }
#endif
        for (int g = 0; g < SC / 8; g += 2) {
            SCAN_LOAD(B, g + 1);
            SCAN_GROUP(A, B, g, false);
            const bool last = (g + 2 >= SC / 8);
            if (!last) SCAN_LOAD(A, g + 2);
            SCAN_GROUP(B, A, g + 1, last);
        }
#undef SCAN_STEP1
#undef SCAN_GROUP
#undef SCAN_LOAD
        if (!dummy) { stp[0] = S0; stp[64] = S1; stp[128] = S2; stp[192] = S3; }
    }
}
typedef short s16x4 __attribute__((ext_vector_type(4)));
#define M16K32(a, b, c) __builtin_amdgcn_mfma_f32_16x16x32_bf16((a), (b), (c), 0, 0, 0)
#define M16K16(a, b, c) __builtin_amdgcn_mfma_f32_16x16x16bf16_1k((a), (b), (c), 0, 0, 0)
DI s16x4 pk4(f32x4 v) { u32x2 u; u[0] = pk2(v[0], v[1]); u[1] = pk2(v[2], v[3]); return __builtin_bit_cast(s16x4, u); }
DI float dpp_shr1(float x, float old) { return __uint_as_float(__builtin_amdgcn_update_dpp(__float_as_uint(old), __float_as_uint(x), 0x111, 0xf, 0xf, false)); }
DI float dpp_shr2(float x, float old) { return __uint_as_float(__builtin_amdgcn_update_dpp(__float_as_uint(old), __float_as_uint(x), 0x112, 0xf, 0xf, false)); }
DI float dpp_shr4(float x, float old) { return __uint_as_float(__builtin_amdgcn_update_dpp(__float_as_uint(old), __float_as_uint(x), 0x114, 0xf, 0xf, false)); }
DI float dpp_shr8(float x, float old) { return __uint_as_float(__builtin_amdgcn_update_dpp(__float_as_uint(old), __float_as_uint(x), 0x118, 0xf, 0xf, false)); }
DI float dpp_bcast15(float x) { return __uint_as_float(__builtin_amdgcn_update_dpp(0, __float_as_uint(x), 0x15F, 0xf, 0xf, false)); }
DI void phase_scan_chunked(int l, int c, LAS unsigned char* lds) {
    const int tid = TID(), lane = tid & 63, wave = tid >> 6, r16 = lane & 15, g = lane >> 4;
    if (wave >= 2) return;
    const int item = BID() * 2 + wave;
    if (item >= NB * NH * 4) return;
    const int bh = item >> 2, ig = item & 3, b = bh >> 3, h = bh & 7, i0 = 16 * ig;
    LAS unsigned char* wl = lds + wave * 4096;
    const bf16_t* kkb = wsp<bf16_t>(WS_KKB); const bf16_t* bbb = wsp<bf16_t>(WS_BBB); const bf16_t* kfb = wsp<bf16_t>(WS_KF); const bf16_t* rrb = wsp<bf16_t>(WS_RR);
    const bf16_t* vsb = wsp<bf16_t>(l == 0 ? WS_VV : WS_V2); const float* dec = wsp<float>(WS_DEC); float* outb = wsp<float>(WS_OUT);
    float* stp = wsp<float>(WS_STATE) + ((size_t)bh * 64 + i0 + r16) * 64 + 8 * g;
    f32x4 ST[4];
#pragma unroll
    for (int sg = 0; sg < 4; ++sg) ST[sg] = (c > 0) ? *(const f32x4*)(stp + 32 * (sg >> 1) + 4 * (sg & 1)) : (f32x4){0.f, 0.f, 0.f, 0.f};
    const size_t e0 = ((size_t)b * SC + r16) * 512 + h * 64 + 8 * g;
    const size_t ev = ((size_t)b * SC + 4 * g) * 512 + h * 64 + i0 + r16;
    const size_t eo = ((size_t)b * SC + 4 * g) * 512 + h * 64 + i0 + r16;
    u32x4 rk[2], rb[2], rq[2], rr_[2]; f32x4 rw[4]; bf16_t rv[4];
#define CS_LOAD(blk) do { const size_t o = e0 + (size_t)(blk) * 16 * 512; _Pragma("unroll") for (int s = 0; s < 2; ++s) { \
        rk[s] = *(const u32x4*)(kkb + o + 32 * s); rb[s] = *(const u32x4*)(bbb + o + 32 * s); rq[s] = *(const u32x4*)(kfb + o + 32 * s); rr_[s] = *(const u32x4*)(rrb + o + 32 * s); \
        rw[2 * s] = *(const f32x4*)(dec + o + 32 * s); rw[2 * s + 1] = *(const f32x4*)(dec + o + 32 * s + 4); } \
        _Pragma("unroll") for (int e = 0; e < 4; ++e) rv[e] = vsb[ev + (size_t)(blk) * 16 * 512 + (size_t)e * 512]; } while (0)
    CS_LOAD(0);
    for (int blk = 0; blk < SC / 16; ++blk) {
        float P[16], kap[16], bet[16], kq[16], rt[16];
#pragma unroll
        for (int s = 0; s < 2; ++s)
#pragma unroll
            for (int q = 0; q < 4; ++q) { const int i = 8 * s + 2 * q;
                kap[i] = bflo(rk[s][q]); kap[i + 1] = bfhi(rk[s][q]); bet[i] = bflo(rb[s][q]); bet[i + 1] = bfhi(rb[s][q]);
                kq[i] = bflo(rq[s][q]); kq[i + 1] = bfhi(rq[s][q]); rt[i] = bflo(rr_[s][q]); rt[i + 1] = bfhi(rr_[s][q]);
                P[i] = rw[2 * s + (q >> 1)][2 * (q & 1)]; P[i + 1] = rw[2 * s + (q >> 1)][2 * (q & 1) + 1]; }
        s16x4 Vb; { u32x2 u; u[0] = (unsigned)rv[0] | ((unsigned)rv[1] << 16); u[1] = (unsigned)rv[2] | ((unsigned)rv[3] << 16); Vb = __builtin_bit_cast(s16x4, u); }
        if (blk + 1 < SC / 16) CS_LOAD(blk + 1);
        float P16[16];
        bf16x8 ktp[2], btp[2], kqp[2], rtp[2];
#pragma unroll
        for (int i = 0; i < 16; ++i) { float p = P[i];
            p *= dpp_shr1(p, 1.f); p *= dpp_shr2(p, 1.f); p *= dpp_shr4(p, 1.f); p *= dpp_shr8(p, 1.f);
            const float pm1 = dpp_shr1(p, 1.f); const float inv = frcp(p); const float p16 = dpp_bcast15(p);
            P16[i] = p16; kap[i] *= pm1; bet[i] *= inv; kq[i] *= inv; rt[i] *= p; }
#pragma unroll
        for (int s = 0; s < 2; ++s) { u32x4 a, bb_, cc, dd;
#pragma unroll
            for (int q = 0; q < 4; ++q) { const int i = 8 * s + 2 * q; a[q] = pk2(kap[i], kap[i + 1]); bb_[q] = pk2(bet[i], bet[i + 1]); cc[q] = pk2(kq[i], kq[i + 1]); dd[q] = pk2(rt[i], rt[i + 1]); }
            ktp[s] = __builtin_bit_cast(bf16x8, a); btp[s] = __builtin_bit_cast(bf16x8, bb_); kqp[s] = __builtin_bit_cast(bf16x8, cc); rtp[s] = __builtin_bit_cast(bf16x8, dd); }
#pragma unroll
        for (int s = 0; s < 2; ++s)
#pragma unroll
            for (int hb = 0; hb < 2; ++hb) { const int i = 8 * s + 4 * hb; u32x2 uk, ub;
                uk[0] = pk2(kq[i] * P16[i], kq[i + 1] * P16[i + 1]); uk[1] = pk2(kq[i + 2] * P16[i + 2], kq[i + 3] * P16[i + 3]);
                ub[0] = pk2(bet[i] * P16[i], bet[i + 1] * P16[i + 1]); ub[1] = pk2(bet[i + 2] * P16[i + 2], bet[i + 3] * P16[i + 3]);
                const int off = r16 * 128 + (32 * s + 16 * hb + 4 * g) * 2;
                *(LAS u32x2*)(wl + off) = uk; *(LAS u32x2*)(wl + 2048 + off) = ub; }
        const f32x4 Z = {0.f, 0.f, 0.f, 0.f};
        f32x4 A1a = M16K32(btp[1], ktp[1], M16K32(btp[0], ktp[0], Z));
        f32x4 A1c = M16K32(ktp[1], btp[1], M16K32(ktp[0], btp[0], Z));
        f32x4 A2a = M16K32(kqp[1], ktp[1], M16K32(kqp[0], ktp[0], Z));
        f32x4 B1a = M16K32(btp[1], rtp[1], M16K32(btp[0], rtp[0], Z));
        f32x4 B2a = M16K32(kqp[1], rtp[1], M16K32(kqp[0], rtp[0], Z));
#pragma unroll
        for (int e = 0; e < 4; ++e) { const int s_ = 4 * g + e;
            A1a[e] = (s_ < r16) ? A1a[e] : 0.f; A2a[e] = (s_ < r16) ? A2a[e] : 0.f; A1c[e] = (r16 < s_) ? A1c[e] : 0.f;
            B1a[e] = (s_ <= r16) ? B1a[e] : 0.f; B2a[e] = (s_ <= r16) ? B2a[e] : 0.f; }
        const s16x4 a1a = pk4(A1a), a1c = pk4(A1c);
        const f32x4 M2a = M16K16(a1c, a1a, Z), M2c = M16K16(a1a, a1c, Z);
        const s16x4 m2a = pk4(M2a), m2c = pk4(M2c);
        const f32x4 M4a = M16K16(m2c, m2a, Z), M4c = M16K16(m2a, m2c, Z);
        const s16x4 m4a = pk4(M4a), m4c = pk4(M4c);
        const s16x4 m8a = pk4(M16K16(m4c, m4a, Z));
        s16x4 stb[4];
#pragma unroll
        for (int sg = 0; sg < 4; ++sg) stb[sg] = pk4(ST[sg]);
        f32x4 G = Z, G2 = Z;
#pragma unroll
        for (int sg = 0; sg < 4; ++sg) {
            const s16x4 kf_ = (sg & 1) ? __builtin_shufflevector(ktp[sg >> 1], ktp[sg >> 1], 4, 5, 6, 7) : __builtin_shufflevector(ktp[sg >> 1], ktp[sg >> 1], 0, 1, 2, 3);
            const s16x4 rf_ = (sg & 1) ? __builtin_shufflevector(rtp[sg >> 1], rtp[sg >> 1], 4, 5, 6, 7) : __builtin_shufflevector(rtp[sg >> 1], rtp[sg >> 1], 0, 1, 2, 3);
            G = M16K16(kf_, stb[sg], G); G2 = M16K16(rf_, stb[sg], G2); }
        const f32x4 RHS = M16K16(pk4(A2a), Vb, G);
        const f32x4 X1 = M16K16(m8a, pk4(RHS), RHS);
        const f32x4 X2 = M16K16(m4a, pk4(X1), X1);
        const f32x4 X3 = M16K16(m2a, pk4(X2), X2);
        const f32x4 U = M16K16(pk4(-A1a), pk4(X3), X3);
        const s16x4 un = pk4(-U);
        f32x4 O = M16K16(pk4(B2a), Vb, G2);
        O = M16K16(pk4(B1a), un, O);
        { float* op = outb + eo + (size_t)blk * 16 * 512;
#pragma unroll
          for (int e = 0; e < 4; ++e) op[(size_t)e * 512] = O[e]; }
#pragma unroll
        for (int sg = 0; sg < 4; ++sg) {
#pragma unroll
            for (int e = 0; e < 4; ++e) ST[sg][e] *= P16[8 * (sg >> 1) + 4 * (sg & 1) + e];
            const int toff = (4 * g + (r16 >> 2)) * 128 + 32 * sg + 8 * (r16 & 3);
            const s16x4 kh = __builtin_amdgcn_ds_read_tr16_b64_v4i16((LAS s16x4*)(wl + toff));
            const s16x4 bh_ = __builtin_amdgcn_ds_read_tr16_b64_v4i16((LAS s16x4*)(wl + 2048 + toff));
            ST[sg] = M16K16(kh, Vb, ST[sg]);
            ST[sg] = M16K16(bh_, un, ST[sg]);
        }
    }
#undef CS_LOAD
#pragma unroll
    for (int sg = 0; sg < 4; ++sg) *(f32x4*)(stp + 32 * (sg >> 1) + 4 * (sg & 1)) = ST[sg];
}
DI void phase_rwkv_post(int l, int par) {
    const int lane = TID() & 63, gw = BID() * 8 + (TID() >> 6), nw = gridDim.x * 8;
    const float* outb = wsp<float>(WS_OUT); const bf16_t* rrb = wsp<bf16_t>(WS_RR); const bf16_t* kfb = wsp<bf16_t>(WS_KF);
    const bf16_t* vsb = wsp<bf16_t>(l == 0 ? WS_VV : WS_V2); const bf16_t* ggb = wsp<bf16_t>(WS_GG); bf16_t* orw = wsp<bf16_t>(WS_ORW + par * PAR_O);
    const float* lnw = KP()->in[I_LNW] + l * 512; const float* lnb = KP()->in[I_LNB] + l * 512; const float* rk = KP()->in[I_RK] + l * 512;
    for (int it = gw; it < TC * NH; it += nw) {
        const int h = it & 7; const size_t e = (size_t)(it >> 3) * 512 + h * 64 + lane;
        const float o = outb[e];
        const float mean = wave_sum(o) * (1.f / 64.f); const float d = o - mean;
        const float var = wave_sum(d * d) * (1.f / 64.f);
        const float bonus = wave_sum(bf2f(rrb[e]) * bf2f(kfb[e]) * rk[h * 64 + lane]);
        float y = d * __builtin_amdgcn_rsqf(var + 64e-5f) * lnw[h * 64 + lane] + lnb[h * 64 + lane];
        y = (y + bonus * bf2f(vsb[e])) * bf2f(ggb[e]);
        orw[e] = f2bf(y);
    }
}

#define MFMA32(a, b, c) __builtin_amdgcn_mfma_f32_32x32x16_bf16((a), (b), (c), 0, 0, 0)
DI unsigned fkey(float v) { v = v + 0.f; const unsigned u = __float_as_uint(v); return (u & 0x80000000u) ? ~u : (u | 0x80000000u); }
DI int half_sum(int x) {
    x += __builtin_amdgcn_update_dpp(0, x, 0x128, 0xf, 0xf, false);
    x += __builtin_amdgcn_update_dpp(0, x, 0x124, 0xf, 0xf, false);
    x += __builtin_amdgcn_update_dpp(0, x, 0x122, 0xf, 0xf, false);
    x += __builtin_amdgcn_update_dpp(0, x, 0x121, 0xf, 0xf, false);
    auto r = __builtin_amdgcn_permlane16_swap((unsigned)x, (unsigned)x, false, false);
    return (int)(r[0] + r[1]);
}
DI void phase_dsa_select(int c, int wofs = 0, int wcnt = 8) {
    const int lane = TID() & 63, wv = (TID() >> 6) - wofs;
    if (wv < 0) return;
    const int gw = BID() * wcnt + wv, nw = gridDim.x * wcnt;
    for (int item = gw; item < TC / 4; item += nw) {
        int lz = lane; asm volatile("" : "+v"(lz));
        const int hh = lz >> 5, r5 = lz & 31;
        const int rc0 = item * 4, b = rc0 >> 9, t0 = c * SC + (rc0 & 511);
        const int qq = ((r5 >> 2) & 1) + 2 * (r5 >> 4), hd = (r5 & 3) + 4 * ((r5 >> 3) & 1);
        const bf16_t* qp = wsp<bf16_t>(WS_IDXQ) + (size_t)(rc0 + qq) * 256 + hd * 32 + 8 * hh;
        const bf16x8 Af0 = *(const bf16x8*)qp, Af1 = *(const bf16x8*)(qp + 16);
        const float* wp = wsp<float>(WS_IDXW) + ((size_t)b * SEQ + t0 + hh) * 8;
        const f32x4 wa0 = *(const f32x4*)wp, wa1 = *(const f32x4*)(wp + 4), wb0 = *(const f32x4*)(wp + 16), wb1 = *(const f32x4*)(wp + 20);
        const int tA = t0 + hh, tB = t0 + hh + 2;
        const int ngrp = ((t0 + 3) >> 9) + 1;
        unsigned keyA[64], keyB[64];
        const bf16_t* kbase = wsp<bf16_t>(WS_IDXK) + ((size_t)b * SEQ + r5) * 32 + 8 * hh;
        int keyv = r5;
        unsigned kofs = 0u;
        bf16x8 Bn0 = *(const bf16x8*)kbase, Bn1 = *(const bf16x8*)(kbase + 16);
#pragma unroll
        for (int g = 0; g < 4; ++g) {
            if (g < ngrp) {
#pragma unroll
                for (int j = 0; j < 16; ++j) {
                    const int kt = g * 16 + j;
                    const bf16x8 Bf0 = Bn0, Bf1 = Bn1;
                    { const unsigned nofs = (kt < 63) ? kofs + 32 * 32 : kofs; const bf16_t* kp = kbase + nofs; Bn0 = *(const bf16x8*)kp; Bn1 = *(const bf16x8*)(kp + 16); }
                    f32x16 C = {0.f, 0.f, 0.f, 0.f, 0.f, 0.f, 0.f, 0.f, 0.f, 0.f, 0.f, 0.f, 0.f, 0.f, 0.f, 0.f};
                    C = MFMA32(Af0, Bf0, C); C = MFMA32(Af1, Bf1, C);
                    float va = 0.f, vb = 0.f;
#pragma unroll
                    for (int i = 0; i < 4; ++i) { va += fmaxf(C[i], 0.f) * wa0[i]; vb += fmaxf(C[8 + i], 0.f) * wb0[i]; }
#pragma unroll
                    for (int i = 0; i < 4; ++i) { va += fmaxf(C[4 + i], 0.f) * wa1[i]; vb += fmaxf(C[12 + i], 0.f) * wb1[i]; }
                    unsigned ka = (keyv <= tA) ? fkey(va) : 0u, kb = (keyv <= tB) ? fkey(vb) : 0u;
                    asm volatile("" : "+v"(ka), "+v"(kb), "+v"(keyv), "+v"(kofs));
                    keyA[kt] = ka; keyB[kt] = kb;
                    keyv += 32; kofs += 32 * 32;
                }
            } else {
#pragma unroll
                for (int j = 0; j < 16; ++j) { keyA[g * 16 + j] = 0u; keyB[g * 16 + j] = 0u; }
            }
        }
        unsigned KA = 0u, KB = 0u;
        if (t0 + 3 >= 256) {
            for (int bit = 31; bit >= 0; --bit) {
                const unsigned bm = 1u << bit;
                const unsigned cA = KA | bm, cB = KB | bm;
                int nA = 0, nB = 0;
#pragma unroll
                for (int g = 0; g < 4; ++g) {
                    if (g < ngrp) {
#pragma unroll
                        for (int j = 0; j < 16; ++j) { nA += (keyA[g * 16 + j] >= cA) ? 1 : 0; nB += (keyB[g * 16 + j] >= cB) ? 1 : 0; }
                    }
                }
                nA = half_sum(nA); nB = half_sum(nB);
                if (nA >= 256) KA = cA;
                if (nB >= 256) KB = cB;
            }
        }
        int gA = 0, gB = 0;
#pragma unroll
        for (int kt = 0; kt < 64; ++kt) { gA += (keyA[kt] > KA) ? 1 : 0; gB += (keyB[kt] > KB) ? 1 : 0; }
        gA = half_sum(gA); gB = half_sum(gB);
        const int needA = (KA == 0u) ? 0 : 256 - gA, needB = (KB == 0u) ? 0 : 256 - gB;
        asm volatile("" : "+v"(KA), "+v"(KB));
        int runA = 0, runB = 0, lsel = lz;
        unsigned w0 = 0u, w1 = 0u, w2 = 0u, w3 = 0u;
#pragma unroll
        for (int kt = 0; kt < 64; ++kt) {
            const bool eqA = keyA[kt] == KA, eqB = keyB[kt] == KB;
            const unsigned long long ea = __ballot(eqA), eb = __ballot(eqB);
            const int rkA = runA + (hh ? (int)__builtin_amdgcn_mbcnt_hi((unsigned)(ea >> 32), 0u) : (int)__builtin_amdgcn_mbcnt_lo((unsigned)ea, 0u));
            const int rkB = runB + (hh ? (int)__builtin_amdgcn_mbcnt_hi((unsigned)(eb >> 32), 0u) : (int)__builtin_amdgcn_mbcnt_lo((unsigned)eb, 0u));
            const bool sA = (keyA[kt] > KA) || (eqA && rkA < needA), sB = (keyB[kt] > KB) || (eqB && rkB < needB);
            runA += hh ? __builtin_popcount((unsigned)(ea >> 32)) : __builtin_popcount((unsigned)ea);
            runB += hh ? __builtin_popcount((unsigned)(eb >> 32)) : __builtin_popcount((unsigned)eb);
            const unsigned long long sa = __ballot(sA), sb = __ballot(sB);
            if (lsel == 0) { w0 = (unsigned)sa; w1 = (unsigned)(sa >> 32); w2 = (unsigned)sb; w3 = (unsigned)(sb >> 32); }
            lsel -= 1; asm volatile("" : "+v"(lsel));
            __builtin_amdgcn_sched_barrier(0);
        }
        unsigned* sp = wsp<unsigned>(WS_SELB) + (size_t)rc0 * 64 + lz;
        sp[0] = w0; sp[64] = w1; sp[128] = w2; sp[192] = w3;
    }
}

struct AttnSt { f32x16 O0, O1; float m, l; };
constexpr float C2 = 0.125f * LOG2E;
DI void attn_load_kv(bf16x8 (&Kf)[4], bf16x8 (&Vf)[2][2], const bf16_t* kbase, const bf16_t* vtbase, int key0, int lane) {
    const int r5 = lane & 31;
    const int prow = (r5 & 19) | ((r5 & 4) << 1) | ((r5 & 8) >> 1);
    const bf16_t* kp = kbase + (size_t)(key0 + prow) * 512;
#pragma unroll
    for (int s = 0; s < 4; ++s) Kf[s] = *(const bf16x8*)(kp + 16 * s);
#pragma unroll
    for (int n = 0; n < 2; ++n)
#pragma unroll
        for (int s = 0; s < 2; ++s) Vf[n][s] = *(const bf16x8*)(vtbase + (size_t)(32 * n) * SEQ + key0 + 16 * s);
}
template <int MODE, bool FAR>
DI void attn_tile(AttnSt& st, const bf16x8 (&Qf)[4], const bf16x8 (&Kf)[4], const bf16x8 (&Vf)[2][2], int key0, int tq, bool allowed, unsigned word, LAS const float* bt, float ub, int lane) {
    const int hh = lane >> 5;
    f32x16 S = {0.f, 0.f, 0.f, 0.f, 0.f, 0.f, 0.f, 0.f, 0.f, 0.f, 0.f, 0.f, 0.f, 0.f, 0.f, 0.f};
#pragma unroll
    for (int s = 0; s < 4; ++s) S = MFMA32(Kf[s], Qf[s], S);
    const unsigned wsh = word >> (8 * hh);
    float ps = 0.f; float pv[16];
    if (FAR) {
        const float cb = (MODE == 0 && !allowed) ? -INFINITY : (bt[127] - ub);
#pragma unroll
        for (int i = 0; i < 16; ++i) {
            float p = fexp2(S[i] * C2 + cb);
            if (MODE == 1) p = __uint_as_float(__float_as_uint(p) & (unsigned)__builtin_amdgcn_sbfe((int)wsh, 16 * (i >> 3) + (i & 7), 1));
            pv[i] = p; ps += p;
        }
    } else {
#pragma unroll
        for (int i = 0; i < 16; ++i) {
            const int koff = 16 * (i >> 3) + 8 * hh + (i & 7);
            const int dist = tq - (key0 + koff);
            const bool ok = (MODE == 0) ? (allowed && dist >= 0) : (((wsh >> (16 * (i >> 3) + (i & 7))) & 1u) != 0u);
            const float p = fexp2(S[i] * C2 + (bt[min(max(dist, 0), 127)] - ub));
            pv[i] = ok ? p : 0.f; ps += pv[i];
        }
    }
    st.l += ps;
#pragma unroll
    for (int s = 0; s < 2; ++s) {
        u32x4 pw; pw[0] = pk2(pv[8 * s], pv[8 * s + 1]); pw[1] = pk2(pv[8 * s + 2], pv[8 * s + 3]); pw[2] = pk2(pv[8 * s + 4], pv[8 * s + 5]); pw[3] = pk2(pv[8 * s + 6], pv[8 * s + 7]);
        const bf16x8 Pf = __builtin_bit_cast(bf16x8, pw);
        st.O0 = MFMA32(Vf[0][s], Pf, st.O0); st.O1 = MFMA32(Vf[1][s], Pf, st.O1);
    }
}
constexpr int AT_ROW = 144, AT_KV = 64 * AT_ROW, AT_STAGE = 2 * AT_KV;
template <int MODE>
DI void attn_block(int c, int b, int h, int half, LAS unsigned char* stg, LAS unsigned* uni, LAS const float* bt, float kbound, float bmax, bool dummy) {
    const int tid = TID(), lane = tid & 63, wave = tid >> 6, r5 = lane & 31, hh = lane >> 5;
    bf16_t* qbuf = wsp<bf16_t>((MODE == 0 ? WS_MQ : WS_DQ) + (c & 1) * PAR_O);
    const int tb = c * SC + 256 * half, t0 = tb + 32 * wave, tq = t0 + r5, rowc0 = b * SC + 256 * half + 32 * wave;
    bf16_t* qp = qbuf + (size_t)(rowc0 + r5) * 512 + h * 64;
    bf16x8 Qf[4];
#pragma unroll
    for (int s = 0; s < 4; ++s) Qf[s] = *(const bf16x8*)(qp + 16 * s + 8 * hh);
    AttnSt st; st.m = 0.f; st.l = 0.f;
#pragma unroll
    for (int i = 0; i < 16; ++i) { st.O0[i] = 0.f; st.O1[i] = 0.f; }
    float ub;
    { float q2 = 0.f;
#pragma unroll
      for (int s = 0; s < 4; ++s)
#pragma unroll
          for (int j = 0; j < 8; ++j) { const float v = bf2f((bf16_t)Qf[s][j]); q2 += v * v; }
      q2 += __shfl_xor(q2, 32);
      ub = sqrtf(q2) * kbound * C2 + bmax; }
    const int ktl = (t0 + 31) >> 5;
    const int own = tb >> 8;
    unsigned bm = 0u, anyw = 0xffu;
    if (MODE == 0) {
        if (own > 0) {
            const float* km = wsp<float>(WS_KMEAN) + ((size_t)(b * 8 + h) * 8) * 64 + 8 * hh;
            float g[8];
#pragma unroll
            for (int n = 0; n < 8; ++n) {
                g[n] = -INFINITY;
                if (n < own) {
                    float part = 0.f;
#pragma unroll
                    for (int s = 0; s < 4; ++s) { const f32x4 k0 = *(const f32x4*)(km + n * 64 + 16 * s), k1 = *(const f32x4*)(km + n * 64 + 16 * s + 4);
#pragma unroll
                        for (int j = 0; j < 4; ++j) part += bf2f((bf16_t)Qf[s][j]) * k0[j] + bf2f((bf16_t)Qf[s][4 + j]) * k1[j]; }
                    g[n] = part + __shfl_xor(part, 32);
                }
            }
#pragma unroll
            for (int n = 0; n < 8; ++n) {
                if (n < own) { int rank = 0;
#pragma unroll
                    for (int m2 = 0; m2 < 8; ++m2) if (m2 != n && m2 < own) rank += ((g[m2] > g[n]) || (g[m2] == g[n] && m2 < n)) ? 1 : 0;
                    if (rank < 3) bm |= 1u << n; }
            }
        }
        anyw = 1u << own;
#pragma unroll
        for (int n = 0; n < 8; ++n) if (n < own && __ballot((bm >> n) & 1u) != 0ull) anyw |= 1u << n;
    }
    if (tid == 0) uni[0] = 0u;
    __syncthreads();
    if (lane == 0) __hip_atomic_fetch_or(uni, anyw, __ATOMIC_RELAXED, __HIP_MEMORY_SCOPE_WORKGROUP);
    __syncthreads();
    const unsigned anyb = MODE == 0 ? uni[0] : 0xffu;
    const int lrow = tid >> 3, lpart = tid & 7;
    const bf16_t* kg = wsp<bf16_t>(MODE == 0 ? WS_MK : WS_DK) + ((size_t)b * SEQ + lrow) * 512 + h * 64 + lpart * 8;
    const bf16_t* vg = wsp<bf16_t>(MODE == 0 ? WS_MVT : WS_DVT) + ((size_t)b * 512 + h * 64 + lrow) * SEQ + lpart * 8;
    const int lofs = lrow * AT_ROW + lpart * 16;
    const int prow = (r5 & 19) | ((r5 & 4) << 1) | ((r5 & 8) >> 1);
    const int kofs = prow * AT_ROW + 16 * hh, vofs = r5 * AT_ROW + 16 * hh;
    const unsigned* sp = wsp<unsigned>(WS_SELB) + (size_t)(rowc0 + r5) * 64;
    const int nst = (tb + 256) >> 6;
    int stp = 0;
    if (MODE == 0) { while (!((anyb >> (stp >> 2)) & 1u)) stp += 4; }
    u32x4 kreg = *(const u32x4*)(kg + (size_t)(stp * 64) * 512), vreg = *(const u32x4*)(vg + stp * 64);
    *(LAS u32x4*)(stg + lofs) = kreg; *(LAS u32x4*)(stg + AT_KV + lofs) = vreg;
    u32x2 wcur = {0u, 0u}, wnxt = {0u, 0u};
    if (MODE == 1) wcur = *(const u32x2*)(sp + 2 * stp);
    __syncthreads();
    int cur = 0;
    while (stp < nst) {
        int nx = stp + 1;
        if (MODE == 0) { while (nx < nst && !((anyb >> (nx >> 2)) & 1u)) nx += 4 - (nx & 3); }
        const bool more = nx < nst;
        if (more) { kreg = *(const u32x4*)(kg + (size_t)(nx * 64) * 512); vreg = *(const u32x4*)(vg + nx * 64); if (MODE == 1) wnxt = *(const u32x2*)(sp + 2 * nx); }
        LAS const unsigned char* ks = stg + cur * AT_STAGE; LAS const unsigned char* vs = ks + AT_KV;
#pragma unroll
        for (int u = 0; u < 2; ++u) {
            const int kt = 2 * stp + u, key0 = kt * 32, nb = kt >> 3;
            const bool waveon = (kt <= ktl) && (MODE == 1 || ((anyw >> nb) & 1u));
            if (waveon) {
                bf16x8 Kf[4], Vf[2][2];
#pragma unroll
                for (int s = 0; s < 4; ++s) Kf[s] = *(LAS const bf16x8*)(ks + 32 * u * AT_ROW + kofs + 32 * s);
#pragma unroll
                for (int n = 0; n < 2; ++n)
#pragma unroll
                    for (int s = 0; s < 2; ++s) Vf[n][s] = *(LAS const bf16x8*)(vs + 32 * n * AT_ROW + vofs + 64 * u + 32 * s);
                const unsigned word = (MODE == 1) ? wcur[u] : 0u;
                const bool allowed = (MODE == 0) ? ((nb == own) || (((bm >> nb) & 1u) != 0u)) : true;
                if (t0 - (key0 + 31) >= 113) attn_tile<MODE, true>(st, Qf, Kf, Vf, key0, tq, allowed, word, bt, ub, lane);
                else attn_tile<MODE, false>(st, Qf, Kf, Vf, key0, tq, allowed, word, bt, ub, lane);
            }
        }
        if (more) { LAS unsigned char* ws_ = stg + (cur ^ 1) * AT_STAGE; *(LAS u32x4*)(ws_ + lofs) = kreg; *(LAS u32x4*)(ws_ + AT_KV + lofs) = vreg; }
        __syncthreads();
        cur ^= 1; stp = nx; wcur = wnxt;
    }
    const float lt = st.l + __shfl_xor(st.l, 32);
    const float inv = 1.f / lt;
    if (dummy) qp = wsp<bf16_t>(WS_RAW + (MODE ? 8 * MiB : 0)) + (size_t)(rowc0 + r5) * 512 + h * 64;
#pragma unroll
    for (int g4 = 0; g4 < 4; ++g4) {
        st_bf4(qp + 8 * g4 + 4 * hh, (f32x4){st.O0[4 * g4] * inv, st.O0[4 * g4 + 1] * inv, st.O0[4 * g4 + 2] * inv, st.O0[4 * g4 + 3] * inv});
        st_bf4(qp + 32 + 8 * g4 + 4 * hh, (f32x4){st.O1[4 * g4] * inv, st.O1[4 * g4 + 1] * inv, st.O1[4 * g4 + 2] * inv, st.O1[4 * g4 + 3] * inv});
    }
    __syncthreads();
}
__device__ const unsigned char kBucket[128] = {0,1,2,3,4,5,6,7,8,9,10,11,12,13,14,15,16,16,16,17,17,18,18,18,19,19,19,20,20,20,20,21,21,21,21,22,22,22,22,22,23,23,23,23,23,23,24,24,24,24,24,24,25,25,25,25,25,25,25,26,26,26,26,26,26,26,26,27,27,27,27,27,27,27,27,27,27,28,28,28,28,28,28,28,28,28,28,29,29,29,29,29,29,29,29,29,29,29,29,30,30,30,30,30,30,30,30,30,30,30,30,30,30,31,31,31,31,31,31,31,31,31,31,31,31,31,31,31};
DI void phase_attn(int l, int c, LAS float* lds, bool dummy = false) {
    const int tid = TID();
    for (int e = tid; e < 2 * 8 * 128; e += 512) { const int d = e & 127, h = (e >> 7) & 7, mx = e >> 10; lds[e] = KP()->in[I_REL][kBucket[d] * 16 + mx * 8 + h] * LOG2E; }
    if (tid < 2) { const float* g = KP()->in[I_QKN] + l * 256 + (tid == 0 ? 64 : 192); float m = 0.f; for (int i = 0; i < 64; ++i) m = fmaxf(m, fabsf(g[i])); lds[2048 + tid] = 8.1f * m; }
    if (tid >= 64 && tid < 80) { const int mx = (tid - 64) >> 3, h = (tid - 64) & 7; float m = 0.f; for (int k = 0; k < 32; ++k) m = fmaxf(m, fabsf(KP()->in[I_REL][k * 16 + mx * 8 + h])); lds[2064 + (tid - 64)] = m * LOG2E; }
    __syncthreads();
    LAS unsigned char* stg = (LAS unsigned char*)lds + 16384; LAS unsigned* uni = (LAS unsigned*)((LAS unsigned char*)lds + 8192 + 256);
    for (int it = BID(); it < NB * NH * 2; it += gridDim.x) {
        const int bh = it >> 1, b = bh >> 3, h = bh & 7, hf = it & 1;
        attn_block<0>(c, b, h, hf, stg, uni, lds + h * 128, lds[2048], lds[2064 + h], dummy);
        attn_block<1>(c, b, h, hf ^ 1, stg, uni, lds + 1024 + h * 128, lds[2049], lds[2072 + h], dummy);
    }
    if (!dummy) phase_rwkv_post(l, c & 1);
}

constexpr int LDS_BYTES = pg8::STAGE_BYTES + 256;
constexpr int PH_PER_LAYER = 32, N_PHASES = 2 * PH_PER_LAYER;
#ifndef DBL_PHASE
#define DBL_PHASE 0
#endif
#ifndef MK_ONE_LAUNCH
#define MK_ONE_LAUNCH 1
#endif
__global__ void __launch_bounds__(512, 2) mega(Params p) {
    extern __shared__ __attribute__((aligned(16))) unsigned char lds_raw[];
    LAS unsigned char* lds = (LAS unsigned char*)lds_raw;
    volatile LAS unsigned* bst = (volatile LAS unsigned*)(lds + pg8::STAGE_BYTES);
    if (TID() < 4) bst[TID()] = 0u;
    __syncthreads();
    if (p.ph_hi - p.ph_lo > 1) (void)xcd_barrier_post((unsigned*)(KP()->ws + WS_CTL), bst);
#ifndef PH_ONLY
#define PH_ONLY -1
#endif
#define IN(k) (KP()->ph_lo <= (k) && (k) < KP()->ph_hi)
#define INT(tag, k) ((PH_ONLY < 0 || PH_ONLY == (tag)) && IN(k))
#define SEAM(k) do { if (IN(k) && IN((k) + 1)) { XcdBarrier bar_; bar_.bar = (unsigned*)(KP()->ws + WS_CTL); bar_.x = xb_xcc_id(); bar_.st = (volatile LAS unsigned*)(lds + pg8::STAGE_BYTES); xcd_barrier(bar_); if (DBL_PHASE == 20) xcd_barrier(bar_); } } while (0)
    for (int l = 0; l < 2; ++l) {
        const int pb = PH_PER_LAYER * l;
        if (INT(0, pb + 0)) {
#if DBL_PHASE == 6
            phase_conv(l, (LAS float*)lds);
#endif
            phase_conv(l, (LAS float*)lds); }
        SEAM(pb + 0);
        if (INT(1, pb + 1)) {
#if DBL_PHASE == 7
            phase_norm(l == 0 ? KP()->in[I_X] : (const float*)KP()->out, KP()->in[I_NMIX] + l * DM, wsp<bf16_t>(WS_H));
#endif
            phase_norm(l == 0 ? KP()->in[I_X] : (const float*)KP()->out, KP()->in[I_NMIX] + l * DM, wsp<bf16_t>(WS_H)); }
        SEAM(pb + 1);
        if (INT(2, pb + 2)) {
            { const SchedLin S = mk_sched(128, 4, WS_H, WS_WB, 1024); const EpiB E{l}; pg8::gemm_phase(lds, 1024, S, E); }
            { const SchedLin S = mk_sched(2, 128, WS_WV, WS_H, 1024); const EpiVt E{(unsigned)WS_MVT}; pg8::gemm_phase(lds, 1024, S, E); }
#if DBL_PHASE == 9
            { const SchedLin S = mk_sched(128, 4, WS_H, WS_WB, 1024); const EpiB E{l}; pg8::gemm_phase(lds, 1024, S, E); }
            { const SchedLin S = mk_sched(2, 128, WS_WV, WS_H, 1024); const EpiVt E{(unsigned)WS_MVT}; pg8::gemm_phase(lds, 1024, S, E); }
#endif
        }
        SEAM(pb + 2);
        if (INT(3, pb + 3)) { phase_dcn(l); phase_kmean();
#if DBL_PHASE == 14
            phase_kmean();
#endif
        }
        SEAM(pb + 3);
        if (INT(4, pb + 4)) {
            { const SchedLin S = mk_sched(128, 2, WS_DCN, WS_WKVK, 256); const EpiHN E{l}; pg8::gemm_phase(lds, 256, S, E); }
            { const SchedLin S = mk_sched(2, 128, WS_WKVV, WS_DCN, 256); const EpiVt E{(unsigned)WS_DVT}; pg8::gemm_phase(lds, 256, S, E); }
        }
        SEAM(pb + 4);
        for (int c = 0; c < NCH; ++c) {
            const int pc = pb + 5 + 5 * c + 2 * (c >> 1), cbase = c * SC;
            if (INT(5, pc + 0)) { const SchedLin S = mk_sched(32, 24, WS_H, WS_WD1, 1024, 1, cbase); const EpiD1 E{l, c & 1}; pg8::gemm_phase(lds, 1024, S, E);
#if DBL_PHASE == 5
                pg8::gemm_phase(lds, 1024, S, E);
#endif
            }
            SEAM(pc + 0);
            if (INT(6, pc + 1)) {
#if DBL_PHASE == 4
                phase_rwkv_prep(l, c);
#endif
#if DBL_PHASE == 3
                phase_dsa_select(c);
#endif
                phase_rwkv_prep(l, c); }
            SEAM(pc + 1);
            if (INT(7, pc + 2)) { const SchedLin S = mk_sched(32, l == 0 ? 6 : 8, WS_LORAA, WS_WL, 512, 0, 0, WS_VV, 6); const EpiLora E{l, cbase}; pg8::gemm_phase(lds, 512, S, E); }
            SEAM(pc + 2);
            if (INT(8, pc + 3)) {
#if DBL_PHASE == 2
                phase_scan(l, c, 1);
#endif
#if DBL_PHASE == 11
                phase_scan(l, c, 2);
#endif
#if DBL_PHASE == 12
                phase_scan(l, c, 3);
#endif
                phase_scan_chunked(l, c, lds); phase_dsa_select(c, 2, 6); }
            SEAM(pc + 3);
            if (INT(9, pc + 4)) {
#if DBL_PHASE == 1
                phase_attn(l, c, (LAS float*)lds, true); __syncthreads();
#endif
                phase_attn(l, c, (LAS float*)lds); }
            SEAM(pc + 4);
            if (c & 1) {
                if (INT(10, pc + 5)) { const SchedMerge S{(int)gridDim.x, (int)BID()}; const EpiMerge E{}; pg8::gemm_phase(lds, 512, S, E);
#if DBL_PHASE == 10
                    pg8::gemm_phase(lds, 512, S, E);
#endif
                }
                SEAM(pc + 5);
                if (INT(11, pc + 6)) { const SchedLin S = mk_sched(64, 4, WS_Y, WS_WO, 1024); const EpiRes E{l == 0 ? 1 : 0, 2, cbase - SC, 0u}; pg8::gemm_phase(lds, 1024, S, E); }
                SEAM(pc + 6);
            }
        }
        if (INT(33, pb + 29)) phase_norm(KP()->out, KP()->in[I_NFFN] + l * DM, wsp<bf16_t>(WS_H));
        SEAM(pb + 29);
        if (INT(34, pb + 30)) { const SchedLin S = mk_sched(128, 22, WS_H, WS_WF1, 1024); const EpiSwiglu E{}; pg8::gemm_phase(lds, 1024, S, E);
#if DBL_PHASE == 8
            pg8::gemm_phase(lds, 1024, S, E);
#endif
        }
        SEAM(pb + 30);
        if (INT(35, pb + 31)) { const SchedLin S = mk_sched(128, 4, WS_ACT, WS_WF2, DFF); const EpiRes E{0, 0, 0, 0u};
#if DBL_PHASE == 16
            { const EpiRes E2{0, 0, 0, (unsigned)(WS_ACT + 176 * MiB)}; pg8::gemm_phase(lds, DFF, S, E2); }
#endif
            pg8::gemm_phase(lds, DFF, S, E); }
        SEAM(pb + 31);
    }
#undef IN
#undef INT
#undef SEAM
}

extern "C" void kernel_launch(void* const* d_in, const int* in_sizes, int n_in, void* d_out, int out_size, void* d_ws, size_t ws_size, hipStream_t stream) {
    static int grid = 0;
    if (grid == 0) {
        if (n_in != 26 || ws_size < WS_END) { grid = -1; return; }
        int dev = 0, cus = 0;
        if (hipGetDevice(&dev) != hipSuccess || hipDeviceGetAttribute(&cus, hipDeviceAttributeMultiprocessorCount, dev) != hipSuccess) { grid = -1; return; }
        if (hipFuncSetAttribute((const void*)mega, hipFuncAttributeMaxDynamicSharedMemorySize, LDS_BYTES) != hipSuccess) { grid = -1; return; }
        grid = cus;
    }
    if (grid < 0) return;
    (void)hipMemsetAsync((char*)d_ws + WS_CTL, 0, 64 * 1024, stream);
    Params p{};
    for (int i = 0; i < 26; ++i) p.in[i] = (const float*)d_in[i];
    p.out = (float*)d_out; p.ws = (unsigned char*)d_ws;
#if MK_ONE_LAUNCH
    p.ph_lo = 0; p.ph_hi = N_PHASES;
    hipLaunchKernelGGL(mega, dim3(grid), dim3(512), LDS_BYTES, stream, p);
#else
    for (int ph = 0; ph < N_PHASES; ++ph) { p.ph_lo = ph; p.ph_hi = ph + 1; hipLaunchKernelGGL(mega, dim3(grid), dim3(512), LDS_BYTES, stream, p); }
#endif
}
```

```cpp
#include <hip/hip_runtime.h>
#include <stdint.h>
#ifndef DBL_PHASE
#define DBL_PHASE 22
#endif

#define DI __device__ __forceinline__
#define LAS __attribute__((address_space(3)))
typedef unsigned short bf16_t;
typedef short bf16x8 __attribute__((ext_vector_type(8)));
typedef float f32x2 __attribute__((ext_vector_type(2)));
typedef float f32x4 __attribute__((ext_vector_type(4)));
typedef float f32x16 __attribute__((ext_vector_type(16)));
typedef unsigned u32x2 __attribute__((ext_vector_type(2)));
typedef unsigned u32x4 __attribute__((ext_vector_type(4)));
typedef __bf16 bf2_t __attribute__((ext_vector_type(2)));

constexpr int NB = 16, SEQ = 2048, DM = 1024, NT = NB * SEQ, NH = 8, BW = 512;
constexpr int NCH = 4, SC = 512, TC = NB * SC;
constexpr int D_IN = 7496, DFF = 2816;
constexpr int C_MQ = 0, C_MK = 512, C_MV = 1024, C_RW = 1536, C_DS = 3360, C_GT = 4424;
constexpr int RAWLD = 1792;
constexpr float NORM_EPS = 1e-6f;
constexpr float LOG2E = 1.4426950408889634f;

constexpr size_t MiB = 1024 * 1024;
constexpr size_t WS_CTL = 0;
constexpr size_t WS_WB = 64 * 1024;
constexpr size_t WS_WV = WS_WB + 2 * MiB;
constexpr size_t WS_WD1 = WS_WV + 1 * MiB;
constexpr size_t WS_WKVK = WS_WD1 + 12 * MiB;
constexpr size_t WS_WKVV = WS_WKVK + MiB / 4;
constexpr size_t WS_WL = WS_WKVV + MiB / 4;
constexpr size_t WS_WBR = WS_WL + 2 * MiB;
constexpr size_t WS_WO = WS_WBR + 3 * MiB;
constexpr size_t WS_WF1 = WS_WO + 2 * MiB;
constexpr size_t WS_WF2 = WS_WF1 + 11 * MiB;
constexpr size_t WS_VFIRST = WS_WF2 + 6 * MiB;
constexpr size_t WS_STATE = WS_VFIRST + 32 * MiB;
constexpr size_t WS_H = WS_STATE + 2 * MiB;
constexpr size_t WS_IDXK = WS_H + 64 * MiB;
constexpr size_t WS_IDXW = WS_IDXK + 2 * MiB;
constexpr size_t WS_LEFT = WS_IDXW + 1 * MiB;
constexpr size_t WS_KMEAN = WS_LEFT + 2 * MiB;
constexpr size_t WS_CARRY = WS_KMEAN + MiB / 4;
constexpr size_t WS_MK = WS_CARRY + MiB / 4;
constexpr size_t WS_MVT = WS_MK + 32 * MiB;
constexpr size_t WS_DK = WS_MVT + 32 * MiB;
constexpr size_t WS_DVT = WS_DK + 32 * MiB;
constexpr size_t WS_MQ = WS_DVT + 32 * MiB;
constexpr size_t WS_DQ = WS_MQ + 16 * MiB;
constexpr size_t WS_ORW = WS_DQ + 16 * MiB;
constexpr size_t WS_GATES = WS_ORW + 16 * MiB;
constexpr size_t PAR_O = 8 * MiB, PAR_G = 24 * MiB;
constexpr size_t WS_IDXQ = WS_GATES + 48 * MiB;
constexpr size_t WS_RAW = WS_IDXQ + 4 * MiB;
constexpr size_t WS_LORAA = WS_RAW + 28 * MiB;
constexpr size_t WS_RR = WS_LORAA + 8 * MiB;
constexpr size_t WS_KF = WS_RR + 8 * MiB;
constexpr size_t WS_VV = WS_KF + 8 * MiB;
constexpr size_t WS_KKB = WS_VV + 8 * MiB;
constexpr size_t WS_BBB = WS_KKB + 8 * MiB;
constexpr size_t WS_GG = WS_BBB + 8 * MiB;
constexpr size_t WS_DEC = WS_GG + 8 * MiB;
constexpr size_t WS_OUT = WS_DEC + 16 * MiB;
constexpr size_t WS_V2 = WS_OUT + 16 * MiB;
constexpr size_t WS_SELB = WS_V2 + 8 * MiB;
constexpr size_t WS_END = WS_SELB + 2 * MiB;
constexpr size_t WS_DCN = WS_RAW;
constexpr size_t WS_Y32 = WS_IDXQ;
constexpr size_t WS_Y = WS_Y32 + 64 * MiB;
static_assert(WS_Y + 32 * MiB <= WS_END, "y32 / y alias");
constexpr size_t WS_ACT = WS_MK;
static_assert(WS_END <= 512 * MiB, "workspace map exceeds 512 MiB");
static_assert(WS_ACT + 176 * MiB <= WS_END, "ACT alias");

DI unsigned pk2(float a, float b) { f32x2 v = {a, b}; return __builtin_bit_cast(unsigned, __builtin_convertvector(v, bf2_t)); }
DI bf16_t f2bf(float a) { return (bf16_t)(pk2(a, 0.f) & 0xffffu); }
DI float bflo(unsigned u) { return __uint_as_float(u << 16); }
DI float bfhi(unsigned u) { return __uint_as_float(u & 0xffff0000u); }
DI float bf2f(bf16_t b) { return __uint_as_float((unsigned)b << 16); }
DI float fexp2(float x) { return __builtin_amdgcn_exp2f(x); }
DI float frcp(float x) { return __builtin_amdgcn_rcpf(x); }
DI float fsigmoid(float x) { return frcp(1.f + fexp2(-x * LOG2E)); }
DI float wave_sum(float v) {
    v += __uint_as_float(__builtin_amdgcn_update_dpp(0, __float_as_uint(v), 0x128, 0xf, 0xf, false));
    v += __uint_as_float(__builtin_amdgcn_update_dpp(0, __float_as_uint(v), 0x124, 0xf, 0xf, false));
    v += __uint_as_float(__builtin_amdgcn_update_dpp(0, __float_as_uint(v), 0x122, 0xf, 0xf, false));
    v += __uint_as_float(__builtin_amdgcn_update_dpp(0, __float_as_uint(v), 0x121, 0xf, 0xf, false));
    auto r = __builtin_amdgcn_permlane16_swap(__float_as_uint(v), __float_as_uint(v), false, false);
    v = __uint_as_float(r[0]) + __uint_as_float(r[1]);
    r = __builtin_amdgcn_permlane32_swap(__float_as_uint(v), __float_as_uint(v), false, false);
    return __uint_as_float(r[0]) + __uint_as_float(r[1]);
}

#define XB_TMO      128
#define XB_XCNT(j)  (256  + 64 * (j))
#define XB_XSUB(j)  (1280 + 64 * (j))
#define XB_XGEN(j)  (2304 + 64 * (j))
#define XB_TOP      3328
#define XB_TOPGEN   3392
#define XCD_BAR_WORDS 3456
#define XB_SPIN_CAP (1u << 18)
__device__ __forceinline__ unsigned xb_ld(unsigned* p)              { return __hip_atomic_load(p, __ATOMIC_RELAXED, __HIP_MEMORY_SCOPE_AGENT); }
__device__ __forceinline__ unsigned xb_add(unsigned* p, unsigned v) { return __hip_atomic_fetch_add(p, v, __ATOMIC_RELAXED, __HIP_MEMORY_SCOPE_AGENT); }
__device__ __forceinline__ unsigned xb_xcc_id() { return (unsigned)__builtin_amdgcn_s_getreg((3 << 11) | 20) & 0xFu; }
#define XB_SPIN(cond, bar) do { unsigned _sp = 0; while (cond) { __builtin_amdgcn_s_sleep(1); \
    if ((++_sp & 255u) == 0u) { if (xb_ld(&(bar)[XB_TMO])) break; if (_sp > XB_SPIN_CAP) { atomicAdd(&(bar)[XB_TMO], 1u); break; } } } } while (0)
struct XcdBarrier { unsigned* bar; unsigned x; volatile LAS unsigned* st; };
__device__ __forceinline__ XcdBarrier xcd_barrier_post(unsigned* bar, volatile LAS unsigned* st) {
    XcdBarrier b; b.bar = bar; b.x = xb_xcc_id(); b.st = st;
    if (threadIdx.x == 0) (void)xb_add(&bar[XB_XCNT(b.x)], 1u);
    return b;
}
__device__ __forceinline__ void xcd_barrier_complete(unsigned* bar, unsigned x, unsigned& nloc, unsigned& nx) {
    const unsigned G = gridDim.x * gridDim.y * gridDim.z;
    unsigned sum, cnt, mine, sp = 0u;
    for (;;) {
        sum = 0u; cnt = 0u; mine = 0u;
#pragma unroll 1
        for (unsigned j = 0; j < 16; ++j) { const unsigned c = xb_ld(&bar[XB_XCNT(j)]); sum += c; cnt += (c > 0u) ? 1u : 0u; mine = (j == x) ? c : mine; }
        if (sum == G) break;
        __builtin_amdgcn_s_sleep(1);
        if ((++sp & 255u) == 0u) { if (xb_ld(&bar[XB_TMO])) break; if (sp > XB_SPIN_CAP) { atomicAdd(&bar[XB_TMO], 1u); break; } }
    }
    nloc = mine > 0u ? mine : 1u; nx = cnt > 0u ? cnt : 1u;
}
__device__ __forceinline__ void xcd_barrier(const XcdBarrier& b) {
    asm volatile("s_waitcnt vmcnt(0)" ::: "memory");
    __syncthreads();
    if (threadIdx.x == 0) {
        unsigned* bar = b.bar;
        __builtin_amdgcn_s_waitcnt(0);
        unsigned nloc = b.st[0], nx = b.st[1];
        if (nloc == 0u) { xcd_barrier_complete(bar, b.x, nloc, nx); b.st[0] = nloc; b.st[1] = nx; }
        const unsigned old = xb_add(&bar[XB_XSUB(b.x)], 1u);
        const unsigned gen = old / nloc;
        if (old + 1u == (gen + 1u) * nloc) {
            __builtin_amdgcn_fence(__ATOMIC_RELEASE, "agent");
            asm volatile("s_waitcnt vmcnt(0)" ::: "memory");
            const unsigned og = xb_add(&bar[XB_TOP], 1u);
            const unsigned tg = og / nx;
            if (og + 1u == (tg + 1u) * nx) xb_add(&bar[XB_TOPGEN], 1u);
            else XB_SPIN(xb_ld(&bar[XB_TOPGEN]) == tg, bar);
            __builtin_amdgcn_fence(__ATOMIC_ACQUIRE, "agent");
            xb_add(&bar[XB_XGEN(b.x)], 1u);
            asm volatile("s_waitcnt vmcnt(0)" ::: "memory");
        } else {
            XB_SPIN(xb_ld(&bar[XB_XGEN(b.x)]) == gen, bar);
            __builtin_amdgcn_fence(__ATOMIC_ACQUIRE, "agent");
            asm volatile("s_waitcnt vmcnt(0)" ::: "memory");
        }
    }
    __syncthreads();
}

DI int TID() { int t = threadIdx.x; asm volatile("" : "+v"(t)); return t; }
DI int BID() { int b = blockIdx.x; asm volatile("" : "+s"(b)); return b; }

namespace pg8 {
constexpr int BM = 256, BK = 64, HALF = 128, HTB = HALF * BK * 2, STAGE_BYTES = 8 * HTB, NXCD = 8, WGM = 8;
DI int lds_byte(int r, int c) { const int st = (r >> 4) * 2 + (c >> 5), rr = r & 15, cc = c & 31, ob = rr * 64 + cc * 2; return st * 1024 + (ob ^ (((ob >> 9) & 1) << 5)); }
DI void stage_rc(int b, int& R, int& C) { const int st = b / 1024, sb = b % 1024, swz = sb ^ (((sb >> 9) & 1) << 5); R = (st >> 1) * 16 + swz / 64; C = (st & 1) * 32 + (swz % 64) / 2; }
struct Unit { int pm, pn, z; };

DI bool order_xcd(int nM, int nN, int G, int c, int i, Unit& u) {
    const int nwg = nM * nN; const long L = (long)i * G + c; if (L >= nwg) return false;
    int wgid = (int)L; { const int q = nwg / NXCD, r = nwg % NXCD, xcd = wgid % NXCD, off = wgid / NXCD; wgid = (xcd < r ? xcd * (q + 1) : r * (q + 1) + (xcd - r) * q) + off; }
    const int nig = WGM * nN, gid = wgid / nig, fm = gid * WGM, gsz = (nM - fm) < WGM ? (nM - fm) : WGM;
    u.pm = fm + ((wgid % nig) % gsz); u.pn = (wgid % nig) / gsz; u.z = 0; return true;
}

template <class Epi, class Sched, bool HALFN = false>
DI void gemm_phase(LAS unsigned char* lds, const int K, const Sched& S, const Epi& E) {
    const int tid = TID(), wid = __builtin_amdgcn_readfirstlane(tid >> 6), lane = tid & 63, wr = wid >> 2, wc = wid & 3, fr = lane & 15, fq = lane >> 4;
    const int nt = K / BK;
    unsigned voffA[2];
#pragma unroll
    for (int i = 0; i < 2; ++i) { int R, C; stage_rc(tid * 16 + i * 8192, R, C); voffA[i] = (unsigned)(R * K + C) * 2u; }
    const size_t kstep = (size_t)(BK * 2);
    const size_t hstep = (size_t)HALF * K * 2;
    const unsigned ldsw = (unsigned)wid * 1024u;
    const int aoff = lds_byte(wr * 64 + fr, fq * 8), boff = lds_byte(wc * 32 + fr, fq * 8);
#define PG8_SA(b, h) (((b) * 2 + (h)) * HTB)
#define PG8_SB(b, h) ((4 + (b) * 2 + (h)) * HTB)
#define PG8_STAGE(bufoff, gbase) do { _Pragma("unroll") for (int _i = 0; _i < 2; ++_i) \
        __builtin_amdgcn_global_load_lds((const unsigned*)((const char*)(gbase) + voffA[_i]), (LAS unsigned*)(lds + (bufoff) + ldsw + _i * 8192), 16, 0, 0); } while (0)
#define PG8_LDA(dst, b, h) do { _Pragma("unroll") for (int m = 0; m < 4; ++m) _Pragma("unroll") for (int k = 0; k < 2; ++k) dst[m][k] = *(const LAS bf16x8*)(lds + PG8_SA(b, h) + aoff + m * 2048 + k * 1024); } while (0)
#define PG8_LDB(dst, b, h) do { _Pragma("unroll") for (int n = 0; n < 2; ++n) _Pragma("unroll") for (int k = 0; k < 2; ++k) dst[n][k] = *(const LAS bf16x8*)(lds + PG8_SB(b, h) + boff + n * 2048 + k * 1024); } while (0)
#define PG8_MMA(ai, bj, At, Bt) do { __builtin_amdgcn_s_setprio(1); _Pragma("unroll") for (int m = 0; m < 4; ++m) _Pragma("unroll") for (int n = 0; n < 2; ++n) _Pragma("unroll") for (int k = 0; k < 2; ++k) \
        acc[ai][bj][m][n] = __builtin_amdgcn_mfma_f32_16x16x32_bf16(Bt[n][k], At[m][k], acc[ai][bj][m][n], 0, 0, 0); __builtin_amdgcn_s_setprio(0); } while (0)
#define PG8_WAIT_V(n) asm volatile("s_waitcnt vmcnt(" #n ")" ::: "memory")
#define PG8_WAIT_L(n) asm volatile("s_waitcnt lgkmcnt(" #n ")" ::: "memory")
#define PG8_BAR __builtin_amdgcn_s_barrier()
#define PG8_SCHED __builtin_amdgcn_sched_barrier(0)
    Unit cur, nxt; int ui = 0;
    if (!S.next(0, cur)) return;
    f32x4 acc[2][2][4][2];
#pragma unroll
    for (int a = 0; a < 2; ++a)
#pragma unroll
        for (int b = 0; b < 2; ++b)
#pragma unroll
            for (int m = 0; m < 4; ++m)
#pragma unroll
                for (int n = 0; n < 2; ++n) acc[a][b][m][n] = (f32x4){0.f, 0.f, 0.f, 0.f};
    bf16x8 At[4][2], B0[2][2], B1[2][2];
    const char* cA = S.aptr(cur); const char* cB = S.bptr(cur);
    PG8_STAGE(PG8_SB(0, 0), cB); PG8_STAGE(PG8_SA(0, 0), cA); PG8_STAGE(PG8_SB(0, 1), cB + hstep); PG8_STAGE(PG8_SA(0, 1), cA + hstep);
    if (wr == 1) PG8_BAR;
    PG8_WAIT_V(4); PG8_BAR;
    PG8_STAGE(PG8_SB(1, 0), cB + kstep); PG8_STAGE(PG8_SA(1, 0), cA + kstep); PG8_STAGE(PG8_SB(1, 1), cB + hstep + kstep);
    PG8_WAIT_V(6); PG8_BAR;
    for (;;) {
        const bool has_next = S.next(ui + 1, nxt);
        const char* nA = has_next ? S.aptr(nxt) : cA; const char* nB = has_next ? S.bptr(nxt) : cB;
#pragma unroll 1
        for (int t = 0; t < nt; t += 2) {
            const bool last = (t == nt - 2);
            const char* a1 = cA + (size_t)(t + 1) * kstep;
            const char* a2 = last ? nA : cA + (size_t)(t + 2) * kstep; const char* b2 = last ? nB : cB + (size_t)(t + 2) * kstep;
            const char* a3 = a2 + kstep; const char* b3 = b2 + kstep;
            PG8_LDB(B0, 0, 0); PG8_SCHED; PG8_LDA(At, 0, 0); PG8_STAGE(PG8_SA(1, 1), a1 + hstep);
            PG8_WAIT_L(8); PG8_BAR; PG8_WAIT_L(0); PG8_MMA(0, 0, At, B0); PG8_BAR; PG8_SCHED;
            PG8_LDB(B1, 0, 1); PG8_STAGE(PG8_SB(0, 0), b2);
            PG8_BAR; PG8_WAIT_L(0); if (!HALFN) PG8_MMA(0, 1, At, B1); PG8_BAR;
            PG8_LDA(At, 0, 1); PG8_STAGE(PG8_SA(0, 0), a2);
            PG8_BAR; PG8_WAIT_L(0); PG8_MMA(1, 0, At, B0); PG8_BAR; PG8_SCHED;
            PG8_STAGE(PG8_SB(0, 1), b2 + hstep);
            PG8_WAIT_V(6); PG8_BAR; if (!HALFN) PG8_MMA(1, 1, At, B1); PG8_BAR;
            PG8_LDB(B0, 1, 0); PG8_SCHED; PG8_LDA(At, 1, 0); PG8_STAGE(PG8_SA(0, 1), a2 + hstep);
            PG8_WAIT_L(8); PG8_BAR; PG8_WAIT_L(0); PG8_MMA(0, 0, At, B0); PG8_BAR; PG8_SCHED;
            PG8_LDB(B1, 1, 1); PG8_STAGE(PG8_SB(1, 0), b3);
            PG8_BAR; PG8_WAIT_L(0); if (!HALFN) PG8_MMA(0, 1, At, B1); PG8_BAR;
            PG8_LDA(At, 1, 1); PG8_STAGE(PG8_SA(1, 0), a3);
            PG8_BAR; PG8_WAIT_L(0); PG8_MMA(1, 0, At, B0); PG8_BAR; PG8_SCHED;
            PG8_STAGE(PG8_SB(1, 1), b3 + hstep);
            PG8_WAIT_V(6); PG8_BAR; if (!HALFN) PG8_MMA(1, 1, At, B1); PG8_BAR;
        }
        { int tz = TID(); asm volatile("" : "+v"(tz));
          const int wz = __builtin_amdgcn_readfirstlane(tz >> 6), lz = tz & 63; E(acc, cur, wz >> 2, wz & 3, lz & 15, lz >> 4); }
        if (!has_next) break;
#pragma unroll
        for (int a = 0; a < 2; ++a)
#pragma unroll
            for (int b = 0; b < (HALFN ? 1 : 2); ++b)
#pragma unroll
                for (int m = 0; m < 4; ++m)
#pragma unroll
                    for (int n = 0; n < 2; ++n) acc[a][b][m][n] = (f32x4){0.f, 0.f, 0.f, 0.f};
        cur = nxt; cA = nA; cB = nB; ++ui;
    }
    PG8_WAIT_V(0);
    if (wr == 0) PG8_BAR;
    PG8_BAR;
#undef PG8_SA
#undef PG8_SB
#undef PG8_STAGE
#undef PG8_LDA
#undef PG8_LDB
#undef PG8_MMA
#undef PG8_WAIT_V
#undef PG8_WAIT_L
#undef PG8_BAR
#undef PG8_SCHED
}
}
using pg8::Unit;
typedef f32x4 AccT[2][2][4][2];

struct Params {
    const float* in[26];
    float* out;
    unsigned char* ws;
    int ph_lo, ph_hi;
};
enum { I_X = 0, I_WIN, I_NMIX, I_NFFN, I_QKN, I_REL, I_MU, I_W0, I_W2, I_A0, I_A2, I_G2, I_KK, I_KA, I_RK, I_LNW, I_LNB, I_V0, I_VA, I_VB, I_KVN, I_KVUP, I_WBR, I_WO, I_F1, I_F2 };

DI const Params* KP() { auto k = __builtin_amdgcn_kernarg_segment_ptr(); asm volatile("" : "+s"(k)); return (const Params*)k; }
template <class T> DI T* wsp(size_t off) { return (T*)(KP()->ws + off); }

DI int wide_col(int x) { const int pi = x & 255; return (x & ~255) + 64 * ((pi >> 5) & 3) + 16 * ((pi >> 2) & 3) + 8 * (pi >> 7) + 4 * ((pi >> 4) & 1) + (pi & 3); }
template <int MAP> DI int colmap(int r) {
    if (MAP == 0) {
        if (r < 512) return C_MK + wide_col(r);
        if (r < 768) return C_DS + 512 + wide_col(r - 512);
        const int a = wide_col(r - 768);
        if (a < 32) return C_DS + 1024 + a;
        if (a < 40) return C_DS + 1056 + (a - 32);
        if (a >= 64 && a < 96) return C_RW + 1792 + (a - 64);
        return -1;
    }
    if (MAP == 1) return C_MV + r;
    if (MAP == 2) {
        if (r < 512) return C_MQ + wide_col(r);
        if (r < 1024) return C_DS + wide_col(r - 512);
        if (r < 1280) return C_DS + 768 + wide_col(r - 1024);
        if (r < 3072) return C_RW + wide_col(r - 1280);
        return C_GT + wide_col(r - 3072);
    }
    if (MAP == 3) return wide_col(r);
    if (MAP == 4) return 512 + r;
    if (MAP == 5) return wide_col(r);
    if (MAP == 6) { const int pn = r >> 8, pi = r & 255;
        return ((pi >> 7) ? DFF : 0) + 128 * pn + 32 * ((pi >> 5) & 3) + 8 * ((pi >> 2) & 3) + 4 * ((pi >> 4) & 1) + (pi & 3); }
    return -1;
}
template <int MAP> DI void conv_t(LAS float* sm, bf16_t* dst, int nrows, int K, const float* src, int ld) {
    const int tid = TID(), tx = tid & 63, ty = tid >> 6;
    const int ntr = nrows / 64, ntk = K / 64, ntiles = ntr * ntk;
    for (int t = BID(); t < ntiles; t += gridDim.x) {
        const int r0 = (t / ntk) * 64, k0 = (t % ntk) * 64;
        const int col = colmap<MAP>(r0 + tx);
#pragma unroll
        for (int i = 0; i < 8; ++i) { const int kl = ty + 8 * i; sm[kl * 65 + tx] = (col >= 0) ? src[(size_t)(k0 + kl) * ld + col] : 0.f; }
        __syncthreads();
#pragma unroll
        for (int i = 0; i < 8; ++i) { const int rl = ty + 8 * i; dst[(size_t)(r0 + rl) * K + k0 + tx] = f2bf(sm[tx * 65 + rl]); }
        __syncthreads();
    }
}
DI void conv_lora(int l) {
    bf16_t* dst = wsp<bf16_t>(WS_WL);
    const float* w2 = KP()->in[I_W2] + (size_t)l * 64 * 512; const float* a2 = KP()->in[I_A2] + (size_t)l * 64 * 512; const float* g2 = KP()->in[I_G2] + (size_t)l * 160 * 512;
    const float* va = KP()->in[I_VA]; const float* vb = KP()->in[I_VB];
    const int n = 2048 * 512;
    for (int e = BID() * 512 + TID(); e < n; e += gridDim.x * 512) {
        const int r = wide_col(e >> 9), k = e & 511; float v = 0.f;
        if (r < 512) { if (k < 64) v = w2[k * 512 + r]; }
        else if (r < 1024) { if (k >= 64 && k < 128) v = a2[(k - 64) * 512 + (r - 512)]; }
        else if (r < 1536) { if (k >= 128 && k < 288) v = g2[(k - 128) * 512 + (r - 1024)]; }
        else if (l == 1) { const int c = r - 1536; float s = 0.f;
#pragma unroll 8
            for (int j = 0; j < 32; ++j) s += va[k * 32 + j] * vb[j * 512 + c];
            v = s; }
        dst[e] = f2bf(v);
    }
}
DI void phase_conv(int l, LAS float* sm) {
    const float* win = KP()->in[I_WIN] + (size_t)l * DM * D_IN;
    conv_t<0>(sm, wsp<bf16_t>(WS_WB), 1024, 1024, win, D_IN);
    conv_t<1>(sm, wsp<bf16_t>(WS_WV), 512, 1024, win, D_IN);
    conv_t<2>(sm, wsp<bf16_t>(WS_WD1), 6144, 1024, win, D_IN);
    const float* kvup = KP()->in[I_KVUP] + (size_t)l * 256 * 1024;
    conv_t<3>(sm, wsp<bf16_t>(WS_WKVK), 512, 256, kvup, 1024);
    conv_t<4>(sm, wsp<bf16_t>(WS_WKVV), 512, 256, kvup, 1024);
    for (int i = 0; i < 3; ++i) conv_t<5>(sm, wsp<bf16_t>(WS_WBR) + (size_t)i * 1024 * 512, 1024, 512, KP()->in[I_WBR] + ((size_t)l * 3 + i) * 512 * 1024, 1024);
    conv_t<5>(sm, wsp<bf16_t>(WS_WO), 1024, 1024, KP()->in[I_WO] + (size_t)l * 1024 * 1024, 1024);
    conv_t<6>(sm, wsp<bf16_t>(WS_WF1), 5632, 1024, KP()->in[I_F1] + (size_t)l * 1024 * 5632, 5632);
    conv_t<5>(sm, wsp<bf16_t>(WS_WF2), 1024, 2816, KP()->in[I_F2] + (size_t)l * 2816 * 1024, 1024);
    conv_lora(l);
}

DI void phase_norm(const float* x, const float* g, bf16_t* h) {
    const int lane = TID() & 63, gw = BID() * 8 + (TID() >> 6), nw = gridDim.x * 8;
    f32x4 gv[4];
#pragma unroll
    for (int i = 0; i < 4; ++i) gv[i] = ((const f32x4*)g)[lane + 64 * i];
    for (int row = gw; row < NT; row += nw) {
        const f32x4* xr = (const f32x4*)(x + (size_t)row * DM);
        f32x4 v[4]; float ss = 0.f;
#pragma unroll
        for (int i = 0; i < 4; ++i) { v[i] = xr[lane + 64 * i]; ss += v[i][0] * v[i][0] + v[i][1] * v[i][1] + v[i][2] * v[i][2] + v[i][3] * v[i][3]; }
        ss = wave_sum(ss);
        const float rs = __builtin_amdgcn_rsqf(ss * (1.f / DM) + NORM_EPS);
#pragma unroll
        for (int i = 0; i < 4; ++i) {
            u32x2 o; o[0] = pk2(v[i][0] * rs * gv[i][0], v[i][1] * rs * gv[i][1]); o[1] = pk2(v[i][2] * rs * gv[i][2], v[i][3] * rs * gv[i][3]);
            *(u32x2*)(h + (size_t)row * DM + 4 * (lane + 64 * i)) = o;
        }
    }
}

struct SchedLin {
    int nM, nN, G, c; unsigned aoff, boff, a2off; int rowbytes, amode, cbase, pn2;
    DI bool next(int i, Unit& u) const { return pg8::order_xcd(nM, nN, G, c, i, u); }
    DI const char* aptr(const Unit& u) const { const int row0 = amode ? ((u.pm >> 1) * SEQ + cbase + (u.pm & 1) * 256) : u.pm * 256; return (const char*)KP()->ws + ((u.pn >= pn2) ? a2off : aoff) + (size_t)row0 * rowbytes; }
    DI const char* bptr(const Unit& u) const { return (const char*)KP()->ws + boff + (size_t)u.pn * 256 * rowbytes; }
};
DI SchedLin mk_sched(int nM, int nN, size_t aoff, size_t boff, int K, int amode = 0, int cbase = 0, size_t a2off = 0, int pn2 = 1 << 30) {
    SchedLin s; s.nM = nM; s.nN = nN; s.G = gridDim.x; s.c = BID(); s.aoff = (unsigned)aoff; s.boff = (unsigned)boff; s.rowbytes = K * 2; s.amode = amode; s.cbase = cbase; s.a2off = (unsigned)a2off; s.pn2 = pn2; return s;
}
struct SchedMerge {
    int G, c;
    DI bool next(int i, Unit& u) const { const int z = i % 3, tile = (i / 3) * G + c; if (tile >= 256) return false; u.pm = tile >> 2; u.pn = tile & 3; u.z = z; return true; }
    DI const char* aptr(const Unit& u) const { return (const char*)KP()->ws + (u.z == 0 ? WS_MQ : (u.z == 1 ? WS_ORW : WS_DQ)) + (size_t)(u.pm >> 5) * PAR_O + (size_t)(u.pm & 31) * 256 * 1024; }
    DI const char* bptr(const Unit& u) const { return (const char*)KP()->ws + WS_WBR + (size_t)u.z * (1024 * 512 * 2) + (size_t)u.pn * 256 * 1024; }
};

DI void st_bf4(bf16_t* p, f32x4 v) { u32x2 o; o[0] = pk2(v[0], v[1]); o[1] = pk2(v[2], v[3]); *(u32x2*)p = o; }
DI f32x4 ld_bf4(const bf16_t* p) { const u32x2 u = *(const u32x2*)p; return (f32x4){bflo(u[0]), bfhi(u[0]), bflo(u[1]), bfhi(u[1])}; }
#define EPI_ROWS(ai, m) (128 * (ai) + 64 * wr + 16 * (m) + fr)
#define EPI_COLS(bj, n) (64 * wc + 16 * fq + 8 * (bj) + 4 * (n))
#define EPI_COLS_T(bj, n) (128 * (bj) + 32 * wc + 16 * (n) + 4 * fq)
#define FOR_AM _Pragma("unroll") for (int ai = 0; ai < 2; ++ai) _Pragma("unroll") for (int m = 0; m < 4; ++m)
#define FOR_BN _Pragma("unroll") for (int bj = 0; bj < 2; ++bj) _Pragma("unroll") for (int n = 0; n < 2; ++n)

DI void epi_headnorm(const AccT& acc, bf16_t* out, int ld, const float* gain, int wr, int wc, int fr, int fq) {
    f32x4 gv[2][2];
    FOR_BN gv[bj][n] = *(const f32x4*)(gain + 16 * fq + 8 * bj + 4 * n);
    FOR_AM {
        float ss = 0.f;
        FOR_BN { const f32x4 a = acc[ai][bj][m][n]; ss += a[0] * a[0] + a[1] * a[1] + a[2] * a[2] + a[3] * a[3]; }
        ss += __shfl_xor(ss, 16); ss += __shfl_xor(ss, 32);
        const float sc = __builtin_amdgcn_rsqf(ss * (1.f / 64.f) + NORM_EPS);
        bf16_t* rp = out + (size_t)EPI_ROWS(ai, m) * ld;
        FOR_BN st_bf4(rp + EPI_COLS(bj, n), acc[ai][bj][m][n] * sc * gv[bj][n]);
    }
}
DI void epi_store_bf16(const AccT& acc, bf16_t* out, int ld, int wr, int wc, int fr, int fq) {
    FOR_AM { bf16_t* rp = out + (size_t)EPI_ROWS(ai, m) * ld; FOR_BN st_bf4(rp + EPI_COLS(bj, n), acc[ai][bj][m][n]); }
}

struct EpiB {
    int l;
    DI void operator()(const AccT& acc, const Unit& u, int wr, int wc, int fr, int fq) const {
        const size_t row0 = (size_t)u.pm * 256;
        if (u.pn < 2) epi_headnorm(acc, wsp<bf16_t>(WS_MK) + row0 * 512 + u.pn * 256, 512, KP()->in[I_QKN] + l * 256 + 64, wr, wc, fr, fq);
        else if (u.pn == 2) epi_store_bf16(acc, wsp<bf16_t>(WS_DCN) + row0 * 256, 256, wr, wc, fr, fq);
        else {
            bf16_t* idxk = wsp<bf16_t>(WS_IDXK); float* idxw = wsp<float>(WS_IDXW); bf16_t* left = wsp<bf16_t>(WS_LEFT);
            FOR_AM { const size_t row = row0 + EPI_ROWS(ai, m);
                if (wc == 0 && fq < 2) { FOR_BN st_bf4(idxk + row * 32 + 16 * fq + 8 * bj + 4 * n, acc[ai][bj][m][n]); }
                else if (wc == 0 && fq == 2) { *(f32x4*)(idxw + row * 8) = acc[ai][0][m][0]; *(f32x4*)(idxw + row * 8 + 4) = acc[ai][0][m][1]; }
                else if (wc == 1 && fq < 2) { FOR_BN st_bf4(left + row * 32 + 16 * fq + 8 * bj + 4 * n, acc[ai][bj][m][n]); }
            }
        }
    }
};
struct EpiVt {
    unsigned off;
    DI void operator()(const AccT& acc, const Unit& u, int wr, int wc, int fr, int fq) const {
        bf16_t* vt = wsp<bf16_t>(off);
        const int b = u.pn >> 3, s0 = (u.pn & 7) * 256;
        FOR_AM { bf16_t* rp = vt + ((size_t)b * 512 + u.pm * 256 + EPI_ROWS(ai, m)) * SEQ + s0; FOR_BN st_bf4(rp + EPI_COLS_T(bj, n), acc[ai][bj][m][n]); }
    }
};
struct EpiHN {
    int l;
    DI void operator()(const AccT& acc, const Unit& u, int wr, int wc, int fr, int fq) const { epi_headnorm(acc, wsp<bf16_t>(WS_DK) + (size_t)u.pm * 256 * 512 + u.pn * 256, 512, KP()->in[I_QKN] + l * 256 + 192, wr, wc, fr, fq); }
};
struct EpiD1 {
    int l, par;
    DI void operator()(const AccT& acc, const Unit& u, int wr, int wc, int fr, int fq) const {
        const size_t row0 = (size_t)u.pm * 256;
        if (u.pn < 2) epi_headnorm(acc, wsp<bf16_t>(WS_MQ + par * PAR_O) + row0 * 512 + u.pn * 256, 512, KP()->in[I_QKN] + l * 256, wr, wc, fr, fq);
        else if (u.pn < 4) epi_headnorm(acc, wsp<bf16_t>(WS_DQ + par * PAR_O) + row0 * 512 + (u.pn - 2) * 256, 512, KP()->in[I_QKN] + l * 256 + 128, wr, wc, fr, fq);
        else if (u.pn == 4) epi_store_bf16(acc, wsp<bf16_t>(WS_IDXQ) + row0 * 256, 256, wr, wc, fr, fq);
        else if (u.pn < 12) epi_store_bf16(acc, wsp<bf16_t>(WS_RAW) + row0 * RAWLD + (u.pn - 5) * 256, RAWLD, wr, wc, fr, fq);
        else {
            unsigned char* o = wsp<unsigned char>(WS_GATES + par * PAR_G) + row0 * 3072 + (u.pn - 12) * 256;
            FOR_AM { unsigned char* rp = o + (size_t)EPI_ROWS(ai, m) * 3072;
                FOR_BN { const f32x4 a = acc[ai][bj][m][n];
                    const unsigned q0 = (unsigned)(fsigmoid(a[0]) * 255.f + 0.5f), q1 = (unsigned)(fsigmoid(a[1]) * 255.f + 0.5f), q2 = (unsigned)(fsigmoid(a[2]) * 255.f + 0.5f), q3 = (unsigned)(fsigmoid(a[3]) * 255.f + 0.5f);
                    *(unsigned*)(rp + EPI_COLS(bj, n)) = q0 | (q1 << 8) | (q2 << 16) | (q3 << 24); } }
        }
    }
};
struct EpiLora {
    int l, cbase;
    DI void operator()(const AccT& acc, const Unit& u, int wr, int wc, int fr, int fq) const {
        const size_t row0 = (size_t)u.pm * 256; const int kind = u.pn >> 1, cb = (u.pn & 1) * 256;
        if (kind == 0) {
            float* dec = wsp<float>(WS_DEC); const float* w0 = KP()->in[I_W0] + l * 512;
            FOR_AM { const size_t row = row0 + EPI_ROWS(ai, m);
                FOR_BN { const int col = cb + EPI_COLS(bj, n); const f32x4 a = acc[ai][bj][m][n]; const f32x4 wv = *(const f32x4*)(w0 + col); f32x4 d;
#pragma unroll
                    for (int e = 0; e < 4; ++e) { const float x = -(wv[e] + a[e]);
                        const float sp = fmaxf(x, 0.f) + __builtin_amdgcn_logf(1.f + fexp2(-fabsf(x) * LOG2E)) * 0.6931471805599453f;
                        const float w = -sp - 0.5f; d[e] = fexp2(-fexp2(w * LOG2E) * LOG2E); }
                    *(f32x4*)(dec + row * 512 + col) = d; } }
        } else if (kind == 1) {
            bf16_t* kf = wsp<bf16_t>(WS_KF); const bf16_t* kkb = wsp<bf16_t>(WS_KKB); bf16_t* bbb = wsp<bf16_t>(WS_BBB);
            const float* a0 = KP()->in[I_A0] + l * 512; const float* ka = KP()->in[I_KA] + l * 512;
            FOR_AM { const size_t row = row0 + EPI_ROWS(ai, m);
                f32x4 kp[2][2], kk[2][2];
                FOR_BN { const int col = cb + EPI_COLS(bj, n); kp[bj][n] = ld_bf4(kf + row * 512 + col); kk[bj][n] = ld_bf4(kkb + row * 512 + col); }
                FOR_BN { const int col = cb + EPI_COLS(bj, n); const f32x4 a = acc[ai][bj][m][n];
                    const f32x4 av = *(const f32x4*)(a0 + col), kav = *(const f32x4*)(ka + col); f32x4 ko, bo;
#pragma unroll
                    for (int e = 0; e < 4; ++e) { const float s = fsigmoid(av[e] + a[e]); ko[e] = kp[bj][n][e] * (1.f + (s - 1.f) * kav[e]); bo[e] = kk[bj][n][e] * s; }
                    st_bf4(kf + row * 512 + col, ko); st_bf4(bbb + row * 512 + col, bo); } }
        } else if (kind == 2) {
            epi_store_bf16(acc, wsp<bf16_t>(WS_GG) + row0 * 512 + cb, 512, wr, wc, fr, fq);
        } else {
            const bf16_t* vv = wsp<bf16_t>(WS_VV); bf16_t* v2 = wsp<bf16_t>(WS_V2); const bf16_t* vfirst = wsp<bf16_t>(WS_VFIRST); const float* v0 = KP()->in[I_V0];
            FOR_AM { const size_t row = row0 + EPI_ROWS(ai, m); const size_t arow = (size_t)(row >> 9) * SEQ + cbase + (row & 511);
                f32x4 vp[2][2], vf[2][2];
                FOR_BN { const int col = cb + EPI_COLS(bj, n); vp[bj][n] = ld_bf4(vv + row * 512 + col); vf[bj][n] = ld_bf4(vfirst + arow * 512 + col); }
                FOR_BN { const int col = cb + EPI_COLS(bj, n); const f32x4 a = acc[ai][bj][m][n]; const f32x4 v0v = *(const f32x4*)(v0 + col); f32x4 o;
#pragma unroll
                    for (int e = 0; e < 4; ++e) o[e] = vp[bj][n][e] + (vf[bj][n][e] - vp[bj][n][e]) * fsigmoid(v0v[e] + a[e]);
                    st_bf4(v2 + row * 512 + col, o); } }
        }
    }
};
struct EpiMerge {
    DI void operator()(const AccT& acc, const Unit& u, int wr, int wc, int fr, int fq) const {
        bf16_t* y = wsp<bf16_t>(WS_Y); const unsigned char* gates = wsp<unsigned char>(WS_GATES + (size_t)(u.pm >> 5) * PAR_G);
        const size_t row0 = (size_t)u.pm * 256, grow0 = (size_t)(u.pm & 31) * 256; const int c0 = u.pn * 256 + 64 * wc + 16 * fq, z = u.z;
#pragma unroll
        for (int ai = 0; ai < 2; ++ai)
#pragma unroll
            for (int mp = 0; mp < 2; ++mp) {
                u32x4 g[2]; u32x4 y0[2], y1[2];
#pragma unroll
                for (int mm = 0; mm < 2; ++mm) { const int rt = EPI_ROWS(ai, 2 * mp + mm);
                    g[mm] = *(const u32x4*)(gates + (grow0 + rt) * 3072 + z * 1024 + c0);
                    if (z > 0) { y0[mm] = *(const u32x4*)(y + (row0 + rt) * 1024 + c0); y1[mm] = *(const u32x4*)(y + (row0 + rt) * 1024 + c0 + 8); } }
#pragma unroll
                for (int mm = 0; mm < 2; ++mm) { const int m = 2 * mp + mm; const size_t row = row0 + EPI_ROWS(ai, m);
                    u32x4 o0, o1;
#pragma unroll
                    for (int bj = 0; bj < 2; ++bj)
#pragma unroll
                        for (int n = 0; n < 2; ++n) { const int q = 2 * bj + n; const unsigned gu = g[mm][q];
                            const f32x4 gf = (f32x4){(float)(gu & 255u), (float)((gu >> 8) & 255u), (float)((gu >> 16) & 255u), (float)(gu >> 24)} * (1.f / 255.f);
                            f32x4 v = acc[ai][bj][m][n] * gf;
                            if (z > 0) { const u32x4 yy = (q < 2) ? y0[mm] : y1[mm]; const unsigned ya = yy[2 * (q & 1)], yb = yy[2 * (q & 1) + 1]; v += (f32x4){bflo(ya), bfhi(ya), bflo(yb), bfhi(yb)}; }
                            const unsigned pa = pk2(v[0], v[1]), pb = pk2(v[2], v[3]);
                            if (q < 2) { o0[2 * q] = pa; o0[2 * q + 1] = pb; } else { o1[2 * (q - 2)] = pa; o1[2 * (q - 2) + 1] = pb; } }
                    *(u32x4*)(y + row * 1024 + c0) = o0; *(u32x4*)(y + row * 1024 + c0 + 8) = o1; }
            }
    }
};
struct EpiRes {
    int first, amode, cbase; unsigned dummy_off;
    DI void operator()(const AccT& acc, const Unit& u, int wr, int wc, int fr, int fq) const {
        float* out = KP()->out; const float* res = first ? KP()->in[I_X] : (const float*)out;
        if (dummy_off) out = wsp<float>(dummy_off);
        const size_t grow0 = amode == 2 ? ((size_t)((u.pm & 31) >> 1) * SEQ + cbase + (u.pm >> 5) * SC + (u.pm & 1) * 256) : (amode ? ((size_t)(u.pm >> 1) * SEQ + cbase + (u.pm & 1) * 256) : (size_t)u.pm * 256); const int c0 = u.pn * 256;
#pragma unroll
        for (int ai = 0; ai < 2; ++ai)
#pragma unroll
            for (int mp = 0; mp < 2; ++mp) {
                f32x4 rv[2][2][2];
#pragma unroll
                for (int mm = 0; mm < 2; ++mm) { const size_t row = grow0 + EPI_ROWS(ai, 2 * mp + mm); FOR_BN rv[mm][bj][n] = *(const f32x4*)(res + row * DM + c0 + EPI_COLS(bj, n)); }
#pragma unroll
                for (int mm = 0; mm < 2; ++mm) { const int m = 2 * mp + mm; const size_t row = grow0 + EPI_ROWS(ai, m); FOR_BN *(f32x4*)(out + row * DM + c0 + EPI_COLS(bj, n)) = rv[mm][bj][n] + acc[ai][bj][m][n]; }
            }
    }
};
struct EpiSwiglu {
    DI void operator()(const AccT& acc, const Unit& u, int wr, int wc, int fr, int fq) const {
        bf16_t* act = wsp<bf16_t>(WS_ACT);
        FOR_AM { bf16_t* rp = act + ((size_t)u.pm * 256 + EPI_ROWS(ai, m)) * DFF + u.pn * 128 + 32 * wc + 8 * fq;
            u32x4 w;
#pragma unroll
            for (int n = 0; n < 2; ++n) { const f32x4 g = acc[ai][0][m][n], up = acc[ai][1][m][n]; f32x4 o;
#pragma unroll
                for (int e = 0; e < 4; ++e) o[e] = g[e] * fsigmoid(g[e]) * up[e];
                w[2 * n] = pk2(o[0], o[1]); w[2 * n + 1] = pk2(o[2], o[3]); }
            *(u32x4*)rp = w; }
    }
};

DI void phase_dcn(int l) {
    const int lane = TID() & 63, gw = BID() * 8 + (TID() >> 6), nw = gridDim.x * 8;
    bf16_t* dcn = wsp<bf16_t>(WS_DCN);
    const f32x4 g = *(const f32x4*)(KP()->in[I_KVN] + l * 256 + 4 * lane);
    for (int row = gw; row < NT; row += nw) {
        bf16_t* rp = dcn + (size_t)row * 256 + 4 * lane;
        const f32x4 v = ld_bf4(rp);
        const float ss = wave_sum(v[0] * v[0] + v[1] * v[1] + v[2] * v[2] + v[3] * v[3]);
        const float rs = __builtin_amdgcn_rsqf(ss * (1.f / 256.f) + NORM_EPS);
        st_bf4(rp, v * rs * g);
    }
}
DI void phase_kmean() {
    const int lane = TID() & 63, gw = BID() * 8 + (TID() >> 6), nw = gridDim.x * 8;
    const bf16_t* mk = wsp<bf16_t>(WS_MK); float* km = wsp<float>(WS_KMEAN);
    for (int it = gw; it < NB * NH * 8; it += nw) {
        const int n = it & 7, h = (it >> 3) & 7, b = it >> 6;
        const bf16_t* kp = mk + ((size_t)b * SEQ + n * 256) * 512 + h * 64 + lane;
        float s0 = 0.f, s1 = 0.f, s2 = 0.f, s3 = 0.f;
        for (int k = 0; k < 256; k += 32) {
            bf16_t v[32];
#pragma unroll
            for (int j = 0; j < 32; ++j) v[j] = kp[(size_t)(k + j) * 512];
#pragma unroll
            for (int j = 0; j < 32; j += 4) { s0 += bf2f(v[j]); s1 += bf2f(v[j + 1]); s2 += bf2f(v[j + 2]); s3 += bf2f(v[j + 3]); }
        }
        km[(size_t)it * 64 + lane] = ((s0 + s1) + (s2 + s3)) * (1.f / 256.f);
    }
}

DI void phase_rwkv_prep(int l, int c) {
    const int lane = TID() & 63, gw = BID() * 8 + (TID() >> 6), nw = gridDim.x * 8;
    const bf16_t* raw = wsp<bf16_t>(WS_RAW); const bf16_t* left = wsp<bf16_t>(WS_LEFT); bf16_t* carry = wsp<bf16_t>(WS_CARRY);
    bf16_t* rr = wsp<bf16_t>(WS_RR); bf16_t* kf = wsp<bf16_t>(WS_KF); bf16_t* vv = wsp<bf16_t>(WS_VV); bf16_t* kkb = wsp<bf16_t>(WS_KKB);
    bf16_t* la = wsp<bf16_t>(WS_LORAA); bf16_t* vfirst = wsp<bf16_t>(WS_VFIRST);
    const float* mu = KP()->in[I_MU] + l * 1824; const float* kkw = KP()->in[I_KK] + l * 512;
    for (int rc = gw; rc < TC; rc += nw) {
        const int b = rc >> 9, sl = rc & 511, s = c * SC + sl; const size_t ra = (size_t)b * SEQ + s;
        const bf16_t* cur = raw + (size_t)rc * RAWLD;
        const bf16_t* prv = (sl > 0) ? (cur - RAWLD) : (carry + (size_t)((((c + 1) & 1) * 16) + b) * RAWLD);
        const bool hp = s > 0;
        auto mix8 = [&](int j, float* o) {
            const u32x4 cu = *(const u32x4*)(cur + j); u32x4 pu = {0u, 0u, 0u, 0u}; if (hp) pu = *(const u32x4*)(prv + j);
            const f32x4 m0 = *(const f32x4*)(mu + j), m1 = *(const f32x4*)(mu + j + 4);
#pragma unroll
            for (int e = 0; e < 4; ++e) { const float c0 = bflo(cu[e]), c1 = bfhi(cu[e]), p0 = bflo(pu[e]), p1 = bfhi(pu[e]);
                const float ma = (2 * e < 4) ? m0[2 * e] : m1[2 * e - 4], mb = (2 * e + 1 < 4) ? m0[2 * e + 1] : m1[2 * e + 1 - 4];
                o[2 * e] = c0 + (p0 - c0) * ma; o[2 * e + 1] = c1 + (p1 - c1) * mb; }
        };
        auto mix1 = [&](int j) -> float { const float c0 = bf2f(cur[j]); const float p0 = hp ? bf2f(prv[j]) : 0.f; return c0 + (p0 - c0) * mu[j]; };
        float o[8];
        mix8(8 * lane, o);
        { u32x4 w; w[0] = pk2(o[0], o[1]); w[1] = pk2(o[2], o[3]); w[2] = pk2(o[4], o[5]); w[3] = pk2(o[6], o[7]); *(u32x4*)(rr + (size_t)rc * 512 + 8 * lane) = w; }
        mix8(576 + 8 * lane, o);
        { u32x4 w; w[0] = pk2(o[0], o[1]); w[1] = pk2(o[2], o[3]); w[2] = pk2(o[4], o[5]); w[3] = pk2(o[6], o[7]); *(u32x4*)(kf + (size_t)rc * 512 + 8 * lane) = w;
          const f32x4 k0 = *(const f32x4*)(kkw + 8 * lane), k1 = *(const f32x4*)(kkw + 8 * lane + 4);
          float q[8]; float ss = 0.f;
#pragma unroll
          for (int e = 0; e < 8; ++e) { q[e] = o[e] * (e < 4 ? k0[e] : k1[e - 4]); ss += q[e] * q[e]; }
          ss += __shfl_xor(ss, 1); ss += __shfl_xor(ss, 2); ss += __shfl_xor(ss, 4);
          const float inv = 1.f / fmaxf(sqrtf(ss), 1e-12f);
          w[0] = pk2(q[0] * inv, q[1] * inv); w[1] = pk2(q[2] * inv, q[3] * inv); w[2] = pk2(q[4] * inv, q[5] * inv); w[3] = pk2(q[6] * inv, q[7] * inv);
          *(u32x4*)(kkb + (size_t)rc * 512 + 8 * lane) = w; }
        mix8(1088 + 8 * lane, o);
        { u32x4 w; w[0] = pk2(o[0], o[1]); w[1] = pk2(o[2], o[3]); w[2] = pk2(o[4], o[5]); w[3] = pk2(o[6], o[7]); *(u32x4*)(vv + (size_t)rc * 512 + 8 * lane) = w;
          if (l == 0) *(u32x4*)(vfirst + ra * 512 + 8 * lane) = w; }
        bf16_t* lr = la + (size_t)rc * 512;
        { const float x = mix1(512 + lane); const float t = fexp2(2.f * x * LOG2E); lr[lane] = f2bf(1.f - 2.f * frcp(t + 1.f)); }
        lr[64 + lane] = f2bf(mix1(1600 + lane));
        lr[128 + lane] = f2bf(fsigmoid(mix1(1664 + lane)));
        lr[192 + lane] = f2bf(fsigmoid(mix1(1728 + lane)));
        if (lane < 32) { const float c0 = bf2f(left[ra * 32 + lane]); const float p0 = hp ? bf2f(left[(ra - 1) * 32 + lane]) : 0.f;
            lr[256 + lane] = f2bf(fsigmoid(c0 + (p0 - c0) * mu[1792 + lane])); }
        if (lane < 56) *(u32x2*)(lr + 288 + 4 * lane) = (u32x2){0u, 0u};
        if (sl == SC - 1) { bf16_t* cp = carry + (size_t)(((c & 1) * 16) + b) * RAWLD;
            for (int j = lane; j < RAWLD / 8; j += 64) *(u32x4*)(cp + 8 * j) = *(const u32x4*)(cur + 8 * j); }
    }
}

DI float dpp_ror_add(float x, int) { return x; }
DI void reduce4(float p0, float p1, float p2, float p3, float& s0, float& s1, float& s2, float& s3) {
    auto r = __builtin_amdgcn_permlane32_swap(__float_as_uint(p0), __float_as_uint(p2), false, false);
    const float u0 = __uint_as_float(r[0]) + __uint_as_float(r[1]);
    r = __builtin_amdgcn_permlane32_swap(__float_as_uint(p1), __float_as_uint(p3), false, false);
    const float u1 = __uint_as_float(r[0]) + __uint_as_float(r[1]);
    r = __builtin_amdgcn_permlane16_swap(__float_as_uint(u0), __float_as_uint(u1), false, false);
    float w = __uint_as_float(r[0]) + __uint_as_float(r[1]);
    w += __uint_as_float(__builtin_amdgcn_update_dpp(0, __float_as_uint(w), 0x128, 0xf, 0xf, false));
    w += __uint_as_float(__builtin_amdgcn_update_dpp(0, __float_as_uint(w), 0x124, 0xf, 0xf, false));
    w += __uint_as_float(__builtin_amdgcn_update_dpp(0, __float_as_uint(w), 0x122, 0xf, 0xf, false));
    w += __uint_as_float(__builtin_amdgcn_update_dpp(0, __float_as_uint(w), 0x121, 0xf, 0xf, false));
    s0 = __uint_as_float(__builtin_amdgcn_readlane(__float_as_uint(w), 0));
    s1 = __uint_as_float(__builtin_amdgcn_readlane(__float_as_uint(w), 16));
    s2 = __uint_as_float(__builtin_amdgcn_readlane(__float_as_uint(w), 32));
    s3 = __uint_as_float(__builtin_amdgcn_readlane(__float_as_uint(w), 48));
}
DI void reduce8(float p0, float p1, float p2, float p3, float q0, float q1, float q2, float q3, float& pw, float& s0, float& s1, float& s2, float& s3) {
    auto r = __builtin_amdgcn_permlane32_swap(__float_as_uint(p0), __float_as_uint(p2), false, false);
    auto t = __builtin_amdgcn_permlane32_swap(__float_as_uint(q0), __float_as_uint(q2), false, false);
    const float u0 = __uint_as_float(r[0]) + __uint_as_float(r[1]);
    const float x0 = __uint_as_float(t[0]) + __uint_as_float(t[1]);
    r = __builtin_amdgcn_permlane32_swap(__float_as_uint(p1), __float_as_uint(p3), false, false);
    t = __builtin_amdgcn_permlane32_swap(__float_as_uint(q1), __float_as_uint(q3), false, false);
    const float u1 = __uint_as_float(r[0]) + __uint_as_float(r[1]);
    const float x1 = __uint_as_float(t[0]) + __uint_as_float(t[1]);
    r = __builtin_amdgcn_permlane16_swap(__float_as_uint(u0), __float_as_uint(u1), false, false);
    t = __builtin_amdgcn_permlane16_swap(__float_as_uint(x0), __float_as_uint(x1), false, false);
    float w = __uint_as_float(r[0]) + __uint_as_float(r[1]);
    float y = __uint_as_float(t[0]) + __uint_as_float(t[1]);
    w += __uint_as_float(__builtin_amdgcn_update_dpp(0, __float_as_uint(w), 0x128, 0xf, 0xf, false));
    y += __uint_as_float(__builtin_amdgcn_update_dpp(0, __float_as_uint(y), 0x128, 0xf, 0xf, false));
    w += __uint_as_float(__builtin_amdgcn_update_dpp(0, __float_as_uint(w), 0x124, 0xf, 0xf, false));
    y += __uint_as_float(__builtin_amdgcn_update_dpp(0, __float_as_uint(y), 0x124, 0xf, 0xf, false));
    w += __uint_as_float(__builtin_amdgcn_update_dpp(0, __float_as_uint(w), 0x122, 0xf, 0xf, false));
    y += __uint_as_float(__builtin_amdgcn_update_dpp(0, __float_as_uint(y), 0x122, 0xf, 0xf, false));
    w += __uint_as_float(__builtin_amdgcn_update_dpp(0, __float_as_uint(w), 0x121, 0xf, 0xf, false));
    y += __uint_as_float(__builtin_amdgcn_update_dpp(0, __float_as_uint(y), 0x121, 0xf, 0xf, false));
    pw = w;
    s0 = __uint_as_float(__builtin_amdgcn_readlane(__float_as_uint(y), 0));
    s1 = __uint_as_float(__builtin_amdgcn_readlane(__float_as_uint(y), 16));
    s2 = __uint_as_float(__builtin_amdgcn_readlane(__float_as_uint(y), 32));
    s3 = __uint_as_float(__builtin_amdgcn_readlane(__float_as_uint(y), 48));
}
struct ScanIn { bf16_t kk, bb, k, r, v; float w; };
DI void phase_scan(int l, int c, int dummy = 0) {
    const int lane = TID() & 63, gw = BID() * 8 + (TID() >> 6), nw = gridDim.x * 8;
    const bf16_t* kkb = wsp<bf16_t>(WS_KKB); const bf16_t* bbb = wsp<bf16_t>(WS_BBB); const bf16_t* kfb = wsp<bf16_t>(WS_KF); const bf16_t* rrb = wsp<bf16_t>(WS_RR);
    const bf16_t* vsb = wsp<bf16_t>(l == 0 ? WS_VV : WS_V2); const float* dec = wsp<float>(WS_DEC); float* outb = wsp<float>(WS_OUT); float* state = wsp<float>(WS_STATE);
    for (int item = gw; item < NB * NH * 16; item += nw) {
        const int bh = item >> 4, rg = item & 15, b = bh >> 3, h = bh & 7, i0 = rg * 4;
        float* stp = state + ((size_t)bh * 64 + i0) * 64 + lane;
        float S0 = 0.f, S1 = 0.f, S2 = 0.f, S3 = 0.f;
        if (c > 0) { S0 = stp[0]; S1 = stp[64]; S2 = stp[128]; S3 = stp[192]; }
        const size_t e0 = (size_t)b * SC * 512 + h * 64 + lane;
        const size_t ev = (size_t)b * SC * 512 + h * 64 + i0 + (lane & 3);
        float* op = outb + (size_t)b * SC * 512 + h * 64 + i0 + (lane >> 4);
        ScanIn A[8], B[8];
#define SCAN_LOAD(X, g) do { _Pragma("unroll") for (int j = 0; j < 8; ++j) { const size_t o = (size_t)((g) * 8 + j) * 512; \
            X[j].kk = kkb[e0 + o]; X[j].bb = bbb[e0 + o]; X[j].k = kfb[e0 + o]; X[j].r = rrb[e0 + o]; X[j].w = dec[e0 + o]; X[j].v = vsb[ev + o]; } } while (0)
#define SCAN_STEP1(Xj, kknext, t) do { \
            const float bb = bf2f(Xj.bb), kx = bf2f(Xj.k), rx = bf2f(Xj.r), wx = Xj.w; const unsigned vu = (unsigned)Xj.v << 16; \
            const float v0 = __uint_as_float(__builtin_amdgcn_readlane(vu, 0)), v1 = __uint_as_float(__builtin_amdgcn_readlane(vu, 1)), v2 = __uint_as_float(__builtin_amdgcn_readlane(vu, 2)), v3 = __uint_as_float(__builtin_amdgcn_readlane(vu, 3)); \
            S0 = S0 * wx + (v0 * kx - a0 * bb); S1 = S1 * wx + (v1 * kx - a1 * bb); S2 = S2 * wx + (v2 * kx - a2 * bb); S3 = S3 * wx + (v3 * kx - a3 * bb); \
            float ov; const float kn = (kknext); \
            reduce8(S0 * rx, S1 * rx, S2 * rx, S3 * rx, S0 * kn, S1 * kn, S2 * kn, S3 * kn, ov, a0, a1, a2, a3); \
            if ((lane & 15) == 0) op[(size_t)(t) * 512] = ov; } while (0)
#define SCAN_GROUP(X, Y, g, lastg) do { _Pragma("unroll") for (int j = 0; j < 8; ++j) { \
            const float kkn = (j < 7) ? bf2f(X[j < 7 ? j + 1 : 7].kk) : ((lastg) ? 0.f : bf2f(Y[0].kk)); \
            SCAN_STEP1(X[j], kkn, (g) * 8 + j); } } while (0)
        SCAN_LOAD(A, 0);
        float a0, a1, a2, a3;
        { const float k0 = bf2f(A[0].kk); reduce4(S0 * k0, S1 * k0, S2 * k0, S3 * k0, a0, a1, a2, a3); }
#if DBL_PHASE == 11
        if (dummy == 2) {
            float acc_ = 0.f;
            for (int g = 0; g < SC / 8; g += 2) {
                SCAN_LOAD(B, g + 1);
#pragma unroll
                for (int j = 0; j < 8; ++j) acc_ += bf2f(A[j].kk) + bf2f(A[j].bb) + bf2f(A[j].k) + bf2f(A[j].r) + bf2f(A[j].v) + A[j].w;
                if (g + 2 < SC / 8) SCAN_LOAD(A, g + 2);
#pragma unroll
                for (int j = 0; j < 8; ++j) acc_ += bf2f(B[j].kk) + bf2f(B[j].bb) + bf2f(B[j].k) + bf2f(B[j].r) + bf2f(B[j].v) + B[j].w;
            }
            if (acc_ == 12345.678f) stp[0] = acc_;
            continue;
        }
#endif
#if DBL_PHASE == 12
        if (dummy == 3) {
#pragma unroll
            for (int j = 0; j < 8; ++j) { A[j].kk = (bf16_t)(0x3c00 + lane + j); A[j].bb = (bf16_t)(0x3b00 + lane); A[j].k = (bf16_t)(0x3d00 + j); A[j].r = (bf16_t)(0x3e00 + lane); A[j].v = (bf16_t)(0x3c80 + j); A[j].w = 0.9f; B[j] = A[j]; }
            op = wsp<float>(WS_RAW) + (size_t)item * 4 + (lane >> 4);
            for (int g = 0; g < SC / 8; g += 2) {
                SCAN_GROUP(A, B, 0, false);
                SCAN_GROUP(B, A, 0, false);
            }
            if (S0 + S1 + S2 + S3 == 12345.678f) stp[0] = S0;
            continue;
        }
#endif
        for (int g = 0; g < SC / 8; g += 2) {
            SCAN_LOAD(B, g + 1);
            SCAN_GROUP(A, B, g, false);
            const bool last = (g + 2 >= SC / 8);
            if (!last) SCAN_LOAD(A, g + 2);
            SCAN_GROUP(B, A, g + 1, last);
        }
#undef SCAN_STEP1
#undef SCAN_GROUP
#undef SCAN_LOAD
        if (!dummy) { stp[0] = S0; stp[64] = S1; stp[128] = S2; stp[192] = S3; }
    }
}
typedef short s16x4 __attribute__((ext_vector_type(4)));
#define M16K32(a, b, c) __builtin_amdgcn_mfma_f32_16x16x32_bf16((a), (b), (c), 0, 0, 0)
#define M16K16(a, b, c) __builtin_amdgcn_mfma_f32_16x16x16bf16_1k((a), (b), (c), 0, 0, 0)
DI s16x4 pk4(f32x4 v) { u32x2 u; u[0] = pk2(v[0], v[1]); u[1] = pk2(v[2], v[3]); return __builtin_bit_cast(s16x4, u); }
DI float dpp_shr1(float x, float old) { return __uint_as_float(__builtin_amdgcn_update_dpp(__float_as_uint(old), __float_as_uint(x), 0x111, 0xf, 0xf, false)); }
DI float dpp_shr2(float x, float old) { return __uint_as_float(__builtin_amdgcn_update_dpp(__float_as_uint(old), __float_as_uint(x), 0x112, 0xf, 0xf, false)); }
DI float dpp_shr4(float x, float old) { return __uint_as_float(__builtin_amdgcn_update_dpp(__float_as_uint(old), __float_as_uint(x), 0x114, 0xf, 0xf, false)); }
DI float dpp_shr8(float x, float old) { return __uint_as_float(__builtin_amdgcn_update_dpp(__float_as_uint(old), __float_as_uint(x), 0x118, 0xf, 0xf, false)); }
DI float dpp_bcast15(float x) { return __uint_as_float(__builtin_amdgcn_update_dpp(0, __float_as_uint(x), 0x15F, 0xf, 0xf, false)); }
DI void phase_scan_chunked(int l, int c, LAS unsigned char* lds, bool dummy = false) {
    const int tid = TID(), lane = tid & 63, wave = tid >> 6, r16 = lane & 15, g = lane >> 4;
    if (wave >= 2) return;
    const int item = BID() * 2 + wave;
    if (item >= NB * NH * 4) return;
    const int bh = item >> 2, ig = item & 3, b = bh >> 3, h = bh & 7, i0 = 16 * ig;
    LAS unsigned char* wl = lds + wave * 4096;
    const bf16_t* kkb = wsp<bf16_t>(WS_KKB); const bf16_t* bbb = wsp<bf16_t>(WS_BBB); const bf16_t* kfb = wsp<bf16_t>(WS_KF); const bf16_t* rrb = wsp<bf16_t>(WS_RR);
    const bf16_t* vsb = wsp<bf16_t>(l == 0 ? WS_VV : WS_V2); const float* dec = wsp<float>(WS_DEC); float* outb = wsp<float>(WS_OUT);
    float* stp = wsp<float>(WS_STATE) + ((size_t)bh * 64 + i0 + r16) * 64 + 8 * g;
    f32x4 ST[4];
#pragma unroll
    for (int sg = 0; sg < 4; ++sg) ST[sg] = (c > 0) ? *(const f32x4*)(stp + 32 * (sg >> 1) + 4 * (sg & 1)) : (f32x4){0.f, 0.f, 0.f, 0.f};
    const size_t e0 = ((size_t)b * SC + r16) * 512 + h * 64 + 8 * g;
    const size_t ev = ((size_t)b * SC + 4 * g) * 512 + h * 64 + i0 + r16;
    const size_t eo = ((size_t)b * SC + 4 * g) * 512 + h * 64 + i0 + r16;
    u32x4 rk[2], rb[2], rq[2], rr_[2]; f32x4 rw[4]; bf16_t rv[4];
#define CS_LOAD(blk) do { const size_t o = e0 + (size_t)(blk) * 16 * 512; _Pragma("unroll") for (int s = 0; s < 2; ++s) { \
        rk[s] = *(const u32x4*)(kkb + o + 32 * s); rb[s] = *(const u32x4*)(bbb + o + 32 * s); rq[s] = *(const u32x4*)(kfb + o + 32 * s); rr_[s] = *(const u32x4*)(rrb + o + 32 * s); \
        rw[2 * s] = *(const f32x4*)(dec + o + 32 * s); rw[2 * s + 1] = *(const f32x4*)(dec + o + 32 * s + 4); } \
        _Pragma("unroll") for (int e = 0; e < 4; ++e) rv[e] = vsb[ev + (size_t)(blk) * 16 * 512 + (size_t)e * 512]; } while (0)
    CS_LOAD(0);
    for (int blk = 0; blk < SC / 16; ++blk) {
        float P[16], kap[16], bet[16], kq[16], rt[16];
#pragma unroll
        for (int s = 0; s < 2; ++s)
#pragma unroll
            for (int q = 0; q < 4; ++q) { const int i = 8 * s + 2 * q;
                kap[i] = bflo(rk[s][q]); kap[i + 1] = bfhi(rk[s][q]); bet[i] = bflo(rb[s][q]); bet[i + 1] = bfhi(rb[s][q]);
                kq[i] = bflo(rq[s][q]); kq[i + 1] = bfhi(rq[s][q]); rt[i] = bflo(rr_[s][q]); rt[i + 1] = bfhi(rr_[s][q]);
                P[i] = rw[2 * s + (q >> 1)][2 * (q & 1)]; P[i + 1] = rw[2 * s + (q >> 1)][2 * (q & 1) + 1]; }
        s16x4 Vb; { u32x2 u; u[0] = (unsigned)rv[0] | ((unsigned)rv[1] << 16); u[1] = (unsigned)rv[2] | ((unsigned)rv[3] << 16); Vb = __builtin_bit_cast(s16x4, u); }
        if (blk + 1 < SC / 16) CS_LOAD(blk + 1);
        float P16[16];
        bf16x8 ktp[2], btp[2], kqp[2], rtp[2];
#pragma unroll
        for (int i = 0; i < 16; ++i) { float p = P[i];
            p *= dpp_shr1(p, 1.f); p *= dpp_shr2(p, 1.f); p *= dpp_shr4(p, 1.f); p *= dpp_shr8(p, 1.f);
            const float pm1 = dpp_shr1(p, 1.f); const float inv = frcp(p); const float p16 = dpp_bcast15(p);
            P16[i] = p16; kap[i] *= pm1; bet[i] *= inv; kq[i] *= inv; rt[i] *= p; }
#pragma unroll
        for (int s = 0; s < 2; ++s) { u32x4 a, bb_, cc, dd;
#pragma unroll
            for (int q = 0; q < 4; ++q) { const int i = 8 * s + 2 * q; a[q] = pk2(kap[i], kap[i + 1]); bb_[q] = pk2(bet[i], bet[i + 1]); cc[q] = pk2(kq[i], kq[i + 1]); dd[q] = pk2(rt[i], rt[i + 1]); }
            ktp[s] = __builtin_bit_cast(bf16x8, a); btp[s] = __builtin_bit_cast(bf16x8, bb_); kqp[s] = __builtin_bit_cast(bf16x8, cc); rtp[s] = __builtin_bit_cast(bf16x8, dd); }
#pragma unroll
        for (int s = 0; s < 2; ++s)
#pragma unroll
            for (int hb = 0; hb < 2; ++hb) { const int i = 8 * s + 4 * hb; u32x2 uk, ub;
                uk[0] = pk2(kq[i] * P16[i], kq[i + 1] * P16[i + 1]); uk[1] = pk2(kq[i + 2] * P16[i + 2], kq[i + 3] * P16[i + 3]);
                ub[0] = pk2(bet[i] * P16[i], bet[i + 1] * P16[i + 1]); ub[1] = pk2(bet[i + 2] * P16[i + 2], bet[i + 3] * P16[i + 3]);
                const int off = r16 * 128 + (32 * s + 16 * hb + 4 * g) * 2;
                *(LAS u32x2*)(wl + off) = uk; *(LAS u32x2*)(wl + 2048 + off) = ub; }
        const f32x4 Z = {0.f, 0.f, 0.f, 0.f};
        f32x4 A1a = M16K32(btp[1], ktp[1], M16K32(btp[0], ktp[0], Z));
        f32x4 A1c = M16K32(ktp[1], btp[1], M16K32(ktp[0], btp[0], Z));
        f32x4 A2a = M16K32(kqp[1], ktp[1], M16K32(kqp[0], ktp[0], Z));
        f32x4 B1a = M16K32(btp[1], rtp[1], M16K32(btp[0], rtp[0], Z));
        f32x4 B2a = M16K32(kqp[1], rtp[1], M16K32(kqp[0], rtp[0], Z));
#pragma unroll
        for (int e = 0; e < 4; ++e) { const int s_ = 4 * g + e;
            A1a[e] = (s_ < r16) ? A1a[e] : 0.f; A2a[e] = (s_ < r16) ? A2a[e] : 0.f; A1c[e] = (r16 < s_) ? A1c[e] : 0.f;
            B1a[e] = (s_ <= r16) ? B1a[e] : 0.f; B2a[e] = (s_ <= r16) ? B2a[e] : 0.f; }
        const s16x4 a1a = pk4(A1a), a1c = pk4(A1c);
        const f32x4 M2a = M16K16(a1c, a1a, Z), M2c = M16K16(a1a, a1c, Z);
        const s16x4 m2a = pk4(M2a), m2c = pk4(M2c);
        const f32x4 M4a = M16K16(m2c, m2a, Z), M4c = M16K16(m2a, m2c, Z);
        const s16x4 m4a = pk4(M4a), m4c = pk4(M4c);
        const s16x4 m8a = pk4(M16K16(m4c, m4a, Z));
        s16x4 stb[4];
#pragma unroll
        for (int sg = 0; sg < 4; ++sg) stb[sg] = pk4(ST[sg]);
        f32x4 G = Z, G2 = Z;
#pragma unroll
        for (int sg = 0; sg < 4; ++sg) {
            const s16x4 kf_ = (sg & 1) ? __builtin_shufflevector(ktp[sg >> 1], ktp[sg >> 1], 4, 5, 6, 7) : __builtin_shufflevector(ktp[sg >> 1], ktp[sg >> 1], 0, 1, 2, 3);
            const s16x4 rf_ = (sg & 1) ? __builtin_shufflevector(rtp[sg >> 1], rtp[sg >> 1], 4, 5, 6, 7) : __builtin_shufflevector(rtp[sg >> 1], rtp[sg >> 1], 0, 1, 2, 3);
            G = M16K16(kf_, stb[sg], G); G2 = M16K16(rf_, stb[sg], G2); }
        const f32x4 RHS = M16K16(pk4(A2a), Vb, G);
        const f32x4 X1 = M16K16(m8a, pk4(RHS), RHS);
        const f32x4 X2 = M16K16(m4a, pk4(X1), X1);
        const f32x4 X3 = M16K16(m2a, pk4(X2), X2);
        const f32x4 U = M16K16(pk4(-A1a), pk4(X3), X3);
        const s16x4 un = pk4(-U);
        f32x4 O = M16K16(pk4(B2a), Vb, G2);
        O = M16K16(pk4(B1a), un, O);
        { float* op = outb + eo + (size_t)blk * 16 * 512;
#pragma unroll
          for (int e = 0; e < 4; ++e) op[(size_t)e * 512] = O[e]; }
#pragma unroll
        for (int sg = 0; sg < 4; ++sg) {
#pragma unroll
            for (int e = 0; e < 4; ++e) ST[sg][e] *= P16[8 * (sg >> 1) + 4 * (sg & 1) + e];
            const int toff = (4 * g + (r16 >> 2)) * 128 + 32 * sg + 8 * (r16 & 3);
            const s16x4 kh = __builtin_amdgcn_ds_read_tr16_b64_v4i16((LAS s16x4*)(wl + toff));
            const s16x4 bh_ = __builtin_amdgcn_ds_read_tr16_b64_v4i16((LAS s16x4*)(wl + 2048 + toff));
            ST[sg] = M16K16(kh, Vb, ST[sg]);
            ST[sg] = M16K16(bh_, un, ST[sg]);
        }
    }
#undef CS_LOAD
    if (dummy) return;
#pragma unroll
    for (int sg = 0; sg < 4; ++sg) *(f32x4*)(stp + 32 * (sg >> 1) + 4 * (sg & 1)) = ST[sg];
}
DI float sum8(float v) {
    v += __uint_as_float(__builtin_amdgcn_update_dpp(0, __float_as_uint(v), 0xB1, 0xf, 0xf, false));
    v += __uint_as_float(__builtin_amdgcn_update_dpp(0, __float_as_uint(v), 0x4E, 0xf, 0xf, false));
    v += __uint_as_float(__builtin_amdgcn_update_dpp(0, __float_as_uint(v), 0x141, 0xf, 0xf, false));
    return v;
}
DI void unpk8(const u32x4 u, float* f) {
#pragma unroll
    for (int q = 0; q < 4; ++q) { f[2 * q] = bflo(u[q]); f[2 * q + 1] = bfhi(u[q]); }
}
DI void phase_rwkv_post(int l, int par) {
    const int lane = TID() & 63, gw = BID() * 8 + (TID() >> 6), nw = gridDim.x * 8;
    const float* outb = wsp<float>(WS_OUT); const bf16_t* rrb = wsp<bf16_t>(WS_RR); const bf16_t* kfb = wsp<bf16_t>(WS_KF);
    const bf16_t* vsb = wsp<bf16_t>(l == 0 ? WS_VV : WS_V2); const bf16_t* ggb = wsp<bf16_t>(WS_GG); bf16_t* orw = wsp<bf16_t>(WS_ORW + par * PAR_O);
    float lw[8], lb[8], rkc[8];
    { const float* lnw = KP()->in[I_LNW] + l * 512 + 8 * lane; const float* lnb = KP()->in[I_LNB] + l * 512 + 8 * lane; const float* rk = KP()->in[I_RK] + l * 512 + 8 * lane;
#pragma unroll
      for (int e = 0; e < 8; ++e) { lw[e] = lnw[e]; lb[e] = lnb[e]; rkc[e] = rk[e]; } }
    for (int row = gw; row < TC; row += nw) {
        const size_t e0 = (size_t)row * 512 + 8 * lane;
        const f32x4 o0 = *(const f32x4*)(outb + e0), o1 = *(const f32x4*)(outb + e0 + 4);
        float o[8] = {o0[0], o0[1], o0[2], o0[3], o1[0], o1[1], o1[2], o1[3]}, r[8], k[8], v[8], g[8];
        unpk8(*(const u32x4*)(rrb + e0), r); unpk8(*(const u32x4*)(kfb + e0), k); unpk8(*(const u32x4*)(vsb + e0), v); unpk8(*(const u32x4*)(ggb + e0), g);
        float s = 0.f, bo = 0.f;
#pragma unroll
        for (int e = 0; e < 8; ++e) { s += o[e]; bo += r[e] * k[e] * rkc[e]; }
        const float mean = sum8(s) * (1.f / 64.f); const float bonus = sum8(bo);
        float q = 0.f;
#pragma unroll
        for (int e = 0; e < 8; ++e) { o[e] -= mean; q += o[e] * o[e]; }
        const float rs = __builtin_amdgcn_rsqf(sum8(q) * (1.f / 64.f) + 64e-5f);
        u32x4 w;
#pragma unroll
        for (int p = 0; p < 4; ++p) { float y0 = (o[2 * p] * rs * lw[2 * p] + lb[2 * p] + bonus * v[2 * p]) * g[2 * p], y1 = (o[2 * p + 1] * rs * lw[2 * p + 1] + lb[2 * p + 1] + bonus * v[2 * p + 1]) * g[2 * p + 1]; w[p] = pk2(y0, y1); }
        *(u32x4*)(orw + e0) = w;
    }
}

#define MFMA32(a, b, c) __builtin_amdgcn_mfma_f32_32x32x16_bf16((a), (b), (c), 0, 0, 0)
DI unsigned fkey(float v) { v = v + 0.f; const unsigned u = __float_as_uint(v); return (u & 0x80000000u) ? ~u : (u | 0x80000000u); }
DI int half_sum(int x) {
    x += __builtin_amdgcn_update_dpp(0, x, 0x128, 0xf, 0xf, false);
    x += __builtin_amdgcn_update_dpp(0, x, 0x124, 0xf, 0xf, false);
    x += __builtin_amdgcn_update_dpp(0, x, 0x122, 0xf, 0xf, false);
    x += __builtin_amdgcn_update_dpp(0, x, 0x121, 0xf, 0xf, false);
    auto r = __builtin_amdgcn_permlane16_swap((unsigned)x, (unsigned)x, false, false);
    return (int)(r[0] + r[1]);
}
DI void dsa_select_half(int c, int item4, int set, int lane) {
    int lz = lane; asm volatile("" : "+v"(lz));
    const int hh = lz >> 5, r5 = lz & 31;
    const int rc0 = item4 * 4, b = rc0 >> 9, t0 = c * SC + (rc0 & 511);
    const int qq = ((r5 >> 2) & 1) + 2 * ((r5 >> 4) ^ set), hd = (r5 & 3) + 4 * ((r5 >> 3) & 1);
    const bf16_t* qp = wsp<bf16_t>(WS_IDXQ) + (size_t)(rc0 + qq) * 256 + hd * 32 + 8 * hh;
    const bf16x8 Af0 = *(const bf16x8*)qp, Af1 = *(const bf16x8*)(qp + 16);
    const int tA = t0 + hh + 2 * set;
    const float* wp = wsp<float>(WS_IDXW) + ((size_t)b * SEQ + tA) * 8;
    const f32x4 wa0 = *(const f32x4*)wp, wa1 = *(const f32x4*)(wp + 4);
    const int ngrp = ((t0 + 2 * set + 1) >> 9) + 1;
    unsigned keyA[64];
    const bf16_t* kbase = wsp<bf16_t>(WS_IDXK) + ((size_t)b * SEQ + r5) * 32 + 8 * hh;
    int keyv = r5; unsigned kofs = 0u;
    bf16x8 Bn0 = *(const bf16x8*)kbase, Bn1 = *(const bf16x8*)(kbase + 16);
#pragma unroll
    for (int g = 0; g < 4; ++g) {
        if (g < ngrp) {
#pragma unroll
            for (int j = 0; j < 16; ++j) {
                const int kt = g * 16 + j;
                const bf16x8 Bf0 = Bn0, Bf1 = Bn1;
                { const unsigned nofs = (kt < 63) ? kofs + 32 * 32 : kofs; const bf16_t* kp = kbase + nofs; Bn0 = *(const bf16x8*)kp; Bn1 = *(const bf16x8*)(kp + 16); }
                f32x16 C = {0.f, 0.f, 0.f, 0.f, 0.f, 0.f, 0.f, 0.f, 0.f, 0.f, 0.f, 0.f, 0.f, 0.f, 0.f, 0.f};
                C = MFMA32(Af0, Bf0, C); C = MFMA32(Af1, Bf1, C);
                float va = 0.f;
#pragma unroll
                for (int i = 0; i < 4; ++i) va += fmaxf(C[i], 0.f) * wa0[i];
#pragma unroll
                for (int i = 0; i < 4; ++i) va += fmaxf(C[4 + i], 0.f) * wa1[i];
                unsigned ka = (keyv <= tA) ? fkey(va) : 0u;
                asm volatile("" : "+v"(ka), "+v"(keyv), "+v"(kofs));
                keyA[kt] = ka;
                keyv += 32; kofs += 32 * 32;
            }
        } else {
#pragma unroll
            for (int j = 0; j < 16; ++j) keyA[g * 16 + j] = 0u;
        }
    }
    unsigned KA = 0u;
    if (t0 + 2 * set + 1 >= 256) {
        bool dA = tA < 255;
        for (int bit = 31; bit >= 0; --bit) {
            const unsigned cA = KA | (1u << bit);
            int nA = 0;
#pragma unroll
            for (int g = 0; g < 4; ++g) {
                if (g < ngrp) {
#pragma unroll
                    for (int j = 0; j < 16; ++j) nA += (keyA[g * 16 + j] >= cA) ? 1 : 0;
                }
            }
            nA = half_sum(nA);
            if (!dA && nA >= 256) KA = cA;
            dA = dA || (nA == 256);
            if (__ballot(dA) == ~0ull) break;
        }
    }
    int gA = 0;
#pragma unroll
    for (int kt = 0; kt < 64; ++kt) gA += (keyA[kt] > KA) ? 1 : 0;
    gA = half_sum(gA);
    const int needA = (KA == 0u) ? 0 : 256 - gA;
    asm volatile("" : "+v"(KA));
    int runA = 0, lsel = lz;
    unsigned w0 = 0u, w1 = 0u;
#pragma unroll
    for (int kt = 0; kt < 64; ++kt) {
        const bool eqA = keyA[kt] == KA;
        const unsigned long long ea = __ballot(eqA);
        const int rkA = runA + (hh ? (int)__builtin_amdgcn_mbcnt_hi((unsigned)(ea >> 32), 0u) : (int)__builtin_amdgcn_mbcnt_lo((unsigned)ea, 0u));
        const bool sA = (keyA[kt] > KA) || (eqA && rkA < needA);
        runA += hh ? __builtin_popcount((unsigned)(ea >> 32)) : __builtin_popcount((unsigned)ea);
        const unsigned long long sa = __ballot(sA);
        if (lsel == 0) { w0 = (unsigned)sa; w1 = (unsigned)(sa >> 32); }
        lsel -= 1; asm volatile("" : "+v"(lsel));
        __builtin_amdgcn_sched_barrier(0);
    }
    unsigned* sp = wsp<unsigned>(WS_SELB) + (size_t)(rc0 + 2 * set) * 64 + lz;
    sp[0] = w0; sp[64] = w1;
}
DI void phase_dsa_select_queue(int c, LAS unsigned* ctr) {
    const int lane = TID() & 63;
    const int base = BID() * 8;
    for (;;) {
        unsigned idx = 0u;
        if (lane == 0) idx = __hip_atomic_fetch_add(ctr, 1u, __ATOMIC_RELAXED, __HIP_MEMORY_SCOPE_WORKGROUP);
        idx = (unsigned)__builtin_amdgcn_readfirstlane((int)idx);
        if (idx >= 16u) break;
        const int item4 = base + (int)(idx >> 1);
        if (item4 < TC / 4) dsa_select_half(c, item4, (int)(idx & 1u), lane);
    }
}

struct AttnSt { f32x16 O0, O1; float m, l; };
constexpr float C2 = 0.125f * LOG2E;
DI void attn_load_kv(bf16x8 (&Kf)[4], bf16x8 (&Vf)[2][2], const bf16_t* kbase, const bf16_t* vtbase, int key0, int lane) {
    const int r5 = lane & 31;
    const int prow = (r5 & 19) | ((r5 & 4) << 1) | ((r5 & 8) >> 1);
    const bf16_t* kp = kbase + (size_t)(key0 + prow) * 512;
#pragma unroll
    for (int s = 0; s < 4; ++s) Kf[s] = *(const bf16x8*)(kp + 16 * s);
#pragma unroll
    for (int n = 0; n < 2; ++n)
#pragma unroll
        for (int s = 0; s < 2; ++s) Vf[n][s] = *(const bf16x8*)(vtbase + (size_t)(32 * n) * SEQ + key0 + 16 * s);
}
template <int MODE, bool FAR>
DI void attn_tile(AttnSt& st, const bf16x8 (&Qf)[4], const bf16x8 (&Kf)[4], const bf16x8 (&Vf)[2][2], int key0, int tq, bool allowed, unsigned word, LAS const float* bt, float ub, int lane) {
    const int hh = lane >> 5;
    f32x16 S = {0.f, 0.f, 0.f, 0.f, 0.f, 0.f, 0.f, 0.f, 0.f, 0.f, 0.f, 0.f, 0.f, 0.f, 0.f, 0.f};
#pragma unroll
    for (int s = 0; s < 4; ++s) S = MFMA32(Kf[s], Qf[s], S);
    const unsigned wsh = word >> (8 * hh);
    float ps = 0.f; float pv[16];
    if (FAR) {
        const float cb = (MODE == 0 && !allowed) ? -INFINITY : (bt[127] - ub);
#pragma unroll
        for (int i = 0; i < 16; ++i) {
            float p = fexp2(S[i] * C2 + cb);
            if (MODE == 1) p = __uint_as_float(__float_as_uint(p) & (unsigned)__builtin_amdgcn_sbfe((int)wsh, 16 * (i >> 3) + (i & 7), 1));
            pv[i] = p; ps += p;
        }
    } else {
#pragma unroll
        for (int i = 0; i < 16; ++i) {
            const int koff = 16 * (i >> 3) + 8 * hh + (i & 7);
            const int dist = tq - (key0 + koff);
            const bool ok = (MODE == 0) ? (allowed && dist >= 0) : (((wsh >> (16 * (i >> 3) + (i & 7))) & 1u) != 0u);
            const float p = fexp2(S[i] * C2 + (bt[min(max(dist, 0), 127)] - ub));
            pv[i] = ok ? p : 0.f; ps += pv[i];
        }
    }
    st.l += ps;
#pragma unroll
    for (int s = 0; s < 2; ++s) {
        u32x4 pw; pw[0] = pk2(pv[8 * s], pv[8 * s + 1]); pw[1] = pk2(pv[8 * s + 2], pv[8 * s + 3]); pw[2] = pk2(pv[8 * s + 4], pv[8 * s + 5]); pw[3] = pk2(pv[8 * s + 6], pv[8 * s + 7]);
        const bf16x8 Pf = __builtin_bit_cast(bf16x8, pw);
        st.O0 = MFMA32(Vf[0][s], Pf, st.O0); st.O1 = MFMA32(Vf[1][s], Pf, st.O1);
    }
}
constexpr int AT_ROW = 144, AT_KV = 64 * AT_ROW, AT_STAGE = 2 * AT_KV;
template <int MODE>
DI void attn_block(int c, int b, int h, int half, LAS unsigned char* stg, LAS unsigned* uni, LAS const float* bt, float kbound, float bmax, bool dummy) {
    const int tid = TID(), lane = tid & 63, wave = tid >> 6, r5 = lane & 31, hh = lane >> 5;
    bf16_t* qbuf = wsp<bf16_t>((MODE == 0 ? WS_MQ : WS_DQ) + (c & 1) * PAR_O);
    const int tb = c * SC + 256 * half, t0 = tb + 32 * wave, tq = t0 + r5, rowc0 = b * SC + 256 * half + 32 * wave;
    bf16_t* qp = qbuf + (size_t)(rowc0 + r5) * 512 + h * 64;
    bf16x8 Qf[4];
#pragma unroll
    for (int s = 0; s < 4; ++s) Qf[s] = *(const bf16x8*)(qp + 16 * s + 8 * hh);
    AttnSt st; st.m = 0.f; st.l = 0.f;
#pragma unroll
    for (int i = 0; i < 16; ++i) { st.O0[i] = 0.f; st.O1[i] = 0.f; }
    float ub;
    { float q2 = 0.f;
#pragma unroll
      for (int s = 0; s < 4; ++s)
#pragma unroll
          for (int j = 0; j < 8; ++j) { const float v = bf2f((bf16_t)Qf[s][j]); q2 += v * v; }
      q2 += __shfl_xor(q2, 32);
      ub = sqrtf(q2) * kbound * C2 + bmax; }
    const int ktl = (t0 + 31) >> 5;
    const int own = tb >> 8;
    unsigned bm = 0u, anyw = 0xffu;
    if (MODE == 0) {
        if (own > 0) {
            const float* km = wsp<float>(WS_KMEAN) + ((size_t)(b * 8 + h) * 8) * 64 + 8 * hh;
            float g[8];
#pragma unroll
            for (int n = 0; n < 8; ++n) {
                g[n] = -INFINITY;
                if (n < own) {
                    float part = 0.f;
#pragma unroll
                    for (int s = 0; s < 4; ++s) { const f32x4 k0 = *(const f32x4*)(km + n * 64 + 16 * s), k1 = *(const f32x4*)(km + n * 64 + 16 * s + 4);
#pragma unroll
                        for (int j = 0; j < 4; ++j) part += bf2f((bf16_t)Qf[s][j]) * k0[j] + bf2f((bf16_t)Qf[s][4 + j]) * k1[j]; }
                    g[n] = part + __shfl_xor(part, 32);
                }
            }
#pragma unroll
            for (int n = 0; n < 8; ++n) {
                if (n < own) { int rank = 0;
#pragma unroll
                    for (int m2 = 0; m2 < 8; ++m2) if (m2 != n && m2 < own) rank += ((g[m2] > g[n]) || (g[m2] == g[n] && m2 < n)) ? 1 : 0;
                    if (rank < 3) bm |= 1u << n; }
            }
        }
        anyw = 1u << own;
#pragma unroll
        for (int n = 0; n < 8; ++n) if (n < own && __ballot((bm >> n) & 1u) != 0ull) anyw |= 1u << n;
    }
    if (tid == 0) uni[0] = 0u;
    __syncthreads();
    if (lane == 0) __hip_atomic_fetch_or(uni, anyw, __ATOMIC_RELAXED, __HIP_MEMORY_SCOPE_WORKGROUP);
    __syncthreads();
    const unsigned anyb = MODE == 0 ? uni[0] : 0xffu;
    const int lrow = tid >> 3, lpart = tid & 7;
    const bf16_t* kg = wsp<bf16_t>(MODE == 0 ? WS_MK : WS_DK) + ((size_t)b * SEQ + lrow) * 512 + h * 64 + lpart * 8;
    const bf16_t* vg = wsp<bf16_t>(MODE == 0 ? WS_MVT : WS_DVT) + ((size_t)b * 512 + h * 64 + lrow) * SEQ + lpart * 8;
    const int lofs = lrow * AT_ROW + lpart * 16;
    const int prow = (r5 & 19) | ((r5 & 4) << 1) | ((r5 & 8) >> 1);
    const int kofs = prow * AT_ROW + 16 * hh, vofs = r5 * AT_ROW + 16 * hh;
    const unsigned* sp = wsp<unsigned>(WS_SELB) + (size_t)(rowc0 + r5) * 64;
    const int nst = (tb + 256) >> 6;
    int stp = 0;
    if (MODE == 0) { while (!((anyb >> (stp >> 2)) & 1u)) stp += 4; }
    u32x4 kreg = *(const u32x4*)(kg + (size_t)(stp * 64) * 512), vreg = *(const u32x4*)(vg + stp * 64);
    *(LAS u32x4*)(stg + lofs) = kreg; *(LAS u32x4*)(stg + AT_KV + lofs) = vreg;
    u32x2 wcur = {0u, 0u}, wnxt = {0u, 0u};
    if (MODE == 1) wcur = *(const u32x2*)(sp + 2 * stp);
    __syncthreads();
    int cur = 0;
    while (stp < nst) {
        int nx = stp + 1;
        if (MODE == 0) { while (nx < nst && !((anyb >> (nx >> 2)) & 1u)) nx += 4 - (nx & 3); }
        const bool more = nx < nst;
        if (more) { kreg = *(const u32x4*)(kg + (size_t)(nx * 64) * 512); vreg = *(const u32x4*)(vg + nx * 64); if (MODE == 1) wnxt = *(const u32x2*)(sp + 2 * nx); }
        LAS const unsigned char* ks = stg + cur * AT_STAGE; LAS const unsigned char* vs = ks + AT_KV;
#pragma unroll
        for (int u = 0; u < 2; ++u) {
            const int kt = 2 * stp + u, key0 = kt * 32, nb = kt >> 3;
            const bool waveon = (kt <= ktl) && (MODE == 1 || ((anyw >> nb) & 1u));
            if (waveon) {
                bf16x8 Kf[4], Vf[2][2];
#pragma unroll
                for (int s = 0; s < 4; ++s) Kf[s] = *(LAS const bf16x8*)(ks + 32 * u * AT_ROW + kofs + 32 * s);
#pragma unroll
                for (int n = 0; n < 2; ++n)
#pragma unroll
                    for (int s = 0; s < 2; ++s) Vf[n][s] = *(LAS const bf16x8*)(vs + 32 * n * AT_ROW + vofs + 64 * u + 32 * s);
                const unsigned word = (MODE == 1) ? wcur[u] : 0u;
                const bool allowed = (MODE == 0) ? ((nb == own) || (((bm >> nb) & 1u) != 0u)) : true;
                if (t0 - (key0 + 31) >= 113) attn_tile<MODE, true>(st, Qf, Kf, Vf, key0, tq, allowed, word, bt, ub, lane);
                else attn_tile<MODE, false>(st, Qf, Kf, Vf, key0, tq, allowed, word, bt, ub, lane);
            }
        }
        if (more) { LAS unsigned char* ws_ = stg + (cur ^ 1) * AT_STAGE; *(LAS u32x4*)(ws_ + lofs) = kreg; *(LAS u32x4*)(ws_ + AT_KV + lofs) = vreg; }
        __syncthreads();
        cur ^= 1; stp = nx; wcur = wnxt;
    }
    const float lt = st.l + __shfl_xor(st.l, 32);
    const float inv = 1.f / lt;
    if (dummy) qp = wsp<bf16_t>(WS_RAW + (MODE ? 8 * MiB : 0)) + (size_t)(rowc0 + r5) * 512 + h * 64;
#pragma unroll
    for (int g4 = 0; g4 < 4; ++g4) {
        st_bf4(qp + 8 * g4 + 4 * hh, (f32x4){st.O0[4 * g4] * inv, st.O0[4 * g4 + 1] * inv, st.O0[4 * g4 + 2] * inv, st.O0[4 * g4 + 3] * inv});
        st_bf4(qp + 32 + 8 * g4 + 4 * hh, (f32x4){st.O1[4 * g4] * inv, st.O1[4 * g4 + 1] * inv, st.O1[4 * g4 + 2] * inv, st.O1[4 * g4 + 3] * inv});
    }
    __syncthreads();
}
__device__ const unsigned char kBucket[128] = {0,1,2,3,4,5,6,7,8,9,10,11,12,13,14,15,16,16,16,17,17,18,18,18,19,19,19,20,20,20,20,21,21,21,21,22,22,22,22,22,23,23,23,23,23,23,24,24,24,24,24,24,25,25,25,25,25,25,25,26,26,26,26,26,26,26,26,27,27,27,27,27,27,27,27,27,27,28,28,28,28,28,28,28,28,28,28,29,29,29,29,29,29,29,29,29,29,29,29,30,30,30,30,30,30,30,30,30,30,30,30,30,30,31,31,31,31,31,31,31,31,31,31,31,31,31,31,31};
DI void phase_attn(int l, int c, LAS float* lds, bool dummy = false) {
    const int tid = TID();
    for (int e = tid; e < 2 * 8 * 128; e += 512) { const int d = e & 127, h = (e >> 7) & 7, mx = e >> 10; lds[e] = KP()->in[I_REL][kBucket[d] * 16 + mx * 8 + h] * LOG2E; }
    if (tid < 2) { const float* g = KP()->in[I_QKN] + l * 256 + (tid == 0 ? 64 : 192); float m = 0.f; for (int i = 0; i < 64; ++i) m = fmaxf(m, fabsf(g[i])); lds[2048 + tid] = 8.1f * m; }
    if (tid >= 64 && tid < 80) { const int mx = (tid - 64) >> 3, h = (tid - 64) & 7; float m = 0.f; for (int k = 0; k < 32; ++k) m = fmaxf(m, fabsf(KP()->in[I_REL][k * 16 + mx * 8 + h])); lds[2064 + (tid - 64)] = m * LOG2E; }
    __syncthreads();
    LAS unsigned char* stg = (LAS unsigned char*)lds + 16384; LAS unsigned* uni = (LAS unsigned*)((LAS unsigned char*)lds + 8192 + 256);
    for (int it = BID(); it < NB * NH * 2; it += gridDim.x) {
        const int bh = it >> 1, b = bh >> 3, h = bh & 7, hf = it & 1;
        attn_block<0>(c, b, h, hf, stg, uni, lds + h * 128, lds[2048], lds[2064 + h], dummy);
        attn_block<1>(c, b, h, hf ^ 1, stg, uni, lds + 1024 + h * 128, lds[2049], lds[2072 + h], dummy);
    }
    if (!dummy) { phase_rwkv_post(l, c & 1); if (DBL_PHASE == 24) phase_rwkv_post(l, c & 1); }
}

constexpr int LDS_BYTES = pg8::STAGE_BYTES + 256;
constexpr int PH_PER_LAYER = 32, N_PHASES = 2 * PH_PER_LAYER;
#ifndef DBL_PHASE
#define DBL_PHASE 22
#endif
#ifndef MK_ONE_LAUNCH
#define MK_ONE_LAUNCH 1
#endif
__global__ void __launch_bounds__(512, 2) mega(Params p) {
    extern __shared__ __attribute__((aligned(16))) unsigned char lds_raw[];
    LAS unsigned char* lds = (LAS unsigned char*)lds_raw;
    volatile LAS unsigned* bst = (volatile LAS unsigned*)(lds + pg8::STAGE_BYTES);
    if (TID() < 4) bst[TID()] = 0u;
    __syncthreads();
    if (p.ph_hi - p.ph_lo > 1) (void)xcd_barrier_post((unsigned*)(KP()->ws + WS_CTL), bst);
#ifndef PH_ONLY
#define PH_ONLY -1
#endif
#define IN(k) (KP()->ph_lo <= (k) && (k) < KP()->ph_hi)
#define INT(tag, k) ((PH_ONLY < 0 || PH_ONLY == (tag)) && IN(k))
#define SEAM(k) do { if (IN(k) && IN((k) + 1)) { XcdBarrier bar_; bar_.bar = (unsigned*)(KP()->ws + WS_CTL); bar_.x = xb_xcc_id(); bar_.st = (volatile LAS unsigned*)(lds + pg8::STAGE_BYTES); xcd_barrier(bar_); if (DBL_PHASE == 20) xcd_barrier(bar_); } } while (0)
    for (int l = 0; l < 2; ++l) {
        const int pb = PH_PER_LAYER * l;
        if (INT(0, pb + 0)) {
#if DBL_PHASE == 6
            phase_conv(l, (LAS float*)lds);
#endif
            phase_conv(l, (LAS float*)lds); }
        SEAM(pb + 0);
        if (INT(1, pb + 1)) {
#if DBL_PHASE == 7
            phase_norm(l == 0 ? KP()->in[I_X] : (const float*)KP()->out, KP()->in[I_NMIX] + l * DM, wsp<bf16_t>(WS_H));
#endif
            phase_norm(l == 0 ? KP()->in[I_X] : (const float*)KP()->out, KP()->in[I_NMIX] + l * DM, wsp<bf16_t>(WS_H)); }
        SEAM(pb + 1);
        if (INT(2, pb + 2)) {
            { const SchedLin S = mk_sched(128, 4, WS_H, WS_WB, 1024); const EpiB E{l}; pg8::gemm_phase(lds, 1024, S, E); }
            { const SchedLin S = mk_sched(2, 128, WS_WV, WS_H, 1024); const EpiVt E{(unsigned)WS_MVT}; pg8::gemm_phase(lds, 1024, S, E); }
#if DBL_PHASE == 9
            { const SchedLin S = mk_sched(128, 4, WS_H, WS_WB, 1024); const EpiB E{l}; pg8::gemm_phase(lds, 1024, S, E); }
            { const SchedLin S = mk_sched(2, 128, WS_WV, WS_H, 1024); const EpiVt E{(unsigned)WS_MVT}; pg8::gemm_phase(lds, 1024, S, E); }
#endif
        }
        SEAM(pb + 2);
        if (INT(3, pb + 3)) { phase_dcn(l); phase_kmean();
#if DBL_PHASE == 14
            phase_kmean();
#endif
        }
        SEAM(pb + 3);
        if (INT(4, pb + 4)) {
            { const SchedLin S = mk_sched(128, 2, WS_DCN, WS_WKVK, 256); const EpiHN E{l}; pg8::gemm_phase(lds, 256, S, E); }
            { const SchedLin S = mk_sched(2, 128, WS_WKVV, WS_DCN, 256); const EpiVt E{(unsigned)WS_DVT}; pg8::gemm_phase(lds, 256, S, E); }
#if DBL_PHASE == 13
            { const SchedLin S = mk_sched(128, 2, WS_DCN, WS_WKVK, 256); const EpiHN E{l}; pg8::gemm_phase(lds, 256, S, E); }
            { const SchedLin S = mk_sched(2, 128, WS_WKVV, WS_DCN, 256); const EpiVt E{(unsigned)WS_DVT}; pg8::gemm_phase(lds, 256, S, E); }
#endif
        }
        SEAM(pb + 4);
        for (int c = 0; c < NCH; ++c) {
            const int pc = pb + 5 + 5 * c + 2 * (c >> 1), cbase = c * SC;
            if (INT(5, pc + 0)) { const SchedLin S = mk_sched(32, 24, WS_H, WS_WD1, 1024, 1, cbase); const EpiD1 E{l, c & 1}; pg8::gemm_phase(lds, 1024, S, E);
#if DBL_PHASE == 5
                pg8::gemm_phase(lds, 1024, S, E);
#endif
            }
            SEAM(pc + 0);
            if (INT(6, pc + 1)) {
#if DBL_PHASE == 4
                phase_rwkv_prep(l, c);
#endif

                phase_rwkv_prep(l, c); }
            SEAM(pc + 1);
            if (INT(7, pc + 2)) { const SchedLin S = mk_sched(32, l == 0 ? 6 : 8, WS_LORAA, WS_WL, 512, 0, 0, WS_VV, 6); const EpiLora E{l, cbase}; pg8::gemm_phase(lds, 512, S, E); }
            SEAM(pc + 2);
            if (INT(8, pc + 3)) {
#if DBL_PHASE == 2
                phase_scan_chunked(l, c, lds, true);
#endif
#if DBL_PHASE == 22
                phase_scan_chunked(l, c, lds, true);
#endif

#if DBL_PHASE == 11
                phase_scan(l, c, 2);
#endif
#if DBL_PHASE == 12
                phase_scan(l, c, 3);
#endif
#if DBL_PHASE == 25
                if (TID() == 0) *(LAS unsigned*)(lds + 8192) = 0u;
                __syncthreads();
                phase_scan_chunked(l, c, lds, true); phase_dsa_select_queue(c, (LAS unsigned*)(lds + 8192));
                __syncthreads();
#endif
#if DBL_PHASE == 26
                if (TID() == 0) *(LAS unsigned*)(lds + 8192) = 0u;
                __syncthreads();
                phase_dsa_select_queue(c, (LAS unsigned*)(lds + 8192));
                __syncthreads();
#endif
                if (TID() == 0) *(LAS unsigned*)(lds + 8192) = 0u;
                __syncthreads();
                phase_scan_chunked(l, c, lds);
                phase_dsa_select_queue(c, (LAS unsigned*)(lds + 8192)); }
            SEAM(pc + 3);
            if (INT(9, pc + 4)) {
#if DBL_PHASE == 1
                phase_attn(l, c, (LAS float*)lds, true); __syncthreads();
#endif
                phase_attn(l, c, (LAS float*)lds); }
            SEAM(pc + 4);
            if (c & 1) {
                if (INT(10, pc + 5)) { const SchedMerge S{(int)gridDim.x, (int)BID()}; const EpiMerge E{}; pg8::gemm_phase(lds, 512, S, E);
#if DBL_PHASE == 10
                    pg8::gemm_phase(lds, 512, S, E);
#endif
                }
                SEAM(pc + 5);
                if (INT(11, pc + 6)) { const SchedLin S = mk_sched(64, 4, WS_Y, WS_WO, 1024); const EpiRes E{l == 0 ? 1 : 0, 2, cbase - SC, 0u}; pg8::gemm_phase(lds, 1024, S, E); }
                SEAM(pc + 6);
            }
        }
        if (INT(33, pb + 29)) phase_norm(KP()->out, KP()->in[I_NFFN] + l * DM, wsp<bf16_t>(WS_H));
        SEAM(pb + 29);
        if (INT(34, pb + 30)) { const SchedLin S = mk_sched(128, 22, WS_H, WS_WF1, 1024); const EpiSwiglu E{}; pg8::gemm_phase(lds, 1024, S, E);
#if DBL_PHASE == 8
            pg8::gemm_phase(lds, 1024, S, E);
#endif
        }
        SEAM(pb + 30);
        if (INT(35, pb + 31)) { const SchedLin S = mk_sched(128, 4, WS_ACT, WS_WF2, DFF); const EpiRes E{0, 0, 0, 0u};
#if DBL_PHASE == 16
            { const EpiRes E2{0, 0, 0, (unsigned)(WS_ACT + 176 * MiB)}; pg8::gemm_phase(lds, DFF, S, E2); }
#endif
            pg8::gemm_phase(lds, DFF, S, E); }
        SEAM(pb + 31);
    }
#undef IN
#undef INT
#undef SEAM
}

extern "C" void kernel_launch(void* const* d_in, const int* in_sizes, int n_in, void* d_out, int out_size, void* d_ws, size_t ws_size, hipStream_t stream) {
    static int grid = 0;
    if (grid == 0) {
        if (n_in != 26 || ws_size < WS_END) { grid = -1; return; }
        int dev = 0, cus = 0;
        if (hipGetDevice(&dev) != hipSuccess || hipDeviceGetAttribute(&cus, hipDeviceAttributeMultiprocessorCount, dev) != hipSuccess) { grid = -1; return; }
        if (hipFuncSetAttribute((const void*)mega, hipFuncAttributeMaxDynamicSharedMemorySize, LDS_BYTES) != hipSuccess) { grid = -1; return; }
        grid = cus;
    }
    if (grid < 0) return;
    (void)hipMemsetAsync((char*)d_ws + WS_CTL, 0, 64 * 1024, stream);
    Params p{};
    for (int i = 0; i < 26; ++i) p.in[i] = (const float*)d_in[i];
    p.out = (float*)d_out; p.ws = (unsigned char*)d_ws;
#if MK_ONE_LAUNCH
    p.ph_lo = 0; p.ph_hi = N_PHASES;
    hipLaunchKernelGGL(mega, dim3(grid), dim3(512), LDS_BYTES, stream, p);
#else
    for (int ph = 0; ph < N_PHASES; ++ph) { p.ph_lo = ph; p.ph_hi = ph + 1; hipLaunchKernelGGL(mega, dim3(grid), dim3(512), LDS_BYTES, stream, p); }
#endif
}
```

```cpp
#include <hip/hip_runtime.h>
#include <stdint.h>
#ifndef DBL_PHASE
#define DBL_PHASE 0
#endif

#define DI __device__ __forceinline__
#define LAS __attribute__((address_space(3)))
typedef unsigned short bf16_t;
typedef short bf16x8 __attribute__((ext_vector_type(8)));
typedef float f32x2 __attribute__((ext_vector_type(2)));
typedef float f32x4 __attribute__((ext_vector_type(4)));
typedef float f32x16 __attribute__((ext_vector_type(16)));
typedef unsigned u32x2 __attribute__((ext_vector_type(2)));
typedef unsigned u32x4 __attribute__((ext_vector_type(4)));
typedef __bf16 bf2_t __attribute__((ext_vector_type(2)));

constexpr int NB = 16, SEQ = 2048, DM = 1024, NT = NB * SEQ, NH = 8, BW = 512;
constexpr int NCH = 4, SC = 512, TC = NB * SC;
constexpr int D_IN = 7496, DFF = 2816;
constexpr int C_MQ = 0, C_MK = 512, C_MV = 1024, C_RW = 1536, C_DS = 3360, C_GT = 4424;
constexpr int RAWLD = 1792;
constexpr float NORM_EPS = 1e-6f;
constexpr float LOG2E = 1.4426950408889634f;

constexpr size_t MiB = 1024 * 1024;
constexpr size_t WS_CTL = 0;
constexpr size_t WS_WB = 64 * 1024;
constexpr size_t WS_WV = WS_WB + 2 * MiB;
constexpr size_t WS_WD1 = WS_WV + 1 * MiB;
constexpr size_t WS_WKVK = WS_WD1 + 12 * MiB;
constexpr size_t WS_WKVV = WS_WKVK + MiB / 4;
constexpr size_t WS_WL = WS_WKVV + MiB / 4;
constexpr size_t WS_WBR = WS_WL + 2 * MiB;
constexpr size_t WS_WO = WS_WBR + 3 * MiB;
constexpr size_t WS_WF1 = WS_WO + 2 * MiB;
constexpr size_t WS_WF2 = WS_WF1 + 11 * MiB;
constexpr size_t WS_VFIRST = WS_WF2 + 6 * MiB;
constexpr size_t WS_STATE = WS_VFIRST + 32 * MiB;
constexpr size_t WS_H = WS_STATE + 2 * MiB;
constexpr size_t WS_IDXK = WS_H + 64 * MiB;
constexpr size_t WS_IDXW = WS_IDXK + 2 * MiB;
constexpr size_t WS_LEFT = WS_IDXW + 1 * MiB;
constexpr size_t WS_KMEAN = WS_LEFT + 2 * MiB;
constexpr size_t WS_CARRY = WS_KMEAN + MiB / 4;
constexpr size_t WS_MK = WS_CARRY + MiB / 4;
constexpr size_t WS_MVT = WS_MK + 32 * MiB;
constexpr size_t WS_DK = WS_MVT + 32 * MiB;
constexpr size_t WS_DVT = WS_DK + 32 * MiB;
constexpr size_t WS_MQ = WS_DVT + 32 * MiB;
constexpr size_t WS_DQ = WS_MQ + 16 * MiB;
constexpr size_t WS_ORW = WS_DQ + 16 * MiB;
constexpr size_t WS_GATES = WS_ORW + 16 * MiB;
constexpr size_t PAR_O = 8 * MiB, PAR_G = 24 * MiB;
constexpr size_t WS_IDXQ = WS_GATES + 48 * MiB;
constexpr size_t WS_RAW = WS_IDXQ + 4 * MiB;
constexpr size_t WS_LORAA = WS_RAW + 28 * MiB;
constexpr size_t WS_RR = WS_LORAA + 8 * MiB;
constexpr size_t WS_KF = WS_RR + 8 * MiB;
constexpr size_t WS_VV = WS_KF + 8 * MiB;
constexpr size_t WS_KKB = WS_VV + 8 * MiB;
constexpr size_t WS_BBB = WS_KKB + 8 * MiB;
constexpr size_t WS_GG = WS_BBB + 8 * MiB;
constexpr size_t WS_DEC = WS_GG + 8 * MiB;
constexpr size_t WS_OUT = WS_DEC + 16 * MiB;
constexpr size_t WS_V2 = WS_OUT + 16 * MiB;
constexpr size_t WS_SELB = WS_V2 + 8 * MiB;
constexpr size_t WS_END = WS_SELB + 2 * MiB;
constexpr size_t WS_DCN = WS_RAW;
constexpr size_t WS_Y32 = WS_IDXQ;
constexpr size_t WS_Y = WS_Y32 + 64 * MiB;
static_assert(WS_Y + 32 * MiB <= WS_END, "y32 / y alias");
constexpr size_t WS_ACT = WS_MK;
static_assert(WS_END <= 512 * MiB, "workspace map exceeds 512 MiB");
static_assert(WS_ACT + 176 * MiB <= WS_END, "ACT alias");

DI unsigned pk2(float a, float b) { f32x2 v = {a, b}; return __builtin_bit_cast(unsigned, __builtin_convertvector(v, bf2_t)); }
DI bf16_t f2bf(float a) { return (bf16_t)(pk2(a, 0.f) & 0xffffu); }
DI float bflo(unsigned u) { return __uint_as_float(u << 16); }
DI float bfhi(unsigned u) { return __uint_as_float(u & 0xffff0000u); }
DI float bf2f(bf16_t b) { return __uint_as_float((unsigned)b << 16); }
DI float fexp2(float x) { return __builtin_amdgcn_exp2f(x); }
DI float frcp(float x) { return __builtin_amdgcn_rcpf(x); }
DI float fsigmoid(float x) { return frcp(1.f + fexp2(-x * LOG2E)); }
DI float wave_sum(float v) {
    v += __uint_as_float(__builtin_amdgcn_update_dpp(0, __float_as_uint(v), 0x128, 0xf, 0xf, false));
    v += __uint_as_float(__builtin_amdgcn_update_dpp(0, __float_as_uint(v), 0x124, 0xf, 0xf, false));
    v += __uint_as_float(__builtin_amdgcn_update_dpp(0, __float_as_uint(v), 0x122, 0xf, 0xf, false));
    v += __uint_as_float(__builtin_amdgcn_update_dpp(0, __float_as_uint(v), 0x121, 0xf, 0xf, false));
    auto r = __builtin_amdgcn_permlane16_swap(__float_as_uint(v), __float_as_uint(v), false, false);
    v = __uint_as_float(r[0]) + __uint_as_float(r[1]);
    r = __builtin_amdgcn_permlane32_swap(__float_as_uint(v), __float_as_uint(v), false, false);
    return __uint_as_float(r[0]) + __uint_as_float(r[1]);
}

#define XB_TMO      128
#define XB_XCNT(j)  (256  + 64 * (j))
#define XB_XSUB(j)  (1280 + 64 * (j))
#define XB_XGEN(j)  (2304 + 64 * (j))
#define XB_TOP      3328
#define XB_TOPGEN   3392
#define XCD_BAR_WORDS 3456
#define XB_SPIN_CAP (1u << 18)
__device__ __forceinline__ unsigned xb_ld(unsigned* p)              { return __hip_atomic_load(p, __ATOMIC_RELAXED, __HIP_MEMORY_SCOPE_AGENT); }
__device__ __forceinline__ unsigned xb_add(unsigned* p, unsigned v) { return __hip_atomic_fetch_add(p, v, __ATOMIC_RELAXED, __HIP_MEMORY_SCOPE_AGENT); }
__device__ __forceinline__ unsigned xb_xcc_id() { return (unsigned)__builtin_amdgcn_s_getreg((3 << 11) | 20) & 0xFu; }
#define XB_SPIN(cond, bar) do { unsigned _sp = 0; while (cond) { __builtin_amdgcn_s_sleep(1); \
    if ((++_sp & 255u) == 0u) { if (xb_ld(&(bar)[XB_TMO])) break; if (_sp > XB_SPIN_CAP) { atomicAdd(&(bar)[XB_TMO], 1u); break; } } } } while (0)
struct XcdBarrier { unsigned* bar; unsigned x; volatile LAS unsigned* st; };
__device__ __forceinline__ XcdBarrier xcd_barrier_post(unsigned* bar, volatile LAS unsigned* st) {
    XcdBarrier b; b.bar = bar; b.x = xb_xcc_id(); b.st = st;
    if (threadIdx.x == 0) (void)xb_add(&bar[XB_XCNT(b.x)], 1u);
    return b;
}
__device__ __forceinline__ void xcd_barrier_complete(unsigned* bar, unsigned x, unsigned& nloc, unsigned& nx) {
    const unsigned G = gridDim.x * gridDim.y * gridDim.z;
    unsigned sum, cnt, mine, sp = 0u;
    for (;;) {
        sum = 0u; cnt = 0u; mine = 0u;
#pragma unroll 1
        for (unsigned j = 0; j < 16; ++j) { const unsigned c = xb_ld(&bar[XB_XCNT(j)]); sum += c; cnt += (c > 0u) ? 1u : 0u; mine = (j == x) ? c : mine; }
        if (sum == G) break;
        __builtin_amdgcn_s_sleep(1);
        if ((++sp & 255u) == 0u) { if (xb_ld(&bar[XB_TMO])) break; if (sp > XB_SPIN_CAP) { atomicAdd(&bar[XB_TMO], 1u); break; } }
    }
    nloc = mine > 0u ? mine : 1u; nx = cnt > 0u ? cnt : 1u;
}
__device__ __forceinline__ void xcd_barrier(const XcdBarrier& b) {
    asm volatile("s_waitcnt vmcnt(0)" ::: "memory");
    __syncthreads();
    if (threadIdx.x == 0) {
        unsigned* bar = b.bar;
        __builtin_amdgcn_s_waitcnt(0);
        unsigned nloc = b.st[0], nx = b.st[1];
        if (nloc == 0u) { xcd_barrier_complete(bar, b.x, nloc, nx); b.st[0] = nloc; b.st[1] = nx; }
        const unsigned old = xb_add(&bar[XB_XSUB(b.x)], 1u);
        const unsigned gen = old / nloc;
        if (old + 1u == (gen + 1u) * nloc) {
            __builtin_amdgcn_fence(__ATOMIC_RELEASE, "agent");
            asm volatile("s_waitcnt vmcnt(0)" ::: "memory");
            const unsigned og = xb_add(&bar[XB_TOP], 1u);
            const unsigned tg = og / nx;
            if (og + 1u == (tg + 1u) * nx) xb_add(&bar[XB_TOPGEN], 1u);
            else XB_SPIN(xb_ld(&bar[XB_TOPGEN]) == tg, bar);
            __builtin_amdgcn_fence(__ATOMIC_ACQUIRE, "agent");
            xb_add(&bar[XB_XGEN(b.x)], 1u);
            asm volatile("s_waitcnt vmcnt(0)" ::: "memory");
        } else {
            XB_SPIN(xb_ld(&bar[XB_XGEN(b.x)]) == gen, bar);
            __builtin_amdgcn_fence(__ATOMIC_ACQUIRE, "agent");
            asm volatile("s_waitcnt vmcnt(0)" ::: "memory");
        }
    }
    __syncthreads();
}

DI int TID() { int t = threadIdx.x; asm volatile("" : "+v"(t)); return t; }
DI int BID() { int b = blockIdx.x; asm volatile("" : "+s"(b)); return b; }

namespace pg8 {
constexpr int BM = 256, BK = 64, HALF = 128, HTB = HALF * BK * 2, STAGE_BYTES = 8 * HTB, NXCD = 8, WGM = 8;
DI int lds_byte(int r, int c) { const int st = (r >> 4) * 2 + (c >> 5), rr = r & 15, cc = c & 31, ob = rr * 64 + cc * 2; return st * 1024 + (ob ^ (((ob >> 9) & 1) << 5)); }
DI void stage_rc(int b, int& R, int& C) { const int st = b / 1024, sb = b % 1024, swz = sb ^ (((sb >> 9) & 1) << 5); R = (st >> 1) * 16 + swz / 64; C = (st & 1) * 32 + (swz % 64) / 2; }
struct Unit { int pm, pn, z; };

DI bool order_xcd(int nM, int nN, int G, int c, int i, Unit& u) {
    const int nwg = nM * nN; const long L = (long)i * G + c; if (L >= nwg) return false;
    int wgid = (int)L; { const int q = nwg / NXCD, r = nwg % NXCD, xcd = wgid % NXCD, off = wgid / NXCD; wgid = (xcd < r ? xcd * (q + 1) : r * (q + 1) + (xcd - r) * q) + off; }
    const int nig = WGM * nN, gid = wgid / nig, fm = gid * WGM, gsz = (nM - fm) < WGM ? (nM - fm) : WGM;
    u.pm = fm + ((wgid % nig) % gsz); u.pn = (wgid % nig) / gsz; u.z = 0; return true;
}

template <class Epi, class Sched, bool HALFN = false>
DI void gemm_phase(LAS unsigned char* lds, const int K, const Sched& S, const Epi& E) {
    const int tid = TID(), wid = __builtin_amdgcn_readfirstlane(tid >> 6), lane = tid & 63, wr = wid >> 2, wc = wid & 3, fr = lane & 15, fq = lane >> 4;
    const int nt = K / BK;
    unsigned voffA[2];
#pragma unroll
    for (int i = 0; i < 2; ++i) { int R, C; stage_rc(tid * 16 + i * 8192, R, C); voffA[i] = (unsigned)(R * K + C) * 2u; }
    const size_t kstep = (size_t)(BK * 2);
    const size_t hstep = (size_t)HALF * K * 2;
    const unsigned ldsw = (unsigned)wid * 1024u;
    const int aoff = lds_byte(wr * 64 + fr, fq * 8), boff = lds_byte(wc * 32 + fr, fq * 8);
#define PG8_SA(b, h) (((b) * 2 + (h)) * HTB)
#define PG8_SB(b, h) ((4 + (b) * 2 + (h)) * HTB)
#define PG8_STAGE(bufoff, gbase) do { _Pragma("unroll") for (int _i = 0; _i < 2; ++_i) \
        __builtin_amdgcn_global_load_lds((const unsigned*)((const char*)(gbase) + voffA[_i]), (LAS unsigned*)(lds + (bufoff) + ldsw + _i * 8192), 16, 0, 0); } while (0)
#define PG8_LDA(dst, b, h) do { _Pragma("unroll") for (int m = 0; m < 4; ++m) _Pragma("unroll") for (int k = 0; k < 2; ++k) dst[m][k] = *(const LAS bf16x8*)(lds + PG8_SA(b, h) + aoff + m * 2048 + k * 1024); } while (0)
#define PG8_LDB(dst, b, h) do { _Pragma("unroll") for (int n = 0; n < 2; ++n) _Pragma("unroll") for (int k = 0; k < 2; ++k) dst[n][k] = *(const LAS bf16x8*)(lds + PG8_SB(b, h) + boff + n * 2048 + k * 1024); } while (0)
#define PG8_MMA(ai, bj, At, Bt) do { __builtin_amdgcn_s_setprio(1); _Pragma("unroll") for (int m = 0; m < 4; ++m) _Pragma("unroll") for (int n = 0; n < 2; ++n) _Pragma("unroll") for (int k = 0; k < 2; ++k) \
        acc[ai][bj][m][n] = __builtin_amdgcn_mfma_f32_16x16x32_bf16(Bt[n][k], At[m][k], acc[ai][bj][m][n], 0, 0, 0); __builtin_amdgcn_s_setprio(0); } while (0)
#define PG8_WAIT_V(n) asm volatile("s_waitcnt vmcnt(" #n ")" ::: "memory")
#define PG8_WAIT_L(n) asm volatile("s_waitcnt lgkmcnt(" #n ")" ::: "memory")
#define PG8_BAR __builtin_amdgcn_s_barrier()
#define PG8_SCHED __builtin_amdgcn_sched_barrier(0)
    Unit cur, nxt; int ui = 0;
    if (!S.next(0, cur)) return;
    f32x4 acc[2][2][4][2];
#pragma unroll
    for (int a = 0; a < 2; ++a)
#pragma unroll
        for (int b = 0; b < 2; ++b)
#pragma unroll
            for (int m = 0; m < 4; ++m)
#pragma unroll
                for (int n = 0; n < 2; ++n) acc[a][b][m][n] = (f32x4){0.f, 0.f, 0.f, 0.f};
    bf16x8 At[4][2], B0[2][2], B1[2][2];
    const char* cA = S.aptr(cur); const char* cB = S.bptr(cur);
    PG8_STAGE(PG8_SB(0, 0), cB); PG8_STAGE(PG8_SA(0, 0), cA); PG8_STAGE(PG8_SB(0, 1), cB + hstep); PG8_STAGE(PG8_SA(0, 1), cA + hstep);
    if (wr == 1) PG8_BAR;
    PG8_WAIT_V(4); PG8_BAR;
    PG8_STAGE(PG8_SB(1, 0), cB + kstep); PG8_STAGE(PG8_SA(1, 0), cA + kstep); PG8_STAGE(PG8_SB(1, 1), cB + hstep + kstep);
    PG8_WAIT_V(6); PG8_BAR;
    for (;;) {
        const bool has_next = S.next(ui + 1, nxt);
        const char* nA = has_next ? S.aptr(nxt) : cA; const char* nB = has_next ? S.bptr(nxt) : cB;
#pragma unroll 1
        for (int t = 0; t < nt; t += 2) {
            const bool last = (t == nt - 2);
            const char* a1 = cA + (size_t)(t + 1) * kstep;
            const char* a2 = last ? nA : cA + (size_t)(t + 2) * kstep; const char* b2 = last ? nB : cB + (size_t)(t + 2) * kstep;
            const char* a3 = a2 + kstep; const char* b3 = b2 + kstep;
            PG8_LDB(B0, 0, 0); PG8_SCHED; PG8_LDA(At, 0, 0); PG8_STAGE(PG8_SA(1, 1), a1 + hstep);
            PG8_WAIT_L(8); PG8_BAR; PG8_WAIT_L(0); PG8_MMA(0, 0, At, B0); PG8_BAR; PG8_SCHED;
            PG8_LDB(B1, 0, 1); PG8_STAGE(PG8_SB(0, 0), b2);
            PG8_BAR; PG8_WAIT_L(0); if (!HALFN) PG8_MMA(0, 1, At, B1); PG8_BAR;
            PG8_LDA(At, 0, 1); PG8_STAGE(PG8_SA(0, 0), a2);
            PG8_BAR; PG8_WAIT_L(0); PG8_MMA(1, 0, At, B0); PG8_BAR; PG8_SCHED;
            PG8_STAGE(PG8_SB(0, 1), b2 + hstep);
            PG8_WAIT_V(6); PG8_BAR; if (!HALFN) PG8_MMA(1, 1, At, B1); PG8_BAR;
            PG8_LDB(B0, 1, 0); PG8_SCHED; PG8_LDA(At, 1, 0); PG8_STAGE(PG8_SA(0, 1), a2 + hstep);
            PG8_WAIT_L(8); PG8_BAR; PG8_WAIT_L(0); PG8_MMA(0, 0, At, B0); PG8_BAR; PG8_SCHED;
            PG8_LDB(B1, 1, 1); PG8_STAGE(PG8_SB(1, 0), b3);
            PG8_BAR; PG8_WAIT_L(0); if (!HALFN) PG8_MMA(0, 1, At, B1); PG8_BAR;
            PG8_LDA(At, 1, 1); PG8_STAGE(PG8_SA(1, 0), a3);
            PG8_BAR; PG8_WAIT_L(0); PG8_MMA(1, 0, At, B0); PG8_BAR; PG8_SCHED;
            PG8_STAGE(PG8_SB(1, 1), b3 + hstep);
            PG8_WAIT_V(6); PG8_BAR; if (!HALFN) PG8_MMA(1, 1, At, B1); PG8_BAR;
        }
        { int tz = TID(); asm volatile("" : "+v"(tz));
          const int wz = __builtin_amdgcn_readfirstlane(tz >> 6), lz = tz & 63; E(acc, cur, wz >> 2, wz & 3, lz & 15, lz >> 4); }
        if (!has_next) break;
#pragma unroll
        for (int a = 0; a < 2; ++a)
#pragma unroll
            for (int b = 0; b < (HALFN ? 1 : 2); ++b)
#pragma unroll
                for (int m = 0; m < 4; ++m)
#pragma unroll
                    for (int n = 0; n < 2; ++n) acc[a][b][m][n] = (f32x4){0.f, 0.f, 0.f, 0.f};
        cur = nxt; cA = nA; cB = nB; ++ui;
    }
    PG8_WAIT_V(0);
    if (wr == 0) PG8_BAR;
    PG8_BAR;
#undef PG8_SA
#undef PG8_SB
#undef PG8_STAGE
#undef PG8_LDA
#undef PG8_LDB
#undef PG8_MMA
#undef PG8_WAIT_V
#undef PG8_WAIT_L
#undef PG8_BAR
#undef PG8_SCHED
}
}
using pg8::Unit;
typedef f32x4 AccT[2][2][4][2];

struct Params {
    const float* in[26];
    float* out;
    unsigned char* ws;
    int ph_lo, ph_hi;
};
enum { I_X = 0, I_WIN, I_NMIX, I_NFFN, I_QKN, I_REL, I_MU, I_W0, I_W2, I_A0, I_A2, I_G2, I_KK, I_KA, I_RK, I_LNW, I_LNB, I_V0, I_VA, I_VB, I_KVN, I_KVUP, I_WBR, I_WO, I_F1, I_F2 };

DI const Params* KP() { auto k = __builtin_amdgcn_kernarg_segment_ptr(); asm volatile("" : "+s"(k)); return (const Params*)k; }
template <class T> DI T* wsp(size_t off) { return (T*)(KP()->ws + off); }

DI int wide_col(int x) { const int pi = x & 255; return (x & ~255) + 64 * ((pi >> 5) & 3) + 16 * ((pi >> 2) & 3) + 8 * (pi >> 7) + 4 * ((pi >> 4) & 1) + (pi & 3); }
template <int MAP> DI int colmap(int r) {
    if (MAP == 0) {
        if (r < 512) return C_MK + wide_col(r);
        if (r < 768) return C_DS + 512 + wide_col(r - 512);
        const int a = wide_col(r - 768);
        if (a < 32) return C_DS + 1024 + a;
        if (a < 40) return C_DS + 1056 + (a - 32);
        if (a >= 64 && a < 96) return C_RW + 1792 + (a - 64);
        return -1;
    }
    if (MAP == 1) return C_MV + r;
    if (MAP == 2) {
        if (r < 512) return C_MQ + wide_col(r);
        if (r < 1024) return C_DS + wide_col(r - 512);
        if (r < 1280) return C_DS + 768 + wide_col(r - 1024);
        if (r < 3072) return C_RW + wide_col(r - 1280);
        return C_GT + wide_col(r - 3072);
    }
    if (MAP == 3) return wide_col(r);
    if (MAP == 4) return 512 + r;
    if (MAP == 5) return wide_col(r);
    if (MAP == 6) { const int pn = r >> 8, pi = r & 255;
        return ((pi >> 7) ? DFF : 0) + 128 * pn + 32 * ((pi >> 5) & 3) + 8 * ((pi >> 2) & 3) + 4 * ((pi >> 4) & 1) + (pi & 3); }
    return -1;
}
template <int MAP> DI void conv_t(LAS float* sm, bf16_t* dst, int nrows, int K, const float* src, int ld) {
    const int tid = TID(), tx = tid & 63, ty = tid >> 6;
    const int ntr = nrows / 64, ntk = K / 64, ntiles = ntr * ntk;
    for (int t = BID(); t < ntiles; t += gridDim.x) {
        const int r0 = (t / ntk) * 64, k0 = (t % ntk) * 64;
        const int col = colmap<MAP>(r0 + tx);
#pragma unroll
        for (int i = 0; i < 8; ++i) { const int kl = ty + 8 * i; sm[kl * 65 + tx] = (col >= 0) ? src[(size_t)(k0 + kl) * ld + col] : 0.f; }
        __syncthreads();
#pragma unroll
        for (int i = 0; i < 8; ++i) { const int rl = ty + 8 * i; dst[(size_t)(r0 + rl) * K + k0 + tx] = f2bf(sm[tx * 65 + rl]); }
        __syncthreads();
    }
}
DI void conv_lora(int l) {
    bf16_t* dst = wsp<bf16_t>(WS_WL);
    const float* w2 = KP()->in[I_W2] + (size_t)l * 64 * 512; const float* a2 = KP()->in[I_A2] + (size_t)l * 64 * 512; const float* g2 = KP()->in[I_G2] + (size_t)l * 160 * 512;
    const float* va = KP()->in[I_VA]; const float* vb = KP()->in[I_VB];
    const int n = 2048 * 512;
    for (int e = BID() * 512 + TID(); e < n; e += gridDim.x * 512) {
        const int r = wide_col(e >> 9), k = e & 511; float v = 0.f;
        if (r < 512) { if (k < 64) v = w2[k * 512 + r]; }
        else if (r < 1024) { if (k >= 64 && k < 128) v = a2[(k - 64) * 512 + (r - 512)]; }
        else if (r < 1536) { if (k >= 128 && k < 288) v = g2[(k - 128) * 512 + (r - 1024)]; }
        else if (l == 1) { const int c = r - 1536; float s = 0.f;
#pragma unroll 8
            for (int j = 0; j < 32; ++j) s += va[k * 32 + j] * vb[j * 512 + c];
            v = s; }
        dst[e] = f2bf(v);
    }
}
DI void phase_conv(int l, LAS float* sm) {
    const float* win = KP()->in[I_WIN] + (size_t)l * DM * D_IN;
    conv_t<0>(sm, wsp<bf16_t>(WS_WB), 1024, 1024, win, D_IN);
    conv_t<1>(sm, wsp<bf16_t>(WS_WV), 512, 1024, win, D_IN);
    conv_t<2>(sm, wsp<bf16_t>(WS_WD1), 6144, 1024, win, D_IN);
    const float* kvup = KP()->in[I_KVUP] + (size_t)l * 256 * 1024;
    conv_t<3>(sm, wsp<bf16_t>(WS_WKVK), 512, 256, kvup, 1024);
    conv_t<4>(sm, wsp<bf16_t>(WS_WKVV), 512, 256, kvup, 1024);
    for (int i = 0; i < 3; ++i) conv_t<5>(sm, wsp<bf16_t>(WS_WBR) + (size_t)i * 1024 * 512, 1024, 512, KP()->in[I_WBR] + ((size_t)l * 3 + i) * 512 * 1024, 1024);
    conv_t<5>(sm, wsp<bf16_t>(WS_WO), 1024, 1024, KP()->in[I_WO] + (size_t)l * 1024 * 1024, 1024);
    conv_t<6>(sm, wsp<bf16_t>(WS_WF1), 5632, 1024, KP()->in[I_F1] + (size_t)l * 1024 * 5632, 5632);
    conv_t<5>(sm, wsp<bf16_t>(WS_WF2), 1024, 2816, KP()->in[I_F2] + (size_t)l * 2816 * 1024, 1024);
    conv_lora(l);
}

DI void phase_norm(const float* x, const float* g, bf16_t* h) {
    const int lane = TID() & 63, gw = BID() * 8 + (TID() >> 6), nw = gridDim.x * 8;
    f32x4 gv[4];
#pragma unroll
    for (int i = 0; i < 4; ++i) gv[i] = ((const f32x4*)g)[lane + 64 * i];
    for (int row = gw; row < NT; row += nw) {
        const f32x4* xr = (const f32x4*)(x + (size_t)row * DM);
        f32x4 v[4]; float ss = 0.f;
#pragma unroll
        for (int i = 0; i < 4; ++i) { v[i] = xr[lane + 64 * i]; ss += v[i][0] * v[i][0] + v[i][1] * v[i][1] + v[i][2] * v[i][2] + v[i][3] * v[i][3]; }
        ss = wave_sum(ss);
        const float rs = __builtin_amdgcn_rsqf(ss * (1.f / DM) + NORM_EPS);
#pragma unroll
        for (int i = 0; i < 4; ++i) {
            u32x2 o; o[0] = pk2(v[i][0] * rs * gv[i][0], v[i][1] * rs * gv[i][1]); o[1] = pk2(v[i][2] * rs * gv[i][2], v[i][3] * rs * gv[i][3]);
            *(u32x2*)(h + (size_t)row * DM + 4 * (lane + 64 * i)) = o;
        }
    }
}

struct SchedLin {
    int nM, nN, G, c; unsigned aoff, boff, a2off; int rowbytes, amode, cbase, pn2;
    DI bool next(int i, Unit& u) const { return pg8::order_xcd(nM, nN, G, c, i, u); }
    DI const char* aptr(const Unit& u) const { const int row0 = amode ? ((u.pm >> 1) * SEQ + cbase + (u.pm & 1) * 256) : u.pm * 256; return (const char*)KP()->ws + ((u.pn >= pn2) ? a2off : aoff) + (size_t)row0 * rowbytes; }
    DI const char* bptr(const Unit& u) const { return (const char*)KP()->ws + boff + (size_t)u.pn * 256 * rowbytes; }
};
DI SchedLin mk_sched(int nM, int nN, size_t aoff, size_t boff, int K, int amode = 0, int cbase = 0, size_t a2off = 0, int pn2 = 1 << 30) {
    SchedLin s; s.nM = nM; s.nN = nN; s.G = gridDim.x; s.c = BID(); s.aoff = (unsigned)aoff; s.boff = (unsigned)boff; s.rowbytes = K * 2; s.amode = amode; s.cbase = cbase; s.a2off = (unsigned)a2off; s.pn2 = pn2; return s;
}
struct SchedMerge {
    int G, c;
    DI bool next(int i, Unit& u) const { const int z = i % 3, tile = (i / 3) * G + c; if (tile >= 256) return false; u.pm = tile >> 2; u.pn = tile & 3; u.z = z; return true; }
    DI const char* aptr(const Unit& u) const { return (const char*)KP()->ws + (u.z == 0 ? WS_MQ : (u.z == 1 ? WS_ORW : WS_DQ)) + (size_t)(u.pm >> 5) * PAR_O + (size_t)(u.pm & 31) * 256 * 1024; }
    DI const char* bptr(const Unit& u) const { return (const char*)KP()->ws + WS_WBR + (size_t)u.z * (1024 * 512 * 2) + (size_t)u.pn * 256 * 1024; }
};

DI void st_bf4(bf16_t* p, f32x4 v) { u32x2 o; o[0] = pk2(v[0], v[1]); o[1] = pk2(v[2], v[3]); *(u32x2*)p = o; }
DI f32x4 ld_bf4(const bf16_t* p) { const u32x2 u = *(const u32x2*)p; return (f32x4){bflo(u[0]), bfhi(u[0]), bflo(u[1]), bfhi(u[1])}; }
#define EPI_ROWS(ai, m) (128 * (ai) + 64 * wr + 16 * (m) + fr)
#define EPI_COLS(bj, n) (64 * wc + 16 * fq + 8 * (bj) + 4 * (n))
#define EPI_COLS_T(bj, n) (128 * (bj) + 32 * wc + 16 * (n) + 4 * fq)
#define FOR_AM _Pragma("unroll") for (int ai = 0; ai < 2; ++ai) _Pragma("unroll") for (int m = 0; m < 4; ++m)
#define FOR_BN _Pragma("unroll") for (int bj = 0; bj < 2; ++bj) _Pragma("unroll") for (int n = 0; n < 2; ++n)

DI void epi_headnorm(const AccT& acc, bf16_t* out, int ld, const float* gain, int wr, int wc, int fr, int fq) {
    f32x4 gv[2][2];
    FOR_BN gv[bj][n] = *(const f32x4*)(gain + 16 * fq + 8 * bj + 4 * n);
    FOR_AM {
        float ss = 0.f;
        FOR_BN { const f32x4 a = acc[ai][bj][m][n]; ss += a[0] * a[0] + a[1] * a[1] + a[2] * a[2] + a[3] * a[3]; }
        ss += __shfl_xor(ss, 16); ss += __shfl_xor(ss, 32);
        const float sc = __builtin_amdgcn_rsqf(ss * (1.f / 64.f) + NORM_EPS);
        bf16_t* rp = out + (size_t)EPI_ROWS(ai, m) * ld;
        FOR_BN st_bf4(rp + EPI_COLS(bj, n), acc[ai][bj][m][n] * sc * gv[bj][n]);
    }
}
DI void epi_store_bf16(const AccT& acc, bf16_t* out, int ld, int wr, int wc, int fr, int fq) {
    FOR_AM { bf16_t* rp = out + (size_t)EPI_ROWS(ai, m) * ld; FOR_BN st_bf4(rp + EPI_COLS(bj, n), acc[ai][bj][m][n]); }
}

struct EpiB {
    int l;
    DI void operator()(const AccT& acc, const Unit& u, int wr, int wc, int fr, int fq) const {
        const size_t row0 = (size_t)u.pm * 256;
        if (u.pn < 2) epi_headnorm(acc, wsp<bf16_t>(WS_MK) + row0 * 512 + u.pn * 256, 512, KP()->in[I_QKN] + l * 256 + 64, wr, wc, fr, fq);
        else if (u.pn == 2) epi_store_bf16(acc, wsp<bf16_t>(WS_DCN) + row0 * 256, 256, wr, wc, fr, fq);
        else {
            bf16_t* idxk = wsp<bf16_t>(WS_IDXK); float* idxw = wsp<float>(WS_IDXW); bf16_t* left = wsp<bf16_t>(WS_LEFT);
            FOR_AM { const size_t row = row0 + EPI_ROWS(ai, m);
                if (wc == 0 && fq < 2) { FOR_BN st_bf4(idxk + row * 32 + 16 * fq + 8 * bj + 4 * n, acc[ai][bj][m][n]); }
                else if (wc == 0 && fq == 2) { *(f32x4*)(idxw + row * 8) = acc[ai][0][m][0]; *(f32x4*)(idxw + row * 8 + 4) = acc[ai][0][m][1]; }
                else if (wc == 1 && fq < 2) { FOR_BN st_bf4(left + row * 32 + 16 * fq + 8 * bj + 4 * n, acc[ai][bj][m][n]); }
            }
        }
    }
};
struct EpiVt {
    unsigned off;
    DI void operator()(const AccT& acc, const Unit& u, int wr, int wc, int fr, int fq) const {
        bf16_t* vt = wsp<bf16_t>(off);
        const int b = u.pn >> 3, s0 = (u.pn & 7) * 256;
        FOR_AM { bf16_t* rp = vt + ((size_t)b * 512 + u.pm * 256 + EPI_ROWS(ai, m)) * SEQ + s0; FOR_BN st_bf4(rp + EPI_COLS_T(bj, n), acc[ai][bj][m][n]); }
    }
};
struct EpiHN {
    int l;
    DI void operator()(const AccT& acc, const Unit& u, int wr, int wc, int fr, int fq) const { epi_headnorm(acc, wsp<bf16_t>(WS_DK) + (size_t)u.pm * 256 * 512 + u.pn * 256, 512, KP()->in[I_QKN] + l * 256 + 192, wr, wc, fr, fq); }
};
struct EpiD1 {
    int l, par;
    DI void operator()(const AccT& acc, const Unit& u, int wr, int wc, int fr, int fq) const {
        const size_t row0 = (size_t)u.pm * 256;
        if (u.pn < 2) epi_headnorm(acc, wsp<bf16_t>(WS_MQ + par * PAR_O) + row0 * 512 + u.pn * 256, 512, KP()->in[I_QKN] + l * 256, wr, wc, fr, fq);
        else if (u.pn < 4) epi_headnorm(acc, wsp<bf16_t>(WS_DQ + par * PAR_O) + row0 * 512 + (u.pn - 2) * 256, 512, KP()->in[I_QKN] + l * 256 + 128, wr, wc, fr, fq);
        else if (u.pn == 4) epi_store_bf16(acc, wsp<bf16_t>(WS_IDXQ) + row0 * 256, 256, wr, wc, fr, fq);
        else if (u.pn < 12) epi_store_bf16(acc, wsp<bf16_t>(WS_RAW) + row0 * RAWLD + (u.pn - 5) * 256, RAWLD, wr, wc, fr, fq);
        else {
            unsigned char* o = wsp<unsigned char>(WS_GATES + par * PAR_G) + row0 * 3072 + (u.pn - 12) * 256;
            FOR_AM { unsigned char* rp = o + (size_t)EPI_ROWS(ai, m) * 3072;
                FOR_BN { const f32x4 a = acc[ai][bj][m][n];
                    const unsigned q0 = (unsigned)(fsigmoid(a[0]) * 255.f + 0.5f), q1 = (unsigned)(fsigmoid(a[1]) * 255.f + 0.5f), q2 = (unsigned)(fsigmoid(a[2]) * 255.f + 0.5f), q3 = (unsigned)(fsigmoid(a[3]) * 255.f + 0.5f);
                    *(unsigned*)(rp + EPI_COLS(bj, n)) = q0 | (q1 << 8) | (q2 << 16) | (q3 << 24); } }
        }
    }
};
struct EpiLora {
    int l, cbase;
    DI void operator()(const AccT& acc, const Unit& u, int wr, int wc, int fr, int fq) const {
        const size_t row0 = (size_t)u.pm * 256; const int kind = u.pn >> 1, cb = (u.pn & 1) * 256;
        if (kind == 0) {
            float* dec = wsp<float>(WS_DEC); const float* w0 = KP()->in[I_W0] + l * 512;
            FOR_AM { const size_t row = row0 + EPI_ROWS(ai, m);
                FOR_BN { const int col = cb + EPI_COLS(bj, n); const f32x4 a = acc[ai][bj][m][n]; const f32x4 wv = *(const f32x4*)(w0 + col); f32x4 d;
#pragma unroll
                    for (int e = 0; e < 4; ++e) { const float x = -(wv[e] + a[e]);
                        const float sp = fmaxf(x, 0.f) + __builtin_amdgcn_logf(1.f + fexp2(-fabsf(x) * LOG2E)) * 0.6931471805599453f;
                        const float w = -sp - 0.5f; d[e] = fexp2(-fexp2(w * LOG2E) * LOG2E); }
                    *(f32x4*)(dec + row * 512 + col) = d; } }
        } else if (kind == 1) {
            bf16_t* kf = wsp<bf16_t>(WS_KF); const bf16_t* kkb = wsp<bf16_t>(WS_KKB); bf16_t* bbb = wsp<bf16_t>(WS_BBB);
            const float* a0 = KP()->in[I_A0] + l * 512; const float* ka = KP()->in[I_KA] + l * 512;
            FOR_AM { const size_t row = row0 + EPI_ROWS(ai, m);
                f32x4 kp[2][2], kk[2][2];
                FOR_BN { const int col = cb + EPI_COLS(bj, n); kp[bj][n] = ld_bf4(kf + row * 512 + col); kk[bj][n] = ld_bf4(kkb + row * 512 + col); }
                FOR_BN { const int col = cb + EPI_COLS(bj, n); const f32x4 a = acc[ai][bj][m][n];
                    const f32x4 av = *(const f32x4*)(a0 + col), kav = *(const f32x4*)(ka + col); f32x4 ko, bo;
#pragma unroll
                    for (int e = 0; e < 4; ++e) { const float s = fsigmoid(av[e] + a[e]); ko[e] = kp[bj][n][e] * (1.f + (s - 1.f) * kav[e]); bo[e] = kk[bj][n][e] * s; }
                    st_bf4(kf + row * 512 + col, ko); st_bf4(bbb + row * 512 + col, bo); } }
        } else if (kind == 2) {
            epi_store_bf16(acc, wsp<bf16_t>(WS_GG) + row0 * 512 + cb, 512, wr, wc, fr, fq);
        } else {
            const bf16_t* vv = wsp<bf16_t>(WS_VV); bf16_t* v2 = wsp<bf16_t>(WS_V2); const bf16_t* vfirst = wsp<bf16_t>(WS_VFIRST); const float* v0 = KP()->in[I_V0];
            FOR_AM { const size_t row = row0 + EPI_ROWS(ai, m); const size_t arow = (size_t)(row >> 9) * SEQ + cbase + (row & 511);
                f32x4 vp[2][2], vf[2][2];
                FOR_BN { const int col = cb + EPI_COLS(bj, n); vp[bj][n] = ld_bf4(vv + row * 512 + col); vf[bj][n] = ld_bf4(vfirst + arow * 512 + col); }
                FOR_BN { const int col = cb + EPI_COLS(bj, n); const f32x4 a = acc[ai][bj][m][n]; const f32x4 v0v = *(const f32x4*)(v0 + col); f32x4 o;
#pragma unroll
                    for (int e = 0; e < 4; ++e) o[e] = vp[bj][n][e] + (vf[bj][n][e] - vp[bj][n][e]) * fsigmoid(v0v[e] + a[e]);
                    st_bf4(v2 + row * 512 + col, o); } }
        }
    }
};
struct EpiMerge {
    DI void operator()(const AccT& acc, const Unit& u, int wr, int wc, int fr, int fq) const {
        bf16_t* y = wsp<bf16_t>(WS_Y); const unsigned char* gates = wsp<unsigned char>(WS_GATES + (size_t)(u.pm >> 5) * PAR_G);
        const size_t row0 = (size_t)u.pm * 256, grow0 = (size_t)(u.pm & 31) * 256; const int c0 = u.pn * 256 + 64 * wc + 16 * fq, z = u.z;
#pragma unroll
        for (int ai = 0; ai < 2; ++ai)
#pragma unroll
            for (int mp = 0; mp < 2; ++mp) {
                u32x4 g[2]; u32x4 y0[2], y1[2];
#pragma unroll
                for (int mm = 0; mm < 2; ++mm) { const int rt = EPI_ROWS(ai, 2 * mp + mm);
                    g[mm] = *(const u32x4*)(gates + (grow0 + rt) * 3072 + z * 1024 + c0);
                    if (z > 0) { y0[mm] = *(const u32x4*)(y + (row0 + rt) * 1024 + c0); y1[mm] = *(const u32x4*)(y + (row0 + rt) * 1024 + c0 + 8); } }
#pragma unroll
                for (int mm = 0; mm < 2; ++mm) { const int m = 2 * mp + mm; const size_t row = row0 + EPI_ROWS(ai, m);
                    u32x4 o0, o1;
#pragma unroll
                    for (int bj = 0; bj < 2; ++bj)
#pragma unroll
                        for (int n = 0; n < 2; ++n) { const int q = 2 * bj + n; const unsigned gu = g[mm][q];
                            const f32x4 gf = (f32x4){(float)(gu & 255u), (float)((gu >> 8) & 255u), (float)((gu >> 16) & 255u), (float)(gu >> 24)} * (1.f / 255.f);
                            f32x4 v = acc[ai][bj][m][n] * gf;
                            if (z > 0) { const u32x4 yy = (q < 2) ? y0[mm] : y1[mm]; const unsigned ya = yy[2 * (q & 1)], yb = yy[2 * (q & 1) + 1]; v += (f32x4){bflo(ya), bfhi(ya), bflo(yb), bfhi(yb)}; }
                            const unsigned pa = pk2(v[0], v[1]), pb = pk2(v[2], v[3]);
                            if (q < 2) { o0[2 * q] = pa; o0[2 * q + 1] = pb; } else { o1[2 * (q - 2)] = pa; o1[2 * (q - 2) + 1] = pb; } }
                    *(u32x4*)(y + row * 1024 + c0) = o0; *(u32x4*)(y + row * 1024 + c0 + 8) = o1; }
            }
    }
};
struct EpiRes {
    int first, amode, cbase; unsigned dummy_off;
    DI void operator()(const AccT& acc, const Unit& u, int wr, int wc, int fr, int fq) const {
        float* out = KP()->out; const float* res = first ? KP()->in[I_X] : (const float*)out;
        if (dummy_off) out = wsp<float>(dummy_off);
        const size_t grow0 = amode == 2 ? ((size_t)((u.pm & 31) >> 1) * SEQ + cbase + (u.pm >> 5) * SC + (u.pm & 1) * 256) : (amode ? ((size_t)(u.pm >> 1) * SEQ + cbase + (u.pm & 1) * 256) : (size_t)u.pm * 256); const int c0 = u.pn * 256;
#pragma unroll
        for (int ai = 0; ai < 2; ++ai)
#pragma unroll
            for (int mp = 0; mp < 2; ++mp) {
                f32x4 rv[2][2][2];
#pragma unroll
                for (int mm = 0; mm < 2; ++mm) { const size_t row = grow0 + EPI_ROWS(ai, 2 * mp + mm); FOR_BN rv[mm][bj][n] = *(const f32x4*)(res + row * DM + c0 + EPI_COLS(bj, n)); }
#pragma unroll
                for (int mm = 0; mm < 2; ++mm) { const int m = 2 * mp + mm; const size_t row = grow0 + EPI_ROWS(ai, m); FOR_BN *(f32x4*)(out + row * DM + c0 + EPI_COLS(bj, n)) = rv[mm][bj][n] + acc[ai][bj][m][n]; }
            }
    }
};
struct EpiSwiglu {
    DI void operator()(const AccT& acc, const Unit& u, int wr, int wc, int fr, int fq) const {
        bf16_t* act = wsp<bf16_t>(WS_ACT);
        FOR_AM { bf16_t* rp = act + ((size_t)u.pm * 256 + EPI_ROWS(ai, m)) * DFF + u.pn * 128 + 32 * wc + 8 * fq;
            u32x4 w;
#pragma unroll
            for (int n = 0; n < 2; ++n) { const f32x4 g = acc[ai][0][m][n], up = acc[ai][1][m][n]; f32x4 o;
#pragma unroll
                for (int e = 0; e < 4; ++e) o[e] = g[e] * fsigmoid(g[e]) * up[e];
                w[2 * n] = pk2(o[0], o[1]); w[2 * n + 1] = pk2(o[2], o[3]); }
            *(u32x4*)rp = w; }
    }
};

DI void phase_dcn(int l) {
    const int lane = TID() & 63, gw = BID() * 8 + (TID() >> 6), nw = gridDim.x * 8;
    bf16_t* dcn = wsp<bf16_t>(WS_DCN);
    const f32x4 g = *(const f32x4*)(KP()->in[I_KVN] + l * 256 + 4 * lane);
    for (int row = gw; row < NT; row += nw) {
        bf16_t* rp = dcn + (size_t)row * 256 + 4 * lane;
        const f32x4 v = ld_bf4(rp);
        const float ss = wave_sum(v[0] * v[0] + v[1] * v[1] + v[2] * v[2] + v[3] * v[3]);
        const float rs = __builtin_amdgcn_rsqf(ss * (1.f / 256.f) + NORM_EPS);
        st_bf4(rp, v * rs * g);
    }
}
DI void phase_kmean() {
    const int lane = TID() & 63, gw = BID() * 8 + (TID() >> 6), nw = gridDim.x * 8;
    const bf16_t* mk = wsp<bf16_t>(WS_MK); float* km = wsp<float>(WS_KMEAN);
    for (int it = gw; it < NB * NH * 8; it += nw) {
        const int n = it & 7, h = (it >> 3) & 7, b = it >> 6;
        const bf16_t* kp = mk + ((size_t)b * SEQ + n * 256) * 512 + h * 64 + lane;
        float s0 = 0.f, s1 = 0.f, s2 = 0.f, s3 = 0.f;
        for (int k = 0; k < 256; k += 32) {
            bf16_t v[32];
#pragma unroll
            for (int j = 0; j < 32; ++j) v[j] = kp[(size_t)(k + j) * 512];
#pragma unroll
            for (int j = 0; j < 32; j += 4) { s0 += bf2f(v[j]); s1 += bf2f(v[j + 1]); s2 += bf2f(v[j + 2]); s3 += bf2f(v[j + 3]); }
        }
        km[(size_t)it * 64 + lane] = ((s0 + s1) + (s2 + s3)) * (1.f / 256.f);
    }
}

DI void phase_rwkv_prep(int l, int c) {
    const int lane = TID() & 63, gw = BID() * 8 + (TID() >> 6), nw = gridDim.x * 8;
    const bf16_t* raw = wsp<bf16_t>(WS_RAW); const bf16_t* left = wsp<bf16_t>(WS_LEFT); bf16_t* carry = wsp<bf16_t>(WS_CARRY);
    bf16_t* rr = wsp<bf16_t>(WS_RR); bf16_t* kf = wsp<bf16_t>(WS_KF); bf16_t* vv = wsp<bf16_t>(WS_VV); bf16_t* kkb = wsp<bf16_t>(WS_KKB);
    bf16_t* la = wsp<bf16_t>(WS_LORAA); bf16_t* vfirst = wsp<bf16_t>(WS_VFIRST);
    const float* mu = KP()->in[I_MU] + l * 1824; const float* kkw = KP()->in[I_KK] + l * 512;
    for (int rc = gw; rc < TC; rc += nw) {
        const int b = rc >> 9, sl = rc & 511, s = c * SC + sl; const size_t ra = (size_t)b * SEQ + s;
        const bf16_t* cur = raw + (size_t)rc * RAWLD;
        const bf16_t* prv = (sl > 0) ? (cur - RAWLD) : (carry + (size_t)((((c + 1) & 1) * 16) + b) * RAWLD);
        const bool hp = s > 0;
        auto mix8 = [&](int j, float* o) {
            const u32x4 cu = *(const u32x4*)(cur + j); u32x4 pu = {0u, 0u, 0u, 0u}; if (hp) pu = *(const u32x4*)(prv + j);
            const f32x4 m0 = *(const f32x4*)(mu + j), m1 = *(const f32x4*)(mu + j + 4);
#pragma unroll
            for (int e = 0; e < 4; ++e) { const float c0 = bflo(cu[e]), c1 = bfhi(cu[e]), p0 = bflo(pu[e]), p1 = bfhi(pu[e]);
                const float ma = (2 * e < 4) ? m0[2 * e] : m1[2 * e - 4], mb = (2 * e + 1 < 4) ? m0[2 * e + 1] : m1[2 * e + 1 - 4];
                o[2 * e] = c0 + (p0 - c0) * ma; o[2 * e + 1] = c1 + (p1 - c1) * mb; }
        };
        auto mix1 = [&](int j) -> float { const float c0 = bf2f(cur[j]); const float p0 = hp ? bf2f(prv[j]) : 0.f; return c0 + (p0 - c0) * mu[j]; };
        float o[8];
        mix8(8 * lane, o);
        { u32x4 w; w[0] = pk2(o[0], o[1]); w[1] = pk2(o[2], o[3]); w[2] = pk2(o[4], o[5]); w[3] = pk2(o[6], o[7]); *(u32x4*)(rr + (size_t)rc * 512 + 8 * lane) = w; }
        mix8(576 + 8 * lane, o);
        { u32x4 w; w[0] = pk2(o[0], o[1]); w[1] = pk2(o[2], o[3]); w[2] = pk2(o[4], o[5]); w[3] = pk2(o[6], o[7]); *(u32x4*)(kf + (size_t)rc * 512 + 8 * lane) = w;
          const f32x4 k0 = *(const f32x4*)(kkw + 8 * lane), k1 = *(const f32x4*)(kkw + 8 * lane + 4);
          float q[8]; float ss = 0.f;
#pragma unroll
          for (int e = 0; e < 8; ++e) { q[e] = o[e] * (e < 4 ? k0[e] : k1[e - 4]); ss += q[e] * q[e]; }
          ss += __shfl_xor(ss, 1); ss += __shfl_xor(ss, 2); ss += __shfl_xor(ss, 4);
          const float inv = 1.f / fmaxf(sqrtf(ss), 1e-12f);
          w[0] = pk2(q[0] * inv, q[1] * inv); w[1] = pk2(q[2] * inv, q[3] * inv); w[2] = pk2(q[4] * inv, q[5] * inv); w[3] = pk2(q[6] * inv, q[7] * inv);
          *(u32x4*)(kkb + (size_t)rc * 512 + 8 * lane) = w; }
        mix8(1088 + 8 * lane, o);
        { u32x4 w; w[0] = pk2(o[0], o[1]); w[1] = pk2(o[2], o[3]); w[2] = pk2(o[4], o[5]); w[3] = pk2(o[6], o[7]); *(u32x4*)(vv + (size_t)rc * 512 + 8 * lane) = w;
          if (l == 0) *(u32x4*)(vfirst + ra * 512 + 8 * lane) = w; }
        bf16_t* lr = la + (size_t)rc * 512;
        { const float x = mix1(512 + lane); const float t = fexp2(2.f * x * LOG2E); lr[lane] = f2bf(1.f - 2.f * frcp(t + 1.f)); }
        lr[64 + lane] = f2bf(mix1(1600 + lane));
        lr[128 + lane] = f2bf(fsigmoid(mix1(1664 + lane)));
        lr[192 + lane] = f2bf(fsigmoid(mix1(1728 + lane)));
        if (lane < 32) { const float c0 = bf2f(left[ra * 32 + lane]); const float p0 = hp ? bf2f(left[(ra - 1) * 32 + lane]) : 0.f;
            lr[256 + lane] = f2bf(fsigmoid(c0 + (p0 - c0) * mu[1792 + lane])); }
        if (lane < 56) *(u32x2*)(lr + 288 + 4 * lane) = (u32x2){0u, 0u};
        if (sl == SC - 1) { bf16_t* cp = carry + (size_t)(((c & 1) * 16) + b) * RAWLD;
            for (int j = lane; j < RAWLD / 8; j += 64) *(u32x4*)(cp + 8 * j) = *(const u32x4*)(cur + 8 * j); }
    }
}

DI float dpp_ror_add(float x, int) { return x; }
DI void reduce4(float p0, float p1, float p2, float p3, float& s0, float& s1, float& s2, float& s3) {
    auto r = __builtin_amdgcn_permlane32_swap(__float_as_uint(p0), __float_as_uint(p2), false, false);
    const float u0 = __uint_as_float(r[0]) + __uint_as_float(r[1]);
    r = __builtin_amdgcn_permlane32_swap(__float_as_uint(p1), __float_as_uint(p3), false, false);
    const float u1 = __uint_as_float(r[0]) + __uint_as_float(r[1]);
    r = __builtin_amdgcn_permlane16_swap(__float_as_uint(u0), __float_as_uint(u1), false, false);
    float w = __uint_as_float(r[0]) + __uint_as_float(r[1]);
    w += __uint_as_float(__builtin_amdgcn_update_dpp(0, __float_as_uint(w), 0x128, 0xf, 0xf, false));
    w += __uint_as_float(__builtin_amdgcn_update_dpp(0, __float_as_uint(w), 0x124, 0xf, 0xf, false));
    w += __uint_as_float(__builtin_amdgcn_update_dpp(0, __float_as_uint(w), 0x122, 0xf, 0xf, false));
    w += __uint_as_float(__builtin_amdgcn_update_dpp(0, __float_as_uint(w), 0x121, 0xf, 0xf, false));
    s0 = __uint_as_float(__builtin_amdgcn_readlane(__float_as_uint(w), 0));
    s1 = __uint_as_float(__builtin_amdgcn_readlane(__float_as_uint(w), 16));
    s2 = __uint_as_float(__builtin_amdgcn_readlane(__float_as_uint(w), 32));
    s3 = __uint_as_float(__builtin_amdgcn_readlane(__float_as_uint(w), 48));
}
DI void reduce8(float p0, float p1, float p2, float p3, float q0, float q1, float q2, float q3, float& pw, float& s0, float& s1, float& s2, float& s3) {
    auto r = __builtin_amdgcn_permlane32_swap(__float_as_uint(p0), __float_as_uint(p2), false, false);
    auto t = __builtin_amdgcn_permlane32_swap(__float_as_uint(q0), __float_as_uint(q2), false, false);
    const float u0 = __uint_as_float(r[0]) + __uint_as_float(r[1]);
    const float x0 = __uint_as_float(t[0]) + __uint_as_float(t[1]);
    r = __builtin_amdgcn_permlane32_swap(__float_as_uint(p1), __float_as_uint(p3), false, false);
    t = __builtin_amdgcn_permlane32_swap(__float_as_uint(q1), __float_as_uint(q3), false, false);
    const float u1 = __uint_as_float(r[0]) + __uint_as_float(r[1]);
    const float x1 = __uint_as_float(t[0]) + __uint_as_float(t[1]);
    r = __builtin_amdgcn_permlane16_swap(__float_as_uint(u0), __float_as_uint(u1), false, false);
    t = __builtin_amdgcn_permlane16_swap(__float_as_uint(x0), __float_as_uint(x1), false, false);
    float w = __uint_as_float(r[0]) + __uint_as_float(r[1]);
    float y = __uint_as_float(t[0]) + __uint_as_float(t[1]);
    w += __uint_as_float(__builtin_amdgcn_update_dpp(0, __float_as_uint(w), 0x128, 0xf, 0xf, false));
    y += __uint_as_float(__builtin_amdgcn_update_dpp(0, __float_as_uint(y), 0x128, 0xf, 0xf, false));
    w += __uint_as_float(__builtin_amdgcn_update_dpp(0, __float_as_uint(w), 0x124, 0xf, 0xf, false));
    y += __uint_as_float(__builtin_amdgcn_update_dpp(0, __float_as_uint(y), 0x124, 0xf, 0xf, false));
    w += __uint_as_float(__builtin_amdgcn_update_dpp(0, __float_as_uint(w), 0x122, 0xf, 0xf, false));
    y += __uint_as_float(__builtin_amdgcn_update_dpp(0, __float_as_uint(y), 0x122, 0xf, 0xf, false));
    w += __uint_as_float(__builtin_amdgcn_update_dpp(0, __float_as_uint(w), 0x121, 0xf, 0xf, false));
    y += __uint_as_float(__builtin_amdgcn_update_dpp(0, __float_as_uint(y), 0x121, 0xf, 0xf, false));
    pw = w;
    s0 = __uint_as_float(__builtin_amdgcn_readlane(__float_as_uint(y), 0));
    s1 = __uint_as_float(__builtin_amdgcn_readlane(__float_as_uint(y), 16));
    s2 = __uint_as_float(__builtin_amdgcn_readlane(__float_as_uint(y), 32));
    s3 = __uint_as_float(__builtin_amdgcn_readlane(__float_as_uint(y), 48));
}
struct ScanIn { bf16_t kk, bb, k, r, v; float w; };
DI void phase_scan(int l, int c, int dummy = 0) {
    const int lane = TID() & 63, gw = BID() * 8 + (TID() >> 6), nw = gridDim.x * 8;
    const bf16_t* kkb = wsp<bf16_t>(WS_KKB); const bf16_t* bbb = wsp<bf16_t>(WS_BBB); const bf16_t* kfb = wsp<bf16_t>(WS_KF); const bf16_t* rrb = wsp<bf16_t>(WS_RR);
    const bf16_t* vsb = wsp<bf16_t>(l == 0 ? WS_VV : WS_V2); const float* dec = wsp<float>(WS_DEC); float* outb = wsp<float>(WS_OUT); float* state = wsp<float>(WS_STATE);
    for (int item = gw; item < NB * NH * 16; item += nw) {
        const int bh = item >> 4, rg = item & 15, b = bh >> 3, h = bh & 7, i0 = rg * 4;
        float* stp = state + ((size_t)bh * 64 + i0) * 64 + lane;
        float S0 = 0.f, S1 = 0.f, S2 = 0.f, S3 = 0.f;
        if (c > 0) { S0 = stp[0]; S1 = stp[64]; S2 = stp[128]; S3 = stp[192]; }
        const size_t e0 = (size_t)b * SC * 512 + h * 64 + lane;
        const size_t ev = (size_t)b * SC * 512 + h * 64 + i0 + (lane & 3);
        float* op = outb + (size_t)b * SC * 512 + h * 64 + i0 + (lane >> 4);
        ScanIn A[8], B[8];
#define SCAN_LOAD(X, g) do { _Pragma("unroll") for (int j = 0; j < 8; ++j) { const size_t o = (size_t)((g) * 8 + j) * 512; \
            X[j].kk = kkb[e0 + o]; X[j].bb = bbb[e0 + o]; X[j].k = kfb[e0 + o]; X[j].r = rrb[e0 + o]; X[j].w = dec[e0 + o]; X[j].v = vsb[ev + o]; } } while (0)
#define SCAN_STEP1(Xj, kknext, t) do { \
            const float bb = bf2f(Xj.bb), kx = bf2f(Xj.k), rx = bf2f(Xj.r), wx = Xj.w; const unsigned vu = (unsigned)Xj.v << 16; \
            const float v0 = __uint_as_float(__builtin_amdgcn_readlane(vu, 0)), v1 = __uint_as_float(__builtin_amdgcn_readlane(vu, 1)), v2 = __uint_as_float(__builtin_amdgcn_readlane(vu, 2)), v3 = __uint_as_float(__builtin_amdgcn_readlane(vu, 3)); \
            S0 = S0 * wx + (v0 * kx - a0 * bb); S1 = S1 * wx + (v1 * kx - a1 * bb); S2 = S2 * wx + (v2 * kx - a2 * bb); S3 = S3 * wx + (v3 * kx - a3 * bb); \
            float ov; const float kn = (kknext); \
            reduce8(S0 * rx, S1 * rx, S2 * rx, S3 * rx, S0 * kn, S1 * kn, S2 * kn, S3 * kn, ov, a0, a1, a2, a3); \
            if ((lane & 15) == 0) op[(size_t)(t) * 512] = ov; } while (0)
#define SCAN_GROUP(X, Y, g, lastg) do { _Pragma("unroll") for (int j = 0; j < 8; ++j) { \
            const float kkn = (j < 7) ? bf2f(X[j < 7 ? j + 1 : 7].kk) : ((lastg) ? 0.f : bf2f(Y[0].kk)); \
            SCAN_STEP1(X[j], kkn, (g) * 8 + j); } } while (0)
        SCAN_LOAD(A, 0);
        float a0, a1, a2, a3;
        { const float k0 = bf2f(A[0].kk); reduce4(S0 * k0, S1 * k0, S2 * k0, S3 * k0, a0, a1, a2, a3); }
#if DBL_PHASE == 11
        if (dummy == 2) {
            float acc_ = 0.f;
            for (int g = 0; g < SC / 8; g += 2) {
                SCAN_LOAD(B, g + 1);
#pragma unroll
                for (int j = 0; j < 8; ++j) acc_ += bf2f(A[j].kk) + bf2f(A[j].bb) + bf2f(A[j].k) + bf2f(A[j].r) + bf2f(A[j].v) + A[j].w;
                if (g + 2 < SC / 8) SCAN_LOAD(A, g + 2);
#pragma unroll
                for (int j = 0; j < 8; ++j) acc_ += bf2f(B[j].kk) + bf2f(B[j].bb) + bf2f(B[j].k) + bf2f(B[j].r) + bf2f(B[j].v) + B[j].w;
            }
            if (acc_ == 12345.678f) stp[0] = acc_;
            continue;
        }
#endif
#if DBL_PHASE == 12
        if (dummy == 3) {
#pragma unroll
            for (int j = 0; j < 8; ++j) { A[j].kk = (bf16_t)(0x3c00 + lane + j); A[j].bb = (bf16_t)(0x3b00 + lane); A[j].k = (bf16_t)(0x3d00 + j); A[j].r = (bf16_t)(0x3e00 + lane); A[j].v = (bf16_t)(0x3c80 + j); A[j].w = 0.9f; B[j] = A[j]; }
            op = wsp<float>(WS_RAW) + (size_t)item * 4 + (lane >> 4);
            for (int g = 0; g < SC / 8; g += 2) {
                SCAN_GROUP(A, B, 0, false);
                SCAN_GROUP(B, A, 0, false);
            }
            if (S0 + S1 + S2 + S3 == 12345.678f) stp[0] = S0;
            continue;
        }
#endif
        for (int g = 0; g < SC / 8; g += 2) {
            SCAN_LOAD(B, g + 1);
            SCAN_GROUP(A, B, g, false);
            const bool last = (g + 2 >= SC / 8);
            if (!last) SCAN_LOAD(A, g + 2);
            SCAN_GROUP(B, A, g + 1, last);
        }
#undef SCAN_STEP1
#undef SCAN_GROUP
#undef SCAN_LOAD
        if (!dummy) { stp[0] = S0; stp[64] = S1; stp[128] = S2; stp[192] = S3; }
    }
}
typedef short s16x4 __attribute__((ext_vector_type(4)));
#define M16K32(a, b, c) __builtin_amdgcn_mfma_f32_16x16x32_bf16((a), (b), (c), 0, 0, 0)
#define M16K16(a, b, c) __builtin_amdgcn_mfma_f32_16x16x16bf16_1k((a), (b), (c), 0, 0, 0)
DI s16x4 pk4(f32x4 v) { u32x2 u; u[0] = pk2(v[0], v[1]); u[1] = pk2(v[2], v[3]); return __builtin_bit_cast(s16x4, u); }
DI float dpp_shr1(float x, float old) { return __uint_as_float(__builtin_amdgcn_update_dpp(__float_as_uint(old), __float_as_uint(x), 0x111, 0xf, 0xf, false)); }
DI float dpp_shr2(float x, float old) { return __uint_as_float(__builtin_amdgcn_update_dpp(__float_as_uint(old), __float_as_uint(x), 0x112, 0xf, 0xf, false)); }
DI float dpp_shr4(float x, float old) { return __uint_as_float(__builtin_amdgcn_update_dpp(__float_as_uint(old), __float_as_uint(x), 0x114, 0xf, 0xf, false)); }
DI float dpp_shr8(float x, float old) { return __uint_as_float(__builtin_amdgcn_update_dpp(__float_as_uint(old), __float_as_uint(x), 0x118, 0xf, 0xf, false)); }
DI float dpp_bcast15(float x) { return __uint_as_float(__builtin_amdgcn_update_dpp(0, __float_as_uint(x), 0x15F, 0xf, 0xf, false)); }
DI void phase_scan_chunked(int l, int c, LAS unsigned char* lds, bool dummy = false) {
    const int tid = TID(), lane = tid & 63, wave = tid >> 6, r16 = lane & 15, g = lane >> 4;
    if (wave >= 2) return;
    const int item = BID() * 2 + wave;
    if (item >= NB * NH * 4) return;
    const int bh = item >> 2, ig = item & 3, b = bh >> 3, h = bh & 7, i0 = 16 * ig;
    LAS unsigned char* wl = lds + wave * 4096;
    const bf16_t* kkb = wsp<bf16_t>(WS_KKB); const bf16_t* bbb = wsp<bf16_t>(WS_BBB); const bf16_t* kfb = wsp<bf16_t>(WS_KF); const bf16_t* rrb = wsp<bf16_t>(WS_RR);
    const bf16_t* vsb = wsp<bf16_t>(l == 0 ? WS_VV : WS_V2); const float* dec = wsp<float>(WS_DEC); float* outb = wsp<float>(WS_OUT);
    float* stp = wsp<float>(WS_STATE) + ((size_t)bh * 64 + i0 + r16) * 64 + 8 * g;
    f32x4 ST[4];
#pragma unroll
    for (int sg = 0; sg < 4; ++sg) ST[sg] = (c > 0) ? *(const f32x4*)(stp + 32 * (sg >> 1) + 4 * (sg & 1)) : (f32x4){0.f, 0.f, 0.f, 0.f};
    const size_t e0 = ((size_t)b * SC + r16) * 512 + h * 64 + 8 * g;
    const size_t ev = ((size_t)b * SC + 4 * g) * 512 + h * 64 + i0 + r16;
    const size_t eo = ((size_t)b * SC + 4 * g) * 512 + h * 64 + i0 + r16;
    u32x4 rk[2], rb[2], rq[2], rr_[2]; f32x4 rw[4]; bf16_t rv[4];
#define CS_LOAD(blk) do { const size_t o = e0 + (size_t)(blk) * 16 * 512; _Pragma("unroll") for (int s = 0; s < 2; ++s) { \
        rk[s] = *(const u32x4*)(kkb + o + 32 * s); rb[s] = *(const u32x4*)(bbb + o + 32 * s); rq[s] = *(const u32x4*)(kfb + o + 32 * s); rr_[s] = *(const u32x4*)(rrb + o + 32 * s); \
        rw[2 * s] = *(const f32x4*)(dec + o + 32 * s); rw[2 * s + 1] = *(const f32x4*)(dec + o + 32 * s + 4); } \
        _Pragma("unroll") for (int e = 0; e < 4; ++e) rv[e] = vsb[ev + (size_t)(blk) * 16 * 512 + (size_t)e * 512]; } while (0)
    CS_LOAD(0);
    for (int blk = 0; blk < SC / 16; ++blk) {
        float P[16], kap[16], bet[16], kq[16], rt[16];
#pragma unroll
        for (int s = 0; s < 2; ++s)
#pragma unroll
            for (int q = 0; q < 4; ++q) { const int i = 8 * s + 2 * q;
                kap[i] = bflo(rk[s][q]); kap[i + 1] = bfhi(rk[s][q]); bet[i] = bflo(rb[s][q]); bet[i + 1] = bfhi(rb[s][q]);
                kq[i] = bflo(rq[s][q]); kq[i + 1] = bfhi(rq[s][q]); rt[i] = bflo(rr_[s][q]); rt[i + 1] = bfhi(rr_[s][q]);
                P[i] = rw[2 * s + (q >> 1)][2 * (q & 1)]; P[i + 1] = rw[2 * s + (q >> 1)][2 * (q & 1) + 1]; }
        s16x4 Vb; { u32x2 u; u[0] = (unsigned)rv[0] | ((unsigned)rv[1] << 16); u[1] = (unsigned)rv[2] | ((unsigned)rv[3] << 16); Vb = __builtin_bit_cast(s16x4, u); }
        if (blk + 1 < SC / 16) CS_LOAD(blk + 1);
        float P16[16];
        bf16x8 ktp[2], btp[2], kqp[2], rtp[2];
#pragma unroll
        for (int i = 0; i < 16; ++i) { float p = P[i];
            p *= dpp_shr1(p, 1.f); p *= dpp_shr2(p, 1.f); p *= dpp_shr4(p, 1.f); p *= dpp_shr8(p, 1.f);
            const float pm1 = dpp_shr1(p, 1.f); const float inv = frcp(p); const float p16 = dpp_bcast15(p);
            P16[i] = p16; kap[i] *= pm1; bet[i] *= inv; kq[i] *= inv; rt[i] *= p; }
#pragma unroll
        for (int s = 0; s < 2; ++s) { u32x4 a, bb_, cc, dd;
#pragma unroll
            for (int q = 0; q < 4; ++q) { const int i = 8 * s + 2 * q; a[q] = pk2(kap[i], kap[i + 1]); bb_[q] = pk2(bet[i], bet[i + 1]); cc[q] = pk2(kq[i], kq[i + 1]); dd[q] = pk2(rt[i], rt[i + 1]); }
            ktp[s] = __builtin_bit_cast(bf16x8, a); btp[s] = __builtin_bit_cast(bf16x8, bb_); kqp[s] = __builtin_bit_cast(bf16x8, cc); rtp[s] = __builtin_bit_cast(bf16x8, dd); }
#pragma unroll
        for (int s = 0; s < 2; ++s)
#pragma unroll
            for (int hb = 0; hb < 2; ++hb) { const int i = 8 * s + 4 * hb; u32x2 uk, ub;
                uk[0] = pk2(kq[i] * P16[i], kq[i + 1] * P16[i + 1]); uk[1] = pk2(kq[i + 2] * P16[i + 2], kq[i + 3] * P16[i + 3]);
                ub[0] = pk2(bet[i] * P16[i], bet[i + 1] * P16[i + 1]); ub[1] = pk2(bet[i + 2] * P16[i + 2], bet[i + 3] * P16[i + 3]);
                const int off = r16 * 128 + (32 * s + 16 * hb + 4 * g) * 2;
                *(LAS u32x2*)(wl + off) = uk; *(LAS u32x2*)(wl + 2048 + off) = ub; }
        const f32x4 Z = {0.f, 0.f, 0.f, 0.f};
        f32x4 A1a = M16K32(btp[1], ktp[1], M16K32(btp[0], ktp[0], Z));
        f32x4 A1c = M16K32(ktp[1], btp[1], M16K32(ktp[0], btp[0], Z));
        f32x4 A2a = M16K32(kqp[1], ktp[1], M16K32(kqp[0], ktp[0], Z));
        f32x4 B1a = M16K32(btp[1], rtp[1], M16K32(btp[0], rtp[0], Z));
        f32x4 B2a = M16K32(kqp[1], rtp[1], M16K32(kqp[0], rtp[0], Z));
#pragma unroll
        for (int e = 0; e < 4; ++e) { const int s_ = 4 * g + e;
            A1a[e] = (s_ < r16) ? A1a[e] : 0.f; A2a[e] = (s_ < r16) ? A2a[e] : 0.f; A1c[e] = (r16 < s_) ? A1c[e] : 0.f;
            B1a[e] = (s_ <= r16) ? B1a[e] : 0.f; B2a[e] = (s_ <= r16) ? B2a[e] : 0.f; }
        const s16x4 a1a = pk4(A1a), a1c = pk4(A1c);
        const f32x4 M2a = M16K16(a1c, a1a, Z), M2c = M16K16(a1a, a1c, Z);
        const s16x4 m2a = pk4(M2a), m2c = pk4(M2c);
        const f32x4 M4a = M16K16(m2c, m2a, Z), M4c = M16K16(m2a, m2c, Z);
        const s16x4 m4a = pk4(M4a), m4c = pk4(M4c);
        const s16x4 m8a = pk4(M16K16(m4c, m4a, Z));
        s16x4 stb[4];
#pragma unroll
        for (int sg = 0; sg < 4; ++sg) stb[sg] = pk4(ST[sg]);
        f32x4 G = Z, G2 = Z;
#pragma unroll
        for (int sg = 0; sg < 4; ++sg) {
            const s16x4 kf_ = (sg & 1) ? __builtin_shufflevector(ktp[sg >> 1], ktp[sg >> 1], 4, 5, 6, 7) : __builtin_shufflevector(ktp[sg >> 1], ktp[sg >> 1], 0, 1, 2, 3);
            const s16x4 rf_ = (sg & 1) ? __builtin_shufflevector(rtp[sg >> 1], rtp[sg >> 1], 4, 5, 6, 7) : __builtin_shufflevector(rtp[sg >> 1], rtp[sg >> 1], 0, 1, 2, 3);
            G = M16K16(kf_, stb[sg], G); G2 = M16K16(rf_, stb[sg], G2); }
        const f32x4 RHS = M16K16(pk4(A2a), Vb, G);
        const f32x4 X1 = M16K16(m8a, pk4(RHS), RHS);
        const f32x4 X2 = M16K16(m4a, pk4(X1), X1);
        const f32x4 X3 = M16K16(m2a, pk4(X2), X2);
        const f32x4 U = M16K16(pk4(-A1a), pk4(X3), X3);
        const s16x4 un = pk4(-U);
        f32x4 O = M16K16(pk4(B2a), Vb, G2);
        O = M16K16(pk4(B1a), un, O);
        { float* op = outb + eo + (size_t)blk * 16 * 512;
#pragma unroll
          for (int e = 0; e < 4; ++e) op[(size_t)e * 512] = O[e]; }
#pragma unroll
        for (int sg = 0; sg < 4; ++sg) {
#pragma unroll
            for (int e = 0; e < 4; ++e) ST[sg][e] *= P16[8 * (sg >> 1) + 4 * (sg & 1) + e];
            const int toff = (4 * g + (r16 >> 2)) * 128 + 32 * sg + 8 * (r16 & 3);
            const s16x4 kh = __builtin_amdgcn_ds_read_tr16_b64_v4i16((LAS s16x4*)(wl + toff));
            const s16x4 bh_ = __builtin_amdgcn_ds_read_tr16_b64_v4i16((LAS s16x4*)(wl + 2048 + toff));
            ST[sg] = M16K16(kh, Vb, ST[sg]);
            ST[sg] = M16K16(bh_, un, ST[sg]);
        }
    }
#undef CS_LOAD
    if (dummy) return;
#pragma unroll
    for (int sg = 0; sg < 4; ++sg) *(f32x4*)(stp + 32 * (sg >> 1) + 4 * (sg & 1)) = ST[sg];
}
DI float sum8(float v) {
    v += __uint_as_float(__builtin_amdgcn_update_dpp(0, __float_as_uint(v), 0xB1, 0xf, 0xf, false));
    v += __uint_as_float(__builtin_amdgcn_update_dpp(0, __float_as_uint(v), 0x4E, 0xf, 0xf, false));
    v += __uint_as_float(__builtin_amdgcn_update_dpp(0, __float_as_uint(v), 0x141, 0xf, 0xf, false));
    return v;
}
DI void unpk8(const u32x4 u, float* f) {
#pragma unroll
    for (int q = 0; q < 4; ++q) { f[2 * q] = bflo(u[q]); f[2 * q + 1] = bfhi(u[q]); }
}
DI void phase_rwkv_post(int l, int par) {
    const int lane = TID() & 63, gw = BID() * 8 + (TID() >> 6), nw = gridDim.x * 8;
    const float* outb = wsp<float>(WS_OUT); const bf16_t* rrb = wsp<bf16_t>(WS_RR); const bf16_t* kfb = wsp<bf16_t>(WS_KF);
    const bf16_t* vsb = wsp<bf16_t>(l == 0 ? WS_VV : WS_V2); const bf16_t* ggb = wsp<bf16_t>(WS_GG); bf16_t* orw = wsp<bf16_t>(WS_ORW + par * PAR_O);
    float lw[8], lb[8], rkc[8];
    { const float* lnw = KP()->in[I_LNW] + l * 512 + 8 * lane; const float* lnb = KP()->in[I_LNB] + l * 512 + 8 * lane; const float* rk = KP()->in[I_RK] + l * 512 + 8 * lane;
#pragma unroll
      for (int e = 0; e < 8; ++e) { lw[e] = lnw[e]; lb[e] = lnb[e]; rkc[e] = rk[e]; } }
    for (int row = gw; row < TC; row += nw) {
        const size_t e0 = (size_t)row * 512 + 8 * lane;
        const f32x4 o0 = *(const f32x4*)(outb + e0), o1 = *(const f32x4*)(outb + e0 + 4);
        float o[8] = {o0[0], o0[1], o0[2], o0[3], o1[0], o1[1], o1[2], o1[3]}, r[8], k[8], v[8], g[8];
        unpk8(*(const u32x4*)(rrb + e0), r); unpk8(*(const u32x4*)(kfb + e0), k); unpk8(*(const u32x4*)(vsb + e0), v); unpk8(*(const u32x4*)(ggb + e0), g);
        float s = 0.f, bo = 0.f;
#pragma unroll
        for (int e = 0; e < 8; ++e) { s += o[e]; bo += r[e] * k[e] * rkc[e]; }
        const float mean = sum8(s) * (1.f / 64.f); const float bonus = sum8(bo);
        float q = 0.f;
#pragma unroll
        for (int e = 0; e < 8; ++e) { o[e] -= mean; q += o[e] * o[e]; }
        const float rs = __builtin_amdgcn_rsqf(sum8(q) * (1.f / 64.f) + 64e-5f);
        u32x4 w;
#pragma unroll
        for (int p = 0; p < 4; ++p) { float y0 = (o[2 * p] * rs * lw[2 * p] + lb[2 * p] + bonus * v[2 * p]) * g[2 * p], y1 = (o[2 * p + 1] * rs * lw[2 * p + 1] + lb[2 * p + 1] + bonus * v[2 * p + 1]) * g[2 * p + 1]; w[p] = pk2(y0, y1); }
        *(u32x4*)(orw + e0) = w;
    }
}

#define MFMA32(a, b, c) __builtin_amdgcn_mfma_f32_32x32x16_bf16((a), (b), (c), 0, 0, 0)
DI unsigned fkey(float v) { v = v + 0.f; const unsigned u = __float_as_uint(v); return (u & 0x80000000u) ? ~u : (u | 0x80000000u); }
DI int half_sum(int x) {
    x += __builtin_amdgcn_update_dpp(0, x, 0x128, 0xf, 0xf, false);
    x += __builtin_amdgcn_update_dpp(0, x, 0x124, 0xf, 0xf, false);
    x += __builtin_amdgcn_update_dpp(0, x, 0x122, 0xf, 0xf, false);
    x += __builtin_amdgcn_update_dpp(0, x, 0x121, 0xf, 0xf, false);
    auto r = __builtin_amdgcn_permlane16_swap((unsigned)x, (unsigned)x, false, false);
    return (int)(r[0] + r[1]);
}
DI void dsa_select_half(int c, int item4, int set, int lane) {
    int lz = lane; asm volatile("" : "+v"(lz));
    const int hh = lz >> 5, r5 = lz & 31;
    const int rc0 = item4 * 4, b = rc0 >> 9, t0 = c * SC + (rc0 & 511);
    const int qq = ((r5 >> 2) & 1) + 2 * ((r5 >> 4) ^ set), hd = (r5 & 3) + 4 * ((r5 >> 3) & 1);
    const bf16_t* qp = wsp<bf16_t>(WS_IDXQ) + (size_t)(rc0 + qq) * 256 + hd * 32 + 8 * hh;
    const bf16x8 Af0 = *(const bf16x8*)qp, Af1 = *(const bf16x8*)(qp + 16);
    const int tA = t0 + hh + 2 * set;
    const float* wp = wsp<float>(WS_IDXW) + ((size_t)b * SEQ + tA) * 8;
    const f32x4 wa0 = *(const f32x4*)wp, wa1 = *(const f32x4*)(wp + 4);
    const int ngrp = ((t0 + 2 * set + 1) >> 9) + 1;
    unsigned keyA[64];
    const bf16_t* kbase = wsp<bf16_t>(WS_IDXK) + ((size_t)b * SEQ + r5) * 32 + 8 * hh;
    int keyv = r5; unsigned kofs = 0u;
    bf16x8 Bn0 = *(const bf16x8*)kbase, Bn1 = *(const bf16x8*)(kbase + 16);
#pragma unroll
    for (int g = 0; g < 4; ++g) {
        if (g < ngrp) {
#pragma unroll
            for (int j = 0; j < 16; ++j) {
                const int kt = g * 16 + j;
                const bf16x8 Bf0 = Bn0, Bf1 = Bn1;
                { const unsigned nofs = (kt < 63) ? kofs + 32 * 32 : kofs; const bf16_t* kp = kbase + nofs; Bn0 = *(const bf16x8*)kp; Bn1 = *(const bf16x8*)(kp + 16); }
                f32x16 C = {0.f, 0.f, 0.f, 0.f, 0.f, 0.f, 0.f, 0.f, 0.f, 0.f, 0.f, 0.f, 0.f, 0.f, 0.f, 0.f};
                C = MFMA32(Af0, Bf0, C); C = MFMA32(Af1, Bf1, C);
                float va = 0.f;
#pragma unroll
                for (int i = 0; i < 4; ++i) va += fmaxf(C[i], 0.f) * wa0[i];
#pragma unroll
                for (int i = 0; i < 4; ++i) va += fmaxf(C[4 + i], 0.f) * wa1[i];
                unsigned ka = (keyv <= tA) ? fkey(va) : 0u;
                asm volatile("" : "+v"(ka), "+v"(keyv), "+v"(kofs));
                keyA[kt] = ka;
                keyv += 32; kofs += 32 * 32;
            }
        } else {
#pragma unroll
            for (int j = 0; j < 16; ++j) keyA[g * 16 + j] = 0u;
        }
    }
    unsigned KA = 0u;
    if (t0 + 2 * set + 1 >= 256) {
        bool dA = tA < 255;
        for (int bit = 31; bit >= 0; --bit) {
            const unsigned cA = KA | (1u << bit);
            int nA = 0;
#pragma unroll
            for (int g = 0; g < 4; ++g) {
                if (g < ngrp) {
#pragma unroll
                    for (int j = 0; j < 16; ++j) nA += (keyA[g * 16 + j] >= cA) ? 1 : 0;
                }
            }
            nA = half_sum(nA);
            if (!dA && nA >= 256) KA = cA;
            dA = dA || (nA == 256);
            if (__ballot(dA) == ~0ull) break;
        }
    }
    int gA = 0;
#pragma unroll
    for (int kt = 0; kt < 64; ++kt) gA += (keyA[kt] > KA) ? 1 : 0;
    gA = half_sum(gA);
    const int needA = (KA == 0u) ? 0 : 256 - gA;
    asm volatile("" : "+v"(KA));
    int runA = 0, lsel = lz;
    unsigned w0 = 0u, w1 = 0u;
#pragma unroll
    for (int kt = 0; kt < 64; ++kt) {
        const bool eqA = keyA[kt] == KA;
        const unsigned long long ea = __ballot(eqA);
        const int rkA = runA + (hh ? (int)__builtin_amdgcn_mbcnt_hi((unsigned)(ea >> 32), 0u) : (int)__builtin_amdgcn_mbcnt_lo((unsigned)ea, 0u));
        const bool sA = (keyA[kt] > KA) || (eqA && rkA < needA);
        runA += hh ? __builtin_popcount((unsigned)(ea >> 32)) : __builtin_popcount((unsigned)ea);
        const unsigned long long sa = __ballot(sA);
        if (lsel == 0) { w0 = (unsigned)sa; w1 = (unsigned)(sa >> 32); }
        lsel -= 1; asm volatile("" : "+v"(lsel));
        __builtin_amdgcn_sched_barrier(0);
    }
    unsigned* sp = wsp<unsigned>(WS_SELB) + (size_t)(rc0 + 2 * set) * 64 + lz;
    sp[0] = w0; sp[64] = w1;
}
DI void phase_dsa_select_queue(int c, LAS unsigned* ctr) {
    const int lane = TID() & 63;
    const int base = BID() * 8;
    for (;;) {
        unsigned idx = 0u;
        if (lane == 0) idx = __hip_atomic_fetch_add(ctr, 1u, __ATOMIC_RELAXED, __HIP_MEMORY_SCOPE_WORKGROUP);
        idx = (unsigned)__builtin_amdgcn_readfirstlane((int)idx);
        if (idx >= 16u) break;
        const int item4 = base + (int)(idx >> 1);
        if (item4 < TC / 4) dsa_select_half(c, item4, (int)(idx & 1u), lane);
    }
}

struct AttnSt { f32x16 O0, O1; float m, l; };
constexpr float C2 = 0.125f * LOG2E;
DI void attn_load_kv(bf16x8 (&Kf)[4], bf16x8 (&Vf)[2][2], const bf16_t* kbase, const bf16_t* vtbase, int key0, int lane) {
    const int r5 = lane & 31;
    const int prow = (r5 & 19) | ((r5 & 4) << 1) | ((r5 & 8) >> 1);
    const bf16_t* kp = kbase + (size_t)(key0 + prow) * 512;
#pragma unroll
    for (int s = 0; s < 4; ++s) Kf[s] = *(const bf16x8*)(kp + 16 * s);
#pragma unroll
    for (int n = 0; n < 2; ++n)
#pragma unroll
        for (int s = 0; s < 2; ++s) Vf[n][s] = *(const bf16x8*)(vtbase + (size_t)(32 * n) * SEQ + key0 + 16 * s);
}
template <int MODE, bool FAR>
DI void attn_tile(AttnSt& st, const bf16x8 (&Qf)[4], const bf16x8 (&Kf)[4], const bf16x8 (&Vf)[2][2], int key0, int tq, bool allowed, unsigned word, LAS const float* bt, float ub, int lane) {
    const int hh = lane >> 5;
    f32x16 S = {0.f, 0.f, 0.f, 0.f, 0.f, 0.f, 0.f, 0.f, 0.f, 0.f, 0.f, 0.f, 0.f, 0.f, 0.f, 0.f};
#pragma unroll
    for (int s = 0; s < 4; ++s) S = MFMA32(Kf[s], Qf[s], S);
    const unsigned wsh = word >> (8 * hh);
    float ps = 0.f; float pv[16];
    if (FAR) {
        const float cb = (MODE == 0 && !allowed) ? -INFINITY : (bt[127] - ub);
#pragma unroll
        for (int i = 0; i < 16; ++i) {
            float p = fexp2(S[i] * C2 + cb);
            if (MODE == 1) p = __uint_as_float(__float_as_uint(p) & (unsigned)__builtin_amdgcn_sbfe((int)wsh, 16 * (i >> 3) + (i & 7), 1));
            pv[i] = p; ps += p;
        }
    } else {
#pragma unroll
        for (int i = 0; i < 16; ++i) {
            const int koff = 16 * (i >> 3) + 8 * hh + (i & 7);
            const int dist = tq - (key0 + koff);
            const bool ok = (MODE == 0) ? (allowed && dist >= 0) : (((wsh >> (16 * (i >> 3) + (i & 7))) & 1u) != 0u);
            const float p = fexp2(S[i] * C2 + (bt[min(max(dist, 0), 127)] - ub));
            pv[i] = ok ? p : 0.f; ps += pv[i];
        }
    }
    st.l += ps;
#pragma unroll
    for (int s = 0; s < 2; ++s) {
        u32x4 pw; pw[0] = pk2(pv[8 * s], pv[8 * s + 1]); pw[1] = pk2(pv[8 * s + 2], pv[8 * s + 3]); pw[2] = pk2(pv[8 * s + 4], pv[8 * s + 5]); pw[3] = pk2(pv[8 * s + 6], pv[8 * s + 7]);
        const bf16x8 Pf = __builtin_bit_cast(bf16x8, pw);
        st.O0 = MFMA32(Vf[0][s], Pf, st.O0); st.O1 = MFMA32(Vf[1][s], Pf, st.O1);
    }
}
constexpr int AT_ROW = 144, AT_KV = 64 * AT_ROW, AT_STAGE = 2 * AT_KV;
template <int MODE>
DI void attn_block(int c, int b, int h, int half, LAS unsigned char* stg, LAS unsigned* uni, LAS const float* bt, float kbound, float bmax, bool dummy) {
    const int tid = TID(), lane = tid & 63, wave = tid >> 6, r5 = lane & 31, hh = lane >> 5;
    bf16_t* qbuf = wsp<bf16_t>((MODE == 0 ? WS_MQ : WS_DQ) + (c & 1) * PAR_O);
    const int tb = c * SC + 256 * half, t0 = tb + 32 * wave, tq = t0 + r5, rowc0 = b * SC + 256 * half + 32 * wave;
    bf16_t* qp = qbuf + (size_t)(rowc0 + r5) * 512 + h * 64;
    bf16x8 Qf[4];
#pragma unroll
    for (int s = 0; s < 4; ++s) Qf[s] = *(const bf16x8*)(qp + 16 * s + 8 * hh);
    AttnSt st; st.m = 0.f; st.l = 0.f;
#pragma unroll
    for (int i = 0; i < 16; ++i) { st.O0[i] = 0.f; st.O1[i] = 0.f; }
    float ub;
    { float q2 = 0.f;
#pragma unroll
      for (int s = 0; s < 4; ++s)
#pragma unroll
          for (int j = 0; j < 8; ++j) { const float v = bf2f((bf16_t)Qf[s][j]); q2 += v * v; }
      q2 += __shfl_xor(q2, 32);
      ub = sqrtf(q2) * kbound * C2 + bmax; }
    const int ktl = (t0 + 31) >> 5;
    const int own = tb >> 8;
    unsigned bm = 0u, anyw = 0xffu;
    if (MODE == 0) {
        if (own > 0) {
            const float* km = wsp<float>(WS_KMEAN) + ((size_t)(b * 8 + h) * 8) * 64 + 8 * hh;
            float g[8];
#pragma unroll
            for (int n = 0; n < 8; ++n) {
                g[n] = -INFINITY;
                if (n < own) {
                    float part = 0.f;
#pragma unroll
                    for (int s = 0; s < 4; ++s) { const f32x4 k0 = *(const f32x4*)(km + n * 64 + 16 * s), k1 = *(const f32x4*)(km + n * 64 + 16 * s + 4);
#pragma unroll
                        for (int j = 0; j < 4; ++j) part += bf2f((bf16_t)Qf[s][j]) * k0[j] + bf2f((bf16_t)Qf[s][4 + j]) * k1[j]; }
                    g[n] = part + __shfl_xor(part, 32);
                }
            }
#pragma unroll
            for (int n = 0; n < 8; ++n) {
                if (n < own) { int rank = 0;
#pragma unroll
                    for (int m2 = 0; m2 < 8; ++m2) if (m2 != n && m2 < own) rank += ((g[m2] > g[n]) || (g[m2] == g[n] && m2 < n)) ? 1 : 0;
                    if (rank < 3) bm |= 1u << n; }
            }
        }
        anyw = 1u << own;
#pragma unroll
        for (int n = 0; n < 8; ++n) if (n < own && __ballot((bm >> n) & 1u) != 0ull) anyw |= 1u << n;
    }
    if (tid == 0) uni[0] = 0u;
    __syncthreads();
    if (lane == 0) __hip_atomic_fetch_or(uni, anyw, __ATOMIC_RELAXED, __HIP_MEMORY_SCOPE_WORKGROUP);
    __syncthreads();
    const unsigned anyb = MODE == 0 ? uni[0] : 0xffu;
    const int lrow = tid >> 3, lpart = tid & 7;
    const bf16_t* kg = wsp<bf16_t>(MODE == 0 ? WS_MK : WS_DK) + ((size_t)b * SEQ + lrow) * 512 + h * 64 + lpart * 8;
    const bf16_t* vg = wsp<bf16_t>(MODE == 0 ? WS_MVT : WS_DVT) + ((size_t)b * 512 + h * 64 + lrow) * SEQ + lpart * 8;
    const int lofs = lrow * AT_ROW + lpart * 16;
    const int prow = (r5 & 19) | ((r5 & 4) << 1) | ((r5 & 8) >> 1);
    const int kofs = prow * AT_ROW + 16 * hh, vofs = r5 * AT_ROW + 16 * hh;
    const unsigned* sp = wsp<unsigned>(WS_SELB) + (size_t)(rowc0 + r5) * 64;
    const int nst = (tb + 256) >> 6;
    int stp = 0;
    if (MODE == 0) { while (!((anyb >> (stp >> 2)) & 1u)) stp += 4; }
    u32x4 kreg = *(const u32x4*)(kg + (size_t)(stp * 64) * 512), vreg = *(const u32x4*)(vg + stp * 64);
    *(LAS u32x4*)(stg + lofs) = kreg; *(LAS u32x4*)(stg + AT_KV + lofs) = vreg;
    u32x2 wcur = {0u, 0u}, wnxt = {0u, 0u};
    if (MODE == 1) wcur = *(const u32x2*)(sp + 2 * stp);
    __syncthreads();
    int cur = 0;
    while (stp < nst) {
        int nx = stp + 1;
        if (MODE == 0) { while (nx < nst && !((anyb >> (nx >> 2)) & 1u)) nx += 4 - (nx & 3); }
        const bool more = nx < nst;
        if (more) { kreg = *(const u32x4*)(kg + (size_t)(nx * 64) * 512); vreg = *(const u32x4*)(vg + nx * 64); if (MODE == 1) wnxt = *(const u32x2*)(sp + 2 * nx); }
        LAS const unsigned char* ks = stg + cur * AT_STAGE; LAS const unsigned char* vs = ks + AT_KV;
#pragma unroll
        for (int u = 0; u < 2; ++u) {
            const int kt = 2 * stp + u, key0 = kt * 32, nb = kt >> 3;
            const bool waveon = (kt <= ktl) && (MODE == 1 || ((anyw >> nb) & 1u));
            if (waveon) {
                bf16x8 Kf[4], Vf[2][2];
#pragma unroll
                for (int s = 0; s < 4; ++s) Kf[s] = *(LAS const bf16x8*)(ks + 32 * u * AT_ROW + kofs + 32 * s);
#pragma unroll
                for (int n = 0; n < 2; ++n)
#pragma unroll
                    for (int s = 0; s < 2; ++s) Vf[n][s] = *(LAS const bf16x8*)(vs + 32 * n * AT_ROW + vofs + 64 * u + 32 * s);
                const unsigned word = (MODE == 1) ? wcur[u] : 0u;
                const bool allowed = (MODE == 0) ? ((nb == own) || (((bm >> nb) & 1u) != 0u)) : true;
                if (t0 - (key0 + 31) >= 113) attn_tile<MODE, true>(st, Qf, Kf, Vf, key0, tq, allowed, word, bt, ub, lane);
                else attn_tile<MODE, false>(st, Qf, Kf, Vf, key0, tq, allowed, word, bt, ub, lane);
            }
        }
        if (more) { LAS unsigned char* ws_ = stg + (cur ^ 1) * AT_STAGE; *(LAS u32x4*)(ws_ + lofs) = kreg; *(LAS u32x4*)(ws_ + AT_KV + lofs) = vreg; }
        __syncthreads();
        cur ^= 1; stp = nx; wcur = wnxt;
    }
    const float lt = st.l + __shfl_xor(st.l, 32);
    const float inv = 1.f / lt;
    if (dummy) qp = wsp<bf16_t>(WS_RAW + (MODE ? 8 * MiB : 0)) + (size_t)(rowc0 + r5) * 512 + h * 64;
#pragma unroll
    for (int g4 = 0; g4 < 4; ++g4) {
        st_bf4(qp + 8 * g4 + 4 * hh, (f32x4){st.O0[4 * g4] * inv, st.O0[4 * g4 + 1] * inv, st.O0[4 * g4 + 2] * inv, st.O0[4 * g4 + 3] * inv});
        st_bf4(qp + 32 + 8 * g4 + 4 * hh, (f32x4){st.O1[4 * g4] * inv, st.O1[4 * g4 + 1] * inv, st.O1[4 * g4 + 2] * inv, st.O1[4 * g4 + 3] * inv});
    }
    __syncthreads();
}
__device__ const unsigned char kBucket[128] = {0,1,2,3,4,5,6,7,8,9,10,11,12,13,14,15,16,16,16,17,17,18,18,18,19,19,19,20,20,20,20,21,21,21,21,22,22,22,22,22,23,23,23,23,23,23,24,24,24,24,24,24,25,25,25,25,25,25,25,26,26,26,26,26,26,26,26,27,27,27,27,27,27,27,27,27,27,28,28,28,28,28,28,28,28,28,28,29,29,29,29,29,29,29,29,29,29,29,29,30,30,30,30,30,30,30,30,30,30,30,30,30,30,31,31,31,31,31,31,31,31,31,31,31,31,31,31,31};
DI void phase_attn(int l, int c, LAS float* lds, bool dummy = false) {
    const int tid = TID();
    for (int e = tid; e < 2 * 8 * 128; e += 512) { const int d = e & 127, h = (e >> 7) & 7, mx = e >> 10; lds[e] = KP()->in[I_REL][kBucket[d] * 16 + mx * 8 + h] * LOG2E; }
    if (tid < 2) { const float* g = KP()->in[I_QKN] + l * 256 + (tid == 0 ? 64 : 192); float m = 0.f; for (int i = 0; i < 64; ++i) m = fmaxf(m, fabsf(g[i])); lds[2048 + tid] = 8.1f * m; }
    if (tid >= 64 && tid < 80) { const int mx = (tid - 64) >> 3, h = (tid - 64) & 7; float m = 0.f; for (int k = 0; k < 32; ++k) m = fmaxf(m, fabsf(KP()->in[I_REL][k * 16 + mx * 8 + h])); lds[2064 + (tid - 64)] = m * LOG2E; }
    __syncthreads();
    LAS unsigned char* stg = (LAS unsigned char*)lds + 16384; LAS unsigned* uni = (LAS unsigned*)((LAS unsigned char*)lds + 8192 + 256);
    for (int it = BID(); it < NB * NH * 2; it += gridDim.x) {
        const int bh = it >> 1, b = bh >> 3, h = bh & 7, hf = it & 1;
        attn_block<0>(c, b, h, hf, stg, uni, lds + h * 128, lds[2048], lds[2064 + h], dummy);
        attn_block<1>(c, b, h, hf ^ 1, stg, uni, lds + 1024 + h * 128, lds[2049], lds[2072 + h], dummy);
    }
    if (!dummy) { phase_rwkv_post(l, c & 1); if (DBL_PHASE == 24) phase_rwkv_post(l, c & 1); }
}

constexpr int LDS_BYTES = pg8::STAGE_BYTES + 256;
constexpr int PH_PER_LAYER = 32, N_PHASES = 2 * PH_PER_LAYER;
#ifndef DBL_PHASE
#define DBL_PHASE 0
#endif
#ifndef MK_ONE_LAUNCH
#define MK_ONE_LAUNCH 1
#endif
__global__ void __launch_bounds__(512, 2) mega(Params p) {
    extern __shared__ __attribute__((aligned(16))) unsigned char lds_raw[];
    LAS unsigned char* lds = (LAS unsigned char*)lds_raw;
    volatile LAS unsigned* bst = (volatile LAS unsigned*)(lds + pg8::STAGE_BYTES);
    if (TID() < 4) bst[TID()] = 0u;
    __syncthreads();
    if (p.ph_hi - p.ph_lo > 1) (void)xcd_barrier_post((unsigned*)(KP()->ws + WS_CTL), bst);
#ifndef PH_ONLY
#define PH_ONLY -1
#endif
#define IN(k) (KP()->ph_lo <= (k) && (k) < KP()->ph_hi)
#define INT(tag, k) ((PH_ONLY < 0 || PH_ONLY == (tag)) && IN(k))
#define SEAM(k) do { if (IN(k) && IN((k) + 1)) { XcdBarrier bar_; bar_.bar = (unsigned*)(KP()->ws + WS_CTL); bar_.x = xb_xcc_id(); bar_.st = (volatile LAS unsigned*)(lds + pg8::STAGE_BYTES); xcd_barrier(bar_); if (DBL_PHASE == 20) xcd_barrier(bar_); } } while (0)
    for (int l = 0; l < 2; ++l) {
        const int pb = PH_PER_LAYER * l;
        if (INT(0, pb + 0)) {
#if DBL_PHASE == 6
            phase_conv(l, (LAS float*)lds);
#endif
            phase_conv(l, (LAS float*)lds); }
        SEAM(pb + 0);
        if (INT(1, pb + 1)) {
#if DBL_PHASE == 7
            phase_norm(l == 0 ? KP()->in[I_X] : (const float*)KP()->out, KP()->in[I_NMIX] + l * DM, wsp<bf16_t>(WS_H));
#endif
            phase_norm(l == 0 ? KP()->in[I_X] : (const float*)KP()->out, KP()->in[I_NMIX] + l * DM, wsp<bf16_t>(WS_H)); }
        SEAM(pb + 1);
        if (INT(2, pb + 2)) {
            { const SchedLin S = mk_sched(128, 4, WS_H, WS_WB, 1024); const EpiB E{l}; pg8::gemm_phase(lds, 1024, S, E); }
            { const SchedLin S = mk_sched(2, 128, WS_WV, WS_H, 1024); const EpiVt E{(unsigned)WS_MVT}; pg8::gemm_phase(lds, 1024, S, E); }
#if DBL_PHASE == 9
            { const SchedLin S = mk_sched(128, 4, WS_H, WS_WB, 1024); const EpiB E{l}; pg8::gemm_phase(lds, 1024, S, E); }
            { const SchedLin S = mk_sched(2, 128, WS_WV, WS_H, 1024); const EpiVt E{(unsigned)WS_MVT}; pg8::gemm_phase(lds, 1024, S, E); }
#endif
        }
        SEAM(pb + 2);
        if (INT(3, pb + 3)) { phase_dcn(l); phase_kmean();
#if DBL_PHASE == 14
            phase_kmean();
#endif
        }
        SEAM(pb + 3);
        if (INT(4, pb + 4)) {
            { const SchedLin S = mk_sched(128, 2, WS_DCN, WS_WKVK, 256); const EpiHN E{l}; pg8::gemm_phase(lds, 256, S, E); }
            { const SchedLin S = mk_sched(2, 128, WS_WKVV, WS_DCN, 256); const EpiVt E{(unsigned)WS_DVT}; pg8::gemm_phase(lds, 256, S, E); }
#if DBL_PHASE == 13
            { const SchedLin S = mk_sched(128, 2, WS_DCN, WS_WKVK, 256); const EpiHN E{l}; pg8::gemm_phase(lds, 256, S, E); }
            { const SchedLin S = mk_sched(2, 128, WS_WKVV, WS_DCN, 256); const EpiVt E{(unsigned)WS_DVT}; pg8::gemm_phase(lds, 256, S, E); }
#endif
        }
        SEAM(pb + 4);
        for (int c = 0; c < NCH; ++c) {
            const int pc = pb + 5 + 5 * c + 2 * (c >> 1), cbase = c * SC;
            if (INT(5, pc + 0)) { const SchedLin S = mk_sched(32, 24, WS_H, WS_WD1, 1024, 1, cbase); const EpiD1 E{l, c & 1}; pg8::gemm_phase(lds, 1024, S, E);
#if DBL_PHASE == 5
                pg8::gemm_phase(lds, 1024, S, E);
#endif
            }
            SEAM(pc + 0);
            if (INT(6, pc + 1)) {
#if DBL_PHASE == 4
                phase_rwkv_prep(l, c);
#endif

                phase_rwkv_prep(l, c); }
            SEAM(pc + 1);
            if (INT(7, pc + 2)) { const SchedLin S = mk_sched(32, l == 0 ? 6 : 8, WS_LORAA, WS_WL, 512, 0, 0, WS_VV, 6); const EpiLora E{l, cbase}; pg8::gemm_phase(lds, 512, S, E); }
            SEAM(pc + 2);
            if (INT(8, pc + 3)) {
#if DBL_PHASE == 2
                phase_scan_chunked(l, c, lds, true);
#endif
#if DBL_PHASE == 22
                phase_scan_chunked(l, c, lds, true);
#endif

#if DBL_PHASE == 11
                phase_scan(l, c, 2);
#endif
#if DBL_PHASE == 12
                phase_scan(l, c, 3);
#endif
#if DBL_PHASE == 25
                if (TID() == 0) *(LAS unsigned*)(lds + 8192) = 0u;
                __syncthreads();
                phase_scan_chunked(l, c, lds, true); phase_dsa_select_queue(c, (LAS unsigned*)(lds + 8192));
                __syncthreads();
#endif
#if DBL_PHASE == 26
                if (TID() == 0) *(LAS unsigned*)(lds + 8192) = 0u;
                __syncthreads();
                phase_dsa_select_queue(c, (LAS unsigned*)(lds + 8192));
                __syncthreads();
#endif
                if (TID() == 0) *(LAS unsigned*)(lds + 8192) = 0u;
                __syncthreads();
                phase_scan_chunked(l, c, lds);
                phase_dsa_select_queue(c, (LAS unsigned*)(lds + 8192)); }
            SEAM(pc + 3);
            if (INT(9, pc + 4)) {
#if DBL_PHASE == 1
                phase_attn(l, c, (LAS float*)lds, true); __syncthreads();
#endif
                phase_attn(l, c, (LAS float*)lds); }
            SEAM(pc + 4);
            if (c & 1) {
                if (INT(10, pc + 5)) { const SchedMerge S{(int)gridDim.x, (int)BID()}; const EpiMerge E{}; pg8::gemm_phase(lds, 512, S, E);
#if DBL_PHASE == 10
                    pg8::gemm_phase(lds, 512, S, E);
#endif
                }
                SEAM(pc + 5);
                if (INT(11, pc + 6)) { const SchedLin S = mk_sched(64, 4, WS_Y, WS_WO, 1024); const EpiRes E{l == 0 ? 1 : 0, 2, cbase - SC, 0u}; pg8::gemm_phase(lds, 1024, S, E); }
                SEAM(pc + 6);
            }
        }
        if (INT(33, pb + 29)) phase_norm(KP()->out, KP()->in[I_NFFN] + l * DM, wsp<bf16_t>(WS_H));
        SEAM(pb + 29);
        if (INT(34, pb + 30)) { const SchedLin S = mk_sched(128, 22, WS_H, WS_WF1, 1024); const EpiSwiglu E{}; pg8::gemm_phase(lds, 1024, S, E);
#if DBL_PHASE == 8
            pg8::gemm_phase(lds, 1024, S, E);
#endif
        }
        SEAM(pb + 30);
        if (INT(35, pb + 31)) { const SchedLin S = mk_sched(128, 4, WS_ACT, WS_WF2, DFF); const EpiRes E{0, 0, 0, 0u};
#if DBL_PHASE == 16
            { const EpiRes E2{0, 0, 0, (unsigned)(WS_ACT + 176 * MiB)}; pg8::gemm_phase(lds, DFF, S, E2); }
#endif
            pg8::gemm_phase(lds, DFF, S, E); }
        SEAM(pb + 31);
    }
#undef IN
#undef INT
#undef SEAM
}

extern "C" void kernel_launch(void* const* d_in, const int* in_sizes, int n_in, void* d_out, int out_size, void* d_ws, size_t ws_size, hipStream_t stream) {
    static int grid = 0;
    if (grid == 0) {
        if (n_in != 26 || ws_size < WS_END) { grid = -1; return; }
        int dev = 0, cus = 0;
        if (hipGetDevice(&dev) != hipSuccess || hipDeviceGetAttribute(&cus, hipDeviceAttributeMultiprocessorCount, dev) != hipSuccess) { grid = -1; return; }
        if (hipFuncSetAttribute((const void*)mega, hipFuncAttributeMaxDynamicSharedMemorySize, LDS_BYTES) != hipSuccess) { grid = -1; return; }
        grid = cus;
    }
    if (grid < 0) return;
    (void)hipMemsetAsync((char*)d_ws + WS_CTL, 0, 64 * 1024, stream);
    Params p{};
    for (int i = 0; i < 26; ++i) p.in[i] = (const float*)d_in[i];
    p.out = (float*)d_out; p.ws = (unsigned char*)d_ws;
#if MK_ONE_LAUNCH
    p.ph_lo = 0; p.ph_hi = N_PHASES;
    hipLaunchKernelGGL(mega, dim3(grid), dim3(512), LDS_BYTES, stream, p);
#else
    for (int ph = 0; ph < N_PHASES; ++ph) { p.ph_lo = ph; p.ph_hi = ph + 1; hipLaunchKernelGGL(mega, dim3(grid), dim3(512), LDS_BYTES, stream, p); }
#endif
}
```

```cpp
#include <hip/hip_runtime.h>
#include <stdint.h>
#ifndef DBL_PHASE
#define DBL_PHASE 0
#endif

#define DI __device__ __forceinline__
#define LAS __attribute__((address_space(3)))
typedef unsigned short bf16_t;
typedef short bf16x8 __attribute__((ext_vector_type(8)));
typedef float f32x2 __attribute__((ext_vector_type(2)));
typedef float f32x4 __attribute__((ext_vector_type(4)));
typedef float f32x16 __attribute__((ext_vector_type(16)));
typedef unsigned u32x2 __attribute__((ext_vector_type(2)));
typedef unsigned u32x4 __attribute__((ext_vector_type(4)));
typedef __bf16 bf2_t __attribute__((ext_vector_type(2)));

constexpr int NB = 16, SEQ = 2048, DM = 1024, NT = NB * SEQ, NH = 8, BW = 512;
constexpr int NCH = 4, SC = 512, TC = NB * SC;
constexpr int D_IN = 7496, DFF = 2816;
constexpr int C_MQ = 0, C_MK = 512, C_MV = 1024, C_RW = 1536, C_DS = 3360, C_GT = 4424;
constexpr int RAWLD = 1792;
constexpr float NORM_EPS = 1e-6f;
constexpr float LOG2E = 1.4426950408889634f;

constexpr size_t MiB = 1024 * 1024;
constexpr size_t WS_CTL = 0;
constexpr size_t WS_WB = 64 * 1024;
constexpr size_t WS_WV = WS_WB + 2 * MiB;
constexpr size_t WS_WD1 = WS_WV + 1 * MiB;
constexpr size_t WS_WKVK = WS_WD1 + 12 * MiB;
constexpr size_t WS_WKVV = WS_WKVK + MiB / 4;
constexpr size_t WS_WL = WS_WKVV + MiB / 4;
constexpr size_t WS_WBR = WS_WL + 2 * MiB;
constexpr size_t WS_WO = WS_WBR + 3 * MiB;
constexpr size_t WS_WF1 = WS_WO + 2 * MiB;
constexpr size_t WS_WF2 = WS_WF1 + 11 * MiB;
constexpr size_t WS_VFIRST = WS_WF2 + 6 * MiB;
constexpr size_t WS_STATE = WS_VFIRST + 32 * MiB;
constexpr size_t WS_H = WS_STATE + 2 * MiB;
constexpr size_t WS_IDXK = WS_H + 64 * MiB;
constexpr size_t WS_IDXW = WS_IDXK + 2 * MiB;
constexpr size_t WS_LEFT = WS_IDXW + 1 * MiB;
constexpr size_t WS_KMEAN = WS_LEFT + 2 * MiB;
constexpr size_t WS_CARRY = WS_KMEAN + MiB / 4;
constexpr size_t WS_MK = WS_CARRY + MiB / 4;
constexpr size_t WS_MVT = WS_MK + 32 * MiB;
constexpr size_t WS_DK = WS_MVT + 32 * MiB;
constexpr size_t WS_DVT = WS_DK + 32 * MiB;
constexpr size_t WS_MQ = WS_DVT + 32 * MiB;
constexpr size_t WS_DQ = WS_MQ + 16 * MiB;
constexpr size_t WS_ORW = WS_DQ + 16 * MiB;
constexpr size_t WS_GATES = WS_ORW + 16 * MiB;
constexpr size_t PAR_O = 8 * MiB, PAR_G = 24 * MiB;
constexpr size_t WS_IDXQ = WS_GATES + 48 * MiB;
constexpr size_t WS_RAW = WS_IDXQ + 4 * MiB;
constexpr size_t WS_LORAA = WS_RAW + 28 * MiB;
constexpr size_t WS_RR = WS_LORAA + 8 * MiB;
constexpr size_t WS_KF = WS_RR + 8 * MiB;
constexpr size_t WS_VV = WS_KF + 8 * MiB;
constexpr size_t WS_KKB = WS_VV + 8 * MiB;
constexpr size_t WS_BBB = WS_KKB + 8 * MiB;
constexpr size_t WS_GG = WS_BBB + 8 * MiB;
constexpr size_t WS_DEC = WS_GG + 8 * MiB;
constexpr size_t WS_OUT = WS_DEC + 16 * MiB;
constexpr size_t WS_V2 = WS_OUT + 16 * MiB;
constexpr size_t WS_SELB = WS_V2 + 8 * MiB;
constexpr size_t WS_END = WS_SELB + 2 * MiB;
constexpr size_t WS_DCN = WS_RAW;
constexpr size_t WS_Y32 = WS_IDXQ;
constexpr size_t WS_Y = WS_Y32 + 64 * MiB;
static_assert(WS_Y + 32 * MiB <= WS_END, "y32 / y alias");
constexpr size_t WS_ACT = WS_MK;
static_assert(WS_END <= 512 * MiB, "workspace map exceeds 512 MiB");
static_assert(WS_ACT + 176 * MiB <= WS_END, "ACT alias");

DI unsigned pk2(float a, float b) { f32x2 v = {a, b}; return __builtin_bit_cast(unsigned, __builtin_convertvector(v, bf2_t)); }
DI bf16_t f2bf(float a) { return (bf16_t)(pk2(a, 0.f) & 0xffffu); }
DI float bflo(unsigned u) { return __uint_as_float(u << 16); }
DI float bfhi(unsigned u) { return __uint_as_float(u & 0xffff0000u); }
DI float bf2f(bf16_t b) { return __uint_as_float((unsigned)b << 16); }
DI float fexp2(float x) { return __builtin_amdgcn_exp2f(x); }
DI float frcp(float x) { return __builtin_amdgcn_rcpf(x); }
DI float fsigmoid(float x) { return frcp(1.f + fexp2(-x * LOG2E)); }
DI float wave_sum(float v) {
    v += __uint_as_float(__builtin_amdgcn_update_dpp(0, __float_as_uint(v), 0x128, 0xf, 0xf, false));
    v += __uint_as_float(__builtin_amdgcn_update_dpp(0, __float_as_uint(v), 0x124, 0xf, 0xf, false));
    v += __uint_as_float(__builtin_amdgcn_update_dpp(0, __float_as_uint(v), 0x122, 0xf, 0xf, false));
    v += __uint_as_float(__builtin_amdgcn_update_dpp(0, __float_as_uint(v), 0x121, 0xf, 0xf, false));
    auto r = __builtin_amdgcn_permlane16_swap(__float_as_uint(v), __float_as_uint(v), false, false);
    v = __uint_as_float(r[0]) + __uint_as_float(r[1]);
    r = __builtin_amdgcn_permlane32_swap(__float_as_uint(v), __float_as_uint(v), false, false);
    return __uint_as_float(r[0]) + __uint_as_float(r[1]);
}

#define XB_TMO      128
#define XB_XCNT(j)  (256  + 64 * (j))
#define XB_XSUB(j)  (1280 + 64 * (j))
#define XB_XGEN(j)  (2304 + 64 * (j))
#define XB_TOP      3328
#define XB_TOPGEN   3392
#define XCD_BAR_WORDS 3456
#define XB_SPIN_CAP (1u << 18)
__device__ __forceinline__ unsigned xb_ld(unsigned* p)              { return __hip_atomic_load(p, __ATOMIC_RELAXED, __HIP_MEMORY_SCOPE_AGENT); }
__device__ __forceinline__ unsigned xb_add(unsigned* p, unsigned v) { return __hip_atomic_fetch_add(p, v, __ATOMIC_RELAXED, __HIP_MEMORY_SCOPE_AGENT); }
__device__ __forceinline__ unsigned xb_xcc_id() { return (unsigned)__builtin_amdgcn_s_getreg((3 << 11) | 20) & 0xFu; }
#define XB_SPIN(cond, bar) do { unsigned _sp = 0; while (cond) { __builtin_amdgcn_s_sleep(1); \
    if ((++_sp & 255u) == 0u) { if (xb_ld(&(bar)[XB_TMO])) break; if (_sp > XB_SPIN_CAP) { atomicAdd(&(bar)[XB_TMO], 1u); break; } } } } while (0)
struct XcdBarrier { unsigned* bar; unsigned x; volatile LAS unsigned* st; };
__device__ __forceinline__ XcdBarrier xcd_barrier_post(unsigned* bar, volatile LAS unsigned* st) {
    XcdBarrier b; b.bar = bar; b.x = xb_xcc_id(); b.st = st;
    if (threadIdx.x == 0) (void)xb_add(&bar[XB_XCNT(b.x)], 1u);
    return b;
}
__device__ __forceinline__ void xcd_barrier_complete(unsigned* bar, unsigned x, unsigned& nloc, unsigned& nx) {
    const unsigned G = gridDim.x * gridDim.y * gridDim.z;
    unsigned sum, cnt, mine, sp = 0u;
    for (;;) {
        sum = 0u; cnt = 0u; mine = 0u;
#pragma unroll 1
        for (unsigned j = 0; j < 16; ++j) { const unsigned c = xb_ld(&bar[XB_XCNT(j)]); sum += c; cnt += (c > 0u) ? 1u : 0u; mine = (j == x) ? c : mine; }
        if (sum == G) break;
        __builtin_amdgcn_s_sleep(1);
        if ((++sp & 255u) == 0u) { if (xb_ld(&bar[XB_TMO])) break; if (sp > XB_SPIN_CAP) { atomicAdd(&bar[XB_TMO], 1u); break; } }
    }
    nloc = mine > 0u ? mine : 1u; nx = cnt > 0u ? cnt : 1u;
}
__device__ __forceinline__ void xcd_barrier(const XcdBarrier& b) {
    asm volatile("s_waitcnt vmcnt(0)" ::: "memory");
    __syncthreads();
    if (threadIdx.x == 0) {
        unsigned* bar = b.bar;
        __builtin_amdgcn_s_waitcnt(0);
        unsigned nloc = b.st[0], nx = b.st[1];
        if (nloc == 0u) { xcd_barrier_complete(bar, b.x, nloc, nx); b.st[0] = nloc; b.st[1] = nx; }
        const unsigned old = xb_add(&bar[XB_XSUB(b.x)], 1u);
        const unsigned gen = old / nloc;
        if (old + 1u == (gen + 1u) * nloc) {
            __builtin_amdgcn_fence(__ATOMIC_RELEASE, "agent");
            asm volatile("s_waitcnt vmcnt(0)" ::: "memory");
            const unsigned og = xb_add(&bar[XB_TOP], 1u);
            const unsigned tg = og / nx;
            if (og + 1u == (tg + 1u) * nx) xb_add(&bar[XB_TOPGEN], 1u);
            else XB_SPIN(xb_ld(&bar[XB_TOPGEN]) == tg, bar);
            __builtin_amdgcn_fence(__ATOMIC_ACQUIRE, "agent");
            xb_add(&bar[XB_XGEN(b.x)], 1u);
            asm volatile("s_waitcnt vmcnt(0)" ::: "memory");
        } else {
            XB_SPIN(xb_ld(&bar[XB_XGEN(b.x)]) == gen, bar);
            __builtin_amdgcn_fence(__ATOMIC_ACQUIRE, "agent");
            asm volatile("s_waitcnt vmcnt(0)" ::: "memory");
        }
    }
    __syncthreads();
}

DI int TID() { int t = threadIdx.x; asm volatile("" : "+v"(t)); return t; }
DI int BID() { int b = blockIdx.x; asm volatile("" : "+s"(b)); return b; }

namespace pg8 {
constexpr int BM = 256, BK = 64, HALF = 128, HTB = HALF * BK * 2, STAGE_BYTES = 8 * HTB, NXCD = 8, WGM = 8;
DI int lds_byte(int r, int c) { const int st = (r >> 4) * 2 + (c >> 5), rr = r & 15, cc = c & 31, ob = rr * 64 + cc * 2; return st * 1024 + (ob ^ (((ob >> 9) & 1) << 5)); }
DI void stage_rc(int b, int& R, int& C) { const int st = b / 1024, sb = b % 1024, swz = sb ^ (((sb >> 9) & 1) << 5); R = (st >> 1) * 16 + swz / 64; C = (st & 1) * 32 + (swz % 64) / 2; }
struct Unit { int pm, pn, z; };

DI bool order_xcd(int nM, int nN, int G, int c, int i, Unit& u) {
    const int nwg = nM * nN; const long L = (long)i * G + c; if (L >= nwg) return false;
    int wgid = (int)L; { const int q = nwg / NXCD, r = nwg % NXCD, xcd = wgid % NXCD, off = wgid / NXCD; wgid = (xcd < r ? xcd * (q + 1) : r * (q + 1) + (xcd - r) * q) + off; }
    const int nig = WGM * nN, gid = wgid / nig, fm = gid * WGM, gsz = (nM - fm) < WGM ? (nM - fm) : WGM;
    u.pm = fm + ((wgid % nig) % gsz); u.pn = (wgid % nig) / gsz; u.z = 0; return true;
}

template <class Epi, class Sched, bool HALFN = false>
DI void gemm_phase(LAS unsigned char* lds, const int K, const Sched& S, const Epi& E) {
    const int tid = TID(), wid = __builtin_amdgcn_readfirstlane(tid >> 6), lane = tid & 63, wr = wid >> 2, wc = wid & 3, fr = lane & 15, fq = lane >> 4;
    const int nt = K / BK;
    unsigned voffA[2];
#pragma unroll
    for (int i = 0; i < 2; ++i) { int R, C; stage_rc(tid * 16 + i * 8192, R, C); voffA[i] = (unsigned)(R * K + C) * 2u; }
    const size_t kstep = (size_t)(BK * 2);
    const size_t hstep = (size_t)HALF * K * 2;
    const unsigned ldsw = (unsigned)wid * 1024u;
    const int aoff = lds_byte(wr * 64 + fr, fq * 8), boff = lds_byte(wc * 32 + fr, fq * 8);
#define PG8_SA(b, h) (((b) * 2 + (h)) * HTB)
#define PG8_SB(b, h) ((4 + (b) * 2 + (h)) * HTB)
#define PG8_STAGE(bufoff, gbase) do { _Pragma("unroll") for (int _i = 0; _i < 2; ++_i) \
        __builtin_amdgcn_global_load_lds((const unsigned*)((const char*)(gbase) + voffA[_i]), (LAS unsigned*)(lds + (bufoff) + ldsw + _i * 8192), 16, 0, 0); } while (0)
#define PG8_LDA(dst, b, h) do { _Pragma("unroll") for (int m = 0; m < 4; ++m) _Pragma("unroll") for (int k = 0; k < 2; ++k) dst[m][k] = *(const LAS bf16x8*)(lds + PG8_SA(b, h) + aoff + m * 2048 + k * 1024); } while (0)
#define PG8_LDB(dst, b, h) do { _Pragma("unroll") for (int n = 0; n < 2; ++n) _Pragma("unroll") for (int k = 0; k < 2; ++k) dst[n][k] = *(const LAS bf16x8*)(lds + PG8_SB(b, h) + boff + n * 2048 + k * 1024); } while (0)
#define PG8_MMA(ai, bj, At, Bt) do { __builtin_amdgcn_s_setprio(1); _Pragma("unroll") for (int m = 0; m < 4; ++m) _Pragma("unroll") for (int n = 0; n < 2; ++n) _Pragma("unroll") for (int k = 0; k < 2; ++k) \
        acc[ai][bj][m][n] = __builtin_amdgcn_mfma_f32_16x16x32_bf16(Bt[n][k], At[m][k], acc[ai][bj][m][n], 0, 0, 0); __builtin_amdgcn_s_setprio(0); } while (0)
#define PG8_WAIT_V(n) asm volatile("s_waitcnt vmcnt(" #n ")" ::: "memory")
#define PG8_WAIT_L(n) asm volatile("s_waitcnt lgkmcnt(" #n ")" ::: "memory")
#define PG8_BAR __builtin_amdgcn_s_barrier()
#define PG8_SCHED __builtin_amdgcn_sched_barrier(0)
    Unit cur, nxt; int ui = 0;
    if (!S.next(0, cur)) return;
    f32x4 acc[2][2][4][2];
#pragma unroll
    for (int a = 0; a < 2; ++a)
#pragma unroll
        for (int b = 0; b < 2; ++b)
#pragma unroll
            for (int m = 0; m < 4; ++m)
#pragma unroll
                for (int n = 0; n < 2; ++n) acc[a][b][m][n] = (f32x4){0.f, 0.f, 0.f, 0.f};
    bf16x8 At[4][2], B0[2][2], B1[2][2];
    const char* cA = S.aptr(cur); const char* cB = S.bptr(cur);
    PG8_STAGE(PG8_SB(0, 0), cB); PG8_STAGE(PG8_SA(0, 0), cA); PG8_STAGE(PG8_SB(0, 1), cB + hstep); PG8_STAGE(PG8_SA(0, 1), cA + hstep);
    if (wr == 1) PG8_BAR;
    PG8_WAIT_V(4); PG8_BAR;
    PG8_STAGE(PG8_SB(1, 0), cB + kstep); PG8_STAGE(PG8_SA(1, 0), cA + kstep); PG8_STAGE(PG8_SB(1, 1), cB + hstep + kstep);
    PG8_WAIT_V(6); PG8_BAR;
    for (;;) {
        const bool has_next = S.next(ui + 1, nxt);
        const char* nA = has_next ? S.aptr(nxt) : cA; const char* nB = has_next ? S.bptr(nxt) : cB;
#pragma unroll 1
        for (int t = 0; t < nt; t += 2) {
            const bool last = (t == nt - 2);
            const char* a1 = cA + (size_t)(t + 1) * kstep;
            const char* a2 = last ? nA : cA + (size_t)(t + 2) * kstep; const char* b2 = last ? nB : cB + (size_t)(t + 2) * kstep;
            const char* a3 = a2 + kstep; const char* b3 = b2 + kstep;
            PG8_LDB(B0, 0, 0); PG8_SCHED; PG8_LDA(At, 0, 0); PG8_STAGE(PG8_SA(1, 1), a1 + hstep);
            PG8_WAIT_L(8); PG8_BAR; PG8_WAIT_L(0); PG8_MMA(0, 0, At, B0); PG8_BAR; PG8_SCHED;
            PG8_LDB(B1, 0, 1); PG8_STAGE(PG8_SB(0, 0), b2);
            PG8_BAR; PG8_WAIT_L(0); if (!HALFN) PG8_MMA(0, 1, At, B1); PG8_BAR;
            PG8_LDA(At, 0, 1); PG8_STAGE(PG8_SA(0, 0), a2);
            PG8_BAR; PG8_WAIT_L(0); PG8_MMA(1, 0, At, B0); PG8_BAR; PG8_SCHED;
            PG8_STAGE(PG8_SB(0, 1), b2 + hstep);
            PG8_WAIT_V(6); PG8_BAR; if (!HALFN) PG8_MMA(1, 1, At, B1); PG8_BAR;
            PG8_LDB(B0, 1, 0); PG8_SCHED; PG8_LDA(At, 1, 0); PG8_STAGE(PG8_SA(0, 1), a2 + hstep);
            PG8_WAIT_L(8); PG8_BAR; PG8_WAIT_L(0); PG8_MMA(0, 0, At, B0); PG8_BAR; PG8_SCHED;
            PG8_LDB(B1, 1, 1); PG8_STAGE(PG8_SB(1, 0), b3);
            PG8_BAR; PG8_WAIT_L(0); if (!HALFN) PG8_MMA(0, 1, At, B1); PG8_BAR;
            PG8_LDA(At, 1, 1); PG8_STAGE(PG8_SA(1, 0), a3);
            PG8_BAR; PG8_WAIT_L(0); PG8_MMA(1, 0, At, B0); PG8_BAR; PG8_SCHED;
            PG8_STAGE(PG8_SB(1, 1), b3 + hstep);
            PG8_WAIT_V(6); PG8_BAR; if (!HALFN) PG8_MMA(1, 1, At, B1); PG8_BAR;
        }
        { int tz = TID(); asm volatile("" : "+v"(tz));
          const int wz = __builtin_amdgcn_readfirstlane(tz >> 6), lz = tz & 63; E(acc, cur, wz >> 2, wz & 3, lz & 15, lz >> 4); }
        if (!has_next) break;
#pragma unroll
        for (int a = 0; a < 2; ++a)
#pragma unroll
            for (int b = 0; b < (HALFN ? 1 : 2); ++b)
#pragma unroll
                for (int m = 0; m < 4; ++m)
#pragma unroll
                    for (int n = 0; n < 2; ++n) acc[a][b][m][n] = (f32x4){0.f, 0.f, 0.f, 0.f};
        cur = nxt; cA = nA; cB = nB; ++ui;
    }
    PG8_WAIT_V(0);
    if (wr == 0) PG8_BAR;
    PG8_BAR;
#undef PG8_SA
#undef PG8_SB
#undef PG8_STAGE
#undef PG8_LDA
#undef PG8_LDB
#undef PG8_MMA
#undef PG8_WAIT_V
#undef PG8_WAIT_L
#undef PG8_BAR
#undef PG8_SCHED
}
}
using pg8::Unit;
typedef f32x4 AccT[2][2][4][2];

struct Params {
    const float* in[26];
    float* out;
    unsigned char* ws;
    int ph_lo, ph_hi;
};
enum { I_X = 0, I_WIN, I_NMIX, I_NFFN, I_QKN, I_REL, I_MU, I_W0, I_W2, I_A0, I_A2, I_G2, I_KK, I_KA, I_RK, I_LNW, I_LNB, I_V0, I_VA, I_VB, I_KVN, I_KVUP, I_WBR, I_WO, I_F1, I_F2 };

DI const Params* KP() { auto k = __builtin_amdgcn_kernarg_segment_ptr(); asm volatile("" : "+s"(k)); return (const Params*)k; }
template <class T> DI T* wsp(size_t off) { return (T*)(KP()->ws + off); }

DI int cmap_b(int x) { const int pi = x & 255; return (x & ~255) + 64 * ((pi >> 5) & 3) + 32 * (pi >> 7) + 8 * ((pi >> 2) & 3) + 4 * ((pi >> 4) & 1) + (pi & 3); }
DI int cmap_f(int x) { const int pi = x & 255; return (x & ~255) + 64 * ((pi >> 5) & 3) + 32 * (pi >> 7) + 16 * ((pi >> 4) & 1) + 4 * ((pi >> 2) & 3) + (pi & 3); }
DI int wide_col(int x) { return cmap_b(x); }
template <int MAP> DI int colmap(int r) {
    if (MAP == 0) {
        if (r < 512) return C_MK + wide_col(r);
        if (r < 768) return C_DS + 512 + wide_col(r - 512);
        const int a = wide_col(r - 768);
        if (a < 32) return C_DS + 1024 + a;
        if (a < 40) return C_DS + 1056 + (a - 32);
        if (a >= 64 && a < 96) return C_RW + 1792 + (a - 64);
        return -1;
    }
    if (MAP == 1) return C_MV + r;
    if (MAP == 2) {
        if (r < 512) return C_MQ + wide_col(r);
        if (r < 1024) return C_DS + wide_col(r - 512);
        if (r < 1280) return C_DS + 768 + wide_col(r - 1024);
        if (r < 3072) return C_RW + wide_col(r - 1280);
        return C_GT + wide_col(r - 3072);
    }
    if (MAP == 3) return wide_col(r);
    if (MAP == 4) return 512 + r;
    if (MAP == 5) return cmap_b(r);
    if (MAP == 7) return cmap_f(r);
    if (MAP == 6) { const int pn = r >> 8, pi = r & 255;
        return ((pi >> 7) ? DFF : 0) + 128 * pn + 32 * ((pi >> 5) & 3) + 8 * ((pi >> 2) & 3) + 4 * ((pi >> 4) & 1) + (pi & 3); }
    return -1;
}
template <int MAP> DI void conv_t(LAS float* sm, bf16_t* dst, int nrows, int K, const float* src, int ld) {
    const int tid = TID(), tx = tid & 63, ty = tid >> 6;
    const int ntr = nrows / 64, ntk = K / 64, ntiles = ntr * ntk;
    for (int t = BID(); t < ntiles; t += gridDim.x) {
        const int r0 = (t / ntk) * 64, k0 = (t % ntk) * 64;
        const int col = colmap<MAP>(r0 + tx);
#pragma unroll
        for (int i = 0; i < 8; ++i) { const int kl = ty + 8 * i; sm[kl * 65 + tx] = (col >= 0) ? src[(size_t)(k0 + kl) * ld + col] : 0.f; }
        __syncthreads();
#pragma unroll
        for (int i = 0; i < 8; ++i) { const int rl = ty + 8 * i; dst[(size_t)(r0 + rl) * K + k0 + tx] = f2bf(sm[tx * 65 + rl]); }
        __syncthreads();
    }
}
DI void conv_lora(int l) {
    bf16_t* dst = wsp<bf16_t>(WS_WL);
    const float* w2 = KP()->in[I_W2] + (size_t)l * 64 * 512; const float* a2 = KP()->in[I_A2] + (size_t)l * 64 * 512; const float* g2 = KP()->in[I_G2] + (size_t)l * 160 * 512;
    const float* va = KP()->in[I_VA]; const float* vb = KP()->in[I_VB];
    const int n = 2048 * 512;
    for (int e = BID() * 512 + TID(); e < n; e += gridDim.x * 512) {
        const int r = wide_col(e >> 9), k = e & 511; float v = 0.f;
        if (r < 512) { if (k < 64) v = w2[k * 512 + r]; }
        else if (r < 1024) { if (k >= 64 && k < 128) v = a2[(k - 64) * 512 + (r - 512)]; }
        else if (r < 1536) { if (k >= 128 && k < 288) v = g2[(k - 128) * 512 + (r - 1024)]; }
        else if (l == 1) { const int c = r - 1536; float s = 0.f;
#pragma unroll 8
            for (int j = 0; j < 32; ++j) s += va[k * 32 + j] * vb[j * 512 + c];
            v = s; }
        dst[e] = f2bf(v);
    }
}
DI void phase_conv(int l, LAS float* sm) {
    const float* win = KP()->in[I_WIN] + (size_t)l * DM * D_IN;
    conv_t<0>(sm, wsp<bf16_t>(WS_WB), 1024, 1024, win, D_IN);
    conv_t<1>(sm, wsp<bf16_t>(WS_WV), 512, 1024, win, D_IN);
    conv_t<2>(sm, wsp<bf16_t>(WS_WD1), 6144, 1024, win, D_IN);
    const float* kvup = KP()->in[I_KVUP] + (size_t)l * 256 * 1024;
    conv_t<3>(sm, wsp<bf16_t>(WS_WKVK), 512, 256, kvup, 1024);
    conv_t<4>(sm, wsp<bf16_t>(WS_WKVV), 512, 256, kvup, 1024);
    for (int i = 0; i < 3; ++i) conv_t<5>(sm, wsp<bf16_t>(WS_WBR) + (size_t)i * 1024 * 512, 1024, 512, KP()->in[I_WBR] + ((size_t)l * 3 + i) * 512 * 1024, 1024);
    conv_t<7>(sm, wsp<bf16_t>(WS_WO), 1024, 1024, KP()->in[I_WO] + (size_t)l * 1024 * 1024, 1024);
    conv_t<6>(sm, wsp<bf16_t>(WS_WF1), 5632, 1024, KP()->in[I_F1] + (size_t)l * 1024 * 5632, 5632);
    conv_t<7>(sm, wsp<bf16_t>(WS_WF2), 1024, 2816, KP()->in[I_F2] + (size_t)l * 2816 * 1024, 1024);
    conv_lora(l);
}

DI void phase_norm(const float* x, const float* g, bf16_t* h) {
    const int lane = TID() & 63, gw = BID() * 8 + (TID() >> 6), nw = gridDim.x * 8;
    f32x4 gv[4];
#pragma unroll
    for (int i = 0; i < 4; ++i) gv[i] = ((const f32x4*)g)[lane + 64 * i];
    for (int row = gw; row < NT; row += nw) {
        const f32x4* xr = (const f32x4*)(x + (size_t)row * DM);
        f32x4 v[4]; float ss = 0.f;
#pragma unroll
        for (int i = 0; i < 4; ++i) { v[i] = xr[lane + 64 * i]; ss += v[i][0] * v[i][0] + v[i][1] * v[i][1] + v[i][2] * v[i][2] + v[i][3] * v[i][3]; }
        ss = wave_sum(ss);
        const float rs = __builtin_amdgcn_rsqf(ss * (1.f / DM) + NORM_EPS);
#pragma unroll
        for (int i = 0; i < 4; ++i) {
            u32x2 o; o[0] = pk2(v[i][0] * rs * gv[i][0], v[i][1] * rs * gv[i][1]); o[1] = pk2(v[i][2] * rs * gv[i][2], v[i][3] * rs * gv[i][3]);
            *(u32x2*)(h + (size_t)row * DM + 4 * (lane + 64 * i)) = o;
        }
    }
}

struct SchedLin {
    int nM, nN, G, c; unsigned aoff, boff, a2off; int rowbytes, amode, cbase, pn2;
    DI bool next(int i, Unit& u) const { return pg8::order_xcd(nM, nN, G, c, i, u); }
    DI const char* aptr(const Unit& u) const { const int row0 = amode ? ((u.pm >> 1) * SEQ + cbase + (u.pm & 1) * 256) : u.pm * 256; return (const char*)KP()->ws + ((u.pn >= pn2) ? a2off : aoff) + (size_t)row0 * rowbytes; }
    DI const char* bptr(const Unit& u) const { return (const char*)KP()->ws + boff + (size_t)u.pn * 256 * rowbytes; }
};
DI SchedLin mk_sched(int nM, int nN, size_t aoff, size_t boff, int K, int amode = 0, int cbase = 0, size_t a2off = 0, int pn2 = 1 << 30) {
    SchedLin s; s.nM = nM; s.nN = nN; s.G = gridDim.x; s.c = BID(); s.aoff = (unsigned)aoff; s.boff = (unsigned)boff; s.rowbytes = K * 2; s.amode = amode; s.cbase = cbase; s.a2off = (unsigned)a2off; s.pn2 = pn2; return s;
}
struct SchedMerge {
    int G, c;
    DI bool next(int i, Unit& u) const { const int z = i % 3, tile = (i / 3) * G + c; if (tile >= 256) return false; u.pm = tile >> 2; u.pn = tile & 3; u.z = z; return true; }
    DI const char* aptr(const Unit& u) const { return (const char*)KP()->ws + (u.z == 0 ? WS_MQ : (u.z == 1 ? WS_ORW : WS_DQ)) + (size_t)(u.pm >> 5) * PAR_O + (size_t)(u.pm & 31) * 256 * 1024; }
    DI const char* bptr(const Unit& u) const { return (const char*)KP()->ws + WS_WBR + (size_t)u.z * (1024 * 512 * 2) + (size_t)u.pn * 256 * 1024; }
};

DI void st_bf4(bf16_t* p, f32x4 v) { u32x2 o; o[0] = pk2(v[0], v[1]); o[1] = pk2(v[2], v[3]); *(u32x2*)p = o; }
DI f32x4 ld_bf4(const bf16_t* p) { const u32x2 u = *(const u32x2*)p; return (f32x4){bflo(u[0]), bfhi(u[0]), bflo(u[1]), bfhi(u[1])}; }
#define EPI_ROWS(ai, m) (128 * (ai) + 64 * wr + 16 * (m) + fr)
#define EPI_COLS(bj, n) (64 * wc + 32 * (bj) + 8 * fq + 4 * (n))
#define EPI_COLS_F(bj, n) (64 * wc + 32 * (bj) + 16 * (n) + 4 * fq)
#define EPI_COLS_T(bj, n) (128 * (bj) + 32 * wc + 16 * (n) + 4 * fq)
#define FOR_AM _Pragma("unroll") for (int ai = 0; ai < 2; ++ai) _Pragma("unroll") for (int m = 0; m < 4; ++m)
#define FOR_BN _Pragma("unroll") for (int bj = 0; bj < 2; ++bj) _Pragma("unroll") for (int n = 0; n < 2; ++n)

DI void epi_headnorm(const AccT& acc, bf16_t* out, int ld, const float* gain, int wr, int wc, int fr, int fq) {
    f32x4 gv[2][2];
    FOR_BN gv[bj][n] = *(const f32x4*)(gain + 32 * bj + 8 * fq + 4 * n);
    FOR_AM {
        float ss = 0.f;
        FOR_BN { const f32x4 a = acc[ai][bj][m][n]; ss += a[0] * a[0] + a[1] * a[1] + a[2] * a[2] + a[3] * a[3]; }
        ss += __shfl_xor(ss, 16); ss += __shfl_xor(ss, 32);
        const float sc = __builtin_amdgcn_rsqf(ss * (1.f / 64.f) + NORM_EPS);
        bf16_t* rp = out + (size_t)EPI_ROWS(ai, m) * ld;
        FOR_BN st_bf4(rp + EPI_COLS(bj, n), acc[ai][bj][m][n] * sc * gv[bj][n]);
    }
}
DI void epi_store_bf16(const AccT& acc, bf16_t* out, int ld, int wr, int wc, int fr, int fq) {
    FOR_AM { bf16_t* rp = out + (size_t)EPI_ROWS(ai, m) * ld; FOR_BN st_bf4(rp + EPI_COLS(bj, n), acc[ai][bj][m][n]); }
}

struct EpiB {
    int l;
    DI void operator()(const AccT& acc, const Unit& u, int wr, int wc, int fr, int fq) const {
        const size_t row0 = (size_t)u.pm * 256;
        if (u.pn < 2) epi_headnorm(acc, wsp<bf16_t>(WS_MK) + row0 * 512 + u.pn * 256, 512, KP()->in[I_QKN] + l * 256 + 64, wr, wc, fr, fq);
        else if (u.pn == 2) epi_store_bf16(acc, wsp<bf16_t>(WS_DCN) + row0 * 256, 256, wr, wc, fr, fq);
        else {
            bf16_t* idxk = wsp<bf16_t>(WS_IDXK); float* idxw = wsp<float>(WS_IDXW); bf16_t* left = wsp<bf16_t>(WS_LEFT);
            FOR_AM { const size_t row = row0 + EPI_ROWS(ai, m);
                if (wc == 0) {
#pragma unroll
                    for (int n = 0; n < 2; ++n) st_bf4(idxk + row * 32 + 8 * fq + 4 * n, acc[ai][0][m][n]);
                    if (fq == 0) { *(f32x4*)(idxw + row * 8) = acc[ai][1][m][0]; *(f32x4*)(idxw + row * 8 + 4) = acc[ai][1][m][1]; }
                } else if (wc == 1) {
#pragma unroll
                    for (int n = 0; n < 2; ++n) st_bf4(left + row * 32 + 8 * fq + 4 * n, acc[ai][0][m][n]);
                }
            }
        }
    }
};
struct EpiVt {
    unsigned off;
    DI void operator()(const AccT& acc, const Unit& u, int wr, int wc, int fr, int fq) const {
        bf16_t* vt = wsp<bf16_t>(off);
        const int b = u.pn >> 3, s0 = (u.pn & 7) * 256;
        FOR_AM { bf16_t* rp = vt + ((size_t)b * 512 + u.pm * 256 + EPI_ROWS(ai, m)) * SEQ + s0; FOR_BN st_bf4(rp + EPI_COLS_T(bj, n), acc[ai][bj][m][n]); }
    }
};
struct EpiHN {
    int l;
    DI void operator()(const AccT& acc, const Unit& u, int wr, int wc, int fr, int fq) const { epi_headnorm(acc, wsp<bf16_t>(WS_DK) + (size_t)u.pm * 256 * 512 + u.pn * 256, 512, KP()->in[I_QKN] + l * 256 + 192, wr, wc, fr, fq); }
};
struct EpiD1 {
    int l, par;
    DI void operator()(const AccT& acc, const Unit& u, int wr, int wc, int fr, int fq) const {
        const size_t row0 = (size_t)u.pm * 256;
        if (u.pn < 2) epi_headnorm(acc, wsp<bf16_t>(WS_MQ + par * PAR_O) + row0 * 512 + u.pn * 256, 512, KP()->in[I_QKN] + l * 256, wr, wc, fr, fq);
        else if (u.pn < 4) epi_headnorm(acc, wsp<bf16_t>(WS_DQ + par * PAR_O) + row0 * 512 + (u.pn - 2) * 256, 512, KP()->in[I_QKN] + l * 256 + 128, wr, wc, fr, fq);
        else if (u.pn == 4) epi_store_bf16(acc, wsp<bf16_t>(WS_IDXQ) + row0 * 256, 256, wr, wc, fr, fq);
        else if (u.pn < 12) epi_store_bf16(acc, wsp<bf16_t>(WS_RAW) + row0 * RAWLD + (u.pn - 5) * 256, RAWLD, wr, wc, fr, fq);
        else {
            unsigned char* o = wsp<unsigned char>(WS_GATES + par * PAR_G) + row0 * 3072 + (u.pn - 12) * 256;
            FOR_AM { unsigned char* rp = o + (size_t)EPI_ROWS(ai, m) * 3072;
                FOR_BN { const f32x4 a = acc[ai][bj][m][n];
                    const unsigned q0 = (unsigned)(fsigmoid(a[0]) * 255.f + 0.5f), q1 = (unsigned)(fsigmoid(a[1]) * 255.f + 0.5f), q2 = (unsigned)(fsigmoid(a[2]) * 255.f + 0.5f), q3 = (unsigned)(fsigmoid(a[3]) * 255.f + 0.5f);
                    *(unsigned*)(rp + EPI_COLS(bj, n)) = q0 | (q1 << 8) | (q2 << 16) | (q3 << 24); } }
        }
    }
};
struct EpiLora {
    int l, cbase;
    DI void operator()(const AccT& acc, const Unit& u, int wr, int wc, int fr, int fq) const {
        const size_t row0 = (size_t)u.pm * 256; const int kind = u.pn >> 1, cb = (u.pn & 1) * 256;
        if (kind == 0) {
            float* dec = wsp<float>(WS_DEC); const float* w0 = KP()->in[I_W0] + l * 512;
            FOR_AM { const size_t row = row0 + EPI_ROWS(ai, m);
                FOR_BN { const int col = cb + EPI_COLS(bj, n); const f32x4 a = acc[ai][bj][m][n]; const f32x4 wv = *(const f32x4*)(w0 + col); f32x4 d;
#pragma unroll
                    for (int e = 0; e < 4; ++e) { const float x = -(wv[e] + a[e]);
                        const float sp = fmaxf(x, 0.f) + __builtin_amdgcn_logf(1.f + fexp2(-fabsf(x) * LOG2E)) * 0.6931471805599453f;
                        const float w = -sp - 0.5f; d[e] = fexp2(-fexp2(w * LOG2E) * LOG2E); }
                    *(f32x4*)(dec + row * 512 + col) = d; } }
        } else if (kind == 1) {
            bf16_t* kf = wsp<bf16_t>(WS_KF); const bf16_t* kkb = wsp<bf16_t>(WS_KKB); bf16_t* bbb = wsp<bf16_t>(WS_BBB);
            const float* a0 = KP()->in[I_A0] + l * 512; const float* ka = KP()->in[I_KA] + l * 512;
            FOR_AM { const size_t row = row0 + EPI_ROWS(ai, m);
                f32x4 kp[2][2], kk[2][2];
                FOR_BN { const int col = cb + EPI_COLS(bj, n); kp[bj][n] = ld_bf4(kf + row * 512 + col); kk[bj][n] = ld_bf4(kkb + row * 512 + col); }
                FOR_BN { const int col = cb + EPI_COLS(bj, n); const f32x4 a = acc[ai][bj][m][n];
                    const f32x4 av = *(const f32x4*)(a0 + col), kav = *(const f32x4*)(ka + col); f32x4 ko, bo;
#pragma unroll
                    for (int e = 0; e < 4; ++e) { const float s = fsigmoid(av[e] + a[e]); ko[e] = kp[bj][n][e] * (1.f + (s - 1.f) * kav[e]); bo[e] = kk[bj][n][e] * s; }
                    st_bf4(kf + row * 512 + col, ko); st_bf4(bbb + row * 512 + col, bo); } }
        } else if (kind == 2) {
            epi_store_bf16(acc, wsp<bf16_t>(WS_GG) + row0 * 512 + cb, 512, wr, wc, fr, fq);
        } else {
            const bf16_t* vv = wsp<bf16_t>(WS_VV); bf16_t* v2 = wsp<bf16_t>(WS_V2); const bf16_t* vfirst = wsp<bf16_t>(WS_VFIRST); const float* v0 = KP()->in[I_V0];
            FOR_AM { const size_t row = row0 + EPI_ROWS(ai, m); const size_t arow = (size_t)(row >> 9) * SEQ + cbase + (row & 511);
                f32x4 vp[2][2], vf[2][2];
                FOR_BN { const int col = cb + EPI_COLS(bj, n); vp[bj][n] = ld_bf4(vv + row * 512 + col); vf[bj][n] = ld_bf4(vfirst + arow * 512 + col); }
                FOR_BN { const int col = cb + EPI_COLS(bj, n); const f32x4 a = acc[ai][bj][m][n]; const f32x4 v0v = *(const f32x4*)(v0 + col); f32x4 o;
#pragma unroll
                    for (int e = 0; e < 4; ++e) o[e] = vp[bj][n][e] + (vf[bj][n][e] - vp[bj][n][e]) * fsigmoid(v0v[e] + a[e]);
                    st_bf4(v2 + row * 512 + col, o); } }
        }
    }
};
struct EpiMerge {
    DI void operator()(const AccT& acc, const Unit& u, int wr, int wc, int fr, int fq) const {
        bf16_t* y = wsp<bf16_t>(WS_Y); const unsigned char* gates = wsp<unsigned char>(WS_GATES + (size_t)(u.pm >> 5) * PAR_G);
        const size_t row0 = (size_t)u.pm * 256, grow0 = (size_t)(u.pm & 31) * 256; const int c0 = u.pn * 256 + 64 * wc + 8 * fq, z = u.z;
#pragma unroll
        for (int ai = 0; ai < 2; ++ai) {
            u32x2 g[4][2]; u32x4 yv[4][2];
#pragma unroll
            for (int m = 0; m < 4; ++m) { const int rt = EPI_ROWS(ai, m);
#pragma unroll
                for (int bj = 0; bj < 2; ++bj) { g[m][bj] = *(const u32x2*)(gates + (grow0 + rt) * 3072 + z * 1024 + c0 + 32 * bj);
                    if (z > 0) yv[m][bj] = *(const u32x4*)(y + (row0 + rt) * 1024 + c0 + 32 * bj); } }
#pragma unroll
            for (int m = 0; m < 4; ++m) { const size_t row = row0 + EPI_ROWS(ai, m);
#pragma unroll
                for (int bj = 0; bj < 2; ++bj) { u32x4 o;
#pragma unroll
                    for (int n = 0; n < 2; ++n) { const unsigned gu = g[m][bj][n];
                        const f32x4 gf = (f32x4){(float)(gu & 255u), (float)((gu >> 8) & 255u), (float)((gu >> 16) & 255u), (float)(gu >> 24)} * (1.f / 255.f);
                        f32x4 v = acc[ai][bj][m][n] * gf;
                        if (z > 0) { const unsigned ya = yv[m][bj][2 * n], yb = yv[m][bj][2 * n + 1]; v += (f32x4){bflo(ya), bfhi(ya), bflo(yb), bfhi(yb)}; }
                        o[2 * n] = pk2(v[0], v[1]); o[2 * n + 1] = pk2(v[2], v[3]); }
                    *(u32x4*)(y + row * 1024 + c0 + 32 * bj) = o; } }
        }
    }
};
struct EpiRes {
    int first, amode, cbase; unsigned dummy_off;
    DI void operator()(const AccT& acc, const Unit& u, int wr, int wc, int fr, int fq) const {
        float* out = KP()->out; const float* res = first ? KP()->in[I_X] : (const float*)out;
        if (dummy_off) out = wsp<float>(dummy_off);
        const size_t grow0 = amode == 2 ? ((size_t)((u.pm & 31) >> 1) * SEQ + cbase + (u.pm >> 5) * SC + (u.pm & 1) * 256) : (amode ? ((size_t)(u.pm >> 1) * SEQ + cbase + (u.pm & 1) * 256) : (size_t)u.pm * 256); const int c0 = u.pn * 256;
#pragma unroll
        for (int ai = 0; ai < 2; ++ai) {
            f32x4 rv[4][2][2];
#pragma unroll
            for (int m = 0; m < 4; ++m) { const size_t row = grow0 + EPI_ROWS(ai, m); FOR_BN rv[m][bj][n] = *(const f32x4*)(res + row * DM + c0 + EPI_COLS_F(bj, n)); }
#pragma unroll
            for (int m = 0; m < 4; ++m) { const size_t row = grow0 + EPI_ROWS(ai, m); FOR_BN *(f32x4*)(out + row * DM + c0 + EPI_COLS_F(bj, n)) = rv[m][bj][n] + acc[ai][bj][m][n]; }
        }
    }
};
struct EpiNull { DI void operator()(const AccT& acc, const Unit& u, int wr, int wc, int fr, int fq) const { f32x4 s = {0.f, 0.f, 0.f, 0.f}; FOR_AM { FOR_BN s += acc[ai][bj][m][n]; } if (s[0] + s[1] + s[2] + s[3] == 12345.678f) *wsp<float>(WS_OUT) = 1.f; } };
struct EpiSwiglu {
    DI void operator()(const AccT& acc, const Unit& u, int wr, int wc, int fr, int fq) const {
        bf16_t* act = wsp<bf16_t>(WS_ACT);
        FOR_AM { bf16_t* rp = act + ((size_t)u.pm * 256 + EPI_ROWS(ai, m)) * DFF + u.pn * 128 + 32 * wc + 8 * fq;
            u32x4 w;
#pragma unroll
            for (int n = 0; n < 2; ++n) { const f32x4 g = acc[ai][0][m][n], up = acc[ai][1][m][n]; f32x4 o;
#pragma unroll
                for (int e = 0; e < 4; ++e) o[e] = g[e] * fsigmoid(g[e]) * up[e];
                w[2 * n] = pk2(o[0], o[1]); w[2 * n + 1] = pk2(o[2], o[3]); }
            *(u32x4*)rp = w; }
    }
};

DI void phase_dcn(int l) {
    const int lane = TID() & 63, gw = BID() * 8 + (TID() >> 6), nw = gridDim.x * 8;
    bf16_t* dcn = wsp<bf16_t>(WS_DCN);
    const f32x4 g = *(const f32x4*)(KP()->in[I_KVN] + l * 256 + 4 * lane);
    for (int row = gw; row < NT; row += nw) {
        bf16_t* rp = dcn + (size_t)row * 256 + 4 * lane;
        const f32x4 v = ld_bf4(rp);
        const float ss = wave_sum(v[0] * v[0] + v[1] * v[1] + v[2] * v[2] + v[3] * v[3]);
        const float rs = __builtin_amdgcn_rsqf(ss * (1.f / 256.f) + NORM_EPS);
        st_bf4(rp, v * rs * g);
    }
}
DI void phase_kmean() {
    const int lane = TID() & 63, gw = BID() * 8 + (TID() >> 6), nw = gridDim.x * 8;
    const bf16_t* mk = wsp<bf16_t>(WS_MK); float* km = wsp<float>(WS_KMEAN);
    for (int it = gw; it < NB * NH * 8; it += nw) {
        const int n = it & 7, h = (it >> 3) & 7, b = it >> 6;
        const bf16_t* kp = mk + ((size_t)b * SEQ + n * 256 + (lane >> 3)) * 512 + h * 64 + 8 * (lane & 7);
        float s[8] = {0.f, 0.f, 0.f, 0.f, 0.f, 0.f, 0.f, 0.f};
#pragma unroll 8
        for (int k = 0; k < 256; k += 8) { const u32x4 u = *(const u32x4*)(kp + (size_t)k * 512);
#pragma unroll
            for (int q = 0; q < 4; ++q) { s[2 * q] += bflo(u[q]); s[2 * q + 1] += bfhi(u[q]); } }
#pragma unroll
        for (int e = 0; e < 8; ++e) {
            float v = s[e];
            v += __uint_as_float(__builtin_amdgcn_update_dpp(0, __float_as_uint(v), 0x128, 0xf, 0xf, false));
            auto r = __builtin_amdgcn_permlane16_swap(__float_as_uint(v), __float_as_uint(v), false, false); v = __uint_as_float(r[0]) + __uint_as_float(r[1]);
            r = __builtin_amdgcn_permlane32_swap(__float_as_uint(v), __float_as_uint(v), false, false); s[e] = (__uint_as_float(r[0]) + __uint_as_float(r[1])) * (1.f / 256.f);
        }
        if (lane < 8) { float* o = km + (size_t)it * 64 + 8 * lane; *(f32x4*)o = (f32x4){s[0], s[1], s[2], s[3]}; *(f32x4*)(o + 4) = (f32x4){s[4], s[5], s[6], s[7]}; }
    }
}

DI void phase_rwkv_prep(int l, int c) {
    const int lane = TID() & 63, gw = BID() * 8 + (TID() >> 6), nw = gridDim.x * 8;
    const bf16_t* raw = wsp<bf16_t>(WS_RAW); const bf16_t* left = wsp<bf16_t>(WS_LEFT); bf16_t* carry = wsp<bf16_t>(WS_CARRY);
    bf16_t* rr = wsp<bf16_t>(WS_RR); bf16_t* kf = wsp<bf16_t>(WS_KF); bf16_t* vv = wsp<bf16_t>(WS_VV); bf16_t* kkb = wsp<bf16_t>(WS_KKB);
    bf16_t* la = wsp<bf16_t>(WS_LORAA); bf16_t* vfirst = wsp<bf16_t>(WS_VFIRST);
    const float* mu = KP()->in[I_MU] + l * 1824; const float* kkw = KP()->in[I_KK] + l * 512;
    for (int rc = gw; rc < TC; rc += nw) {
        const int b = rc >> 9, sl = rc & 511, s = c * SC + sl; const size_t ra = (size_t)b * SEQ + s;
        const bf16_t* cur = raw + (size_t)rc * RAWLD;
        const bf16_t* prv = (sl > 0) ? (cur - RAWLD) : (carry + (size_t)((((c + 1) & 1) * 16) + b) * RAWLD);
        const bool hp = s > 0;
        auto mix8 = [&](int j, float* o) {
            const u32x4 cu = *(const u32x4*)(cur + j); u32x4 pu = {0u, 0u, 0u, 0u}; if (hp) pu = *(const u32x4*)(prv + j);
            const f32x4 m0 = *(const f32x4*)(mu + j), m1 = *(const f32x4*)(mu + j + 4);
#pragma unroll
            for (int e = 0; e < 4; ++e) { const float c0 = bflo(cu[e]), c1 = bfhi(cu[e]), p0 = bflo(pu[e]), p1 = bfhi(pu[e]);
                const float ma = (2 * e < 4) ? m0[2 * e] : m1[2 * e - 4], mb = (2 * e + 1 < 4) ? m0[2 * e + 1] : m1[2 * e + 1 - 4];
                o[2 * e] = c0 + (p0 - c0) * ma; o[2 * e + 1] = c1 + (p1 - c1) * mb; }
        };
        float o[8];
        mix8(8 * lane, o);
        { u32x4 w; w[0] = pk2(o[0], o[1]); w[1] = pk2(o[2], o[3]); w[2] = pk2(o[4], o[5]); w[3] = pk2(o[6], o[7]); *(u32x4*)(rr + (size_t)rc * 512 + 8 * lane) = w; }
        mix8(576 + 8 * lane, o);
        { u32x4 w; w[0] = pk2(o[0], o[1]); w[1] = pk2(o[2], o[3]); w[2] = pk2(o[4], o[5]); w[3] = pk2(o[6], o[7]); *(u32x4*)(kf + (size_t)rc * 512 + 8 * lane) = w;
          const f32x4 k0 = *(const f32x4*)(kkw + 8 * lane), k1 = *(const f32x4*)(kkw + 8 * lane + 4);
          float q[8]; float ss = 0.f;
#pragma unroll
          for (int e = 0; e < 8; ++e) { q[e] = o[e] * (e < 4 ? k0[e] : k1[e - 4]); ss += q[e] * q[e]; }
          ss += __shfl_xor(ss, 1); ss += __shfl_xor(ss, 2); ss += __shfl_xor(ss, 4);
          const float inv = 1.f / fmaxf(sqrtf(ss), 1e-12f);
          w[0] = pk2(q[0] * inv, q[1] * inv); w[1] = pk2(q[2] * inv, q[3] * inv); w[2] = pk2(q[4] * inv, q[5] * inv); w[3] = pk2(q[6] * inv, q[7] * inv);
          *(u32x4*)(kkb + (size_t)rc * 512 + 8 * lane) = w; }
        mix8(1088 + 8 * lane, o);
        { u32x4 w; w[0] = pk2(o[0], o[1]); w[1] = pk2(o[2], o[3]); w[2] = pk2(o[4], o[5]); w[3] = pk2(o[6], o[7]); *(u32x4*)(vv + (size_t)rc * 512 + 8 * lane) = w;
          if (l == 0) *(u32x4*)(vfirst + ra * 512 + 8 * lane) = w; }
        { bf16_t* lr = la + (size_t)rc * 512;
          const bf16_t* cs = cur; const bf16_t* ps_ = prv; int sc = 512 + 8 * lane, dc = 8 * lane, fn = 0; const float* mup = mu;
          if (lane >= 8) { sc = 1600 + 8 * (lane - 8); dc = 64 + 8 * (lane - 8); fn = 1; }
          if (lane >= 16) { sc = 1664 + 8 * (lane - 16); dc = 128 + 8 * (lane - 16); fn = 2; }
          if (lane >= 32) { cs = left + ra * 32; ps_ = left + (ra - 1) * 32; sc = 8 * (lane - 32); dc = 256 + 8 * (lane - 32); mup = mu + 1792; }
          u32x4 w = {0u, 0u, 0u, 0u};
          if (lane < 36) {
              const u32x4 cu = *(const u32x4*)(cs + sc); u32x4 pu = {0u, 0u, 0u, 0u}; if (hp) pu = *(const u32x4*)(ps_ + sc);
              const f32x4 m0 = *(const f32x4*)(mup + sc), m1 = *(const f32x4*)(mup + sc + 4);
              float x[8];
#pragma unroll
              for (int e = 0; e < 4; ++e) { const float c0 = bflo(cu[e]), c1 = bfhi(cu[e]), p0 = bflo(pu[e]), p1 = bfhi(pu[e]);
                  const float ma = (2 * e < 4) ? m0[2 * e] : m1[2 * e - 4], mb = (2 * e + 1 < 4) ? m0[2 * e + 1] : m1[2 * e + 1 - 4];
                  x[2 * e] = c0 + (p0 - c0) * ma; x[2 * e + 1] = c1 + (p1 - c1) * mb; }
#pragma unroll
              for (int e = 0; e < 8; ++e) { const float th = 1.f - 2.f * frcp(fexp2(2.f * x[e] * LOG2E) + 1.f), sg = fsigmoid(x[e]); x[e] = fn == 0 ? th : (fn == 1 ? x[e] : sg); }
              w[0] = pk2(x[0], x[1]); w[1] = pk2(x[2], x[3]); w[2] = pk2(x[4], x[5]); w[3] = pk2(x[6], x[7]);
          } else dc = 288 + 8 * (lane - 36);
          *(u32x4*)(lr + dc) = w; }
        if (sl == SC - 1) { bf16_t* cp = carry + (size_t)(((c & 1) * 16) + b) * RAWLD;
            for (int j = lane; j < RAWLD / 8; j += 64) *(u32x4*)(cp + 8 * j) = *(const u32x4*)(cur + 8 * j); }
    }
}

DI float dpp_ror_add(float x, int) { return x; }
DI void reduce4(float p0, float p1, float p2, float p3, float& s0, float& s1, float& s2, float& s3) {
    auto r = __builtin_amdgcn_permlane32_swap(__float_as_uint(p0), __float_as_uint(p2), false, false);
    const float u0 = __uint_as_float(r[0]) + __uint_as_float(r[1]);
    r = __builtin_amdgcn_permlane32_swap(__float_as_uint(p1), __float_as_uint(p3), false, false);
    const float u1 = __uint_as_float(r[0]) + __uint_as_float(r[1]);
    r = __builtin_amdgcn_permlane16_swap(__float_as_uint(u0), __float_as_uint(u1), false, false);
    float w = __uint_as_float(r[0]) + __uint_as_float(r[1]);
    w += __uint_as_float(__builtin_amdgcn_update_dpp(0, __float_as_uint(w), 0x128, 0xf, 0xf, false));
    w += __uint_as_float(__builtin_amdgcn_update_dpp(0, __float_as_uint(w), 0x124, 0xf, 0xf, false));
    w += __uint_as_float(__builtin_amdgcn_update_dpp(0, __float_as_uint(w), 0x122, 0xf, 0xf, false));
    w += __uint_as_float(__builtin_amdgcn_update_dpp(0, __float_as_uint(w), 0x121, 0xf, 0xf, false));
    s0 = __uint_as_float(__builtin_amdgcn_readlane(__float_as_uint(w), 0));
    s1 = __uint_as_float(__builtin_amdgcn_readlane(__float_as_uint(w), 16));
    s2 = __uint_as_float(__builtin_amdgcn_readlane(__float_as_uint(w), 32));
    s3 = __uint_as_float(__builtin_amdgcn_readlane(__float_as_uint(w), 48));
}
DI void reduce8(float p0, float p1, float p2, float p3, float q0, float q1, float q2, float q3, float& pw, float& s0, float& s1, float& s2, float& s3) {
    auto r = __builtin_amdgcn_permlane32_swap(__float_as_uint(p0), __float_as_uint(p2), false, false);
    auto t = __builtin_amdgcn_permlane32_swap(__float_as_uint(q0), __float_as_uint(q2), false, false);
    const float u0 = __uint_as_float(r[0]) + __uint_as_float(r[1]);
    const float x0 = __uint_as_float(t[0]) + __uint_as_float(t[1]);
    r = __builtin_amdgcn_permlane32_swap(__float_as_uint(p1), __float_as_uint(p3), false, false);
    t = __builtin_amdgcn_permlane32_swap(__float_as_uint(q1), __float_as_uint(q3), false, false);
    const float u1 = __uint_as_float(r[0]) + __uint_as_float(r[1]);
    const float x1 = __uint_as_float(t[0]) + __uint_as_float(t[1]);
    r = __builtin_amdgcn_permlane16_swap(__float_as_uint(u0), __float_as_uint(u1), false, false);
    t = __builtin_amdgcn_permlane16_swap(__float_as_uint(x0), __float_as_uint(x1), false, false);
    float w = __uint_as_float(r[0]) + __uint_as_float(r[1]);
    float y = __uint_as_float(t[0]) + __uint_as_float(t[1]);
    w += __uint_as_float(__builtin_amdgcn_update_dpp(0, __float_as_uint(w), 0x128, 0xf, 0xf, false));
    y += __uint_as_float(__builtin_amdgcn_update_dpp(0, __float_as_uint(y), 0x128, 0xf, 0xf, false));
    w += __uint_as_float(__builtin_amdgcn_update_dpp(0, __float_as_uint(w), 0x124, 0xf, 0xf, false));
    y += __uint_as_float(__builtin_amdgcn_update_dpp(0, __float_as_uint(y), 0x124, 0xf, 0xf, false));
    w += __uint_as_float(__builtin_amdgcn_update_dpp(0, __float_as_uint(w), 0x122, 0xf, 0xf, false));
    y += __uint_as_float(__builtin_amdgcn_update_dpp(0, __float_as_uint(y), 0x122, 0xf, 0xf, false));
    w += __uint_as_float(__builtin_amdgcn_update_dpp(0, __float_as_uint(w), 0x121, 0xf, 0xf, false));
    y += __uint_as_float(__builtin_amdgcn_update_dpp(0, __float_as_uint(y), 0x121, 0xf, 0xf, false));
    pw = w;
    s0 = __uint_as_float(__builtin_amdgcn_readlane(__float_as_uint(y), 0));
    s1 = __uint_as_float(__builtin_amdgcn_readlane(__float_as_uint(y), 16));
    s2 = __uint_as_float(__builtin_amdgcn_readlane(__float_as_uint(y), 32));
    s3 = __uint_as_float(__builtin_amdgcn_readlane(__float_as_uint(y), 48));
}
struct ScanIn { bf16_t kk, bb, k, r, v; float w; };
DI void phase_scan(int l, int c, int dummy = 0) {
    const int lane = TID() & 63, gw = BID() * 8 + (TID() >> 6), nw = gridDim.x * 8;
    const bf16_t* kkb = wsp<bf16_t>(WS_KKB); const bf16_t* bbb = wsp<bf16_t>(WS_BBB); const bf16_t* kfb = wsp<bf16_t>(WS_KF); const bf16_t* rrb = wsp<bf16_t>(WS_RR);
    const bf16_t* vsb = wsp<bf16_t>(l == 0 ? WS_VV : WS_V2); const float* dec = wsp<float>(WS_DEC); float* outb = wsp<float>(WS_OUT); float* state = wsp<float>(WS_STATE);
    for (int item = gw; item < NB * NH * 16; item += nw) {
        const int bh = item >> 4, rg = item & 15, b = bh >> 3, h = bh & 7, i0 = rg * 4;
        float* stp = state + ((size_t)bh * 64 + i0) * 64 + lane;
        float S0 = 0.f, S1 = 0.f, S2 = 0.f, S3 = 0.f;
        if (c > 0) { S0 = stp[0]; S1 = stp[64]; S2 = stp[128]; S3 = stp[192]; }
        const size_t e0 = (size_t)b * SC * 512 + h * 64 + lane;
        const size_t ev = (size_t)b * SC * 512 + h * 64 + i0 + (lane & 3);
        float* op = outb + (size_t)b * SC * 512 + h * 64 + i0 + (lane >> 4);
        ScanIn A[8], B[8];
#define SCAN_LOAD(X, g) do { _Pragma("unroll") for (int j = 0; j < 8; ++j) { const size_t o = (size_t)((g) * 8 + j) * 512; \
            X[j].kk = kkb[e0 + o]; X[j].bb = bbb[e0 + o]; X[j].k = kfb[e0 + o]; X[j].r = rrb[e0 + o]; X[j].w = dec[e0 + o]; X[j].v = vsb[ev + o]; } } while (0)
#define SCAN_STEP1(Xj, kknext, t) do { \
            const float bb = bf2f(Xj.bb), kx = bf2f(Xj.k), rx = bf2f(Xj.r), wx = Xj.w; const unsigned vu = (unsigned)Xj.v << 16; \
            const float v0 = __uint_as_float(__builtin_amdgcn_readlane(vu, 0)), v1 = __uint_as_float(__builtin_amdgcn_readlane(vu, 1)), v2 = __uint_as_float(__builtin_amdgcn_readlane(vu, 2)), v3 = __uint_as_float(__builtin_amdgcn_readlane(vu, 3)); \
            S0 = S0 * wx + (v0 * kx - a0 * bb); S1 = S1 * wx + (v1 * kx - a1 * bb); S2 = S2 * wx + (v2 * kx - a2 * bb); S3 = S3 * wx + (v3 * kx - a3 * bb); \
            float ov; const float kn = (kknext); \
            reduce8(S0 * rx, S1 * rx, S2 * rx, S3 * rx, S0 * kn, S1 * kn, S2 * kn, S3 * kn, ov, a0, a1, a2, a3); \
            if ((lane & 15) == 0) op[(size_t)(t) * 512] = ov; } while (0)
#define SCAN_GROUP(X, Y, g, lastg) do { _Pragma("unroll") for (int j = 0; j < 8; ++j) { \
            const float kkn = (j < 7) ? bf2f(X[j < 7 ? j + 1 : 7].kk) : ((lastg) ? 0.f : bf2f(Y[0].kk)); \
            SCAN_STEP1(X[j], kkn, (g) * 8 + j); } } while (0)
        SCAN_LOAD(A, 0);
        float a0, a1, a2, a3;
        { const float k0 = bf2f(A[0].kk); reduce4(S0 * k0, S1 * k0, S2 * k0, S3 * k0, a0, a1, a2, a3); }
#if DBL_PHASE == 11
        if (dummy == 2) {
            float acc_ = 0.f;
            for (int g = 0; g < SC / 8; g += 2) {
                SCAN_LOAD(B, g + 1);
#pragma unroll
                for (int j = 0; j < 8; ++j) acc_ += bf2f(A[j].kk) + bf2f(A[j].bb) + bf2f(A[j].k) + bf2f(A[j].r) + bf2f(A[j].v) + A[j].w;
                if (g + 2 < SC / 8) SCAN_LOAD(A, g + 2);
#pragma unroll
                for (int j = 0; j < 8; ++j) acc_ += bf2f(B[j].kk) + bf2f(B[j].bb) + bf2f(B[j].k) + bf2f(B[j].r) + bf2f(B[j].v) + B[j].w;
            }
            if (acc_ == 12345.678f) stp[0] = acc_;
            continue;
        }
#endif
#if DBL_PHASE == 12
        if (dummy == 3) {
#pragma unroll
            for (int j = 0; j < 8; ++j) { A[j].kk = (bf16_t)(0x3c00 + lane + j); A[j].bb = (bf16_t)(0x3b00 + lane); A[j].k = (bf16_t)(0x3d00 + j); A[j].r = (bf16_t)(0x3e00 + lane); A[j].v = (bf16_t)(0x3c80 + j); A[j].w = 0.9f; B[j] = A[j]; }
            op = wsp<float>(WS_RAW) + (size_t)item * 4 + (lane >> 4);
            for (int g = 0; g < SC / 8; g += 2) {
                SCAN_GROUP(A, B, 0, false);
                SCAN_GROUP(B, A, 0, false);
            }
            if (S0 + S1 + S2 + S3 == 12345.678f) stp[0] = S0;
            continue;
        }
#endif
        for (int g = 0; g < SC / 8; g += 2) {
            SCAN_LOAD(B, g + 1);
            SCAN_GROUP(A, B, g, false);
            const bool last = (g + 2 >= SC / 8);
            if (!last) SCAN_LOAD(A, g + 2);
            SCAN_GROUP(B, A, g + 1, last);
        }
#undef SCAN_STEP1
#undef SCAN_GROUP
#undef SCAN_LOAD
        if (!dummy) { stp[0] = S0; stp[64] = S1; stp[128] = S2; stp[192] = S3; }
    }
}
typedef short s16x4 __attribute__((ext_vector_type(4)));
#define M16K32(a, b, c) __builtin_amdgcn_mfma_f32_16x16x32_bf16((a), (b), (c), 0, 0, 0)
#define M16K16(a, b, c) __builtin_amdgcn_mfma_f32_16x16x16bf16_1k((a), (b), (c), 0, 0, 0)
DI s16x4 pk4(f32x4 v) { u32x2 u; u[0] = pk2(v[0], v[1]); u[1] = pk2(v[2], v[3]); return __builtin_bit_cast(s16x4, u); }
DI float dpp_shr1(float x, float old) { return __uint_as_float(__builtin_amdgcn_update_dpp(__float_as_uint(old), __float_as_uint(x), 0x111, 0xf, 0xf, false)); }
DI float dpp_shr2(float x, float old) { return __uint_as_float(__builtin_amdgcn_update_dpp(__float_as_uint(old), __float_as_uint(x), 0x112, 0xf, 0xf, false)); }
DI float dpp_shr4(float x, float old) { return __uint_as_float(__builtin_amdgcn_update_dpp(__float_as_uint(old), __float_as_uint(x), 0x114, 0xf, 0xf, false)); }
DI float dpp_shr8(float x, float old) { return __uint_as_float(__builtin_amdgcn_update_dpp(__float_as_uint(old), __float_as_uint(x), 0x118, 0xf, 0xf, false)); }
DI float dpp_bcast15(float x) { return __uint_as_float(__builtin_amdgcn_update_dpp(0, __float_as_uint(x), 0x15F, 0xf, 0xf, false)); }
DI void phase_scan_chunked(int l, int c, LAS unsigned char* lds, bool dummy = false) {
    const int tid = TID(), lane = tid & 63, wave = tid >> 6, r16 = lane & 15, g = lane >> 4;
    if (wave >= 2) return;
    const int item = BID() * 2 + wave;
    if (item >= NB * NH * 4) return;
    const int bh = item >> 2, ig = item & 3, b = bh >> 3, h = bh & 7, i0 = 16 * ig;
    LAS unsigned char* wl = lds + wave * 4096;
    const bf16_t* kkb = wsp<bf16_t>(WS_KKB); const bf16_t* bbb = wsp<bf16_t>(WS_BBB); const bf16_t* kfb = wsp<bf16_t>(WS_KF); const bf16_t* rrb = wsp<bf16_t>(WS_RR);
    const bf16_t* vsb = wsp<bf16_t>(l == 0 ? WS_VV : WS_V2); const float* dec = wsp<float>(WS_DEC); float* outb = wsp<float>(WS_OUT);
    float* stp = wsp<float>(WS_STATE) + ((size_t)bh * 64 + i0 + r16) * 64 + 8 * g;
    f32x4 ST[4];
#pragma unroll
    for (int sg = 0; sg < 4; ++sg) ST[sg] = (c > 0) ? *(const f32x4*)(stp + 32 * (sg >> 1) + 4 * (sg & 1)) : (f32x4){0.f, 0.f, 0.f, 0.f};
    const size_t e0 = ((size_t)b * SC + r16) * 512 + h * 64 + 8 * g;
    const size_t ev = ((size_t)b * SC + 4 * g) * 512 + h * 64 + i0 + r16;
    const size_t eo = ((size_t)b * SC + 4 * g) * 512 + h * 64 + i0 + r16;
    u32x4 rk[2], rb[2], rq[2], rr_[2]; f32x4 rw[4]; bf16_t rv[4];
#define CS_LOAD(blk) do { const size_t o = e0 + (size_t)(blk) * 16 * 512; _Pragma("unroll") for (int s = 0; s < 2; ++s) { \
        rk[s] = *(const u32x4*)(kkb + o + 32 * s); rb[s] = *(const u32x4*)(bbb + o + 32 * s); rq[s] = *(const u32x4*)(kfb + o + 32 * s); rr_[s] = *(const u32x4*)(rrb + o + 32 * s); \
        rw[2 * s] = *(const f32x4*)(dec + o + 32 * s); rw[2 * s + 1] = *(const f32x4*)(dec + o + 32 * s + 4); } \
        _Pragma("unroll") for (int e = 0; e < 4; ++e) rv[e] = vsb[ev + (size_t)(blk) * 16 * 512 + (size_t)e * 512]; } while (0)
    CS_LOAD(0);
    for (int blk = 0; blk < SC / 16; ++blk) {
        float P[16], kap[16], bet[16], kq[16], rt[16];
#pragma unroll
        for (int s = 0; s < 2; ++s)
#pragma unroll
            for (int q = 0; q < 4; ++q) { const int i = 8 * s + 2 * q;
                kap[i] = bflo(rk[s][q]); kap[i + 1] = bfhi(rk[s][q]); bet[i] = bflo(rb[s][q]); bet[i + 1] = bfhi(rb[s][q]);
                kq[i] = bflo(rq[s][q]); kq[i + 1] = bfhi(rq[s][q]); rt[i] = bflo(rr_[s][q]); rt[i + 1] = bfhi(rr_[s][q]);
                P[i] = rw[2 * s + (q >> 1)][2 * (q & 1)]; P[i + 1] = rw[2 * s + (q >> 1)][2 * (q & 1) + 1]; }
        s16x4 Vb; { u32x2 u; u[0] = (unsigned)rv[0] | ((unsigned)rv[1] << 16); u[1] = (unsigned)rv[2] | ((unsigned)rv[3] << 16); Vb = __builtin_bit_cast(s16x4, u); }
        if (blk + 1 < SC / 16) CS_LOAD(blk + 1);
        float P16[16];
        bf16x8 ktp[2], btp[2], kqp[2], rtp[2];
#pragma unroll
        for (int i = 0; i < 16; ++i) { float p = P[i];
            p *= dpp_shr1(p, 1.f); p *= dpp_shr2(p, 1.f); p *= dpp_shr4(p, 1.f); p *= dpp_shr8(p, 1.f);
            const float pm1 = dpp_shr1(p, 1.f); const float inv = frcp(p); const float p16 = dpp_bcast15(p);
            P16[i] = p16; kap[i] *= pm1; bet[i] *= inv; kq[i] *= inv; rt[i] *= p; }
#pragma unroll
        for (int s = 0; s < 2; ++s) { u32x4 a, bb_, cc, dd;
#pragma unroll
            for (int q = 0; q < 4; ++q) { const int i = 8 * s + 2 * q; a[q] = pk2(kap[i], kap[i + 1]); bb_[q] = pk2(bet[i], bet[i + 1]); cc[q] = pk2(kq[i], kq[i + 1]); dd[q] = pk2(rt[i], rt[i + 1]); }
            ktp[s] = __builtin_bit_cast(bf16x8, a); btp[s] = __builtin_bit_cast(bf16x8, bb_); kqp[s] = __builtin_bit_cast(bf16x8, cc); rtp[s] = __builtin_bit_cast(bf16x8, dd); }
#pragma unroll
        for (int s = 0; s < 2; ++s)
#pragma unroll
            for (int hb = 0; hb < 2; ++hb) { const int i = 8 * s + 4 * hb; u32x2 uk, ub;
                uk[0] = pk2(kq[i] * P16[i], kq[i + 1] * P16[i + 1]); uk[1] = pk2(kq[i + 2] * P16[i + 2], kq[i + 3] * P16[i + 3]);
                ub[0] = pk2(bet[i] * P16[i], bet[i + 1] * P16[i + 1]); ub[1] = pk2(bet[i + 2] * P16[i + 2], bet[i + 3] * P16[i + 3]);
                const int off = r16 * 128 + (32 * s + 16 * hb + 4 * g) * 2;
                *(LAS u32x2*)(wl + off) = uk; *(LAS u32x2*)(wl + 2048 + off) = ub; }
        const f32x4 Z = {0.f, 0.f, 0.f, 0.f};
        f32x4 A1a = M16K32(btp[1], ktp[1], M16K32(btp[0], ktp[0], Z));
        f32x4 A1c = M16K32(ktp[1], btp[1], M16K32(ktp[0], btp[0], Z));
        f32x4 A2a = M16K32(kqp[1], ktp[1], M16K32(kqp[0], ktp[0], Z));
        f32x4 B1a = M16K32(btp[1], rtp[1], M16K32(btp[0], rtp[0], Z));
        f32x4 B2a = M16K32(kqp[1], rtp[1], M16K32(kqp[0], rtp[0], Z));
#pragma unroll
        for (int e = 0; e < 4; ++e) { const int s_ = 4 * g + e;
            A1a[e] = (s_ < r16) ? A1a[e] : 0.f; A2a[e] = (s_ < r16) ? A2a[e] : 0.f; A1c[e] = (r16 < s_) ? A1c[e] : 0.f;
            B1a[e] = (s_ <= r16) ? B1a[e] : 0.f; B2a[e] = (s_ <= r16) ? B2a[e] : 0.f; }
        const s16x4 a1a = pk4(A1a), a1c = pk4(A1c);
        const f32x4 M2a = M16K16(a1c, a1a, Z), M2c = M16K16(a1a, a1c, Z);
        const s16x4 m2a = pk4(M2a), m2c = pk4(M2c);
        const f32x4 M4a = M16K16(m2c, m2a, Z), M4c = M16K16(m2a, m2c, Z);
        const s16x4 m4a = pk4(M4a), m4c = pk4(M4c);
        const s16x4 m8a = pk4(M16K16(m4c, m4a, Z));
        s16x4 stb[4];
#pragma unroll
        for (int sg = 0; sg < 4; ++sg) stb[sg] = pk4(ST[sg]);
        f32x4 G = Z, G2 = Z;
#pragma unroll
        for (int sg = 0; sg < 4; ++sg) {
            const s16x4 kf_ = (sg & 1) ? __builtin_shufflevector(ktp[sg >> 1], ktp[sg >> 1], 4, 5, 6, 7) : __builtin_shufflevector(ktp[sg >> 1], ktp[sg >> 1], 0, 1, 2, 3);
            const s16x4 rf_ = (sg & 1) ? __builtin_shufflevector(rtp[sg >> 1], rtp[sg >> 1], 4, 5, 6, 7) : __builtin_shufflevector(rtp[sg >> 1], rtp[sg >> 1], 0, 1, 2, 3);
            G = M16K16(kf_, stb[sg], G); G2 = M16K16(rf_, stb[sg], G2); }
        const f32x4 RHS = M16K16(pk4(A2a), Vb, G);
        const f32x4 X1 = M16K16(m8a, pk4(RHS), RHS);
        const f32x4 X2 = M16K16(m4a, pk4(X1), X1);
        const f32x4 X3 = M16K16(m2a, pk4(X2), X2);
        const f32x4 U = M16K16(pk4(-A1a), pk4(X3), X3);
        const s16x4 un = pk4(-U);
        f32x4 O = M16K16(pk4(B2a), Vb, G2);
        O = M16K16(pk4(B1a), un, O);
        { float* op = outb + eo + (size_t)blk * 16 * 512;
#pragma unroll
          for (int e = 0; e < 4; ++e) op[(size_t)e * 512] = O[e]; }
#pragma unroll
        for (int sg = 0; sg < 4; ++sg) {
#pragma unroll
            for (int e = 0; e < 4; ++e) ST[sg][e] *= P16[8 * (sg >> 1) + 4 * (sg & 1) + e];
            const int toff = (4 * g + (r16 >> 2)) * 128 + 32 * sg + 8 * (r16 & 3);
            const s16x4 kh = __builtin_amdgcn_ds_read_tr16_b64_v4i16((LAS s16x4*)(wl + toff));
            const s16x4 bh_ = __builtin_amdgcn_ds_read_tr16_b64_v4i16((LAS s16x4*)(wl + 2048 + toff));
            ST[sg] = M16K16(kh, Vb, ST[sg]);
            ST[sg] = M16K16(bh_, un, ST[sg]);
        }
    }
#undef CS_LOAD
    if (dummy) return;
#pragma unroll
    for (int sg = 0; sg < 4; ++sg) *(f32x4*)(stp + 32 * (sg >> 1) + 4 * (sg & 1)) = ST[sg];
}
DI float sum8(float v) {
    v += __uint_as_float(__builtin_amdgcn_update_dpp(0, __float_as_uint(v), 0xB1, 0xf, 0xf, false));
    v += __uint_as_float(__builtin_amdgcn_update_dpp(0, __float_as_uint(v), 0x4E, 0xf, 0xf, false));
    v += __uint_as_float(__builtin_amdgcn_update_dpp(0, __float_as_uint(v), 0x141, 0xf, 0xf, false));
    return v;
}
DI void unpk8(const u32x4 u, float* f) {
#pragma unroll
    for (int q = 0; q < 4; ++q) { f[2 * q] = bflo(u[q]); f[2 * q + 1] = bfhi(u[q]); }
}
DI void phase_rwkv_post(int l, int par) {
    const int lane = TID() & 63, gw = BID() * 8 + (TID() >> 6), nw = gridDim.x * 8;
    const float* outb = wsp<float>(WS_OUT); const bf16_t* rrb = wsp<bf16_t>(WS_RR); const bf16_t* kfb = wsp<bf16_t>(WS_KF);
    const bf16_t* vsb = wsp<bf16_t>(l == 0 ? WS_VV : WS_V2); const bf16_t* ggb = wsp<bf16_t>(WS_GG); bf16_t* orw = wsp<bf16_t>(WS_ORW + par * PAR_O);
    float lw[8], lb[8], rkc[8];
    { const float* lnw = KP()->in[I_LNW] + l * 512 + 8 * lane; const float* lnb = KP()->in[I_LNB] + l * 512 + 8 * lane; const float* rk = KP()->in[I_RK] + l * 512 + 8 * lane;
#pragma unroll
      for (int e = 0; e < 8; ++e) { lw[e] = lnw[e]; lb[e] = lnb[e]; rkc[e] = rk[e]; } }
    for (int row = gw; row < TC; row += nw) {
        const size_t e0 = (size_t)row * 512 + 8 * lane;
        const f32x4 o0 = *(const f32x4*)(outb + e0), o1 = *(const f32x4*)(outb + e0 + 4);
        float o[8] = {o0[0], o0[1], o0[2], o0[3], o1[0], o1[1], o1[2], o1[3]}, r[8], k[8], v[8], g[8];
        unpk8(*(const u32x4*)(rrb + e0), r); unpk8(*(const u32x4*)(kfb + e0), k); unpk8(*(const u32x4*)(vsb + e0), v); unpk8(*(const u32x4*)(ggb + e0), g);
        float s = 0.f, bo = 0.f;
#pragma unroll
        for (int e = 0; e < 8; ++e) { s += o[e]; bo += r[e] * k[e] * rkc[e]; }
        const float mean = sum8(s) * (1.f / 64.f); const float bonus = sum8(bo);
        float q = 0.f;
#pragma unroll
        for (int e = 0; e < 8; ++e) { o[e] -= mean; q += o[e] * o[e]; }
        const float rs = __builtin_amdgcn_rsqf(sum8(q) * (1.f / 64.f) + 64e-5f);
        u32x4 w;
#pragma unroll
        for (int p = 0; p < 4; ++p) { float y0 = (o[2 * p] * rs * lw[2 * p] + lb[2 * p] + bonus * v[2 * p]) * g[2 * p], y1 = (o[2 * p + 1] * rs * lw[2 * p + 1] + lb[2 * p + 1] + bonus * v[2 * p + 1]) * g[2 * p + 1]; w[p] = pk2(y0, y1); }
        *(u32x4*)(orw + e0) = w;
    }
}

#define MFMA32(a, b, c) __builtin_amdgcn_mfma_f32_32x32x16_bf16((a), (b), (c), 0, 0, 0)
DI unsigned fkey(float v) { v = v + 0.f; const unsigned u = __float_as_uint(v); return (u & 0x80000000u) ? ~u : (u | 0x80000000u); }
DI int half_sum(int x) {
    x += __builtin_amdgcn_update_dpp(0, x, 0x128, 0xf, 0xf, false);
    x += __builtin_amdgcn_update_dpp(0, x, 0x124, 0xf, 0xf, false);
    x += __builtin_amdgcn_update_dpp(0, x, 0x122, 0xf, 0xf, false);
    x += __builtin_amdgcn_update_dpp(0, x, 0x121, 0xf, 0xf, false);
    auto r = __builtin_amdgcn_permlane16_swap((unsigned)x, (unsigned)x, false, false);
    return (int)(r[0] + r[1]);
}
DI void dsa_select_half(int c, int item4, int set, int lane) {
    int lz = lane; asm volatile("" : "+v"(lz));
    const int hh = lz >> 5, r5 = lz & 31;
    const int rc0 = item4 * 4, b = rc0 >> 9, t0 = c * SC + (rc0 & 511);
    const int qq = ((r5 >> 2) & 1) + 2 * ((r5 >> 4) ^ set), hd = (r5 & 3) + 4 * ((r5 >> 3) & 1);
    const bf16_t* qp = wsp<bf16_t>(WS_IDXQ) + (size_t)(rc0 + qq) * 256 + hd * 32 + 8 * hh;
    const bf16x8 Af0 = *(const bf16x8*)qp, Af1 = *(const bf16x8*)(qp + 16);
    const int tA = t0 + hh + 2 * set;
    const float* wp = wsp<float>(WS_IDXW) + ((size_t)b * SEQ + tA) * 8;
    const f32x4 wa0 = *(const f32x4*)wp, wa1 = *(const f32x4*)(wp + 4);
    const int ngrp = ((t0 + 2 * set + 1) >> 9) + 1;
    unsigned keyA[64];
    const bf16_t* kbase = wsp<bf16_t>(WS_IDXK) + ((size_t)b * SEQ + r5) * 32 + 8 * hh;
    int keyv = r5; unsigned kofs = 0u;
    bf16x8 Bn0 = *(const bf16x8*)kbase, Bn1 = *(const bf16x8*)(kbase + 16);
#pragma unroll
    for (int g = 0; g < 4; ++g) {
        if (g < ngrp) {
#pragma unroll
            for (int j = 0; j < 16; ++j) {
                const int kt = g * 16 + j;
                const bf16x8 Bf0 = Bn0, Bf1 = Bn1;
                { const unsigned nofs = (kt < 63) ? kofs + 32 * 32 : kofs; const bf16_t* kp = kbase + nofs; Bn0 = *(const bf16x8*)kp; Bn1 = *(const bf16x8*)(kp + 16); }
                f32x16 C = {0.f, 0.f, 0.f, 0.f, 0.f, 0.f, 0.f, 0.f, 0.f, 0.f, 0.f, 0.f, 0.f, 0.f, 0.f, 0.f};
                C = MFMA32(Af0, Bf0, C); C = MFMA32(Af1, Bf1, C);
                float va = 0.f;
#pragma unroll
                for (int i = 0; i < 4; ++i) va += fmaxf(C[i], 0.f) * wa0[i];
#pragma unroll
                for (int i = 0; i < 4; ++i) va += fmaxf(C[4 + i], 0.f) * wa1[i];
                unsigned ka = (keyv <= tA) ? fkey(va) : 0u;
                asm volatile("" : "+v"(ka), "+v"(keyv), "+v"(kofs));
                keyA[kt] = ka;
                keyv += 32; kofs += 32 * 32;
            }
        } else {
#pragma unroll
            for (int j = 0; j < 16; ++j) keyA[g * 16 + j] = 0u;
        }
    }
    unsigned KA = 0u;
    if (t0 + 2 * set + 1 >= 256) {
        bool dA = tA < 255;
        for (int bit = 31; bit >= 0; --bit) {
            const unsigned cA = KA | (1u << bit);
            int nA = 0;
#pragma unroll
            for (int g = 0; g < 4; ++g) {
                if (g < ngrp) {
#pragma unroll
                    for (int j = 0; j < 16; ++j) nA += (keyA[g * 16 + j] >= cA) ? 1 : 0;
                }
            }
            nA = half_sum(nA);
            if (!dA && nA >= 256) KA = cA;
            dA = dA || (nA == 256);
            if (__ballot(dA) == ~0ull) break;
        }
    }
    int gA = 0;
#pragma unroll
    for (int kt = 0; kt < 64; ++kt) gA += (keyA[kt] > KA) ? 1 : 0;
    gA = half_sum(gA);
    const int needA = (KA == 0u) ? 0 : 256 - gA;
    asm volatile("" : "+v"(KA));
    int runA = 0, lsel = lz;
    unsigned w0 = 0u, w1 = 0u;
#pragma unroll
    for (int kt = 0; kt < 64; ++kt) {
        const bool eqA = keyA[kt] == KA;
        const unsigned long long ea = __ballot(eqA);
        const int rkA = runA + (hh ? (int)__builtin_amdgcn_mbcnt_hi((unsigned)(ea >> 32), 0u) : (int)__builtin_amdgcn_mbcnt_lo((unsigned)ea, 0u));
        const bool sA = (keyA[kt] > KA) || (eqA && rkA < needA);
        runA += hh ? __builtin_popcount((unsigned)(ea >> 32)) : __builtin_popcount((unsigned)ea);
        const unsigned long long sa = __ballot(sA);
        if (lsel == 0) { w0 = (unsigned)sa; w1 = (unsigned)(sa >> 32); }
        lsel -= 1; asm volatile("" : "+v"(lsel));
        __builtin_amdgcn_sched_barrier(0);
    }
    unsigned* sp = wsp<unsigned>(WS_SELB) + (size_t)(rc0 + 2 * set) * 64 + lz;
    sp[0] = w0; sp[64] = w1;
}
DI void dsa_select_full(int c, int item, int lane) {
    {
        int lz = lane; asm volatile("" : "+v"(lz));
        const int hh = lz >> 5, r5 = lz & 31;
        const int rc0 = item * 4, b = rc0 >> 9, t0 = c * SC + (rc0 & 511);
        const int qq = ((r5 >> 2) & 1) + 2 * (r5 >> 4), hd = (r5 & 3) + 4 * ((r5 >> 3) & 1);
        const bf16_t* qp = wsp<bf16_t>(WS_IDXQ) + (size_t)(rc0 + qq) * 256 + hd * 32 + 8 * hh;
        const bf16x8 Af0 = *(const bf16x8*)qp, Af1 = *(const bf16x8*)(qp + 16);
        const float* wp = wsp<float>(WS_IDXW) + ((size_t)b * SEQ + t0 + hh) * 8;
        const f32x4 wa0 = *(const f32x4*)wp, wa1 = *(const f32x4*)(wp + 4), wb0 = *(const f32x4*)(wp + 16), wb1 = *(const f32x4*)(wp + 20);
        const int tA = t0 + hh, tB = t0 + hh + 2;
        const int ngrp = ((t0 + 3) >> 9) + 1;
        unsigned keyA[64], keyB[64];
        const bf16_t* kbase = wsp<bf16_t>(WS_IDXK) + ((size_t)b * SEQ + r5) * 32 + 8 * hh;
        int keyv = r5;
        unsigned kofs = 0u;
        bf16x8 Bn0 = *(const bf16x8*)kbase, Bn1 = *(const bf16x8*)(kbase + 16);
#pragma unroll
        for (int g = 0; g < 4; ++g) {
            if (g < ngrp) {
#pragma unroll
                for (int j = 0; j < 16; ++j) {
                    const int kt = g * 16 + j;
                    const bf16x8 Bf0 = Bn0, Bf1 = Bn1;
                    { const unsigned nofs = (kt < 63) ? kofs + 32 * 32 : kofs; const bf16_t* kp = kbase + nofs; Bn0 = *(const bf16x8*)kp; Bn1 = *(const bf16x8*)(kp + 16); }
                    f32x16 C = {0.f, 0.f, 0.f, 0.f, 0.f, 0.f, 0.f, 0.f, 0.f, 0.f, 0.f, 0.f, 0.f, 0.f, 0.f, 0.f};
                    C = MFMA32(Af0, Bf0, C); C = MFMA32(Af1, Bf1, C);
                    float va = 0.f, vb = 0.f;
#pragma unroll
                    for (int i = 0; i < 4; ++i) { va += fmaxf(C[i], 0.f) * wa0[i]; vb += fmaxf(C[8 + i], 0.f) * wb0[i]; }
#pragma unroll
                    for (int i = 0; i < 4; ++i) { va += fmaxf(C[4 + i], 0.f) * wa1[i]; vb += fmaxf(C[12 + i], 0.f) * wb1[i]; }
                    unsigned ka = (keyv <= tA) ? fkey(va) : 0u, kb = (keyv <= tB) ? fkey(vb) : 0u;
                    asm volatile("" : "+v"(ka), "+v"(kb), "+v"(keyv), "+v"(kofs));
                    keyA[kt] = ka; keyB[kt] = kb;
                    keyv += 32; kofs += 32 * 32;
                }
            } else {
#pragma unroll
                for (int j = 0; j < 16; ++j) { keyA[g * 16 + j] = 0u; keyB[g * 16 + j] = 0u; }
            }
        }
        unsigned KA = 0u, KB = 0u;
        if (t0 + 3 >= 256) {
            bool dA = false, dB = false;
            for (int bit = 31; bit >= 0; --bit) {
                const unsigned bm = 1u << bit;
                const unsigned cA = KA | bm, cB = KB | bm;
                int nA = 0, nB = 0;
#pragma unroll
                for (int g = 0; g < 4; ++g) {
                    if (g < ngrp) {
#pragma unroll
                        for (int j = 0; j < 16; ++j) { nA += (keyA[g * 16 + j] >= cA) ? 1 : 0; nB += (keyB[g * 16 + j] >= cB) ? 1 : 0; }
                    }
                }
                nA = half_sum(nA); nB = half_sum(nB);
                if (!dA && nA >= 256) KA = cA;
                if (!dB && nB >= 256) KB = cB;
                dA = dA || (nA == 256); dB = dB || (nB == 256);
                if (__ballot(dA && dB) == ~0ull) break;
            }
        }
        int gA = 0, gB = 0;
#pragma unroll
        for (int kt = 0; kt < 64; ++kt) { gA += (keyA[kt] > KA) ? 1 : 0; gB += (keyB[kt] > KB) ? 1 : 0; }
        gA = half_sum(gA); gB = half_sum(gB);
        const int needA = (KA == 0u) ? 0 : 256 - gA, needB = (KB == 0u) ? 0 : 256 - gB;
        asm volatile("" : "+v"(KA), "+v"(KB));
        int runA = 0, runB = 0, lsel = lz;
        unsigned w0 = 0u, w1 = 0u, w2 = 0u, w3 = 0u;
#pragma unroll
        for (int kt = 0; kt < 64; ++kt) {
            const bool eqA = keyA[kt] == KA, eqB = keyB[kt] == KB;
            const unsigned long long ea = __ballot(eqA), eb = __ballot(eqB);
            const int rkA = runA + (hh ? (int)__builtin_amdgcn_mbcnt_hi((unsigned)(ea >> 32), 0u) : (int)__builtin_amdgcn_mbcnt_lo((unsigned)ea, 0u));
            const int rkB = runB + (hh ? (int)__builtin_amdgcn_mbcnt_hi((unsigned)(eb >> 32), 0u) : (int)__builtin_amdgcn_mbcnt_lo((unsigned)eb, 0u));
            const bool sA = (keyA[kt] > KA) || (eqA && rkA < needA), sB = (keyB[kt] > KB) || (eqB && rkB < needB);
            runA += hh ? __builtin_popcount((unsigned)(ea >> 32)) : __builtin_popcount((unsigned)ea);
            runB += hh ? __builtin_popcount((unsigned)(eb >> 32)) : __builtin_popcount((unsigned)eb);
            const unsigned long long sa = __ballot(sA), sb = __ballot(sB);
            if (lsel == 0) { w0 = (unsigned)sa; w1 = (unsigned)(sa >> 32); w2 = (unsigned)sb; w3 = (unsigned)(sb >> 32); }
            lsel -= 1; asm volatile("" : "+v"(lsel));
            __builtin_amdgcn_sched_barrier(0);
        }
        unsigned* sp = wsp<unsigned>(WS_SELB) + (size_t)rc0 * 64 + lz;
        sp[0] = w0; sp[64] = w1; sp[128] = w2; sp[192] = w3;
    }
}

DI void phase_dsa_select_queue(int c, LAS unsigned* ctr) {
    const int lane = TID() & 63;
    const int base = BID() * 8;
    for (;;) {
        unsigned idx = 0u;
        if (lane == 0) idx = __hip_atomic_fetch_add(ctr, 1u, __ATOMIC_RELAXED, __HIP_MEMORY_SCOPE_WORKGROUP);
        idx = (unsigned)__builtin_amdgcn_readfirstlane((int)idx);
        if (idx >= 8u) break;
        const int item4 = base + (int)idx;
        if (item4 < TC / 4) dsa_select_full(c, item4, lane);
    }
}

struct AttnSt { f32x16 O0, O1; float m, l; };
constexpr float C2 = 0.125f * LOG2E;
DI void attn_load_kv(bf16x8 (&Kf)[4], bf16x8 (&Vf)[2][2], const bf16_t* kbase, const bf16_t* vtbase, int key0, int lane) {
    const int r5 = lane & 31;
    const int prow = (r5 & 19) | ((r5 & 4) << 1) | ((r5 & 8) >> 1);
    const bf16_t* kp = kbase + (size_t)(key0 + prow) * 512;
#pragma unroll
    for (int s = 0; s < 4; ++s) Kf[s] = *(const bf16x8*)(kp + 16 * s);
#pragma unroll
    for (int n = 0; n < 2; ++n)
#pragma unroll
        for (int s = 0; s < 2; ++s) Vf[n][s] = *(const bf16x8*)(vtbase + (size_t)(32 * n) * SEQ + key0 + 16 * s);
}
template <int MODE, bool FAR>
DI void attn_tile(AttnSt& st, const bf16x8 (&Qf)[4], const bf16x8 (&Kf)[4], const bf16x8 (&Vf)[2][2], int key0, int tq, bool allowed, unsigned word, LAS const float* bt, float ub, int lane) {
    const int hh = lane >> 5;
    f32x16 S = {0.f, 0.f, 0.f, 0.f, 0.f, 0.f, 0.f, 0.f, 0.f, 0.f, 0.f, 0.f, 0.f, 0.f, 0.f, 0.f};
#pragma unroll
    for (int s = 0; s < 4; ++s) S = MFMA32(Kf[s], Qf[s], S);
    const unsigned wsh = word >> (8 * hh);
    float ps = 0.f; float pv[16];
    if (FAR) {
        const float cb = (MODE == 0 && !allowed) ? -INFINITY : (bt[127] - ub);
#pragma unroll
        for (int i = 0; i < 16; ++i) {
            float p = fexp2(S[i] * C2 + cb);
            if (MODE == 1) p = __uint_as_float(__float_as_uint(p) & (unsigned)__builtin_amdgcn_sbfe((int)wsh, 16 * (i >> 3) + (i & 7), 1));
            pv[i] = p; ps += p;
        }
    } else {
#pragma unroll
        for (int i = 0; i < 16; ++i) {
            const int koff = 16 * (i >> 3) + 8 * hh + (i & 7);
            const int dist = tq - (key0 + koff);
            const bool ok = (MODE == 0) ? (allowed && dist >= 0) : (((wsh >> (16 * (i >> 3) + (i & 7))) & 1u) != 0u);
            const float p = fexp2(S[i] * C2 + (bt[min(max(dist, 0), 127)] - ub));
            pv[i] = ok ? p : 0.f; ps += pv[i];
        }
    }
    st.l += ps;
#pragma unroll
    for (int s = 0; s < 2; ++s) {
        u32x4 pw; pw[0] = pk2(pv[8 * s], pv[8 * s + 1]); pw[1] = pk2(pv[8 * s + 2], pv[8 * s + 3]); pw[2] = pk2(pv[8 * s + 4], pv[8 * s + 5]); pw[3] = pk2(pv[8 * s + 6], pv[8 * s + 7]);
        const bf16x8 Pf = __builtin_bit_cast(bf16x8, pw);
        st.O0 = MFMA32(Vf[0][s], Pf, st.O0); st.O1 = MFMA32(Vf[1][s], Pf, st.O1);
    }
}
constexpr int AT_ROW = 144, AT_KV = 64 * AT_ROW, AT_STAGE = 2 * AT_KV;
template <int MODE>
DI void attn_pair_far(AttnSt& st, const bf16x8 (&Qf)[4], LAS const unsigned char* ks, LAS const unsigned char* vs, int kofs, int vofs, bool allowed, unsigned w0, unsigned w1, float cb, int lane) {
    const int hh = lane >> 5;
    bf16x8 K0[4], K1[4], V0[2][2], V1[2][2];
#pragma unroll
    for (int s = 0; s < 4; ++s) { K0[s] = *(LAS const bf16x8*)(ks + kofs + 32 * s); K1[s] = *(LAS const bf16x8*)(ks + 32 * AT_ROW + kofs + 32 * s); }
#pragma unroll
    for (int n = 0; n < 2; ++n)
#pragma unroll
        for (int s = 0; s < 2; ++s) { V0[n][s] = *(LAS const bf16x8*)(vs + 32 * n * AT_ROW + vofs + 32 * s); V1[n][s] = *(LAS const bf16x8*)(vs + 32 * n * AT_ROW + vofs + 64 + 32 * s); }
    f32x16 S0 = {0.f, 0.f, 0.f, 0.f, 0.f, 0.f, 0.f, 0.f, 0.f, 0.f, 0.f, 0.f, 0.f, 0.f, 0.f, 0.f}, S1 = S0;
#pragma unroll
    for (int s = 0; s < 4; ++s) { S0 = MFMA32(K0[s], Qf[s], S0); S1 = MFMA32(K1[s], Qf[s], S1); }
    const float cbe = (MODE == 0 && !allowed) ? -INFINITY : cb;
    const unsigned wa = w0 >> (8 * hh), wb = w1 >> (8 * hh);
    float ps = 0.f; float p0[16], p1[16];
#pragma unroll
    for (int i = 0; i < 16; ++i) {
        float a = fexp2(S0[i] * C2 + cbe), b = fexp2(S1[i] * C2 + cbe);
        if (MODE == 1) { a = __uint_as_float(__float_as_uint(a) & (unsigned)__builtin_amdgcn_sbfe((int)wa, 16 * (i >> 3) + (i & 7), 1));
                         b = __uint_as_float(__float_as_uint(b) & (unsigned)__builtin_amdgcn_sbfe((int)wb, 16 * (i >> 3) + (i & 7), 1)); }
        p0[i] = a; p1[i] = b; ps += a + b;
    }
    st.l += ps;
#pragma unroll
    for (int s = 0; s < 2; ++s) {
        u32x4 pw; pw[0] = pk2(p0[8 * s], p0[8 * s + 1]); pw[1] = pk2(p0[8 * s + 2], p0[8 * s + 3]); pw[2] = pk2(p0[8 * s + 4], p0[8 * s + 5]); pw[3] = pk2(p0[8 * s + 6], p0[8 * s + 7]);
        const bf16x8 Pf = __builtin_bit_cast(bf16x8, pw);
        st.O0 = MFMA32(V0[0][s], Pf, st.O0); st.O1 = MFMA32(V0[1][s], Pf, st.O1);
    }
#pragma unroll
    for (int s = 0; s < 2; ++s) {
        u32x4 pw; pw[0] = pk2(p1[8 * s], p1[8 * s + 1]); pw[1] = pk2(p1[8 * s + 2], p1[8 * s + 3]); pw[2] = pk2(p1[8 * s + 4], p1[8 * s + 5]); pw[3] = pk2(p1[8 * s + 6], p1[8 * s + 7]);
        const bf16x8 Pf = __builtin_bit_cast(bf16x8, pw);
        st.O0 = MFMA32(V1[0][s], Pf, st.O0); st.O1 = MFMA32(V1[1][s], Pf, st.O1);
    }
}
template <int MODE>
DI void attn_block(int c, int b, int h, int half, LAS unsigned char* stg, LAS unsigned* uni, LAS const float* bt, float kbound, float bmax, bool dummy) {
    const int tid = TID(), lane = tid & 63, wave = tid >> 6, r5 = lane & 31, hh = lane >> 5;
    bf16_t* qbuf = wsp<bf16_t>((MODE == 0 ? WS_MQ : WS_DQ) + (c & 1) * PAR_O);
    const int tb = c * SC + 256 * half, t0 = tb + 32 * wave, tq = t0 + r5, rowc0 = b * SC + 256 * half + 32 * wave;
    bf16_t* qp = qbuf + (size_t)(rowc0 + r5) * 512 + h * 64;
    bf16x8 Qf[4];
#pragma unroll
    for (int s = 0; s < 4; ++s) Qf[s] = *(const bf16x8*)(qp + 16 * s + 8 * hh);
    AttnSt st; st.m = 0.f; st.l = 0.f;
#pragma unroll
    for (int i = 0; i < 16; ++i) { st.O0[i] = 0.f; st.O1[i] = 0.f; }
    float ub;
    { float q2 = 0.f;
#pragma unroll
      for (int s = 0; s < 4; ++s)
#pragma unroll
          for (int j = 0; j < 8; ++j) { const float v = bf2f((bf16_t)Qf[s][j]); q2 += v * v; }
      q2 += __shfl_xor(q2, 32);
      ub = sqrtf(q2) * kbound * C2 + bmax; }
    const int ktl = (t0 + 31) >> 5;
    const int own = tb >> 8;
    unsigned bm = 0u, anyw = 0xffu;
    if (MODE == 0) {
        if (own > 0) {
            const float* km = wsp<float>(WS_KMEAN) + ((size_t)(b * 8 + h) * 8) * 64 + 8 * hh;
            float g[8];
#pragma unroll
            for (int n = 0; n < 8; ++n) {
                g[n] = -INFINITY;
                if (n < own) {
                    float part = 0.f;
#pragma unroll
                    for (int s = 0; s < 4; ++s) { const f32x4 k0 = *(const f32x4*)(km + n * 64 + 16 * s), k1 = *(const f32x4*)(km + n * 64 + 16 * s + 4);
#pragma unroll
                        for (int j = 0; j < 4; ++j) part += bf2f((bf16_t)Qf[s][j]) * k0[j] + bf2f((bf16_t)Qf[s][4 + j]) * k1[j]; }
                    g[n] = part + __shfl_xor(part, 32);
                }
            }
#pragma unroll
            for (int n = 0; n < 8; ++n) {
                if (n < own) { int rank = 0;
#pragma unroll
                    for (int m2 = 0; m2 < 8; ++m2) if (m2 != n && m2 < own) rank += ((g[m2] > g[n]) || (g[m2] == g[n] && m2 < n)) ? 1 : 0;
                    if (rank < 3) bm |= 1u << n; }
            }
        }
        anyw = 1u << own;
#pragma unroll
        for (int n = 0; n < 8; ++n) if (n < own && __ballot((bm >> n) & 1u) != 0ull) anyw |= 1u << n;
    }
    if (tid == 0) uni[0] = 0u;
    __syncthreads();
    if (lane == 0) __hip_atomic_fetch_or(uni, anyw, __ATOMIC_RELAXED, __HIP_MEMORY_SCOPE_WORKGROUP);
    __syncthreads();
    const unsigned anyb = MODE == 0 ? uni[0] : 0xffu;
    const int lrow = tid >> 3, lpart = tid & 7;
    const bf16_t* kg = wsp<bf16_t>(MODE == 0 ? WS_MK : WS_DK) + ((size_t)b * SEQ + lrow) * 512 + h * 64 + lpart * 8;
    const bf16_t* vg = wsp<bf16_t>(MODE == 0 ? WS_MVT : WS_DVT) + ((size_t)b * 512 + h * 64 + lrow) * SEQ + lpart * 8;
    const int lofs = lrow * AT_ROW + lpart * 16;
    const int prow = (r5 & 19) | ((r5 & 4) << 1) | ((r5 & 8) >> 1);
    const int kofs = prow * AT_ROW + 16 * hh, vofs = r5 * AT_ROW + 16 * hh;
    const unsigned* sp = wsp<unsigned>(WS_SELB) + (size_t)(rowc0 + r5) * 64;
    const int nst = (tb + 256) >> 6;
    int stp = 0;
    if (MODE == 0) { while (!((anyb >> (stp >> 2)) & 1u)) stp += 4; }
    u32x4 kreg = *(const u32x4*)(kg + (size_t)(stp * 64) * 512), vreg = *(const u32x4*)(vg + stp * 64);
    *(LAS u32x4*)(stg + lofs) = kreg; *(LAS u32x4*)(stg + AT_KV + lofs) = vreg;
    u32x2 wcur = {0u, 0u}, wnxt = {0u, 0u};
    if (MODE == 1) wcur = *(const u32x2*)(sp + 2 * stp);
    __syncthreads();
    int cur = 0;
    while (stp < nst) {
        int nx = stp + 1;
        if (MODE == 0) { while (nx < nst && !((anyb >> (nx >> 2)) & 1u)) nx += 4 - (nx & 3); }
        const bool more = nx < nst;
        if (more) { kreg = *(const u32x4*)(kg + (size_t)(nx * 64) * 512); vreg = *(const u32x4*)(vg + nx * 64); if (MODE == 1) wnxt = *(const u32x2*)(sp + 2 * nx); }
        LAS const unsigned char* ks = stg + cur * AT_STAGE; LAS const unsigned char* vs = ks + AT_KV;
        const int nbs = stp >> 2;
        const bool won = (MODE == 1) || (((anyw >> nbs) & 1u) != 0u);
        if (won && (2 * stp + 1 <= ktl) && (t0 - (stp * 64 + 63) >= 113)) {
            const bool allowed = (MODE == 0) ? ((nbs == own) || (((bm >> nbs) & 1u) != 0u)) : true;
            attn_pair_far<MODE>(st, Qf, ks, vs, kofs, vofs, allowed, wcur[0], wcur[1], bt[127] - ub, lane);
        } else {
#pragma unroll
        for (int u = 0; u < 2; ++u) {
            const int kt = 2 * stp + u, key0 = kt * 32, nb = kt >> 3;
            const bool waveon = (kt <= ktl) && (MODE == 1 || ((anyw >> nb) & 1u));
            if (waveon) {
                bf16x8 Kf[4], Vf[2][2];
#pragma unroll
                for (int s = 0; s < 4; ++s) Kf[s] = *(LAS const bf16x8*)(ks + 32 * u * AT_ROW + kofs + 32 * s);
#pragma unroll
                for (int n = 0; n < 2; ++n)
#pragma unroll
                    for (int s = 0; s < 2; ++s) Vf[n][s] = *(LAS const bf16x8*)(vs + 32 * n * AT_ROW + vofs + 64 * u + 32 * s);
                const unsigned word = (MODE == 1) ? wcur[u] : 0u;
                const bool allowed = (MODE == 0) ? ((nb == own) || (((bm >> nb) & 1u) != 0u)) : true;
                if (t0 - (key0 + 31) >= 113) attn_tile<MODE, true>(st, Qf, Kf, Vf, key0, tq, allowed, word, bt, ub, lane);
                else attn_tile<MODE, false>(st, Qf, Kf, Vf, key0, tq, allowed, word, bt, ub, lane);
            }
        }
        }
        if (more) { LAS unsigned char* ws_ = stg + (cur ^ 1) * AT_STAGE; *(LAS u32x4*)(ws_ + lofs) = kreg; *(LAS u32x4*)(ws_ + AT_KV + lofs) = vreg; }
        __syncthreads();
        cur ^= 1; stp = nx; wcur = wnxt;
    }
    const float lt = st.l + __shfl_xor(st.l, 32);
    const float inv = 1.f / lt;
    if (dummy) qp = wsp<bf16_t>(WS_RAW + (MODE ? 8 * MiB : 0)) + (size_t)(rowc0 + r5) * 512 + h * 64;
#pragma unroll
    for (int g4 = 0; g4 < 4; ++g4) {
        st_bf4(qp + 8 * g4 + 4 * hh, (f32x4){st.O0[4 * g4] * inv, st.O0[4 * g4 + 1] * inv, st.O0[4 * g4 + 2] * inv, st.O0[4 * g4 + 3] * inv});
        st_bf4(qp + 32 + 8 * g4 + 4 * hh, (f32x4){st.O1[4 * g4] * inv, st.O1[4 * g4 + 1] * inv, st.O1[4 * g4 + 2] * inv, st.O1[4 * g4 + 3] * inv});
    }
    __syncthreads();
}
__device__ const unsigned char kBucket[128] = {0,1,2,3,4,5,6,7,8,9,10,11,12,13,14,15,16,16,16,17,17,18,18,18,19,19,19,20,20,20,20,21,21,21,21,22,22,22,22,22,23,23,23,23,23,23,24,24,24,24,24,24,25,25,25,25,25,25,25,26,26,26,26,26,26,26,26,27,27,27,27,27,27,27,27,27,27,28,28,28,28,28,28,28,28,28,28,29,29,29,29,29,29,29,29,29,29,29,29,30,30,30,30,30,30,30,30,30,30,30,30,30,30,31,31,31,31,31,31,31,31,31,31,31,31,31,31,31};
DI void phase_attn(int l, int c, LAS float* lds, bool dummy = false) {
    const int tid = TID();
    for (int e = tid; e < 2 * 8 * 128; e += 512) { const int d = e & 127, h = (e >> 7) & 7, mx = e >> 10; lds[e] = KP()->in[I_REL][kBucket[d] * 16 + mx * 8 + h] * LOG2E; }
    if (tid < 2) { const float* g = KP()->in[I_QKN] + l * 256 + (tid == 0 ? 64 : 192); float m = 0.f; for (int i = 0; i < 64; ++i) m = fmaxf(m, fabsf(g[i])); lds[2048 + tid] = 8.1f * m; }
    if (tid >= 64 && tid < 80) { const int mx = (tid - 64) >> 3, h = (tid - 64) & 7; float m = 0.f; for (int k = 0; k < 32; ++k) m = fmaxf(m, fabsf(KP()->in[I_REL][k * 16 + mx * 8 + h])); lds[2064 + (tid - 64)] = m * LOG2E; }
    __syncthreads();
    LAS unsigned char* stg = (LAS unsigned char*)lds + 16384; LAS unsigned* uni = (LAS unsigned*)((LAS unsigned char*)lds + 8192 + 256);
    for (int it = BID(); it < NB * NH * 2; it += gridDim.x) {
        const int bh = it >> 1, b = bh >> 3, h = bh & 7, hf = it & 1;
        attn_block<0>(c, b, h, hf, stg, uni, lds + h * 128, lds[2048], lds[2064 + h], dummy);
        attn_block<1>(c, b, h, hf ^ 1, stg, uni, lds + 1024 + h * 128, lds[2049], lds[2072 + h], dummy);
    }
    if (!dummy) { phase_rwkv_post(l, c & 1); if (DBL_PHASE == 24) phase_rwkv_post(l, c & 1); }
}

constexpr int LDS_BYTES = pg8::STAGE_BYTES + 256;
constexpr int PH_PER_LAYER = 32, N_PHASES = 2 * PH_PER_LAYER;
#ifndef DBL_PHASE
#define DBL_PHASE 0
#endif
#ifndef MK_ONE_LAUNCH
#define MK_ONE_LAUNCH 1
#endif
__global__ void __launch_bounds__(512, 2) mega(Params p) {
    extern __shared__ __attribute__((aligned(16))) unsigned char lds_raw[];
    LAS unsigned char* lds = (LAS unsigned char*)lds_raw;
    volatile LAS unsigned* bst = (volatile LAS unsigned*)(lds + pg8::STAGE_BYTES);
    if (TID() < 4) bst[TID()] = 0u;
    __syncthreads();
    if (p.ph_hi - p.ph_lo > 1) (void)xcd_barrier_post((unsigned*)(KP()->ws + WS_CTL), bst);
#ifndef PH_ONLY
#define PH_ONLY -1
#endif
#define IN(k) (KP()->ph_lo <= (k) && (k) < KP()->ph_hi)
#define INT(tag, k) ((PH_ONLY < 0 || PH_ONLY == (tag)) && IN(k))
#define SEAM(k) do { if (IN(k) && IN((k) + 1)) { XcdBarrier bar_; bar_.bar = (unsigned*)(KP()->ws + WS_CTL); bar_.x = xb_xcc_id(); bar_.st = (volatile LAS unsigned*)(lds + pg8::STAGE_BYTES); xcd_barrier(bar_); if (DBL_PHASE == 20) xcd_barrier(bar_); } } while (0)
    for (int l = 0; l < 2; ++l) {
        const int pb = PH_PER_LAYER * l;
        if (INT(0, pb + 0)) {
#if DBL_PHASE == 6
            phase_conv(l, (LAS float*)lds);
#endif
            phase_conv(l, (LAS float*)lds); }
        SEAM(pb + 0);
        if (INT(1, pb + 1)) {
#if DBL_PHASE == 7
            phase_norm(l == 0 ? KP()->in[I_X] : (const float*)KP()->out, KP()->in[I_NMIX] + l * DM, wsp<bf16_t>(WS_H));
#endif
            phase_norm(l == 0 ? KP()->in[I_X] : (const float*)KP()->out, KP()->in[I_NMIX] + l * DM, wsp<bf16_t>(WS_H)); }
        SEAM(pb + 1);
        if (INT(2, pb + 2)) {
            { const SchedLin S = mk_sched(128, 4, WS_H, WS_WB, 1024); const EpiB E{l}; pg8::gemm_phase(lds, 1024, S, E); }
            { const SchedLin S = mk_sched(2, 128, WS_WV, WS_H, 1024); const EpiVt E{(unsigned)WS_MVT}; pg8::gemm_phase(lds, 1024, S, E); }
#if DBL_PHASE == 9
            { const SchedLin S = mk_sched(128, 4, WS_H, WS_WB, 1024); const EpiB E{l}; pg8::gemm_phase(lds, 1024, S, E); }
            { const SchedLin S = mk_sched(2, 128, WS_WV, WS_H, 1024); const EpiVt E{(unsigned)WS_MVT}; pg8::gemm_phase(lds, 1024, S, E); }
#endif
        }
        SEAM(pb + 2);
        if (INT(3, pb + 3)) { phase_dcn(l); phase_kmean();
#if DBL_PHASE == 14
            phase_kmean();
#endif
        }
        SEAM(pb + 3);
        if (INT(4, pb + 4)) {
            { const SchedLin S = mk_sched(128, 2, WS_DCN, WS_WKVK, 256); const EpiHN E{l}; pg8::gemm_phase(lds, 256, S, E); }
            { const SchedLin S = mk_sched(2, 128, WS_WKVV, WS_DCN, 256); const EpiVt E{(unsigned)WS_DVT}; pg8::gemm_phase(lds, 256, S, E); }
#if DBL_PHASE == 13
            { const SchedLin S = mk_sched(128, 2, WS_DCN, WS_WKVK, 256); const EpiHN E{l}; pg8::gemm_phase(lds, 256, S, E); }
            { const SchedLin S = mk_sched(2, 128, WS_WKVV, WS_DCN, 256); const EpiVt E{(unsigned)WS_DVT}; pg8::gemm_phase(lds, 256, S, E); }
#endif
        }
        SEAM(pb + 4);
        for (int c = 0; c < NCH; ++c) {
            const int pc = pb + 5 + 5 * c + 2 * (c >> 1), cbase = c * SC;
            if (INT(5, pc + 0)) { const SchedLin S = mk_sched(32, 24, WS_H, WS_WD1, 1024, 1, cbase); const EpiD1 E{l, c & 1}; pg8::gemm_phase(lds, 1024, S, E);
#if DBL_PHASE == 5
                pg8::gemm_phase(lds, 1024, S, E);
#endif
#if DBL_PHASE == 27
                { const EpiNull E0{}; pg8::gemm_phase(lds, 1024, S, E0); }
#endif
            }
            SEAM(pc + 0);
            if (INT(6, pc + 1)) {
#if DBL_PHASE == 4
                phase_rwkv_prep(l, c);
#endif

                phase_rwkv_prep(l, c); }
            SEAM(pc + 1);
            if (INT(7, pc + 2)) { const SchedLin S = mk_sched(32, l == 0 ? 6 : 8, WS_LORAA, WS_WL, 512, 0, 0, WS_VV, 6); const EpiLora E{l, cbase}; pg8::gemm_phase(lds, 512, S, E); }
            SEAM(pc + 2);
            if (INT(8, pc + 3)) {
#if DBL_PHASE == 2
                phase_scan_chunked(l, c, lds, true);
#endif
#if DBL_PHASE == 22
                phase_scan_chunked(l, c, lds, true);
#endif

#if DBL_PHASE == 11
                phase_scan(l, c, 2);
#endif
#if DBL_PHASE == 12
                phase_scan(l, c, 3);
#endif
#if DBL_PHASE == 25
                if (TID() == 0) *(LAS unsigned*)(lds + 8192) = 0u;
                __syncthreads();
                phase_scan_chunked(l, c, lds, true); phase_dsa_select_queue(c, (LAS unsigned*)(lds + 8192));
                __syncthreads();
#endif
#if DBL_PHASE == 26
                if (TID() == 0) *(LAS unsigned*)(lds + 8192) = 0u;
                __syncthreads();
                phase_dsa_select_queue(c, (LAS unsigned*)(lds + 8192));
                __syncthreads();
#endif
                if (TID() == 0) *(LAS unsigned*)(lds + 8192) = 0u;
                __syncthreads();
                phase_scan_chunked(l, c, lds);
                phase_dsa_select_queue(c, (LAS unsigned*)(lds + 8192)); }
            SEAM(pc + 3);
            if (INT(9, pc + 4)) {
#if DBL_PHASE == 1
                phase_attn(l, c, (LAS float*)lds, true); __syncthreads();
#endif
                phase_attn(l, c, (LAS float*)lds); }
            SEAM(pc + 4);
            if (c & 1) {
                if (INT(10, pc + 5)) { const SchedMerge S{(int)gridDim.x, (int)BID()}; const EpiMerge E{}; pg8::gemm_phase(lds, 512, S, E);
#if DBL_PHASE == 10
                    pg8::gemm_phase(lds, 512, S, E);
#endif
                }
                SEAM(pc + 5);
                if (INT(11, pc + 6)) { const SchedLin S = mk_sched(64, 4, WS_Y, WS_WO, 1024); const EpiRes E{l == 0 ? 1 : 0, 2, cbase - SC, 0u}; pg8::gemm_phase(lds, 1024, S, E); }
                SEAM(pc + 6);
            }
        }
        if (INT(33, pb + 29)) phase_norm(KP()->out, KP()->in[I_NFFN] + l * DM, wsp<bf16_t>(WS_H));
        SEAM(pb + 29);
        if (INT(34, pb + 30)) { const SchedLin S = mk_sched(128, 22, WS_H, WS_WF1, 1024); const EpiSwiglu E{}; pg8::gemm_phase(lds, 1024, S, E);
#if DBL_PHASE == 8
            pg8::gemm_phase(lds, 1024, S, E);
#endif
        }
        SEAM(pb + 30);
        if (INT(35, pb + 31)) { const SchedLin S = mk_sched(128, 4, WS_ACT, WS_WF2, DFF); const EpiRes E{0, 0, 0, 0u};
#if DBL_PHASE == 16
            { const EpiRes E2{0, 0, 0, (unsigned)(WS_ACT + 176 * MiB)}; pg8::gemm_phase(lds, DFF, S, E2); }
#endif
            pg8::gemm_phase(lds, DFF, S, E); }
        SEAM(pb + 31);
    }
#undef IN
#undef INT
#undef SEAM
}

extern "C" void kernel_launch(void* const* d_in, const int* in_sizes, int n_in, void* d_out, int out_size, void* d_ws, size_t ws_size, hipStream_t stream) {
    static int grid = 0;
    if (grid == 0) {
        if (n_in != 26 || ws_size < WS_END) { grid = -1; return; }
        int dev = 0, cus = 0;
        if (hipGetDevice(&dev) != hipSuccess || hipDeviceGetAttribute(&cus, hipDeviceAttributeMultiprocessorCount, dev) != hipSuccess) { grid = -1; return; }
        if (hipFuncSetAttribute((const void*)mega, hipFuncAttributeMaxDynamicSharedMemorySize, LDS_BYTES) != hipSuccess) { grid = -1; return; }
        grid = cus;
    }
    if (grid < 0) return;
    (void)hipMemsetAsync((char*)d_ws + WS_CTL, 0, 64 * 1024, stream);
    Params p{};
    for (int i = 0; i < 26; ++i) p.in[i] = (const float*)d_in[i];
    p.out = (float*)d_out; p.ws = (unsigned char*)d_ws;
#if MK_ONE_LAUNCH
    p.ph_lo = 0; p.ph_hi = N_PHASES;
    hipLaunchKernelGGL(mega, dim3(grid), dim3(512), LDS_BYTES, stream, p);
#else
    for (int ph = 0; ph < N_PHASES; ++ph) { p.ph_lo = ph; p.ph_hi = ph + 1; hipLaunchKernelGGL(mega, dim3(grid), dim3(512), LDS_BYTES, stream, p); }
#endif
}
```

```cpp
#include <hip/hip_runtime.h>
#include <stdint.h>
#ifndef DBL_PHASE
#define DBL_PHASE 0
#endif

#define DI __device__ __forceinline__
#define LAS __attribute__((address_space(3)))
typedef unsigned short bf16_t;
typedef short bf16x8 __attribute__((ext_vector_type(8)));
typedef float f32x2 __attribute__((ext_vector_type(2)));
typedef float f32x4 __attribute__((ext_vector_type(4)));
typedef float f32x16 __attribute__((ext_vector_type(16)));
typedef unsigned u32x2 __attribute__((ext_vector_type(2)));
typedef unsigned u32x4 __attribute__((ext_vector_type(4)));
typedef __bf16 bf2_t __attribute__((ext_vector_type(2)));

constexpr int NB = 16, SEQ = 2048, DM = 1024, NT = NB * SEQ, NH = 8, BW = 512;
constexpr int NCH = 4, SC = 512, TC = NB * SC;
constexpr int D_IN = 7496, DFF = 2816;
constexpr int C_MQ = 0, C_MK = 512, C_MV = 1024, C_RW = 1536, C_DS = 3360, C_GT = 4424;
constexpr int RAWLD = 1792;
constexpr float NORM_EPS = 1e-6f;
constexpr float LOG2E = 1.4426950408889634f;

constexpr size_t MiB = 1024 * 1024;
constexpr size_t WS_CTL = 0;
constexpr size_t WS_WB = 64 * 1024;
constexpr size_t WS_WV = WS_WB + 2 * MiB;
constexpr size_t WS_WD1 = WS_WV + 1 * MiB;
constexpr size_t WS_WKVK = WS_WD1 + 12 * MiB;
constexpr size_t WS_WKVV = WS_WKVK + MiB / 4;
constexpr size_t WS_WL = WS_WKVV + MiB / 4;
constexpr size_t WS_WBR = WS_WL + 2 * MiB;
constexpr size_t WS_WO = WS_WBR + 3 * MiB;
constexpr size_t WS_WF1 = WS_WO + 2 * MiB;
constexpr size_t WS_WF2 = WS_WF1 + 11 * MiB;
constexpr size_t WS_VFIRST = WS_WF2 + 6 * MiB;
constexpr size_t WS_STATE = WS_VFIRST + 32 * MiB;
constexpr size_t WS_H = WS_STATE + 2 * MiB;
constexpr size_t WS_IDXK = WS_H + 64 * MiB;
constexpr size_t WS_IDXW = WS_IDXK + 2 * MiB;
constexpr size_t WS_LEFT = WS_IDXW + 1 * MiB;
constexpr size_t WS_KMEAN = WS_LEFT + 2 * MiB;
constexpr size_t WS_CARRY = WS_KMEAN + MiB / 4;
constexpr size_t WS_MK = WS_CARRY + MiB / 4;
constexpr size_t WS_MVT = WS_MK + 32 * MiB;
constexpr size_t WS_DK = WS_MVT + 32 * MiB;
constexpr size_t WS_DVT = WS_DK + 32 * MiB;
constexpr size_t WS_MQ = WS_DVT + 32 * MiB;
constexpr size_t WS_DQ = WS_MQ + 16 * MiB;
constexpr size_t WS_ORW = WS_DQ + 16 * MiB;
constexpr size_t WS_GATES = WS_ORW + 16 * MiB;
constexpr size_t PAR_O = 8 * MiB, PAR_G = 24 * MiB;
constexpr size_t WS_IDXQ = WS_GATES + 48 * MiB;
constexpr size_t WS_RAW = WS_IDXQ + 4 * MiB;
constexpr size_t WS_LORAA = WS_RAW + 28 * MiB;
constexpr size_t WS_RR = WS_LORAA + 8 * MiB;
constexpr size_t WS_KF = WS_RR + 8 * MiB;
constexpr size_t WS_VV = WS_KF + 8 * MiB;
constexpr size_t WS_KKB = WS_VV + 8 * MiB;
constexpr size_t WS_BBB = WS_KKB + 8 * MiB;
constexpr size_t WS_GG = WS_BBB + 8 * MiB;
constexpr size_t WS_DEC = WS_GG + 8 * MiB;
constexpr size_t WS_OUT = WS_DEC + 16 * MiB;
constexpr size_t WS_V2 = WS_OUT + 16 * MiB;
constexpr size_t WS_SELB = WS_V2 + 8 * MiB;
constexpr size_t WS_END = WS_SELB + 2 * MiB;
constexpr size_t WS_DCN = WS_RAW;
constexpr size_t WS_Y32 = WS_IDXQ;
constexpr size_t WS_Y = WS_Y32 + 64 * MiB;
static_assert(WS_Y + 32 * MiB <= WS_END, "y32 / y alias");
constexpr size_t WS_ACT = WS_MK;
static_assert(WS_END <= 512 * MiB, "workspace map exceeds 512 MiB");
static_assert(WS_ACT + 176 * MiB <= WS_END, "ACT alias");

DI unsigned pk2(float a, float b) { f32x2 v = {a, b}; return __builtin_bit_cast(unsigned, __builtin_convertvector(v, bf2_t)); }
DI bf16_t f2bf(float a) { return (bf16_t)(pk2(a, 0.f) & 0xffffu); }
DI float bflo(unsigned u) { return __uint_as_float(u << 16); }
DI float bfhi(unsigned u) { return __uint_as_float(u & 0xffff0000u); }
DI float bf2f(bf16_t b) { return __uint_as_float((unsigned)b << 16); }
DI float fexp2(float x) { return __builtin_amdgcn_exp2f(x); }
DI float frcp(float x) { return __builtin_amdgcn_rcpf(x); }
DI float fsigmoid(float x) { return frcp(1.f + fexp2(-x * LOG2E)); }
DI float wave_sum(float v) {
    v += __uint_as_float(__builtin_amdgcn_update_dpp(0, __float_as_uint(v), 0x128, 0xf, 0xf, false));
    v += __uint_as_float(__builtin_amdgcn_update_dpp(0, __float_as_uint(v), 0x124, 0xf, 0xf, false));
    v += __uint_as_float(__builtin_amdgcn_update_dpp(0, __float_as_uint(v), 0x122, 0xf, 0xf, false));
    v += __uint_as_float(__builtin_amdgcn_update_dpp(0, __float_as_uint(v), 0x121, 0xf, 0xf, false));
    auto r = __builtin_amdgcn_permlane16_swap(__float_as_uint(v), __float_as_uint(v), false, false);
    v = __uint_as_float(r[0]) + __uint_as_float(r[1]);
    r = __builtin_amdgcn_permlane32_swap(__float_as_uint(v), __float_as_uint(v), false, false);
    return __uint_as_float(r[0]) + __uint_as_float(r[1]);
}

#define XB_TMO      128
#define XB_XCNT(j)  (256  + 64 * (j))
#define XB_XSUB(j)  (1280 + 64 * (j))
#define XB_XGEN(j)  (2304 + 64 * (j))
#define XB_TOP      3328
#define XB_TOPGEN   3392
#define XCD_BAR_WORDS 3456
#define XB_SPIN_CAP (1u << 18)
__device__ __forceinline__ unsigned xb_ld(unsigned* p)              { return __hip_atomic_load(p, __ATOMIC_RELAXED, __HIP_MEMORY_SCOPE_AGENT); }
__device__ __forceinline__ unsigned xb_add(unsigned* p, unsigned v) { return __hip_atomic_fetch_add(p, v, __ATOMIC_RELAXED, __HIP_MEMORY_SCOPE_AGENT); }
__device__ __forceinline__ unsigned xb_xcc_id() { return (unsigned)__builtin_amdgcn_s_getreg((3 << 11) | 20) & 0xFu; }
#define XB_SPIN(cond, bar) do { unsigned _sp = 0; while (cond) { __builtin_amdgcn_s_sleep(1); \
    if ((++_sp & 255u) == 0u) { if (xb_ld(&(bar)[XB_TMO])) break; if (_sp > XB_SPIN_CAP) { atomicAdd(&(bar)[XB_TMO], 1u); break; } } } } while (0)
struct XcdBarrier { unsigned* bar; unsigned x; volatile LAS unsigned* st; };
__device__ __forceinline__ XcdBarrier xcd_barrier_post(unsigned* bar, volatile LAS unsigned* st) {
    XcdBarrier b; b.bar = bar; b.x = xb_xcc_id(); b.st = st;
    if (threadIdx.x == 0) (void)xb_add(&bar[XB_XCNT(b.x)], 1u);
    return b;
}
__device__ __forceinline__ void xcd_barrier_complete(unsigned* bar, unsigned x, unsigned& nloc, unsigned& nx) {
    const unsigned G = gridDim.x * gridDim.y * gridDim.z;
    unsigned sum, cnt, mine, sp = 0u;
    for (;;) {
        sum = 0u; cnt = 0u; mine = 0u;
#pragma unroll 1
        for (unsigned j = 0; j < 16; ++j) { const unsigned c = xb_ld(&bar[XB_XCNT(j)]); sum += c; cnt += (c > 0u) ? 1u : 0u; mine = (j == x) ? c : mine; }
        if (sum == G) break;
        __builtin_amdgcn_s_sleep(1);
        if ((++sp & 255u) == 0u) { if (xb_ld(&bar[XB_TMO])) break; if (sp > XB_SPIN_CAP) { atomicAdd(&bar[XB_TMO], 1u); break; } }
    }
    nloc = mine > 0u ? mine : 1u; nx = cnt > 0u ? cnt : 1u;
}
__device__ __forceinline__ void xcd_barrier(const XcdBarrier& b) {
    asm volatile("s_waitcnt vmcnt(0)" ::: "memory");
    __syncthreads();
    if (threadIdx.x == 0) {
        unsigned* bar = b.bar;
        __builtin_amdgcn_s_waitcnt(0);
        unsigned nloc = b.st[0], nx = b.st[1];
        if (nloc == 0u) { xcd_barrier_complete(bar, b.x, nloc, nx); b.st[0] = nloc; b.st[1] = nx; }
        const unsigned old = xb_add(&bar[XB_XSUB(b.x)], 1u);
        const unsigned gen = old / nloc;
        if (old + 1u == (gen + 1u) * nloc) {
            __builtin_amdgcn_fence(__ATOMIC_RELEASE, "agent");
            asm volatile("s_waitcnt vmcnt(0)" ::: "memory");
            const unsigned og = xb_add(&bar[XB_TOP], 1u);
            const unsigned tg = og / nx;
            if (og + 1u == (tg + 1u) * nx) xb_add(&bar[XB_TOPGEN], 1u);
            else XB_SPIN(xb_ld(&bar[XB_TOPGEN]) == tg, bar);
            __builtin_amdgcn_fence(__ATOMIC_ACQUIRE, "agent");
            xb_add(&bar[XB_XGEN(b.x)], 1u);
            asm volatile("s_waitcnt vmcnt(0)" ::: "memory");
        } else {
            XB_SPIN(xb_ld(&bar[XB_XGEN(b.x)]) == gen, bar);
            __builtin_amdgcn_fence(__ATOMIC_ACQUIRE, "agent");
            asm volatile("s_waitcnt vmcnt(0)" ::: "memory");
        }
    }
    __syncthreads();
}

DI int TID() { int t = threadIdx.x; asm volatile("" : "+v"(t)); return t; }
DI int BID() { int b = blockIdx.x; asm volatile("" : "+s"(b)); return b; }

namespace pg8 {
constexpr int BM = 256, BK = 64, HALF = 128, HTB = HALF * BK * 2, STAGE_BYTES = 8 * HTB, NXCD = 8, WGM = 8;
DI int lds_byte(int r, int c) { const int st = (r >> 4) * 2 + (c >> 5), rr = r & 15, cc = c & 31, ob = rr * 64 + cc * 2; return st * 1024 + (ob ^ (((ob >> 9) & 1) << 5)); }
DI void stage_rc(int b, int& R, int& C) { const int st = b / 1024, sb = b % 1024, swz = sb ^ (((sb >> 9) & 1) << 5); R = (st >> 1) * 16 + swz / 64; C = (st & 1) * 32 + (swz % 64) / 2; }
struct Unit { int pm, pn, z; };

DI bool order_xcd(int nM, int nN, int G, int c, int i, Unit& u) {
    const int nwg = nM * nN; const long L = (long)i * G + c; if (L >= nwg) return false;
    int wgid = (int)L; { const int q = nwg / NXCD, r = nwg % NXCD, xcd = wgid % NXCD, off = wgid / NXCD; wgid = (xcd < r ? xcd * (q + 1) : r * (q + 1) + (xcd - r) * q) + off; }
    const int nig = WGM * nN, gid = wgid / nig, fm = gid * WGM, gsz = (nM - fm) < WGM ? (nM - fm) : WGM;
    u.pm = fm + ((wgid % nig) % gsz); u.pn = (wgid % nig) / gsz; u.z = 0; return true;
}

template <class Epi, class Sched, bool HALFN = false>
DI void gemm_phase(LAS unsigned char* lds, const int K, const Sched& S, const Epi& E) {
    const int tid = TID(), wid = __builtin_amdgcn_readfirstlane(tid >> 6), lane = tid & 63, wr = wid >> 2, wc = wid & 3, fr = lane & 15, fq = lane >> 4;
    const int nt = K / BK;
    unsigned voffA[2];
#pragma unroll
    for (int i = 0; i < 2; ++i) { int R, C; stage_rc(tid * 16 + i * 8192, R, C); voffA[i] = (unsigned)(R * K + C) * 2u; }
    const size_t kstep = (size_t)(BK * 2);
    const size_t hstep = (size_t)HALF * K * 2;
    const unsigned ldsw = (unsigned)wid * 1024u;
    const int aoff = lds_byte(wr * 64 + fr, fq * 8), boff = lds_byte(wc * 32 + fr, fq * 8);
#define PG8_SA(b, h) (((b) * 2 + (h)) * HTB)
#define PG8_SB(b, h) ((4 + (b) * 2 + (h)) * HTB)
#define PG8_STAGE(bufoff, gbase) do { _Pragma("unroll") for (int _i = 0; _i < 2; ++_i) \
        __builtin_amdgcn_global_load_lds((const unsigned*)((const char*)(gbase) + voffA[_i]), (LAS unsigned*)(lds + (bufoff) + ldsw + _i * 8192), 16, 0, 0); } while (0)
#define PG8_LDA(dst, b, h) do { _Pragma("unroll") for (int m = 0; m < 4; ++m) _Pragma("unroll") for (int k = 0; k < 2; ++k) dst[m][k] = *(const LAS bf16x8*)(lds + PG8_SA(b, h) + aoff + m * 2048 + k * 1024); } while (0)
#define PG8_LDB(dst, b, h) do { _Pragma("unroll") for (int n = 0; n < 2; ++n) _Pragma("unroll") for (int k = 0; k < 2; ++k) dst[n][k] = *(const LAS bf16x8*)(lds + PG8_SB(b, h) + boff + n * 2048 + k * 1024); } while (0)
#define PG8_MMA(ai, bj, At, Bt) do { __builtin_amdgcn_s_setprio(1); _Pragma("unroll") for (int m = 0; m < 4; ++m) _Pragma("unroll") for (int n = 0; n < 2; ++n) _Pragma("unroll") for (int k = 0; k < 2; ++k) \
        acc[ai][bj][m][n] = __builtin_amdgcn_mfma_f32_16x16x32_bf16(Bt[n][k], At[m][k], acc[ai][bj][m][n], 0, 0, 0); __builtin_amdgcn_s_setprio(0); } while (0)
#define PG8_WAIT_V(n) asm volatile("s_waitcnt vmcnt(" #n ")" ::: "memory")
#define PG8_WAIT_L(n) asm volatile("s_waitcnt lgkmcnt(" #n ")" ::: "memory")
#define PG8_BAR __builtin_amdgcn_s_barrier()
#define PG8_SCHED __builtin_amdgcn_sched_barrier(0)
    Unit cur, nxt; int ui = 0;
    if (!S.next(0, cur)) return;
    f32x4 acc[2][2][4][2];
#pragma unroll
    for (int a = 0; a < 2; ++a)
#pragma unroll
        for (int b = 0; b < 2; ++b)
#pragma unroll
            for (int m = 0; m < 4; ++m)
#pragma unroll
                for (int n = 0; n < 2; ++n) acc[a][b][m][n] = (f32x4){0.f, 0.f, 0.f, 0.f};
    bf16x8 At[4][2], B0[2][2], B1[2][2];
    const char* cA = S.aptr(cur); const char* cB = S.bptr(cur);
    PG8_STAGE(PG8_SB(0, 0), cB); PG8_STAGE(PG8_SA(0, 0), cA); PG8_STAGE(PG8_SB(0, 1), cB + hstep); PG8_STAGE(PG8_SA(0, 1), cA + hstep);
    if (wr == 1) PG8_BAR;
    PG8_WAIT_V(4); PG8_BAR;
    PG8_STAGE(PG8_SB(1, 0), cB + kstep); PG8_STAGE(PG8_SA(1, 0), cA + kstep); PG8_STAGE(PG8_SB(1, 1), cB + hstep + kstep);
    PG8_WAIT_V(6); PG8_BAR;
    for (;;) {
        const bool has_next = S.next(ui + 1, nxt);
        const char* nA = has_next ? S.aptr(nxt) : cA; const char* nB = has_next ? S.bptr(nxt) : cB;
#pragma unroll 1
        for (int t = 0; t < nt; t += 2) {
            const bool last = (t == nt - 2);
            const char* a1 = cA + (size_t)(t + 1) * kstep;
            const char* a2 = last ? nA : cA + (size_t)(t + 2) * kstep; const char* b2 = last ? nB : cB + (size_t)(t + 2) * kstep;
            const char* a3 = a2 + kstep; const char* b3 = b2 + kstep;
            PG8_LDB(B0, 0, 0); PG8_SCHED; PG8_LDA(At, 0, 0); PG8_STAGE(PG8_SA(1, 1), a1 + hstep);
            PG8_WAIT_L(8); PG8_BAR; PG8_WAIT_L(0); PG8_MMA(0, 0, At, B0); PG8_BAR; PG8_SCHED;
            PG8_LDB(B1, 0, 1); PG8_STAGE(PG8_SB(0, 0), b2);
            PG8_BAR; PG8_WAIT_L(0); if (!HALFN) PG8_MMA(0, 1, At, B1); PG8_BAR;
            PG8_LDA(At, 0, 1); PG8_STAGE(PG8_SA(0, 0), a2);
            PG8_BAR; PG8_WAIT_L(0); PG8_MMA(1, 0, At, B0); PG8_BAR; PG8_SCHED;
            PG8_STAGE(PG8_SB(0, 1), b2 + hstep);
            PG8_WAIT_V(6); PG8_BAR; if (!HALFN) PG8_MMA(1, 1, At, B1); PG8_BAR;
            PG8_LDB(B0, 1, 0); PG8_SCHED; PG8_LDA(At, 1, 0); PG8_STAGE(PG8_SA(0, 1), a2 + hstep);
            PG8_WAIT_L(8); PG8_BAR; PG8_WAIT_L(0); PG8_MMA(0, 0, At, B0); PG8_BAR; PG8_SCHED;
            PG8_LDB(B1, 1, 1); PG8_STAGE(PG8_SB(1, 0), b3);
            PG8_BAR; PG8_WAIT_L(0); if (!HALFN) PG8_MMA(0, 1, At, B1); PG8_BAR;
            PG8_LDA(At, 1, 1); PG8_STAGE(PG8_SA(1, 0), a3);
            PG8_BAR; PG8_WAIT_L(0); PG8_MMA(1, 0, At, B0); PG8_BAR; PG8_SCHED;
            PG8_STAGE(PG8_SB(1, 1), b3 + hstep);
            PG8_WAIT_V(6); PG8_BAR; if (!HALFN) PG8_MMA(1, 1, At, B1); PG8_BAR;
        }
        { int tz = TID(); asm volatile("" : "+v"(tz));
          const int wz = __builtin_amdgcn_readfirstlane(tz >> 6), lz = tz & 63; E(acc, cur, wz >> 2, wz & 3, lz & 15, lz >> 4); }
        if (!has_next) break;
#pragma unroll
        for (int a = 0; a < 2; ++a)
#pragma unroll
            for (int b = 0; b < (HALFN ? 1 : 2); ++b)
#pragma unroll
                for (int m = 0; m < 4; ++m)
#pragma unroll
                    for (int n = 0; n < 2; ++n) acc[a][b][m][n] = (f32x4){0.f, 0.f, 0.f, 0.f};
        cur = nxt; cA = nA; cB = nB; ++ui;
    }
    PG8_WAIT_V(0);
    if (wr == 0) PG8_BAR;
    PG8_BAR;
#undef PG8_SA
#undef PG8_SB
#undef PG8_STAGE
#undef PG8_LDA
#undef PG8_LDB
#undef PG8_MMA
#undef PG8_WAIT_V
#undef PG8_WAIT_L
#undef PG8_BAR
#undef PG8_SCHED
}
}
using pg8::Unit;
typedef f32x4 AccT[2][2][4][2];

struct Params {
    const float* in[26];
    float* out;
    unsigned char* ws;
    int ph_lo, ph_hi;
};
enum { I_X = 0, I_WIN, I_NMIX, I_NFFN, I_QKN, I_REL, I_MU, I_W0, I_W2, I_A0, I_A2, I_G2, I_KK, I_KA, I_RK, I_LNW, I_LNB, I_V0, I_VA, I_VB, I_KVN, I_KVUP, I_WBR, I_WO, I_F1, I_F2 };

DI const Params* KP() { auto k = __builtin_amdgcn_kernarg_segment_ptr(); asm volatile("" : "+s"(k)); return (const Params*)k; }
template <class T> DI T* wsp(size_t off) { return (T*)(KP()->ws + off); }

DI int cmap_b(int x) { const int pi = x & 255; return (x & ~255) + 64 * ((pi >> 5) & 3) + 32 * (pi >> 7) + 8 * ((pi >> 2) & 3) + 4 * ((pi >> 4) & 1) + (pi & 3); }
DI int cmap_f(int x) { const int pi = x & 255; return (x & ~255) + 64 * ((pi >> 5) & 3) + 32 * (pi >> 7) + 16 * ((pi >> 4) & 1) + 4 * ((pi >> 2) & 3) + (pi & 3); }
DI int wide_col(int x) { return cmap_b(x); }
template <int MAP> DI int colmap(int r) {
    if (MAP == 0) {
        if (r < 512) return C_MK + wide_col(r);
        if (r < 768) return C_DS + 512 + wide_col(r - 512);
        const int a = wide_col(r - 768);
        if (a < 32) return C_DS + 1024 + a;
        if (a < 40) return C_DS + 1056 + (a - 32);
        if (a >= 64 && a < 96) return C_RW + 1792 + (a - 64);
        return -1;
    }
    if (MAP == 1) return C_MV + r;
    if (MAP == 2) {
        if (r < 512) return C_MQ + wide_col(r);
        if (r < 1024) return C_DS + wide_col(r - 512);
        if (r < 1280) return C_DS + 768 + wide_col(r - 1024);
        if (r < 3072) return C_RW + wide_col(r - 1280);
        return C_GT + wide_col(r - 3072);
    }
    if (MAP == 3) return wide_col(r);
    if (MAP == 4) return 512 + r;
    if (MAP == 5) return cmap_b(r);
    if (MAP == 7) return cmap_f(r);
    if (MAP == 6) { const int pn = r >> 8, pi = r & 255;
        return ((pi >> 7) ? DFF : 0) + 128 * pn + 32 * ((pi >> 5) & 3) + 8 * ((pi >> 2) & 3) + 4 * ((pi >> 4) & 1) + (pi & 3); }
    return -1;
}
template <int MAP> DI void conv_t(LAS float* sm, bf16_t* dst, int nrows, int K, const float* src, int ld) {
    const int tid = TID(), tx = tid & 63, ty = tid >> 6;
    const int ntr = nrows / 64, ntk = K / 64, ntiles = ntr * ntk;
    for (int t = BID(); t < ntiles; t += gridDim.x) {
        const int r0 = (t / ntk) * 64, k0 = (t % ntk) * 64;
        const int col = colmap<MAP>(r0 + tx);
#pragma unroll
        for (int i = 0; i < 8; ++i) { const int kl = ty + 8 * i; sm[kl * 65 + tx] = (col >= 0) ? src[(size_t)(k0 + kl) * ld + col] : 0.f; }
        __syncthreads();
#pragma unroll
        for (int i = 0; i < 8; ++i) { const int rl = ty + 8 * i; dst[(size_t)(r0 + rl) * K + k0 + tx] = f2bf(sm[tx * 65 + rl]); }
        __syncthreads();
    }
}
DI void conv_lora(int l) {
    bf16_t* dst = wsp<bf16_t>(WS_WL);
    const float* w2 = KP()->in[I_W2] + (size_t)l * 64 * 512; const float* a2 = KP()->in[I_A2] + (size_t)l * 64 * 512; const float* g2 = KP()->in[I_G2] + (size_t)l * 160 * 512;
    const float* va = KP()->in[I_VA]; const float* vb = KP()->in[I_VB];
    const int n = 2048 * 512;
    for (int e = BID() * 512 + TID(); e < n; e += gridDim.x * 512) {
        const int r = wide_col(e >> 9), k = e & 511; float v = 0.f;
        if (r < 512) { if (k < 64) v = w2[k * 512 + r]; }
        else if (r < 1024) { if (k >= 64 && k < 128) v = a2[(k - 64) * 512 + (r - 512)]; }
        else if (r < 1536) { if (k >= 128 && k < 288) v = g2[(k - 128) * 512 + (r - 1024)]; }
        else if (l == 1) { const int c = r - 1536; float s = 0.f;
#pragma unroll 8
            for (int j = 0; j < 32; ++j) s += va[k * 32 + j] * vb[j * 512 + c];
            v = s; }
        dst[e] = f2bf(v);
    }
}
DI void phase_conv(int l, LAS float* sm) {
    const float* win = KP()->in[I_WIN] + (size_t)l * DM * D_IN;
    conv_t<0>(sm, wsp<bf16_t>(WS_WB), 1024, 1024, win, D_IN);
    conv_t<1>(sm, wsp<bf16_t>(WS_WV), 512, 1024, win, D_IN);
    conv_t<2>(sm, wsp<bf16_t>(WS_WD1), 6144, 1024, win, D_IN);
    const float* kvup = KP()->in[I_KVUP] + (size_t)l * 256 * 1024;
    conv_t<3>(sm, wsp<bf16_t>(WS_WKVK), 512, 256, kvup, 1024);
    conv_t<4>(sm, wsp<bf16_t>(WS_WKVV), 512, 256, kvup, 1024);
    for (int i = 0; i < 3; ++i) conv_t<5>(sm, wsp<bf16_t>(WS_WBR) + (size_t)i * 1024 * 512, 1024, 512, KP()->in[I_WBR] + ((size_t)l * 3 + i) * 512 * 1024, 1024);
    conv_t<7>(sm, wsp<bf16_t>(WS_WO), 1024, 1024, KP()->in[I_WO] + (size_t)l * 1024 * 1024, 1024);
    conv_t<6>(sm, wsp<bf16_t>(WS_WF1), 5632, 1024, KP()->in[I_F1] + (size_t)l * 1024 * 5632, 5632);
    conv_t<7>(sm, wsp<bf16_t>(WS_WF2), 1024, 2816, KP()->in[I_F2] + (size_t)l * 2816 * 1024, 1024);
    conv_lora(l);
}

DI void phase_norm(const float* x, const float* g, bf16_t* h) {
    const int lane = TID() & 63, gw = BID() * 8 + (TID() >> 6), nw = gridDim.x * 8;
    f32x4 gv[4];
#pragma unroll
    for (int i = 0; i < 4; ++i) gv[i] = ((const f32x4*)g)[lane + 64 * i];
    for (int row = gw; row < NT; row += nw) {
        const f32x4* xr = (const f32x4*)(x + (size_t)row * DM);
        f32x4 v[4]; float ss = 0.f;
#pragma unroll
        for (int i = 0; i < 4; ++i) { v[i] = xr[lane + 64 * i]; ss += v[i][0] * v[i][0] + v[i][1] * v[i][1] + v[i][2] * v[i][2] + v[i][3] * v[i][3]; }
        ss = wave_sum(ss);
        const float rs = __builtin_amdgcn_rsqf(ss * (1.f / DM) + NORM_EPS);
#pragma unroll
        for (int i = 0; i < 4; ++i) {
            u32x2 o; o[0] = pk2(v[i][0] * rs * gv[i][0], v[i][1] * rs * gv[i][1]); o[1] = pk2(v[i][2] * rs * gv[i][2], v[i][3] * rs * gv[i][3]);
            *(u32x2*)(h + (size_t)row * DM + 4 * (lane + 64 * i)) = o;
        }
    }
}

struct SchedLin {
    int nM, nN, G, c; unsigned aoff, boff, a2off; int rowbytes, amode, cbase, pn2;
    DI bool next(int i, Unit& u) const { return pg8::order_xcd(nM, nN, G, c, i, u); }
    DI const char* aptr(const Unit& u) const { const int row0 = amode ? ((u.pm >> 1) * SEQ + cbase + (u.pm & 1) * 256) : u.pm * 256; return (const char*)KP()->ws + ((u.pn >= pn2) ? a2off : aoff) + (size_t)row0 * rowbytes; }
    DI const char* bptr(const Unit& u) const { return (const char*)KP()->ws + boff + (size_t)u.pn * 256 * rowbytes; }
};
DI SchedLin mk_sched(int nM, int nN, size_t aoff, size_t boff, int K, int amode = 0, int cbase = 0, size_t a2off = 0, int pn2 = 1 << 30) {
    SchedLin s; s.nM = nM; s.nN = nN; s.G = gridDim.x; s.c = BID(); s.aoff = (unsigned)aoff; s.boff = (unsigned)boff; s.rowbytes = K * 2; s.amode = amode; s.cbase = cbase; s.a2off = (unsigned)a2off; s.pn2 = pn2; return s;
}
struct SchedMerge {
    int G, c;
    DI bool next(int i, Unit& u) const { const int z = i % 3, tile = (i / 3) * G + c; if (tile >= 256) return false; u.pm = tile >> 2; u.pn = tile & 3; u.z = z; return true; }
    DI const char* aptr(const Unit& u) const { return (const char*)KP()->ws + (u.z == 0 ? WS_MQ : (u.z == 1 ? WS_ORW : WS_DQ)) + (size_t)(u.pm >> 5) * PAR_O + (size_t)(u.pm & 31) * 256 * 1024; }
    DI const char* bptr(const Unit& u) const { return (const char*)KP()->ws + WS_WBR + (size_t)u.z * (1024 * 512 * 2) + (size_t)u.pn * 256 * 1024; }
};

DI void st_bf4(bf16_t* p, f32x4 v) { u32x2 o; o[0] = pk2(v[0], v[1]); o[1] = pk2(v[2], v[3]); *(u32x2*)p = o; }
DI f32x4 ld_bf4(const bf16_t* p) { const u32x2 u = *(const u32x2*)p; return (f32x4){bflo(u[0]), bfhi(u[0]), bflo(u[1]), bfhi(u[1])}; }
#define EPI_ROWS(ai, m) (128 * (ai) + 64 * wr + 16 * (m) + fr)
#define EPI_COLS(bj, n) (64 * wc + 32 * (bj) + 8 * fq + 4 * (n))
#define EPI_COLS_F(bj, n) (64 * wc + 32 * (bj) + 16 * (n) + 4 * fq)
#define EPI_COLS_T(bj, n) (128 * (bj) + 32 * wc + 16 * (n) + 4 * fq)
#define FOR_AM _Pragma("unroll") for (int ai = 0; ai < 2; ++ai) _Pragma("unroll") for (int m = 0; m < 4; ++m)
#define FOR_BN _Pragma("unroll") for (int bj = 0; bj < 2; ++bj) _Pragma("unroll") for (int n = 0; n < 2; ++n)

DI void epi_headnorm(const AccT& acc, bf16_t* out, int ld, const float* gain, int wr, int wc, int fr, int fq) {
    f32x4 gv[2][2];
    FOR_BN gv[bj][n] = *(const f32x4*)(gain + 32 * bj + 8 * fq + 4 * n);
    FOR_AM {
        float ss = 0.f;
        FOR_BN { const f32x4 a = acc[ai][bj][m][n]; ss += a[0] * a[0] + a[1] * a[1] + a[2] * a[2] + a[3] * a[3]; }
        ss += __shfl_xor(ss, 16); ss += __shfl_xor(ss, 32);
        const float sc = __builtin_amdgcn_rsqf(ss * (1.f / 64.f) + NORM_EPS);
        bf16_t* rp = out + (size_t)EPI_ROWS(ai, m) * ld;
        FOR_BN st_bf4(rp + EPI_COLS(bj, n), acc[ai][bj][m][n] * sc * gv[bj][n]);
    }
}
DI void epi_store_bf16(const AccT& acc, bf16_t* out, int ld, int wr, int wc, int fr, int fq) {
    FOR_AM { bf16_t* rp = out + (size_t)EPI_ROWS(ai, m) * ld; FOR_BN st_bf4(rp + EPI_COLS(bj, n), acc[ai][bj][m][n]); }
}

struct EpiB {
    int l;
    DI void operator()(const AccT& acc, const Unit& u, int wr, int wc, int fr, int fq) const {
        const size_t row0 = (size_t)u.pm * 256;
        if (u.pn < 2) epi_headnorm(acc, wsp<bf16_t>(WS_MK) + row0 * 512 + u.pn * 256, 512, KP()->in[I_QKN] + l * 256 + 64, wr, wc, fr, fq);
        else if (u.pn == 2) epi_store_bf16(acc, wsp<bf16_t>(WS_DCN) + row0 * 256, 256, wr, wc, fr, fq);
        else {
            bf16_t* idxk = wsp<bf16_t>(WS_IDXK); float* idxw = wsp<float>(WS_IDXW); bf16_t* left = wsp<bf16_t>(WS_LEFT);
            FOR_AM { const size_t row = row0 + EPI_ROWS(ai, m);
                if (wc == 0) {
#pragma unroll
                    for (int n = 0; n < 2; ++n) st_bf4(idxk + row * 32 + 8 * fq + 4 * n, acc[ai][0][m][n]);
                    if (fq == 0) { *(f32x4*)(idxw + row * 8) = acc[ai][1][m][0]; *(f32x4*)(idxw + row * 8 + 4) = acc[ai][1][m][1]; }
                } else if (wc == 1) {
#pragma unroll
                    for (int n = 0; n < 2; ++n) st_bf4(left + row * 32 + 8 * fq + 4 * n, acc[ai][0][m][n]);
                }
            }
        }
    }
};
struct EpiVt {
    unsigned off;
    DI void operator()(const AccT& acc, const Unit& u, int wr, int wc, int fr, int fq) const {
        bf16_t* vt = wsp<bf16_t>(off);
        const int b = u.pn >> 3, s0 = (u.pn & 7) * 256;
        FOR_AM { bf16_t* rp = vt + ((size_t)b * 512 + u.pm * 256 + EPI_ROWS(ai, m)) * SEQ + s0; FOR_BN st_bf4(rp + EPI_COLS_T(bj, n), acc[ai][bj][m][n]); }
    }
};
struct EpiHN {
    int l;
    DI void operator()(const AccT& acc, const Unit& u, int wr, int wc, int fr, int fq) const { epi_headnorm(acc, wsp<bf16_t>(WS_DK) + (size_t)u.pm * 256 * 512 + u.pn * 256, 512, KP()->in[I_QKN] + l * 256 + 192, wr, wc, fr, fq); }
};
struct EpiD1 {
    int l, par;
    DI void operator()(const AccT& acc, const Unit& u, int wr, int wc, int fr, int fq) const {
        const size_t row0 = (size_t)u.pm * 256;
        if (u.pn < 2) epi_headnorm(acc, wsp<bf16_t>(WS_MQ + par * PAR_O) + row0 * 512 + u.pn * 256, 512, KP()->in[I_QKN] + l * 256, wr, wc, fr, fq);
        else if (u.pn < 4) epi_headnorm(acc, wsp<bf16_t>(WS_DQ + par * PAR_O) + row0 * 512 + (u.pn - 2) * 256, 512, KP()->in[I_QKN] + l * 256 + 128, wr, wc, fr, fq);
        else if (u.pn == 4) epi_store_bf16(acc, wsp<bf16_t>(WS_IDXQ) + row0 * 256, 256, wr, wc, fr, fq);
        else if (u.pn < 12) epi_store_bf16(acc, wsp<bf16_t>(WS_RAW) + row0 * RAWLD + (u.pn - 5) * 256, RAWLD, wr, wc, fr, fq);
        else {
            unsigned char* o = wsp<unsigned char>(WS_GATES + par * PAR_G) + row0 * 3072 + (u.pn - 12) * 256;
            FOR_AM { unsigned char* rp = o + (size_t)EPI_ROWS(ai, m) * 3072;
                FOR_BN { const f32x4 a = acc[ai][bj][m][n];
                    const unsigned q0 = (unsigned)(fsigmoid(a[0]) * 255.f + 0.5f), q1 = (unsigned)(fsigmoid(a[1]) * 255.f + 0.5f), q2 = (unsigned)(fsigmoid(a[2]) * 255.f + 0.5f), q3 = (unsigned)(fsigmoid(a[3]) * 255.f + 0.5f);
                    *(unsigned*)(rp + EPI_COLS(bj, n)) = q0 | (q1 << 8) | (q2 << 16) | (q3 << 24); } }
        }
    }
};
struct EpiLora {
    int l, cbase;
    DI void operator()(const AccT& acc, const Unit& u, int wr, int wc, int fr, int fq) const {
        const size_t row0 = (size_t)u.pm * 256; const int kind = u.pn >> 1, cb = (u.pn & 1) * 256;
        if (kind == 0) {
            float* dec = wsp<float>(WS_DEC); const float* w0 = KP()->in[I_W0] + l * 512;
            FOR_AM { const size_t row = row0 + EPI_ROWS(ai, m);
                FOR_BN { const int col = cb + EPI_COLS(bj, n); const f32x4 a = acc[ai][bj][m][n]; const f32x4 wv = *(const f32x4*)(w0 + col); f32x4 d;
#pragma unroll
                    for (int e = 0; e < 4; ++e) { const float x = -(wv[e] + a[e]);
                        const float sp = fmaxf(x, 0.f) + __builtin_amdgcn_logf(1.f + fexp2(-fabsf(x) * LOG2E)) * 0.6931471805599453f;
                        const float w = -sp - 0.5f; d[e] = fexp2(-fexp2(w * LOG2E) * LOG2E); }
                    *(f32x4*)(dec + row * 512 + col) = d; } }
        } else if (kind == 1) {
            bf16_t* kf = wsp<bf16_t>(WS_KF); const bf16_t* kkb = wsp<bf16_t>(WS_KKB); bf16_t* bbb = wsp<bf16_t>(WS_BBB);
            const float* a0 = KP()->in[I_A0] + l * 512; const float* ka = KP()->in[I_KA] + l * 512;
            FOR_AM { const size_t row = row0 + EPI_ROWS(ai, m);
                f32x4 kp[2][2], kk[2][2];
                FOR_BN { const int col = cb + EPI_COLS(bj, n); kp[bj][n] = ld_bf4(kf + row * 512 + col); kk[bj][n] = ld_bf4(kkb + row * 512 + col); }
                FOR_BN { const int col = cb + EPI_COLS(bj, n); const f32x4 a = acc[ai][bj][m][n];
                    const f32x4 av = *(const f32x4*)(a0 + col), kav = *(const f32x4*)(ka + col); f32x4 ko, bo;
#pragma unroll
                    for (int e = 0; e < 4; ++e) { const float s = fsigmoid(av[e] + a[e]); ko[e] = kp[bj][n][e] * (1.f + (s - 1.f) * kav[e]); bo[e] = kk[bj][n][e] * s; }
                    st_bf4(kf + row * 512 + col, ko); st_bf4(bbb + row * 512 + col, bo); } }
        } else if (kind == 2) {
            epi_store_bf16(acc, wsp<bf16_t>(WS_GG) + row0 * 512 + cb, 512, wr, wc, fr, fq);
        } else {
            const bf16_t* vv = wsp<bf16_t>(WS_VV); bf16_t* v2 = wsp<bf16_t>(WS_V2); const bf16_t* vfirst = wsp<bf16_t>(WS_VFIRST); const float* v0 = KP()->in[I_V0];
            FOR_AM { const size_t row = row0 + EPI_ROWS(ai, m); const size_t arow = (size_t)(row >> 9) * SEQ + cbase + (row & 511);
                f32x4 vp[2][2], vf[2][2];
                FOR_BN { const int col = cb + EPI_COLS(bj, n); vp[bj][n] = ld_bf4(vv + row * 512 + col); vf[bj][n] = ld_bf4(vfirst + arow * 512 + col); }
                FOR_BN { const int col = cb + EPI_COLS(bj, n); const f32x4 a = acc[ai][bj][m][n]; const f32x4 v0v = *(const f32x4*)(v0 + col); f32x4 o;
#pragma unroll
                    for (int e = 0; e < 4; ++e) o[e] = vp[bj][n][e] + (vf[bj][n][e] - vp[bj][n][e]) * fsigmoid(v0v[e] + a[e]);
                    st_bf4(v2 + row * 512 + col, o); } }
        }
    }
};
struct EpiMerge {
    DI void operator()(const AccT& acc, const Unit& u, int wr, int wc, int fr, int fq) const {
        bf16_t* y = wsp<bf16_t>(WS_Y); const unsigned char* gates = wsp<unsigned char>(WS_GATES + (size_t)(u.pm >> 5) * PAR_G);
        const size_t row0 = (size_t)u.pm * 256, grow0 = (size_t)(u.pm & 31) * 256; const int c0 = u.pn * 256 + 64 * wc + 8 * fq, z = u.z;
#pragma unroll
        for (int ai = 0; ai < 2; ++ai) {
            u32x2 g[4][2]; u32x4 yv[4][2];
#pragma unroll
            for (int m = 0; m < 4; ++m) { const int rt = EPI_ROWS(ai, m);
#pragma unroll
                for (int bj = 0; bj < 2; ++bj) { g[m][bj] = *(const u32x2*)(gates + (grow0 + rt) * 3072 + z * 1024 + c0 + 32 * bj);
                    if (z > 0) yv[m][bj] = *(const u32x4*)(y + (row0 + rt) * 1024 + c0 + 32 * bj); } }
#pragma unroll
            for (int m = 0; m < 4; ++m) { const size_t row = row0 + EPI_ROWS(ai, m);
#pragma unroll
                for (int bj = 0; bj < 2; ++bj) { u32x4 o;
#pragma unroll
                    for (int n = 0; n < 2; ++n) { const unsigned gu = g[m][bj][n];
                        const f32x4 gf = (f32x4){(float)(gu & 255u), (float)((gu >> 8) & 255u), (float)((gu >> 16) & 255u), (float)(gu >> 24)} * (1.f / 255.f);
                        f32x4 v = acc[ai][bj][m][n] * gf;
                        if (z > 0) { const unsigned ya = yv[m][bj][2 * n], yb = yv[m][bj][2 * n + 1]; v += (f32x4){bflo(ya), bfhi(ya), bflo(yb), bfhi(yb)}; }
                        o[2 * n] = pk2(v[0], v[1]); o[2 * n + 1] = pk2(v[2], v[3]); }
                    *(u32x4*)(y + row * 1024 + c0 + 32 * bj) = o; } }
        }
    }
};
struct EpiRes {
    int first, amode, cbase; unsigned dummy_off;
    DI void operator()(const AccT& acc, const Unit& u, int wr, int wc, int fr, int fq) const {
        float* out = KP()->out; const float* res = first ? KP()->in[I_X] : (const float*)out;
        if (dummy_off) out = wsp<float>(dummy_off);
        const size_t grow0 = amode == 2 ? ((size_t)((u.pm & 31) >> 1) * SEQ + cbase + (u.pm >> 5) * SC + (u.pm & 1) * 256) : (amode ? ((size_t)(u.pm >> 1) * SEQ + cbase + (u.pm & 1) * 256) : (size_t)u.pm * 256); const int c0 = u.pn * 256;
#pragma unroll
        for (int ai = 0; ai < 2; ++ai) {
            f32x4 rv[4][2][2];
#pragma unroll
            for (int m = 0; m < 4; ++m) { const size_t row = grow0 + EPI_ROWS(ai, m); FOR_BN rv[m][bj][n] = *(const f32x4*)(res + row * DM + c0 + EPI_COLS_F(bj, n)); }
#pragma unroll
            for (int m = 0; m < 4; ++m) { const size_t row = grow0 + EPI_ROWS(ai, m); FOR_BN *(f32x4*)(out + row * DM + c0 + EPI_COLS_F(bj, n)) = rv[m][bj][n] + acc[ai][bj][m][n]; }
        }
    }
};
struct EpiNull { DI void operator()(const AccT& acc, const Unit& u, int wr, int wc, int fr, int fq) const { f32x4 s = {0.f, 0.f, 0.f, 0.f}; FOR_AM { FOR_BN s += acc[ai][bj][m][n]; } if (s[0] + s[1] + s[2] + s[3] == 12345.678f) *wsp<float>(WS_OUT) = 1.f; } };
struct EpiSwiglu {
    DI void operator()(const AccT& acc, const Unit& u, int wr, int wc, int fr, int fq) const {
        bf16_t* act = wsp<bf16_t>(WS_ACT);
        FOR_AM { bf16_t* rp = act + ((size_t)u.pm * 256 + EPI_ROWS(ai, m)) * DFF + u.pn * 128 + 32 * wc + 8 * fq;
            u32x4 w;
#pragma unroll
            for (int n = 0; n < 2; ++n) { const f32x4 g = acc[ai][0][m][n], up = acc[ai][1][m][n]; f32x4 o;
#pragma unroll
                for (int e = 0; e < 4; ++e) o[e] = g[e] * fsigmoid(g[e]) * up[e];
                w[2 * n] = pk2(o[0], o[1]); w[2 * n + 1] = pk2(o[2], o[3]); }
            *(u32x4*)rp = w; }
    }
};

DI void phase_dcn(int l) {
    const int lane = TID() & 63, gw = BID() * 8 + (TID() >> 6), nw = gridDim.x * 8;
    bf16_t* dcn = wsp<bf16_t>(WS_DCN);
    const f32x4 g = *(const f32x4*)(KP()->in[I_KVN] + l * 256 + 4 * lane);
    for (int row = gw; row < NT; row += nw) {
        bf16_t* rp = dcn + (size_t)row * 256 + 4 * lane;
        const f32x4 v = ld_bf4(rp);
        const float ss = wave_sum(v[0] * v[0] + v[1] * v[1] + v[2] * v[2] + v[3] * v[3]);
        const float rs = __builtin_amdgcn_rsqf(ss * (1.f / 256.f) + NORM_EPS);
        st_bf4(rp, v * rs * g);
    }
}
DI void phase_kmean() {
    const int lane = TID() & 63, gw = BID() * 8 + (TID() >> 6), nw = gridDim.x * 8;
    const bf16_t* mk = wsp<bf16_t>(WS_MK); float* km = wsp<float>(WS_KMEAN);
    for (int it = gw; it < NB * NH * 8; it += nw) {
        const int n = it & 7, h = (it >> 3) & 7, b = it >> 6;
        const bf16_t* kp = mk + ((size_t)b * SEQ + n * 256 + (lane >> 3)) * 512 + h * 64 + 8 * (lane & 7);
        float s[8] = {0.f, 0.f, 0.f, 0.f, 0.f, 0.f, 0.f, 0.f};
#pragma unroll 8
        for (int k = 0; k < 256; k += 8) { const u32x4 u = *(const u32x4*)(kp + (size_t)k * 512);
#pragma unroll
            for (int q = 0; q < 4; ++q) { s[2 * q] += bflo(u[q]); s[2 * q + 1] += bfhi(u[q]); } }
#pragma unroll
        for (int e = 0; e < 8; ++e) {
            float v = s[e];
            v += __uint_as_float(__builtin_amdgcn_update_dpp(0, __float_as_uint(v), 0x128, 0xf, 0xf, false));
            auto r = __builtin_amdgcn_permlane16_swap(__float_as_uint(v), __float_as_uint(v), false, false); v = __uint_as_float(r[0]) + __uint_as_float(r[1]);
            r = __builtin_amdgcn_permlane32_swap(__float_as_uint(v), __float_as_uint(v), false, false); s[e] = (__uint_as_float(r[0]) + __uint_as_float(r[1])) * (1.f / 256.f);
        }
        if (lane < 8) { float* o = km + (size_t)it * 64 + 8 * lane; *(f32x4*)o = (f32x4){s[0], s[1], s[2], s[3]}; *(f32x4*)(o + 4) = (f32x4){s[4], s[5], s[6], s[7]}; }
    }
}

DI void phase_rwkv_prep(int l, int c) {
    const int lane = TID() & 63, gw = BID() * 8 + (TID() >> 6), nw = gridDim.x * 8;
    const bf16_t* raw = wsp<bf16_t>(WS_RAW); const bf16_t* left = wsp<bf16_t>(WS_LEFT); bf16_t* carry = wsp<bf16_t>(WS_CARRY);
    bf16_t* rr = wsp<bf16_t>(WS_RR); bf16_t* kf = wsp<bf16_t>(WS_KF); bf16_t* vv = wsp<bf16_t>(WS_VV); bf16_t* kkb = wsp<bf16_t>(WS_KKB);
    bf16_t* la = wsp<bf16_t>(WS_LORAA); bf16_t* vfirst = wsp<bf16_t>(WS_VFIRST);
    const float* mu = KP()->in[I_MU] + l * 1824; const float* kkw = KP()->in[I_KK] + l * 512;
    for (int rc = gw; rc < TC; rc += nw) {
        const int b = rc >> 9, sl = rc & 511, s = c * SC + sl; const size_t ra = (size_t)b * SEQ + s;
        const bf16_t* cur = raw + (size_t)rc * RAWLD;
        const bf16_t* prv = (sl > 0) ? (cur - RAWLD) : (carry + (size_t)((((c + 1) & 1) * 16) + b) * RAWLD);
        const bool hp = s > 0;
        auto mix8 = [&](int j, float* o) {
            const u32x4 cu = *(const u32x4*)(cur + j); u32x4 pu = {0u, 0u, 0u, 0u}; if (hp) pu = *(const u32x4*)(prv + j);
            const f32x4 m0 = *(const f32x4*)(mu + j), m1 = *(const f32x4*)(mu + j + 4);
#pragma unroll
            for (int e = 0; e < 4; ++e) { const float c0 = bflo(cu[e]), c1 = bfhi(cu[e]), p0 = bflo(pu[e]), p1 = bfhi(pu[e]);
                const float ma = (2 * e < 4) ? m0[2 * e] : m1[2 * e - 4], mb = (2 * e + 1 < 4) ? m0[2 * e + 1] : m1[2 * e + 1 - 4];
                o[2 * e] = c0 + (p0 - c0) * ma; o[2 * e + 1] = c1 + (p1 - c1) * mb; }
        };
        float o[8];
        mix8(8 * lane, o);
        { u32x4 w; w[0] = pk2(o[0], o[1]); w[1] = pk2(o[2], o[3]); w[2] = pk2(o[4], o[5]); w[3] = pk2(o[6], o[7]); *(u32x4*)(rr + (size_t)rc * 512 + 8 * lane) = w; }
        mix8(576 + 8 * lane, o);
        { u32x4 w; w[0] = pk2(o[0], o[1]); w[1] = pk2(o[2], o[3]); w[2] = pk2(o[4], o[5]); w[3] = pk2(o[6], o[7]); *(u32x4*)(kf + (size_t)rc * 512 + 8 * lane) = w;
          const f32x4 k0 = *(const f32x4*)(kkw + 8 * lane), k1 = *(const f32x4*)(kkw + 8 * lane + 4);
          float q[8]; float ss = 0.f;
#pragma unroll
          for (int e = 0; e < 8; ++e) { q[e] = o[e] * (e < 4 ? k0[e] : k1[e - 4]); ss += q[e] * q[e]; }
          ss += __shfl_xor(ss, 1); ss += __shfl_xor(ss, 2); ss += __shfl_xor(ss, 4);
          const float inv = 1.f / fmaxf(sqrtf(ss), 1e-12f);
          w[0] = pk2(q[0] * inv, q[1] * inv); w[1] = pk2(q[2] * inv, q[3] * inv); w[2] = pk2(q[4] * inv, q[5] * inv); w[3] = pk2(q[6] * inv, q[7] * inv);
          *(u32x4*)(kkb + (size_t)rc * 512 + 8 * lane) = w; }
        mix8(1088 + 8 * lane, o);
        { u32x4 w; w[0] = pk2(o[0], o[1]); w[1] = pk2(o[2], o[3]); w[2] = pk2(o[4], o[5]); w[3] = pk2(o[6], o[7]); *(u32x4*)(vv + (size_t)rc * 512 + 8 * lane) = w;
          if (l == 0) *(u32x4*)(vfirst + ra * 512 + 8 * lane) = w; }
        { bf16_t* lr = la + (size_t)rc * 512;
          const bf16_t* cs = cur; const bf16_t* ps_ = prv; int sc = 512 + 8 * lane, dc = 8 * lane, fn = 0; const float* mup = mu;
          if (lane >= 8) { sc = 1600 + 8 * (lane - 8); dc = 64 + 8 * (lane - 8); fn = 1; }
          if (lane >= 16) { sc = 1664 + 8 * (lane - 16); dc = 128 + 8 * (lane - 16); fn = 2; }
          if (lane >= 32) { cs = left + ra * 32; ps_ = left + (ra - 1) * 32; sc = 8 * (lane - 32); dc = 256 + 8 * (lane - 32); mup = mu + 1792; }
          u32x4 w = {0u, 0u, 0u, 0u};
          if (lane < 36) {
              const u32x4 cu = *(const u32x4*)(cs + sc); u32x4 pu = {0u, 0u, 0u, 0u}; if (hp) pu = *(const u32x4*)(ps_ + sc);
              const f32x4 m0 = *(const f32x4*)(mup + sc), m1 = *(const f32x4*)(mup + sc + 4);
              float x[8];
#pragma unroll
              for (int e = 0; e < 4; ++e) { const float c0 = bflo(cu[e]), c1 = bfhi(cu[e]), p0 = bflo(pu[e]), p1 = bfhi(pu[e]);
                  const float ma = (2 * e < 4) ? m0[2 * e] : m1[2 * e - 4], mb = (2 * e + 1 < 4) ? m0[2 * e + 1] : m1[2 * e + 1 - 4];
                  x[2 * e] = c0 + (p0 - c0) * ma; x[2 * e + 1] = c1 + (p1 - c1) * mb; }
#pragma unroll
              for (int e = 0; e < 8; ++e) { const float th = 1.f - 2.f * frcp(fexp2(2.f * x[e] * LOG2E) + 1.f), sg = fsigmoid(x[e]); x[e] = fn == 0 ? th : (fn == 1 ? x[e] : sg); }
              w[0] = pk2(x[0], x[1]); w[1] = pk2(x[2], x[3]); w[2] = pk2(x[4], x[5]); w[3] = pk2(x[6], x[7]);
          } else dc = 288 + 8 * (lane - 36);
          *(u32x4*)(lr + dc) = w; }
        if (sl == SC - 1) { bf16_t* cp = carry + (size_t)(((c & 1) * 16) + b) * RAWLD;
            for (int j = lane; j < RAWLD / 8; j += 64) *(u32x4*)(cp + 8 * j) = *(const u32x4*)(cur + 8 * j); }
    }
}

DI float dpp_ror_add(float x, int) { return x; }
DI void reduce4(float p0, float p1, float p2, float p3, float& s0, float& s1, float& s2, float& s3) {
    auto r = __builtin_amdgcn_permlane32_swap(__float_as_uint(p0), __float_as_uint(p2), false, false);
    const float u0 = __uint_as_float(r[0]) + __uint_as_float(r[1]);
    r = __builtin_amdgcn_permlane32_swap(__float_as_uint(p1), __float_as_uint(p3), false, false);
    const float u1 = __uint_as_float(r[0]) + __uint_as_float(r[1]);
    r = __builtin_amdgcn_permlane16_swap(__float_as_uint(u0), __float_as_uint(u1), false, false);
    float w = __uint_as_float(r[0]) + __uint_as_float(r[1]);
    w += __uint_as_float(__builtin_amdgcn_update_dpp(0, __float_as_uint(w), 0x128, 0xf, 0xf, false));
    w += __uint_as_float(__builtin_amdgcn_update_dpp(0, __float_as_uint(w), 0x124, 0xf, 0xf, false));
    w += __uint_as_float(__builtin_amdgcn_update_dpp(0, __float_as_uint(w), 0x122, 0xf, 0xf, false));
    w += __uint_as_float(__builtin_amdgcn_update_dpp(0, __float_as_uint(w), 0x121, 0xf, 0xf, false));
    s0 = __uint_as_float(__builtin_amdgcn_readlane(__float_as_uint(w), 0));
    s1 = __uint_as_float(__builtin_amdgcn_readlane(__float_as_uint(w), 16));
    s2 = __uint_as_float(__builtin_amdgcn_readlane(__float_as_uint(w), 32));
    s3 = __uint_as_float(__builtin_amdgcn_readlane(__float_as_uint(w), 48));
}
DI void reduce8(float p0, float p1, float p2, float p3, float q0, float q1, float q2, float q3, float& pw, float& s0, float& s1, float& s2, float& s3) {
    auto r = __builtin_amdgcn_permlane32_swap(__float_as_uint(p0), __float_as_uint(p2), false, false);
    auto t = __builtin_amdgcn_permlane32_swap(__float_as_uint(q0), __float_as_uint(q2), false, false);
    const float u0 = __uint_as_float(r[0]) + __uint_as_float(r[1]);
    const float x0 = __uint_as_float(t[0]) + __uint_as_float(t[1]);
    r = __builtin_amdgcn_permlane32_swap(__float_as_uint(p1), __float_as_uint(p3), false, false);
    t = __builtin_amdgcn_permlane32_swap(__float_as_uint(q1), __float_as_uint(q3), false, false);
    const float u1 = __uint_as_float(r[0]) + __uint_as_float(r[1]);
    const float x1 = __uint_as_float(t[0]) + __uint_as_float(t[1]);
    r = __builtin_amdgcn_permlane16_swap(__float_as_uint(u0), __float_as_uint(u1), false, false);
    t = __builtin_amdgcn_permlane16_swap(__float_as_uint(x0), __float_as_uint(x1), false, false);
    float w = __uint_as_float(r[0]) + __uint_as_float(r[1]);
    float y = __uint_as_float(t[0]) + __uint_as_float(t[1]);
    w += __uint_as_float(__builtin_amdgcn_update_dpp(0, __float_as_uint(w), 0x128, 0xf, 0xf, false));
    y += __uint_as_float(__builtin_amdgcn_update_dpp(0, __float_as_uint(y), 0x128, 0xf, 0xf, false));
    w += __uint_as_float(__builtin_amdgcn_update_dpp(0, __float_as_uint(w), 0x124, 0xf, 0xf, false));
    y += __uint_as_float(__builtin_amdgcn_update_dpp(0, __float_as_uint(y), 0x124, 0xf, 0xf, false));
    w += __uint_as_float(__builtin_amdgcn_update_dpp(0, __float_as_uint(w), 0x122, 0xf, 0xf, false));
    y += __uint_as_float(__builtin_amdgcn_update_dpp(0, __float_as_uint(y), 0x122, 0xf, 0xf, false));
    w += __uint_as_float(__builtin_amdgcn_update_dpp(0, __float_as_uint(w), 0x121, 0xf, 0xf, false));
    y += __uint_as_float(__builtin_amdgcn_update_dpp(0, __float_as_uint(y), 0x121, 0xf, 0xf, false));
    pw = w;
    s0 = __uint_as_float(__builtin_amdgcn_readlane(__float_as_uint(y), 0));
    s1 = __uint_as_float(__builtin_amdgcn_readlane(__float_as_uint(y), 16));
    s2 = __uint_as_float(__builtin_amdgcn_readlane(__float_as_uint(y), 32));
    s3 = __uint_as_float(__builtin_amdgcn_readlane(__float_as_uint(y), 48));
}
struct ScanIn { bf16_t kk, bb, k, r, v; float w; };
DI void phase_scan(int l, int c, int dummy = 0) {
    const int lane = TID() & 63, gw = BID() * 8 + (TID() >> 6), nw = gridDim.x * 8;
    const bf16_t* kkb = wsp<bf16_t>(WS_KKB); const bf16_t* bbb = wsp<bf16_t>(WS_BBB); const bf16_t* kfb = wsp<bf16_t>(WS_KF); const bf16_t* rrb = wsp<bf16_t>(WS_RR);
    const bf16_t* vsb = wsp<bf16_t>(l == 0 ? WS_VV : WS_V2); const float* dec = wsp<float>(WS_DEC); float* outb = wsp<float>(WS_OUT); float* state = wsp<float>(WS_STATE);
    for (int item = gw; item < NB * NH * 16; item += nw) {
        const int bh = item >> 4, rg = item & 15, b = bh >> 3, h = bh & 7, i0 = rg * 4;
        float* stp = state + ((size_t)bh * 64 + i0) * 64 + lane;
        float S0 = 0.f, S1 = 0.f, S2 = 0.f, S3 = 0.f;
        if (c > 0) { S0 = stp[0]; S1 = stp[64]; S2 = stp[128]; S3 = stp[192]; }
        const size_t e0 = (size_t)b * SC * 512 + h * 64 + lane;
        const size_t ev = (size_t)b * SC * 512 + h * 64 + i0 + (lane & 3);
        float* op = outb + (size_t)b * SC * 512 + h * 64 + i0 + (lane >> 4);
        ScanIn A[8], B[8];
#define SCAN_LOAD(X, g) do { _Pragma("unroll") for (int j = 0; j < 8; ++j) { const size_t o = (size_t)((g) * 8 + j) * 512; \
            X[j].kk = kkb[e0 + o]; X[j].bb = bbb[e0 + o]; X[j].k = kfb[e0 + o]; X[j].r = rrb[e0 + o]; X[j].w = dec[e0 + o]; X[j].v = vsb[ev + o]; } } while (0)
#define SCAN_STEP1(Xj, kknext, t) do { \
            const float bb = bf2f(Xj.bb), kx = bf2f(Xj.k), rx = bf2f(Xj.r), wx = Xj.w; const unsigned vu = (unsigned)Xj.v << 16; \
            const float v0 = __uint_as_float(__builtin_amdgcn_readlane(vu, 0)), v1 = __uint_as_float(__builtin_amdgcn_readlane(vu, 1)), v2 = __uint_as_float(__builtin_amdgcn_readlane(vu, 2)), v3 = __uint_as_float(__builtin_amdgcn_readlane(vu, 3)); \
            S0 = S0 * wx + (v0 * kx - a0 * bb); S1 = S1 * wx + (v1 * kx - a1 * bb); S2 = S2 * wx + (v2 * kx - a2 * bb); S3 = S3 * wx + (v3 * kx - a3 * bb); \
            float ov; const float kn = (kknext); \
            reduce8(S0 * rx, S1 * rx, S2 * rx, S3 * rx, S0 * kn, S1 * kn, S2 * kn, S3 * kn, ov, a0, a1, a2, a3); \
            if ((lane & 15) == 0) op[(size_t)(t) * 512] = ov; } while (0)
#define SCAN_GROUP(X, Y, g, lastg) do { _Pragma("unroll") for (int j = 0; j < 8; ++j) { \
            const float kkn = (j < 7) ? bf2f(X[j < 7 ? j + 1 : 7].kk) : ((lastg) ? 0.f : bf2f(Y[0].kk)); \
            SCAN_STEP1(X[j], kkn, (g) * 8 + j); } } while (0)
        SCAN_LOAD(A, 0);
        float a0, a1, a2, a3;
        { const float k0 = bf2f(A[0].kk); reduce4(S0 * k0, S1 * k0, S2 * k0, S3 * k0, a0, a1, a2, a3); }
#if DBL_PHASE == 11
        if (dummy == 2) {
            float acc_ = 0.f;
            for (int g = 0; g < SC / 8; g += 2) {
                SCAN_LOAD(B, g + 1);
#pragma unroll
                for (int j = 0; j < 8; ++j) acc_ += bf2f(A[j].kk) + bf2f(A[j].bb) + bf2f(A[j].k) + bf2f(A[j].r) + bf2f(A[j].v) + A[j].w;
                if (g + 2 < SC / 8) SCAN_LOAD(A, g + 2);
#pragma unroll
                for (int j = 0; j < 8; ++j) acc_ += bf2f(B[j].kk) + bf2f(B[j].bb) + bf2f(B[j].k) + bf2f(B[j].r) + bf2f(B[j].v) + B[j].w;
            }
            if (acc_ == 12345.678f) stp[0] = acc_;
            continue;
        }
#endif
#if DBL_PHASE == 12
        if (dummy == 3) {
#pragma unroll
            for (int j = 0; j < 8; ++j) { A[j].kk = (bf16_t)(0x3c00 + lane + j); A[j].bb = (bf16_t)(0x3b00 + lane); A[j].k = (bf16_t)(0x3d00 + j); A[j].r = (bf16_t)(0x3e00 + lane); A[j].v = (bf16_t)(0x3c80 + j); A[j].w = 0.9f; B[j] = A[j]; }
            op = wsp<float>(WS_RAW) + (size_t)item * 4 + (lane >> 4);
            for (int g = 0; g < SC / 8; g += 2) {
                SCAN_GROUP(A, B, 0, false);
                SCAN_GROUP(B, A, 0, false);
            }
            if (S0 + S1 + S2 + S3 == 12345.678f) stp[0] = S0;
            continue;
        }
#endif
        for (int g = 0; g < SC / 8; g += 2) {
            SCAN_LOAD(B, g + 1);
            SCAN_GROUP(A, B, g, false);
            const bool last = (g + 2 >= SC / 8);
            if (!last) SCAN_LOAD(A, g + 2);
            SCAN_GROUP(B, A, g + 1, last);
        }
#undef SCAN_STEP1
#undef SCAN_GROUP
#undef SCAN_LOAD
        if (!dummy) { stp[0] = S0; stp[64] = S1; stp[128] = S2; stp[192] = S3; }
    }
}
typedef short s16x4 __attribute__((ext_vector_type(4)));
#define M16K32(a, b, c) __builtin_amdgcn_mfma_f32_16x16x32_bf16((a), (b), (c), 0, 0, 0)
#define M16K16(a, b, c) __builtin_amdgcn_mfma_f32_16x16x16bf16_1k((a), (b), (c), 0, 0, 0)
DI s16x4 pk4(f32x4 v) { u32x2 u; u[0] = pk2(v[0], v[1]); u[1] = pk2(v[2], v[3]); return __builtin_bit_cast(s16x4, u); }
DI float dpp_shr1(float x, float old) { return __uint_as_float(__builtin_amdgcn_update_dpp(__float_as_uint(old), __float_as_uint(x), 0x111, 0xf, 0xf, false)); }
DI float dpp_shr2(float x, float old) { return __uint_as_float(__builtin_amdgcn_update_dpp(__float_as_uint(old), __float_as_uint(x), 0x112, 0xf, 0xf, false)); }
DI float dpp_shr4(float x, float old) { return __uint_as_float(__builtin_amdgcn_update_dpp(__float_as_uint(old), __float_as_uint(x), 0x114, 0xf, 0xf, false)); }
DI float dpp_shr8(float x, float old) { return __uint_as_float(__builtin_amdgcn_update_dpp(__float_as_uint(old), __float_as_uint(x), 0x118, 0xf, 0xf, false)); }
DI float dpp_bcast15(float x) { return __uint_as_float(__builtin_amdgcn_update_dpp(0, __float_as_uint(x), 0x15F, 0xf, 0xf, false)); }
DI void phase_scan_chunked(int l, int c, LAS unsigned char* lds, bool dummy = false) {
    const int tid = TID(), lane = tid & 63, wave = tid >> 6, r16 = lane & 15, g = lane >> 4;
    if (wave >= 2) return;
    const int item = BID() * 2 + wave;
    if (item >= NB * NH * 4) return;
    const int bh = item >> 2, ig = item & 3, b = bh >> 3, h = bh & 7, i0 = 16 * ig;
    LAS unsigned char* wl = lds + wave * 4096;
    const bf16_t* kkb = wsp<bf16_t>(WS_KKB); const bf16_t* bbb = wsp<bf16_t>(WS_BBB); const bf16_t* kfb = wsp<bf16_t>(WS_KF); const bf16_t* rrb = wsp<bf16_t>(WS_RR);
    const bf16_t* vsb = wsp<bf16_t>(l == 0 ? WS_VV : WS_V2); const float* dec = wsp<float>(WS_DEC); float* outb = wsp<float>(WS_OUT);
    float* stp = wsp<float>(WS_STATE) + ((size_t)bh * 64 + i0 + r16) * 64 + 8 * g;
    f32x4 ST[4];
#pragma unroll
    for (int sg = 0; sg < 4; ++sg) ST[sg] = (c > 0) ? *(const f32x4*)(stp + 32 * (sg >> 1) + 4 * (sg & 1)) : (f32x4){0.f, 0.f, 0.f, 0.f};
    const size_t e0 = ((size_t)b * SC + r16) * 512 + h * 64 + 8 * g;
    const size_t ev = ((size_t)b * SC + 4 * g) * 512 + h * 64 + i0 + r16;
    const size_t eo = ((size_t)b * SC + 4 * g) * 512 + h * 64 + i0 + r16;
    u32x4 rk[2], rb[2], rq[2], rr_[2]; f32x4 rw[4]; bf16_t rv[4];
#define CS_LOAD(blk) do { const size_t o = e0 + (size_t)(blk) * 16 * 512; _Pragma("unroll") for (int s = 0; s < 2; ++s) { \
        rk[s] = *(const u32x4*)(kkb + o + 32 * s); rb[s] = *(const u32x4*)(bbb + o + 32 * s); rq[s] = *(const u32x4*)(kfb + o + 32 * s); rr_[s] = *(const u32x4*)(rrb + o + 32 * s); \
        rw[2 * s] = *(const f32x4*)(dec + o + 32 * s); rw[2 * s + 1] = *(const f32x4*)(dec + o + 32 * s + 4); } \
        _Pragma("unroll") for (int e = 0; e < 4; ++e) rv[e] = vsb[ev + (size_t)(blk) * 16 * 512 + (size_t)e * 512]; } while (0)
    CS_LOAD(0);
    for (int blk = 0; blk < SC / 16; ++blk) {
        float P[16], kap[16], bet[16], kq[16], rt[16];
#pragma unroll
        for (int s = 0; s < 2; ++s)
#pragma unroll
            for (int q = 0; q < 4; ++q) { const int i = 8 * s + 2 * q;
                kap[i] = bflo(rk[s][q]); kap[i + 1] = bfhi(rk[s][q]); bet[i] = bflo(rb[s][q]); bet[i + 1] = bfhi(rb[s][q]);
                kq[i] = bflo(rq[s][q]); kq[i + 1] = bfhi(rq[s][q]); rt[i] = bflo(rr_[s][q]); rt[i + 1] = bfhi(rr_[s][q]);
                P[i] = rw[2 * s + (q >> 1)][2 * (q & 1)]; P[i + 1] = rw[2 * s + (q >> 1)][2 * (q & 1) + 1]; }
        s16x4 Vb; { u32x2 u; u[0] = (unsigned)rv[0] | ((unsigned)rv[1] << 16); u[1] = (unsigned)rv[2] | ((unsigned)rv[3] << 16); Vb = __builtin_bit_cast(s16x4, u); }
        if (blk + 1 < SC / 16) CS_LOAD(blk + 1);
        float P16[16];
        bf16x8 ktp[2], btp[2], kqp[2], rtp[2];
#pragma unroll
        for (int i = 0; i < 16; ++i) { float p = P[i];
            p *= dpp_shr1(p, 1.f); p *= dpp_shr2(p, 1.f); p *= dpp_shr4(p, 1.f); p *= dpp_shr8(p, 1.f);
            const float pm1 = dpp_shr1(p, 1.f); const float inv = frcp(p); const float p16 = dpp_bcast15(p);
            P16[i] = p16; kap[i] *= pm1; bet[i] *= inv; kq[i] *= inv; rt[i] *= p; }
#pragma unroll
        for (int s = 0; s < 2; ++s) { u32x4 a, bb_, cc, dd;
#pragma unroll
            for (int q = 0; q < 4; ++q) { const int i = 8 * s + 2 * q; a[q] = pk2(kap[i], kap[i + 1]); bb_[q] = pk2(bet[i], bet[i + 1]); cc[q] = pk2(kq[i], kq[i + 1]); dd[q] = pk2(rt[i], rt[i + 1]); }
            ktp[s] = __builtin_bit_cast(bf16x8, a); btp[s] = __builtin_bit_cast(bf16x8, bb_); kqp[s] = __builtin_bit_cast(bf16x8, cc); rtp[s] = __builtin_bit_cast(bf16x8, dd); }
#pragma unroll
        for (int s = 0; s < 2; ++s)
#pragma unroll
            for (int hb = 0; hb < 2; ++hb) { const int i = 8 * s + 4 * hb; u32x2 uk, ub;
                uk[0] = pk2(kq[i] * P16[i], kq[i + 1] * P16[i + 1]); uk[1] = pk2(kq[i + 2] * P16[i + 2], kq[i + 3] * P16[i + 3]);
                ub[0] = pk2(bet[i] * P16[i], bet[i + 1] * P16[i + 1]); ub[1] = pk2(bet[i + 2] * P16[i + 2], bet[i + 3] * P16[i + 3]);
                const int off = r16 * 128 + (32 * s + 16 * hb + 4 * g) * 2;
                *(LAS u32x2*)(wl + off) = uk; *(LAS u32x2*)(wl + 2048 + off) = ub; }
        const f32x4 Z = {0.f, 0.f, 0.f, 0.f};
        f32x4 A1a = M16K32(btp[1], ktp[1], M16K32(btp[0], ktp[0], Z));
        f32x4 A1c = M16K32(ktp[1], btp[1], M16K32(ktp[0], btp[0], Z));
        f32x4 A2a = M16K32(kqp[1], ktp[1], M16K32(kqp[0], ktp[0], Z));
        f32x4 B1a = M16K32(btp[1], rtp[1], M16K32(btp[0], rtp[0], Z));
        f32x4 B2a = M16K32(kqp[1], rtp[1], M16K32(kqp[0], rtp[0], Z));
#pragma unroll
        for (int e = 0; e < 4; ++e) { const int s_ = 4 * g + e;
            A1a[e] = (s_ < r16) ? A1a[e] : 0.f; A2a[e] = (s_ < r16) ? A2a[e] : 0.f; A1c[e] = (r16 < s_) ? A1c[e] : 0.f;
            B1a[e] = (s_ <= r16) ? B1a[e] : 0.f; B2a[e] = (s_ <= r16) ? B2a[e] : 0.f; }
        const s16x4 a1a = pk4(A1a), a1c = pk4(A1c);
        const f32x4 M2a = M16K16(a1c, a1a, Z), M2c = M16K16(a1a, a1c, Z);
        const s16x4 m2a = pk4(M2a), m2c = pk4(M2c);
        const f32x4 M4a = M16K16(m2c, m2a, Z), M4c = M16K16(m2a, m2c, Z);
        const s16x4 m4a = pk4(M4a), m4c = pk4(M4c);
        const s16x4 m8a = pk4(M16K16(m4c, m4a, Z));
        s16x4 stb[4];
#pragma unroll
        for (int sg = 0; sg < 4; ++sg) stb[sg] = pk4(ST[sg]);
        f32x4 G = Z, G2 = Z;
#pragma unroll
        for (int sg = 0; sg < 4; ++sg) {
            const s16x4 kf_ = (sg & 1) ? __builtin_shufflevector(ktp[sg >> 1], ktp[sg >> 1], 4, 5, 6, 7) : __builtin_shufflevector(ktp[sg >> 1], ktp[sg >> 1], 0, 1, 2, 3);
            const s16x4 rf_ = (sg & 1) ? __builtin_shufflevector(rtp[sg >> 1], rtp[sg >> 1], 4, 5, 6, 7) : __builtin_shufflevector(rtp[sg >> 1], rtp[sg >> 1], 0, 1, 2, 3);
            G = M16K16(kf_, stb[sg], G); G2 = M16K16(rf_, stb[sg], G2); }
        const f32x4 RHS = M16K16(pk4(A2a), Vb, G);
        const f32x4 X1 = M16K16(m8a, pk4(RHS), RHS);
        const f32x4 X2 = M16K16(m4a, pk4(X1), X1);
        const f32x4 X3 = M16K16(m2a, pk4(X2), X2);
        const f32x4 U = M16K16(pk4(-A1a), pk4(X3), X3);
        const s16x4 un = pk4(-U);
        f32x4 O = M16K16(pk4(B2a), Vb, G2);
        O = M16K16(pk4(B1a), un, O);
        { float* op = outb + eo + (size_t)blk * 16 * 512;
#pragma unroll
          for (int e = 0; e < 4; ++e) op[(size_t)e * 512] = O[e]; }
#pragma unroll
        for (int sg = 0; sg < 4; ++sg) {
#pragma unroll
            for (int e = 0; e < 4; ++e) ST[sg][e] *= P16[8 * (sg >> 1) + 4 * (sg & 1) + e];
            const int toff = (4 * g + (r16 >> 2)) * 128 + 32 * sg + 8 * (r16 & 3);
            const s16x4 kh = __builtin_amdgcn_ds_read_tr16_b64_v4i16((LAS s16x4*)(wl + toff));
            const s16x4 bh_ = __builtin_amdgcn_ds_read_tr16_b64_v4i16((LAS s16x4*)(wl + 2048 + toff));
            ST[sg] = M16K16(kh, Vb, ST[sg]);
            ST[sg] = M16K16(bh_, un, ST[sg]);
        }
    }
#undef CS_LOAD
    if (dummy) return;
#pragma unroll
    for (int sg = 0; sg < 4; ++sg) *(f32x4*)(stp + 32 * (sg >> 1) + 4 * (sg & 1)) = ST[sg];
}
DI float sum8(float v) {
    v += __uint_as_float(__builtin_amdgcn_update_dpp(0, __float_as_uint(v), 0xB1, 0xf, 0xf, false));
    v += __uint_as_float(__builtin_amdgcn_update_dpp(0, __float_as_uint(v), 0x4E, 0xf, 0xf, false));
    v += __uint_as_float(__builtin_amdgcn_update_dpp(0, __float_as_uint(v), 0x141, 0xf, 0xf, false));
    return v;
}
DI void unpk8(const u32x4 u, float* f) {
#pragma unroll
    for (int q = 0; q < 4; ++q) { f[2 * q] = bflo(u[q]); f[2 * q + 1] = bfhi(u[q]); }
}
DI void phase_rwkv_post(int l, int par) {
    const int lane = TID() & 63, gw = BID() * 8 + (TID() >> 6), nw = gridDim.x * 8;
    const float* outb = wsp<float>(WS_OUT); const bf16_t* rrb = wsp<bf16_t>(WS_RR); const bf16_t* kfb = wsp<bf16_t>(WS_KF);
    const bf16_t* vsb = wsp<bf16_t>(l == 0 ? WS_VV : WS_V2); const bf16_t* ggb = wsp<bf16_t>(WS_GG); bf16_t* orw = wsp<bf16_t>(WS_ORW + par * PAR_O);
    float lw[8], lb[8], rkc[8];
    { const float* lnw = KP()->in[I_LNW] + l * 512 + 8 * lane; const float* lnb = KP()->in[I_LNB] + l * 512 + 8 * lane; const float* rk = KP()->in[I_RK] + l * 512 + 8 * lane;
#pragma unroll
      for (int e = 0; e < 8; ++e) { lw[e] = lnw[e]; lb[e] = lnb[e]; rkc[e] = rk[e]; } }
    for (int row = gw; row < TC; row += nw) {
        const size_t e0 = (size_t)row * 512 + 8 * lane;
        const f32x4 o0 = *(const f32x4*)(outb + e0), o1 = *(const f32x4*)(outb + e0 + 4);
        float o[8] = {o0[0], o0[1], o0[2], o0[3], o1[0], o1[1], o1[2], o1[3]}, r[8], k[8], v[8], g[8];
        unpk8(*(const u32x4*)(rrb + e0), r); unpk8(*(const u32x4*)(kfb + e0), k); unpk8(*(const u32x4*)(vsb + e0), v); unpk8(*(const u32x4*)(ggb + e0), g);
        float s = 0.f, bo = 0.f;
#pragma unroll
        for (int e = 0; e < 8; ++e) { s += o[e]; bo += r[e] * k[e] * rkc[e]; }
        const float mean = sum8(s) * (1.f / 64.f); const float bonus = sum8(bo);
        float q = 0.f;
#pragma unroll
        for (int e = 0; e < 8; ++e) { o[e] -= mean; q += o[e] * o[e]; }
        const float rs = __builtin_amdgcn_rsqf(sum8(q) * (1.f / 64.f) + 64e-5f);
        u32x4 w;
#pragma unroll
        for (int p = 0; p < 4; ++p) { float y0 = (o[2 * p] * rs * lw[2 * p] + lb[2 * p] + bonus * v[2 * p]) * g[2 * p], y1 = (o[2 * p + 1] * rs * lw[2 * p + 1] + lb[2 * p + 1] + bonus * v[2 * p + 1]) * g[2 * p + 1]; w[p] = pk2(y0, y1); }
        *(u32x4*)(orw + e0) = w;
    }
}

#define MFMA32(a, b, c) __builtin_amdgcn_mfma_f32_32x32x16_bf16((a), (b), (c), 0, 0, 0)
DI unsigned fkey(float v) { v = v + 0.f; const unsigned u = __float_as_uint(v); return (u & 0x80000000u) ? ~u : (u | 0x80000000u); }
DI int half_sum(int x) {
    x += __builtin_amdgcn_update_dpp(0, x, 0x128, 0xf, 0xf, false);
    x += __builtin_amdgcn_update_dpp(0, x, 0x124, 0xf, 0xf, false);
    x += __builtin_amdgcn_update_dpp(0, x, 0x122, 0xf, 0xf, false);
    x += __builtin_amdgcn_update_dpp(0, x, 0x121, 0xf, 0xf, false);
    auto r = __builtin_amdgcn_permlane16_swap((unsigned)x, (unsigned)x, false, false);
    return (int)(r[0] + r[1]);
}
DI void dsa_select_half(int c, int item4, int set, int lane) {
    int lz = lane; asm volatile("" : "+v"(lz));
    const int hh = lz >> 5, r5 = lz & 31;
    const int rc0 = item4 * 4, b = rc0 >> 9, t0 = c * SC + (rc0 & 511);
    const int qq = ((r5 >> 2) & 1) + 2 * ((r5 >> 4) ^ set), hd = (r5 & 3) + 4 * ((r5 >> 3) & 1);
    const bf16_t* qp = wsp<bf16_t>(WS_IDXQ) + (size_t)(rc0 + qq) * 256 + hd * 32 + 8 * hh;
    const bf16x8 Af0 = *(const bf16x8*)qp, Af1 = *(const bf16x8*)(qp + 16);
    const int tA = t0 + hh + 2 * set;
    const float* wp = wsp<float>(WS_IDXW) + ((size_t)b * SEQ + tA) * 8;
    const f32x4 wa0 = *(const f32x4*)wp, wa1 = *(const f32x4*)(wp + 4);
    const int ngrp = ((t0 + 2 * set + 1) >> 9) + 1;
    unsigned keyA[64];
    const bf16_t* kbase = wsp<bf16_t>(WS_IDXK) + ((size_t)b * SEQ + r5) * 32 + 8 * hh;
    int keyv = r5; unsigned kofs = 0u;
    bf16x8 Bn0 = *(const bf16x8*)kbase, Bn1 = *(const bf16x8*)(kbase + 16);
#pragma unroll
    for (int g = 0; g < 4; ++g) {
        if (g < ngrp) {
#pragma unroll
            for (int j = 0; j < 16; ++j) {
                const int kt = g * 16 + j;
                const bf16x8 Bf0 = Bn0, Bf1 = Bn1;
                { const unsigned nofs = (kt < 63) ? kofs + 32 * 32 : kofs; const bf16_t* kp = kbase + nofs; Bn0 = *(const bf16x8*)kp; Bn1 = *(const bf16x8*)(kp + 16); }
                f32x16 C = {0.f, 0.f, 0.f, 0.f, 0.f, 0.f, 0.f, 0.f, 0.f, 0.f, 0.f, 0.f, 0.f, 0.f, 0.f, 0.f};
                C = MFMA32(Af0, Bf0, C); C = MFMA32(Af1, Bf1, C);
                float va = 0.f;
#pragma unroll
                for (int i = 0; i < 4; ++i) va = __builtin_fmaf(__builtin_amdgcn_fmed3f(C[i], 0.f, 3.0e38f), wa0[i], va);
#pragma unroll
                for (int i = 0; i < 4; ++i) va = __builtin_fmaf(__builtin_amdgcn_fmed3f(C[4 + i], 0.f, 3.0e38f), wa1[i], va);
                unsigned ka = (keyv <= tA) ? fkey(va) : 0u;
                asm volatile("" : "+v"(ka), "+v"(keyv), "+v"(kofs));
                keyA[kt] = ka;
                keyv += 32; kofs += 32 * 32;
            }
        } else {
#pragma unroll
            for (int j = 0; j < 16; ++j) keyA[g * 16 + j] = 0u;
        }
    }
    unsigned KA = 0u;
    if (t0 + 2 * set + 1 >= 256) {
        bool dA = tA < 255;
        for (int bit = 31; bit >= 0; --bit) {
            const unsigned cA = KA | (1u << bit);
            int nA = 0;
#pragma unroll
            for (int g = 0; g < 4; ++g) {
                if (g < ngrp) {
#pragma unroll
                    for (int j = 0; j < 16; ++j) nA += (keyA[g * 16 + j] >= cA) ? 1 : 0;
                }
            }
            nA = half_sum(nA);
            if (!dA && nA >= 256) KA = cA;
            dA = dA || (nA == 256);
            if (__ballot(dA) == ~0ull) break;
        }
    }
    int gA = 0;
#pragma unroll
    for (int kt = 0; kt < 64; ++kt) gA += (keyA[kt] > KA) ? 1 : 0;
    gA = half_sum(gA);
    const int needA = (KA == 0u) ? 0 : 256 - gA;
    asm volatile("" : "+v"(KA));
    int runA = 0, lsel = lz;
    unsigned w0 = 0u, w1 = 0u;
#pragma unroll
    for (int kt = 0; kt < 64; ++kt) {
        const bool eqA = keyA[kt] == KA;
        const unsigned long long ea = __ballot(eqA);
        const int rkA = runA + (hh ? (int)__builtin_amdgcn_mbcnt_hi((unsigned)(ea >> 32), 0u) : (int)__builtin_amdgcn_mbcnt_lo((unsigned)ea, 0u));
        const bool sA = (keyA[kt] > KA) || (eqA && rkA < needA);
        runA += hh ? __builtin_popcount((unsigned)(ea >> 32)) : __builtin_popcount((unsigned)ea);
        const unsigned long long sa = __ballot(sA);
        if (lsel == 0) { w0 = (unsigned)sa; w1 = (unsigned)(sa >> 32); }
        lsel -= 1; asm volatile("" : "+v"(lsel));
        __builtin_amdgcn_sched_barrier(0);
    }
    unsigned* sp = wsp<unsigned>(WS_SELB) + (size_t)(rc0 + 2 * set) * 64 + lz;
    sp[0] = w0; sp[64] = w1;
}
DI void dsa_select_full(int c, int item, int lane) {
    {
        int lz = lane; asm volatile("" : "+v"(lz));
        const int hh = lz >> 5, r5 = lz & 31;
        const int rc0 = item * 4, b = rc0 >> 9, t0 = c * SC + (rc0 & 511);
        const int qq = ((r5 >> 2) & 1) + 2 * (r5 >> 4), hd = (r5 & 3) + 4 * ((r5 >> 3) & 1);
        const bf16_t* qp = wsp<bf16_t>(WS_IDXQ) + (size_t)(rc0 + qq) * 256 + hd * 32 + 8 * hh;
        const bf16x8 Af0 = *(const bf16x8*)qp, Af1 = *(const bf16x8*)(qp + 16);
        const float* wp = wsp<float>(WS_IDXW) + ((size_t)b * SEQ + t0 + hh) * 8;
        const f32x4 wa0 = *(const f32x4*)wp, wa1 = *(const f32x4*)(wp + 4), wb0 = *(const f32x4*)(wp + 16), wb1 = *(const f32x4*)(wp + 20);
        const int tA = t0 + hh, tB = t0 + hh + 2;
        const int ngrp = ((t0 + 3) >> 9) + 1;
        unsigned keyA[64], keyB[64];
        const bf16_t* kbase = wsp<bf16_t>(WS_IDXK) + ((size_t)b * SEQ + r5) * 32 + 8 * hh;
        int keyv = r5;
        unsigned kofs = 0u;
        bf16x8 Bn0 = *(const bf16x8*)kbase, Bn1 = *(const bf16x8*)(kbase + 16);
#pragma unroll
        for (int g = 0; g < 4; ++g) {
            if (g < ngrp) {
#pragma unroll
                for (int j = 0; j < 16; ++j) {
                    const int kt = g * 16 + j;
                    const bf16x8 Bf0 = Bn0, Bf1 = Bn1;
                    { const unsigned nofs = (kt < 63) ? kofs + 32 * 32 : kofs; const bf16_t* kp = kbase + nofs; Bn0 = *(const bf16x8*)kp; Bn1 = *(const bf16x8*)(kp + 16); }
                    f32x16 C = {0.f, 0.f, 0.f, 0.f, 0.f, 0.f, 0.f, 0.f, 0.f, 0.f, 0.f, 0.f, 0.f, 0.f, 0.f, 0.f};
                    C = MFMA32(Af0, Bf0, C); C = MFMA32(Af1, Bf1, C);
                    float va = 0.f, vb = 0.f;
#pragma unroll
                    for (int i = 0; i < 4; ++i) { va = __builtin_fmaf(__builtin_amdgcn_fmed3f(C[i], 0.f, 3.0e38f), wa0[i], va); vb = __builtin_fmaf(__builtin_amdgcn_fmed3f(C[8 + i], 0.f, 3.0e38f), wb0[i], vb); }
#pragma unroll
                    for (int i = 0; i < 4; ++i) { va = __builtin_fmaf(__builtin_amdgcn_fmed3f(C[4 + i], 0.f, 3.0e38f), wa1[i], va); vb = __builtin_fmaf(__builtin_amdgcn_fmed3f(C[12 + i], 0.f, 3.0e38f), wb1[i], vb); }
                    unsigned ka = (keyv <= tA) ? fkey(va) : 0u, kb = (keyv <= tB) ? fkey(vb) : 0u;
                    asm volatile("" : "+v"(ka), "+v"(kb), "+v"(keyv), "+v"(kofs));
                    keyA[kt] = ka; keyB[kt] = kb;
                    keyv += 32; kofs += 32 * 32;
                }
            } else {
#pragma unroll
                for (int j = 0; j < 16; ++j) { keyA[g * 16 + j] = 0u; keyB[g * 16 + j] = 0u; }
            }
        }
        unsigned KA = 0u, KB = 0u;
        if (t0 + 3 >= 256) {
            bool dA = false, dB = false;
            for (int bit = 31; bit >= 0; --bit) {
                const unsigned bm = 1u << bit;
                const unsigned cA = KA | bm, cB = KB | bm;
                int nA = 0, nB = 0;
#pragma unroll
                for (int g = 0; g < 4; ++g) {
                    if (g < ngrp) {
#pragma unroll
                        for (int j = 0; j < 16; ++j) { nA += (keyA[g * 16 + j] >= cA) ? 1 : 0; nB += (keyB[g * 16 + j] >= cB) ? 1 : 0; }
                    }
                }
                nA = half_sum(nA); nB = half_sum(nB);
                if (!dA && nA >= 256) KA = cA;
                if (!dB && nB >= 256) KB = cB;
                dA = dA || (nA == 256); dB = dB || (nB == 256);
                if (__ballot(dA && dB) == ~0ull) break;
            }
        }
        int gA = 0, gB = 0;
#pragma unroll
        for (int kt = 0; kt < 64; ++kt) { gA += (keyA[kt] > KA) ? 1 : 0; gB += (keyB[kt] > KB) ? 1 : 0; }
        gA = half_sum(gA); gB = half_sum(gB);
        const int needA = (KA == 0u) ? 0 : 256 - gA, needB = (KB == 0u) ? 0 : 256 - gB;
        asm volatile("" : "+v"(KA), "+v"(KB));
        int runA = 0, runB = 0, lsel = lz;
        unsigned w0 = 0u, w1 = 0u, w2 = 0u, w3 = 0u;
#pragma unroll
        for (int kt = 0; kt < 64; ++kt) {
            const bool eqA = keyA[kt] == KA, eqB = keyB[kt] == KB;
            const unsigned long long ea = __ballot(eqA), eb = __ballot(eqB);
            const int rkA = runA + (hh ? (int)__builtin_amdgcn_mbcnt_hi((unsigned)(ea >> 32), 0u) : (int)__builtin_amdgcn_mbcnt_lo((unsigned)ea, 0u));
            const int rkB = runB + (hh ? (int)__builtin_amdgcn_mbcnt_hi((unsigned)(eb >> 32), 0u) : (int)__builtin_amdgcn_mbcnt_lo((unsigned)eb, 0u));
            const bool sA = (keyA[kt] > KA) || (eqA && rkA < needA), sB = (keyB[kt] > KB) || (eqB && rkB < needB);
            runA += hh ? __builtin_popcount((unsigned)(ea >> 32)) : __builtin_popcount((unsigned)ea);
            runB += hh ? __builtin_popcount((unsigned)(eb >> 32)) : __builtin_popcount((unsigned)eb);
            const unsigned long long sa = __ballot(sA), sb = __ballot(sB);
            if (lsel == 0) { w0 = (unsigned)sa; w1 = (unsigned)(sa >> 32); w2 = (unsigned)sb; w3 = (unsigned)(sb >> 32); }
            lsel -= 1; asm volatile("" : "+v"(lsel));
            __builtin_amdgcn_sched_barrier(0);
        }
        unsigned* sp = wsp<unsigned>(WS_SELB) + (size_t)rc0 * 64 + lz;
        sp[0] = w0; sp[64] = w1; sp[128] = w2; sp[192] = w3;
    }
}

DI void phase_dsa_select_queue(int c, LAS unsigned* ctr) {
    const int lane = TID() & 63;
    const int base = BID() * 8;
    for (;;) {
        unsigned idx = 0u;
        if (lane == 0) idx = __hip_atomic_fetch_add(ctr, 1u, __ATOMIC_RELAXED, __HIP_MEMORY_SCOPE_WORKGROUP);
        idx = (unsigned)__builtin_amdgcn_readfirstlane((int)idx);
        if (idx >= 8u) break;
        const int item4 = base + (int)idx;
        if (item4 < TC / 4) dsa_select_full(c, item4, lane);
    }
}

struct AttnSt { f32x16 O0, O1; float m, l; };
constexpr float C2 = 0.125f * LOG2E;
DI void attn_load_kv(bf16x8 (&Kf)[4], bf16x8 (&Vf)[2][2], const bf16_t* kbase, const bf16_t* vtbase, int key0, int lane) {
    const int r5 = lane & 31;
    const int prow = (r5 & 19) | ((r5 & 4) << 1) | ((r5 & 8) >> 1);
    const bf16_t* kp = kbase + (size_t)(key0 + prow) * 512;
#pragma unroll
    for (int s = 0; s < 4; ++s) Kf[s] = *(const bf16x8*)(kp + 16 * s);
#pragma unroll
    for (int n = 0; n < 2; ++n)
#pragma unroll
        for (int s = 0; s < 2; ++s) Vf[n][s] = *(const bf16x8*)(vtbase + (size_t)(32 * n) * SEQ + key0 + 16 * s);
}
template <int MODE, bool FAR>
DI void attn_tile(AttnSt& st, const bf16x8 (&Qf)[4], const bf16x8 (&Kf)[4], const bf16x8 (&Vf)[2][2], int key0, int tq, bool allowed, unsigned word, LAS const float* bt, float ub, int lane) {
    const int hh = lane >> 5;
    f32x16 S = {0.f, 0.f, 0.f, 0.f, 0.f, 0.f, 0.f, 0.f, 0.f, 0.f, 0.f, 0.f, 0.f, 0.f, 0.f, 0.f};
#pragma unroll
    for (int s = 0; s < 4; ++s) S = MFMA32(Kf[s], Qf[s], S);
    const unsigned wsh = word >> (8 * hh);
    float ps = 0.f; float pv[16];
    if (FAR) {
        const float cb = (MODE == 0 && !allowed) ? -INFINITY : (bt[127] - ub);
#pragma unroll
        for (int i = 0; i < 16; ++i) {
            float p = fexp2(S[i] * C2 + cb);
            if (MODE == 1) p = __uint_as_float(__float_as_uint(p) & (unsigned)__builtin_amdgcn_sbfe((int)wsh, 16 * (i >> 3) + (i & 7), 1));
            pv[i] = p; ps += p;
        }
    } else {
#pragma unroll
        for (int i = 0; i < 16; ++i) {
            const int koff = 16 * (i >> 3) + 8 * hh + (i & 7);
            const int dist = tq - (key0 + koff);
            const bool ok = (MODE == 0) ? (allowed && dist >= 0) : (((wsh >> (16 * (i >> 3) + (i & 7))) & 1u) != 0u);
            const float p = fexp2(S[i] * C2 + (bt[min(max(dist, 0), 127)] - ub));
            pv[i] = ok ? p : 0.f; ps += pv[i];
        }
    }
    st.l += ps;
#pragma unroll
    for (int s = 0; s < 2; ++s) {
        u32x4 pw; pw[0] = pk2(pv[8 * s], pv[8 * s + 1]); pw[1] = pk2(pv[8 * s + 2], pv[8 * s + 3]); pw[2] = pk2(pv[8 * s + 4], pv[8 * s + 5]); pw[3] = pk2(pv[8 * s + 6], pv[8 * s + 7]);
        const bf16x8 Pf = __builtin_bit_cast(bf16x8, pw);
        st.O0 = MFMA32(Vf[0][s], Pf, st.O0); st.O1 = MFMA32(Vf[1][s], Pf, st.O1);
    }
}
constexpr int AT_ROW = 144, AT_KV = 64 * AT_ROW, AT_STAGE = 2 * AT_KV;
template <int MODE>
DI void attn_pair_far(AttnSt& st, const bf16x8 (&Qf)[4], LAS const unsigned char* ks, LAS const unsigned char* vs, int kofs, int vofs, bool allowed, unsigned w0, unsigned w1, float cb, int lane) {
    const int hh = lane >> 5;
    bf16x8 K0[4], K1[4], V0[2][2], V1[2][2];
#pragma unroll
    for (int s = 0; s < 4; ++s) { K0[s] = *(LAS const bf16x8*)(ks + kofs + 32 * s); K1[s] = *(LAS const bf16x8*)(ks + 32 * AT_ROW + kofs + 32 * s); }
#pragma unroll
    for (int n = 0; n < 2; ++n)
#pragma unroll
        for (int s = 0; s < 2; ++s) { V0[n][s] = *(LAS const bf16x8*)(vs + 32 * n * AT_ROW + vofs + 32 * s); V1[n][s] = *(LAS const bf16x8*)(vs + 32 * n * AT_ROW + vofs + 64 + 32 * s); }
    f32x16 S0 = {0.f, 0.f, 0.f, 0.f, 0.f, 0.f, 0.f, 0.f, 0.f, 0.f, 0.f, 0.f, 0.f, 0.f, 0.f, 0.f}, S1 = S0;
#pragma unroll
    for (int s = 0; s < 4; ++s) { S0 = MFMA32(K0[s], Qf[s], S0); S1 = MFMA32(K1[s], Qf[s], S1); }
    const float cbe = (MODE == 0 && !allowed) ? -INFINITY : cb;
    const unsigned wa = w0 >> (8 * hh), wb = w1 >> (8 * hh);
    float ps = 0.f; float p0[16], p1[16];
#pragma unroll
    for (int i = 0; i < 16; ++i) {
        float a = fexp2(S0[i] * C2 + cbe), b = fexp2(S1[i] * C2 + cbe);
        if (MODE == 1) { a = __uint_as_float(__float_as_uint(a) & (unsigned)__builtin_amdgcn_sbfe((int)wa, 16 * (i >> 3) + (i & 7), 1));
                         b = __uint_as_float(__float_as_uint(b) & (unsigned)__builtin_amdgcn_sbfe((int)wb, 16 * (i >> 3) + (i & 7), 1)); }
        p0[i] = a; p1[i] = b; ps += a + b;
    }
    st.l += ps;
#pragma unroll
    for (int s = 0; s < 2; ++s) {
        u32x4 pw; pw[0] = pk2(p0[8 * s], p0[8 * s + 1]); pw[1] = pk2(p0[8 * s + 2], p0[8 * s + 3]); pw[2] = pk2(p0[8 * s + 4], p0[8 * s + 5]); pw[3] = pk2(p0[8 * s + 6], p0[8 * s + 7]);
        const bf16x8 Pf = __builtin_bit_cast(bf16x8, pw);
        st.O0 = MFMA32(V0[0][s], Pf, st.O0); st.O1 = MFMA32(V0[1][s], Pf, st.O1);
    }
#pragma unroll
    for (int s = 0; s < 2; ++s) {
        u32x4 pw; pw[0] = pk2(p1[8 * s], p1[8 * s + 1]); pw[1] = pk2(p1[8 * s + 2], p1[8 * s + 3]); pw[2] = pk2(p1[8 * s + 4], p1[8 * s + 5]); pw[3] = pk2(p1[8 * s + 6], p1[8 * s + 7]);
        const bf16x8 Pf = __builtin_bit_cast(bf16x8, pw);
        st.O0 = MFMA32(V1[0][s], Pf, st.O0); st.O1 = MFMA32(V1[1][s], Pf, st.O1);
    }
}
template <int MODE>
DI void attn_block(int c, int b, int h, int half, LAS unsigned char* stg, LAS unsigned* uni, LAS const float* bt, float kbound, float bmax, bool dummy) {
    const int tid = TID(), lane = tid & 63, wave = tid >> 6, r5 = lane & 31, hh = lane >> 5;
    bf16_t* qbuf = wsp<bf16_t>((MODE == 0 ? WS_MQ : WS_DQ) + (c & 1) * PAR_O);
    const int tb = c * SC + 256 * half, t0 = tb + 32 * wave, tq = t0 + r5, rowc0 = b * SC + 256 * half + 32 * wave;
    bf16_t* qp = qbuf + (size_t)(rowc0 + r5) * 512 + h * 64;
    bf16x8 Qf[4];
#pragma unroll
    for (int s = 0; s < 4; ++s) Qf[s] = *(const bf16x8*)(qp + 16 * s + 8 * hh);
    AttnSt st; st.m = 0.f; st.l = 0.f;
#pragma unroll
    for (int i = 0; i < 16; ++i) { st.O0[i] = 0.f; st.O1[i] = 0.f; }
    float ub;
    { float q2 = 0.f;
#pragma unroll
      for (int s = 0; s < 4; ++s)
#pragma unroll
          for (int j = 0; j < 8; ++j) { const float v = bf2f((bf16_t)Qf[s][j]); q2 += v * v; }
      q2 += __shfl_xor(q2, 32);
      ub = sqrtf(q2) * kbound * C2 + bmax; }
    const int ktl = (t0 + 31) >> 5;
    const int own = tb >> 8;
    unsigned bm = 0u, anyw = 0xffu;
    if (MODE == 0) {
        if (own > 0) {
            const float* km = wsp<float>(WS_KMEAN) + ((size_t)(b * 8 + h) * 8) * 64 + 8 * hh;
            float g[8];
#pragma unroll
            for (int n = 0; n < 8; ++n) {
                g[n] = -INFINITY;
                if (n < own) {
                    float part = 0.f;
#pragma unroll
                    for (int s = 0; s < 4; ++s) { const f32x4 k0 = *(const f32x4*)(km + n * 64 + 16 * s), k1 = *(const f32x4*)(km + n * 64 + 16 * s + 4);
#pragma unroll
                        for (int j = 0; j < 4; ++j) part += bf2f((bf16_t)Qf[s][j]) * k0[j] + bf2f((bf16_t)Qf[s][4 + j]) * k1[j]; }
                    g[n] = part + __shfl_xor(part, 32);
                }
            }
#pragma unroll
            for (int n = 0; n < 8; ++n) {
                if (n < own) { int rank = 0;
#pragma unroll
                    for (int m2 = 0; m2 < 8; ++m2) if (m2 != n && m2 < own) rank += ((g[m2] > g[n]) || (g[m2] == g[n] && m2 < n)) ? 1 : 0;
                    if (rank < 3) bm |= 1u << n; }
            }
        }
        anyw = 1u << own;
#pragma unroll
        for (int n = 0; n < 8; ++n) if (n < own && __ballot((bm >> n) & 1u) != 0ull) anyw |= 1u << n;
    }
    if (tid == 0) uni[0] = 0u;
    __syncthreads();
    if (lane == 0) __hip_atomic_fetch_or(uni, anyw, __ATOMIC_RELAXED, __HIP_MEMORY_SCOPE_WORKGROUP);
    __syncthreads();
    const unsigned anyb = MODE == 0 ? uni[0] : 0xffu;
    const int lrow = tid >> 3, lpart = tid & 7;
    const bf16_t* kg = wsp<bf16_t>(MODE == 0 ? WS_MK : WS_DK) + ((size_t)b * SEQ + lrow) * 512 + h * 64 + lpart * 8;
    const bf16_t* vg = wsp<bf16_t>(MODE == 0 ? WS_MVT : WS_DVT) + ((size_t)b * 512 + h * 64 + lrow) * SEQ + lpart * 8;
    const int lofs = lrow * AT_ROW + lpart * 16;
    const int prow = (r5 & 19) | ((r5 & 4) << 1) | ((r5 & 8) >> 1);
    const int kofs = prow * AT_ROW + 16 * hh, vofs = r5 * AT_ROW + 16 * hh;
    const unsigned* sp = wsp<unsigned>(WS_SELB) + (size_t)(rowc0 + r5) * 64;
    const int nst = (tb + 256) >> 6;
    int stp = 0;
    if (MODE == 0) { while (!((anyb >> (stp >> 2)) & 1u)) stp += 4; }
    u32x4 kreg = *(const u32x4*)(kg + (size_t)(stp * 64) * 512), vreg = *(const u32x4*)(vg + stp * 64);
    *(LAS u32x4*)(stg + lofs) = kreg; *(LAS u32x4*)(stg + AT_KV + lofs) = vreg;
    u32x2 wcur = {0u, 0u}, wnxt = {0u, 0u};
    if (MODE == 1) wcur = *(const u32x2*)(sp + 2 * stp);
    __syncthreads();
    int cur = 0;
    while (stp < nst) {
        int nx = stp + 1;
        if (MODE == 0) { while (nx < nst && !((anyb >> (nx >> 2)) & 1u)) nx += 4 - (nx & 3); }
        const bool more = nx < nst;
        if (more) { kreg = *(const u32x4*)(kg + (size_t)(nx * 64) * 512); vreg = *(const u32x4*)(vg + nx * 64); if (MODE == 1) wnxt = *(const u32x2*)(sp + 2 * nx); }
        LAS const unsigned char* ks = stg + cur * AT_STAGE; LAS const unsigned char* vs = ks + AT_KV;
        const int nbs = stp >> 2;
        const bool won = (MODE == 1) || (((anyw >> nbs) & 1u) != 0u);
        if (won && (2 * stp + 1 <= ktl) && (t0 - (stp * 64 + 63) >= 113)) {
            const bool allowed = (MODE == 0) ? ((nbs == own) || (((bm >> nbs) & 1u) != 0u)) : true;
            attn_pair_far<MODE>(st, Qf, ks, vs, kofs, vofs, allowed, wcur[0], wcur[1], bt[127] - ub, lane);
        } else {
#pragma unroll
        for (int u = 0; u < 2; ++u) {
            const int kt = 2 * stp + u, key0 = kt * 32, nb = kt >> 3;
            const bool waveon = (kt <= ktl) && (MODE == 1 || ((anyw >> nb) & 1u));
            if (waveon) {
                bf16x8 Kf[4], Vf[2][2];
#pragma unroll
                for (int s = 0; s < 4; ++s) Kf[s] = *(LAS const bf16x8*)(ks + 32 * u * AT_ROW + kofs + 32 * s);
#pragma unroll
                for (int n = 0; n < 2; ++n)
#pragma unroll
                    for (int s = 0; s < 2; ++s) Vf[n][s] = *(LAS const bf16x8*)(vs + 32 * n * AT_ROW + vofs + 64 * u + 32 * s);
                const unsigned word = (MODE == 1) ? wcur[u] : 0u;
                const bool allowed = (MODE == 0) ? ((nb == own) || (((bm >> nb) & 1u) != 0u)) : true;
                if (t0 - (key0 + 31) >= 113) attn_tile<MODE, true>(st, Qf, Kf, Vf, key0, tq, allowed, word, bt, ub, lane);
                else attn_tile<MODE, false>(st, Qf, Kf, Vf, key0, tq, allowed, word, bt, ub, lane);
            }
        }
        }
        if (more) { LAS unsigned char* ws_ = stg + (cur ^ 1) * AT_STAGE; *(LAS u32x4*)(ws_ + lofs) = kreg; *(LAS u32x4*)(ws_ + AT_KV + lofs) = vreg; }
        __syncthreads();
        cur ^= 1; stp = nx; wcur = wnxt;
    }
    const float lt = st.l + __shfl_xor(st.l, 32);
    const float inv = 1.f / lt;
    if (dummy) qp = wsp<bf16_t>(WS_RAW + (MODE ? 8 * MiB : 0)) + (size_t)(rowc0 + r5) * 512 + h * 64;
#pragma unroll
    for (int g4 = 0; g4 < 4; ++g4) {
        st_bf4(qp + 8 * g4 + 4 * hh, (f32x4){st.O0[4 * g4] * inv, st.O0[4 * g4 + 1] * inv, st.O0[4 * g4 + 2] * inv, st.O0[4 * g4 + 3] * inv});
        st_bf4(qp + 32 + 8 * g4 + 4 * hh, (f32x4){st.O1[4 * g4] * inv, st.O1[4 * g4 + 1] * inv, st.O1[4 * g4 + 2] * inv, st.O1[4 * g4 + 3] * inv});
    }
    __syncthreads();
}
__device__ const unsigned char kBucket[128] = {0,1,2,3,4,5,6,7,8,9,10,11,12,13,14,15,16,16,16,17,17,18,18,18,19,19,19,20,20,20,20,21,21,21,21,22,22,22,22,22,23,23,23,23,23,23,24,24,24,24,24,24,25,25,25,25,25,25,25,26,26,26,26,26,26,26,26,27,27,27,27,27,27,27,27,27,27,28,28,28,28,28,28,28,28,28,28,29,29,29,29,29,29,29,29,29,29,29,29,30,30,30,30,30,30,30,30,30,30,30,30,30,30,31,31,31,31,31,31,31,31,31,31,31,31,31,31,31};
DI void phase_attn(int l, int c, LAS float* lds, bool dummy = false) {
    const int tid = TID();
    for (int e = tid; e < 2 * 8 * 128; e += 512) { const int d = e & 127, h = (e >> 7) & 7, mx = e >> 10; lds[e] = KP()->in[I_REL][kBucket[d] * 16 + mx * 8 + h] * LOG2E; }
    if (tid < 2) { const float* g = KP()->in[I_QKN] + l * 256 + (tid == 0 ? 64 : 192); float m = 0.f; for (int i = 0; i < 64; ++i) m = fmaxf(m, fabsf(g[i])); lds[2048 + tid] = 8.1f * m; }
    if (tid >= 64 && tid < 80) { const int mx = (tid - 64) >> 3, h = (tid - 64) & 7; float m = 0.f; for (int k = 0; k < 32; ++k) m = fmaxf(m, fabsf(KP()->in[I_REL][k * 16 + mx * 8 + h])); lds[2064 + (tid - 64)] = m * LOG2E; }
    __syncthreads();
    LAS unsigned char* stg = (LAS unsigned char*)lds + 16384; LAS unsigned* uni = (LAS unsigned*)((LAS unsigned char*)lds + 8192 + 256);
    for (int it = BID(); it < NB * NH * 2; it += gridDim.x) {
        const int bh = it >> 1, b = bh >> 3, h = bh & 7, hf = it & 1;
        attn_block<0>(c, b, h, hf, stg, uni, lds + h * 128, lds[2048], lds[2064 + h], dummy);
        attn_block<1>(c, b, h, hf ^ 1, stg, uni, lds + 1024 + h * 128, lds[2049], lds[2072 + h], dummy);
    }
    if (!dummy) { phase_rwkv_post(l, c & 1); if (DBL_PHASE == 24) phase_rwkv_post(l, c & 1); }
}

constexpr int LDS_BYTES = pg8::STAGE_BYTES + 256;
constexpr int PH_PER_LAYER = 32, N_PHASES = 2 * PH_PER_LAYER;
#ifndef DBL_PHASE
#define DBL_PHASE 0
#endif
#ifndef MK_ONE_LAUNCH
#define MK_ONE_LAUNCH 1
#endif
__global__ void __launch_bounds__(512, 2) mega(Params p) {
    extern __shared__ __attribute__((aligned(16))) unsigned char lds_raw[];
    LAS unsigned char* lds = (LAS unsigned char*)lds_raw;
    volatile LAS unsigned* bst = (volatile LAS unsigned*)(lds + pg8::STAGE_BYTES);
    if (TID() < 4) bst[TID()] = 0u;
    __syncthreads();
    if (p.ph_hi - p.ph_lo > 1) (void)xcd_barrier_post((unsigned*)(KP()->ws + WS_CTL), bst);
#ifndef PH_ONLY
#define PH_ONLY -1
#endif
#define IN(k) (KP()->ph_lo <= (k) && (k) < KP()->ph_hi)
#define INT(tag, k) ((PH_ONLY < 0 || PH_ONLY == (tag)) && IN(k))
#define SEAM(k) do { if (IN(k) && IN((k) + 1)) { XcdBarrier bar_; bar_.bar = (unsigned*)(KP()->ws + WS_CTL); bar_.x = xb_xcc_id(); bar_.st = (volatile LAS unsigned*)(lds + pg8::STAGE_BYTES); xcd_barrier(bar_); if (DBL_PHASE == 20) xcd_barrier(bar_); } } while (0)
    for (int l = 0; l < 2; ++l) {
        const int pb = PH_PER_LAYER * l;
        if (INT(0, pb + 0)) {
#if DBL_PHASE == 6
            phase_conv(l, (LAS float*)lds);
#endif
            phase_conv(l, (LAS float*)lds);
#if DBL_PHASE == 7
            phase_norm(l == 0 ? KP()->in[I_X] : (const float*)KP()->out, KP()->in[I_NMIX] + l * DM, wsp<bf16_t>(WS_H));
#endif
            phase_norm(l == 0 ? KP()->in[I_X] : (const float*)KP()->out, KP()->in[I_NMIX] + l * DM, wsp<bf16_t>(WS_H)); }
        SEAM(pb + 1);
        if (INT(2, pb + 2)) {
            { const SchedLin S = mk_sched(128, 4, WS_H, WS_WB, 1024); const EpiB E{l}; pg8::gemm_phase(lds, 1024, S, E); }
            { const SchedLin S = mk_sched(2, 128, WS_WV, WS_H, 1024); const EpiVt E{(unsigned)WS_MVT}; pg8::gemm_phase(lds, 1024, S, E); }
#if DBL_PHASE == 9
            { const SchedLin S = mk_sched(128, 4, WS_H, WS_WB, 1024); const EpiB E{l}; pg8::gemm_phase(lds, 1024, S, E); }
            { const SchedLin S = mk_sched(2, 128, WS_WV, WS_H, 1024); const EpiVt E{(unsigned)WS_MVT}; pg8::gemm_phase(lds, 1024, S, E); }
#endif
        }
        SEAM(pb + 2);
        if (INT(3, pb + 3)) { phase_dcn(l); phase_kmean();
#if DBL_PHASE == 14
            phase_kmean();
#endif
        }
        SEAM(pb + 3);
        if (INT(4, pb + 4)) {
            { const SchedLin S = mk_sched(128, 2, WS_DCN, WS_WKVK, 256); const EpiHN E{l}; pg8::gemm_phase(lds, 256, S, E); }
            { const SchedLin S = mk_sched(2, 128, WS_WKVV, WS_DCN, 256); const EpiVt E{(unsigned)WS_DVT}; pg8::gemm_phase(lds, 256, S, E); }
#if DBL_PHASE == 13
            { const SchedLin S = mk_sched(128, 2, WS_DCN, WS_WKVK, 256); const EpiHN E{l}; pg8::gemm_phase(lds, 256, S, E); }
            { const SchedLin S = mk_sched(2, 128, WS_WKVV, WS_DCN, 256); const EpiVt E{(unsigned)WS_DVT}; pg8::gemm_phase(lds, 256, S, E); }
#endif
        }
        SEAM(pb + 4);
        for (int c = 0; c < NCH; ++c) {
            const int pc = pb + 5 + 5 * c + 2 * (c >> 1), cbase = c * SC;
            if (INT(5, pc + 0)) { const SchedLin S = mk_sched(32, 24, WS_H, WS_WD1, 1024, 1, cbase); const EpiD1 E{l, c & 1}; pg8::gemm_phase(lds, 1024, S, E);
#if DBL_PHASE == 5
                pg8::gemm_phase(lds, 1024, S, E);
#endif
#if DBL_PHASE == 27
                { const EpiNull E0{}; pg8::gemm_phase(lds, 1024, S, E0); }
#endif
            }
            SEAM(pc + 0);
            if (INT(6, pc + 1)) {
#if DBL_PHASE == 4
                phase_rwkv_prep(l, c);
#endif

                phase_rwkv_prep(l, c); }
            SEAM(pc + 1);
            if (INT(7, pc + 2)) { const SchedLin S = mk_sched(32, l == 0 ? 6 : 8, WS_LORAA, WS_WL, 512, 0, 0, WS_VV, 6); const EpiLora E{l, cbase}; pg8::gemm_phase(lds, 512, S, E); }
            SEAM(pc + 2);
            if (INT(8, pc + 3)) {
#if DBL_PHASE == 2
                phase_scan_chunked(l, c, lds, true);
#endif
#if DBL_PHASE == 22
                phase_scan_chunked(l, c, lds, true);
#endif

#if DBL_PHASE == 11
                phase_scan(l, c, 2);
#endif
#if DBL_PHASE == 12
                phase_scan(l, c, 3);
#endif
#if DBL_PHASE == 25
                if (TID() == 0) *(LAS unsigned*)(lds + 8192) = 0u;
                __syncthreads();
                phase_scan_chunked(l, c, lds, true); phase_dsa_select_queue(c, (LAS unsigned*)(lds + 8192));
                __syncthreads();
#endif
#if DBL_PHASE == 26
                if (TID() == 0) *(LAS unsigned*)(lds + 8192) = 0u;
                __syncthreads();
                phase_dsa_select_queue(c, (LAS unsigned*)(lds + 8192));
                __syncthreads();
#endif
                if (TID() == 0) *(LAS unsigned*)(lds + 8192) = 0u;
                __syncthreads();
                phase_scan_chunked(l, c, lds);
                phase_dsa_select_queue(c, (LAS unsigned*)(lds + 8192)); }
            SEAM(pc + 3);
            if (INT(9, pc + 4)) {
#if DBL_PHASE == 1
                phase_attn(l, c, (LAS float*)lds, true); __syncthreads();
#endif
                phase_attn(l, c, (LAS float*)lds); }
            SEAM(pc + 4);
            if (c & 1) {
                if (INT(10, pc + 5)) { const SchedMerge S{(int)gridDim.x, (int)BID()}; const EpiMerge E{}; pg8::gemm_phase(lds, 512, S, E);
#if DBL_PHASE == 10
                    pg8::gemm_phase(lds, 512, S, E);
#endif
                }
                SEAM(pc + 5);
                if (INT(11, pc + 6)) { const SchedLin S = mk_sched(64, 4, WS_Y, WS_WO, 1024); const EpiRes E{l == 0 ? 1 : 0, 2, cbase - SC, 0u}; pg8::gemm_phase(lds, 1024, S, E); }
                SEAM(pc + 6);
            }
        }
        if (INT(33, pb + 29)) phase_norm(KP()->out, KP()->in[I_NFFN] + l * DM, wsp<bf16_t>(WS_H));
        SEAM(pb + 29);
        if (INT(34, pb + 30)) { const SchedLin S = mk_sched(128, 22, WS_H, WS_WF1, 1024); const EpiSwiglu E{}; pg8::gemm_phase(lds, 1024, S, E);
#if DBL_PHASE == 8
            pg8::gemm_phase(lds, 1024, S, E);
#endif
        }
        SEAM(pb + 30);
        if (INT(35, pb + 31)) { const SchedLin S = mk_sched(128, 4, WS_ACT, WS_WF2, DFF); const EpiRes E{0, 0, 0, 0u};
#if DBL_PHASE == 16
            { const EpiRes E2{0, 0, 0, (unsigned)(WS_ACT + 176 * MiB)}; pg8::gemm_phase(lds, DFF, S, E2); }
#endif
            pg8::gemm_phase(lds, DFF, S, E); }
        SEAM(pb + 31);
    }
#undef IN
#undef INT
#undef SEAM
}

extern "C" void kernel_launch(void* const* d_in, const int* in_sizes, int n_in, void* d_out, int out_size, void* d_ws, size_t ws_size, hipStream_t stream) {
    static int grid = 0;
    if (grid == 0) {
        if (n_in != 26 || ws_size < WS_END) { grid = -1; return; }
        int dev = 0, cus = 0;
        if (hipGetDevice(&dev) != hipSuccess || hipDeviceGetAttribute(&cus, hipDeviceAttributeMultiprocessorCount, dev) != hipSuccess) { grid = -1; return; }
        if (hipFuncSetAttribute((const void*)mega, hipFuncAttributeMaxDynamicSharedMemorySize, LDS_BYTES) != hipSuccess) { grid = -1; return; }
        grid = cus;
    }
    if (grid < 0) return;
    (void)hipMemsetAsync((char*)d_ws + WS_CTL, 0, 64 * 1024, stream);
    Params p{};
    for (int i = 0; i < 26; ++i) p.in[i] = (const float*)d_in[i];
    p.out = (float*)d_out; p.ws = (unsigned char*)d_ws;
#if MK_ONE_LAUNCH
    p.ph_lo = 0; p.ph_hi = N_PHASES;
    hipLaunchKernelGGL(mega, dim3(grid), dim3(512), LDS_BYTES, stream, p);
#else
    for (int ph = 0; ph < N_PHASES; ++ph) { p.ph_lo = ph; p.ph_hi = ph + 1; hipLaunchKernelGGL(mega, dim3(grid), dim3(512), LDS_BYTES, stream, p); }
#endif
}
```

```cpp
#include <hip/hip_runtime.h>
#include <stdint.h>
#ifndef DBL_PHASE
#define DBL_PHASE 0
#endif

#define DI __device__ __forceinline__
#define LAS __attribute__((address_space(3)))
typedef unsigned short bf16_t;
typedef short bf16x8 __attribute__((ext_vector_type(8)));
typedef float f32x2 __attribute__((ext_vector_type(2)));
typedef float f32x4 __attribute__((ext_vector_type(4)));
typedef float f32x16 __attribute__((ext_vector_type(16)));
typedef unsigned u32x2 __attribute__((ext_vector_type(2)));
typedef unsigned u32x4 __attribute__((ext_vector_type(4)));
typedef __bf16 bf2_t __attribute__((ext_vector_type(2)));

constexpr int NB = 16, SEQ = 2048, DM = 1024, NT = NB * SEQ, NH = 8, BW = 512;
constexpr int NCH = 4, SC = 512, TC = NB * SC;
constexpr int D_IN = 7496, DFF = 2816;
constexpr int C_MQ = 0, C_MK = 512, C_MV = 1024, C_RW = 1536, C_DS = 3360, C_GT = 4424;
constexpr int RAWLD = 1792;
constexpr float NORM_EPS = 1e-6f;
constexpr float LOG2E = 1.4426950408889634f;
constexpr float QSCALE = 0.125f * LOG2E;

constexpr size_t MiB = 1024 * 1024;
constexpr size_t WS_CTL = 0;
constexpr size_t WS_WB = 64 * 1024;
constexpr size_t WS_WV = WS_WB + 2 * MiB;
constexpr size_t WS_WD1 = WS_WV + 1 * MiB;
constexpr size_t WS_WKVK = WS_WD1 + 12 * MiB;
constexpr size_t WS_WKVV = WS_WKVK + MiB / 4;
constexpr size_t WS_WL = WS_WKVV + MiB / 4;
constexpr size_t WS_WBR = WS_WL + 2 * MiB;
constexpr size_t WS_WO = WS_WBR + 3 * MiB;
constexpr size_t WS_WF1 = WS_WO + 2 * MiB;
constexpr size_t WS_WF2 = WS_WF1 + 11 * MiB;
constexpr size_t WS_VFIRST = WS_WF2 + 6 * MiB;
constexpr size_t WS_STATE = WS_VFIRST + 32 * MiB;
constexpr size_t WS_H = WS_STATE + 2 * MiB;
constexpr size_t WS_IDXK = WS_H + 64 * MiB;
constexpr size_t WS_IDXW = WS_IDXK + 2 * MiB;
constexpr size_t WS_LEFT = WS_IDXW + 1 * MiB;
constexpr size_t WS_KMEAN = WS_LEFT + 2 * MiB;
constexpr size_t WS_CARRY = WS_KMEAN + MiB / 4;
constexpr size_t WS_MK = WS_CARRY + MiB / 4;
constexpr size_t WS_MVT = WS_MK + 32 * MiB;
constexpr size_t WS_DK = WS_MVT + 32 * MiB;
constexpr size_t WS_DVT = WS_DK + 32 * MiB;
constexpr size_t WS_MQ = WS_DVT + 32 * MiB;
constexpr size_t WS_DQ = WS_MQ + 16 * MiB;
constexpr size_t WS_ORW = WS_DQ + 16 * MiB;
constexpr size_t WS_GATES = WS_ORW + 16 * MiB;
constexpr size_t PAR_O = 8 * MiB, PAR_G = 24 * MiB;
constexpr size_t WS_IDXQ = WS_GATES + 48 * MiB;
constexpr size_t WS_RAW = WS_IDXQ + 4 * MiB;
constexpr size_t WS_LORAA = WS_RAW + 28 * MiB;
constexpr size_t WS_RR = WS_LORAA + 8 * MiB;
constexpr size_t WS_KF = WS_RR + 8 * MiB;
constexpr size_t WS_VV = WS_KF + 8 * MiB;
constexpr size_t WS_KKB = WS_VV + 8 * MiB;
constexpr size_t WS_BBB = WS_KKB + 8 * MiB;
constexpr size_t WS_GG = WS_BBB + 8 * MiB;
constexpr size_t WS_DEC = WS_GG + 8 * MiB;
constexpr size_t WS_OUT = WS_DEC + 16 * MiB;
constexpr size_t WS_V2 = WS_OUT + 16 * MiB;
constexpr size_t WS_SELB = WS_V2 + 8 * MiB;
constexpr size_t WS_END = WS_SELB + 2 * MiB;
constexpr size_t WS_DCN = WS_RAW;
constexpr size_t WS_Y32 = WS_IDXQ;
constexpr size_t WS_Y = WS_Y32 + 64 * MiB;
static_assert(WS_Y + 32 * MiB <= WS_END, "y32 / y alias");
constexpr size_t WS_ACT = WS_MK;
static_assert(WS_END <= 512 * MiB, "workspace map exceeds 512 MiB");
static_assert(WS_ACT + 176 * MiB <= WS_END, "ACT alias");

DI unsigned pk2(float a, float b) { f32x2 v = {a, b}; return __builtin_bit_cast(unsigned, __builtin_convertvector(v, bf2_t)); }
DI bf16_t f2bf(float a) { return (bf16_t)(pk2(a, 0.f) & 0xffffu); }
DI float bflo(unsigned u) { return __uint_as_float(u << 16); }
DI float bfhi(unsigned u) { return __uint_as_float(u & 0xffff0000u); }
DI float bf2f(bf16_t b) { return __uint_as_float((unsigned)b << 16); }
DI float fexp2(float x) { return __builtin_amdgcn_exp2f(x); }
DI float frcp(float x) { return __builtin_amdgcn_rcpf(x); }
DI float fsigmoid(float x) { return frcp(1.f + fexp2(-x * LOG2E)); }
DI float wave_sum(float v) {
    v += __uint_as_float(__builtin_amdgcn_update_dpp(0, __float_as_uint(v), 0x128, 0xf, 0xf, false));
    v += __uint_as_float(__builtin_amdgcn_update_dpp(0, __float_as_uint(v), 0x124, 0xf, 0xf, false));
    v += __uint_as_float(__builtin_amdgcn_update_dpp(0, __float_as_uint(v), 0x122, 0xf, 0xf, false));
    v += __uint_as_float(__builtin_amdgcn_update_dpp(0, __float_as_uint(v), 0x121, 0xf, 0xf, false));
    auto r = __builtin_amdgcn_permlane16_swap(__float_as_uint(v), __float_as_uint(v), false, false);
    v = __uint_as_float(r[0]) + __uint_as_float(r[1]);
    r = __builtin_amdgcn_permlane32_swap(__float_as_uint(v), __float_as_uint(v), false, false);
    return __uint_as_float(r[0]) + __uint_as_float(r[1]);
}

#define XB_TMO      128
#define XB_XCNT(j)  (256  + 64 * (j))
#define XB_XSUB(j)  (1280 + 64 * (j))
#define XB_XGEN(j)  (2304 + 64 * (j))
#define XB_TOP      3328
#define XB_TOPGEN   3392
#define XCD_BAR_WORDS 3456
#define XB_SPIN_CAP (1u << 18)
__device__ __forceinline__ unsigned xb_ld(unsigned* p)              { return __hip_atomic_load(p, __ATOMIC_RELAXED, __HIP_MEMORY_SCOPE_AGENT); }
__device__ __forceinline__ unsigned xb_add(unsigned* p, unsigned v) { return __hip_atomic_fetch_add(p, v, __ATOMIC_RELAXED, __HIP_MEMORY_SCOPE_AGENT); }
__device__ __forceinline__ unsigned xb_xcc_id() { return (unsigned)__builtin_amdgcn_s_getreg((3 << 11) | 20) & 0xFu; }
#define XB_SPIN(cond, bar) do { unsigned _sp = 0; while (cond) { __builtin_amdgcn_s_sleep(1); \
    if ((++_sp & 255u) == 0u) { if (xb_ld(&(bar)[XB_TMO])) break; if (_sp > XB_SPIN_CAP) { atomicAdd(&(bar)[XB_TMO], 1u); break; } } } } while (0)
struct XcdBarrier { unsigned* bar; unsigned x; volatile LAS unsigned* st; };
__device__ __forceinline__ XcdBarrier xcd_barrier_post(unsigned* bar, volatile LAS unsigned* st) {
    XcdBarrier b; b.bar = bar; b.x = xb_xcc_id(); b.st = st;
    if (threadIdx.x == 0) (void)xb_add(&bar[XB_XCNT(b.x)], 1u);
    return b;
}
__device__ __forceinline__ void xcd_barrier_complete(unsigned* bar, unsigned x, unsigned& nloc, unsigned& nx) {
    const unsigned G = gridDim.x * gridDim.y * gridDim.z;
    unsigned sum, cnt, mine, sp = 0u;
    for (;;) {
        sum = 0u; cnt = 0u; mine = 0u;
#pragma unroll 1
        for (unsigned j = 0; j < 16; ++j) { const unsigned c = xb_ld(&bar[XB_XCNT(j)]); sum += c; cnt += (c > 0u) ? 1u : 0u; mine = (j == x) ? c : mine; }
        if (sum == G) break;
        __builtin_amdgcn_s_sleep(1);
        if ((++sp & 255u) == 0u) { if (xb_ld(&bar[XB_TMO])) break; if (sp > XB_SPIN_CAP) { atomicAdd(&bar[XB_TMO], 1u); break; } }
    }
    nloc = mine > 0u ? mine : 1u; nx = cnt > 0u ? cnt : 1u;
}
__device__ __forceinline__ void xcd_barrier(const XcdBarrier& b) {
    asm volatile("s_waitcnt vmcnt(0)" ::: "memory");
    __syncthreads();
    if (threadIdx.x == 0) {
        unsigned* bar = b.bar;
        __builtin_amdgcn_s_waitcnt(0);
        unsigned nloc = b.st[0], nx = b.st[1];
        if (nloc == 0u) { xcd_barrier_complete(bar, b.x, nloc, nx); b.st[0] = nloc; b.st[1] = nx; }
        const unsigned old = xb_add(&bar[XB_XSUB(b.x)], 1u);
        const unsigned gen = old / nloc;
        if (old + 1u == (gen + 1u) * nloc) {
            __builtin_amdgcn_fence(__ATOMIC_RELEASE, "agent");
            asm volatile("s_waitcnt vmcnt(0)" ::: "memory");
            const unsigned og = xb_add(&bar[XB_TOP], 1u);
            const unsigned tg = og / nx;
            if (og + 1u == (tg + 1u) * nx) xb_add(&bar[XB_TOPGEN], 1u);
            else XB_SPIN(xb_ld(&bar[XB_TOPGEN]) == tg, bar);
            __builtin_amdgcn_fence(__ATOMIC_ACQUIRE, "agent");
            xb_add(&bar[XB_XGEN(b.x)], 1u);
            asm volatile("s_waitcnt vmcnt(0)" ::: "memory");
        } else {
            XB_SPIN(xb_ld(&bar[XB_XGEN(b.x)]) == gen, bar);
            __builtin_amdgcn_fence(__ATOMIC_ACQUIRE, "agent");
            asm volatile("s_waitcnt vmcnt(0)" ::: "memory");
        }
    }
    __syncthreads();
}

DI int TID() { int t = threadIdx.x; asm volatile("" : "+v"(t)); return t; }
DI int BID() { int b = blockIdx.x; asm volatile("" : "+s"(b)); return b; }

namespace pg8 {
constexpr int BM = 256, BK = 64, HALF = 128, HTB = HALF * BK * 2, STAGE_BYTES = 8 * HTB, NXCD = 8, WGM = 8;
DI int lds_byte(int r, int c) { const int st = (r >> 4) * 2 + (c >> 5), rr = r & 15, cc = c & 31, ob = rr * 64 + cc * 2; return st * 1024 + (ob ^ (((ob >> 9) & 1) << 5)); }
DI void stage_rc(int b, int& R, int& C) { const int st = b / 1024, sb = b % 1024, swz = sb ^ (((sb >> 9) & 1) << 5); R = (st >> 1) * 16 + swz / 64; C = (st & 1) * 32 + (swz % 64) / 2; }
struct Unit { int pm, pn, z; };

DI bool order_xcd(int nM, int nN, int G, int c, int i, Unit& u) {
    const int nwg = nM * nN; const long L = (long)i * G + c; if (L >= nwg) return false;
    int wgid = (int)L; { const int q = nwg / NXCD, r = nwg % NXCD, xcd = wgid % NXCD, off = wgid / NXCD; wgid = (xcd < r ? xcd * (q + 1) : r * (q + 1) + (xcd - r) * q) + off; }
    const int nig = WGM * nN, gid = wgid / nig, fm = gid * WGM, gsz = (nM - fm) < WGM ? (nM - fm) : WGM;
    u.pm = fm + ((wgid % nig) % gsz); u.pn = (wgid % nig) / gsz; u.z = 0; return true;
}

template <class Epi, class Sched, bool HALFN = false>
DI void gemm_phase(LAS unsigned char* lds, const int K, const Sched& S, const Epi& E) {
    const int tid = TID(), wid = __builtin_amdgcn_readfirstlane(tid >> 6), lane = tid & 63, wr = wid >> 2, wc = wid & 3, fr = lane & 15, fq = lane >> 4;
    const int nt = K / BK;
    unsigned voffA[2];
#pragma unroll
    for (int i = 0; i < 2; ++i) { int R, C; stage_rc(tid * 16 + i * 8192, R, C); voffA[i] = (unsigned)(R * K + C) * 2u; }
    const size_t kstep = (size_t)(BK * 2);
    const size_t hstep = (size_t)HALF * K * 2;
    const unsigned ldsw = (unsigned)wid * 1024u;
    const int aoff = lds_byte(wr * 64 + fr, fq * 8), boff = lds_byte(wc * 32 + fr, fq * 8);
#define PG8_SA(b, h) (((b) * 2 + (h)) * HTB)
#define PG8_SB(b, h) ((4 + (b) * 2 + (h)) * HTB)
#define PG8_STAGE(bufoff, gbase) do { _Pragma("unroll") for (int _i = 0; _i < 2; ++_i) \
        __builtin_amdgcn_global_load_lds((const unsigned*)((const char*)(gbase) + voffA[_i]), (LAS unsigned*)(lds + (bufoff) + ldsw + _i * 8192), 16, 0, 0); } while (0)
#define PG8_LDA(dst, b, h) do { _Pragma("unroll") for (int m = 0; m < 4; ++m) _Pragma("unroll") for (int k = 0; k < 2; ++k) dst[m][k] = *(const LAS bf16x8*)(lds + PG8_SA(b, h) + aoff + m * 2048 + k * 1024); } while (0)
#define PG8_LDB(dst, b, h) do { _Pragma("unroll") for (int n = 0; n < 2; ++n) _Pragma("unroll") for (int k = 0; k < 2; ++k) dst[n][k] = *(const LAS bf16x8*)(lds + PG8_SB(b, h) + boff + n * 2048 + k * 1024); } while (0)
#define PG8_MMA(ai, bj, At, Bt) do { __builtin_amdgcn_s_setprio(1); _Pragma("unroll") for (int m = 0; m < 4; ++m) _Pragma("unroll") for (int n = 0; n < 2; ++n) _Pragma("unroll") for (int k = 0; k < 2; ++k) \
        acc[ai][bj][m][n] = __builtin_amdgcn_mfma_f32_16x16x32_bf16(Bt[n][k], At[m][k], acc[ai][bj][m][n], 0, 0, 0); __builtin_amdgcn_s_setprio(0); } while (0)
#define PG8_WAIT_V(n) asm volatile("s_waitcnt vmcnt(" #n ")" ::: "memory")
#define PG8_WAIT_L(n) asm volatile("s_waitcnt lgkmcnt(" #n ")" ::: "memory")
#define PG8_BAR __builtin_amdgcn_s_barrier()
#define PG8_SCHED __builtin_amdgcn_sched_barrier(0)
    Unit cur, nxt; int ui = 0;
    if (!S.next(0, cur)) return;
    f32x4 acc[2][2][4][2];
#pragma unroll
    for (int a = 0; a < 2; ++a)
#pragma unroll
        for (int b = 0; b < 2; ++b)
#pragma unroll
            for (int m = 0; m < 4; ++m)
#pragma unroll
                for (int n = 0; n < 2; ++n) acc[a][b][m][n] = (f32x4){0.f, 0.f, 0.f, 0.f};
    bf16x8 At[4][2], B0[2][2], B1[2][2];
    const char* cA = S.aptr(cur); const char* cB = S.bptr(cur);
    PG8_STAGE(PG8_SB(0, 0), cB); PG8_STAGE(PG8_SA(0, 0), cA); PG8_STAGE(PG8_SB(0, 1), cB + hstep); PG8_STAGE(PG8_SA(0, 1), cA + hstep);
    if (wr == 1) PG8_BAR;
    PG8_WAIT_V(4); PG8_BAR;
    PG8_STAGE(PG8_SB(1, 0), cB + kstep); PG8_STAGE(PG8_SA(1, 0), cA + kstep); PG8_STAGE(PG8_SB(1, 1), cB + hstep + kstep);
    PG8_WAIT_V(6); PG8_BAR;
    for (;;) {
        const bool has_next = S.next(ui + 1, nxt);
        const char* nA = has_next ? S.aptr(nxt) : cA; const char* nB = has_next ? S.bptr(nxt) : cB;
#pragma unroll 1
        for (int t = 0; t < nt; t += 2) {
            const bool last = (t == nt - 2);
            const char* a1 = cA + (size_t)(t + 1) * kstep;
            const char* a2 = last ? nA : cA + (size_t)(t + 2) * kstep; const char* b2 = last ? nB : cB + (size_t)(t + 2) * kstep;
            const char* a3 = a2 + kstep; const char* b3 = b2 + kstep;
            PG8_LDB(B0, 0, 0); PG8_SCHED; PG8_LDA(At, 0, 0); PG8_STAGE(PG8_SA(1, 1), a1 + hstep);
            PG8_WAIT_L(8); PG8_BAR; PG8_WAIT_L(0); PG8_MMA(0, 0, At, B0); PG8_BAR; PG8_SCHED;
            PG8_LDB(B1, 0, 1); PG8_STAGE(PG8_SB(0, 0), b2);
            PG8_BAR; PG8_WAIT_L(0); if (!HALFN) PG8_MMA(0, 1, At, B1); PG8_BAR;
            PG8_LDA(At, 0, 1); PG8_STAGE(PG8_SA(0, 0), a2);
            PG8_BAR; PG8_WAIT_L(0); PG8_MMA(1, 0, At, B0); PG8_BAR; PG8_SCHED;
            PG8_STAGE(PG8_SB(0, 1), b2 + hstep);
            PG8_WAIT_V(6); PG8_BAR; if (!HALFN) PG8_MMA(1, 1, At, B1); PG8_BAR;
            PG8_LDB(B0, 1, 0); PG8_SCHED; PG8_LDA(At, 1, 0); PG8_STAGE(PG8_SA(0, 1), a2 + hstep);
            PG8_WAIT_L(8); PG8_BAR; PG8_WAIT_L(0); PG8_MMA(0, 0, At, B0); PG8_BAR; PG8_SCHED;
            PG8_LDB(B1, 1, 1); PG8_STAGE(PG8_SB(1, 0), b3);
            PG8_BAR; PG8_WAIT_L(0); if (!HALFN) PG8_MMA(0, 1, At, B1); PG8_BAR;
            PG8_LDA(At, 1, 1); PG8_STAGE(PG8_SA(1, 0), a3);
            PG8_BAR; PG8_WAIT_L(0); PG8_MMA(1, 0, At, B0); PG8_BAR; PG8_SCHED;
            PG8_STAGE(PG8_SB(1, 1), b3 + hstep);
            PG8_WAIT_V(6); PG8_BAR; if (!HALFN) PG8_MMA(1, 1, At, B1); PG8_BAR;
        }
        { int tz = TID(); asm volatile("" : "+v"(tz));
          const int wz = __builtin_amdgcn_readfirstlane(tz >> 6), lz = tz & 63; E(acc, cur, wz >> 2, wz & 3, lz & 15, lz >> 4); }
        if (!has_next) break;
#pragma unroll
        for (int a = 0; a < 2; ++a)
#pragma unroll
            for (int b = 0; b < (HALFN ? 1 : 2); ++b)
#pragma unroll
                for (int m = 0; m < 4; ++m)
#pragma unroll
                    for (int n = 0; n < 2; ++n) acc[a][b][m][n] = (f32x4){0.f, 0.f, 0.f, 0.f};
        cur = nxt; cA = nA; cB = nB; ++ui;
    }
    PG8_WAIT_V(0);
    if (wr == 0) PG8_BAR;
    PG8_BAR;
#undef PG8_SA
#undef PG8_SB
#undef PG8_STAGE
#undef PG8_LDA
#undef PG8_LDB
#undef PG8_MMA
#undef PG8_WAIT_V
#undef PG8_WAIT_L
#undef PG8_BAR
#undef PG8_SCHED
}
}
using pg8::Unit;
typedef f32x4 AccT[2][2][4][2];

struct Params {
    const float* in[26];
    float* out;
    unsigned char* ws;
    int ph_lo, ph_hi;
};
enum { I_X = 0, I_WIN, I_NMIX, I_NFFN, I_QKN, I_REL, I_MU, I_W0, I_W2, I_A0, I_A2, I_G2, I_KK, I_KA, I_RK, I_LNW, I_LNB, I_V0, I_VA, I_VB, I_KVN, I_KVUP, I_WBR, I_WO, I_F1, I_F2 };

DI const Params* KP() { auto k = __builtin_amdgcn_kernarg_segment_ptr(); asm volatile("" : "+s"(k)); return (const Params*)k; }
template <class T> DI T* wsp(size_t off) { return (T*)(KP()->ws + off); }

DI int cmap_b(int x) { const int pi = x & 255; return (x & ~255) + 64 * ((pi >> 5) & 3) + 32 * (pi >> 7) + 8 * ((pi >> 2) & 3) + 4 * ((pi >> 4) & 1) + (pi & 3); }
DI int cmap_f(int x) { const int pi = x & 255; return (x & ~255) + 64 * ((pi >> 5) & 3) + 32 * (pi >> 7) + 16 * ((pi >> 4) & 1) + 4 * ((pi >> 2) & 3) + (pi & 3); }
DI int wide_col(int x) { return cmap_b(x); }
template <int MAP> DI int colmap(int r) {
    if (MAP == 0) {
        if (r < 512) return C_MK + wide_col(r);
        if (r < 768) return C_DS + 512 + wide_col(r - 512);
        const int a = wide_col(r - 768);
        if (a < 32) return C_DS + 1024 + a;
        if (a < 40) return C_DS + 1056 + (a - 32);
        if (a >= 64 && a < 96) return C_RW + 1792 + (a - 64);
        return -1;
    }
    if (MAP == 1) return C_MV + r;
    if (MAP == 2) {
        if (r < 512) return C_MQ + wide_col(r);
        if (r < 1024) return C_DS + wide_col(r - 512);
        if (r < 1280) return C_DS + 768 + wide_col(r - 1024);
        if (r < 3072) return C_RW + wide_col(r - 1280);
        return C_GT + wide_col(r - 3072);
    }
    if (MAP == 3) return wide_col(r);
    if (MAP == 4) return 512 + r;
    if (MAP == 5) return cmap_b(r);
    if (MAP == 7) return cmap_f(r);
    if (MAP == 6) { const int pn = r >> 8, pi = r & 255;
        return ((pi >> 7) ? DFF : 0) + 128 * pn + 32 * ((pi >> 5) & 3) + 8 * ((pi >> 2) & 3) + 4 * ((pi >> 4) & 1) + (pi & 3); }
    return -1;
}
template <int MAP> DI void conv_t(LAS float* sm, bf16_t* dst, int nrows, int K, const float* src, int ld) {
    const int tid = TID(), tx = tid & 63, ty = tid >> 6;
    const int ntr = nrows / 64, ntk = K / 64, ntiles = ntr * ntk;
    for (int t = BID(); t < ntiles; t += gridDim.x) {
        const int r0 = (t / ntk) * 64, k0 = (t % ntk) * 64;
        const int col = colmap<MAP>(r0 + tx);
#pragma unroll
        for (int i = 0; i < 8; ++i) { const int kl = ty + 8 * i; sm[kl * 65 + tx] = (col >= 0) ? src[(size_t)(k0 + kl) * ld + col] : 0.f; }
        __syncthreads();
#pragma unroll
        for (int i = 0; i < 8; ++i) { const int rl = ty + 8 * i; dst[(size_t)(r0 + rl) * K + k0 + tx] = f2bf(sm[tx * 65 + rl]); }
        __syncthreads();
    }
}
DI void conv_lora(int l) {
    bf16_t* dst = wsp<bf16_t>(WS_WL);
    const float* w2 = KP()->in[I_W2] + (size_t)l * 64 * 512; const float* a2 = KP()->in[I_A2] + (size_t)l * 64 * 512; const float* g2 = KP()->in[I_G2] + (size_t)l * 160 * 512;
    const float* va = KP()->in[I_VA]; const float* vb = KP()->in[I_VB];
    const int n = 2048 * 512;
    for (int e = BID() * 512 + TID(); e < n; e += gridDim.x * 512) {
        const int r = wide_col(e >> 9), k = e & 511; float v = 0.f;
        if (r < 512) { if (k < 64) v = w2[k * 512 + r]; }
        else if (r < 1024) { if (k >= 64 && k < 128) v = a2[(k - 64) * 512 + (r - 512)]; }
        else if (r < 1536) { if (k >= 128 && k < 288) v = g2[(k - 128) * 512 + (r - 1024)]; }
        else if (l == 1) { const int c = r - 1536; float s = 0.f;
#pragma unroll 8
            for (int j = 0; j < 32; ++j) s += va[k * 32 + j] * vb[j * 512 + c];
            v = s; }
        dst[e] = f2bf(v);
    }
}
DI void phase_conv(int l, LAS float* sm) {
    const float* win = KP()->in[I_WIN] + (size_t)l * DM * D_IN;
    conv_t<0>(sm, wsp<bf16_t>(WS_WB), 1024, 1024, win, D_IN);
    conv_t<1>(sm, wsp<bf16_t>(WS_WV), 512, 1024, win, D_IN);
    conv_t<2>(sm, wsp<bf16_t>(WS_WD1), 6144, 1024, win, D_IN);
    const float* kvup = KP()->in[I_KVUP] + (size_t)l * 256 * 1024;
    conv_t<3>(sm, wsp<bf16_t>(WS_WKVK), 512, 256, kvup, 1024);
    conv_t<4>(sm, wsp<bf16_t>(WS_WKVV), 512, 256, kvup, 1024);
    for (int i = 0; i < 3; ++i) conv_t<5>(sm, wsp<bf16_t>(WS_WBR) + (size_t)i * 1024 * 512, 1024, 512, KP()->in[I_WBR] + ((size_t)l * 3 + i) * 512 * 1024, 1024);
    conv_t<7>(sm, wsp<bf16_t>(WS_WO), 1024, 1024, KP()->in[I_WO] + (size_t)l * 1024 * 1024, 1024);
    conv_t<6>(sm, wsp<bf16_t>(WS_WF1), 5632, 1024, KP()->in[I_F1] + (size_t)l * 1024 * 5632, 5632);
    conv_t<7>(sm, wsp<bf16_t>(WS_WF2), 1024, 2816, KP()->in[I_F2] + (size_t)l * 2816 * 1024, 1024);
    conv_lora(l);
}

DI void phase_norm(const float* x, const float* g, bf16_t* h) {
    const int lane = TID() & 63, gw = BID() * 8 + (TID() >> 6), nw = gridDim.x * 8;
    f32x4 gv[4];
#pragma unroll
    for (int i = 0; i < 4; ++i) gv[i] = ((const f32x4*)g)[lane + 64 * i];
    for (int row = gw; row < NT; row += nw) {
        const f32x4* xr = (const f32x4*)(x + (size_t)row * DM);
        f32x4 v[4]; float ss = 0.f;
#pragma unroll
        for (int i = 0; i < 4; ++i) { v[i] = xr[lane + 64 * i]; ss += v[i][0] * v[i][0] + v[i][1] * v[i][1] + v[i][2] * v[i][2] + v[i][3] * v[i][3]; }
        ss = wave_sum(ss);
        const float rs = __builtin_amdgcn_rsqf(ss * (1.f / DM) + NORM_EPS);
#pragma unroll
        for (int i = 0; i < 4; ++i) {
            u32x2 o; o[0] = pk2(v[i][0] * rs * gv[i][0], v[i][1] * rs * gv[i][1]); o[1] = pk2(v[i][2] * rs * gv[i][2], v[i][3] * rs * gv[i][3]);
            *(u32x2*)(h + (size_t)row * DM + 4 * (lane + 64 * i)) = o;
        }
    }
}

struct SchedLin {
    int nM, nN, G, c; unsigned aoff, boff, a2off; int rowbytes, amode, cbase, pn2;
    DI bool next(int i, Unit& u) const { return pg8::order_xcd(nM, nN, G, c, i, u); }
    DI const char* aptr(const Unit& u) const { const int row0 = amode ? ((u.pm >> 1) * SEQ + cbase + (u.pm & 1) * 256) : u.pm * 256; return (const char*)KP()->ws + ((u.pn >= pn2) ? a2off : aoff) + (size_t)row0 * rowbytes; }
    DI const char* bptr(const Unit& u) const { return (const char*)KP()->ws + boff + (size_t)u.pn * 256 * rowbytes; }
};
DI SchedLin mk_sched(int nM, int nN, size_t aoff, size_t boff, int K, int amode = 0, int cbase = 0, size_t a2off = 0, int pn2 = 1 << 30) {
    SchedLin s; s.nM = nM; s.nN = nN; s.G = gridDim.x; s.c = BID(); s.aoff = (unsigned)aoff; s.boff = (unsigned)boff; s.rowbytes = K * 2; s.amode = amode; s.cbase = cbase; s.a2off = (unsigned)a2off; s.pn2 = pn2; return s;
}
struct SchedMerge {
    int G, c;
    DI bool next(int i, Unit& u) const { const int z = i % 3, tile = (i / 3) * G + c; if (tile >= 256) return false; u.pm = tile >> 2; u.pn = tile & 3; u.z = z; return true; }
    DI const char* aptr(const Unit& u) const { return (const char*)KP()->ws + (u.z == 0 ? WS_MQ : (u.z == 1 ? WS_ORW : WS_DQ)) + (size_t)(u.pm >> 5) * PAR_O + (size_t)(u.pm & 31) * 256 * 1024; }
    DI const char* bptr(const Unit& u) const { return (const char*)KP()->ws + WS_WBR + (size_t)u.z * (1024 * 512 * 2) + (size_t)u.pn * 256 * 1024; }
};

DI void st_bf4(bf16_t* p, f32x4 v) { u32x2 o; o[0] = pk2(v[0], v[1]); o[1] = pk2(v[2], v[3]); *(u32x2*)p = o; }
DI f32x4 ld_bf4(const bf16_t* p) { const u32x2 u = *(const u32x2*)p; return (f32x4){bflo(u[0]), bfhi(u[0]), bflo(u[1]), bfhi(u[1])}; }
#define EPI_ROWS(ai, m) (128 * (ai) + 64 * wr + 16 * (m) + fr)
#define EPI_COLS(bj, n) (64 * wc + 32 * (bj) + 8 * fq + 4 * (n))
#define EPI_COLS_F(bj, n) (64 * wc + 32 * (bj) + 16 * (n) + 4 * fq)
#define EPI_COLS_T(bj, n) (128 * (bj) + 32 * wc + 16 * (n) + 4 * fq)
#define FOR_AM _Pragma("unroll") for (int ai = 0; ai < 2; ++ai) _Pragma("unroll") for (int m = 0; m < 4; ++m)
#define FOR_BN _Pragma("unroll") for (int bj = 0; bj < 2; ++bj) _Pragma("unroll") for (int n = 0; n < 2; ++n)

DI void epi_headnorm(const AccT& acc, bf16_t* out, int ld, const float* gain, int wr, int wc, int fr, int fq, float gscale = 1.f) {
    f32x4 gv[2][2];
    FOR_BN gv[bj][n] = *(const f32x4*)(gain + 32 * bj + 8 * fq + 4 * n) * gscale;
    FOR_AM {
        float ss = 0.f;
        FOR_BN { const f32x4 a = acc[ai][bj][m][n]; ss += a[0] * a[0] + a[1] * a[1] + a[2] * a[2] + a[3] * a[3]; }
        ss += __shfl_xor(ss, 16); ss += __shfl_xor(ss, 32);
        const float sc = __builtin_amdgcn_rsqf(ss * (1.f / 64.f) + NORM_EPS);
        bf16_t* rp = out + (size_t)EPI_ROWS(ai, m) * ld;
        FOR_BN st_bf4(rp + EPI_COLS(bj, n), acc[ai][bj][m][n] * sc * gv[bj][n]);
    }
}
DI void epi_store_bf16(const AccT& acc, bf16_t* out, int ld, int wr, int wc, int fr, int fq) {
    FOR_AM { bf16_t* rp = out + (size_t)EPI_ROWS(ai, m) * ld; FOR_BN st_bf4(rp + EPI_COLS(bj, n), acc[ai][bj][m][n]); }
}

struct EpiB {
    int l;
    DI void operator()(const AccT& acc, const Unit& u, int wr, int wc, int fr, int fq) const {
        const size_t row0 = (size_t)u.pm * 256;
        if (u.pn < 2) epi_headnorm(acc, wsp<bf16_t>(WS_MK) + row0 * 512 + u.pn * 256, 512, KP()->in[I_QKN] + l * 256 + 64, wr, wc, fr, fq);
        else if (u.pn == 2) epi_store_bf16(acc, wsp<bf16_t>(WS_DCN) + row0 * 256, 256, wr, wc, fr, fq);
        else {
            bf16_t* idxk = wsp<bf16_t>(WS_IDXK); float* idxw = wsp<float>(WS_IDXW); bf16_t* left = wsp<bf16_t>(WS_LEFT);
            FOR_AM { const size_t row = row0 + EPI_ROWS(ai, m);
                if (wc == 0) {
#pragma unroll
                    for (int n = 0; n < 2; ++n) st_bf4(idxk + row * 32 + 8 * fq + 4 * n, acc[ai][0][m][n]);
                    if (fq == 0) { *(f32x4*)(idxw + row * 8) = acc[ai][1][m][0]; *(f32x4*)(idxw + row * 8 + 4) = acc[ai][1][m][1]; }
                } else if (wc == 1) {
#pragma unroll
                    for (int n = 0; n < 2; ++n) st_bf4(left + row * 32 + 8 * fq + 4 * n, acc[ai][0][m][n]);
                }
            }
        }
    }
};
struct EpiVt {
    unsigned off;
    DI void operator()(const AccT& acc, const Unit& u, int wr, int wc, int fr, int fq) const {
        bf16_t* vt = wsp<bf16_t>(off);
        const int b = u.pn >> 3, s0 = (u.pn & 7) * 256;
        FOR_AM { bf16_t* rp = vt + ((size_t)b * 512 + u.pm * 256 + EPI_ROWS(ai, m)) * SEQ + s0; FOR_BN st_bf4(rp + EPI_COLS_T(bj, n), acc[ai][bj][m][n]); }
    }
};
struct EpiHN {
    int l;
    DI void operator()(const AccT& acc, const Unit& u, int wr, int wc, int fr, int fq) const { epi_headnorm(acc, wsp<bf16_t>(WS_DK) + (size_t)u.pm * 256 * 512 + u.pn * 256, 512, KP()->in[I_QKN] + l * 256 + 192, wr, wc, fr, fq); }
};
struct EpiD1 {
    int l, par;
    DI void operator()(const AccT& acc, const Unit& u, int wr, int wc, int fr, int fq) const {
        const size_t row0 = (size_t)u.pm * 256;
        if (u.pn < 2) epi_headnorm(acc, wsp<bf16_t>(WS_MQ + par * PAR_O) + row0 * 512 + u.pn * 256, 512, KP()->in[I_QKN] + l * 256, wr, wc, fr, fq, QSCALE);
        else if (u.pn < 4) epi_headnorm(acc, wsp<bf16_t>(WS_DQ + par * PAR_O) + row0 * 512 + (u.pn - 2) * 256, 512, KP()->in[I_QKN] + l * 256 + 128, wr, wc, fr, fq, QSCALE);
        else if (u.pn == 4) epi_store_bf16(acc, wsp<bf16_t>(WS_IDXQ) + row0 * 256, 256, wr, wc, fr, fq);
        else if (u.pn < 12) epi_store_bf16(acc, wsp<bf16_t>(WS_RAW) + row0 * RAWLD + (u.pn - 5) * 256, RAWLD, wr, wc, fr, fq);
        else {
            unsigned char* o = wsp<unsigned char>(WS_GATES + par * PAR_G) + row0 * 3072 + (u.pn - 12) * 256;
            FOR_AM { unsigned char* rp = o + (size_t)EPI_ROWS(ai, m) * 3072;
                FOR_BN { const f32x4 a = acc[ai][bj][m][n];
                    const unsigned q0 = (unsigned)(fsigmoid(a[0]) * 255.f + 0.5f), q1 = (unsigned)(fsigmoid(a[1]) * 255.f + 0.5f), q2 = (unsigned)(fsigmoid(a[2]) * 255.f + 0.5f), q3 = (unsigned)(fsigmoid(a[3]) * 255.f + 0.5f);
                    *(unsigned*)(rp + EPI_COLS(bj, n)) = q0 | (q1 << 8) | (q2 << 16) | (q3 << 24); } }
        }
    }
};
struct EpiLora {
    int l, cbase;
    DI void operator()(const AccT& acc, const Unit& u, int wr, int wc, int fr, int fq) const {
        const size_t row0 = (size_t)u.pm * 256; const int kind = u.pn >> 1, cb = (u.pn & 1) * 256;
        if (kind == 0) {
            float* dec = wsp<float>(WS_DEC); const float* w0 = KP()->in[I_W0] + l * 512;
            FOR_AM { const size_t row = row0 + EPI_ROWS(ai, m);
                FOR_BN { const int col = cb + EPI_COLS(bj, n); const f32x4 a = acc[ai][bj][m][n]; const f32x4 wv = *(const f32x4*)(w0 + col); f32x4 d;
#pragma unroll
                    for (int e = 0; e < 4; ++e) { const float x = -(wv[e] + a[e]);
                        const float sp = fmaxf(x, 0.f) + __builtin_amdgcn_logf(1.f + fexp2(-fabsf(x) * LOG2E)) * 0.6931471805599453f;
                        const float w = -sp - 0.5f; d[e] = fexp2(-fexp2(w * LOG2E) * LOG2E); }
                    *(f32x4*)(dec + row * 512 + col) = d; } }
        } else if (kind == 1) {
            bf16_t* kf = wsp<bf16_t>(WS_KF); const bf16_t* kkb = wsp<bf16_t>(WS_KKB); bf16_t* bbb = wsp<bf16_t>(WS_BBB);
            const float* a0 = KP()->in[I_A0] + l * 512; const float* ka = KP()->in[I_KA] + l * 512;
            FOR_AM { const size_t row = row0 + EPI_ROWS(ai, m);
                f32x4 kp[2][2], kk[2][2];
                FOR_BN { const int col = cb + EPI_COLS(bj, n); kp[bj][n] = ld_bf4(kf + row * 512 + col); kk[bj][n] = ld_bf4(kkb + row * 512 + col); }
                FOR_BN { const int col = cb + EPI_COLS(bj, n); const f32x4 a = acc[ai][bj][m][n];
                    const f32x4 av = *(const f32x4*)(a0 + col), kav = *(const f32x4*)(ka + col); f32x4 ko, bo;
#pragma unroll
                    for (int e = 0; e < 4; ++e) { const float s = fsigmoid(av[e] + a[e]); ko[e] = kp[bj][n][e] * (1.f + (s - 1.f) * kav[e]); bo[e] = kk[bj][n][e] * s; }
                    st_bf4(kf + row * 512 + col, ko); st_bf4(bbb + row * 512 + col, bo); } }
        } else if (kind == 2) {
            epi_store_bf16(acc, wsp<bf16_t>(WS_GG) + row0 * 512 + cb, 512, wr, wc, fr, fq);
        } else {
            const bf16_t* vv = wsp<bf16_t>(WS_VV); bf16_t* v2 = wsp<bf16_t>(WS_V2); const bf16_t* vfirst = wsp<bf16_t>(WS_VFIRST); const float* v0 = KP()->in[I_V0];
            FOR_AM { const size_t row = row0 + EPI_ROWS(ai, m); const size_t arow = (size_t)(row >> 9) * SEQ + cbase + (row & 511);
                f32x4 vp[2][2], vf[2][2];
                FOR_BN { const int col = cb + EPI_COLS(bj, n); vp[bj][n] = ld_bf4(vv + row * 512 + col); vf[bj][n] = ld_bf4(vfirst + arow * 512 + col); }
                FOR_BN { const int col = cb + EPI_COLS(bj, n); const f32x4 a = acc[ai][bj][m][n]; const f32x4 v0v = *(const f32x4*)(v0 + col); f32x4 o;
#pragma unroll
                    for (int e = 0; e < 4; ++e) o[e] = vp[bj][n][e] + (vf[bj][n][e] - vp[bj][n][e]) * fsigmoid(v0v[e] + a[e]);
                    st_bf4(v2 + row * 512 + col, o); } }
        }
    }
};
struct EpiMerge {
    DI void operator()(const AccT& acc, const Unit& u, int wr, int wc, int fr, int fq) const {
        bf16_t* y = wsp<bf16_t>(WS_Y); const unsigned char* gates = wsp<unsigned char>(WS_GATES + (size_t)(u.pm >> 5) * PAR_G);
        const size_t row0 = (size_t)u.pm * 256, grow0 = (size_t)(u.pm & 31) * 256; const int c0 = u.pn * 256 + 64 * wc + 8 * fq, z = u.z;
#pragma unroll
        for (int ai = 0; ai < 2; ++ai) {
            u32x2 g[4][2]; u32x4 yv[4][2];
#pragma unroll
            for (int m = 0; m < 4; ++m) { const int rt = EPI_ROWS(ai, m);
#pragma unroll
                for (int bj = 0; bj < 2; ++bj) { g[m][bj] = *(const u32x2*)(gates + (grow0 + rt) * 3072 + z * 1024 + c0 + 32 * bj);
                    if (z > 0) yv[m][bj] = *(const u32x4*)(y + (row0 + rt) * 1024 + c0 + 32 * bj); } }
#pragma unroll
            for (int m = 0; m < 4; ++m) { const size_t row = row0 + EPI_ROWS(ai, m);
#pragma unroll
                for (int bj = 0; bj < 2; ++bj) { u32x4 o;
#pragma unroll
                    for (int n = 0; n < 2; ++n) { const unsigned gu = g[m][bj][n];
                        const f32x4 gf = (f32x4){(float)(gu & 255u), (float)((gu >> 8) & 255u), (float)((gu >> 16) & 255u), (float)(gu >> 24)} * (1.f / 255.f);
                        f32x4 v = acc[ai][bj][m][n] * gf;
                        if (z > 0) { const unsigned ya = yv[m][bj][2 * n], yb = yv[m][bj][2 * n + 1]; v += (f32x4){bflo(ya), bfhi(ya), bflo(yb), bfhi(yb)}; }
                        o[2 * n] = pk2(v[0], v[1]); o[2 * n + 1] = pk2(v[2], v[3]); }
                    *(u32x4*)(y + row * 1024 + c0 + 32 * bj) = o; } }
        }
    }
};
struct EpiRes {
    int first, amode, cbase; unsigned dummy_off;
    DI void operator()(const AccT& acc, const Unit& u, int wr, int wc, int fr, int fq) const {
        float* out = KP()->out; const float* res = first ? KP()->in[I_X] : (const float*)out;
        if (dummy_off) out = wsp<float>(dummy_off);
        const size_t grow0 = amode == 2 ? ((size_t)((u.pm & 31) >> 1) * SEQ + cbase + (u.pm >> 5) * SC + (u.pm & 1) * 256) : (amode ? ((size_t)(u.pm >> 1) * SEQ + cbase + (u.pm & 1) * 256) : (size_t)u.pm * 256); const int c0 = u.pn * 256;
#pragma unroll
        for (int ai = 0; ai < 2; ++ai) {
            f32x4 rv[4][2][2];
#pragma unroll
            for (int m = 0; m < 4; ++m) { const size_t row = grow0 + EPI_ROWS(ai, m); FOR_BN rv[m][bj][n] = *(const f32x4*)(res + row * DM + c0 + EPI_COLS_F(bj, n)); }
#pragma unroll
            for (int m = 0; m < 4; ++m) { const size_t row = grow0 + EPI_ROWS(ai, m); FOR_BN *(f32x4*)(out + row * DM + c0 + EPI_COLS_F(bj, n)) = rv[m][bj][n] + acc[ai][bj][m][n]; }
        }
    }
};
struct EpiNull { DI void operator()(const AccT& acc, const Unit& u, int wr, int wc, int fr, int fq) const { f32x4 s = {0.f, 0.f, 0.f, 0.f}; FOR_AM { FOR_BN s += acc[ai][bj][m][n]; } if (s[0] + s[1] + s[2] + s[3] == 12345.678f) *wsp<float>(WS_OUT) = 1.f; } };
struct EpiSwiglu {
    DI void operator()(const AccT& acc, const Unit& u, int wr, int wc, int fr, int fq) const {
        bf16_t* act = wsp<bf16_t>(WS_ACT);
        FOR_AM { bf16_t* rp = act + ((size_t)u.pm * 256 + EPI_ROWS(ai, m)) * DFF + u.pn * 128 + 32 * wc + 8 * fq;
            u32x4 w;
#pragma unroll
            for (int n = 0; n < 2; ++n) { const f32x4 g = acc[ai][0][m][n], up = acc[ai][1][m][n]; f32x4 o;
#pragma unroll
                for (int e = 0; e < 4; ++e) o[e] = g[e] * fsigmoid(g[e]) * up[e];
                w[2 * n] = pk2(o[0], o[1]); w[2 * n + 1] = pk2(o[2], o[3]); }
            *(u32x4*)rp = w; }
    }
};

DI void phase_dcn(int l) {
    const int lane = TID() & 63, gw = BID() * 8 + (TID() >> 6), nw = gridDim.x * 8;
    bf16_t* dcn = wsp<bf16_t>(WS_DCN);
    const f32x4 g = *(const f32x4*)(KP()->in[I_KVN] + l * 256 + 4 * lane);
    for (int row = gw; row < NT; row += nw) {
        bf16_t* rp = dcn + (size_t)row * 256 + 4 * lane;
        const f32x4 v = ld_bf4(rp);
        const float ss = wave_sum(v[0] * v[0] + v[1] * v[1] + v[2] * v[2] + v[3] * v[3]);
        const float rs = __builtin_amdgcn_rsqf(ss * (1.f / 256.f) + NORM_EPS);
        st_bf4(rp, v * rs * g);
    }
}
DI void phase_kmean() {
    const int lane = TID() & 63, gw = BID() * 8 + (TID() >> 6), nw = gridDim.x * 8;
    const bf16_t* mk = wsp<bf16_t>(WS_MK); float* km = wsp<float>(WS_KMEAN);
    for (int it = gw; it < NB * NH * 8; it += nw) {
        const int n = it & 7, h = (it >> 3) & 7, b = it >> 6;
        const bf16_t* kp = mk + ((size_t)b * SEQ + n * 256 + (lane >> 3)) * 512 + h * 64 + 8 * (lane & 7);
        float s[8] = {0.f, 0.f, 0.f, 0.f, 0.f, 0.f, 0.f, 0.f};
#pragma unroll 8
        for (int k = 0; k < 256; k += 8) { const u32x4 u = *(const u32x4*)(kp + (size_t)k * 512);
#pragma unroll
            for (int q = 0; q < 4; ++q) { s[2 * q] += bflo(u[q]); s[2 * q + 1] += bfhi(u[q]); } }
#pragma unroll
        for (int e = 0; e < 8; ++e) {
            float v = s[e];
            v += __uint_as_float(__builtin_amdgcn_update_dpp(0, __float_as_uint(v), 0x128, 0xf, 0xf, false));
            auto r = __builtin_amdgcn_permlane16_swap(__float_as_uint(v), __float_as_uint(v), false, false); v = __uint_as_float(r[0]) + __uint_as_float(r[1]);
            r = __builtin_amdgcn_permlane32_swap(__float_as_uint(v), __float_as_uint(v), false, false); s[e] = (__uint_as_float(r[0]) + __uint_as_float(r[1])) * (1.f / 256.f);
        }
        if (lane < 8) { float* o = km + (size_t)it * 64 + 8 * lane; *(f32x4*)o = (f32x4){s[0], s[1], s[2], s[3]}; *(f32x4*)(o + 4) = (f32x4){s[4], s[5], s[6], s[7]}; }
    }
}

DI void phase_rwkv_prep(int l, int c) {
    const int lane = TID() & 63, gw = BID() * 8 + (TID() >> 6), nw = gridDim.x * 8;
    const bf16_t* raw = wsp<bf16_t>(WS_RAW); const bf16_t* left = wsp<bf16_t>(WS_LEFT); bf16_t* carry = wsp<bf16_t>(WS_CARRY);
    bf16_t* rr = wsp<bf16_t>(WS_RR); bf16_t* kf = wsp<bf16_t>(WS_KF); bf16_t* vv = wsp<bf16_t>(WS_VV); bf16_t* kkb = wsp<bf16_t>(WS_KKB);
    bf16_t* la = wsp<bf16_t>(WS_LORAA); bf16_t* vfirst = wsp<bf16_t>(WS_VFIRST);
    const float* mu = KP()->in[I_MU] + l * 1824; const float* kkw = KP()->in[I_KK] + l * 512;
    for (int rc = gw; rc < TC; rc += nw) {
        const int b = rc >> 9, sl = rc & 511, s = c * SC + sl; const size_t ra = (size_t)b * SEQ + s;
        const bf16_t* cur = raw + (size_t)rc * RAWLD;
        const bf16_t* prv = (sl > 0) ? (cur - RAWLD) : (carry + (size_t)((((c + 1) & 1) * 16) + b) * RAWLD);
        const bool hp = s > 0;
        auto mix8 = [&](int j, float* o) {
            const u32x4 cu = *(const u32x4*)(cur + j); u32x4 pu = {0u, 0u, 0u, 0u}; if (hp) pu = *(const u32x4*)(prv + j);
            const f32x4 m0 = *(const f32x4*)(mu + j), m1 = *(const f32x4*)(mu + j + 4);
#pragma unroll
            for (int e = 0; e < 4; ++e) { const float c0 = bflo(cu[e]), c1 = bfhi(cu[e]), p0 = bflo(pu[e]), p1 = bfhi(pu[e]);
                const float ma = (2 * e < 4) ? m0[2 * e] : m1[2 * e - 4], mb = (2 * e + 1 < 4) ? m0[2 * e + 1] : m1[2 * e + 1 - 4];
                o[2 * e] = c0 + (p0 - c0) * ma; o[2 * e + 1] = c1 + (p1 - c1) * mb; }
        };
        float o[8];
        mix8(8 * lane, o);
        { u32x4 w; w[0] = pk2(o[0], o[1]); w[1] = pk2(o[2], o[3]); w[2] = pk2(o[4], o[5]); w[3] = pk2(o[6], o[7]); *(u32x4*)(rr + (size_t)rc * 512 + 8 * lane) = w; }
        mix8(576 + 8 * lane, o);
        { u32x4 w; w[0] = pk2(o[0], o[1]); w[1] = pk2(o[2], o[3]); w[2] = pk2(o[4], o[5]); w[3] = pk2(o[6], o[7]); *(u32x4*)(kf + (size_t)rc * 512 + 8 * lane) = w;
          const f32x4 k0 = *(const f32x4*)(kkw + 8 * lane), k1 = *(const f32x4*)(kkw + 8 * lane + 4);
          float q[8]; float ss = 0.f;
#pragma unroll
          for (int e = 0; e < 8; ++e) { q[e] = o[e] * (e < 4 ? k0[e] : k1[e - 4]); ss += q[e] * q[e]; }
          ss += __shfl_xor(ss, 1); ss += __shfl_xor(ss, 2); ss += __shfl_xor(ss, 4);
          const float inv = 1.f / fmaxf(sqrtf(ss), 1e-12f);
          w[0] = pk2(q[0] * inv, q[1] * inv); w[1] = pk2(q[2] * inv, q[3] * inv); w[2] = pk2(q[4] * inv, q[5] * inv); w[3] = pk2(q[6] * inv, q[7] * inv);
          *(u32x4*)(kkb + (size_t)rc * 512 + 8 * lane) = w; }
        mix8(1088 + 8 * lane, o);
        { u32x4 w; w[0] = pk2(o[0], o[1]); w[1] = pk2(o[2], o[3]); w[2] = pk2(o[4], o[5]); w[3] = pk2(o[6], o[7]); *(u32x4*)(vv + (size_t)rc * 512 + 8 * lane) = w;
          if (l == 0) *(u32x4*)(vfirst + ra * 512 + 8 * lane) = w; }
        { bf16_t* lr = la + (size_t)rc * 512;
          const bf16_t* cs = cur; const bf16_t* ps_ = prv; int sc = 512 + 8 * lane, dc = 8 * lane, fn = 0; const float* mup = mu;
          if (lane >= 8) { sc = 1600 + 8 * (lane - 8); dc = 64 + 8 * (lane - 8); fn = 1; }
          if (lane >= 16) { sc = 1664 + 8 * (lane - 16); dc = 128 + 8 * (lane - 16); fn = 2; }
          if (lane >= 32) { cs = left + ra * 32; ps_ = left + (ra - 1) * 32; sc = 8 * (lane - 32); dc = 256 + 8 * (lane - 32); mup = mu + 1792; }
          u32x4 w = {0u, 0u, 0u, 0u};
          if (lane < 36) {
              const u32x4 cu = *(const u32x4*)(cs + sc); u32x4 pu = {0u, 0u, 0u, 0u}; if (hp) pu = *(const u32x4*)(ps_ + sc);
              const f32x4 m0 = *(const f32x4*)(mup + sc), m1 = *(const f32x4*)(mup + sc + 4);
              float x[8];
#pragma unroll
              for (int e = 0; e < 4; ++e) { const float c0 = bflo(cu[e]), c1 = bfhi(cu[e]), p0 = bflo(pu[e]), p1 = bfhi(pu[e]);
                  const float ma = (2 * e < 4) ? m0[2 * e] : m1[2 * e - 4], mb = (2 * e + 1 < 4) ? m0[2 * e + 1] : m1[2 * e + 1 - 4];
                  x[2 * e] = c0 + (p0 - c0) * ma; x[2 * e + 1] = c1 + (p1 - c1) * mb; }
#pragma unroll
              for (int e = 0; e < 8; ++e) { const float th = 1.f - 2.f * frcp(fexp2(2.f * x[e] * LOG2E) + 1.f), sg = fsigmoid(x[e]); x[e] = fn == 0 ? th : (fn == 1 ? x[e] : sg); }
              w[0] = pk2(x[0], x[1]); w[1] = pk2(x[2], x[3]); w[2] = pk2(x[4], x[5]); w[3] = pk2(x[6], x[7]);
          } else dc = 288 + 8 * (lane - 36);
          *(u32x4*)(lr + dc) = w; }
        if (sl == SC - 1) { bf16_t* cp = carry + (size_t)(((c & 1) * 16) + b) * RAWLD;
            for (int j = lane; j < RAWLD / 8; j += 64) *(u32x4*)(cp + 8 * j) = *(const u32x4*)(cur + 8 * j); }
    }
}

DI float dpp_ror_add(float x, int) { return x; }
DI void reduce4(float p0, float p1, float p2, float p3, float& s0, float& s1, float& s2, float& s3) {
    auto r = __builtin_amdgcn_permlane32_swap(__float_as_uint(p0), __float_as_uint(p2), false, false);
    const float u0 = __uint_as_float(r[0]) + __uint_as_float(r[1]);
    r = __builtin_amdgcn_permlane32_swap(__float_as_uint(p1), __float_as_uint(p3), false, false);
    const float u1 = __uint_as_float(r[0]) + __uint_as_float(r[1]);
    r = __builtin_amdgcn_permlane16_swap(__float_as_uint(u0), __float_as_uint(u1), false, false);
    float w = __uint_as_float(r[0]) + __uint_as_float(r[1]);
    w += __uint_as_float(__builtin_amdgcn_update_dpp(0, __float_as_uint(w), 0x128, 0xf, 0xf, false));
    w += __uint_as_float(__builtin_amdgcn_update_dpp(0, __float_as_uint(w), 0x124, 0xf, 0xf, false));
    w += __uint_as_float(__builtin_amdgcn_update_dpp(0, __float_as_uint(w), 0x122, 0xf, 0xf, false));
    w += __uint_as_float(__builtin_amdgcn_update_dpp(0, __float_as_uint(w), 0x121, 0xf, 0xf, false));
    s0 = __uint_as_float(__builtin_amdgcn_readlane(__float_as_uint(w), 0));
    s1 = __uint_as_float(__builtin_amdgcn_readlane(__float_as_uint(w), 16));
    s2 = __uint_as_float(__builtin_amdgcn_readlane(__float_as_uint(w), 32));
    s3 = __uint_as_float(__builtin_amdgcn_readlane(__float_as_uint(w), 48));
}
DI void reduce8(float p0, float p1, float p2, float p3, float q0, float q1, float q2, float q3, float& pw, float& s0, float& s1, float& s2, float& s3) {
    auto r = __builtin_amdgcn_permlane32_swap(__float_as_uint(p0), __float_as_uint(p2), false, false);
    auto t = __builtin_amdgcn_permlane32_swap(__float_as_uint(q0), __float_as_uint(q2), false, false);
    const float u0 = __uint_as_float(r[0]) + __uint_as_float(r[1]);
    const float x0 = __uint_as_float(t[0]) + __uint_as_float(t[1]);
    r = __builtin_amdgcn_permlane32_swap(__float_as_uint(p1), __float_as_uint(p3), false, false);
    t = __builtin_amdgcn_permlane32_swap(__float_as_uint(q1), __float_as_uint(q3), false, false);
    const float u1 = __uint_as_float(r[0]) + __uint_as_float(r[1]);
    const float x1 = __uint_as_float(t[0]) + __uint_as_float(t[1]);
    r = __builtin_amdgcn_permlane16_swap(__float_as_uint(u0), __float_as_uint(u1), false, false);
    t = __builtin_amdgcn_permlane16_swap(__float_as_uint(x0), __float_as_uint(x1), false, false);
    float w = __uint_as_float(r[0]) + __uint_as_float(r[1]);
    float y = __uint_as_float(t[0]) + __uint_as_float(t[1]);
    w += __uint_as_float(__builtin_amdgcn_update_dpp(0, __float_as_uint(w), 0x128, 0xf, 0xf, false));
    y += __uint_as_float(__builtin_amdgcn_update_dpp(0, __float_as_uint(y), 0x128, 0xf, 0xf, false));
    w += __uint_as_float(__builtin_amdgcn_update_dpp(0, __float_as_uint(w), 0x124, 0xf, 0xf, false));
    y += __uint_as_float(__builtin_amdgcn_update_dpp(0, __float_as_uint(y), 0x124, 0xf, 0xf, false));
    w += __uint_as_float(__builtin_amdgcn_update_dpp(0, __float_as_uint(w), 0x122, 0xf, 0xf, false));
    y += __uint_as_float(__builtin_amdgcn_update_dpp(0, __float_as_uint(y), 0x122, 0xf, 0xf, false));
    w += __uint_as_float(__builtin_amdgcn_update_dpp(0, __float_as_uint(w), 0x121, 0xf, 0xf, false));
    y += __uint_as_float(__builtin_amdgcn_update_dpp(0, __float_as_uint(y), 0x121, 0xf, 0xf, false));
    pw = w;
    s0 = __uint_as_float(__builtin_amdgcn_readlane(__float_as_uint(y), 0));
    s1 = __uint_as_float(__builtin_amdgcn_readlane(__float_as_uint(y), 16));
    s2 = __uint_as_float(__builtin_amdgcn_readlane(__float_as_uint(y), 32));
    s3 = __uint_as_float(__builtin_amdgcn_readlane(__float_as_uint(y), 48));
}
struct ScanIn { bf16_t kk, bb, k, r, v; float w; };
DI void phase_scan(int l, int c, int dummy = 0) {
    const int lane = TID() & 63, gw = BID() * 8 + (TID() >> 6), nw = gridDim.x * 8;
    const bf16_t* kkb = wsp<bf16_t>(WS_KKB); const bf16_t* bbb = wsp<bf16_t>(WS_BBB); const bf16_t* kfb = wsp<bf16_t>(WS_KF); const bf16_t* rrb = wsp<bf16_t>(WS_RR);
    const bf16_t* vsb = wsp<bf16_t>(l == 0 ? WS_VV : WS_V2); const float* dec = wsp<float>(WS_DEC); float* outb = wsp<float>(WS_OUT); float* state = wsp<float>(WS_STATE);
    for (int item = gw; item < NB * NH * 16; item += nw) {
        const int bh = item >> 4, rg = item & 15, b = bh >> 3, h = bh & 7, i0 = rg * 4;
        float* stp = state + ((size_t)bh * 64 + i0) * 64 + lane;
        float S0 = 0.f, S1 = 0.f, S2 = 0.f, S3 = 0.f;
        if (c > 0) { S0 = stp[0]; S1 = stp[64]; S2 = stp[128]; S3 = stp[192]; }
        const size_t e0 = (size_t)b * SC * 512 + h * 64 + lane;
        const size_t ev = (size_t)b * SC * 512 + h * 64 + i0 + (lane & 3);
        float* op = outb + (size_t)b * SC * 512 + h * 64 + i0 + (lane >> 4);
        ScanIn A[8], B[8];
#define SCAN_LOAD(X, g) do { _Pragma("unroll") for (int j = 0; j < 8; ++j) { const size_t o = (size_t)((g) * 8 + j) * 512; \
            X[j].kk = kkb[e0 + o]; X[j].bb = bbb[e0 + o]; X[j].k = kfb[e0 + o]; X[j].r = rrb[e0 + o]; X[j].w = dec[e0 + o]; X[j].v = vsb[ev + o]; } } while (0)
#define SCAN_STEP1(Xj, kknext, t) do { \
            const float bb = bf2f(Xj.bb), kx = bf2f(Xj.k), rx = bf2f(Xj.r), wx = Xj.w; const unsigned vu = (unsigned)Xj.v << 16; \
            const float v0 = __uint_as_float(__builtin_amdgcn_readlane(vu, 0)), v1 = __uint_as_float(__builtin_amdgcn_readlane(vu, 1)), v2 = __uint_as_float(__builtin_amdgcn_readlane(vu, 2)), v3 = __uint_as_float(__builtin_amdgcn_readlane(vu, 3)); \
            S0 = S0 * wx + (v0 * kx - a0 * bb); S1 = S1 * wx + (v1 * kx - a1 * bb); S2 = S2 * wx + (v2 * kx - a2 * bb); S3 = S3 * wx + (v3 * kx - a3 * bb); \
            float ov; const float kn = (kknext); \
            reduce8(S0 * rx, S1 * rx, S2 * rx, S3 * rx, S0 * kn, S1 * kn, S2 * kn, S3 * kn, ov, a0, a1, a2, a3); \
            if ((lane & 15) == 0) op[(size_t)(t) * 512] = ov; } while (0)
#define SCAN_GROUP(X, Y, g, lastg) do { _Pragma("unroll") for (int j = 0; j < 8; ++j) { \
            const float kkn = (j < 7) ? bf2f(X[j < 7 ? j + 1 : 7].kk) : ((lastg) ? 0.f : bf2f(Y[0].kk)); \
            SCAN_STEP1(X[j], kkn, (g) * 8 + j); } } while (0)
        SCAN_LOAD(A, 0);
        float a0, a1, a2, a3;
        { const float k0 = bf2f(A[0].kk); reduce4(S0 * k0, S1 * k0, S2 * k0, S3 * k0, a0, a1, a2, a3); }
#if DBL_PHASE == 11
        if (dummy == 2) {
            float acc_ = 0.f;
            for (int g = 0; g < SC / 8; g += 2) {
                SCAN_LOAD(B, g + 1);
#pragma unroll
                for (int j = 0; j < 8; ++j) acc_ += bf2f(A[j].kk) + bf2f(A[j].bb) + bf2f(A[j].k) + bf2f(A[j].r) + bf2f(A[j].v) + A[j].w;
                if (g + 2 < SC / 8) SCAN_LOAD(A, g + 2);
#pragma unroll
                for (int j = 0; j < 8; ++j) acc_ += bf2f(B[j].kk) + bf2f(B[j].bb) + bf2f(B[j].k) + bf2f(B[j].r) + bf2f(B[j].v) + B[j].w;
            }
            if (acc_ == 12345.678f) stp[0] = acc_;
            continue;
        }
#endif
#if DBL_PHASE == 12
        if (dummy == 3) {
#pragma unroll
            for (int j = 0; j < 8; ++j) { A[j].kk = (bf16_t)(0x3c00 + lane + j); A[j].bb = (bf16_t)(0x3b00 + lane); A[j].k = (bf16_t)(0x3d00 + j); A[j].r = (bf16_t)(0x3e00 + lane); A[j].v = (bf16_t)(0x3c80 + j); A[j].w = 0.9f; B[j] = A[j]; }
            op = wsp<float>(WS_RAW) + (size_t)item * 4 + (lane >> 4);
            for (int g = 0; g < SC / 8; g += 2) {
                SCAN_GROUP(A, B, 0, false);
                SCAN_GROUP(B, A, 0, false);
            }
            if (S0 + S1 + S2 + S3 == 12345.678f) stp[0] = S0;
            continue;
        }
#endif
        for (int g = 0; g < SC / 8; g += 2) {
            SCAN_LOAD(B, g + 1);
            SCAN_GROUP(A, B, g, false);
            const bool last = (g + 2 >= SC / 8);
            if (!last) SCAN_LOAD(A, g + 2);
            SCAN_GROUP(B, A, g + 1, last);
        }
#undef SCAN_STEP1
#undef SCAN_GROUP
#undef SCAN_LOAD
        if (!dummy) { stp[0] = S0; stp[64] = S1; stp[128] = S2; stp[192] = S3; }
    }
}
typedef short s16x4 __attribute__((ext_vector_type(4)));
#define M16K32(a, b, c) __builtin_amdgcn_mfma_f32_16x16x32_bf16((a), (b), (c), 0, 0, 0)
#define M16K16(a, b, c) __builtin_amdgcn_mfma_f32_16x16x16bf16_1k((a), (b), (c), 0, 0, 0)
DI s16x4 pk4(f32x4 v) { u32x2 u; u[0] = pk2(v[0], v[1]); u[1] = pk2(v[2], v[3]); return __builtin_bit_cast(s16x4, u); }
DI float dpp_shr1(float x, float old) { return __uint_as_float(__builtin_amdgcn_update_dpp(__float_as_uint(old), __float_as_uint(x), 0x111, 0xf, 0xf, false)); }
DI float dpp_shr2(float x, float old) { return __uint_as_float(__builtin_amdgcn_update_dpp(__float_as_uint(old), __float_as_uint(x), 0x112, 0xf, 0xf, false)); }
DI float dpp_shr4(float x, float old) { return __uint_as_float(__builtin_amdgcn_update_dpp(__float_as_uint(old), __float_as_uint(x), 0x114, 0xf, 0xf, false)); }
DI float dpp_shr8(float x, float old) { return __uint_as_float(__builtin_amdgcn_update_dpp(__float_as_uint(old), __float_as_uint(x), 0x118, 0xf, 0xf, false)); }
DI float dpp_bcast15(float x) { return __uint_as_float(__builtin_amdgcn_update_dpp(0, __float_as_uint(x), 0x15F, 0xf, 0xf, false)); }
DI void phase_scan_chunked(int l, int c, LAS unsigned char* lds, bool dummy = false) {
    const int tid = TID(), lane = tid & 63, wave = tid >> 6, r16 = lane & 15, g = lane >> 4;
    if (wave >= 2) return;
    const int item = BID() * 2 + wave;
    if (item >= NB * NH * 4) return;
    const int bh = item >> 2, ig = item & 3, b = bh >> 3, h = bh & 7, i0 = 16 * ig;
    LAS unsigned char* wl = lds + wave * 4096;
    const bf16_t* kkb = wsp<bf16_t>(WS_KKB); const bf16_t* bbb = wsp<bf16_t>(WS_BBB); const bf16_t* kfb = wsp<bf16_t>(WS_KF); const bf16_t* rrb = wsp<bf16_t>(WS_RR);
    const bf16_t* vsb = wsp<bf16_t>(l == 0 ? WS_VV : WS_V2); const float* dec = wsp<float>(WS_DEC); float* outb = wsp<float>(WS_OUT);
    float* stp = wsp<float>(WS_STATE) + ((size_t)bh * 64 + i0 + r16) * 64 + 8 * g;
    f32x4 ST[4];
#pragma unroll
    for (int sg = 0; sg < 4; ++sg) ST[sg] = (c > 0) ? *(const f32x4*)(stp + 32 * (sg >> 1) + 4 * (sg & 1)) : (f32x4){0.f, 0.f, 0.f, 0.f};
    const size_t e0 = ((size_t)b * SC + r16) * 512 + h * 64 + 8 * g;
    const size_t ev = ((size_t)b * SC + 4 * g) * 512 + h * 64 + i0 + r16;
    const size_t eo = ((size_t)b * SC + 4 * g) * 512 + h * 64 + i0 + r16;
    u32x4 rk[2], rb[2], rq[2], rr_[2]; f32x4 rw[4]; bf16_t rv[4];
#define CS_LOAD(blk) do { const size_t o = e0 + (size_t)(blk) * 16 * 512; _Pragma("unroll") for (int s = 0; s < 2; ++s) { \
        rk[s] = *(const u32x4*)(kkb + o + 32 * s); rb[s] = *(const u32x4*)(bbb + o + 32 * s); rq[s] = *(const u32x4*)(kfb + o + 32 * s); rr_[s] = *(const u32x4*)(rrb + o + 32 * s); \
        rw[2 * s] = *(const f32x4*)(dec + o + 32 * s); rw[2 * s + 1] = *(const f32x4*)(dec + o + 32 * s + 4); } \
        _Pragma("unroll") for (int e = 0; e < 4; ++e) rv[e] = vsb[ev + (size_t)(blk) * 16 * 512 + (size_t)e * 512]; } while (0)
    CS_LOAD(0);
    for (int blk = 0; blk < SC / 16; ++blk) {
        float P[16], kap[16], bet[16], kq[16], rt[16];
#pragma unroll
        for (int s = 0; s < 2; ++s)
#pragma unroll
            for (int q = 0; q < 4; ++q) { const int i = 8 * s + 2 * q;
                kap[i] = bflo(rk[s][q]); kap[i + 1] = bfhi(rk[s][q]); bet[i] = bflo(rb[s][q]); bet[i + 1] = bfhi(rb[s][q]);
                kq[i] = bflo(rq[s][q]); kq[i + 1] = bfhi(rq[s][q]); rt[i] = bflo(rr_[s][q]); rt[i + 1] = bfhi(rr_[s][q]);
                P[i] = rw[2 * s + (q >> 1)][2 * (q & 1)]; P[i + 1] = rw[2 * s + (q >> 1)][2 * (q & 1) + 1]; }
        s16x4 Vb; { u32x2 u; u[0] = (unsigned)rv[0] | ((unsigned)rv[1] << 16); u[1] = (unsigned)rv[2] | ((unsigned)rv[3] << 16); Vb = __builtin_bit_cast(s16x4, u); }
        if (blk + 1 < SC / 16) CS_LOAD(blk + 1);
        float P16[16];
        bf16x8 ktp[2], btp[2], kqp[2], rtp[2];
#pragma unroll
        for (int i = 0; i < 16; ++i) { float p = P[i];
            p *= dpp_shr1(p, 1.f); p *= dpp_shr2(p, 1.f); p *= dpp_shr4(p, 1.f); p *= dpp_shr8(p, 1.f);
            const float pm1 = dpp_shr1(p, 1.f); const float inv = frcp(p); const float p16 = dpp_bcast15(p);
            P16[i] = p16; kap[i] *= pm1; bet[i] *= inv; kq[i] *= inv; rt[i] *= p; }
#pragma unroll
        for (int s = 0; s < 2; ++s) { u32x4 a, bb_, cc, dd;
#pragma unroll
            for (int q = 0; q < 4; ++q) { const int i = 8 * s + 2 * q; a[q] = pk2(kap[i], kap[i + 1]); bb_[q] = pk2(bet[i], bet[i + 1]); cc[q] = pk2(kq[i], kq[i + 1]); dd[q] = pk2(rt[i], rt[i + 1]); }
            ktp[s] = __builtin_bit_cast(bf16x8, a); btp[s] = __builtin_bit_cast(bf16x8, bb_); kqp[s] = __builtin_bit_cast(bf16x8, cc); rtp[s] = __builtin_bit_cast(bf16x8, dd); }
#pragma unroll
        for (int s = 0; s < 2; ++s)
#pragma unroll
            for (int hb = 0; hb < 2; ++hb) { const int i = 8 * s + 4 * hb; u32x2 uk, ub;
                uk[0] = pk2(kq[i] * P16[i], kq[i + 1] * P16[i + 1]); uk[1] = pk2(kq[i + 2] * P16[i + 2], kq[i + 3] * P16[i + 3]);
                ub[0] = pk2(bet[i] * P16[i], bet[i + 1] * P16[i + 1]); ub[1] = pk2(bet[i + 2] * P16[i + 2], bet[i + 3] * P16[i + 3]);
                const int off = r16 * 128 + (32 * s + 16 * hb + 4 * g) * 2;
                *(LAS u32x2*)(wl + off) = uk; *(LAS u32x2*)(wl + 2048 + off) = ub; }
        const f32x4 Z = {0.f, 0.f, 0.f, 0.f};
        f32x4 A1a = M16K32(btp[1], ktp[1], M16K32(btp[0], ktp[0], Z));
        f32x4 A1c = M16K32(ktp[1], btp[1], M16K32(ktp[0], btp[0], Z));
        f32x4 A2a = M16K32(kqp[1], ktp[1], M16K32(kqp[0], ktp[0], Z));
        f32x4 B1a = M16K32(btp[1], rtp[1], M16K32(btp[0], rtp[0], Z));
        f32x4 B2a = M16K32(kqp[1], rtp[1], M16K32(kqp[0], rtp[0], Z));
#pragma unroll
        for (int e = 0; e < 4; ++e) { const int s_ = 4 * g + e;
            A1a[e] = (s_ < r16) ? A1a[e] : 0.f; A2a[e] = (s_ < r16) ? A2a[e] : 0.f; A1c[e] = (r16 < s_) ? A1c[e] : 0.f;
            B1a[e] = (s_ <= r16) ? B1a[e] : 0.f; B2a[e] = (s_ <= r16) ? B2a[e] : 0.f; }
        const s16x4 a1a = pk4(A1a), a1c = pk4(A1c);
        const f32x4 M2a = M16K16(a1c, a1a, Z), M2c = M16K16(a1a, a1c, Z);
        const s16x4 m2a = pk4(M2a), m2c = pk4(M2c);
        const f32x4 M4a = M16K16(m2c, m2a, Z), M4c = M16K16(m2a, m2c, Z);
        const s16x4 m4a = pk4(M4a), m4c = pk4(M4c);
        const s16x4 m8a = pk4(M16K16(m4c, m4a, Z));
        s16x4 stb[4];
#pragma unroll
        for (int sg = 0; sg < 4; ++sg) stb[sg] = pk4(ST[sg]);
        f32x4 G = Z, G2 = Z;
#pragma unroll
        for (int sg = 0; sg < 4; ++sg) {
            const s16x4 kf_ = (sg & 1) ? __builtin_shufflevector(ktp[sg >> 1], ktp[sg >> 1], 4, 5, 6, 7) : __builtin_shufflevector(ktp[sg >> 1], ktp[sg >> 1], 0, 1, 2, 3);
            const s16x4 rf_ = (sg & 1) ? __builtin_shufflevector(rtp[sg >> 1], rtp[sg >> 1], 4, 5, 6, 7) : __builtin_shufflevector(rtp[sg >> 1], rtp[sg >> 1], 0, 1, 2, 3);
            G = M16K16(kf_, stb[sg], G); G2 = M16K16(rf_, stb[sg], G2); }
        const f32x4 RHS = M16K16(pk4(A2a), Vb, G);
        const f32x4 X1 = M16K16(m8a, pk4(RHS), RHS);
        const f32x4 X2 = M16K16(m4a, pk4(X1), X1);
        const f32x4 X3 = M16K16(m2a, pk4(X2), X2);
        const f32x4 U = M16K16(pk4(-A1a), pk4(X3), X3);
        const s16x4 un = pk4(-U);
        f32x4 O = M16K16(pk4(B2a), Vb, G2);
        O = M16K16(pk4(B1a), un, O);
        { float* op = outb + eo + (size_t)blk * 16 * 512;
#pragma unroll
          for (int e = 0; e < 4; ++e) op[(size_t)e * 512] = O[e]; }
#pragma unroll
        for (int sg = 0; sg < 4; ++sg) {
#pragma unroll
            for (int e = 0; e < 4; ++e) ST[sg][e] *= P16[8 * (sg >> 1) + 4 * (sg & 1) + e];
            const int toff = (4 * g + (r16 >> 2)) * 128 + 32 * sg + 8 * (r16 & 3);
            const s16x4 kh = __builtin_amdgcn_ds_read_tr16_b64_v4i16((LAS s16x4*)(wl + toff));
            const s16x4 bh_ = __builtin_amdgcn_ds_read_tr16_b64_v4i16((LAS s16x4*)(wl + 2048 + toff));
            ST[sg] = M16K16(kh, Vb, ST[sg]);
            ST[sg] = M16K16(bh_, un, ST[sg]);
        }
    }
#undef CS_LOAD
    if (dummy) return;
#pragma unroll
    for (int sg = 0; sg < 4; ++sg) *(f32x4*)(stp + 32 * (sg >> 1) + 4 * (sg & 1)) = ST[sg];
}
DI float sum8(float v) {
    v += __uint_as_float(__builtin_amdgcn_update_dpp(0, __float_as_uint(v), 0xB1, 0xf, 0xf, false));
    v += __uint_as_float(__builtin_amdgcn_update_dpp(0, __float_as_uint(v), 0x4E, 0xf, 0xf, false));
    v += __uint_as_float(__builtin_amdgcn_update_dpp(0, __float_as_uint(v), 0x141, 0xf, 0xf, false));
    return v;
}
DI void unpk8(const u32x4 u, float* f) {
#pragma unroll
    for (int q = 0; q < 4; ++q) { f[2 * q] = bflo(u[q]); f[2 * q + 1] = bfhi(u[q]); }
}
DI void phase_rwkv_post(int l, int par) {
    const int lane = TID() & 63, gw = BID() * 8 + (TID() >> 6), nw = gridDim.x * 8;
    const float* outb = wsp<float>(WS_OUT); const bf16_t* rrb = wsp<bf16_t>(WS_RR); const bf16_t* kfb = wsp<bf16_t>(WS_KF);
    const bf16_t* vsb = wsp<bf16_t>(l == 0 ? WS_VV : WS_V2); const bf16_t* ggb = wsp<bf16_t>(WS_GG); bf16_t* orw = wsp<bf16_t>(WS_ORW + par * PAR_O);
    float lw[8], lb[8], rkc[8];
    { const float* lnw = KP()->in[I_LNW] + l * 512 + 8 * lane; const float* lnb = KP()->in[I_LNB] + l * 512 + 8 * lane; const float* rk = KP()->in[I_RK] + l * 512 + 8 * lane;
#pragma unroll
      for (int e = 0; e < 8; ++e) { lw[e] = lnw[e]; lb[e] = lnb[e]; rkc[e] = rk[e]; } }
    for (int row = gw; row < TC; row += nw) {
        const size_t e0 = (size_t)row * 512 + 8 * lane;
        const f32x4 o0 = *(const f32x4*)(outb + e0), o1 = *(const f32x4*)(outb + e0 + 4);
        float o[8] = {o0[0], o0[1], o0[2], o0[3], o1[0], o1[1], o1[2], o1[3]}, r[8], k[8], v[8], g[8];
        unpk8(*(const u32x4*)(rrb + e0), r); unpk8(*(const u32x4*)(kfb + e0), k); unpk8(*(const u32x4*)(vsb + e0), v); unpk8(*(const u32x4*)(ggb + e0), g);
        float s = 0.f, bo = 0.f;
#pragma unroll
        for (int e = 0; e < 8; ++e) { s += o[e]; bo += r[e] * k[e] * rkc[e]; }
        const float mean = sum8(s) * (1.f / 64.f); const float bonus = sum8(bo);
        float q = 0.f;
#pragma unroll
        for (int e = 0; e < 8; ++e) { o[e] -= mean; q += o[e] * o[e]; }
        const float rs = __builtin_amdgcn_rsqf(sum8(q) * (1.f / 64.f) + 64e-5f);
        u32x4 w;
#pragma unroll
        for (int p = 0; p < 4; ++p) { float y0 = (o[2 * p] * rs * lw[2 * p] + lb[2 * p] + bonus * v[2 * p]) * g[2 * p], y1 = (o[2 * p + 1] * rs * lw[2 * p + 1] + lb[2 * p + 1] + bonus * v[2 * p + 1]) * g[2 * p + 1]; w[p] = pk2(y0, y1); }
        *(u32x4*)(orw + e0) = w;
    }
}

#define MFMA32(a, b, c) __builtin_amdgcn_mfma_f32_32x32x16_bf16((a), (b), (c), 0, 0, 0)
DI unsigned fkey(float v) { v = v + 0.f; const unsigned u = __float_as_uint(v); return (u & 0x80000000u) ? ~u : (u | 0x80000000u); }
DI int half_sum(int x) {
    x += __builtin_amdgcn_update_dpp(0, x, 0x128, 0xf, 0xf, false);
    x += __builtin_amdgcn_update_dpp(0, x, 0x124, 0xf, 0xf, false);
    x += __builtin_amdgcn_update_dpp(0, x, 0x122, 0xf, 0xf, false);
    x += __builtin_amdgcn_update_dpp(0, x, 0x121, 0xf, 0xf, false);
    auto r = __builtin_amdgcn_permlane16_swap((unsigned)x, (unsigned)x, false, false);
    return (int)(r[0] + r[1]);
}
DI void dsa_select_half(int c, int item4, int set, int lane) {
    int lz = lane; asm volatile("" : "+v"(lz));
    const int hh = lz >> 5, r5 = lz & 31;
    const int rc0 = item4 * 4, b = rc0 >> 9, t0 = c * SC + (rc0 & 511);
    const int qq = ((r5 >> 2) & 1) + 2 * ((r5 >> 4) ^ set), hd = (r5 & 3) + 4 * ((r5 >> 3) & 1);
    const bf16_t* qp = wsp<bf16_t>(WS_IDXQ) + (size_t)(rc0 + qq) * 256 + hd * 32 + 8 * hh;
    const bf16x8 Af0 = *(const bf16x8*)qp, Af1 = *(const bf16x8*)(qp + 16);
    const int tA = t0 + hh + 2 * set;
    const float* wp = wsp<float>(WS_IDXW) + ((size_t)b * SEQ + tA) * 8;
    const f32x4 wa0 = *(const f32x4*)wp, wa1 = *(const f32x4*)(wp + 4);
    const int ngrp = ((t0 + 2 * set + 1) >> 9) + 1;
    unsigned keyA[64];
    const bf16_t* kbase = wsp<bf16_t>(WS_IDXK) + ((size_t)b * SEQ + r5) * 32 + 8 * hh;
    int keyv = r5; unsigned kofs = 0u;
    bf16x8 Bn0 = *(const bf16x8*)kbase, Bn1 = *(const bf16x8*)(kbase + 16);
#pragma unroll
    for (int g = 0; g < 4; ++g) {
        if (g < ngrp) {
#pragma unroll
            for (int j = 0; j < 16; ++j) {
                const int kt = g * 16 + j;
                const bf16x8 Bf0 = Bn0, Bf1 = Bn1;
                { const unsigned nofs = (kt < 63) ? kofs + 32 * 32 : kofs; const bf16_t* kp = kbase + nofs; Bn0 = *(const bf16x8*)kp; Bn1 = *(const bf16x8*)(kp + 16); }
                f32x16 C = {0.f, 0.f, 0.f, 0.f, 0.f, 0.f, 0.f, 0.f, 0.f, 0.f, 0.f, 0.f, 0.f, 0.f, 0.f, 0.f};
                C = MFMA32(Af0, Bf0, C); C = MFMA32(Af1, Bf1, C);
                float va = 0.f;
#pragma unroll
                for (int i = 0; i < 4; ++i) va = __builtin_fmaf(__builtin_amdgcn_fmed3f(C[i], 0.f, 3.0e38f), wa0[i], va);
#pragma unroll
                for (int i = 0; i < 4; ++i) va = __builtin_fmaf(__builtin_amdgcn_fmed3f(C[4 + i], 0.f, 3.0e38f), wa1[i], va);
                unsigned ka = (keyv <= tA) ? fkey(va) : 0u;
                asm volatile("" : "+v"(ka), "+v"(keyv), "+v"(kofs));
                keyA[kt] = ka;
                keyv += 32; kofs += 32 * 32;
            }
        } else {
#pragma unroll
            for (int j = 0; j < 16; ++j) keyA[g * 16 + j] = 0u;
        }
    }
    unsigned KA = 0u;
    if (t0 + 2 * set + 1 >= 256) {
        bool dA = tA < 255;
        for (int bit = 31; bit >= 0; --bit) {
            const unsigned cA = KA | (1u << bit);
            int nA = 0;
#pragma unroll
            for (int g = 0; g < 4; ++g) {
                if (g < ngrp) {
#pragma unroll
                    for (int j = 0; j < 16; ++j) nA += (keyA[g * 16 + j] >= cA) ? 1 : 0;
                }
            }
            nA = half_sum(nA);
            if (!dA && nA >= 256) KA = cA;
            dA = dA || (nA == 256);
            if (__ballot(dA) == ~0ull) break;
        }
    }
    int gA = 0;
#pragma unroll
    for (int kt = 0; kt < 64; ++kt) gA += (keyA[kt] > KA) ? 1 : 0;
    gA = half_sum(gA);
    const int needA = (KA == 0u) ? 0 : 256 - gA;
    asm volatile("" : "+v"(KA));
    int runA = 0, lsel = lz;
    unsigned w0 = 0u, w1 = 0u;
#pragma unroll
    for (int kt = 0; kt < 64; ++kt) {
        const bool eqA = keyA[kt] == KA;
        const unsigned long long ea = __ballot(eqA);
        const int rkA = runA + (hh ? (int)__builtin_amdgcn_mbcnt_hi((unsigned)(ea >> 32), 0u) : (int)__builtin_amdgcn_mbcnt_lo((unsigned)ea, 0u));
        const bool sA = (keyA[kt] > KA) || (eqA && rkA < needA);
        runA += hh ? __builtin_popcount((unsigned)(ea >> 32)) : __builtin_popcount((unsigned)ea);
        const unsigned long long sa = __ballot(sA);
        if (lsel == 0) { w0 = (unsigned)sa; w1 = (unsigned)(sa >> 32); }
        lsel -= 1; asm volatile("" : "+v"(lsel));
        __builtin_amdgcn_sched_barrier(0);
    }
    unsigned* sp = wsp<unsigned>(WS_SELB) + (size_t)(rc0 + 2 * set) * 64 + lz;
    sp[0] = w0; sp[64] = w1;
}
DI void dsa_select_full(int c, int item, int lane) {
    {
        int lz = lane; asm volatile("" : "+v"(lz));
        const int hh = lz >> 5, r5 = lz & 31;
        const int rc0 = item * 4, b = rc0 >> 9, t0 = c * SC + (rc0 & 511);
        const int qq = ((r5 >> 2) & 1) + 2 * (r5 >> 4), hd = (r5 & 3) + 4 * ((r5 >> 3) & 1);
        const bf16_t* qp = wsp<bf16_t>(WS_IDXQ) + (size_t)(rc0 + qq) * 256 + hd * 32 + 8 * hh;
        const bf16x8 Af0 = *(const bf16x8*)qp, Af1 = *(const bf16x8*)(qp + 16);
        const float* wp = wsp<float>(WS_IDXW) + ((size_t)b * SEQ + t0 + hh) * 8;
        const f32x4 wa0 = *(const f32x4*)wp, wa1 = *(const f32x4*)(wp + 4), wb0 = *(const f32x4*)(wp + 16), wb1 = *(const f32x4*)(wp + 20);
        const int tA = t0 + hh, tB = t0 + hh + 2;
        const int ngrp = ((t0 + 3) >> 9) + 1;
        unsigned keyA[64], keyB[64];
        const bf16_t* kbase = wsp<bf16_t>(WS_IDXK) + ((size_t)b * SEQ + r5) * 32 + 8 * hh;
        int keyv = r5;
        unsigned kofs = 0u;
        bf16x8 Bn0 = *(const bf16x8*)kbase, Bn1 = *(const bf16x8*)(kbase + 16);
#pragma unroll
        for (int g = 0; g < 4; ++g) {
            if (g < ngrp) {
#pragma unroll
                for (int j = 0; j < 16; ++j) {
                    const int kt = g * 16 + j;
                    const bf16x8 Bf0 = Bn0, Bf1 = Bn1;
                    { const unsigned nofs = (kt < 63) ? kofs + 32 * 32 : kofs; const bf16_t* kp = kbase + nofs; Bn0 = *(const bf16x8*)kp; Bn1 = *(const bf16x8*)(kp + 16); }
                    f32x16 C = {0.f, 0.f, 0.f, 0.f, 0.f, 0.f, 0.f, 0.f, 0.f, 0.f, 0.f, 0.f, 0.f, 0.f, 0.f, 0.f};
                    C = MFMA32(Af0, Bf0, C); C = MFMA32(Af1, Bf1, C);
                    float va = 0.f, vb = 0.f;
#pragma unroll
                    for (int i = 0; i < 4; ++i) { va = __builtin_fmaf(__builtin_amdgcn_fmed3f(C[i], 0.f, 3.0e38f), wa0[i], va); vb = __builtin_fmaf(__builtin_amdgcn_fmed3f(C[8 + i], 0.f, 3.0e38f), wb0[i], vb); }
#pragma unroll
                    for (int i = 0; i < 4; ++i) { va = __builtin_fmaf(__builtin_amdgcn_fmed3f(C[4 + i], 0.f, 3.0e38f), wa1[i], va); vb = __builtin_fmaf(__builtin_amdgcn_fmed3f(C[12 + i], 0.f, 3.0e38f), wb1[i], vb); }
                    unsigned ka = (keyv <= tA) ? fkey(va) : 0u, kb = (keyv <= tB) ? fkey(vb) : 0u;
                    asm volatile("" : "+v"(ka), "+v"(kb), "+v"(keyv), "+v"(kofs));
                    keyA[kt] = ka; keyB[kt] = kb;
                    keyv += 32; kofs += 32 * 32;
                }
            } else {
#pragma unroll
                for (int j = 0; j < 16; ++j) { keyA[g * 16 + j] = 0u; keyB[g * 16 + j] = 0u; }
            }
        }
        unsigned KA = 0u, KB = 0u;
        if (t0 + 3 >= 256) {
            bool dA = false, dB = false;
            for (int bit = 31; bit >= 0; --bit) {
                const unsigned bm = 1u << bit;
                const unsigned cA = KA | bm, cB = KB | bm;
                int nA = 0, nB = 0;
#pragma unroll
                for (int g = 0; g < 4; ++g) {
                    if (g < ngrp) {
#pragma unroll
                        for (int j = 0; j < 16; ++j) { nA += (keyA[g * 16 + j] >= cA) ? 1 : 0; nB += (keyB[g * 16 + j] >= cB) ? 1 : 0; }
                    }
                }
                nA = half_sum(nA); nB = half_sum(nB);
                if (!dA && nA >= 256) KA = cA;
                if (!dB && nB >= 256) KB = cB;
                dA = dA || (nA == 256); dB = dB || (nB == 256);
                if (__ballot(dA && dB) == ~0ull) break;
            }
        }
        int gA = 0, gB = 0;
#pragma unroll
        for (int kt = 0; kt < 64; ++kt) { gA += (keyA[kt] > KA) ? 1 : 0; gB += (keyB[kt] > KB) ? 1 : 0; }
        gA = half_sum(gA); gB = half_sum(gB);
        const int needA = (KA == 0u) ? 0 : 256 - gA, needB = (KB == 0u) ? 0 : 256 - gB;
        asm volatile("" : "+v"(KA), "+v"(KB));
        int runA = 0, runB = 0, lsel = lz;
        unsigned w0 = 0u, w1 = 0u, w2 = 0u, w3 = 0u;
#pragma unroll
        for (int kt = 0; kt < 64; ++kt) {
            const bool eqA = keyA[kt] == KA, eqB = keyB[kt] == KB;
            const unsigned long long ea = __ballot(eqA), eb = __ballot(eqB);
            const int rkA = runA + (hh ? (int)__builtin_amdgcn_mbcnt_hi((unsigned)(ea >> 32), 0u) : (int)__builtin_amdgcn_mbcnt_lo((unsigned)ea, 0u));
            const int rkB = runB + (hh ? (int)__builtin_amdgcn_mbcnt_hi((unsigned)(eb >> 32), 0u) : (int)__builtin_amdgcn_mbcnt_lo((unsigned)eb, 0u));
            const bool sA = (keyA[kt] > KA) || (eqA && rkA < needA), sB = (keyB[kt] > KB) || (eqB && rkB < needB);
            runA += hh ? __builtin_popcount((unsigned)(ea >> 32)) : __builtin_popcount((unsigned)ea);
            runB += hh ? __builtin_popcount((unsigned)(eb >> 32)) : __builtin_popcount((unsigned)eb);
            const unsigned long long sa = __ballot(sA), sb = __ballot(sB);
            if (lsel == 0) { w0 = (unsigned)sa; w1 = (unsigned)(sa >> 32); w2 = (unsigned)sb; w3 = (unsigned)(sb >> 32); }
            lsel -= 1; asm volatile("" : "+v"(lsel));
            __builtin_amdgcn_sched_barrier(0);
        }
        unsigned* sp = wsp<unsigned>(WS_SELB) + (size_t)rc0 * 64 + lz;
        sp[0] = w0; sp[64] = w1; sp[128] = w2; sp[192] = w3;
    }
}

DI void phase_dsa_select_queue(int c, LAS unsigned* ctr) {
    const int lane = TID() & 63;
    const int base = BID() * 8;
    for (;;) {
        unsigned idx = 0u;
        if (lane == 0) idx = __hip_atomic_fetch_add(ctr, 1u, __ATOMIC_RELAXED, __HIP_MEMORY_SCOPE_WORKGROUP);
        idx = (unsigned)__builtin_amdgcn_readfirstlane((int)idx);
        if (idx >= 8u) break;
        const int item4 = base + (int)idx;
        if (item4 < TC / 4) dsa_select_full(c, item4, lane);
    }
}

struct AttnSt { f32x16 O0, O1; float m, l; };
constexpr float C2 = 0.125f * LOG2E;
DI void attn_load_kv(bf16x8 (&Kf)[4], bf16x8 (&Vf)[2][2], const bf16_t* kbase, const bf16_t* vtbase, int key0, int lane) {
    const int r5 = lane & 31;
    const int prow = (r5 & 19) | ((r5 & 4) << 1) | ((r5 & 8) >> 1);
    const bf16_t* kp = kbase + (size_t)(key0 + prow) * 512;
#pragma unroll
    for (int s = 0; s < 4; ++s) Kf[s] = *(const bf16x8*)(kp + 16 * s);
#pragma unroll
    for (int n = 0; n < 2; ++n)
#pragma unroll
        for (int s = 0; s < 2; ++s) Vf[n][s] = *(const bf16x8*)(vtbase + (size_t)(32 * n) * SEQ + key0 + 16 * s);
}
constexpr int BT_N = 192;
template <int MODE, bool FAR>
DI void attn_tile(AttnSt& st, const bf16x8 (&Qf)[4], const bf16x8 (&Kf)[4], const bf16x8 (&Vf)[2][2], int key0, int tq, bool allowed, unsigned word, LAS const float* bt, float ub, int lane) {
    const int hh = lane >> 5;
    const float c0 = (MODE == 0 && !allowed) ? -INFINITY : -ub;
    f32x16 S;
#pragma unroll
    for (int i = 0; i < 16; ++i) S[i] = c0;
#pragma unroll
    for (int s = 0; s < 4; ++s) S = MFMA32(Kf[s], Qf[s], S);
    const unsigned wsh = word >> (8 * hh);
    float ps = 0.f; float pv[16];
    if (FAR) {
        const float cb = bt[BT_N - 1];
#pragma unroll
        for (int i = 0; i < 16; ++i) {
            float p = fexp2(S[i] + cb);
            if (MODE == 1) p = __uint_as_float(__float_as_uint(p) & (unsigned)__builtin_amdgcn_sbfe((int)wsh, 16 * (i >> 3) + (i & 7), 1));
            pv[i] = p; ps += p;
        }
    } else {
        LAS const float* tb_ = bt + (tq - key0 + 32 - 8 * hh - 23);
#pragma unroll
        for (int i = 0; i < 16; ++i) {
            float p = fexp2(S[i] + tb_[23 - (16 * (i >> 3) + (i & 7))]);
            if (MODE == 1) p = __uint_as_float(__float_as_uint(p) & (unsigned)__builtin_amdgcn_sbfe((int)wsh, 16 * (i >> 3) + (i & 7), 1));
            pv[i] = p; ps += p;
        }
    }
    st.l += ps;
#pragma unroll
    for (int s = 0; s < 2; ++s) {
        u32x4 pw; pw[0] = pk2(pv[8 * s], pv[8 * s + 1]); pw[1] = pk2(pv[8 * s + 2], pv[8 * s + 3]); pw[2] = pk2(pv[8 * s + 4], pv[8 * s + 5]); pw[3] = pk2(pv[8 * s + 6], pv[8 * s + 7]);
        const bf16x8 Pf = __builtin_bit_cast(bf16x8, pw);
        st.O0 = MFMA32(Vf[0][s], Pf, st.O0); st.O1 = MFMA32(Vf[1][s], Pf, st.O1);
    }
}
constexpr int AT_KEYS = 128, AT_ROW = 144, AT_VROW = 2 * AT_KEYS + 16, AT_KV = AT_KEYS * AT_ROW, AT_STAGE = AT_KV + 64 * AT_VROW;
template <int MODE>
DI void attn_pair_far(AttnSt& st, const bf16x8 (&Qf)[4], LAS const unsigned char* ks, LAS const unsigned char* vs, int kofs, int vofs, unsigned w0, unsigned w1, const f32x16& CBv, int lane) {
    const int hh = lane >> 5;
    bf16x8 K0[4], K1[4], V0[2][2], V1[2][2];
#pragma unroll
    for (int s = 0; s < 4; ++s) { K0[s] = *(LAS const bf16x8*)(ks + kofs + 32 * s); K1[s] = *(LAS const bf16x8*)(ks + 32 * AT_ROW + kofs + 32 * s); }
#pragma unroll
    for (int n = 0; n < 2; ++n)
#pragma unroll
        for (int s = 0; s < 2; ++s) { V0[n][s] = *(LAS const bf16x8*)(vs + 32 * n * AT_VROW + vofs + 32 * s); V1[n][s] = *(LAS const bf16x8*)(vs + 32 * n * AT_VROW + vofs + 64 + 32 * s); }
    f32x16 S0 = MFMA32(K0[0], Qf[0], CBv), S1 = MFMA32(K1[0], Qf[0], CBv);
#pragma unroll
    for (int s = 1; s < 4; ++s) { S0 = MFMA32(K0[s], Qf[s], S0); S1 = MFMA32(K1[s], Qf[s], S1); }
    const unsigned wa = w0 >> (8 * hh), wb = w1 >> (8 * hh);
    float ps = 0.f; float p0[16], p1[16];
#pragma unroll
    for (int i = 0; i < 16; ++i) {
        float a = fexp2(S0[i]), b = fexp2(S1[i]);
        if (MODE == 1) { a = __uint_as_float(__float_as_uint(a) & (unsigned)__builtin_amdgcn_sbfe((int)wa, 16 * (i >> 3) + (i & 7), 1));
                         b = __uint_as_float(__float_as_uint(b) & (unsigned)__builtin_amdgcn_sbfe((int)wb, 16 * (i >> 3) + (i & 7), 1)); }
        p0[i] = a; p1[i] = b; ps += a + b;
    }
    st.l += ps;
#pragma unroll
    for (int s = 0; s < 2; ++s) {
        u32x4 pw; pw[0] = pk2(p0[8 * s], p0[8 * s + 1]); pw[1] = pk2(p0[8 * s + 2], p0[8 * s + 3]); pw[2] = pk2(p0[8 * s + 4], p0[8 * s + 5]); pw[3] = pk2(p0[8 * s + 6], p0[8 * s + 7]);
        const bf16x8 Pf = __builtin_bit_cast(bf16x8, pw);
        st.O0 = MFMA32(V0[0][s], Pf, st.O0); st.O1 = MFMA32(V0[1][s], Pf, st.O1);
    }
#pragma unroll
    for (int s = 0; s < 2; ++s) {
        u32x4 pw; pw[0] = pk2(p1[8 * s], p1[8 * s + 1]); pw[1] = pk2(p1[8 * s + 2], p1[8 * s + 3]); pw[2] = pk2(p1[8 * s + 4], p1[8 * s + 5]); pw[3] = pk2(p1[8 * s + 6], p1[8 * s + 7]);
        const bf16x8 Pf = __builtin_bit_cast(bf16x8, pw);
        st.O0 = MFMA32(V1[0][s], Pf, st.O0); st.O1 = MFMA32(V1[1][s], Pf, st.O1);
    }
}
template <int MODE>
DI void attn_block(int c, int b, int h, int half, LAS unsigned char* stg, LAS unsigned* uni, LAS const float* bt, float kbound, float bmax, bool dummy) {
    const int tid = TID(), lane = tid & 63, wave = tid >> 6, r5 = lane & 31, hh = lane >> 5;
    bf16_t* qbuf = wsp<bf16_t>((MODE == 0 ? WS_MQ : WS_DQ) + (c & 1) * PAR_O);
    const int tb = c * SC + 256 * half, t0 = tb + 32 * wave, tq = t0 + r5, rowc0 = b * SC + 256 * half + 32 * wave;
    bf16_t* qp = qbuf + (size_t)(rowc0 + r5) * 512 + h * 64;
    bf16x8 Qf[4];
#pragma unroll
    for (int s = 0; s < 4; ++s) Qf[s] = *(const bf16x8*)(qp + 16 * s + 8 * hh);
    AttnSt st; st.m = 0.f; st.l = 0.f;
#pragma unroll
    for (int i = 0; i < 16; ++i) { st.O0[i] = 0.f; st.O1[i] = 0.f; }
    float ub;
    { float q2 = 0.f;
#pragma unroll
      for (int s = 0; s < 4; ++s)
#pragma unroll
          for (int j = 0; j < 8; ++j) { const float v = bf2f((bf16_t)Qf[s][j]); q2 += v * v; }
      q2 += __shfl_xor(q2, 32);
      ub = sqrtf(q2) * kbound + bmax; }
    const int ktl = (t0 + 31) >> 5;
    const int own = tb >> 8;
    unsigned bm = 0u, anyw = 0xffu;
    if (MODE == 0) {
        if (own > 0) {
            const float* km = wsp<float>(WS_KMEAN) + ((size_t)(b * 8 + h) * 8) * 64 + 8 * hh;
            float g[8];
#pragma unroll
            for (int n = 0; n < 8; ++n) {
                g[n] = -INFINITY;
                if (n < own) {
                    float part = 0.f;
#pragma unroll
                    for (int s = 0; s < 4; ++s) { const f32x4 k0 = *(const f32x4*)(km + n * 64 + 16 * s), k1 = *(const f32x4*)(km + n * 64 + 16 * s + 4);
#pragma unroll
                        for (int j = 0; j < 4; ++j) part += bf2f((bf16_t)Qf[s][j]) * k0[j] + bf2f((bf16_t)Qf[s][4 + j]) * k1[j]; }
                    g[n] = part + __shfl_xor(part, 32);
                }
            }
#pragma unroll
            for (int n = 0; n < 8; ++n) {
                if (n < own) { int rank = 0;
#pragma unroll
                    for (int m2 = 0; m2 < 8; ++m2) if (m2 != n && m2 < own) rank += ((g[m2] > g[n]) || (g[m2] == g[n] && m2 < n)) ? 1 : 0;
                    if (rank < 3) bm |= 1u << n; }
            }
        }
        anyw = 1u << own;
#pragma unroll
        for (int n = 0; n < 8; ++n) if (n < own && __ballot((bm >> n) & 1u) != 0ull) anyw |= 1u << n;
    }
    if (tid == 0) uni[0] = 0u;
    __syncthreads();
    if (lane == 0) __hip_atomic_fetch_or(uni, anyw, __ATOMIC_RELAXED, __HIP_MEMORY_SCOPE_WORKGROUP);
    __syncthreads();
    const unsigned anyb = MODE == 0 ? uni[0] : 0xffu;
    const bf16_t* kg[2]; const bf16_t* vg[2]; int klofs[2], vlofs[2];
#pragma unroll
    for (int i = 0; i < 2; ++i) { const int pc_ = tid + 512 * i;
        kg[i] = wsp<bf16_t>(MODE == 0 ? WS_MK : WS_DK) + ((size_t)b * SEQ + (pc_ >> 3)) * 512 + h * 64 + (pc_ & 7) * 8;
        vg[i] = wsp<bf16_t>(MODE == 0 ? WS_MVT : WS_DVT) + ((size_t)b * 512 + h * 64 + (pc_ >> 4)) * SEQ + (pc_ & 15) * 8;
        klofs[i] = (pc_ >> 3) * AT_ROW + (pc_ & 7) * 16; vlofs[i] = AT_KV + (pc_ >> 4) * AT_VROW + (pc_ & 15) * 16; }
    const int prow = (r5 & 19) | ((r5 & 4) << 1) | ((r5 & 8) >> 1);
    const int kofs = prow * AT_ROW + 16 * hh, vofs = r5 * AT_VROW + 16 * hh;
    const unsigned* sp = wsp<unsigned>(WS_SELB) + (size_t)(rowc0 + r5) * 64;
    const int nst = (tb + 256) >> 7;
    int stp = 0;
    if (MODE == 0) { while (!((anyb >> (stp >> 1)) & 1u)) stp += 2; }
    u32x4 kreg[2], vreg[2];
#pragma unroll
    for (int i = 0; i < 2; ++i) { kreg[i] = *(const u32x4*)(kg[i] + (size_t)(stp * AT_KEYS) * 512); vreg[i] = *(const u32x4*)(vg[i] + stp * AT_KEYS);
        *(LAS u32x4*)(stg + klofs[i]) = kreg[i]; *(LAS u32x4*)(stg + vlofs[i]) = vreg[i]; }
    u32x4 wcur = {0u, 0u, 0u, 0u}, wnxt = {0u, 0u, 0u, 0u};
    if (MODE == 1) wcur = *(const u32x4*)(sp + 4 * stp);
    __syncthreads();
    int cur = 0;
    f32x16 CBv; int cbblk = -1;
    while (stp < nst) {
        int nx = stp + 1;
        if (MODE == 0) { while (nx < nst && !((anyb >> (nx >> 1)) & 1u)) nx += 2 - (nx & 1); }
        const bool more = nx < nst;
        if (more) {
#pragma unroll
            for (int i = 0; i < 2; ++i) { kreg[i] = *(const u32x4*)(kg[i] + (size_t)(nx * AT_KEYS) * 512); vreg[i] = *(const u32x4*)(vg[i] + nx * AT_KEYS); }
            if (MODE == 1) wnxt = *(const u32x4*)(sp + 4 * nx); }
        LAS const unsigned char* ks = stg + cur * AT_STAGE; LAS const unsigned char* vs = ks + AT_KV;
        const int nbs = stp >> 1;
        const bool won = (MODE == 1) || (((anyw >> nbs) & 1u) != 0u);
#pragma unroll
        for (int pr = 0; pr < 2; ++pr) {
            const int ktp = 4 * stp + 2 * pr;
            if (won && (ktp + 1 <= ktl) && (t0 - (ktp * 32 + 63) >= 113)) {
                if (cbblk != (MODE == 0 ? nbs : 0)) { cbblk = (MODE == 0 ? nbs : 0);
                    const bool allowed = (MODE == 0) ? ((nbs == own) || (((bm >> nbs) & 1u) != 0u)) : true;
                    const float cb = allowed ? (bt[BT_N - 1] - ub) : -INFINITY;
#pragma unroll
                    for (int i = 0; i < 16; ++i) CBv[i] = cb; }
                attn_pair_far<MODE>(st, Qf, ks + 64 * pr * AT_ROW, vs + 128 * pr, kofs, vofs, wcur[2 * pr], wcur[2 * pr + 1], CBv, lane);
            } else {
#pragma unroll
                for (int uu = 0; uu < 2; ++uu) {
                    const int u = 2 * pr + uu, kt = 4 * stp + u, key0 = kt * 32, nb = kt >> 3;
                    const bool waveon = (kt <= ktl) && (MODE == 1 || ((anyw >> nb) & 1u));
                    if (waveon) {
                        bf16x8 Kf[4], Vf[2][2];
#pragma unroll
                        for (int s = 0; s < 4; ++s) Kf[s] = *(LAS const bf16x8*)(ks + 32 * u * AT_ROW + kofs + 32 * s);
#pragma unroll
                        for (int n = 0; n < 2; ++n)
#pragma unroll
                            for (int s = 0; s < 2; ++s) Vf[n][s] = *(LAS const bf16x8*)(vs + 32 * n * AT_VROW + vofs + 64 * u + 32 * s);
                        const unsigned word = (MODE == 1) ? wcur[u] : 0u;
                        const bool allowed = (MODE == 0) ? ((nb == own) || (((bm >> nb) & 1u) != 0u)) : true;
                        if (t0 - (key0 + 31) >= 113) attn_tile<MODE, true>(st, Qf, Kf, Vf, key0, tq, allowed, word, bt, ub, lane);
                        else attn_tile<MODE, false>(st, Qf, Kf, Vf, key0, tq, allowed, word, bt, ub, lane);
                    }
                }
            }
        }
        if (more) { LAS unsigned char* ws_ = stg + (cur ^ 1) * AT_STAGE;
#pragma unroll
            for (int i = 0; i < 2; ++i) { *(LAS u32x4*)(ws_ + klofs[i]) = kreg[i]; *(LAS u32x4*)(ws_ + vlofs[i]) = vreg[i]; } }
        __syncthreads();
        cur ^= 1; stp = nx; wcur = wnxt;
    }
    const float lt = st.l + __shfl_xor(st.l, 32);
    const float inv = 1.f / lt;
    if (dummy) qp = wsp<bf16_t>(WS_RAW + (MODE ? 8 * MiB : 0)) + (size_t)(rowc0 + r5) * 512 + h * 64;
#pragma unroll
    for (int g4 = 0; g4 < 4; ++g4) {
        st_bf4(qp + 8 * g4 + 4 * hh, (f32x4){st.O0[4 * g4] * inv, st.O0[4 * g4 + 1] * inv, st.O0[4 * g4 + 2] * inv, st.O0[4 * g4 + 3] * inv});
        st_bf4(qp + 32 + 8 * g4 + 4 * hh, (f32x4){st.O1[4 * g4] * inv, st.O1[4 * g4 + 1] * inv, st.O1[4 * g4 + 2] * inv, st.O1[4 * g4 + 3] * inv});
    }
    __syncthreads();
}
__device__ const unsigned char kBucket[128] = {0,1,2,3,4,5,6,7,8,9,10,11,12,13,14,15,16,16,16,17,17,18,18,18,19,19,19,20,20,20,20,21,21,21,21,22,22,22,22,22,23,23,23,23,23,23,24,24,24,24,24,24,25,25,25,25,25,25,25,26,26,26,26,26,26,26,26,27,27,27,27,27,27,27,27,27,27,28,28,28,28,28,28,28,28,28,28,29,29,29,29,29,29,29,29,29,29,29,29,30,30,30,30,30,30,30,30,30,30,30,30,30,30,31,31,31,31,31,31,31,31,31,31,31,31,31,31,31};
DI void phase_attn(int l, int c, LAS float* lds, bool dummy = false) {
    const int tid = TID();
    for (int e = tid; e < 2 * 8 * BT_N; e += 512) { const int j = e % BT_N, h = (e / BT_N) & 7, mx = e / (8 * BT_N); const int d = j - 32;
        lds[e] = (d < 0) ? -INFINITY : KP()->in[I_REL][kBucket[d < 127 ? d : 127] * 16 + mx * 8 + h] * LOG2E; }
    if (tid < 2) { const float* g = KP()->in[I_QKN] + l * 256 + (tid == 0 ? 64 : 192); float m = 0.f; for (int i = 0; i < 64; ++i) m = fmaxf(m, fabsf(g[i])); lds[3072 + tid] = 8.1f * m; }
    if (tid >= 64 && tid < 80) { const int mx = (tid - 64) >> 3, h = (tid - 64) & 7; float m = 0.f; for (int k = 0; k < 32; ++k) m = fmaxf(m, fabsf(KP()->in[I_REL][k * 16 + mx * 8 + h])); lds[3088 + (tid - 64)] = m * LOG2E; }
    __syncthreads();
    LAS unsigned char* stg = (LAS unsigned char*)lds + 16384; LAS unsigned* uni = (LAS unsigned*)((LAS unsigned char*)lds + 12544);
    for (int it = BID(); it < NB * NH * 2; it += gridDim.x) {
        const int bh = it >> 1, b = bh >> 3, h = bh & 7, hf = it & 1;
        attn_block<0>(c, b, h, hf, stg, uni, lds + h * BT_N, lds[3072], lds[3088 + h], dummy);
        attn_block<1>(c, b, h, hf ^ 1, stg, uni, lds + (8 + h) * BT_N, lds[3073], lds[3096 + h], dummy);
    }
    if (!dummy) { phase_rwkv_post(l, c & 1); if (DBL_PHASE == 24) phase_rwkv_post(l, c & 1); }
}

constexpr int LDS_BYTES = pg8::STAGE_BYTES + 256;
constexpr int PH_PER_LAYER = 32, N_PHASES = 2 * PH_PER_LAYER;
#ifndef DBL_PHASE
#define DBL_PHASE 0
#endif
#ifndef MK_ONE_LAUNCH
#define MK_ONE_LAUNCH 1
#endif
__global__ void __launch_bounds__(512, 2) mega(Params p) {
    extern __shared__ __attribute__((aligned(16))) unsigned char lds_raw[];
    LAS unsigned char* lds = (LAS unsigned char*)lds_raw;
    volatile LAS unsigned* bst = (volatile LAS unsigned*)(lds + pg8::STAGE_BYTES);
    if (TID() < 4) bst[TID()] = 0u;
    __syncthreads();
    if (p.ph_hi - p.ph_lo > 1) (void)xcd_barrier_post((unsigned*)(KP()->ws + WS_CTL), bst);
#ifndef PH_ONLY
#define PH_ONLY -1
#endif
#define IN(k) (KP()->ph_lo <= (k) && (k) < KP()->ph_hi)
#define INT(tag, k) ((PH_ONLY < 0 || PH_ONLY == (tag)) && IN(k))
#define SEAM(k) do { if (IN(k) && IN((k) + 1)) { XcdBarrier bar_; bar_.bar = (unsigned*)(KP()->ws + WS_CTL); bar_.x = xb_xcc_id(); bar_.st = (volatile LAS unsigned*)(lds + pg8::STAGE_BYTES); xcd_barrier(bar_); if (DBL_PHASE == 20) xcd_barrier(bar_); } } while (0)
    for (int l = 0; l < 2; ++l) {
        const int pb = PH_PER_LAYER * l;
        if (INT(0, pb + 0)) {
#if DBL_PHASE == 6
            phase_conv(l, (LAS float*)lds);
#endif
            phase_conv(l, (LAS float*)lds);
#if DBL_PHASE == 7
            phase_norm(l == 0 ? KP()->in[I_X] : (const float*)KP()->out, KP()->in[I_NMIX] + l * DM, wsp<bf16_t>(WS_H));
#endif
            phase_norm(l == 0 ? KP()->in[I_X] : (const float*)KP()->out, KP()->in[I_NMIX] + l * DM, wsp<bf16_t>(WS_H)); }
        SEAM(pb + 1);
        if (INT(2, pb + 2)) {
            { const SchedLin S = mk_sched(128, 4, WS_H, WS_WB, 1024); const EpiB E{l}; pg8::gemm_phase(lds, 1024, S, E); }
            { const SchedLin S = mk_sched(2, 128, WS_WV, WS_H, 1024); const EpiVt E{(unsigned)WS_MVT}; pg8::gemm_phase(lds, 1024, S, E); }
#if DBL_PHASE == 9
            { const SchedLin S = mk_sched(128, 4, WS_H, WS_WB, 1024); const EpiB E{l}; pg8::gemm_phase(lds, 1024, S, E); }
            { const SchedLin S = mk_sched(2, 128, WS_WV, WS_H, 1024); const EpiVt E{(unsigned)WS_MVT}; pg8::gemm_phase(lds, 1024, S, E); }
#endif
        }
        SEAM(pb + 2);
        if (INT(3, pb + 3)) { phase_dcn(l); phase_kmean();
#if DBL_PHASE == 14
            phase_kmean();
#endif
        }
        SEAM(pb + 3);
        if (INT(4, pb + 4)) {
            { const SchedLin S = mk_sched(128, 2, WS_DCN, WS_WKVK, 256); const EpiHN E{l}; pg8::gemm_phase(lds, 256, S, E); }
            { const SchedLin S = mk_sched(2, 128, WS_WKVV, WS_DCN, 256); const EpiVt E{(unsigned)WS_DVT}; pg8::gemm_phase(lds, 256, S, E); }
#if DBL_PHASE == 13
            { const SchedLin S = mk_sched(128, 2, WS_DCN, WS_WKVK, 256); const EpiHN E{l}; pg8::gemm_phase(lds, 256, S, E); }
            { const SchedLin S = mk_sched(2, 128, WS_WKVV, WS_DCN, 256); const EpiVt E{(unsigned)WS_DVT}; pg8::gemm_phase(lds, 256, S, E); }
#endif
        }
        SEAM(pb + 4);
        for (int c = 0; c < NCH; ++c) {
            const int pc = pb + 5 + 5 * c + 2 * (c >> 1), cbase = c * SC;
            if (INT(5, pc + 0)) { const SchedLin S = mk_sched(32, 24, WS_H, WS_WD1, 1024, 1, cbase); const EpiD1 E{l, c & 1}; pg8::gemm_phase(lds, 1024, S, E);
#if DBL_PHASE == 5
                pg8::gemm_phase(lds, 1024, S, E);
#endif
#if DBL_PHASE == 27
                { const EpiNull E0{}; pg8::gemm_phase(lds, 1024, S, E0); }
#endif
            }
            SEAM(pc + 0);
            if (INT(6, pc + 1)) {
#if DBL_PHASE == 4
                phase_rwkv_prep(l, c);
#endif

                phase_rwkv_prep(l, c); }
            SEAM(pc + 1);
            if (INT(7, pc + 2)) { const SchedLin S = mk_sched(32, l == 0 ? 6 : 8, WS_LORAA, WS_WL, 512, 0, 0, WS_VV, 6); const EpiLora E{l, cbase}; pg8::gemm_phase(lds, 512, S, E); }
            SEAM(pc + 2);
            if (INT(8, pc + 3)) {
#if DBL_PHASE == 2
                phase_scan_chunked(l, c, lds, true);
#endif
#if DBL_PHASE == 22
                phase_scan_chunked(l, c, lds, true);
#endif

#if DBL_PHASE == 11
                phase_scan(l, c, 2);
#endif
#if DBL_PHASE == 12
                phase_scan(l, c, 3);
#endif
#if DBL_PHASE == 25
                if (TID() == 0) *(LAS unsigned*)(lds + 8192) = 0u;
                __syncthreads();
                phase_scan_chunked(l, c, lds, true); phase_dsa_select_queue(c, (LAS unsigned*)(lds + 8192));
                __syncthreads();
#endif
#if DBL_PHASE == 26
                if (TID() == 0) *(LAS unsigned*)(lds + 8192) = 0u;
                __syncthreads();
                phase_dsa_select_queue(c, (LAS unsigned*)(lds + 8192));
                __syncthreads();
#endif
                if (TID() == 0) *(LAS unsigned*)(lds + 8192) = 0u;
                __syncthreads();
                phase_scan_chunked(l, c, lds);
                phase_dsa_select_queue(c, (LAS unsigned*)(lds + 8192)); }
            SEAM(pc + 3);
            if (INT(9, pc + 4)) {
#if DBL_PHASE == 1
                phase_attn(l, c, (LAS float*)lds, true); __syncthreads();
#endif
                phase_attn(l, c, (LAS float*)lds); }
            SEAM(pc + 4);
            if (c & 1) {
                if (INT(10, pc + 5)) { const SchedMerge S{(int)gridDim.x, (int)BID()}; const EpiMerge E{}; pg8::gemm_phase(lds, 512, S, E);
#if DBL_PHASE == 10
                    pg8::gemm_phase(lds, 512, S, E);
#endif
                }
                SEAM(pc + 5);
                if (INT(11, pc + 6)) { const SchedLin S = mk_sched(64, 4, WS_Y, WS_WO, 1024); const EpiRes E{l == 0 ? 1 : 0, 2, cbase - SC, 0u}; pg8::gemm_phase(lds, 1024, S, E); }
                SEAM(pc + 6);
            }
        }
        if (INT(33, pb + 29)) phase_norm(KP()->out, KP()->in[I_NFFN] + l * DM, wsp<bf16_t>(WS_H));
        SEAM(pb + 29);
        if (INT(34, pb + 30)) { const SchedLin S = mk_sched(128, 22, WS_H, WS_WF1, 1024); const EpiSwiglu E{}; pg8::gemm_phase(lds, 1024, S, E);
#if DBL_PHASE == 8
            pg8::gemm_phase(lds, 1024, S, E);
#endif
        }
        SEAM(pb + 30);
        if (INT(35, pb + 31)) { const SchedLin S = mk_sched(128, 4, WS_ACT, WS_WF2, DFF); const EpiRes E{0, 0, 0, 0u};
#if DBL_PHASE == 16
            { const EpiRes E2{0, 0, 0, (unsigned)(WS_ACT + 176 * MiB)}; pg8::gemm_phase(lds, DFF, S, E2); }
#endif
            pg8::gemm_phase(lds, DFF, S, E); }
        SEAM(pb + 31);
    }
#undef IN
#undef INT
#undef SEAM
}

extern "C" void kernel_launch(void* const* d_in, const int* in_sizes, int n_in, void* d_out, int out_size, void* d_ws, size_t ws_size, hipStream_t stream) {
    static int grid = 0;
    if (grid == 0) {
        if (n_in != 26 || ws_size < WS_END) { grid = -1; return; }
        int dev = 0, cus = 0;
        if (hipGetDevice(&dev) != hipSuccess || hipDeviceGetAttribute(&cus, hipDeviceAttributeMultiprocessorCount, dev) != hipSuccess) { grid = -1; return; }
        if (hipFuncSetAttribute((const void*)mega, hipFuncAttributeMaxDynamicSharedMemorySize, LDS_BYTES) != hipSuccess) { grid = -1; return; }
        grid = cus;
    }
    if (grid < 0) return;
    (void)hipMemsetAsync((char*)d_ws + WS_CTL, 0, 64 * 1024, stream);
    Params p{};
    for (int i = 0; i < 26; ++i) p.in[i] = (const float*)d_in[i];
    p.out = (float*)d_out; p.ws = (unsigned char*)d_ws;
#if MK_ONE_LAUNCH
    p.ph_lo = 0; p.ph_hi = N_PHASES;
    hipLaunchKernelGGL(mega, dim3(grid), dim3(512), LDS_BYTES, stream, p);
#else
    for (int ph = 0; ph < N_PHASES; ++ph) { p.ph_lo = ph; p.ph_hi = ph + 1; hipLaunchKernelGGL(mega, dim3(grid), dim3(512), LDS_BYTES, stream, p); }
#endif
}
```

```cpp
#include <hip/hip_runtime.h>
#include <stdint.h>
#ifndef DBL_PHASE
#define DBL_PHASE 0
#endif

#define DI __device__ __forceinline__
#define LAS __attribute__((address_space(3)))
typedef unsigned short bf16_t;
typedef short bf16x8 __attribute__((ext_vector_type(8)));
typedef float f32x2 __attribute__((ext_vector_type(2)));
typedef float f32x4 __attribute__((ext_vector_type(4)));
typedef float f32x16 __attribute__((ext_vector_type(16)));
typedef unsigned u32x2 __attribute__((ext_vector_type(2)));
typedef unsigned u32x4 __attribute__((ext_vector_type(4)));
typedef __bf16 bf2_t __attribute__((ext_vector_type(2)));

constexpr int NB = 16, SEQ = 2048, DM = 1024, NT = NB * SEQ, NH = 8, BW = 512;
constexpr int NCH = 4, SC = 512, TC = NB * SC;
constexpr int D_IN = 7496, DFF = 2816;
constexpr int C_MQ = 0, C_MK = 512, C_MV = 1024, C_RW = 1536, C_DS = 3360, C_GT = 4424;
constexpr int RAWLD = 1792;
constexpr float NORM_EPS = 1e-6f;
constexpr float LOG2E = 1.4426950408889634f;
constexpr float QSCALE = 0.125f * LOG2E;

constexpr size_t MiB = 1024 * 1024;
constexpr size_t WS_CTL = 0;
constexpr size_t WS_WB = 64 * 1024;
constexpr size_t WS_WV = WS_WB + 2 * MiB;
constexpr size_t WS_WD1 = WS_WV + 1 * MiB;
constexpr size_t WS_WKVK = WS_WD1 + 12 * MiB;
constexpr size_t WS_WKVV = WS_WKVK + MiB / 4;
constexpr size_t WS_WL = WS_WKVV + MiB / 4;
constexpr size_t WS_WBR = WS_WL + 2 * MiB;
constexpr size_t WS_WO = WS_WBR + 3 * MiB;
constexpr size_t WS_WF1 = WS_WO + 2 * MiB;
constexpr size_t WS_WF2 = WS_WF1 + 11 * MiB;
constexpr size_t WS_VFIRST = WS_WF2 + 6 * MiB;
constexpr size_t WS_STATE = WS_VFIRST + 32 * MiB;
constexpr size_t WS_H = WS_STATE + 2 * MiB;
constexpr size_t WS_IDXK = WS_H + 64 * MiB;
constexpr size_t WS_IDXW = WS_IDXK + 2 * MiB;
constexpr size_t WS_LEFT = WS_IDXW + 1 * MiB;
constexpr size_t WS_KMEAN = WS_LEFT + 2 * MiB;
constexpr size_t WS_CARRY = WS_KMEAN + MiB / 4;
constexpr size_t WS_MK = WS_CARRY + MiB / 4;
constexpr size_t WS_MVT = WS_MK + 32 * MiB;
constexpr size_t WS_DK = WS_MVT + 32 * MiB;
constexpr size_t WS_DVT = WS_DK + 32 * MiB;
constexpr size_t WS_MQ = WS_DVT + 32 * MiB;
constexpr size_t WS_DQ = WS_MQ + 16 * MiB;
constexpr size_t WS_ORW = WS_DQ + 16 * MiB;
constexpr size_t WS_GATES = WS_ORW + 16 * MiB;
constexpr size_t PAR_O = 8 * MiB, PAR_G = 24 * MiB;
constexpr size_t WS_IDXQ = WS_GATES + 48 * MiB;
constexpr size_t WS_RAW = WS_IDXQ + 4 * MiB;
constexpr size_t WS_LORAA = WS_RAW + 28 * MiB;
constexpr size_t WS_RR = WS_LORAA + 8 * MiB;
constexpr size_t WS_KF = WS_RR + 8 * MiB;
constexpr size_t WS_VV = WS_KF + 8 * MiB;
constexpr size_t WS_KKB = WS_VV + 8 * MiB;
constexpr size_t WS_BBB = WS_KKB + 8 * MiB;
constexpr size_t WS_GG = WS_BBB + 8 * MiB;
constexpr size_t WS_DEC = WS_GG + 8 * MiB;
constexpr size_t WS_OUT = WS_DEC + 16 * MiB;
constexpr size_t WS_V2 = WS_OUT + 16 * MiB;
constexpr size_t WS_SELB = WS_V2 + 8 * MiB;
constexpr size_t WS_END = WS_SELB + 2 * MiB;
constexpr size_t WS_DCN = WS_RAW;
constexpr size_t WS_Y32 = WS_IDXQ;
constexpr size_t WS_Y = WS_Y32 + 64 * MiB;
static_assert(WS_Y + 32 * MiB <= WS_END, "y32 / y alias");
constexpr size_t WS_ACT = WS_MK;
static_assert(WS_END <= 512 * MiB, "workspace map exceeds 512 MiB");
static_assert(WS_ACT + 176 * MiB <= WS_END, "ACT alias");

DI unsigned pk2(float a, float b) { f32x2 v = {a, b}; return __builtin_bit_cast(unsigned, __builtin_convertvector(v, bf2_t)); }
DI bf16_t f2bf(float a) { return (bf16_t)(pk2(a, 0.f) & 0xffffu); }
DI float bflo(unsigned u) { return __uint_as_float(u << 16); }
DI float bfhi(unsigned u) { return __uint_as_float(u & 0xffff0000u); }
DI float bf2f(bf16_t b) { return __uint_as_float((unsigned)b << 16); }
DI float fexp2(float x) { return __builtin_amdgcn_exp2f(x); }
DI float frcp(float x) { return __builtin_amdgcn_rcpf(x); }
DI float fsigmoid(float x) { return frcp(1.f + fexp2(-x * LOG2E)); }
DI float wave_sum(float v) {
    v += __uint_as_float(__builtin_amdgcn_update_dpp(0, __float_as_uint(v), 0x128, 0xf, 0xf, false));
    v += __uint_as_float(__builtin_amdgcn_update_dpp(0, __float_as_uint(v), 0x124, 0xf, 0xf, false));
    v += __uint_as_float(__builtin_amdgcn_update_dpp(0, __float_as_uint(v), 0x122, 0xf, 0xf, false));
    v += __uint_as_float(__builtin_amdgcn_update_dpp(0, __float_as_uint(v), 0x121, 0xf, 0xf, false));
    auto r = __builtin_amdgcn_permlane16_swap(__float_as_uint(v), __float_as_uint(v), false, false);
    v = __uint_as_float(r[0]) + __uint_as_float(r[1]);
    r = __builtin_amdgcn_permlane32_swap(__float_as_uint(v), __float_as_uint(v), false, false);
    return __uint_as_float(r[0]) + __uint_as_float(r[1]);
}

#define XB_TMO      128
#define XB_XCNT(j)  (256  + 64 * (j))
#define XB_XSUB(j)  (1280 + 64 * (j))
#define XB_XGEN(j)  (2304 + 64 * (j))
#define XB_TOP      3328
#define XB_TOPGEN   3392
#define XCD_BAR_WORDS 3456
#define XB_SPIN_CAP (1u << 18)
__device__ __forceinline__ unsigned xb_ld(unsigned* p)              { return __hip_atomic_load(p, __ATOMIC_RELAXED, __HIP_MEMORY_SCOPE_AGENT); }
__device__ __forceinline__ unsigned xb_add(unsigned* p, unsigned v) { return __hip_atomic_fetch_add(p, v, __ATOMIC_RELAXED, __HIP_MEMORY_SCOPE_AGENT); }
__device__ __forceinline__ unsigned xb_xcc_id() { return (unsigned)__builtin_amdgcn_s_getreg((3 << 11) | 20) & 0xFu; }
#define XB_SPIN(cond, bar) do { unsigned _sp = 0; while (cond) { __builtin_amdgcn_s_sleep(1); \
    if ((++_sp & 255u) == 0u) { if (xb_ld(&(bar)[XB_TMO])) break; if (_sp > XB_SPIN_CAP) { atomicAdd(&(bar)[XB_TMO], 1u); break; } } } } while (0)
struct XcdBarrier { unsigned* bar; unsigned x; volatile LAS unsigned* st; };
__device__ __forceinline__ XcdBarrier xcd_barrier_post(unsigned* bar, volatile LAS unsigned* st) {
    XcdBarrier b; b.bar = bar; b.x = xb_xcc_id(); b.st = st;
    if (threadIdx.x == 0) (void)xb_add(&bar[XB_XCNT(b.x)], 1u);
    return b;
}
__device__ __forceinline__ void xcd_barrier_complete(unsigned* bar, unsigned x, unsigned& nloc, unsigned& nx) {
    const unsigned G = gridDim.x * gridDim.y * gridDim.z;
    unsigned sum, cnt, mine, sp = 0u;
    for (;;) {
        sum = 0u; cnt = 0u; mine = 0u;
#pragma unroll 1
        for (unsigned j = 0; j < 16; ++j) { const unsigned c = xb_ld(&bar[XB_XCNT(j)]); sum += c; cnt += (c > 0u) ? 1u : 0u; mine = (j == x) ? c : mine; }
        if (sum == G) break;
        __builtin_amdgcn_s_sleep(1);
        if ((++sp & 255u) == 0u) { if (xb_ld(&bar[XB_TMO])) break; if (sp > XB_SPIN_CAP) { atomicAdd(&bar[XB_TMO], 1u); break; } }
    }
    nloc = mine > 0u ? mine : 1u; nx = cnt > 0u ? cnt : 1u;
}
__device__ __forceinline__ void xcd_barrier(const XcdBarrier& b) {
    asm volatile("s_waitcnt vmcnt(0)" ::: "memory");
    __syncthreads();
    if (threadIdx.x == 0) {
        unsigned* bar = b.bar;
        __builtin_amdgcn_s_waitcnt(0);
        unsigned nloc = b.st[0], nx = b.st[1];
        if (nloc == 0u) { xcd_barrier_complete(bar, b.x, nloc, nx); b.st[0] = nloc; b.st[1] = nx; }
        const unsigned old = xb_add(&bar[XB_XSUB(b.x)], 1u);
        const unsigned gen = old / nloc;
        if (old + 1u == (gen + 1u) * nloc) {
            __builtin_amdgcn_fence(__ATOMIC_RELEASE, "agent");
            asm volatile("s_waitcnt vmcnt(0)" ::: "memory");
            const unsigned og = xb_add(&bar[XB_TOP], 1u);
            const unsigned tg = og / nx;
            if (og + 1u == (tg + 1u) * nx) xb_add(&bar[XB_TOPGEN], 1u);
            else XB_SPIN(xb_ld(&bar[XB_TOPGEN]) == tg, bar);
            __builtin_amdgcn_fence(__ATOMIC_ACQUIRE, "agent");
            xb_add(&bar[XB_XGEN(b.x)], 1u);
            asm volatile("s_waitcnt vmcnt(0)" ::: "memory");
        } else {
            XB_SPIN(xb_ld(&bar[XB_XGEN(b.x)]) == gen, bar);
            __builtin_amdgcn_fence(__ATOMIC_ACQUIRE, "agent");
            asm volatile("s_waitcnt vmcnt(0)" ::: "memory");
        }
    }
    __syncthreads();
}

DI int TID() { int t = threadIdx.x; asm volatile("" : "+v"(t)); return t; }
DI int BID() { int b = blockIdx.x; asm volatile("" : "+s"(b)); return b; }

namespace pg8 {
constexpr int BM = 256, BK = 64, HALF = 128, HTB = HALF * BK * 2, STAGE_BYTES = 8 * HTB, NXCD = 8, WGM = 8;
DI int lds_byte(int r, int c) { const int st = (r >> 4) * 2 + (c >> 5), rr = r & 15, cc = c & 31, ob = rr * 64 + cc * 2; return st * 1024 + (ob ^ (((ob >> 9) & 1) << 5)); }
DI void stage_rc(int b, int& R, int& C) { const int st = b / 1024, sb = b % 1024, swz = sb ^ (((sb >> 9) & 1) << 5); R = (st >> 1) * 16 + swz / 64; C = (st & 1) * 32 + (swz % 64) / 2; }
struct Unit { int pm, pn, z; };

DI bool order_xcd(int nM, int nN, int G, int c, int i, Unit& u) {
    const int nwg = nM * nN; const long L = (long)i * G + c; if (L >= nwg) return false;
    int wgid = (int)L; { const int q = nwg / NXCD, r = nwg % NXCD, xcd = wgid % NXCD, off = wgid / NXCD; wgid = (xcd < r ? xcd * (q + 1) : r * (q + 1) + (xcd - r) * q) + off; }
    const int nig = WGM * nN, gid = wgid / nig, fm = gid * WGM, gsz = (nM - fm) < WGM ? (nM - fm) : WGM;
    u.pm = fm + ((wgid % nig) % gsz); u.pn = (wgid % nig) / gsz; u.z = 0; return true;
}

template <class Epi, class Sched, bool HALFN = false>
DI void gemm_phase(LAS unsigned char* lds, const int K, const Sched& S, const Epi& E) {
    const int tid = TID(), wid = __builtin_amdgcn_readfirstlane(tid >> 6), lane = tid & 63, wr = wid >> 2, wc = wid & 3, fr = lane & 15, fq = lane >> 4;
    const int nt = K / BK;
    unsigned voffA[2];
#pragma unroll
    for (int i = 0; i < 2; ++i) { int R, C; stage_rc(tid * 16 + i * 8192, R, C); voffA[i] = (unsigned)(R * K + C) * 2u; }
    const size_t kstep = (size_t)(BK * 2);
    const size_t hstep = (size_t)HALF * K * 2;
    const unsigned ldsw = (unsigned)wid * 1024u;
    const int aoff = lds_byte(wr * 64 + fr, fq * 8), boff = lds_byte(wc * 32 + fr, fq * 8);
#define PG8_SA(b, h) (((b) * 2 + (h)) * HTB)
#define PG8_SB(b, h) ((4 + (b) * 2 + (h)) * HTB)
#define PG8_STAGE(bufoff, gbase) do { _Pragma("unroll") for (int _i = 0; _i < 2; ++_i) \
        __builtin_amdgcn_global_load_lds((const unsigned*)((const char*)(gbase) + voffA[_i]), (LAS unsigned*)(lds + (bufoff) + ldsw + _i * 8192), 16, 0, 0); } while (0)
#define PG8_LDA(dst, b, h) do { _Pragma("unroll") for (int m = 0; m < 4; ++m) _Pragma("unroll") for (int k = 0; k < 2; ++k) dst[m][k] = *(const LAS bf16x8*)(lds + PG8_SA(b, h) + aoff + m * 2048 + k * 1024); } while (0)
#define PG8_LDB(dst, b, h) do { _Pragma("unroll") for (int n = 0; n < 2; ++n) _Pragma("unroll") for (int k = 0; k < 2; ++k) dst[n][k] = *(const LAS bf16x8*)(lds + PG8_SB(b, h) + boff + n * 2048 + k * 1024); } while (0)
#define PG8_MMA(ai, bj, At, Bt) do { __builtin_amdgcn_s_setprio(1); _Pragma("unroll") for (int m = 0; m < 4; ++m) _Pragma("unroll") for (int n = 0; n < 2; ++n) _Pragma("unroll") for (int k = 0; k < 2; ++k) \
        acc[ai][bj][m][n] = __builtin_amdgcn_mfma_f32_16x16x32_bf16(Bt[n][k], At[m][k], acc[ai][bj][m][n], 0, 0, 0); __builtin_amdgcn_s_setprio(0); } while (0)
#define PG8_WAIT_V(n) asm volatile("s_waitcnt vmcnt(" #n ")" ::: "memory")
#define PG8_WAIT_L(n) asm volatile("s_waitcnt lgkmcnt(" #n ")" ::: "memory")
#define PG8_BAR __builtin_amdgcn_s_barrier()
#define PG8_SCHED __builtin_amdgcn_sched_barrier(0)
    Unit cur, nxt; int ui = 0;
    if (!S.next(0, cur)) return;
    f32x4 acc[2][2][4][2];
#pragma unroll
    for (int a = 0; a < 2; ++a)
#pragma unroll
        for (int b = 0; b < 2; ++b)
#pragma unroll
            for (int m = 0; m < 4; ++m)
#pragma unroll
                for (int n = 0; n < 2; ++n) acc[a][b][m][n] = (f32x4){0.f, 0.f, 0.f, 0.f};
    bf16x8 At[4][2], B0[2][2], B1[2][2];
    const char* cA = S.aptr(cur); const char* cB = S.bptr(cur);
    PG8_STAGE(PG8_SB(0, 0), cB); PG8_STAGE(PG8_SA(0, 0), cA); PG8_STAGE(PG8_SB(0, 1), cB + hstep); PG8_STAGE(PG8_SA(0, 1), cA + hstep);
    if (wr == 1) PG8_BAR;
    PG8_WAIT_V(4); PG8_BAR;
    PG8_STAGE(PG8_SB(1, 0), cB + kstep); PG8_STAGE(PG8_SA(1, 0), cA + kstep); PG8_STAGE(PG8_SB(1, 1), cB + hstep + kstep);
    PG8_WAIT_V(6); PG8_BAR;
    for (;;) {
        const bool has_next = S.next(ui + 1, nxt);
        const char* nA = has_next ? S.aptr(nxt) : cA; const char* nB = has_next ? S.bptr(nxt) : cB;
#pragma unroll 1
        for (int t = 0; t < nt; t += 2) {
            const bool last = (t == nt - 2);
            const char* a1 = cA + (size_t)(t + 1) * kstep;
            const char* a2 = last ? nA : cA + (size_t)(t + 2) * kstep; const char* b2 = last ? nB : cB + (size_t)(t + 2) * kstep;
            const char* a3 = a2 + kstep; const char* b3 = b2 + kstep;
            PG8_LDB(B0, 0, 0); PG8_SCHED; PG8_LDA(At, 0, 0); PG8_STAGE(PG8_SA(1, 1), a1 + hstep);
            PG8_WAIT_L(8); PG8_BAR; PG8_WAIT_L(0); PG8_MMA(0, 0, At, B0); PG8_BAR; PG8_SCHED;
            PG8_LDB(B1, 0, 1); PG8_STAGE(PG8_SB(0, 0), b2);
            PG8_BAR; PG8_WAIT_L(0); if (!HALFN) PG8_MMA(0, 1, At, B1); PG8_BAR;
            PG8_LDA(At, 0, 1); PG8_STAGE(PG8_SA(0, 0), a2);
            PG8_BAR; PG8_WAIT_L(0); PG8_MMA(1, 0, At, B0); PG8_BAR; PG8_SCHED;
            PG8_STAGE(PG8_SB(0, 1), b2 + hstep);
            PG8_WAIT_V(6); PG8_BAR; if (!HALFN) PG8_MMA(1, 1, At, B1); PG8_BAR;
            PG8_LDB(B0, 1, 0); PG8_SCHED; PG8_LDA(At, 1, 0); PG8_STAGE(PG8_SA(0, 1), a2 + hstep);
            PG8_WAIT_L(8); PG8_BAR; PG8_WAIT_L(0); PG8_MMA(0, 0, At, B0); PG8_BAR; PG8_SCHED;
            PG8_LDB(B1, 1, 1); PG8_STAGE(PG8_SB(1, 0), b3);
            PG8_BAR; PG8_WAIT_L(0); if (!HALFN) PG8_MMA(0, 1, At, B1); PG8_BAR;
            PG8_LDA(At, 1, 1); PG8_STAGE(PG8_SA(1, 0), a3);
            PG8_BAR; PG8_WAIT_L(0); PG8_MMA(1, 0, At, B0); PG8_BAR; PG8_SCHED;
            PG8_STAGE(PG8_SB(1, 1), b3 + hstep);
            PG8_WAIT_V(6); PG8_BAR; if (!HALFN) PG8_MMA(1, 1, At, B1); PG8_BAR;
        }
        { int tz = TID(); asm volatile("" : "+v"(tz));
          const int wz = __builtin_amdgcn_readfirstlane(tz >> 6), lz = tz & 63; E(acc, cur, wz >> 2, wz & 3, lz & 15, lz >> 4); }
        if (!has_next) break;
#pragma unroll
        for (int a = 0; a < 2; ++a)
#pragma unroll
            for (int b = 0; b < (HALFN ? 1 : 2); ++b)
#pragma unroll
                for (int m = 0; m < 4; ++m)
#pragma unroll
                    for (int n = 0; n < 2; ++n) acc[a][b][m][n] = (f32x4){0.f, 0.f, 0.f, 0.f};
        cur = nxt; cA = nA; cB = nB; ++ui;
    }
    PG8_WAIT_V(0);
    if (wr == 0) PG8_BAR;
    PG8_BAR;
#undef PG8_SA
#undef PG8_SB
#undef PG8_STAGE
#undef PG8_LDA
#undef PG8_LDB
#undef PG8_MMA
#undef PG8_WAIT_V
#undef PG8_WAIT_L
#undef PG8_BAR
#undef PG8_SCHED
}
}
using pg8::Unit;
typedef f32x4 AccT[2][2][4][2];

struct Params {
    const float* in[26];
    float* out;
    unsigned char* ws;
    int ph_lo, ph_hi;
};
enum { I_X = 0, I_WIN, I_NMIX, I_NFFN, I_QKN, I_REL, I_MU, I_W0, I_W2, I_A0, I_A2, I_G2, I_KK, I_KA, I_RK, I_LNW, I_LNB, I_V0, I_VA, I_VB, I_KVN, I_KVUP, I_WBR, I_WO, I_F1, I_F2 };

DI const Params* KP() { auto k = __builtin_amdgcn_kernarg_segment_ptr(); asm volatile("" : "+s"(k)); return (const Params*)k; }
template <class T> DI T* wsp(size_t off) { return (T*)(KP()->ws + off); }

DI int cmap_b(int x) { const int pi = x & 255; return (x & ~255) + 64 * ((pi >> 5) & 3) + 32 * (pi >> 7) + 8 * ((pi >> 2) & 3) + 4 * ((pi >> 4) & 1) + (pi & 3); }
DI int cmap_f(int x) { const int pi = x & 255; return (x & ~255) + 64 * ((pi >> 5) & 3) + 32 * (pi >> 7) + 16 * ((pi >> 4) & 1) + 4 * ((pi >> 2) & 3) + (pi & 3); }
DI int wide_col(int x) { return cmap_b(x); }
template <int MAP> DI int colmap(int r) {
    if (MAP == 0) {
        if (r < 512) return C_MK + wide_col(r);
        if (r < 768) return C_DS + 512 + wide_col(r - 512);
        const int a = wide_col(r - 768);
        if (a < 32) return C_DS + 1024 + a;
        if (a < 40) return C_DS + 1056 + (a - 32);
        if (a >= 64 && a < 96) return C_RW + 1792 + (a - 64);
        return -1;
    }
    if (MAP == 1) return C_MV + r;
    if (MAP == 2) {
        if (r < 512) return C_MQ + wide_col(r);
        if (r < 1024) return C_DS + wide_col(r - 512);
        if (r < 1280) return C_DS + 768 + wide_col(r - 1024);
        if (r < 3072) return C_RW + wide_col(r - 1280);
        return C_GT + wide_col(r - 3072);
    }
    if (MAP == 3) return wide_col(r);
    if (MAP == 4) return 512 + r;
    if (MAP == 5) return cmap_b(r);
    if (MAP == 7) return cmap_f(r);
    if (MAP == 6) { const int pn = r >> 8, pi = r & 255;
        return ((pi >> 7) ? DFF : 0) + 128 * pn + 32 * ((pi >> 5) & 3) + 8 * ((pi >> 2) & 3) + 4 * ((pi >> 4) & 1) + (pi & 3); }
    return -1;
}
template <int MAP> DI void conv_t(LAS float* sm, bf16_t* dst, int nrows, int K, const float* src, int ld) {
    const int tid = TID(), tx = tid & 63, ty = tid >> 6;
    const int ntr = nrows / 64, ntk = K / 64, ntiles = ntr * ntk;
    for (int t = BID(); t < ntiles; t += gridDim.x) {
        const int r0 = (t / ntk) * 64, k0 = (t % ntk) * 64;
        const int col = colmap<MAP>(r0 + tx);
#pragma unroll
        for (int i = 0; i < 8; ++i) { const int kl = ty + 8 * i; sm[kl * 65 + tx] = (col >= 0) ? src[(size_t)(k0 + kl) * ld + col] : 0.f; }
        __syncthreads();
#pragma unroll
        for (int i = 0; i < 8; ++i) { const int rl = ty + 8 * i; dst[(size_t)(r0 + rl) * K + k0 + tx] = f2bf(sm[tx * 65 + rl]); }
        __syncthreads();
    }
}
DI void conv_lora(int l) {
    bf16_t* dst = wsp<bf16_t>(WS_WL);
    const float* w2 = KP()->in[I_W2] + (size_t)l * 64 * 512; const float* a2 = KP()->in[I_A2] + (size_t)l * 64 * 512; const float* g2 = KP()->in[I_G2] + (size_t)l * 160 * 512;
    const float* va = KP()->in[I_VA]; const float* vb = KP()->in[I_VB];
    const int n = 2048 * 512;
    for (int e = BID() * 512 + TID(); e < n; e += gridDim.x * 512) {
        const int r = wide_col(e >> 9), k = e & 511; float v = 0.f;
        if (r < 512) { if (k < 64) v = w2[k * 512 + r]; }
        else if (r < 1024) { if (k >= 64 && k < 128) v = a2[(k - 64) * 512 + (r - 512)]; }
        else if (r < 1536) { if (k >= 128 && k < 288) v = g2[(k - 128) * 512 + (r - 1024)]; }
        else if (l == 1) { const int c = r - 1536; float s = 0.f;
#pragma unroll 8
            for (int j = 0; j < 32; ++j) s += va[k * 32 + j] * vb[j * 512 + c];
            v = s; }
        dst[e] = f2bf(v);
    }
}
DI void phase_conv(int l, LAS float* sm) {
    const float* win = KP()->in[I_WIN] + (size_t)l * DM * D_IN;
    conv_t<0>(sm, wsp<bf16_t>(WS_WB), 1024, 1024, win, D_IN);
    conv_t<1>(sm, wsp<bf16_t>(WS_WV), 512, 1024, win, D_IN);
    conv_t<2>(sm, wsp<bf16_t>(WS_WD1), 6144, 1024, win, D_IN);
    const float* kvup = KP()->in[I_KVUP] + (size_t)l * 256 * 1024;
    conv_t<3>(sm, wsp<bf16_t>(WS_WKVK), 512, 256, kvup, 1024);
    conv_t<4>(sm, wsp<bf16_t>(WS_WKVV), 512, 256, kvup, 1024);
    for (int i = 0; i < 3; ++i) conv_t<5>(sm, wsp<bf16_t>(WS_WBR) + (size_t)i * 1024 * 512, 1024, 512, KP()->in[I_WBR] + ((size_t)l * 3 + i) * 512 * 1024, 1024);
    conv_t<7>(sm, wsp<bf16_t>(WS_WO), 1024, 1024, KP()->in[I_WO] + (size_t)l * 1024 * 1024, 1024);
    conv_t<6>(sm, wsp<bf16_t>(WS_WF1), 5632, 1024, KP()->in[I_F1] + (size_t)l * 1024 * 5632, 5632);
    conv_t<7>(sm, wsp<bf16_t>(WS_WF2), 1024, 2816, KP()->in[I_F2] + (size_t)l * 2816 * 1024, 1024);
    conv_lora(l);
}

DI void phase_norm(const float* x, const float* g, bf16_t* h) {
    const int lane = TID() & 63, gw = BID() * 8 + (TID() >> 6), nw = gridDim.x * 8;
    f32x4 gv[4];
#pragma unroll
    for (int i = 0; i < 4; ++i) gv[i] = ((const f32x4*)g)[lane + 64 * i];
    for (int row = gw; row < NT; row += nw) {
        const f32x4* xr = (const f32x4*)(x + (size_t)row * DM);
        f32x4 v[4]; float ss = 0.f;
#pragma unroll
        for (int i = 0; i < 4; ++i) { v[i] = xr[lane + 64 * i]; ss += v[i][0] * v[i][0] + v[i][1] * v[i][1] + v[i][2] * v[i][2] + v[i][3] * v[i][3]; }
        ss = wave_sum(ss);
        const float rs = __builtin_amdgcn_rsqf(ss * (1.f / DM) + NORM_EPS);
#pragma unroll
        for (int i = 0; i < 4; ++i) {
            u32x2 o; o[0] = pk2(v[i][0] * rs * gv[i][0], v[i][1] * rs * gv[i][1]); o[1] = pk2(v[i][2] * rs * gv[i][2], v[i][3] * rs * gv[i][3]);
            *(u32x2*)(h + (size_t)row * DM + 4 * (lane + 64 * i)) = o;
        }
    }
}

struct SchedLin {
    int nM, nN, G, c; unsigned aoff, boff, a2off; int rowbytes, amode, cbase, pn2;
    DI bool next(int i, Unit& u) const { return pg8::order_xcd(nM, nN, G, c, i, u); }
    DI const char* aptr(const Unit& u) const { const int row0 = amode ? ((u.pm >> 1) * SEQ + cbase + (u.pm & 1) * 256) : u.pm * 256; return (const char*)KP()->ws + ((u.pn >= pn2) ? a2off : aoff) + (size_t)row0 * rowbytes; }
    DI const char* bptr(const Unit& u) const { return (const char*)KP()->ws + boff + (size_t)u.pn * 256 * rowbytes; }
};
DI SchedLin mk_sched(int nM, int nN, size_t aoff, size_t boff, int K, int amode = 0, int cbase = 0, size_t a2off = 0, int pn2 = 1 << 30) {
    SchedLin s; s.nM = nM; s.nN = nN; s.G = gridDim.x; s.c = BID(); s.aoff = (unsigned)aoff; s.boff = (unsigned)boff; s.rowbytes = K * 2; s.amode = amode; s.cbase = cbase; s.a2off = (unsigned)a2off; s.pn2 = pn2; return s;
}
struct SchedMerge {
    int G, c;
    DI bool next(int i, Unit& u) const { const int z = i % 3, tile = (i / 3) * G + c; if (tile >= 256) return false; u.pm = tile >> 2; u.pn = tile & 3; u.z = z; return true; }
    DI const char* aptr(const Unit& u) const { return (const char*)KP()->ws + (u.z == 0 ? WS_MQ : (u.z == 1 ? WS_ORW : WS_DQ)) + (size_t)(u.pm >> 5) * PAR_O + (size_t)(u.pm & 31) * 256 * 1024; }
    DI const char* bptr(const Unit& u) const { return (const char*)KP()->ws + WS_WBR + (size_t)u.z * (1024 * 512 * 2) + (size_t)u.pn * 256 * 1024; }
};

DI void st_bf4(bf16_t* p, f32x4 v) { u32x2 o; o[0] = pk2(v[0], v[1]); o[1] = pk2(v[2], v[3]); *(u32x2*)p = o; }
DI f32x4 ld_bf4(const bf16_t* p) { const u32x2 u = *(const u32x2*)p; return (f32x4){bflo(u[0]), bfhi(u[0]), bflo(u[1]), bfhi(u[1])}; }
#define EPI_ROWS(ai, m) (128 * (ai) + 64 * wr + 16 * (m) + fr)
#define EPI_COLS(bj, n) (64 * wc + 32 * (bj) + 8 * fq + 4 * (n))
#define EPI_COLS_F(bj, n) (64 * wc + 32 * (bj) + 16 * (n) + 4 * fq)
#define EPI_COLS_T(bj, n) (128 * (bj) + 32 * wc + 16 * (n) + 4 * fq)
#define FOR_AM _Pragma("unroll") for (int ai = 0; ai < 2; ++ai) _Pragma("unroll") for (int m = 0; m < 4; ++m)
#define FOR_BN _Pragma("unroll") for (int bj = 0; bj < 2; ++bj) _Pragma("unroll") for (int n = 0; n < 2; ++n)

constexpr int XS_OFF = pg8::STAGE_BYTES + 256, XS_BYTES = 4096;
DI float row16_sum(float v) {
    v += __uint_as_float(__builtin_amdgcn_update_dpp(0, __float_as_uint(v), 0x128, 0xf, 0xf, false));
    v += __uint_as_float(__builtin_amdgcn_update_dpp(0, __float_as_uint(v), 0x124, 0xf, 0xf, false));
    v += __uint_as_float(__builtin_amdgcn_update_dpp(0, __float_as_uint(v), 0x122, 0xf, 0xf, false));
    v += __uint_as_float(__builtin_amdgcn_update_dpp(0, __float_as_uint(v), 0x121, 0xf, 0xf, false));
    return v;
}
template <bool KM = false>
DI void epi_headnorm(const AccT& acc, bf16_t* out, int ld, const float* gain, int wr, int wc, int fr, int fq, float gscale = 1.f, float* kmo = nullptr) {
    f32x4 gv[2][2], cs[2][2];
    FOR_BN { gv[bj][n] = *(const f32x4*)(gain + 32 * bj + 8 * fq + 4 * n) * gscale; cs[bj][n] = (f32x4){0.f, 0.f, 0.f, 0.f}; }
    FOR_AM {
        float ss = 0.f;
        FOR_BN { const f32x4 a = acc[ai][bj][m][n]; ss += a[0] * a[0] + a[1] * a[1] + a[2] * a[2] + a[3] * a[3]; }
        ss += __shfl_xor(ss, 16); ss += __shfl_xor(ss, 32);
        const float sc = __builtin_amdgcn_rsqf(ss * (1.f / 64.f) + NORM_EPS);
        bf16_t* rp = out + (size_t)EPI_ROWS(ai, m) * ld;
        FOR_BN { const f32x4 o = acc[ai][bj][m][n] * sc * gv[bj][n]; st_bf4(rp + EPI_COLS(bj, n), o); if (KM) cs[bj][n] += o; }
    }
    if (KM) {
        LAS float* xs = (LAS float*)(unsigned)XS_OFF;
        FOR_BN {
#pragma unroll
            for (int e = 0; e < 4; ++e) cs[bj][n][e] = row16_sum(cs[bj][n][e]);
        }
        if (wr == 0 && fr == 0) { FOR_BN *(LAS f32x4*)(xs + wc * 64 + 32 * bj + 8 * fq + 4 * n) = cs[bj][n]; }
        asm volatile("s_waitcnt lgkmcnt(0)" ::: "memory"); __builtin_amdgcn_s_barrier();
        if (wr == 1 && fr == 0) { FOR_BN { const f32x4 o = (cs[bj][n] + *(LAS const f32x4*)(xs + wc * 64 + 32 * bj + 8 * fq + 4 * n)) * (1.f / 256.f);
            *(f32x4*)(kmo + wc * 512 + 32 * bj + 8 * fq + 4 * n) = o; } }
    }
}
DI void epi_store_bf16(const AccT& acc, bf16_t* out, int ld, int wr, int wc, int fr, int fq) {
    FOR_AM { bf16_t* rp = out + (size_t)EPI_ROWS(ai, m) * ld; FOR_BN st_bf4(rp + EPI_COLS(bj, n), acc[ai][bj][m][n]); }
}

struct EpiB {
    int l;
    DI void operator()(const AccT& acc, const Unit& u, int wr, int wc, int fr, int fq) const {
        const size_t row0 = (size_t)u.pm * 256;
        if (u.pn < 2) epi_headnorm<true>(acc, wsp<bf16_t>(WS_MK) + row0 * 512 + u.pn * 256, 512, KP()->in[I_QKN] + l * 256 + 64, wr, wc, fr, fq, 1.f,
                                         wsp<float>(WS_KMEAN) + ((size_t)((u.pm >> 3) * 8 + u.pn * 4) * 8 + (u.pm & 7)) * 64);
        else if (u.pn == 2) {
            LAS float* xs = (LAS float*)(unsigned)XS_OFF;
            FOR_AM { float ss = 0.f;
                FOR_BN { const f32x4 a = acc[ai][bj][m][n]; ss += a[0] * a[0] + a[1] * a[1] + a[2] * a[2] + a[3] * a[3]; }
                ss += __shfl_xor(ss, 16); ss += __shfl_xor(ss, 32);
                if (fq == 0) xs[EPI_ROWS(ai, m) * 4 + wc] = ss; }
            asm volatile("s_waitcnt lgkmcnt(0)" ::: "memory"); __builtin_amdgcn_s_barrier();
            f32x4 gv[2][2];
            FOR_BN gv[bj][n] = *(const f32x4*)(KP()->in[I_KVN] + l * 256 + EPI_COLS(bj, n));
            bf16_t* out = wsp<bf16_t>(WS_DCN) + row0 * 256;
            FOR_AM { const f32x4 p = *(LAS const f32x4*)(xs + EPI_ROWS(ai, m) * 4);
                const float rs = __builtin_amdgcn_rsqf((p[0] + p[1] + p[2] + p[3]) * (1.f / 256.f) + NORM_EPS);
                bf16_t* rp = out + (size_t)EPI_ROWS(ai, m) * 256;
                FOR_BN st_bf4(rp + EPI_COLS(bj, n), acc[ai][bj][m][n] * rs * gv[bj][n]); }
        } else {
            bf16_t* idxk = wsp<bf16_t>(WS_IDXK); float* idxw = wsp<float>(WS_IDXW); bf16_t* left = wsp<bf16_t>(WS_LEFT);
            FOR_AM { const size_t row = row0 + EPI_ROWS(ai, m);
                if (wc == 0) {
#pragma unroll
                    for (int n = 0; n < 2; ++n) st_bf4(idxk + row * 32 + 8 * fq + 4 * n, acc[ai][0][m][n]);
                    if (fq == 0) { *(f32x4*)(idxw + row * 8) = acc[ai][1][m][0]; *(f32x4*)(idxw + row * 8 + 4) = acc[ai][1][m][1]; }
                } else if (wc == 1) {
#pragma unroll
                    for (int n = 0; n < 2; ++n) st_bf4(left + row * 32 + 8 * fq + 4 * n, acc[ai][0][m][n]);
                }
            }
        }
    }
};
struct EpiVt {
    unsigned off;
    DI void operator()(const AccT& acc, const Unit& u, int wr, int wc, int fr, int fq) const {
        bf16_t* vt = wsp<bf16_t>(off);
        const int b = u.pn >> 3, s0 = (u.pn & 7) * 256;
        FOR_AM { bf16_t* rp = vt + ((size_t)b * 512 + u.pm * 256 + EPI_ROWS(ai, m)) * SEQ + s0; FOR_BN st_bf4(rp + EPI_COLS_T(bj, n), acc[ai][bj][m][n]); }
    }
};
struct EpiHN {
    int l;
    DI void operator()(const AccT& acc, const Unit& u, int wr, int wc, int fr, int fq) const { epi_headnorm(acc, wsp<bf16_t>(WS_DK) + (size_t)u.pm * 256 * 512 + u.pn * 256, 512, KP()->in[I_QKN] + l * 256 + 192, wr, wc, fr, fq); }
};
struct EpiD1 {
    int l, par;
    DI void operator()(const AccT& acc, const Unit& u, int wr, int wc, int fr, int fq) const {
        const size_t row0 = (size_t)u.pm * 256;
        if (u.pn < 2) epi_headnorm(acc, wsp<bf16_t>(WS_MQ + par * PAR_O) + row0 * 512 + u.pn * 256, 512, KP()->in[I_QKN] + l * 256, wr, wc, fr, fq, QSCALE);
        else if (u.pn < 4) epi_headnorm(acc, wsp<bf16_t>(WS_DQ + par * PAR_O) + row0 * 512 + (u.pn - 2) * 256, 512, KP()->in[I_QKN] + l * 256 + 128, wr, wc, fr, fq, QSCALE);
        else if (u.pn == 4) epi_store_bf16(acc, wsp<bf16_t>(WS_IDXQ) + row0 * 256, 256, wr, wc, fr, fq);
        else if (u.pn < 12) epi_store_bf16(acc, wsp<bf16_t>(WS_RAW) + row0 * RAWLD + (u.pn - 5) * 256, RAWLD, wr, wc, fr, fq);
        else {
            unsigned char* o = wsp<unsigned char>(WS_GATES + par * PAR_G) + row0 * 3072 + (u.pn - 12) * 256;
            FOR_AM { unsigned char* rp = o + (size_t)EPI_ROWS(ai, m) * 3072;
                FOR_BN { const f32x4 a = acc[ai][bj][m][n];
                    const unsigned q0 = (unsigned)(fsigmoid(a[0]) * 255.f + 0.5f), q1 = (unsigned)(fsigmoid(a[1]) * 255.f + 0.5f), q2 = (unsigned)(fsigmoid(a[2]) * 255.f + 0.5f), q3 = (unsigned)(fsigmoid(a[3]) * 255.f + 0.5f);
                    *(unsigned*)(rp + EPI_COLS(bj, n)) = q0 | (q1 << 8) | (q2 << 16) | (q3 << 24); } }
        }
    }
};
struct EpiLora {
    int l, cbase;
    DI void operator()(const AccT& acc, const Unit& u, int wr, int wc, int fr, int fq) const {
        const size_t row0 = (size_t)u.pm * 256; const int kind = u.pn >> 1, cb = (u.pn & 1) * 256;
        if (kind == 0) {
            float* dec = wsp<float>(WS_DEC); const float* w0 = KP()->in[I_W0] + l * 512;
            FOR_AM { const size_t row = row0 + EPI_ROWS(ai, m);
                FOR_BN { const int col = cb + EPI_COLS(bj, n); const f32x4 a = acc[ai][bj][m][n]; const f32x4 wv = *(const f32x4*)(w0 + col); f32x4 d;
#pragma unroll
                    for (int e = 0; e < 4; ++e) { const float x = -(wv[e] + a[e]);
                        const float sp = fmaxf(x, 0.f) + __builtin_amdgcn_logf(1.f + fexp2(-fabsf(x) * LOG2E)) * 0.6931471805599453f;
                        const float w = -sp - 0.5f; d[e] = fexp2(-fexp2(w * LOG2E) * LOG2E); }
                    *(f32x4*)(dec + row * 512 + col) = d; } }
        } else if (kind == 1) {
            bf16_t* kf = wsp<bf16_t>(WS_KF); const bf16_t* kkb = wsp<bf16_t>(WS_KKB); bf16_t* bbb = wsp<bf16_t>(WS_BBB);
            const float* a0 = KP()->in[I_A0] + l * 512; const float* ka = KP()->in[I_KA] + l * 512;
            FOR_AM { const size_t row = row0 + EPI_ROWS(ai, m);
                f32x4 kp[2][2], kk[2][2];
                FOR_BN { const int col = cb + EPI_COLS(bj, n); kp[bj][n] = ld_bf4(kf + row * 512 + col); kk[bj][n] = ld_bf4(kkb + row * 512 + col); }
                FOR_BN { const int col = cb + EPI_COLS(bj, n); const f32x4 a = acc[ai][bj][m][n];
                    const f32x4 av = *(const f32x4*)(a0 + col), kav = *(const f32x4*)(ka + col); f32x4 ko, bo;
#pragma unroll
                    for (int e = 0; e < 4; ++e) { const float s = fsigmoid(av[e] + a[e]); ko[e] = kp[bj][n][e] * (1.f + (s - 1.f) * kav[e]); bo[e] = kk[bj][n][e] * s; }
                    st_bf4(kf + row * 512 + col, ko); st_bf4(bbb + row * 512 + col, bo); } }
        } else if (kind == 2) {
            epi_store_bf16(acc, wsp<bf16_t>(WS_GG) + row0 * 512 + cb, 512, wr, wc, fr, fq);
        } else {
            const bf16_t* vv = wsp<bf16_t>(WS_VV); bf16_t* v2 = wsp<bf16_t>(WS_V2); const bf16_t* vfirst = wsp<bf16_t>(WS_VFIRST); const float* v0 = KP()->in[I_V0];
            FOR_AM { const size_t row = row0 + EPI_ROWS(ai, m); const size_t arow = (size_t)(row >> 9) * SEQ + cbase + (row & 511);
                f32x4 vp[2][2], vf[2][2];
                FOR_BN { const int col = cb + EPI_COLS(bj, n); vp[bj][n] = ld_bf4(vv + row * 512 + col); vf[bj][n] = ld_bf4(vfirst + arow * 512 + col); }
                FOR_BN { const int col = cb + EPI_COLS(bj, n); const f32x4 a = acc[ai][bj][m][n]; const f32x4 v0v = *(const f32x4*)(v0 + col); f32x4 o;
#pragma unroll
                    for (int e = 0; e < 4; ++e) o[e] = vp[bj][n][e] + (vf[bj][n][e] - vp[bj][n][e]) * fsigmoid(v0v[e] + a[e]);
                    st_bf4(v2 + row * 512 + col, o); } }
        }
    }
};
struct EpiMerge {
    DI void operator()(const AccT& acc, const Unit& u, int wr, int wc, int fr, int fq) const {
        bf16_t* y = wsp<bf16_t>(WS_Y); const unsigned char* gates = wsp<unsigned char>(WS_GATES + (size_t)(u.pm >> 5) * PAR_G);
        const size_t row0 = (size_t)u.pm * 256, grow0 = (size_t)(u.pm & 31) * 256; const int c0 = u.pn * 256 + 64 * wc + 8 * fq, z = u.z;
#pragma unroll
        for (int ai = 0; ai < 2; ++ai) {
            u32x2 g[4][2]; u32x4 yv[4][2];
#pragma unroll
            for (int m = 0; m < 4; ++m) { const int rt = EPI_ROWS(ai, m);
#pragma unroll
                for (int bj = 0; bj < 2; ++bj) { g[m][bj] = *(const u32x2*)(gates + (grow0 + rt) * 3072 + z * 1024 + c0 + 32 * bj);
                    if (z > 0) yv[m][bj] = *(const u32x4*)(y + (row0 + rt) * 1024 + c0 + 32 * bj); } }
#pragma unroll
            for (int m = 0; m < 4; ++m) { const size_t row = row0 + EPI_ROWS(ai, m);
#pragma unroll
                for (int bj = 0; bj < 2; ++bj) { u32x4 o;
#pragma unroll
                    for (int n = 0; n < 2; ++n) { const unsigned gu = g[m][bj][n];
                        const f32x4 gf = (f32x4){(float)(gu & 255u), (float)((gu >> 8) & 255u), (float)((gu >> 16) & 255u), (float)(gu >> 24)} * (1.f / 255.f);
                        f32x4 v = acc[ai][bj][m][n] * gf;
                        if (z > 0) { const unsigned ya = yv[m][bj][2 * n], yb = yv[m][bj][2 * n + 1]; v += (f32x4){bflo(ya), bfhi(ya), bflo(yb), bfhi(yb)}; }
                        o[2 * n] = pk2(v[0], v[1]); o[2 * n + 1] = pk2(v[2], v[3]); }
                    *(u32x4*)(y + row * 1024 + c0 + 32 * bj) = o; } }
        }
    }
};
struct EpiRes {
    int first, amode, cbase; unsigned dummy_off;
    DI void operator()(const AccT& acc, const Unit& u, int wr, int wc, int fr, int fq) const {
        float* out = KP()->out; const float* res = first ? KP()->in[I_X] : (const float*)out;
        if (dummy_off) out = wsp<float>(dummy_off);
        const size_t grow0 = amode == 2 ? ((size_t)((u.pm & 31) >> 1) * SEQ + cbase + (u.pm >> 5) * SC + (u.pm & 1) * 256) : (amode ? ((size_t)(u.pm >> 1) * SEQ + cbase + (u.pm & 1) * 256) : (size_t)u.pm * 256); const int c0 = u.pn * 256;
#pragma unroll
        for (int ai = 0; ai < 2; ++ai) {
            f32x4 rv[4][2][2];
#pragma unroll
            for (int m = 0; m < 4; ++m) { const size_t row = grow0 + EPI_ROWS(ai, m); FOR_BN rv[m][bj][n] = *(const f32x4*)(res + row * DM + c0 + EPI_COLS_F(bj, n)); }
#pragma unroll
            for (int m = 0; m < 4; ++m) { const size_t row = grow0 + EPI_ROWS(ai, m); FOR_BN *(f32x4*)(out + row * DM + c0 + EPI_COLS_F(bj, n)) = rv[m][bj][n] + acc[ai][bj][m][n]; }
        }
    }
};
struct EpiNull { DI void operator()(const AccT& acc, const Unit& u, int wr, int wc, int fr, int fq) const { f32x4 s = {0.f, 0.f, 0.f, 0.f}; FOR_AM { FOR_BN s += acc[ai][bj][m][n]; } if (s[0] + s[1] + s[2] + s[3] == 12345.678f) *wsp<float>(WS_OUT) = 1.f; } };
struct EpiSwiglu {
    DI void operator()(const AccT& acc, const Unit& u, int wr, int wc, int fr, int fq) const {
        bf16_t* act = wsp<bf16_t>(WS_ACT);
        FOR_AM { bf16_t* rp = act + ((size_t)u.pm * 256 + EPI_ROWS(ai, m)) * DFF + u.pn * 128 + 32 * wc + 8 * fq;
            u32x4 w;
#pragma unroll
            for (int n = 0; n < 2; ++n) { const f32x4 g = acc[ai][0][m][n], up = acc[ai][1][m][n]; f32x4 o;
#pragma unroll
                for (int e = 0; e < 4; ++e) o[e] = g[e] * fsigmoid(g[e]) * up[e];
                w[2 * n] = pk2(o[0], o[1]); w[2 * n + 1] = pk2(o[2], o[3]); }
            *(u32x4*)rp = w; }
    }
};

DI void phase_dcn(int l) {
    const int lane = TID() & 63, gw = BID() * 8 + (TID() >> 6), nw = gridDim.x * 8;
    bf16_t* dcn = wsp<bf16_t>(WS_DCN);
    const f32x4 g = *(const f32x4*)(KP()->in[I_KVN] + l * 256 + 4 * lane);
    for (int row = gw; row < NT; row += nw) {
        bf16_t* rp = dcn + (size_t)row * 256 + 4 * lane;
        const f32x4 v = ld_bf4(rp);
        const float ss = wave_sum(v[0] * v[0] + v[1] * v[1] + v[2] * v[2] + v[3] * v[3]);
        const float rs = __builtin_amdgcn_rsqf(ss * (1.f / 256.f) + NORM_EPS);
        st_bf4(rp, v * rs * g);
    }
}
DI void phase_kmean() {
    const int lane = TID() & 63, gw = BID() * 8 + (TID() >> 6), nw = gridDim.x * 8;
    const bf16_t* mk = wsp<bf16_t>(WS_MK); float* km = wsp<float>(WS_KMEAN);
    for (int it = gw; it < NB * NH * 8; it += nw) {
        const int n = it & 7, h = (it >> 3) & 7, b = it >> 6;
        const bf16_t* kp = mk + ((size_t)b * SEQ + n * 256 + (lane >> 3)) * 512 + h * 64 + 8 * (lane & 7);
        float s[8] = {0.f, 0.f, 0.f, 0.f, 0.f, 0.f, 0.f, 0.f};
#pragma unroll 8
        for (int k = 0; k < 256; k += 8) { const u32x4 u = *(const u32x4*)(kp + (size_t)k * 512);
#pragma unroll
            for (int q = 0; q < 4; ++q) { s[2 * q] += bflo(u[q]); s[2 * q + 1] += bfhi(u[q]); } }
#pragma unroll
        for (int e = 0; e < 8; ++e) {
            float v = s[e];
            v += __uint_as_float(__builtin_amdgcn_update_dpp(0, __float_as_uint(v), 0x128, 0xf, 0xf, false));
            auto r = __builtin_amdgcn_permlane16_swap(__float_as_uint(v), __float_as_uint(v), false, false); v = __uint_as_float(r[0]) + __uint_as_float(r[1]);
            r = __builtin_amdgcn_permlane32_swap(__float_as_uint(v), __float_as_uint(v), false, false); s[e] = (__uint_as_float(r[0]) + __uint_as_float(r[1])) * (1.f / 256.f);
        }
        if (lane < 8) { float* o = km + (size_t)it * 64 + 8 * lane; *(f32x4*)o = (f32x4){s[0], s[1], s[2], s[3]}; *(f32x4*)(o + 4) = (f32x4){s[4], s[5], s[6], s[7]}; }
    }
}

DI void phase_rwkv_prep(int l, int c) {
    const int lane = TID() & 63, gw = BID() * 8 + (TID() >> 6), nw = gridDim.x * 8;
    const bf16_t* raw = wsp<bf16_t>(WS_RAW); const bf16_t* left = wsp<bf16_t>(WS_LEFT); bf16_t* carry = wsp<bf16_t>(WS_CARRY);
    bf16_t* rr = wsp<bf16_t>(WS_RR); bf16_t* kf = wsp<bf16_t>(WS_KF); bf16_t* vv = wsp<bf16_t>(WS_VV); bf16_t* kkb = wsp<bf16_t>(WS_KKB);
    bf16_t* la = wsp<bf16_t>(WS_LORAA); bf16_t* vfirst = wsp<bf16_t>(WS_VFIRST);
    const float* mu = KP()->in[I_MU] + l * 1824; const float* kkw = KP()->in[I_KK] + l * 512;
    for (int rc = gw; rc < TC; rc += nw) {
        const int b = rc >> 9, sl = rc & 511, s = c * SC + sl; const size_t ra = (size_t)b * SEQ + s;
        const bf16_t* cur = raw + (size_t)rc * RAWLD;
        const bf16_t* prv = (sl > 0) ? (cur - RAWLD) : (carry + (size_t)((((c + 1) & 1) * 16) + b) * RAWLD);
        const bool hp = s > 0;
        auto mix8 = [&](int j, float* o) {
            const u32x4 cu = *(const u32x4*)(cur + j); u32x4 pu = {0u, 0u, 0u, 0u}; if (hp) pu = *(const u32x4*)(prv + j);
            const f32x4 m0 = *(const f32x4*)(mu + j), m1 = *(const f32x4*)(mu + j + 4);
#pragma unroll
            for (int e = 0; e < 4; ++e) { const float c0 = bflo(cu[e]), c1 = bfhi(cu[e]), p0 = bflo(pu[e]), p1 = bfhi(pu[e]);
                const float ma = (2 * e < 4) ? m0[2 * e] : m1[2 * e - 4], mb = (2 * e + 1 < 4) ? m0[2 * e + 1] : m1[2 * e + 1 - 4];
                o[2 * e] = c0 + (p0 - c0) * ma; o[2 * e + 1] = c1 + (p1 - c1) * mb; }
        };
        float o[8];
        mix8(8 * lane, o);
        { u32x4 w; w[0] = pk2(o[0], o[1]); w[1] = pk2(o[2], o[3]); w[2] = pk2(o[4], o[5]); w[3] = pk2(o[6], o[7]); *(u32x4*)(rr + (size_t)rc * 512 + 8 * lane) = w; }
        mix8(576 + 8 * lane, o);
        { u32x4 w; w[0] = pk2(o[0], o[1]); w[1] = pk2(o[2], o[3]); w[2] = pk2(o[4], o[5]); w[3] = pk2(o[6], o[7]); *(u32x4*)(kf + (size_t)rc * 512 + 8 * lane) = w;
          const f32x4 k0 = *(const f32x4*)(kkw + 8 * lane), k1 = *(const f32x4*)(kkw + 8 * lane + 4);
          float q[8]; float ss = 0.f;
#pragma unroll
          for (int e = 0; e < 8; ++e) { q[e] = o[e] * (e < 4 ? k0[e] : k1[e - 4]); ss += q[e] * q[e]; }
          ss += __shfl_xor(ss, 1); ss += __shfl_xor(ss, 2); ss += __shfl_xor(ss, 4);
          const float inv = 1.f / fmaxf(sqrtf(ss), 1e-12f);
          w[0] = pk2(q[0] * inv, q[1] * inv); w[1] = pk2(q[2] * inv, q[3] * inv); w[2] = pk2(q[4] * inv, q[5] * inv); w[3] = pk2(q[6] * inv, q[7] * inv);
          *(u32x4*)(kkb + (size_t)rc * 512 + 8 * lane) = w; }
        mix8(1088 + 8 * lane, o);
        { u32x4 w; w[0] = pk2(o[0], o[1]); w[1] = pk2(o[2], o[3]); w[2] = pk2(o[4], o[5]); w[3] = pk2(o[6], o[7]); *(u32x4*)(vv + (size_t)rc * 512 + 8 * lane) = w;
          if (l == 0) *(u32x4*)(vfirst + ra * 512 + 8 * lane) = w; }
        { bf16_t* lr = la + (size_t)rc * 512;
          const bf16_t* cs = cur; const bf16_t* ps_ = prv; int sc = 512 + 8 * lane, dc = 8 * lane, fn = 0; const float* mup = mu;
          if (lane >= 8) { sc = 1600 + 8 * (lane - 8); dc = 64 + 8 * (lane - 8); fn = 1; }
          if (lane >= 16) { sc = 1664 + 8 * (lane - 16); dc = 128 + 8 * (lane - 16); fn = 2; }
          if (lane >= 32) { cs = left + ra * 32; ps_ = left + (ra - 1) * 32; sc = 8 * (lane - 32); dc = 256 + 8 * (lane - 32); mup = mu + 1792; }
          u32x4 w = {0u, 0u, 0u, 0u};
          if (lane < 36) {
              const u32x4 cu = *(const u32x4*)(cs + sc); u32x4 pu = {0u, 0u, 0u, 0u}; if (hp) pu = *(const u32x4*)(ps_ + sc);
              const f32x4 m0 = *(const f32x4*)(mup + sc), m1 = *(const f32x4*)(mup + sc + 4);
              float x[8];
#pragma unroll
              for (int e = 0; e < 4; ++e) { const float c0 = bflo(cu[e]), c1 = bfhi(cu[e]), p0 = bflo(pu[e]), p1 = bfhi(pu[e]);
                  const float ma = (2 * e < 4) ? m0[2 * e] : m1[2 * e - 4], mb = (2 * e + 1 < 4) ? m0[2 * e + 1] : m1[2 * e + 1 - 4];
                  x[2 * e] = c0 + (p0 - c0) * ma; x[2 * e + 1] = c1 + (p1 - c1) * mb; }
#pragma unroll
              for (int e = 0; e < 8; ++e) { const float th = 1.f - 2.f * frcp(fexp2(2.f * x[e] * LOG2E) + 1.f), sg = fsigmoid(x[e]); x[e] = fn == 0 ? th : (fn == 1 ? x[e] : sg); }
              w[0] = pk2(x[0], x[1]); w[1] = pk2(x[2], x[3]); w[2] = pk2(x[4], x[5]); w[3] = pk2(x[6], x[7]);
          } else dc = 288 + 8 * (lane - 36);
          *(u32x4*)(lr + dc) = w; }
        if (sl == SC - 1) { bf16_t* cp = carry + (size_t)(((c & 1) * 16) + b) * RAWLD;
            for (int j = lane; j < RAWLD / 8; j += 64) *(u32x4*)(cp + 8 * j) = *(const u32x4*)(cur + 8 * j); }
    }
}

DI float dpp_ror_add(float x, int) { return x; }
DI void reduce4(float p0, float p1, float p2, float p3, float& s0, float& s1, float& s2, float& s3) {
    auto r = __builtin_amdgcn_permlane32_swap(__float_as_uint(p0), __float_as_uint(p2), false, false);
    const float u0 = __uint_as_float(r[0]) + __uint_as_float(r[1]);
    r = __builtin_amdgcn_permlane32_swap(__float_as_uint(p1), __float_as_uint(p3), false, false);
    const float u1 = __uint_as_float(r[0]) + __uint_as_float(r[1]);
    r = __builtin_amdgcn_permlane16_swap(__float_as_uint(u0), __float_as_uint(u1), false, false);
    float w = __uint_as_float(r[0]) + __uint_as_float(r[1]);
    w += __uint_as_float(__builtin_amdgcn_update_dpp(0, __float_as_uint(w), 0x128, 0xf, 0xf, false));
    w += __uint_as_float(__builtin_amdgcn_update_dpp(0, __float_as_uint(w), 0x124, 0xf, 0xf, false));
    w += __uint_as_float(__builtin_amdgcn_update_dpp(0, __float_as_uint(w), 0x122, 0xf, 0xf, false));
    w += __uint_as_float(__builtin_amdgcn_update_dpp(0, __float_as_uint(w), 0x121, 0xf, 0xf, false));
    s0 = __uint_as_float(__builtin_amdgcn_readlane(__float_as_uint(w), 0));
    s1 = __uint_as_float(__builtin_amdgcn_readlane(__float_as_uint(w), 16));
    s2 = __uint_as_float(__builtin_amdgcn_readlane(__float_as_uint(w), 32));
    s3 = __uint_as_float(__builtin_amdgcn_readlane(__float_as_uint(w), 48));
}
DI void reduce8(float p0, float p1, float p2, float p3, float q0, float q1, float q2, float q3, float& pw, float& s0, float& s1, float& s2, float& s3) {
    auto r = __builtin_amdgcn_permlane32_swap(__float_as_uint(p0), __float_as_uint(p2), false, false);
    auto t = __builtin_amdgcn_permlane32_swap(__float_as_uint(q0), __float_as_uint(q2), false, false);
    const float u0 = __uint_as_float(r[0]) + __uint_as_float(r[1]);
    const float x0 = __uint_as_float(t[0]) + __uint_as_float(t[1]);
    r = __builtin_amdgcn_permlane32_swap(__float_as_uint(p1), __float_as_uint(p3), false, false);
    t = __builtin_amdgcn_permlane32_swap(__float_as_uint(q1), __float_as_uint(q3), false, false);
    const float u1 = __uint_as_float(r[0]) + __uint_as_float(r[1]);
    const float x1 = __uint_as_float(t[0]) + __uint_as_float(t[1]);
    r = __builtin_amdgcn_permlane16_swap(__float_as_uint(u0), __float_as_uint(u1), false, false);
    t = __builtin_amdgcn_permlane16_swap(__float_as_uint(x0), __float_as_uint(x1), false, false);
    float w = __uint_as_float(r[0]) + __uint_as_float(r[1]);
    float y = __uint_as_float(t[0]) + __uint_as_float(t[1]);
    w += __uint_as_float(__builtin_amdgcn_update_dpp(0, __float_as_uint(w), 0x128, 0xf, 0xf, false));
    y += __uint_as_float(__builtin_amdgcn_update_dpp(0, __float_as_uint(y), 0x128, 0xf, 0xf, false));
    w += __uint_as_float(__builtin_amdgcn_update_dpp(0, __float_as_uint(w), 0x124, 0xf, 0xf, false));
    y += __uint_as_float(__builtin_amdgcn_update_dpp(0, __float_as_uint(y), 0x124, 0xf, 0xf, false));
    w += __uint_as_float(__builtin_amdgcn_update_dpp(0, __float_as_uint(w), 0x122, 0xf, 0xf, false));
    y += __uint_as_float(__builtin_amdgcn_update_dpp(0, __float_as_uint(y), 0x122, 0xf, 0xf, false));
    w += __uint_as_float(__builtin_amdgcn_update_dpp(0, __float_as_uint(w), 0x121, 0xf, 0xf, false));
    y += __uint_as_float(__builtin_amdgcn_update_dpp(0, __float_as_uint(y), 0x121, 0xf, 0xf, false));
    pw = w;
    s0 = __uint_as_float(__builtin_amdgcn_readlane(__float_as_uint(y), 0));
    s1 = __uint_as_float(__builtin_amdgcn_readlane(__float_as_uint(y), 16));
    s2 = __uint_as_float(__builtin_amdgcn_readlane(__float_as_uint(y), 32));
    s3 = __uint_as_float(__builtin_amdgcn_readlane(__float_as_uint(y), 48));
}
struct ScanIn { bf16_t kk, bb, k, r, v; float w; };
DI void phase_scan(int l, int c, int dummy = 0) {
    const int lane = TID() & 63, gw = BID() * 8 + (TID() >> 6), nw = gridDim.x * 8;
    const bf16_t* kkb = wsp<bf16_t>(WS_KKB); const bf16_t* bbb = wsp<bf16_t>(WS_BBB); const bf16_t* kfb = wsp<bf16_t>(WS_KF); const bf16_t* rrb = wsp<bf16_t>(WS_RR);
    const bf16_t* vsb = wsp<bf16_t>(l == 0 ? WS_VV : WS_V2); const float* dec = wsp<float>(WS_DEC); float* outb = wsp<float>(WS_OUT); float* state = wsp<float>(WS_STATE);
    for (int item = gw; item < NB * NH * 16; item += nw) {
        const int bh = item >> 4, rg = item & 15, b = bh >> 3, h = bh & 7, i0 = rg * 4;
        float* stp = state + ((size_t)bh * 64 + i0) * 64 + lane;
        float S0 = 0.f, S1 = 0.f, S2 = 0.f, S3 = 0.f;
        if (c > 0) { S0 = stp[0]; S1 = stp[64]; S2 = stp[128]; S3 = stp[192]; }
        const size_t e0 = (size_t)b * SC * 512 + h * 64 + lane;
        const size_t ev = (size_t)b * SC * 512 + h * 64 + i0 + (lane & 3);
        float* op = outb + (size_t)b * SC * 512 + h * 64 + i0 + (lane >> 4);
        ScanIn A[8], B[8];
#define SCAN_LOAD(X, g) do { _Pragma("unroll") for (int j = 0; j < 8; ++j) { const size_t o = (size_t)((g) * 8 + j) * 512; \
            X[j].kk = kkb[e0 + o]; X[j].bb = bbb[e0 + o]; X[j].k = kfb[e0 + o]; X[j].r = rrb[e0 + o]; X[j].w = dec[e0 + o]; X[j].v = vsb[ev + o]; } } while (0)
#define SCAN_STEP1(Xj, kknext, t) do { \
            const float bb = bf2f(Xj.bb), kx = bf2f(Xj.k), rx = bf2f(Xj.r), wx = Xj.w; const unsigned vu = (unsigned)Xj.v << 16; \
            const float v0 = __uint_as_float(__builtin_amdgcn_readlane(vu, 0)), v1 = __uint_as_float(__builtin_amdgcn_readlane(vu, 1)), v2 = __uint_as_float(__builtin_amdgcn_readlane(vu, 2)), v3 = __uint_as_float(__builtin_amdgcn_readlane(vu, 3)); \
            S0 = S0 * wx + (v0 * kx - a0 * bb); S1 = S1 * wx + (v1 * kx - a1 * bb); S2 = S2 * wx + (v2 * kx - a2 * bb); S3 = S3 * wx + (v3 * kx - a3 * bb); \
            float ov; const float kn = (kknext); \
            reduce8(S0 * rx, S1 * rx, S2 * rx, S3 * rx, S0 * kn, S1 * kn, S2 * kn, S3 * kn, ov, a0, a1, a2, a3); \
            if ((lane & 15) == 0) op[(size_t)(t) * 512] = ov; } while (0)
#define SCAN_GROUP(X, Y, g, lastg) do { _Pragma("unroll") for (int j = 0; j < 8; ++j) { \
            const float kkn = (j < 7) ? bf2f(X[j < 7 ? j + 1 : 7].kk) : ((lastg) ? 0.f : bf2f(Y[0].kk)); \
            SCAN_STEP1(X[j], kkn, (g) * 8 + j); } } while (0)
        SCAN_LOAD(A, 0);
        float a0, a1, a2, a3;
        { const float k0 = bf2f(A[0].kk); reduce4(S0 * k0, S1 * k0, S2 * k0, S3 * k0, a0, a1, a2, a3); }
#if DBL_PHASE == 11
        if (dummy == 2) {
            float acc_ = 0.f;
            for (int g = 0; g < SC / 8; g += 2) {
                SCAN_LOAD(B, g + 1);
#pragma unroll
                for (int j = 0; j < 8; ++j) acc_ += bf2f(A[j].kk) + bf2f(A[j].bb) + bf2f(A[j].k) + bf2f(A[j].r) + bf2f(A[j].v) + A[j].w;
                if (g + 2 < SC / 8) SCAN_LOAD(A, g + 2);
#pragma unroll
                for (int j = 0; j < 8; ++j) acc_ += bf2f(B[j].kk) + bf2f(B[j].bb) + bf2f(B[j].k) + bf2f(B[j].r) + bf2f(B[j].v) + B[j].w;
            }
            if (acc_ == 12345.678f) stp[0] = acc_;
            continue;
        }
#endif
#if DBL_PHASE == 12
        if (dummy == 3) {
#pragma unroll
            for (int j = 0; j < 8; ++j) { A[j].kk = (bf16_t)(0x3c00 + lane + j); A[j].bb = (bf16_t)(0x3b00 + lane); A[j].k = (bf16_t)(0x3d00 + j); A[j].r = (bf16_t)(0x3e00 + lane); A[j].v = (bf16_t)(0x3c80 + j); A[j].w = 0.9f; B[j] = A[j]; }
            op = wsp<float>(WS_RAW) + (size_t)item * 4 + (lane >> 4);
            for (int g = 0; g < SC / 8; g += 2) {
                SCAN_GROUP(A, B, 0, false);
                SCAN_GROUP(B, A, 0, false);
            }
            if (S0 + S1 + S2 + S3 == 12345.678f) stp[0] = S0;
            continue;
        }
#endif
        for (int g = 0; g < SC / 8; g += 2) {
            SCAN_LOAD(B, g + 1);
            SCAN_GROUP(A, B, g, false);
            const bool last = (g + 2 >= SC / 8);
            if (!last) SCAN_LOAD(A, g + 2);
            SCAN_GROUP(B, A, g + 1, last);
        }
#undef SCAN_STEP1
#undef SCAN_GROUP
#undef SCAN_LOAD
        if (!dummy) { stp[0] = S0; stp[64] = S1; stp[128] = S2; stp[192] = S3; }
    }
}
typedef short s16x4 __attribute__((ext_vector_type(4)));
#define M16K32(a, b, c) __builtin_amdgcn_mfma_f32_16x16x32_bf16((a), (b), (c), 0, 0, 0)
#define M16K16(a, b, c) __builtin_amdgcn_mfma_f32_16x16x16bf16_1k((a), (b), (c), 0, 0, 0)
DI s16x4 pk4(f32x4 v) { u32x2 u; u[0] = pk2(v[0], v[1]); u[1] = pk2(v[2], v[3]); return __builtin_bit_cast(s16x4, u); }
DI float dpp_shr1(float x, float old) { return __uint_as_float(__builtin_amdgcn_update_dpp(__float_as_uint(old), __float_as_uint(x), 0x111, 0xf, 0xf, false)); }
DI float dpp_shr2(float x, float old) { return __uint_as_float(__builtin_amdgcn_update_dpp(__float_as_uint(old), __float_as_uint(x), 0x112, 0xf, 0xf, false)); }
DI float dpp_shr4(float x, float old) { return __uint_as_float(__builtin_amdgcn_update_dpp(__float_as_uint(old), __float_as_uint(x), 0x114, 0xf, 0xf, false)); }
DI float dpp_shr8(float x, float old) { return __uint_as_float(__builtin_amdgcn_update_dpp(__float_as_uint(old), __float_as_uint(x), 0x118, 0xf, 0xf, false)); }
DI float dpp_bcast15(float x) { return __uint_as_float(__builtin_amdgcn_update_dpp(0, __float_as_uint(x), 0x15F, 0xf, 0xf, false)); }
DI void phase_scan_chunked(int l, int c, LAS unsigned char* lds, bool dummy = false) {
    const int tid = TID(), lane = tid & 63, wave = tid >> 6, r16 = lane & 15, g = lane >> 4;
    if (wave >= 2) return;
    const int item = BID() * 2 + wave;
    if (item >= NB * NH * 4) return;
    const int bh = item >> 2, ig = item & 3, b = bh >> 3, h = bh & 7, i0 = 16 * ig;
    LAS unsigned char* wl = lds + wave * 4096;
    const bf16_t* kkb = wsp<bf16_t>(WS_KKB); const bf16_t* bbb = wsp<bf16_t>(WS_BBB); const bf16_t* kfb = wsp<bf16_t>(WS_KF); const bf16_t* rrb = wsp<bf16_t>(WS_RR);
    const bf16_t* vsb = wsp<bf16_t>(l == 0 ? WS_VV : WS_V2); const float* dec = wsp<float>(WS_DEC); float* outb = wsp<float>(WS_OUT);
    float* stp = wsp<float>(WS_STATE) + ((size_t)bh * 64 + i0 + r16) * 64 + 8 * g;
    f32x4 ST[4];
#pragma unroll
    for (int sg = 0; sg < 4; ++sg) ST[sg] = (c > 0) ? *(const f32x4*)(stp + 32 * (sg >> 1) + 4 * (sg & 1)) : (f32x4){0.f, 0.f, 0.f, 0.f};
    const size_t e0 = ((size_t)b * SC + r16) * 512 + h * 64 + 8 * g;
    const size_t ev = ((size_t)b * SC + 4 * g) * 512 + h * 64 + i0 + r16;
    const size_t eo = ((size_t)b * SC + 4 * g) * 512 + h * 64 + i0 + r16;
    u32x4 rk[2], rb[2], rq[2], rr_[2]; f32x4 rw[4]; bf16_t rv[4];
#define CS_LOAD(blk) do { const size_t o = e0 + (size_t)(blk) * 16 * 512; _Pragma("unroll") for (int s = 0; s < 2; ++s) { \
        rk[s] = *(const u32x4*)(kkb + o + 32 * s); rb[s] = *(const u32x4*)(bbb + o + 32 * s); rq[s] = *(const u32x4*)(kfb + o + 32 * s); rr_[s] = *(const u32x4*)(rrb + o + 32 * s); \
        rw[2 * s] = *(const f32x4*)(dec + o + 32 * s); rw[2 * s + 1] = *(const f32x4*)(dec + o + 32 * s + 4); } \
        _Pragma("unroll") for (int e = 0; e < 4; ++e) rv[e] = vsb[ev + (size_t)(blk) * 16 * 512 + (size_t)e * 512]; } while (0)
    CS_LOAD(0);
    for (int blk = 0; blk < SC / 16; ++blk) {
        float P[16], kap[16], bet[16], kq[16], rt[16];
#pragma unroll
        for (int s = 0; s < 2; ++s)
#pragma unroll
            for (int q = 0; q < 4; ++q) { const int i = 8 * s + 2 * q;
                kap[i] = bflo(rk[s][q]); kap[i + 1] = bfhi(rk[s][q]); bet[i] = bflo(rb[s][q]); bet[i + 1] = bfhi(rb[s][q]);
                kq[i] = bflo(rq[s][q]); kq[i + 1] = bfhi(rq[s][q]); rt[i] = bflo(rr_[s][q]); rt[i + 1] = bfhi(rr_[s][q]);
                P[i] = rw[2 * s + (q >> 1)][2 * (q & 1)]; P[i + 1] = rw[2 * s + (q >> 1)][2 * (q & 1) + 1]; }
        s16x4 Vb; { u32x2 u; u[0] = (unsigned)rv[0] | ((unsigned)rv[1] << 16); u[1] = (unsigned)rv[2] | ((unsigned)rv[3] << 16); Vb = __builtin_bit_cast(s16x4, u); }
        if (blk + 1 < SC / 16) CS_LOAD(blk + 1);
        float P16[16];
        bf16x8 ktp[2], btp[2], kqp[2], rtp[2];
#pragma unroll
        for (int i = 0; i < 16; ++i) { float p = P[i];
            p *= dpp_shr1(p, 1.f); p *= dpp_shr2(p, 1.f); p *= dpp_shr4(p, 1.f); p *= dpp_shr8(p, 1.f);
            const float pm1 = dpp_shr1(p, 1.f); const float inv = frcp(p); const float p16 = dpp_bcast15(p);
            P16[i] = p16; kap[i] *= pm1; bet[i] *= inv; kq[i] *= inv; rt[i] *= p; }
#pragma unroll
        for (int s = 0; s < 2; ++s) { u32x4 a, bb_, cc, dd;
#pragma unroll
            for (int q = 0; q < 4; ++q) { const int i = 8 * s + 2 * q; a[q] = pk2(kap[i], kap[i + 1]); bb_[q] = pk2(bet[i], bet[i + 1]); cc[q] = pk2(kq[i], kq[i + 1]); dd[q] = pk2(rt[i], rt[i + 1]); }
            ktp[s] = __builtin_bit_cast(bf16x8, a); btp[s] = __builtin_bit_cast(bf16x8, bb_); kqp[s] = __builtin_bit_cast(bf16x8, cc); rtp[s] = __builtin_bit_cast(bf16x8, dd); }
#pragma unroll
        for (int s = 0; s < 2; ++s)
#pragma unroll
            for (int hb = 0; hb < 2; ++hb) { const int i = 8 * s + 4 * hb; u32x2 uk, ub;
                uk[0] = pk2(kq[i] * P16[i], kq[i + 1] * P16[i + 1]); uk[1] = pk2(kq[i + 2] * P16[i + 2], kq[i + 3] * P16[i + 3]);
                ub[0] = pk2(bet[i] * P16[i], bet[i + 1] * P16[i + 1]); ub[1] = pk2(bet[i + 2] * P16[i + 2], bet[i + 3] * P16[i + 3]);
                const int off = r16 * 128 + (32 * s + 16 * hb + 4 * g) * 2;
                *(LAS u32x2*)(wl + off) = uk; *(LAS u32x2*)(wl + 2048 + off) = ub; }
        const f32x4 Z = {0.f, 0.f, 0.f, 0.f};
        f32x4 A1a = M16K32(btp[1], ktp[1], M16K32(btp[0], ktp[0], Z));
        f32x4 A1c = M16K32(ktp[1], btp[1], M16K32(ktp[0], btp[0], Z));
        f32x4 A2a = M16K32(kqp[1], ktp[1], M16K32(kqp[0], ktp[0], Z));
        f32x4 B1a = M16K32(btp[1], rtp[1], M16K32(btp[0], rtp[0], Z));
        f32x4 B2a = M16K32(kqp[1], rtp[1], M16K32(kqp[0], rtp[0], Z));
#pragma unroll
        for (int e = 0; e < 4; ++e) { const int s_ = 4 * g + e;
            A1a[e] = (s_ < r16) ? A1a[e] : 0.f; A2a[e] = (s_ < r16) ? A2a[e] : 0.f; A1c[e] = (r16 < s_) ? A1c[e] : 0.f;
            B1a[e] = (s_ <= r16) ? B1a[e] : 0.f; B2a[e] = (s_ <= r16) ? B2a[e] : 0.f; }
        const s16x4 a1a = pk4(A1a), a1c = pk4(A1c);
        const f32x4 M2a = M16K16(a1c, a1a, Z), M2c = M16K16(a1a, a1c, Z);
        const s16x4 m2a = pk4(M2a), m2c = pk4(M2c);
        const f32x4 M4a = M16K16(m2c, m2a, Z), M4c = M16K16(m2a, m2c, Z);
        const s16x4 m4a = pk4(M4a), m4c = pk4(M4c);
        const s16x4 m8a = pk4(M16K16(m4c, m4a, Z));
        s16x4 stb[4];
#pragma unroll
        for (int sg = 0; sg < 4; ++sg) stb[sg] = pk4(ST[sg]);
        f32x4 G = Z, G2 = Z;
#pragma unroll
        for (int sg = 0; sg < 4; ++sg) {
            const s16x4 kf_ = (sg & 1) ? __builtin_shufflevector(ktp[sg >> 1], ktp[sg >> 1], 4, 5, 6, 7) : __builtin_shufflevector(ktp[sg >> 1], ktp[sg >> 1], 0, 1, 2, 3);
            const s16x4 rf_ = (sg & 1) ? __builtin_shufflevector(rtp[sg >> 1], rtp[sg >> 1], 4, 5, 6, 7) : __builtin_shufflevector(rtp[sg >> 1], rtp[sg >> 1], 0, 1, 2, 3);
            G = M16K16(kf_, stb[sg], G); G2 = M16K16(rf_, stb[sg], G2); }
        const f32x4 RHS = M16K16(pk4(A2a), Vb, G);
        const f32x4 X1 = M16K16(m8a, pk4(RHS), RHS);
        const f32x4 X2 = M16K16(m4a, pk4(X1), X1);
        const f32x4 X3 = M16K16(m2a, pk4(X2), X2);
        const f32x4 U = M16K16(pk4(-A1a), pk4(X3), X3);
        const s16x4 un = pk4(-U);
        f32x4 O = M16K16(pk4(B2a), Vb, G2);
        O = M16K16(pk4(B1a), un, O);
        { float* op = outb + eo + (size_t)blk * 16 * 512;
#pragma unroll
          for (int e = 0; e < 4; ++e) op[(size_t)e * 512] = O[e]; }
#pragma unroll
        for (int sg = 0; sg < 4; ++sg) {
#pragma unroll
            for (int e = 0; e < 4; ++e) ST[sg][e] *= P16[8 * (sg >> 1) + 4 * (sg & 1) + e];
            const int toff = (4 * g + (r16 >> 2)) * 128 + 32 * sg + 8 * (r16 & 3);
            const s16x4 kh = __builtin_amdgcn_ds_read_tr16_b64_v4i16((LAS s16x4*)(wl + toff));
            const s16x4 bh_ = __builtin_amdgcn_ds_read_tr16_b64_v4i16((LAS s16x4*)(wl + 2048 + toff));
            ST[sg] = M16K16(kh, Vb, ST[sg]);
            ST[sg] = M16K16(bh_, un, ST[sg]);
        }
    }
#undef CS_LOAD
    if (dummy) return;
#pragma unroll
    for (int sg = 0; sg < 4; ++sg) *(f32x4*)(stp + 32 * (sg >> 1) + 4 * (sg & 1)) = ST[sg];
}
DI float sum8(float v) {
    v += __uint_as_float(__builtin_amdgcn_update_dpp(0, __float_as_uint(v), 0xB1, 0xf, 0xf, false));
    v += __uint_as_float(__builtin_amdgcn_update_dpp(0, __float_as_uint(v), 0x4E, 0xf, 0xf, false));
    v += __uint_as_float(__builtin_amdgcn_update_dpp(0, __float_as_uint(v), 0x141, 0xf, 0xf, false));
    return v;
}
DI void unpk8(const u32x4 u, float* f) {
#pragma unroll
    for (int q = 0; q < 4; ++q) { f[2 * q] = bflo(u[q]); f[2 * q + 1] = bfhi(u[q]); }
}
DI void phase_rwkv_post(int l, int par) {
    const int lane = TID() & 63, gw = BID() * 8 + (TID() >> 6), nw = gridDim.x * 8;
    const float* outb = wsp<float>(WS_OUT); const bf16_t* rrb = wsp<bf16_t>(WS_RR); const bf16_t* kfb = wsp<bf16_t>(WS_KF);
    const bf16_t* vsb = wsp<bf16_t>(l == 0 ? WS_VV : WS_V2); const bf16_t* ggb = wsp<bf16_t>(WS_GG); bf16_t* orw = wsp<bf16_t>(WS_ORW + par * PAR_O);
    float lw[8], lb[8], rkc[8];
    { const float* lnw = KP()->in[I_LNW] + l * 512 + 8 * lane; const float* lnb = KP()->in[I_LNB] + l * 512 + 8 * lane; const float* rk = KP()->in[I_RK] + l * 512 + 8 * lane;
#pragma unroll
      for (int e = 0; e < 8; ++e) { lw[e] = lnw[e]; lb[e] = lnb[e]; rkc[e] = rk[e]; } }
    for (int row = gw; row < TC; row += nw) {
        const size_t e0 = (size_t)row * 512 + 8 * lane;
        const f32x4 o0 = *(const f32x4*)(outb + e0), o1 = *(const f32x4*)(outb + e0 + 4);
        float o[8] = {o0[0], o0[1], o0[2], o0[3], o1[0], o1[1], o1[2], o1[3]}, r[8], k[8], v[8], g[8];
        unpk8(*(const u32x4*)(rrb + e0), r); unpk8(*(const u32x4*)(kfb + e0), k); unpk8(*(const u32x4*)(vsb + e0), v); unpk8(*(const u32x4*)(ggb + e0), g);
        float s = 0.f, bo = 0.f;
#pragma unroll
        for (int e = 0; e < 8; ++e) { s += o[e]; bo += r[e] * k[e] * rkc[e]; }
        const float mean = sum8(s) * (1.f / 64.f); const float bonus = sum8(bo);
        float q = 0.f;
#pragma unroll
        for (int e = 0; e < 8; ++e) { o[e] -= mean; q += o[e] * o[e]; }
        const float rs = __builtin_amdgcn_rsqf(sum8(q) * (1.f / 64.f) + 64e-5f);
        u32x4 w;
#pragma unroll
        for (int p = 0; p < 4; ++p) { float y0 = (o[2 * p] * rs * lw[2 * p] + lb[2 * p] + bonus * v[2 * p]) * g[2 * p], y1 = (o[2 * p + 1] * rs * lw[2 * p + 1] + lb[2 * p + 1] + bonus * v[2 * p + 1]) * g[2 * p + 1]; w[p] = pk2(y0, y1); }
        *(u32x4*)(orw + e0) = w;
    }
}

#define MFMA32(a, b, c) __builtin_amdgcn_mfma_f32_32x32x16_bf16((a), (b), (c), 0, 0, 0)
DI unsigned fkey(float v) { v = v + 0.f; const unsigned u = __float_as_uint(v); return (u & 0x80000000u) ? ~u : (u | 0x80000000u); }
DI int half_sum(int x) {
    x += __builtin_amdgcn_update_dpp(0, x, 0x128, 0xf, 0xf, false);
    x += __builtin_amdgcn_update_dpp(0, x, 0x124, 0xf, 0xf, false);
    x += __builtin_amdgcn_update_dpp(0, x, 0x122, 0xf, 0xf, false);
    x += __builtin_amdgcn_update_dpp(0, x, 0x121, 0xf, 0xf, false);
    auto r = __builtin_amdgcn_permlane16_swap((unsigned)x, (unsigned)x, false, false);
    return (int)(r[0] + r[1]);
}
DI void dsa_select_half(int c, int item4, int set, int lane) {
    int lz = lane; asm volatile("" : "+v"(lz));
    const int hh = lz >> 5, r5 = lz & 31;
    const int rc0 = item4 * 4, b = rc0 >> 9, t0 = c * SC + (rc0 & 511);
    const int qq = ((r5 >> 2) & 1) + 2 * ((r5 >> 4) ^ set), hd = (r5 & 3) + 4 * ((r5 >> 3) & 1);
    const bf16_t* qp = wsp<bf16_t>(WS_IDXQ) + (size_t)(rc0 + qq) * 256 + hd * 32 + 8 * hh;
    const bf16x8 Af0 = *(const bf16x8*)qp, Af1 = *(const bf16x8*)(qp + 16);
    const int tA = t0 + hh + 2 * set;
    const float* wp = wsp<float>(WS_IDXW) + ((size_t)b * SEQ + tA) * 8;
    const f32x4 wa0 = *(const f32x4*)wp, wa1 = *(const f32x4*)(wp + 4);
    const int ngrp = ((t0 + 2 * set + 1) >> 9) + 1;
    unsigned keyA[64];
    const bf16_t* kbase = wsp<bf16_t>(WS_IDXK) + ((size_t)b * SEQ + r5) * 32 + 8 * hh;
    int keyv = r5; unsigned kofs = 0u;
    bf16x8 Bn0 = *(const bf16x8*)kbase, Bn1 = *(const bf16x8*)(kbase + 16);
#pragma unroll
    for (int g = 0; g < 4; ++g) {
        if (g < ngrp) {
#pragma unroll
            for (int j = 0; j < 16; ++j) {
                const int kt = g * 16 + j;
                const bf16x8 Bf0 = Bn0, Bf1 = Bn1;
                { const unsigned nofs = (kt < 63) ? kofs + 32 * 32 : kofs; const bf16_t* kp = kbase + nofs; Bn0 = *(const bf16x8*)kp; Bn1 = *(const bf16x8*)(kp + 16); }
                f32x16 C = {0.f, 0.f, 0.f, 0.f, 0.f, 0.f, 0.f, 0.f, 0.f, 0.f, 0.f, 0.f, 0.f, 0.f, 0.f, 0.f};
                C = MFMA32(Af0, Bf0, C); C = MFMA32(Af1, Bf1, C);
                float va = 0.f;
#pragma unroll
                for (int i = 0; i < 4; ++i) va = __builtin_fmaf(__builtin_amdgcn_fmed3f(C[i], 0.f, 3.0e38f), wa0[i], va);
#pragma unroll
                for (int i = 0; i < 4; ++i) va = __builtin_fmaf(__builtin_amdgcn_fmed3f(C[4 + i], 0.f, 3.0e38f), wa1[i], va);
                unsigned ka = (keyv <= tA) ? fkey(va) : 0u;
                asm volatile("" : "+v"(ka), "+v"(keyv), "+v"(kofs));
                keyA[kt] = ka;
                keyv += 32; kofs += 32 * 32;
            }
        } else {
#pragma unroll
            for (int j = 0; j < 16; ++j) keyA[g * 16 + j] = 0u;
        }
    }
    unsigned KA = 0u;
    if (t0 + 2 * set + 1 >= 256) {
        bool dA = tA < 255;
        for (int bit = 31; bit >= 0; --bit) {
            const unsigned cA = KA | (1u << bit);
            int nA = 0;
#pragma unroll
            for (int g = 0; g < 4; ++g) {
                if (g < ngrp) {
#pragma unroll
                    for (int j = 0; j < 16; ++j) nA += (keyA[g * 16 + j] >= cA) ? 1 : 0;
                }
            }
            nA = half_sum(nA);
            if (!dA && nA >= 256) KA = cA;
            dA = dA || (nA == 256);
            if (__ballot(dA) == ~0ull) break;
        }
    }
    int gA = 0;
#pragma unroll
    for (int kt = 0; kt < 64; ++kt) gA += (keyA[kt] > KA) ? 1 : 0;
    gA = half_sum(gA);
    const int needA = (KA == 0u) ? 0 : 256 - gA;
    asm volatile("" : "+v"(KA));
    int runA = 0, lsel = lz;
    unsigned w0 = 0u, w1 = 0u;
#pragma unroll
    for (int kt = 0; kt < 64; ++kt) {
        const bool eqA = keyA[kt] == KA;
        const unsigned long long ea = __ballot(eqA);
        const int rkA = runA + (hh ? (int)__builtin_amdgcn_mbcnt_hi((unsigned)(ea >> 32), 0u) : (int)__builtin_amdgcn_mbcnt_lo((unsigned)ea, 0u));
        const bool sA = (keyA[kt] > KA) || (eqA && rkA < needA);
        runA += hh ? __builtin_popcount((unsigned)(ea >> 32)) : __builtin_popcount((unsigned)ea);
        const unsigned long long sa = __ballot(sA);
        if (lsel == 0) { w0 = (unsigned)sa; w1 = (unsigned)(sa >> 32); }
        lsel -= 1; asm volatile("" : "+v"(lsel));
        __builtin_amdgcn_sched_barrier(0);
    }
    unsigned* sp = wsp<unsigned>(WS_SELB) + (size_t)(rc0 + 2 * set) * 64 + lz;
    sp[0] = w0; sp[64] = w1;
}
DI void dsa_select_full(int c, int item, int lane) {
    {
        int lz = lane; asm volatile("" : "+v"(lz));
        const int hh = lz >> 5, r5 = lz & 31;
        const int rc0 = item * 4, b = rc0 >> 9, t0 = c * SC + (rc0 & 511);
        const int qq = ((r5 >> 2) & 1) + 2 * (r5 >> 4), hd = (r5 & 3) + 4 * ((r5 >> 3) & 1);
        const bf16_t* qp = wsp<bf16_t>(WS_IDXQ) + (size_t)(rc0 + qq) * 256 + hd * 32 + 8 * hh;
        const bf16x8 Af0 = *(const bf16x8*)qp, Af1 = *(const bf16x8*)(qp + 16);
        const float* wp = wsp<float>(WS_IDXW) + ((size_t)b * SEQ + t0 + hh) * 8;
        const f32x4 wa0 = *(const f32x4*)wp, wa1 = *(const f32x4*)(wp + 4), wb0 = *(const f32x4*)(wp + 16), wb1 = *(const f32x4*)(wp + 20);
        const int tA = t0 + hh, tB = t0 + hh + 2;
        const int ngrp = ((t0 + 3) >> 9) + 1;
        unsigned keyA[64], keyB[64];
        const bf16_t* kbase = wsp<bf16_t>(WS_IDXK) + ((size_t)b * SEQ + r5) * 32 + 8 * hh;
        int keyv = r5;
        unsigned kofs = 0u;
        bf16x8 Bn0 = *(const bf16x8*)kbase, Bn1 = *(const bf16x8*)(kbase + 16);
#pragma unroll
        for (int g = 0; g < 4; ++g) {
            if (g < ngrp) {
#pragma unroll
                for (int j = 0; j < 16; ++j) {
                    const int kt = g * 16 + j;
                    const bf16x8 Bf0 = Bn0, Bf1 = Bn1;
                    { const unsigned nofs = (kt < 63) ? kofs + 32 * 32 : kofs; const bf16_t* kp = kbase + nofs; Bn0 = *(const bf16x8*)kp; Bn1 = *(const bf16x8*)(kp + 16); }
                    f32x16 C = {0.f, 0.f, 0.f, 0.f, 0.f, 0.f, 0.f, 0.f, 0.f, 0.f, 0.f, 0.f, 0.f, 0.f, 0.f, 0.f};
                    C = MFMA32(Af0, Bf0, C); C = MFMA32(Af1, Bf1, C);
                    float va = 0.f, vb = 0.f;
#pragma unroll
                    for (int i = 0; i < 4; ++i) { va = __builtin_fmaf(__builtin_amdgcn_fmed3f(C[i], 0.f, 3.0e38f), wa0[i], va); vb = __builtin_fmaf(__builtin_amdgcn_fmed3f(C[8 + i], 0.f, 3.0e38f), wb0[i], vb); }
#pragma unroll
                    for (int i = 0; i < 4; ++i) { va = __builtin_fmaf(__builtin_amdgcn_fmed3f(C[4 + i], 0.f, 3.0e38f), wa1[i], va); vb = __builtin_fmaf(__builtin_amdgcn_fmed3f(C[12 + i], 0.f, 3.0e38f), wb1[i], vb); }
                    unsigned ka = (keyv <= tA) ? fkey(va) : 0u, kb = (keyv <= tB) ? fkey(vb) : 0u;
                    asm volatile("" : "+v"(ka), "+v"(kb), "+v"(keyv), "+v"(kofs));
                    keyA[kt] = ka; keyB[kt] = kb;
                    keyv += 32; kofs += 32 * 32;
                }
            } else {
#pragma unroll
                for (int j = 0; j < 16; ++j) { keyA[g * 16 + j] = 0u; keyB[g * 16 + j] = 0u; }
            }
        }
        unsigned KA = 0u, KB = 0u;
        if (t0 + 3 >= 256) {
            bool dA = false, dB = false;
            for (int bit = 31; bit >= 0; --bit) {
                const unsigned bm = 1u << bit;
                const unsigned cA = KA | bm, cB = KB | bm;
                int nA = 0, nB = 0;
#pragma unroll
                for (int g = 0; g < 4; ++g) {
                    if (g < ngrp) {
#pragma unroll
                        for (int j = 0; j < 16; ++j) { nA += (keyA[g * 16 + j] >= cA) ? 1 : 0; nB += (keyB[g * 16 + j] >= cB) ? 1 : 0; }
                    }
                }
                nA = half_sum(nA); nB = half_sum(nB);
                if (!dA && nA >= 256) KA = cA;
                if (!dB && nB >= 256) KB = cB;
                dA = dA || (nA == 256); dB = dB || (nB == 256);
                if (__ballot(dA && dB) == ~0ull) break;
            }
        }
        int gA = 0, gB = 0;
#pragma unroll
        for (int kt = 0; kt < 64; ++kt) { gA += (keyA[kt] > KA) ? 1 : 0; gB += (keyB[kt] > KB) ? 1 : 0; }
        gA = half_sum(gA); gB = half_sum(gB);
        const int needA = (KA == 0u) ? 0 : 256 - gA, needB = (KB == 0u) ? 0 : 256 - gB;
        asm volatile("" : "+v"(KA), "+v"(KB));
        int runA = 0, runB = 0, lsel = lz;
        unsigned w0 = 0u, w1 = 0u, w2 = 0u, w3 = 0u;
#pragma unroll
        for (int kt = 0; kt < 64; ++kt) {
            const bool eqA = keyA[kt] == KA, eqB = keyB[kt] == KB;
            const unsigned long long ea = __ballot(eqA), eb = __ballot(eqB);
            const int rkA = runA + (hh ? (int)__builtin_amdgcn_mbcnt_hi((unsigned)(ea >> 32), 0u) : (int)__builtin_amdgcn_mbcnt_lo((unsigned)ea, 0u));
            const int rkB = runB + (hh ? (int)__builtin_amdgcn_mbcnt_hi((unsigned)(eb >> 32), 0u) : (int)__builtin_amdgcn_mbcnt_lo((unsigned)eb, 0u));
            const bool sA = (keyA[kt] > KA) || (eqA && rkA < needA), sB = (keyB[kt] > KB) || (eqB && rkB < needB);
            runA += hh ? __builtin_popcount((unsigned)(ea >> 32)) : __builtin_popcount((unsigned)ea);
            runB += hh ? __builtin_popcount((unsigned)(eb >> 32)) : __builtin_popcount((unsigned)eb);
            const unsigned long long sa = __ballot(sA), sb = __ballot(sB);
            if (lsel == 0) { w0 = (unsigned)sa; w1 = (unsigned)(sa >> 32); w2 = (unsigned)sb; w3 = (unsigned)(sb >> 32); }
            lsel -= 1; asm volatile("" : "+v"(lsel));
            __builtin_amdgcn_sched_barrier(0);
        }
        unsigned* sp = wsp<unsigned>(WS_SELB) + (size_t)rc0 * 64 + lz;
        sp[0] = w0; sp[64] = w1; sp[128] = w2; sp[192] = w3;
    }
}

DI void phase_dsa_select_queue(int c, LAS unsigned* ctr) {
    const int lane = TID() & 63;
    const int base = BID() * 8;
    for (;;) {
        unsigned idx = 0u;
        if (lane == 0) idx = __hip_atomic_fetch_add(ctr, 1u, __ATOMIC_RELAXED, __HIP_MEMORY_SCOPE_WORKGROUP);
        idx = (unsigned)__builtin_amdgcn_readfirstlane((int)idx);
        if (idx >= 8u) break;
        const int item4 = base + (int)idx;
        if (item4 < TC / 4) dsa_select_full(c, item4, lane);
    }
}

struct AttnSt { f32x16 O0, O1; float m, l; };
constexpr float C2 = 0.125f * LOG2E;
DI void attn_load_kv(bf16x8 (&Kf)[4], bf16x8 (&Vf)[2][2], const bf16_t* kbase, const bf16_t* vtbase, int key0, int lane) {
    const int r5 = lane & 31;
    const int prow = (r5 & 19) | ((r5 & 4) << 1) | ((r5 & 8) >> 1);
    const bf16_t* kp = kbase + (size_t)(key0 + prow) * 512;
#pragma unroll
    for (int s = 0; s < 4; ++s) Kf[s] = *(const bf16x8*)(kp + 16 * s);
#pragma unroll
    for (int n = 0; n < 2; ++n)
#pragma unroll
        for (int s = 0; s < 2; ++s) Vf[n][s] = *(const bf16x8*)(vtbase + (size_t)(32 * n) * SEQ + key0 + 16 * s);
}
constexpr int BT_N = 192;
template <int MODE, bool FAR>
DI void attn_tile(AttnSt& st, const bf16x8 (&Qf)[4], const bf16x8 (&Kf)[4], const bf16x8 (&Vf)[2][2], int key0, int tq, bool allowed, unsigned word, LAS const float* bt, float ub, int lane) {
    const int hh = lane >> 5;
    const float c0 = (MODE == 0 && !allowed) ? -INFINITY : -ub;
    f32x16 S;
#pragma unroll
    for (int i = 0; i < 16; ++i) S[i] = c0;
#pragma unroll
    for (int s = 0; s < 4; ++s) S = MFMA32(Kf[s], Qf[s], S);
    const unsigned wsh = word >> (8 * hh);
    float ps = 0.f; float pv[16];
    if (FAR) {
        const float cb = bt[BT_N - 1];
#pragma unroll
        for (int i = 0; i < 16; ++i) {
            float p = fexp2(S[i] + cb);
            if (MODE == 1) p = __uint_as_float(__float_as_uint(p) & (unsigned)__builtin_amdgcn_sbfe((int)wsh, 16 * (i >> 3) + (i & 7), 1));
            pv[i] = p; ps += p;
        }
    } else {
        LAS const float* tb_ = bt + (tq - key0 + 32 - 8 * hh - 23);
#pragma unroll
        for (int i = 0; i < 16; ++i) {
            float p = fexp2(S[i] + tb_[23 - (16 * (i >> 3) + (i & 7))]);
            if (MODE == 1) p = __uint_as_float(__float_as_uint(p) & (unsigned)__builtin_amdgcn_sbfe((int)wsh, 16 * (i >> 3) + (i & 7), 1));
            pv[i] = p; ps += p;
        }
    }
    st.l += ps;
#pragma unroll
    for (int s = 0; s < 2; ++s) {
        u32x4 pw; pw[0] = pk2(pv[8 * s], pv[8 * s + 1]); pw[1] = pk2(pv[8 * s + 2], pv[8 * s + 3]); pw[2] = pk2(pv[8 * s + 4], pv[8 * s + 5]); pw[3] = pk2(pv[8 * s + 6], pv[8 * s + 7]);
        const bf16x8 Pf = __builtin_bit_cast(bf16x8, pw);
        st.O0 = MFMA32(Vf[0][s], Pf, st.O0); st.O1 = MFMA32(Vf[1][s], Pf, st.O1);
    }
}
constexpr int AT_KEYS = 128, AT_ROW = 144, AT_VROW = 2 * AT_KEYS + 16, AT_KV = AT_KEYS * AT_ROW, AT_STAGE = AT_KV + 64 * AT_VROW;
template <int MODE>
DI void attn_pair_far(AttnSt& st, const bf16x8 (&Qf)[4], LAS const unsigned char* ks, LAS const unsigned char* vs, int kofs, int vofs, unsigned w0, unsigned w1, const f32x16& CBv, int lane) {
    const int hh = lane >> 5;
    bf16x8 K0[4], K1[4], V0[2][2], V1[2][2];
#pragma unroll
    for (int s = 0; s < 4; ++s) { K0[s] = *(LAS const bf16x8*)(ks + kofs + 32 * s); K1[s] = *(LAS const bf16x8*)(ks + 32 * AT_ROW + kofs + 32 * s); }
#pragma unroll
    for (int n = 0; n < 2; ++n)
#pragma unroll
        for (int s = 0; s < 2; ++s) { V0[n][s] = *(LAS const bf16x8*)(vs + 32 * n * AT_VROW + vofs + 32 * s); V1[n][s] = *(LAS const bf16x8*)(vs + 32 * n * AT_VROW + vofs + 64 + 32 * s); }
    f32x16 S0 = MFMA32(K0[0], Qf[0], CBv), S1 = MFMA32(K1[0], Qf[0], CBv);
#pragma unroll
    for (int s = 1; s < 4; ++s) { S0 = MFMA32(K0[s], Qf[s], S0); S1 = MFMA32(K1[s], Qf[s], S1); }
    const unsigned wa = w0 >> (8 * hh), wb = w1 >> (8 * hh);
    float ps = 0.f; float p0[16], p1[16];
#pragma unroll
    for (int i = 0; i < 16; ++i) {
        float a = fexp2(S0[i]), b = fexp2(S1[i]);
        if (MODE == 1) { a = __uint_as_float(__float_as_uint(a) & (unsigned)__builtin_amdgcn_sbfe((int)wa, 16 * (i >> 3) + (i & 7), 1));
                         b = __uint_as_float(__float_as_uint(b) & (unsigned)__builtin_amdgcn_sbfe((int)wb, 16 * (i >> 3) + (i & 7), 1)); }
        p0[i] = a; p1[i] = b; ps += a + b;
    }
    st.l += ps;
#pragma unroll
    for (int s = 0; s < 2; ++s) {
        u32x4 pw; pw[0] = pk2(p0[8 * s], p0[8 * s + 1]); pw[1] = pk2(p0[8 * s + 2], p0[8 * s + 3]); pw[2] = pk2(p0[8 * s + 4], p0[8 * s + 5]); pw[3] = pk2(p0[8 * s + 6], p0[8 * s + 7]);
        const bf16x8 Pf = __builtin_bit_cast(bf16x8, pw);
        st.O0 = MFMA32(V0[0][s], Pf, st.O0); st.O1 = MFMA32(V0[1][s], Pf, st.O1);
    }
#pragma unroll
    for (int s = 0; s < 2; ++s) {
        u32x4 pw; pw[0] = pk2(p1[8 * s], p1[8 * s + 1]); pw[1] = pk2(p1[8 * s + 2], p1[8 * s + 3]); pw[2] = pk2(p1[8 * s + 4], p1[8 * s + 5]); pw[3] = pk2(p1[8 * s + 6], p1[8 * s + 7]);
        const bf16x8 Pf = __builtin_bit_cast(bf16x8, pw);
        st.O0 = MFMA32(V1[0][s], Pf, st.O0); st.O1 = MFMA32(V1[1][s], Pf, st.O1);
    }
}
template <int MODE>
DI void attn_block(int c, int b, int h, int half, LAS unsigned char* stg, LAS unsigned* uni, LAS const float* bt, float kbound, float bmax, bool dummy) {
    const int tid = TID(), lane = tid & 63, wave = tid >> 6, r5 = lane & 31, hh = lane >> 5;
    bf16_t* qbuf = wsp<bf16_t>((MODE == 0 ? WS_MQ : WS_DQ) + (c & 1) * PAR_O);
    const int tb = c * SC + 256 * half, t0 = tb + 32 * wave, tq = t0 + r5, rowc0 = b * SC + 256 * half + 32 * wave;
    bf16_t* qp = qbuf + (size_t)(rowc0 + r5) * 512 + h * 64;
    bf16x8 Qf[4];
#pragma unroll
    for (int s = 0; s < 4; ++s) Qf[s] = *(const bf16x8*)(qp + 16 * s + 8 * hh);
    AttnSt st; st.m = 0.f; st.l = 0.f;
#pragma unroll
    for (int i = 0; i < 16; ++i) { st.O0[i] = 0.f; st.O1[i] = 0.f; }
    float ub;
    { float q2 = 0.f;
#pragma unroll
      for (int s = 0; s < 4; ++s)
#pragma unroll
          for (int j = 0; j < 8; ++j) { const float v = bf2f((bf16_t)Qf[s][j]); q2 += v * v; }
      q2 += __shfl_xor(q2, 32);
      ub = sqrtf(q2) * kbound + bmax; }
    const int ktl = (t0 + 31) >> 5;
    const int own = tb >> 8;
    unsigned bm = 0u, anyw = 0xffu;
    if (MODE == 0) {
        if (own > 0) {
            const float* km = wsp<float>(WS_KMEAN) + ((size_t)(b * 8 + h) * 8) * 64 + 8 * hh;
            float g[8];
#pragma unroll
            for (int n = 0; n < 8; ++n) {
                g[n] = -INFINITY;
                if (n < own) {
                    float part = 0.f;
#pragma unroll
                    for (int s = 0; s < 4; ++s) { const f32x4 k0 = *(const f32x4*)(km + n * 64 + 16 * s), k1 = *(const f32x4*)(km + n * 64 + 16 * s + 4);
#pragma unroll
                        for (int j = 0; j < 4; ++j) part += bf2f((bf16_t)Qf[s][j]) * k0[j] + bf2f((bf16_t)Qf[s][4 + j]) * k1[j]; }
                    g[n] = part + __shfl_xor(part, 32);
                }
            }
#pragma unroll
            for (int n = 0; n < 8; ++n) {
                if (n < own) { int rank = 0;
#pragma unroll
                    for (int m2 = 0; m2 < 8; ++m2) if (m2 != n && m2 < own) rank += ((g[m2] > g[n]) || (g[m2] == g[n] && m2 < n)) ? 1 : 0;
                    if (rank < 3) bm |= 1u << n; }
            }
        }
        anyw = 1u << own;
#pragma unroll
        for (int n = 0; n < 8; ++n) if (n < own && __ballot((bm >> n) & 1u) != 0ull) anyw |= 1u << n;
    }
    if (tid == 0) uni[0] = 0u;
    __syncthreads();
    if (lane == 0) __hip_atomic_fetch_or(uni, anyw, __ATOMIC_RELAXED, __HIP_MEMORY_SCOPE_WORKGROUP);
    __syncthreads();
    const unsigned anyb = MODE == 0 ? uni[0] : 0xffu;
    const bf16_t* kg[2]; const bf16_t* vg[2]; int klofs[2], vlofs[2];
#pragma unroll
    for (int i = 0; i < 2; ++i) { const int pc_ = tid + 512 * i;
        kg[i] = wsp<bf16_t>(MODE == 0 ? WS_MK : WS_DK) + ((size_t)b * SEQ + (pc_ >> 3)) * 512 + h * 64 + (pc_ & 7) * 8;
        vg[i] = wsp<bf16_t>(MODE == 0 ? WS_MVT : WS_DVT) + ((size_t)b * 512 + h * 64 + (pc_ >> 4)) * SEQ + (pc_ & 15) * 8;
        klofs[i] = (pc_ >> 3) * AT_ROW + (pc_ & 7) * 16; vlofs[i] = AT_KV + (pc_ >> 4) * AT_VROW + (pc_ & 15) * 16; }
    const int prow = (r5 & 19) | ((r5 & 4) << 1) | ((r5 & 8) >> 1);
    const int kofs = prow * AT_ROW + 16 * hh, vofs = r5 * AT_VROW + 16 * hh;
    const unsigned* sp = wsp<unsigned>(WS_SELB) + (size_t)(rowc0 + r5) * 64;
    const int nst = (tb + 256) >> 7;
    int stp = 0;
    if (MODE == 0) { while (!((anyb >> (stp >> 1)) & 1u)) stp += 2; }
    u32x4 kreg[2], vreg[2];
#pragma unroll
    for (int i = 0; i < 2; ++i) { kreg[i] = *(const u32x4*)(kg[i] + (size_t)(stp * AT_KEYS) * 512); vreg[i] = *(const u32x4*)(vg[i] + stp * AT_KEYS);
        *(LAS u32x4*)(stg + klofs[i]) = kreg[i]; *(LAS u32x4*)(stg + vlofs[i]) = vreg[i]; }
    u32x4 wcur = {0u, 0u, 0u, 0u}, wnxt = {0u, 0u, 0u, 0u};
    if (MODE == 1) wcur = *(const u32x4*)(sp + 4 * stp);
    __syncthreads();
    int cur = 0;
    f32x16 CBv; int cbblk = -1;
    while (stp < nst) {
        int nx = stp + 1;
        if (MODE == 0) { while (nx < nst && !((anyb >> (nx >> 1)) & 1u)) nx += 2 - (nx & 1); }
        const bool more = nx < nst;
        if (more) {
#pragma unroll
            for (int i = 0; i < 2; ++i) { kreg[i] = *(const u32x4*)(kg[i] + (size_t)(nx * AT_KEYS) * 512); vreg[i] = *(const u32x4*)(vg[i] + nx * AT_KEYS); }
            if (MODE == 1) wnxt = *(const u32x4*)(sp + 4 * nx); }
        LAS const unsigned char* ks = stg + cur * AT_STAGE; LAS const unsigned char* vs = ks + AT_KV;
        const int nbs = stp >> 1;
        const bool won = (MODE == 1) || (((anyw >> nbs) & 1u) != 0u);
#pragma unroll
        for (int pr = 0; pr < 2; ++pr) {
            const int ktp = 4 * stp + 2 * pr;
            if (won && (ktp + 1 <= ktl) && (t0 - (ktp * 32 + 63) >= 113)) {
                if (cbblk != (MODE == 0 ? nbs : 0)) { cbblk = (MODE == 0 ? nbs : 0);
                    const bool allowed = (MODE == 0) ? ((nbs == own) || (((bm >> nbs) & 1u) != 0u)) : true;
                    const float cb = allowed ? (bt[BT_N - 1] - ub) : -INFINITY;
#pragma unroll
                    for (int i = 0; i < 16; ++i) CBv[i] = cb; }
                attn_pair_far<MODE>(st, Qf, ks + 64 * pr * AT_ROW, vs + 128 * pr, kofs, vofs, wcur[2 * pr], wcur[2 * pr + 1], CBv, lane);
            } else {
#pragma unroll
                for (int uu = 0; uu < 2; ++uu) {
                    const int u = 2 * pr + uu, kt = 4 * stp + u, key0 = kt * 32, nb = kt >> 3;
                    const bool waveon = (kt <= ktl) && (MODE == 1 || ((anyw >> nb) & 1u));
                    if (waveon) {
                        bf16x8 Kf[4], Vf[2][2];
#pragma unroll
                        for (int s = 0; s < 4; ++s) Kf[s] = *(LAS const bf16x8*)(ks + 32 * u * AT_ROW + kofs + 32 * s);
#pragma unroll
                        for (int n = 0; n < 2; ++n)
#pragma unroll
                            for (int s = 0; s < 2; ++s) Vf[n][s] = *(LAS const bf16x8*)(vs + 32 * n * AT_VROW + vofs + 64 * u + 32 * s);
                        const unsigned word = (MODE == 1) ? wcur[u] : 0u;
                        const bool allowed = (MODE == 0) ? ((nb == own) || (((bm >> nb) & 1u) != 0u)) : true;
                        if (t0 - (key0 + 31) >= 113) attn_tile<MODE, true>(st, Qf, Kf, Vf, key0, tq, allowed, word, bt, ub, lane);
                        else attn_tile<MODE, false>(st, Qf, Kf, Vf, key0, tq, allowed, word, bt, ub, lane);
                    }
                }
            }
        }
        if (more) { LAS unsigned char* ws_ = stg + (cur ^ 1) * AT_STAGE;
#pragma unroll
            for (int i = 0; i < 2; ++i) { *(LAS u32x4*)(ws_ + klofs[i]) = kreg[i]; *(LAS u32x4*)(ws_ + vlofs[i]) = vreg[i]; } }
        __syncthreads();
        cur ^= 1; stp = nx; wcur = wnxt;
    }
    const float lt = st.l + __shfl_xor(st.l, 32);
    const float inv = 1.f / lt;
    if (dummy) qp = wsp<bf16_t>(WS_RAW + (MODE ? 8 * MiB : 0)) + (size_t)(rowc0 + r5) * 512 + h * 64;
#pragma unroll
    for (int g4 = 0; g4 < 4; ++g4) {
        st_bf4(qp + 8 * g4 + 4 * hh, (f32x4){st.O0[4 * g4] * inv, st.O0[4 * g4 + 1] * inv, st.O0[4 * g4 + 2] * inv, st.O0[4 * g4 + 3] * inv});
        st_bf4(qp + 32 + 8 * g4 + 4 * hh, (f32x4){st.O1[4 * g4] * inv, st.O1[4 * g4 + 1] * inv, st.O1[4 * g4 + 2] * inv, st.O1[4 * g4 + 3] * inv});
    }
    __syncthreads();
}
__device__ const unsigned char kBucket[128] = {0,1,2,3,4,5,6,7,8,9,10,11,12,13,14,15,16,16,16,17,17,18,18,18,19,19,19,20,20,20,20,21,21,21,21,22,22,22,22,22,23,23,23,23,23,23,24,24,24,24,24,24,25,25,25,25,25,25,25,26,26,26,26,26,26,26,26,27,27,27,27,27,27,27,27,27,27,28,28,28,28,28,28,28,28,28,28,29,29,29,29,29,29,29,29,29,29,29,29,30,30,30,30,30,30,30,30,30,30,30,30,30,30,31,31,31,31,31,31,31,31,31,31,31,31,31,31,31};
DI void phase_attn(int l, int c, LAS float* lds, bool dummy = false) {
    const int tid = TID();
    for (int e = tid; e < 2 * 8 * BT_N; e += 512) { const int j = e % BT_N, h = (e / BT_N) & 7, mx = e / (8 * BT_N); const int d = j - 32;
        lds[e] = (d < 0) ? -INFINITY : KP()->in[I_REL][kBucket[d < 127 ? d : 127] * 16 + mx * 8 + h] * LOG2E; }
    if (tid < 2) { const float* g = KP()->in[I_QKN] + l * 256 + (tid == 0 ? 64 : 192); float m = 0.f; for (int i = 0; i < 64; ++i) m = fmaxf(m, fabsf(g[i])); lds[3072 + tid] = 8.1f * m; }
    if (tid >= 64 && tid < 80) { const int mx = (tid - 64) >> 3, h = (tid - 64) & 7; float m = 0.f; for (int k = 0; k < 32; ++k) m = fmaxf(m, fabsf(KP()->in[I_REL][k * 16 + mx * 8 + h])); lds[3088 + (tid - 64)] = m * LOG2E; }
    __syncthreads();
    LAS unsigned char* stg = (LAS unsigned char*)lds + 16384; LAS unsigned* uni = (LAS unsigned*)((LAS unsigned char*)lds + 12544);
    for (int it = BID(); it < NB * NH * 2; it += gridDim.x) {
        const int bh = it >> 1, b = bh >> 3, h = bh & 7, hf = it & 1;
        attn_block<0>(c, b, h, hf, stg, uni, lds + h * BT_N, lds[3072], lds[3088 + h], dummy);
        attn_block<1>(c, b, h, hf ^ 1, stg, uni, lds + (8 + h) * BT_N, lds[3073], lds[3096 + h], dummy);
    }
    if (!dummy) { phase_rwkv_post(l, c & 1); if (DBL_PHASE == 24) phase_rwkv_post(l, c & 1); }
}

constexpr int LDS_BYTES = pg8::STAGE_BYTES + 256 + XS_BYTES;
constexpr int PH_PER_LAYER = 32, N_PHASES = 2 * PH_PER_LAYER;
#ifndef DBL_PHASE
#define DBL_PHASE 0
#endif
#ifndef MK_ONE_LAUNCH
#define MK_ONE_LAUNCH 1
#endif
__global__ void __launch_bounds__(512, 2) mega(Params p) {
    extern __shared__ __attribute__((aligned(16))) unsigned char lds_raw[];
    LAS unsigned char* lds = (LAS unsigned char*)lds_raw;
    volatile LAS unsigned* bst = (volatile LAS unsigned*)(lds + pg8::STAGE_BYTES);
    if (TID() < 4) bst[TID()] = 0u;
    __syncthreads();
    if (p.ph_hi - p.ph_lo > 1) (void)xcd_barrier_post((unsigned*)(KP()->ws + WS_CTL), bst);
#ifndef PH_ONLY
#define PH_ONLY -1
#endif
#define IN(k) (KP()->ph_lo <= (k) && (k) < KP()->ph_hi)
#define INT(tag, k) ((PH_ONLY < 0 || PH_ONLY == (tag)) && IN(k))
#define SEAM(k) do { if (IN(k) && IN((k) + 1)) { XcdBarrier bar_; bar_.bar = (unsigned*)(KP()->ws + WS_CTL); bar_.x = xb_xcc_id(); bar_.st = (volatile LAS unsigned*)(lds + pg8::STAGE_BYTES); xcd_barrier(bar_); if (DBL_PHASE == 20) xcd_barrier(bar_); } } while (0)
    for (int l = 0; l < 2; ++l) {
        const int pb = PH_PER_LAYER * l;
        if (INT(0, pb + 0)) {
#if DBL_PHASE == 6
            phase_conv(l, (LAS float*)lds);
#endif
            phase_conv(l, (LAS float*)lds);
#if DBL_PHASE == 7
            phase_norm(l == 0 ? KP()->in[I_X] : (const float*)KP()->out, KP()->in[I_NMIX] + l * DM, wsp<bf16_t>(WS_H));
#endif
            phase_norm(l == 0 ? KP()->in[I_X] : (const float*)KP()->out, KP()->in[I_NMIX] + l * DM, wsp<bf16_t>(WS_H)); }
        SEAM(pb + 1);
        if (INT(2, pb + 2)) {
            { const SchedLin S = mk_sched(128, 4, WS_H, WS_WB, 1024); const EpiB E{l}; pg8::gemm_phase(lds, 1024, S, E); }
            { const SchedLin S = mk_sched(2, 128, WS_WV, WS_H, 1024); const EpiVt E{(unsigned)WS_MVT}; pg8::gemm_phase(lds, 1024, S, E); }
#if DBL_PHASE == 9
            { const SchedLin S = mk_sched(128, 4, WS_H, WS_WB, 1024); const EpiB E{l}; pg8::gemm_phase(lds, 1024, S, E); }
            { const SchedLin S = mk_sched(2, 128, WS_WV, WS_H, 1024); const EpiVt E{(unsigned)WS_MVT}; pg8::gemm_phase(lds, 1024, S, E); }
#endif
        }
        SEAM(pb + 2);
        if (INT(4, pb + 4)) {
            { const SchedLin S = mk_sched(128, 2, WS_DCN, WS_WKVK, 256); const EpiHN E{l}; pg8::gemm_phase(lds, 256, S, E); }
            { const SchedLin S = mk_sched(2, 128, WS_WKVV, WS_DCN, 256); const EpiVt E{(unsigned)WS_DVT}; pg8::gemm_phase(lds, 256, S, E); }
#if DBL_PHASE == 13
            { const SchedLin S = mk_sched(128, 2, WS_DCN, WS_WKVK, 256); const EpiHN E{l}; pg8::gemm_phase(lds, 256, S, E); }
            { const SchedLin S = mk_sched(2, 128, WS_WKVV, WS_DCN, 256); const EpiVt E{(unsigned)WS_DVT}; pg8::gemm_phase(lds, 256, S, E); }
#endif
        }
        SEAM(pb + 4);
        for (int c = 0; c < NCH; ++c) {
            const int pc = pb + 5 + 5 * c + 2 * (c >> 1), cbase = c * SC;
            if (INT(5, pc + 0)) { const SchedLin S = mk_sched(32, 24, WS_H, WS_WD1, 1024, 1, cbase); const EpiD1 E{l, c & 1}; pg8::gemm_phase(lds, 1024, S, E);
#if DBL_PHASE == 5
                pg8::gemm_phase(lds, 1024, S, E);
#endif
#if DBL_PHASE == 27
                { const EpiNull E0{}; pg8::gemm_phase(lds, 1024, S, E0); }
#endif
            }
            SEAM(pc + 0);
            if (INT(6, pc + 1)) {
#if DBL_PHASE == 4
                phase_rwkv_prep(l, c);
#endif

                phase_rwkv_prep(l, c); }
            SEAM(pc + 1);
            if (INT(7, pc + 2)) { const SchedLin S = mk_sched(32, l == 0 ? 6 : 8, WS_LORAA, WS_WL, 512, 0, 0, WS_VV, 6); const EpiLora E{l, cbase}; pg8::gemm_phase(lds, 512, S, E); }
            SEAM(pc + 2);
            if (INT(8, pc + 3)) {
#if DBL_PHASE == 2
                phase_scan_chunked(l, c, lds, true);
#endif
#if DBL_PHASE == 22
                phase_scan_chunked(l, c, lds, true);
#endif

#if DBL_PHASE == 11
                phase_scan(l, c, 2);
#endif
#if DBL_PHASE == 12
                phase_scan(l, c, 3);
#endif
#if DBL_PHASE == 25
                if (TID() == 0) *(LAS unsigned*)(lds + 8192) = 0u;
                __syncthreads();
                phase_scan_chunked(l, c, lds, true); phase_dsa_select_queue(c, (LAS unsigned*)(lds + 8192));
                __syncthreads();
#endif
#if DBL_PHASE == 26
                if (TID() == 0) *(LAS unsigned*)(lds + 8192) = 0u;
                __syncthreads();
                phase_dsa_select_queue(c, (LAS unsigned*)(lds + 8192));
                __syncthreads();
#endif
                if (TID() == 0) *(LAS unsigned*)(lds + 8192) = 0u;
                __syncthreads();
                phase_scan_chunked(l, c, lds);
                phase_dsa_select_queue(c, (LAS unsigned*)(lds + 8192)); }
            SEAM(pc + 3);
            if (INT(9, pc + 4)) {
#if DBL_PHASE == 1
                phase_attn(l, c, (LAS float*)lds, true); __syncthreads();
#endif
                phase_attn(l, c, (LAS float*)lds); }
            SEAM(pc + 4);
            if (c & 1) {
                if (INT(10, pc + 5)) { const SchedMerge S{(int)gridDim.x, (int)BID()}; const EpiMerge E{}; pg8::gemm_phase(lds, 512, S, E);
#if DBL_PHASE == 10
                    pg8::gemm_phase(lds, 512, S, E);
#endif
                }
                SEAM(pc + 5);
                if (INT(11, pc + 6)) { const SchedLin S = mk_sched(64, 4, WS_Y, WS_WO, 1024); const EpiRes E{l == 0 ? 1 : 0, 2, cbase - SC, 0u}; pg8::gemm_phase(lds, 1024, S, E); }
                SEAM(pc + 6);
            }
        }
        if (INT(33, pb + 29)) phase_norm(KP()->out, KP()->in[I_NFFN] + l * DM, wsp<bf16_t>(WS_H));
        SEAM(pb + 29);
        if (INT(34, pb + 30)) { const SchedLin S = mk_sched(128, 22, WS_H, WS_WF1, 1024); const EpiSwiglu E{}; pg8::gemm_phase(lds, 1024, S, E);
#if DBL_PHASE == 8
            pg8::gemm_phase(lds, 1024, S, E);
#endif
        }
        SEAM(pb + 30);
        if (INT(35, pb + 31)) { const SchedLin S = mk_sched(128, 4, WS_ACT, WS_WF2, DFF); const EpiRes E{0, 0, 0, 0u};
#if DBL_PHASE == 16
            { const EpiRes E2{0, 0, 0, (unsigned)(WS_ACT + 176 * MiB)}; pg8::gemm_phase(lds, DFF, S, E2); }
#endif
            pg8::gemm_phase(lds, DFF, S, E); }
        SEAM(pb + 31);
    }
#undef IN
#undef INT
#undef SEAM
}

extern "C" void kernel_launch(void* const* d_in, const int* in_sizes, int n_in, void* d_out, int out_size, void* d_ws, size_t ws_size, hipStream_t stream) {
    static int grid = 0;
    if (grid == 0) {
        if (n_in != 26 || ws_size < WS_END) { grid = -1; return; }
        int dev = 0, cus = 0;
        if (hipGetDevice(&dev) != hipSuccess || hipDeviceGetAttribute(&cus, hipDeviceAttributeMultiprocessorCount, dev) != hipSuccess) { grid = -1; return; }
        if (hipFuncSetAttribute((const void*)mega, hipFuncAttributeMaxDynamicSharedMemorySize, LDS_BYTES) != hipSuccess) { grid = -1; return; }
        grid = cus;
    }
    if (grid < 0) return;
    (void)hipMemsetAsync((char*)d_ws + WS_CTL, 0, 64 * 1024, stream);
    Params p{};
    for (int i = 0; i < 26; ++i) p.in[i] = (const float*)d_in[i];
    p.out = (float*)d_out; p.ws = (unsigned char*)d_ws;
#if MK_ONE_LAUNCH
    p.ph_lo = 0; p.ph_hi = N_PHASES;
    hipLaunchKernelGGL(mega, dim3(grid), dim3(512), LDS_BYTES, stream, p);
#else
    for (int ph = 0; ph < N_PHASES; ++ph) { p.ph_lo = ph; p.ph_hi = ph + 1; hipLaunchKernelGGL(mega, dim3(grid), dim3(512), LDS_BYTES, stream, p); }
#endif
}
```

```cpp
#include <hip/hip_runtime.h>
#include <stdint.h>
#ifndef DBL_PHASE
#define DBL_PHASE 0
#endif

#define DI __device__ __forceinline__
#define LAS __attribute__((address_space(3)))
typedef unsigned short bf16_t;
typedef short bf16x8 __attribute__((ext_vector_type(8)));
typedef float f32x2 __attribute__((ext_vector_type(2)));
typedef float f32x4 __attribute__((ext_vector_type(4)));
typedef float f32x16 __attribute__((ext_vector_type(16)));
typedef unsigned u32x2 __attribute__((ext_vector_type(2)));
typedef unsigned u32x4 __attribute__((ext_vector_type(4)));
typedef __bf16 bf2_t __attribute__((ext_vector_type(2)));

constexpr int NB = 16, SEQ = 2048, DM = 1024, NT = NB * SEQ, NH = 8, BW = 512;
constexpr int NCH = 4, SC = 512, TC = NB * SC;
constexpr int D_IN = 7496, DFF = 2816;
constexpr int C_MQ = 0, C_MK = 512, C_MV = 1024, C_RW = 1536, C_DS = 3360, C_GT = 4424;
constexpr int RAWLD = 1792;
constexpr float NORM_EPS = 1e-6f;
constexpr float LOG2E = 1.4426950408889634f;
constexpr float QSCALE = 0.125f * LOG2E;

constexpr size_t MiB = 1024 * 1024;
constexpr size_t WS_CTL = 0;
constexpr size_t WS_WB = 64 * 1024;
constexpr size_t WS_WV = WS_WB + 2 * MiB;
constexpr size_t WS_WD1 = WS_WV + 1 * MiB;
constexpr size_t WS_WKVK = WS_WD1 + 12 * MiB;
constexpr size_t WS_WKVV = WS_WKVK + MiB / 4;
constexpr size_t WS_WL = WS_WKVV + MiB / 4;
constexpr size_t WS_WBR = WS_WL + 2 * MiB;
constexpr size_t WS_WO = WS_WBR + 3 * MiB;
constexpr size_t WS_WF1 = WS_WO + 2 * MiB;
constexpr size_t WS_WF2 = WS_WF1 + 11 * MiB;
constexpr size_t WS_VFIRST = WS_WF2 + 6 * MiB;
constexpr size_t WS_STATE = WS_VFIRST + 32 * MiB;
constexpr size_t WS_H = WS_STATE + 2 * MiB;
constexpr size_t WS_IDXK = WS_H + 64 * MiB;
constexpr size_t WS_IDXW = WS_IDXK + 2 * MiB;
constexpr size_t WS_LEFT = WS_IDXW + 1 * MiB;
constexpr size_t WS_KMEAN = WS_LEFT + 2 * MiB;
constexpr size_t WS_CARRY = WS_KMEAN + MiB / 4;
constexpr size_t WS_MK = WS_CARRY + MiB / 4;
constexpr size_t WS_MVT = WS_MK + 32 * MiB;
constexpr size_t WS_DK = WS_MVT + 32 * MiB;
constexpr size_t WS_DVT = WS_DK + 32 * MiB;
constexpr size_t WS_MQ = WS_DVT + 32 * MiB;
constexpr size_t WS_DQ = WS_MQ + 16 * MiB;
constexpr size_t WS_ORW = WS_DQ + 16 * MiB;
constexpr size_t WS_GATES = WS_ORW + 16 * MiB;
constexpr size_t PAR_O = 8 * MiB, PAR_G = 24 * MiB;
constexpr size_t WS_IDXQ = WS_GATES + 48 * MiB;
constexpr size_t WS_RAW = WS_IDXQ + 4 * MiB;
constexpr size_t WS_LORAA = WS_RAW + 28 * MiB;
constexpr size_t WS_RR = WS_LORAA + 8 * MiB;
constexpr size_t WS_KF = WS_RR + 8 * MiB;
constexpr size_t WS_VV = WS_KF + 8 * MiB;
constexpr size_t WS_KKB = WS_VV + 8 * MiB;
constexpr size_t WS_BBB = WS_KKB + 8 * MiB;
constexpr size_t WS_GG = WS_BBB + 8 * MiB;
constexpr size_t WS_DEC = WS_GG + 8 * MiB;
constexpr size_t WS_OUT = WS_DEC + 16 * MiB;
constexpr size_t WS_V2 = WS_OUT + 16 * MiB;
constexpr size_t WS_SELB = WS_V2 + 8 * MiB;
constexpr size_t WS_END = WS_SELB + 2 * MiB;
constexpr size_t WS_KT = WS_RAW, WS_BT = WS_RAW + 8 * MiB, WS_KQ = WS_RAW + 16 * MiB, WS_P16 = WS_RAW + 24 * MiB, WS_RT = WS_BBB, WS_KH = WS_DEC, WS_BH = WS_DEC + 8 * MiB;
constexpr size_t WS_DCN = WS_RAW;
constexpr size_t WS_Y32 = WS_IDXQ;
constexpr size_t WS_Y = WS_Y32 + 64 * MiB;
static_assert(WS_Y + 32 * MiB <= WS_END, "y32 / y alias");
constexpr size_t WS_ACT = WS_MK;
static_assert(WS_END <= 512 * MiB, "workspace map exceeds 512 MiB");
static_assert(WS_ACT + 176 * MiB <= WS_END, "ACT alias");

DI unsigned pk2(float a, float b) { f32x2 v = {a, b}; return __builtin_bit_cast(unsigned, __builtin_convertvector(v, bf2_t)); }
DI bf16_t f2bf(float a) { return (bf16_t)(pk2(a, 0.f) & 0xffffu); }
DI float bflo(unsigned u) { return __uint_as_float(u << 16); }
DI float bfhi(unsigned u) { return __uint_as_float(u & 0xffff0000u); }
DI float bf2f(bf16_t b) { return __uint_as_float((unsigned)b << 16); }
DI float fexp2(float x) { return __builtin_amdgcn_exp2f(x); }
DI float frcp(float x) { return __builtin_amdgcn_rcpf(x); }
DI float fsigmoid(float x) { return frcp(1.f + fexp2(-x * LOG2E)); }
DI float wave_sum(float v) {
    v += __uint_as_float(__builtin_amdgcn_update_dpp(0, __float_as_uint(v), 0x128, 0xf, 0xf, false));
    v += __uint_as_float(__builtin_amdgcn_update_dpp(0, __float_as_uint(v), 0x124, 0xf, 0xf, false));
    v += __uint_as_float(__builtin_amdgcn_update_dpp(0, __float_as_uint(v), 0x122, 0xf, 0xf, false));
    v += __uint_as_float(__builtin_amdgcn_update_dpp(0, __float_as_uint(v), 0x121, 0xf, 0xf, false));
    auto r = __builtin_amdgcn_permlane16_swap(__float_as_uint(v), __float_as_uint(v), false, false);
    v = __uint_as_float(r[0]) + __uint_as_float(r[1]);
    r = __builtin_amdgcn_permlane32_swap(__float_as_uint(v), __float_as_uint(v), false, false);
    return __uint_as_float(r[0]) + __uint_as_float(r[1]);
}

DI float dpp_shr1(float x, float old) { return __uint_as_float(__builtin_amdgcn_update_dpp(__float_as_uint(old), __float_as_uint(x), 0x111, 0xf, 0xf, false)); }
DI float dpp_shr2(float x, float old) { return __uint_as_float(__builtin_amdgcn_update_dpp(__float_as_uint(old), __float_as_uint(x), 0x112, 0xf, 0xf, false)); }
DI float dpp_shr4(float x, float old) { return __uint_as_float(__builtin_amdgcn_update_dpp(__float_as_uint(old), __float_as_uint(x), 0x114, 0xf, 0xf, false)); }
DI float dpp_shr8(float x, float old) { return __uint_as_float(__builtin_amdgcn_update_dpp(__float_as_uint(old), __float_as_uint(x), 0x118, 0xf, 0xf, false)); }
DI float dpp_bcast15(float x) { return __uint_as_float(__builtin_amdgcn_update_dpp(0, __float_as_uint(x), 0x15F, 0xf, 0xf, false)); }

#define XB_TMO      128
#define XB_XCNT(j)  (256  + 64 * (j))
#define XB_XSUB(j)  (1280 + 64 * (j))
#define XB_XGEN(j)  (2304 + 64 * (j))
#define XB_TOP      3328
#define XB_TOPGEN   3392
#define XCD_BAR_WORDS 3456
#define XB_SPIN_CAP (1u << 18)
__device__ __forceinline__ unsigned xb_ld(unsigned* p)              { return __hip_atomic_load(p, __ATOMIC_RELAXED, __HIP_MEMORY_SCOPE_AGENT); }
__device__ __forceinline__ unsigned xb_add(unsigned* p, unsigned v) { return __hip_atomic_fetch_add(p, v, __ATOMIC_RELAXED, __HIP_MEMORY_SCOPE_AGENT); }
__device__ __forceinline__ unsigned xb_xcc_id() { return (unsigned)__builtin_amdgcn_s_getreg((3 << 11) | 20) & 0xFu; }
#define XB_SPIN(cond, bar) do { unsigned _sp = 0; while (cond) { __builtin_amdgcn_s_sleep(1); \
    if ((++_sp & 255u) == 0u) { if (xb_ld(&(bar)[XB_TMO])) break; if (_sp > XB_SPIN_CAP) { atomicAdd(&(bar)[XB_TMO], 1u); break; } } } } while (0)
struct XcdBarrier { unsigned* bar; unsigned x; volatile LAS unsigned* st; };
__device__ __forceinline__ XcdBarrier xcd_barrier_post(unsigned* bar, volatile LAS unsigned* st) {
    XcdBarrier b; b.bar = bar; b.x = xb_xcc_id(); b.st = st;
    if (threadIdx.x == 0) (void)xb_add(&bar[XB_XCNT(b.x)], 1u);
    return b;
}
__device__ __forceinline__ void xcd_barrier_complete(unsigned* bar, unsigned x, unsigned& nloc, unsigned& nx) {
    const unsigned G = gridDim.x * gridDim.y * gridDim.z;
    unsigned sum, cnt, mine, sp = 0u;
    for (;;) {
        sum = 0u; cnt = 0u; mine = 0u;
#pragma unroll 1
        for (unsigned j = 0; j < 16; ++j) { const unsigned c = xb_ld(&bar[XB_XCNT(j)]); sum += c; cnt += (c > 0u) ? 1u : 0u; mine = (j == x) ? c : mine; }
        if (sum == G) break;
        __builtin_amdgcn_s_sleep(1);
        if ((++sp & 255u) == 0u) { if (xb_ld(&bar[XB_TMO])) break; if (sp > XB_SPIN_CAP) { atomicAdd(&bar[XB_TMO], 1u); break; } }
    }
    nloc = mine > 0u ? mine : 1u; nx = cnt > 0u ? cnt : 1u;
}
__device__ __forceinline__ void xcd_barrier(const XcdBarrier& b) {
    asm volatile("s_waitcnt vmcnt(0)" ::: "memory");
    __syncthreads();
    if (threadIdx.x == 0) {
        unsigned* bar = b.bar;
        __builtin_amdgcn_s_waitcnt(0);
        unsigned nloc = b.st[0], nx = b.st[1];
        if (nloc == 0u) { xcd_barrier_complete(bar, b.x, nloc, nx); b.st[0] = nloc; b.st[1] = nx; }
        const unsigned old = xb_add(&bar[XB_XSUB(b.x)], 1u);
        const unsigned gen = old / nloc;
        if (old + 1u == (gen + 1u) * nloc) {
            __builtin_amdgcn_fence(__ATOMIC_RELEASE, "agent");
            asm volatile("s_waitcnt vmcnt(0)" ::: "memory");
            const unsigned og = xb_add(&bar[XB_TOP], 1u);
            const unsigned tg = og / nx;
            if (og + 1u == (tg + 1u) * nx) xb_add(&bar[XB_TOPGEN], 1u);
            else XB_SPIN(xb_ld(&bar[XB_TOPGEN]) == tg, bar);
            __builtin_amdgcn_fence(__ATOMIC_ACQUIRE, "agent");
            xb_add(&bar[XB_XGEN(b.x)], 1u);
            asm volatile("s_waitcnt vmcnt(0)" ::: "memory");
        } else {
            XB_SPIN(xb_ld(&bar[XB_XGEN(b.x)]) == gen, bar);
            __builtin_amdgcn_fence(__ATOMIC_ACQUIRE, "agent");
            asm volatile("s_waitcnt vmcnt(0)" ::: "memory");
        }
    }
    __syncthreads();
}

DI int TID() { int t = threadIdx.x; asm volatile("" : "+v"(t)); return t; }
DI int BID() { int b = blockIdx.x; asm volatile("" : "+s"(b)); return b; }

namespace pg8 {
constexpr int BM = 256, BK = 64, HALF = 128, HTB = HALF * BK * 2, STAGE_BYTES = 8 * HTB, NXCD = 8, WGM = 8;
DI int lds_byte(int r, int c) { const int st = (r >> 4) * 2 + (c >> 5), rr = r & 15, cc = c & 31, ob = rr * 64 + cc * 2; return st * 1024 + (ob ^ (((ob >> 9) & 1) << 5)); }
DI void stage_rc(int b, int& R, int& C) { const int st = b / 1024, sb = b % 1024, swz = sb ^ (((sb >> 9) & 1) << 5); R = (st >> 1) * 16 + swz / 64; C = (st & 1) * 32 + (swz % 64) / 2; }
struct Unit { int pm, pn, z; };

DI bool order_xcd(int nM, int nN, int G, int c, int i, Unit& u) {
    const int nwg = nM * nN; const long L = (long)i * G + c; if (L >= nwg) return false;
    int wgid = (int)L; { const int q = nwg / NXCD, r = nwg % NXCD, xcd = wgid % NXCD, off = wgid / NXCD; wgid = (xcd < r ? xcd * (q + 1) : r * (q + 1) + (xcd - r) * q) + off; }
    const int nig = WGM * nN, gid = wgid / nig, fm = gid * WGM, gsz = (nM - fm) < WGM ? (nM - fm) : WGM;
    u.pm = fm + ((wgid % nig) % gsz); u.pn = (wgid % nig) / gsz; u.z = 0; return true;
}

template <class Epi, class Sched, bool HALFN = false>
DI void gemm_phase(LAS unsigned char* lds, const int K, const Sched& S, const Epi& E) {
    const int tid = TID(), wid = __builtin_amdgcn_readfirstlane(tid >> 6), lane = tid & 63, wr = wid >> 2, wc = wid & 3, fr = lane & 15, fq = lane >> 4;
    const int nt = K / BK;
    unsigned voffA[2];
#pragma unroll
    for (int i = 0; i < 2; ++i) { int R, C; stage_rc(tid * 16 + i * 8192, R, C); voffA[i] = (unsigned)(R * K + C) * 2u; }
    const size_t kstep = (size_t)(BK * 2);
    const size_t hstep = (size_t)HALF * K * 2;
    const unsigned ldsw = (unsigned)wid * 1024u;
    const int aoff = lds_byte(wr * 64 + fr, fq * 8), boff = lds_byte(wc * 32 + fr, fq * 8);
#define PG8_SA(b, h) (((b) * 2 + (h)) * HTB)
#define PG8_SB(b, h) ((4 + (b) * 2 + (h)) * HTB)
#define PG8_STAGE(bufoff, gbase) do { _Pragma("unroll") for (int _i = 0; _i < 2; ++_i) \
        __builtin_amdgcn_global_load_lds((const unsigned*)((const char*)(gbase) + voffA[_i]), (LAS unsigned*)(lds + (bufoff) + ldsw + _i * 8192), 16, 0, 0); } while (0)
#define PG8_LDA(dst, b, h) do { _Pragma("unroll") for (int m = 0; m < 4; ++m) _Pragma("unroll") for (int k = 0; k < 2; ++k) dst[m][k] = *(const LAS bf16x8*)(lds + PG8_SA(b, h) + aoff + m * 2048 + k * 1024); } while (0)
#define PG8_LDB(dst, b, h) do { _Pragma("unroll") for (int n = 0; n < 2; ++n) _Pragma("unroll") for (int k = 0; k < 2; ++k) dst[n][k] = *(const LAS bf16x8*)(lds + PG8_SB(b, h) + boff + n * 2048 + k * 1024); } while (0)
#define PG8_MMA(ai, bj, At, Bt) do { __builtin_amdgcn_s_setprio(1); _Pragma("unroll") for (int m = 0; m < 4; ++m) _Pragma("unroll") for (int n = 0; n < 2; ++n) _Pragma("unroll") for (int k = 0; k < 2; ++k) \
        acc[ai][bj][m][n] = __builtin_amdgcn_mfma_f32_16x16x32_bf16(Bt[n][k], At[m][k], acc[ai][bj][m][n], 0, 0, 0); __builtin_amdgcn_s_setprio(0); } while (0)
#define PG8_WAIT_V(n) asm volatile("s_waitcnt vmcnt(" #n ")" ::: "memory")
#define PG8_WAIT_L(n) asm volatile("s_waitcnt lgkmcnt(" #n ")" ::: "memory")
#define PG8_BAR __builtin_amdgcn_s_barrier()
#define PG8_SCHED __builtin_amdgcn_sched_barrier(0)
    Unit cur, nxt; int ui = 0;
    if (!S.next(0, cur)) return;
    f32x4 acc[2][2][4][2];
#pragma unroll
    for (int a = 0; a < 2; ++a)
#pragma unroll
        for (int b = 0; b < 2; ++b)
#pragma unroll
            for (int m = 0; m < 4; ++m)
#pragma unroll
                for (int n = 0; n < 2; ++n) acc[a][b][m][n] = (f32x4){0.f, 0.f, 0.f, 0.f};
    bf16x8 At[4][2], B0[2][2], B1[2][2];
    const char* cA = S.aptr(cur); const char* cB = S.bptr(cur);
    PG8_STAGE(PG8_SB(0, 0), cB); PG8_STAGE(PG8_SA(0, 0), cA); PG8_STAGE(PG8_SB(0, 1), cB + hstep); PG8_STAGE(PG8_SA(0, 1), cA + hstep);
    if (wr == 1) PG8_BAR;
    PG8_WAIT_V(4); PG8_BAR;
    PG8_STAGE(PG8_SB(1, 0), cB + kstep); PG8_STAGE(PG8_SA(1, 0), cA + kstep); PG8_STAGE(PG8_SB(1, 1), cB + hstep + kstep);
    PG8_WAIT_V(6); PG8_BAR;
    for (;;) {
        const bool has_next = S.next(ui + 1, nxt);
        const char* nA = has_next ? S.aptr(nxt) : cA; const char* nB = has_next ? S.bptr(nxt) : cB;
#pragma unroll 1
        for (int t = 0; t < nt; t += 2) {
            const bool last = (t == nt - 2);
            const char* a1 = cA + (size_t)(t + 1) * kstep;
            const char* a2 = last ? nA : cA + (size_t)(t + 2) * kstep; const char* b2 = last ? nB : cB + (size_t)(t + 2) * kstep;
            const char* a3 = a2 + kstep; const char* b3 = b2 + kstep;
            PG8_LDB(B0, 0, 0); PG8_SCHED; PG8_LDA(At, 0, 0); PG8_STAGE(PG8_SA(1, 1), a1 + hstep);
            PG8_WAIT_L(8); PG8_BAR; PG8_WAIT_L(0); PG8_MMA(0, 0, At, B0); PG8_BAR; PG8_SCHED;
            PG8_LDB(B1, 0, 1); PG8_STAGE(PG8_SB(0, 0), b2);
            PG8_BAR; PG8_WAIT_L(0); if (!HALFN) PG8_MMA(0, 1, At, B1); PG8_BAR;
            PG8_LDA(At, 0, 1); PG8_STAGE(PG8_SA(0, 0), a2);
            PG8_BAR; PG8_WAIT_L(0); PG8_MMA(1, 0, At, B0); PG8_BAR; PG8_SCHED;
            PG8_STAGE(PG8_SB(0, 1), b2 + hstep);
            PG8_WAIT_V(6); PG8_BAR; if (!HALFN) PG8_MMA(1, 1, At, B1); PG8_BAR;
            PG8_LDB(B0, 1, 0); PG8_SCHED; PG8_LDA(At, 1, 0); PG8_STAGE(PG8_SA(0, 1), a2 + hstep);
            PG8_WAIT_L(8); PG8_BAR; PG8_WAIT_L(0); PG8_MMA(0, 0, At, B0); PG8_BAR; PG8_SCHED;
            PG8_LDB(B1, 1, 1); PG8_STAGE(PG8_SB(1, 0), b3);
            PG8_BAR; PG8_WAIT_L(0); if (!HALFN) PG8_MMA(0, 1, At, B1); PG8_BAR;
            PG8_LDA(At, 1, 1); PG8_STAGE(PG8_SA(1, 0), a3);
            PG8_BAR; PG8_WAIT_L(0); PG8_MMA(1, 0, At, B0); PG8_BAR; PG8_SCHED;
            PG8_STAGE(PG8_SB(1, 1), b3 + hstep);
            PG8_WAIT_V(6); PG8_BAR; if (!HALFN) PG8_MMA(1, 1, At, B1); PG8_BAR;
        }
        { int tz = TID(); asm volatile("" : "+v"(tz));
          const int wz = __builtin_amdgcn_readfirstlane(tz >> 6), lz = tz & 63; E(acc, cur, wz >> 2, wz & 3, lz & 15, lz >> 4); }
        if (!has_next) break;
#pragma unroll
        for (int a = 0; a < 2; ++a)
#pragma unroll
            for (int b = 0; b < (HALFN ? 1 : 2); ++b)
#pragma unroll
                for (int m = 0; m < 4; ++m)
#pragma unroll
                    for (int n = 0; n < 2; ++n) acc[a][b][m][n] = (f32x4){0.f, 0.f, 0.f, 0.f};
        cur = nxt; cA = nA; cB = nB; ++ui;
    }
    PG8_WAIT_V(0);
    if (wr == 0) PG8_BAR;
    PG8_BAR;
#undef PG8_SA
#undef PG8_SB
#undef PG8_STAGE
#undef PG8_LDA
#undef PG8_LDB
#undef PG8_MMA
#undef PG8_WAIT_V
#undef PG8_WAIT_L
#undef PG8_BAR
#undef PG8_SCHED
}
}
using pg8::Unit;
typedef f32x4 AccT[2][2][4][2];

struct Params {
    const float* in[26];
    float* out;
    unsigned char* ws;
    int ph_lo, ph_hi;
};
enum { I_X = 0, I_WIN, I_NMIX, I_NFFN, I_QKN, I_REL, I_MU, I_W0, I_W2, I_A0, I_A2, I_G2, I_KK, I_KA, I_RK, I_LNW, I_LNB, I_V0, I_VA, I_VB, I_KVN, I_KVUP, I_WBR, I_WO, I_F1, I_F2 };

DI const Params* KP() { auto k = __builtin_amdgcn_kernarg_segment_ptr(); asm volatile("" : "+s"(k)); return (const Params*)k; }
template <class T> DI T* wsp(size_t off) { return (T*)(KP()->ws + off); }

DI int cmap_b(int x) { const int pi = x & 255; return (x & ~255) + 64 * ((pi >> 5) & 3) + 32 * (pi >> 7) + 8 * ((pi >> 2) & 3) + 4 * ((pi >> 4) & 1) + (pi & 3); }
DI int cmap_f(int x) { const int pi = x & 255; return (x & ~255) + 64 * ((pi >> 5) & 3) + 32 * (pi >> 7) + 16 * ((pi >> 4) & 1) + 4 * ((pi >> 2) & 3) + (pi & 3); }
DI int wide_col(int x) { return cmap_b(x); }
template <int MAP> DI int colmap(int r) {
    if (MAP == 0) {
        if (r < 512) return C_MK + wide_col(r);
        if (r < 768) return C_DS + 512 + wide_col(r - 512);
        const int a = wide_col(r - 768);
        if (a < 32) return C_DS + 1024 + a;
        if (a < 40) return C_DS + 1056 + (a - 32);
        if (a >= 64 && a < 96) return C_RW + 1792 + (a - 64);
        return -1;
    }
    if (MAP == 1) return C_MV + r;
    if (MAP == 2) {
        if (r < 512) return C_MQ + wide_col(r);
        if (r < 1024) return C_DS + wide_col(r - 512);
        if (r < 1280) return C_DS + 768 + wide_col(r - 1024);
        if (r < 3072) return C_RW + wide_col(r - 1280);
        return C_GT + wide_col(r - 3072);
    }
    if (MAP == 3) return wide_col(r);
    if (MAP == 4) return 512 + r;
    if (MAP == 5) return cmap_b(r);
    if (MAP == 7) return cmap_f(r);
    if (MAP == 6) { const int pn = r >> 8, pi = r & 255;
        return ((pi >> 7) ? DFF : 0) + 128 * pn + 32 * ((pi >> 5) & 3) + 8 * ((pi >> 2) & 3) + 4 * ((pi >> 4) & 1) + (pi & 3); }
    return -1;
}
template <int MAP> DI void conv_t(LAS float* sm, bf16_t* dst, int nrows, int K, const float* src, int ld) {
    const int tid = TID(), tx = tid & 63, ty = tid >> 6;
    const int ntr = nrows / 64, ntk = K / 64, ntiles = ntr * ntk;
    for (int t = BID(); t < ntiles; t += gridDim.x) {
        const int r0 = (t / ntk) * 64, k0 = (t % ntk) * 64;
        const int col = colmap<MAP>(r0 + tx);
#pragma unroll
        for (int i = 0; i < 8; ++i) { const int kl = ty + 8 * i; sm[kl * 65 + tx] = (col >= 0) ? src[(size_t)(k0 + kl) * ld + col] : 0.f; }
        __syncthreads();
#pragma unroll
        for (int i = 0; i < 8; ++i) { const int rl = ty + 8 * i; dst[(size_t)(r0 + rl) * K + k0 + tx] = f2bf(sm[tx * 65 + rl]); }
        __syncthreads();
    }
}
DI void conv_lora(int l) {
    bf16_t* dst = wsp<bf16_t>(WS_WL);
    const float* w2 = KP()->in[I_W2] + (size_t)l * 64 * 512; const float* a2 = KP()->in[I_A2] + (size_t)l * 64 * 512; const float* g2 = KP()->in[I_G2] + (size_t)l * 160 * 512;
    const float* va = KP()->in[I_VA]; const float* vb = KP()->in[I_VB];
    const int n = 2048 * 512;
    for (int e = BID() * 512 + TID(); e < n; e += gridDim.x * 512) {
        const int r = wide_col(e >> 9), k = e & 511; float v = 0.f;
        if (r < 1024) {
            const int ch = 128 * (r >> 8) + 32 * ((r >> 6) & 3) + (r & 31);
            if ((r >> 5) & 1) { if (k >= 64 && k < 128) v = a2[(k - 64) * 512 + ch]; } else { if (k < 64) v = w2[k * 512 + ch]; } }
        else if (r < 1536) { if (k >= 128 && k < 288) v = g2[(k - 128) * 512 + (r - 1024)]; }
        else if (l == 1) { const int c = r - 1536; float s = 0.f;
#pragma unroll 8
            for (int j = 0; j < 32; ++j) s += va[k * 32 + j] * vb[j * 512 + c];
            v = s; }
        dst[e] = f2bf(v);
    }
}
DI void phase_conv(int l, LAS float* sm) {
    const float* win = KP()->in[I_WIN] + (size_t)l * DM * D_IN;
    conv_t<0>(sm, wsp<bf16_t>(WS_WB), 1024, 1024, win, D_IN);
    conv_t<1>(sm, wsp<bf16_t>(WS_WV), 512, 1024, win, D_IN);
    conv_t<2>(sm, wsp<bf16_t>(WS_WD1), 6144, 1024, win, D_IN);
    const float* kvup = KP()->in[I_KVUP] + (size_t)l * 256 * 1024;
    conv_t<3>(sm, wsp<bf16_t>(WS_WKVK), 512, 256, kvup, 1024);
    conv_t<4>(sm, wsp<bf16_t>(WS_WKVV), 512, 256, kvup, 1024);
    for (int i = 0; i < 3; ++i) conv_t<5>(sm, wsp<bf16_t>(WS_WBR) + (size_t)i * 1024 * 512, 1024, 512, KP()->in[I_WBR] + ((size_t)l * 3 + i) * 512 * 1024, 1024);
    conv_t<7>(sm, wsp<bf16_t>(WS_WO), 1024, 1024, KP()->in[I_WO] + (size_t)l * 1024 * 1024, 1024);
    conv_t<6>(sm, wsp<bf16_t>(WS_WF1), 5632, 1024, KP()->in[I_F1] + (size_t)l * 1024 * 5632, 5632);
    conv_t<7>(sm, wsp<bf16_t>(WS_WF2), 1024, 2816, KP()->in[I_F2] + (size_t)l * 2816 * 1024, 1024);
    conv_lora(l);
}

DI void phase_norm(const float* x, const float* g, bf16_t* h) {
    const int lane = TID() & 63, gw = BID() * 8 + (TID() >> 6), nw = gridDim.x * 8;
    f32x4 gv[4];
#pragma unroll
    for (int i = 0; i < 4; ++i) gv[i] = ((const f32x4*)g)[lane + 64 * i];
    for (int row = gw; row < NT; row += nw) {
        const f32x4* xr = (const f32x4*)(x + (size_t)row * DM);
        f32x4 v[4]; float ss = 0.f;
#pragma unroll
        for (int i = 0; i < 4; ++i) { v[i] = xr[lane + 64 * i]; ss += v[i][0] * v[i][0] + v[i][1] * v[i][1] + v[i][2] * v[i][2] + v[i][3] * v[i][3]; }
        ss = wave_sum(ss);
        const float rs = __builtin_amdgcn_rsqf(ss * (1.f / DM) + NORM_EPS);
#pragma unroll
        for (int i = 0; i < 4; ++i) {
            u32x2 o; o[0] = pk2(v[i][0] * rs * gv[i][0], v[i][1] * rs * gv[i][1]); o[1] = pk2(v[i][2] * rs * gv[i][2], v[i][3] * rs * gv[i][3]);
            *(u32x2*)(h + (size_t)row * DM + 4 * (lane + 64 * i)) = o;
        }
    }
}

struct SchedLin {
    int nM, nN, G, c; unsigned aoff, boff, a2off; int rowbytes, amode, cbase, pn2;
    DI bool next(int i, Unit& u) const { return pg8::order_xcd(nM, nN, G, c, i, u); }
    DI const char* aptr(const Unit& u) const { const int row0 = amode ? ((u.pm >> 1) * SEQ + cbase + (u.pm & 1) * 256) : u.pm * 256; return (const char*)KP()->ws + ((u.pn >= pn2) ? a2off : aoff) + (size_t)row0 * rowbytes; }
    DI const char* bptr(const Unit& u) const { return (const char*)KP()->ws + boff + (size_t)u.pn * 256 * rowbytes; }
};
DI SchedLin mk_sched(int nM, int nN, size_t aoff, size_t boff, int K, int amode = 0, int cbase = 0, size_t a2off = 0, int pn2 = 1 << 30) {
    SchedLin s; s.nM = nM; s.nN = nN; s.G = gridDim.x; s.c = BID(); s.aoff = (unsigned)aoff; s.boff = (unsigned)boff; s.rowbytes = K * 2; s.amode = amode; s.cbase = cbase; s.a2off = (unsigned)a2off; s.pn2 = pn2; return s;
}
struct SchedMerge {
    int G, c;
    DI bool next(int i, Unit& u) const { const int z = i % 3, tile = (i / 3) * G + c; if (tile >= 256) return false; u.pm = tile >> 2; u.pn = tile & 3; u.z = z; return true; }
    DI const char* aptr(const Unit& u) const { return (const char*)KP()->ws + (u.z == 0 ? WS_MQ : (u.z == 1 ? WS_ORW : WS_DQ)) + (size_t)(u.pm >> 5) * PAR_O + (size_t)(u.pm & 31) * 256 * 1024; }
    DI const char* bptr(const Unit& u) const { return (const char*)KP()->ws + WS_WBR + (size_t)u.z * (1024 * 512 * 2) + (size_t)u.pn * 256 * 1024; }
};

DI void st_bf4(bf16_t* p, f32x4 v) { u32x2 o; o[0] = pk2(v[0], v[1]); o[1] = pk2(v[2], v[3]); *(u32x2*)p = o; }
DI f32x4 ld_bf4(const bf16_t* p) { const u32x2 u = *(const u32x2*)p; return (f32x4){bflo(u[0]), bfhi(u[0]), bflo(u[1]), bfhi(u[1])}; }
#define EPI_ROWS(ai, m) (128 * (ai) + 64 * wr + 16 * (m) + fr)
#define EPI_COLS(bj, n) (64 * wc + 32 * (bj) + 8 * fq + 4 * (n))
#define EPI_COLS_F(bj, n) (64 * wc + 32 * (bj) + 16 * (n) + 4 * fq)
#define EPI_COLS_T(bj, n) (128 * (bj) + 32 * wc + 16 * (n) + 4 * fq)
#define FOR_AM _Pragma("unroll") for (int ai = 0; ai < 2; ++ai) _Pragma("unroll") for (int m = 0; m < 4; ++m)
#define FOR_BN _Pragma("unroll") for (int bj = 0; bj < 2; ++bj) _Pragma("unroll") for (int n = 0; n < 2; ++n)

constexpr int XS_OFF = pg8::STAGE_BYTES + 256, XS_BYTES = 4096;
DI float row16_sum(float v) {
    v += __uint_as_float(__builtin_amdgcn_update_dpp(0, __float_as_uint(v), 0x128, 0xf, 0xf, false));
    v += __uint_as_float(__builtin_amdgcn_update_dpp(0, __float_as_uint(v), 0x124, 0xf, 0xf, false));
    v += __uint_as_float(__builtin_amdgcn_update_dpp(0, __float_as_uint(v), 0x122, 0xf, 0xf, false));
    v += __uint_as_float(__builtin_amdgcn_update_dpp(0, __float_as_uint(v), 0x121, 0xf, 0xf, false));
    return v;
}
template <bool KM = false>
DI void epi_headnorm(const AccT& acc, bf16_t* out, int ld, const float* gain, int wr, int wc, int fr, int fq, float gscale = 1.f, float* kmo = nullptr) {
    f32x4 gv[2][2], cs[2][2];
    FOR_BN { gv[bj][n] = *(const f32x4*)(gain + 32 * bj + 8 * fq + 4 * n) * gscale; cs[bj][n] = (f32x4){0.f, 0.f, 0.f, 0.f}; }
    FOR_AM {
        float ss = 0.f;
        FOR_BN { const f32x4 a = acc[ai][bj][m][n]; ss += a[0] * a[0] + a[1] * a[1] + a[2] * a[2] + a[3] * a[3]; }
        ss += __shfl_xor(ss, 16); ss += __shfl_xor(ss, 32);
        const float sc = __builtin_amdgcn_rsqf(ss * (1.f / 64.f) + NORM_EPS);
        bf16_t* rp = out + (size_t)EPI_ROWS(ai, m) * ld;
        FOR_BN { const f32x4 o = acc[ai][bj][m][n] * sc * gv[bj][n]; st_bf4(rp + EPI_COLS(bj, n), o); if (KM) cs[bj][n] += o; }
    }
    if (KM) {
        LAS float* xs = (LAS float*)(unsigned)XS_OFF;
        FOR_BN {
#pragma unroll
            for (int e = 0; e < 4; ++e) cs[bj][n][e] = row16_sum(cs[bj][n][e]);
        }
        if (wr == 0 && fr == 0) { FOR_BN *(LAS f32x4*)(xs + wc * 64 + 32 * bj + 8 * fq + 4 * n) = cs[bj][n]; }
        asm volatile("s_waitcnt lgkmcnt(0)" ::: "memory"); __builtin_amdgcn_s_barrier();
        if (wr == 1 && fr == 0) { FOR_BN { const f32x4 o = (cs[bj][n] + *(LAS const f32x4*)(xs + wc * 64 + 32 * bj + 8 * fq + 4 * n)) * (1.f / 256.f);
            *(f32x4*)(kmo + wc * 512 + 32 * bj + 8 * fq + 4 * n) = o; } }
    }
}
DI void epi_store_bf16(const AccT& acc, bf16_t* out, int ld, int wr, int wc, int fr, int fq) {
    FOR_AM { bf16_t* rp = out + (size_t)EPI_ROWS(ai, m) * ld; FOR_BN st_bf4(rp + EPI_COLS(bj, n), acc[ai][bj][m][n]); }
}

struct EpiB {
    int l;
    DI void operator()(const AccT& acc, const Unit& u, int wr, int wc, int fr, int fq) const {
        const size_t row0 = (size_t)u.pm * 256;
        if (u.pn < 2) epi_headnorm<true>(acc, wsp<bf16_t>(WS_MK) + row0 * 512 + u.pn * 256, 512, KP()->in[I_QKN] + l * 256 + 64, wr, wc, fr, fq, 1.f,
                                         wsp<float>(WS_KMEAN) + ((size_t)((u.pm >> 3) * 8 + u.pn * 4) * 8 + (u.pm & 7)) * 64);
        else if (u.pn == 2) {
            LAS float* xs = (LAS float*)(unsigned)XS_OFF;
            FOR_AM { float ss = 0.f;
                FOR_BN { const f32x4 a = acc[ai][bj][m][n]; ss += a[0] * a[0] + a[1] * a[1] + a[2] * a[2] + a[3] * a[3]; }
                ss += __shfl_xor(ss, 16); ss += __shfl_xor(ss, 32);
                if (fq == 0) xs[EPI_ROWS(ai, m) * 4 + wc] = ss; }
            asm volatile("s_waitcnt lgkmcnt(0)" ::: "memory"); __builtin_amdgcn_s_barrier();
            f32x4 gv[2][2];
            FOR_BN gv[bj][n] = *(const f32x4*)(KP()->in[I_KVN] + l * 256 + EPI_COLS(bj, n));
            bf16_t* out = wsp<bf16_t>(WS_DCN) + row0 * 256;
            FOR_AM { const f32x4 p = *(LAS const f32x4*)(xs + EPI_ROWS(ai, m) * 4);
                const float rs = __builtin_amdgcn_rsqf((p[0] + p[1] + p[2] + p[3]) * (1.f / 256.f) + NORM_EPS);
                bf16_t* rp = out + (size_t)EPI_ROWS(ai, m) * 256;
                FOR_BN st_bf4(rp + EPI_COLS(bj, n), acc[ai][bj][m][n] * rs * gv[bj][n]); }
        } else {
            bf16_t* idxk = wsp<bf16_t>(WS_IDXK); float* idxw = wsp<float>(WS_IDXW); bf16_t* left = wsp<bf16_t>(WS_LEFT);
            FOR_AM { const size_t row = row0 + EPI_ROWS(ai, m);
                if (wc == 0) {
#pragma unroll
                    for (int n = 0; n < 2; ++n) st_bf4(idxk + row * 32 + 8 * fq + 4 * n, acc[ai][0][m][n]);
                    if (fq == 0) { *(f32x4*)(idxw + row * 8) = acc[ai][1][m][0]; *(f32x4*)(idxw + row * 8 + 4) = acc[ai][1][m][1]; }
                } else if (wc == 1) {
#pragma unroll
                    for (int n = 0; n < 2; ++n) st_bf4(left + row * 32 + 8 * fq + 4 * n, acc[ai][0][m][n]);
                }
            }
        }
    }
};
struct EpiVt {
    unsigned off;
    DI void operator()(const AccT& acc, const Unit& u, int wr, int wc, int fr, int fq) const {
        bf16_t* vt = wsp<bf16_t>(off);
        const int b = u.pn >> 3, s0 = (u.pn & 7) * 256;
        FOR_AM { bf16_t* rp = vt + ((size_t)b * 512 + u.pm * 256 + EPI_ROWS(ai, m)) * SEQ + s0; FOR_BN st_bf4(rp + EPI_COLS_T(bj, n), acc[ai][bj][m][n]); }
    }
};
struct EpiHN {
    int l;
    DI void operator()(const AccT& acc, const Unit& u, int wr, int wc, int fr, int fq) const { epi_headnorm(acc, wsp<bf16_t>(WS_DK) + (size_t)u.pm * 256 * 512 + u.pn * 256, 512, KP()->in[I_QKN] + l * 256 + 192, wr, wc, fr, fq); }
};
struct EpiD1 {
    int l, par;
    DI void operator()(const AccT& acc, const Unit& u, int wr, int wc, int fr, int fq) const {
        const size_t row0 = (size_t)u.pm * 256;
        if (u.pn < 2) epi_headnorm(acc, wsp<bf16_t>(WS_MQ + par * PAR_O) + row0 * 512 + u.pn * 256, 512, KP()->in[I_QKN] + l * 256, wr, wc, fr, fq, QSCALE);
        else if (u.pn < 4) epi_headnorm(acc, wsp<bf16_t>(WS_DQ + par * PAR_O) + row0 * 512 + (u.pn - 2) * 256, 512, KP()->in[I_QKN] + l * 256 + 128, wr, wc, fr, fq, QSCALE);
        else if (u.pn == 4) epi_store_bf16(acc, wsp<bf16_t>(WS_IDXQ) + row0 * 256, 256, wr, wc, fr, fq);
        else if (u.pn < 12) epi_store_bf16(acc, wsp<bf16_t>(WS_RAW) + row0 * RAWLD + (u.pn - 5) * 256, RAWLD, wr, wc, fr, fq);
        else {
            unsigned char* o = wsp<unsigned char>(WS_GATES + par * PAR_G) + row0 * 3072 + (u.pn - 12) * 256;
            FOR_AM { unsigned char* rp = o + (size_t)EPI_ROWS(ai, m) * 3072;
                FOR_BN { const f32x4 a = acc[ai][bj][m][n];
                    const unsigned q0 = (unsigned)(fsigmoid(a[0]) * 255.f + 0.5f), q1 = (unsigned)(fsigmoid(a[1]) * 255.f + 0.5f), q2 = (unsigned)(fsigmoid(a[2]) * 255.f + 0.5f), q3 = (unsigned)(fsigmoid(a[3]) * 255.f + 0.5f);
                    *(unsigned*)(rp + EPI_COLS(bj, n)) = q0 | (q1 << 8) | (q2 << 16) | (q3 << 24); } }
        }
    }
};
struct EpiLora {
    int l, cbase;
    DI void operator()(const AccT& acc, const Unit& u, int wr, int wc, int fr, int fq) const {
        const size_t row0 = (size_t)u.pm * 256; const int kind = u.pn >> 1, cb = (u.pn & 1) * 256;
        if (u.pn < 4) {
            const int chb = 128 * u.pn + 32 * wc + 8 * fq;
            f32x4 w0v[2], a0v[2], kav[2];
#pragma unroll
            for (int n = 0; n < 2; ++n) { w0v[n] = *(const f32x4*)(KP()->in[I_W0] + l * 512 + chb + 4 * n); a0v[n] = *(const f32x4*)(KP()->in[I_A0] + l * 512 + chb + 4 * n); kav[n] = *(const f32x4*)(KP()->in[I_KA] + l * 512 + chb + 4 * n); }
            FOR_AM { const size_t row = row0 + EPI_ROWS(ai, m); const size_t o = row * 512 + chb;
                const u32x4 kku = *(const u32x4*)(wsp<bf16_t>(WS_KKB) + o), kpu = *(const u32x4*)(wsp<bf16_t>(WS_KF) + o), ru = *(const u32x4*)(wsp<bf16_t>(WS_RR) + o);
                u32x4 okf, okt, obt, okq, ort, okh, obh; f32x4 pv[2];
#pragma unroll
                for (int n = 0; n < 2; ++n) {
                    float kfv[4], ktv[4], btv[4], kqv[4], rtv[4], khv[4], bhv[4];
#pragma unroll
                    for (int e = 0; e < 4; ++e) { const int j = 4 * n + e;
                        const float kk = (j & 1) ? bfhi(kku[j >> 1]) : bflo(kku[j >> 1]), kp = (j & 1) ? bfhi(kpu[j >> 1]) : bflo(kpu[j >> 1]), r = (j & 1) ? bfhi(ru[j >> 1]) : bflo(ru[j >> 1]);
                        const float x = -(w0v[n][e] + acc[ai][0][m][n][e]);
                        const float sp = fmaxf(x, 0.f) + __builtin_amdgcn_logf(1.f + fexp2(-fabsf(x) * LOG2E)) * 0.6931471805599453f;
                        float p = fexp2(-fexp2((-sp - 0.5f) * LOG2E) * LOG2E);
                        p *= dpp_shr1(p, 1.f); p *= dpp_shr2(p, 1.f); p *= dpp_shr4(p, 1.f); p *= dpp_shr8(p, 1.f);
                        const float pm1 = dpp_shr1(p, 1.f), inv = frcp(p), p16 = dpp_bcast15(p);
                        const float s = fsigmoid(a0v[n][e] + acc[ai][1][m][n][e]);
                        const float kf_ = kp * (1.f + (s - 1.f) * kav[n][e]), bb = kk * s;
                        kfv[e] = kf_; ktv[e] = kk * pm1; btv[e] = bb * inv; kqv[e] = kf_ * inv; rtv[e] = r * p; khv[e] = kqv[e] * p16; bhv[e] = btv[e] * p16; pv[n][e] = p16; }
                    okf[2 * n] = pk2(kfv[0], kfv[1]); okf[2 * n + 1] = pk2(kfv[2], kfv[3]); okt[2 * n] = pk2(ktv[0], ktv[1]); okt[2 * n + 1] = pk2(ktv[2], ktv[3]);
                    obt[2 * n] = pk2(btv[0], btv[1]); obt[2 * n + 1] = pk2(btv[2], btv[3]); okq[2 * n] = pk2(kqv[0], kqv[1]); okq[2 * n + 1] = pk2(kqv[2], kqv[3]);
                    ort[2 * n] = pk2(rtv[0], rtv[1]); ort[2 * n + 1] = pk2(rtv[2], rtv[3]); okh[2 * n] = pk2(khv[0], khv[1]); okh[2 * n + 1] = pk2(khv[2], khv[3]);
                    obh[2 * n] = pk2(bhv[0], bhv[1]); obh[2 * n + 1] = pk2(bhv[2], bhv[3]);
                }
                *(u32x4*)(wsp<bf16_t>(WS_KF) + o) = okf; *(u32x4*)(wsp<bf16_t>(WS_KT) + o) = okt; *(u32x4*)(wsp<bf16_t>(WS_BT) + o) = obt; *(u32x4*)(wsp<bf16_t>(WS_KQ) + o) = okq;
                *(u32x4*)(wsp<bf16_t>(WS_RT) + o) = ort; *(u32x4*)(wsp<bf16_t>(WS_KH) + o) = okh; *(u32x4*)(wsp<bf16_t>(WS_BH) + o) = obh;
                if (fr == 15) { float* pp = wsp<float>(WS_P16) + (row >> 4) * 512 + chb; *(f32x4*)pp = pv[0]; *(f32x4*)(pp + 4) = pv[1]; }
            }
        } else if (kind == 2) {
            epi_store_bf16(acc, wsp<bf16_t>(WS_GG) + row0 * 512 + cb, 512, wr, wc, fr, fq);
        } else {
            const bf16_t* vv = wsp<bf16_t>(WS_VV); bf16_t* v2 = wsp<bf16_t>(WS_V2); const bf16_t* vfirst = wsp<bf16_t>(WS_VFIRST); const float* v0 = KP()->in[I_V0];
            FOR_AM { const size_t row = row0 + EPI_ROWS(ai, m); const size_t arow = (size_t)(row >> 9) * SEQ + cbase + (row & 511);
                f32x4 vp[2][2], vf[2][2];
                FOR_BN { const int col = cb + EPI_COLS(bj, n); vp[bj][n] = ld_bf4(vv + row * 512 + col); vf[bj][n] = ld_bf4(vfirst + arow * 512 + col); }
                FOR_BN { const int col = cb + EPI_COLS(bj, n); const f32x4 a = acc[ai][bj][m][n]; const f32x4 v0v = *(const f32x4*)(v0 + col); f32x4 o;
#pragma unroll
                    for (int e = 0; e < 4; ++e) o[e] = vp[bj][n][e] + (vf[bj][n][e] - vp[bj][n][e]) * fsigmoid(v0v[e] + a[e]);
                    st_bf4(v2 + row * 512 + col, o); } }
        }
    }
};
struct EpiMerge {
    DI void operator()(const AccT& acc, const Unit& u, int wr, int wc, int fr, int fq) const {
        bf16_t* y = wsp<bf16_t>(WS_Y); const unsigned char* gates = wsp<unsigned char>(WS_GATES + (size_t)(u.pm >> 5) * PAR_G);
        const size_t row0 = (size_t)u.pm * 256, grow0 = (size_t)(u.pm & 31) * 256; const int c0 = u.pn * 256 + 64 * wc + 8 * fq, z = u.z;
#pragma unroll
        for (int ai = 0; ai < 2; ++ai) {
            u32x2 g[4][2]; u32x4 yv[4][2];
#pragma unroll
            for (int m = 0; m < 4; ++m) { const int rt = EPI_ROWS(ai, m);
#pragma unroll
                for (int bj = 0; bj < 2; ++bj) { g[m][bj] = *(const u32x2*)(gates + (grow0 + rt) * 3072 + z * 1024 + c0 + 32 * bj);
                    if (z > 0) yv[m][bj] = *(const u32x4*)(y + (row0 + rt) * 1024 + c0 + 32 * bj); } }
#pragma unroll
            for (int m = 0; m < 4; ++m) { const size_t row = row0 + EPI_ROWS(ai, m);
#pragma unroll
                for (int bj = 0; bj < 2; ++bj) { u32x4 o;
#pragma unroll
                    for (int n = 0; n < 2; ++n) { const unsigned gu = g[m][bj][n];
                        const f32x4 gf = (f32x4){(float)(gu & 255u), (float)((gu >> 8) & 255u), (float)((gu >> 16) & 255u), (float)(gu >> 24)} * (1.f / 255.f);
                        f32x4 v = acc[ai][bj][m][n] * gf;
                        if (z > 0) { const unsigned ya = yv[m][bj][2 * n], yb = yv[m][bj][2 * n + 1]; v += (f32x4){bflo(ya), bfhi(ya), bflo(yb), bfhi(yb)}; }
                        o[2 * n] = pk2(v[0], v[1]); o[2 * n + 1] = pk2(v[2], v[3]); }
                    *(u32x4*)(y + row * 1024 + c0 + 32 * bj) = o; } }
        }
    }
};
struct EpiRes {
    int first, amode, cbase; unsigned dummy_off;
    DI void operator()(const AccT& acc, const Unit& u, int wr, int wc, int fr, int fq) const {
        float* out = KP()->out; const float* res = first ? KP()->in[I_X] : (const float*)out;
        if (dummy_off) out = wsp<float>(dummy_off);
        const size_t grow0 = amode == 2 ? ((size_t)((u.pm & 31) >> 1) * SEQ + cbase + (u.pm >> 5) * SC + (u.pm & 1) * 256) : (amode ? ((size_t)(u.pm >> 1) * SEQ + cbase + (u.pm & 1) * 256) : (size_t)u.pm * 256); const int c0 = u.pn * 256;
#pragma unroll
        for (int ai = 0; ai < 2; ++ai) {
            f32x4 rv[4][2][2];
#pragma unroll
            for (int m = 0; m < 4; ++m) { const size_t row = grow0 + EPI_ROWS(ai, m); FOR_BN rv[m][bj][n] = *(const f32x4*)(res + row * DM + c0 + EPI_COLS_F(bj, n)); }
#pragma unroll
            for (int m = 0; m < 4; ++m) { const size_t row = grow0 + EPI_ROWS(ai, m); FOR_BN *(f32x4*)(out + row * DM + c0 + EPI_COLS_F(bj, n)) = rv[m][bj][n] + acc[ai][bj][m][n]; }
        }
    }
};
struct EpiNull { DI void operator()(const AccT& acc, const Unit& u, int wr, int wc, int fr, int fq) const { f32x4 s = {0.f, 0.f, 0.f, 0.f}; FOR_AM { FOR_BN s += acc[ai][bj][m][n]; } if (s[0] + s[1] + s[2] + s[3] == 12345.678f) *wsp<float>(WS_OUT) = 1.f; } };
struct EpiSwiglu {
    DI void operator()(const AccT& acc, const Unit& u, int wr, int wc, int fr, int fq) const {
        bf16_t* act = wsp<bf16_t>(WS_ACT);
        FOR_AM { bf16_t* rp = act + ((size_t)u.pm * 256 + EPI_ROWS(ai, m)) * DFF + u.pn * 128 + 32 * wc + 8 * fq;
            u32x4 w;
#pragma unroll
            for (int n = 0; n < 2; ++n) { const f32x4 g = acc[ai][0][m][n], up = acc[ai][1][m][n]; f32x4 o;
#pragma unroll
                for (int e = 0; e < 4; ++e) o[e] = g[e] * fsigmoid(g[e]) * up[e];
                w[2 * n] = pk2(o[0], o[1]); w[2 * n + 1] = pk2(o[2], o[3]); }
            *(u32x4*)rp = w; }
    }
};

DI void phase_dcn(int l) {
    const int lane = TID() & 63, gw = BID() * 8 + (TID() >> 6), nw = gridDim.x * 8;
    bf16_t* dcn = wsp<bf16_t>(WS_DCN);
    const f32x4 g = *(const f32x4*)(KP()->in[I_KVN] + l * 256 + 4 * lane);
    for (int row = gw; row < NT; row += nw) {
        bf16_t* rp = dcn + (size_t)row * 256 + 4 * lane;
        const f32x4 v = ld_bf4(rp);
        const float ss = wave_sum(v[0] * v[0] + v[1] * v[1] + v[2] * v[2] + v[3] * v[3]);
        const float rs = __builtin_amdgcn_rsqf(ss * (1.f / 256.f) + NORM_EPS);
        st_bf4(rp, v * rs * g);
    }
}
DI void phase_kmean() {
    const int lane = TID() & 63, gw = BID() * 8 + (TID() >> 6), nw = gridDim.x * 8;
    const bf16_t* mk = wsp<bf16_t>(WS_MK); float* km = wsp<float>(WS_KMEAN);
    for (int it = gw; it < NB * NH * 8; it += nw) {
        const int n = it & 7, h = (it >> 3) & 7, b = it >> 6;
        const bf16_t* kp = mk + ((size_t)b * SEQ + n * 256 + (lane >> 3)) * 512 + h * 64 + 8 * (lane & 7);
        float s[8] = {0.f, 0.f, 0.f, 0.f, 0.f, 0.f, 0.f, 0.f};
#pragma unroll 8
        for (int k = 0; k < 256; k += 8) { const u32x4 u = *(const u32x4*)(kp + (size_t)k * 512);
#pragma unroll
            for (int q = 0; q < 4; ++q) { s[2 * q] += bflo(u[q]); s[2 * q + 1] += bfhi(u[q]); } }
#pragma unroll
        for (int e = 0; e < 8; ++e) {
            float v = s[e];
            v += __uint_as_float(__builtin_amdgcn_update_dpp(0, __float_as_uint(v), 0x128, 0xf, 0xf, false));
            auto r = __builtin_amdgcn_permlane16_swap(__float_as_uint(v), __float_as_uint(v), false, false); v = __uint_as_float(r[0]) + __uint_as_float(r[1]);
            r = __builtin_amdgcn_permlane32_swap(__float_as_uint(v), __float_as_uint(v), false, false); s[e] = (__uint_as_float(r[0]) + __uint_as_float(r[1])) * (1.f / 256.f);
        }
        if (lane < 8) { float* o = km + (size_t)it * 64 + 8 * lane; *(f32x4*)o = (f32x4){s[0], s[1], s[2], s[3]}; *(f32x4*)(o + 4) = (f32x4){s[4], s[5], s[6], s[7]}; }
    }
}

DI void phase_rwkv_prep(int l, int c) {
    const int lane = TID() & 63, gw = BID() * 8 + (TID() >> 6), nw = gridDim.x * 8;
    const bf16_t* raw = wsp<bf16_t>(WS_RAW); const bf16_t* left = wsp<bf16_t>(WS_LEFT); bf16_t* carry = wsp<bf16_t>(WS_CARRY);
    bf16_t* rr = wsp<bf16_t>(WS_RR); bf16_t* kf = wsp<bf16_t>(WS_KF); bf16_t* vv = wsp<bf16_t>(WS_VV); bf16_t* kkb = wsp<bf16_t>(WS_KKB);
    bf16_t* la = wsp<bf16_t>(WS_LORAA); bf16_t* vfirst = wsp<bf16_t>(WS_VFIRST);
    const float* mu = KP()->in[I_MU] + l * 1824; const float* kkw = KP()->in[I_KK] + l * 512;
    for (int rc = gw; rc < TC; rc += nw) {
        const int b = rc >> 9, sl = rc & 511, s = c * SC + sl; const size_t ra = (size_t)b * SEQ + s;
        const bf16_t* cur = raw + (size_t)rc * RAWLD;
        const bf16_t* prv = (sl > 0) ? (cur - RAWLD) : (carry + (size_t)((((c + 1) & 1) * 16) + b) * RAWLD);
        const bool hp = s > 0;
        auto mix8 = [&](int j, float* o) {
            const u32x4 cu = *(const u32x4*)(cur + j); u32x4 pu = {0u, 0u, 0u, 0u}; if (hp) pu = *(const u32x4*)(prv + j);
            const f32x4 m0 = *(const f32x4*)(mu + j), m1 = *(const f32x4*)(mu + j + 4);
#pragma unroll
            for (int e = 0; e < 4; ++e) { const float c0 = bflo(cu[e]), c1 = bfhi(cu[e]), p0 = bflo(pu[e]), p1 = bfhi(pu[e]);
                const float ma = (2 * e < 4) ? m0[2 * e] : m1[2 * e - 4], mb = (2 * e + 1 < 4) ? m0[2 * e + 1] : m1[2 * e + 1 - 4];
                o[2 * e] = c0 + (p0 - c0) * ma; o[2 * e + 1] = c1 + (p1 - c1) * mb; }
        };
        float o[8];
        mix8(8 * lane, o);
        { u32x4 w; w[0] = pk2(o[0], o[1]); w[1] = pk2(o[2], o[3]); w[2] = pk2(o[4], o[5]); w[3] = pk2(o[6], o[7]); *(u32x4*)(rr + (size_t)rc * 512 + 8 * lane) = w; }
        mix8(576 + 8 * lane, o);
        { u32x4 w; w[0] = pk2(o[0], o[1]); w[1] = pk2(o[2], o[3]); w[2] = pk2(o[4], o[5]); w[3] = pk2(o[6], o[7]); *(u32x4*)(kf + (size_t)rc * 512 + 8 * lane) = w;
          const f32x4 k0 = *(const f32x4*)(kkw + 8 * lane), k1 = *(const f32x4*)(kkw + 8 * lane + 4);
          float q[8]; float ss = 0.f;
#pragma unroll
          for (int e = 0; e < 8; ++e) { q[e] = o[e] * (e < 4 ? k0[e] : k1[e - 4]); ss += q[e] * q[e]; }
          ss += __shfl_xor(ss, 1); ss += __shfl_xor(ss, 2); ss += __shfl_xor(ss, 4);
          const float inv = 1.f / fmaxf(sqrtf(ss), 1e-12f);
          w[0] = pk2(q[0] * inv, q[1] * inv); w[1] = pk2(q[2] * inv, q[3] * inv); w[2] = pk2(q[4] * inv, q[5] * inv); w[3] = pk2(q[6] * inv, q[7] * inv);
          *(u32x4*)(kkb + (size_t)rc * 512 + 8 * lane) = w; }
        mix8(1088 + 8 * lane, o);
        { u32x4 w; w[0] = pk2(o[0], o[1]); w[1] = pk2(o[2], o[3]); w[2] = pk2(o[4], o[5]); w[3] = pk2(o[6], o[7]); *(u32x4*)(vv + (size_t)rc * 512 + 8 * lane) = w;
          if (l == 0) *(u32x4*)(vfirst + ra * 512 + 8 * lane) = w; }
        { bf16_t* lr = la + (size_t)rc * 512;
          const bf16_t* cs = cur; const bf16_t* ps_ = prv; int sc = 512 + 8 * lane, dc = 8 * lane, fn = 0; const float* mup = mu;
          if (lane >= 8) { sc = 1600 + 8 * (lane - 8); dc = 64 + 8 * (lane - 8); fn = 1; }
          if (lane >= 16) { sc = 1664 + 8 * (lane - 16); dc = 128 + 8 * (lane - 16); fn = 2; }
          if (lane >= 32) { cs = left + ra * 32; ps_ = left + (ra - 1) * 32; sc = 8 * (lane - 32); dc = 256 + 8 * (lane - 32); mup = mu + 1792; }
          u32x4 w = {0u, 0u, 0u, 0u};
          if (lane < 36) {
              const u32x4 cu = *(const u32x4*)(cs + sc); u32x4 pu = {0u, 0u, 0u, 0u}; if (hp) pu = *(const u32x4*)(ps_ + sc);
              const f32x4 m0 = *(const f32x4*)(mup + sc), m1 = *(const f32x4*)(mup + sc + 4);
              float x[8];
#pragma unroll
              for (int e = 0; e < 4; ++e) { const float c0 = bflo(cu[e]), c1 = bfhi(cu[e]), p0 = bflo(pu[e]), p1 = bfhi(pu[e]);
                  const float ma = (2 * e < 4) ? m0[2 * e] : m1[2 * e - 4], mb = (2 * e + 1 < 4) ? m0[2 * e + 1] : m1[2 * e + 1 - 4];
                  x[2 * e] = c0 + (p0 - c0) * ma; x[2 * e + 1] = c1 + (p1 - c1) * mb; }
#pragma unroll
              for (int e = 0; e < 8; ++e) { const float th = 1.f - 2.f * frcp(fexp2(2.f * x[e] * LOG2E) + 1.f), sg = fsigmoid(x[e]); x[e] = fn == 0 ? th : (fn == 1 ? x[e] : sg); }
              w[0] = pk2(x[0], x[1]); w[1] = pk2(x[2], x[3]); w[2] = pk2(x[4], x[5]); w[3] = pk2(x[6], x[7]);
          } else dc = 288 + 8 * (lane - 36);
          *(u32x4*)(lr + dc) = w; }
        if (sl == SC - 1) { bf16_t* cp = carry + (size_t)(((c & 1) * 16) + b) * RAWLD;
            for (int j = lane; j < RAWLD / 8; j += 64) *(u32x4*)(cp + 8 * j) = *(const u32x4*)(cur + 8 * j); }
    }
}

DI float dpp_ror_add(float x, int) { return x; }
DI void reduce4(float p0, float p1, float p2, float p3, float& s0, float& s1, float& s2, float& s3) {
    auto r = __builtin_amdgcn_permlane32_swap(__float_as_uint(p0), __float_as_uint(p2), false, false);
    const float u0 = __uint_as_float(r[0]) + __uint_as_float(r[1]);
    r = __builtin_amdgcn_permlane32_swap(__float_as_uint(p1), __float_as_uint(p3), false, false);
    const float u1 = __uint_as_float(r[0]) + __uint_as_float(r[1]);
    r = __builtin_amdgcn_permlane16_swap(__float_as_uint(u0), __float_as_uint(u1), false, false);
    float w = __uint_as_float(r[0]) + __uint_as_float(r[1]);
    w += __uint_as_float(__builtin_amdgcn_update_dpp(0, __float_as_uint(w), 0x128, 0xf, 0xf, false));
    w += __uint_as_float(__builtin_amdgcn_update_dpp(0, __float_as_uint(w), 0x124, 0xf, 0xf, false));
    w += __uint_as_float(__builtin_amdgcn_update_dpp(0, __float_as_uint(w), 0x122, 0xf, 0xf, false));
    w += __uint_as_float(__builtin_amdgcn_update_dpp(0, __float_as_uint(w), 0x121, 0xf, 0xf, false));
    s0 = __uint_as_float(__builtin_amdgcn_readlane(__float_as_uint(w), 0));
    s1 = __uint_as_float(__builtin_amdgcn_readlane(__float_as_uint(w), 16));
    s2 = __uint_as_float(__builtin_amdgcn_readlane(__float_as_uint(w), 32));
    s3 = __uint_as_float(__builtin_amdgcn_readlane(__float_as_uint(w), 48));
}
DI void reduce8(float p0, float p1, float p2, float p3, float q0, float q1, float q2, float q3, float& pw, float& s0, float& s1, float& s2, float& s3) {
    auto r = __builtin_amdgcn_permlane32_swap(__float_as_uint(p0), __float_as_uint(p2), false, false);
    auto t = __builtin_amdgcn_permlane32_swap(__float_as_uint(q0), __float_as_uint(q2), false, false);
    const float u0 = __uint_as_float(r[0]) + __uint_as_float(r[1]);
    const float x0 = __uint_as_float(t[0]) + __uint_as_float(t[1]);
    r = __builtin_amdgcn_permlane32_swap(__float_as_uint(p1), __float_as_uint(p3), false, false);
    t = __builtin_amdgcn_permlane32_swap(__float_as_uint(q1), __float_as_uint(q3), false, false);
    const float u1 = __uint_as_float(r[0]) + __uint_as_float(r[1]);
    const float x1 = __uint_as_float(t[0]) + __uint_as_float(t[1]);
    r = __builtin_amdgcn_permlane16_swap(__float_as_uint(u0), __float_as_uint(u1), false, false);
    t = __builtin_amdgcn_permlane16_swap(__float_as_uint(x0), __float_as_uint(x1), false, false);
    float w = __uint_as_float(r[0]) + __uint_as_float(r[1]);
    float y = __uint_as_float(t[0]) + __uint_as_float(t[1]);
    w += __uint_as_float(__builtin_amdgcn_update_dpp(0, __float_as_uint(w), 0x128, 0xf, 0xf, false));
    y += __uint_as_float(__builtin_amdgcn_update_dpp(0, __float_as_uint(y), 0x128, 0xf, 0xf, false));
    w += __uint_as_float(__builtin_amdgcn_update_dpp(0, __float_as_uint(w), 0x124, 0xf, 0xf, false));
    y += __uint_as_float(__builtin_amdgcn_update_dpp(0, __float_as_uint(y), 0x124, 0xf, 0xf, false));
    w += __uint_as_float(__builtin_amdgcn_update_dpp(0, __float_as_uint(w), 0x122, 0xf, 0xf, false));
    y += __uint_as_float(__builtin_amdgcn_update_dpp(0, __float_as_uint(y), 0x122, 0xf, 0xf, false));
    w += __uint_as_float(__builtin_amdgcn_update_dpp(0, __float_as_uint(w), 0x121, 0xf, 0xf, false));
    y += __uint_as_float(__builtin_amdgcn_update_dpp(0, __float_as_uint(y), 0x121, 0xf, 0xf, false));
    pw = w;
    s0 = __uint_as_float(__builtin_amdgcn_readlane(__float_as_uint(y), 0));
    s1 = __uint_as_float(__builtin_amdgcn_readlane(__float_as_uint(y), 16));
    s2 = __uint_as_float(__builtin_amdgcn_readlane(__float_as_uint(y), 32));
    s3 = __uint_as_float(__builtin_amdgcn_readlane(__float_as_uint(y), 48));
}
struct ScanIn { bf16_t kk, bb, k, r, v; float w; };
DI void phase_scan(int l, int c, int dummy = 0) {
    const int lane = TID() & 63, gw = BID() * 8 + (TID() >> 6), nw = gridDim.x * 8;
    const bf16_t* kkb = wsp<bf16_t>(WS_KKB); const bf16_t* bbb = wsp<bf16_t>(WS_BBB); const bf16_t* kfb = wsp<bf16_t>(WS_KF); const bf16_t* rrb = wsp<bf16_t>(WS_RR);
    const bf16_t* vsb = wsp<bf16_t>(l == 0 ? WS_VV : WS_V2); const float* dec = wsp<float>(WS_DEC); float* outb = wsp<float>(WS_OUT); float* state = wsp<float>(WS_STATE);
    for (int item = gw; item < NB * NH * 16; item += nw) {
        const int bh = item >> 4, rg = item & 15, b = bh >> 3, h = bh & 7, i0 = rg * 4;
        float* stp = state + ((size_t)bh * 64 + i0) * 64 + lane;
        float S0 = 0.f, S1 = 0.f, S2 = 0.f, S3 = 0.f;
        if (c > 0) { S0 = stp[0]; S1 = stp[64]; S2 = stp[128]; S3 = stp[192]; }
        const size_t e0 = (size_t)b * SC * 512 + h * 64 + lane;
        const size_t ev = (size_t)b * SC * 512 + h * 64 + i0 + (lane & 3);
        float* op = outb + (size_t)b * SC * 512 + h * 64 + i0 + (lane >> 4);
        ScanIn A[8], B[8];
#define SCAN_LOAD(X, g) do { _Pragma("unroll") for (int j = 0; j < 8; ++j) { const size_t o = (size_t)((g) * 8 + j) * 512; \
            X[j].kk = kkb[e0 + o]; X[j].bb = bbb[e0 + o]; X[j].k = kfb[e0 + o]; X[j].r = rrb[e0 + o]; X[j].w = dec[e0 + o]; X[j].v = vsb[ev + o]; } } while (0)
#define SCAN_STEP1(Xj, kknext, t) do { \
            const float bb = bf2f(Xj.bb), kx = bf2f(Xj.k), rx = bf2f(Xj.r), wx = Xj.w; const unsigned vu = (unsigned)Xj.v << 16; \
            const float v0 = __uint_as_float(__builtin_amdgcn_readlane(vu, 0)), v1 = __uint_as_float(__builtin_amdgcn_readlane(vu, 1)), v2 = __uint_as_float(__builtin_amdgcn_readlane(vu, 2)), v3 = __uint_as_float(__builtin_amdgcn_readlane(vu, 3)); \
            S0 = S0 * wx + (v0 * kx - a0 * bb); S1 = S1 * wx + (v1 * kx - a1 * bb); S2 = S2 * wx + (v2 * kx - a2 * bb); S3 = S3 * wx + (v3 * kx - a3 * bb); \
            float ov; const float kn = (kknext); \
            reduce8(S0 * rx, S1 * rx, S2 * rx, S3 * rx, S0 * kn, S1 * kn, S2 * kn, S3 * kn, ov, a0, a1, a2, a3); \
            if ((lane & 15) == 0) op[(size_t)(t) * 512] = ov; } while (0)
#define SCAN_GROUP(X, Y, g, lastg) do { _Pragma("unroll") for (int j = 0; j < 8; ++j) { \
            const float kkn = (j < 7) ? bf2f(X[j < 7 ? j + 1 : 7].kk) : ((lastg) ? 0.f : bf2f(Y[0].kk)); \
            SCAN_STEP1(X[j], kkn, (g) * 8 + j); } } while (0)
        SCAN_LOAD(A, 0);
        float a0, a1, a2, a3;
        { const float k0 = bf2f(A[0].kk); reduce4(S0 * k0, S1 * k0, S2 * k0, S3 * k0, a0, a1, a2, a3); }
#if DBL_PHASE == 11
        if (dummy == 2) {
            float acc_ = 0.f;
            for (int g = 0; g < SC / 8; g += 2) {
                SCAN_LOAD(B, g + 1);
#pragma unroll
                for (int j = 0; j < 8; ++j) acc_ += bf2f(A[j].kk) + bf2f(A[j].bb) + bf2f(A[j].k) + bf2f(A[j].r) + bf2f(A[j].v) + A[j].w;
                if (g + 2 < SC / 8) SCAN_LOAD(A, g + 2);
#pragma unroll
                for (int j = 0; j < 8; ++j) acc_ += bf2f(B[j].kk) + bf2f(B[j].bb) + bf2f(B[j].k) + bf2f(B[j].r) + bf2f(B[j].v) + B[j].w;
            }
            if (acc_ == 12345.678f) stp[0] = acc_;
            continue;
        }
#endif
#if DBL_PHASE == 12
        if (dummy == 3) {
#pragma unroll
            for (int j = 0; j < 8; ++j) { A[j].kk = (bf16_t)(0x3c00 + lane + j); A[j].bb = (bf16_t)(0x3b00 + lane); A[j].k = (bf16_t)(0x3d00 + j); A[j].r = (bf16_t)(0x3e00 + lane); A[j].v = (bf16_t)(0x3c80 + j); A[j].w = 0.9f; B[j] = A[j]; }
            op = wsp<float>(WS_RAW) + (size_t)item * 4 + (lane >> 4);
            for (int g = 0; g < SC / 8; g += 2) {
                SCAN_GROUP(A, B, 0, false);
                SCAN_GROUP(B, A, 0, false);
            }
            if (S0 + S1 + S2 + S3 == 12345.678f) stp[0] = S0;
            continue;
        }
#endif
        for (int g = 0; g < SC / 8; g += 2) {
            SCAN_LOAD(B, g + 1);
            SCAN_GROUP(A, B, g, false);
            const bool last = (g + 2 >= SC / 8);
            if (!last) SCAN_LOAD(A, g + 2);
            SCAN_GROUP(B, A, g + 1, last);
        }
#undef SCAN_STEP1
#undef SCAN_GROUP
#undef SCAN_LOAD
        if (!dummy) { stp[0] = S0; stp[64] = S1; stp[128] = S2; stp[192] = S3; }
    }
}
typedef short s16x4 __attribute__((ext_vector_type(4)));
#define M16K32(a, b, c) __builtin_amdgcn_mfma_f32_16x16x32_bf16((a), (b), (c), 0, 0, 0)
#define M16K16(a, b, c) __builtin_amdgcn_mfma_f32_16x16x16bf16_1k((a), (b), (c), 0, 0, 0)
DI s16x4 pk4(f32x4 v) { u32x2 u; u[0] = pk2(v[0], v[1]); u[1] = pk2(v[2], v[3]); return __builtin_bit_cast(s16x4, u); }
DI void phase_scan_chunked(int l, int c, LAS unsigned char* lds, bool dummy = false) {
    const int tid = TID(), lane = tid & 63, wave = tid >> 6, r16 = lane & 15, g = lane >> 4;
    if (wave >= 2) return;
    const int item = BID() * 2 + wave;
    if (item >= NB * NH * 4) return;
    const int bh = item >> 2, ig = item & 3, b = bh >> 3, h = bh & 7, i0 = 16 * ig;
    LAS unsigned char* wl = lds + wave * 4096;
    const bf16_t* ktb = wsp<bf16_t>(WS_KT); const bf16_t* btb = wsp<bf16_t>(WS_BT); const bf16_t* kqb = wsp<bf16_t>(WS_KQ); const bf16_t* rtb = wsp<bf16_t>(WS_RT);
    const bf16_t* khb = wsp<bf16_t>(WS_KH); const bf16_t* bhb = wsp<bf16_t>(WS_BH); const float* p16b = wsp<float>(WS_P16);
    const bf16_t* vsb = wsp<bf16_t>(l == 0 ? WS_VV : WS_V2); float* outb = wsp<float>(WS_OUT);
    float* stp = wsp<float>(WS_STATE) + ((size_t)bh * 64 + i0 + r16) * 64 + 8 * g;
    f32x4 ST[4];
#pragma unroll
    for (int sg = 0; sg < 4; ++sg) ST[sg] = (c > 0) ? *(const f32x4*)(stp + 32 * (sg >> 1) + 4 * (sg & 1)) : (f32x4){0.f, 0.f, 0.f, 0.f};
    const size_t e0 = ((size_t)b * SC + r16) * 512 + h * 64 + 8 * g;
    const size_t ep = (size_t)(b * (SC / 16)) * 512 + h * 64 + 8 * g;
    const size_t ev = ((size_t)b * SC + 4 * g) * 512 + h * 64 + i0 + r16;
    const size_t eo = ((size_t)b * SC + 4 * g) * 512 + h * 64 + i0 + r16;
    u32x4 rk[2], rb[2], rq[2], rr_[2], rh[2], rg[2]; f32x4 rw[4]; bf16_t rv[4];
#define CS_LOAD(blk) do { const size_t o = e0 + (size_t)(blk) * 16 * 512; _Pragma("unroll") for (int s = 0; s < 2; ++s) { \
        rk[s] = *(const u32x4*)(ktb + o + 32 * s); rb[s] = *(const u32x4*)(btb + o + 32 * s); rq[s] = *(const u32x4*)(kqb + o + 32 * s); rr_[s] = *(const u32x4*)(rtb + o + 32 * s); \
        rh[s] = *(const u32x4*)(khb + o + 32 * s); rg[s] = *(const u32x4*)(bhb + o + 32 * s); \
        rw[2 * s] = *(const f32x4*)(p16b + ep + (size_t)(blk) * 512 + 32 * s); rw[2 * s + 1] = *(const f32x4*)(p16b + ep + (size_t)(blk) * 512 + 32 * s + 4); } \
        _Pragma("unroll") for (int e = 0; e < 4; ++e) rv[e] = vsb[ev + (size_t)(blk) * 16 * 512 + (size_t)e * 512]; } while (0)
    CS_LOAD(0);
    for (int blk = 0; blk < SC / 16; ++blk) {
        float P16[16];
        bf16x8 ktp[2], btp[2], kqp[2], rtp[2];
#pragma unroll
        for (int s = 0; s < 2; ++s) { ktp[s] = __builtin_bit_cast(bf16x8, rk[s]); btp[s] = __builtin_bit_cast(bf16x8, rb[s]); kqp[s] = __builtin_bit_cast(bf16x8, rq[s]); rtp[s] = __builtin_bit_cast(bf16x8, rr_[s]);
#pragma unroll
            for (int q = 0; q < 8; ++q) P16[8 * s + q] = rw[2 * s + (q >> 2)][q & 3]; }
#pragma unroll
        for (int s = 0; s < 2; ++s)
#pragma unroll
            for (int hb = 0; hb < 2; ++hb) { u32x2 uk, ub; uk[0] = rh[s][2 * hb]; uk[1] = rh[s][2 * hb + 1]; ub[0] = rg[s][2 * hb]; ub[1] = rg[s][2 * hb + 1];
                const int off = r16 * 128 + (32 * s + 16 * hb + 4 * g) * 2;
                *(LAS u32x2*)(wl + off) = uk; *(LAS u32x2*)(wl + 2048 + off) = ub; }
        s16x4 Vb; { u32x2 u; u[0] = (unsigned)rv[0] | ((unsigned)rv[1] << 16); u[1] = (unsigned)rv[2] | ((unsigned)rv[3] << 16); Vb = __builtin_bit_cast(s16x4, u); }
        if (blk + 1 < SC / 16) CS_LOAD(blk + 1);
        const f32x4 Z = {0.f, 0.f, 0.f, 0.f};
        f32x4 A1a = M16K32(btp[1], ktp[1], M16K32(btp[0], ktp[0], Z));
        f32x4 A1c = M16K32(ktp[1], btp[1], M16K32(ktp[0], btp[0], Z));
        f32x4 A2a = M16K32(kqp[1], ktp[1], M16K32(kqp[0], ktp[0], Z));
        f32x4 B1a = M16K32(btp[1], rtp[1], M16K32(btp[0], rtp[0], Z));
        f32x4 B2a = M16K32(kqp[1], rtp[1], M16K32(kqp[0], rtp[0], Z));
#pragma unroll
        for (int e = 0; e < 4; ++e) { const int s_ = 4 * g + e;
            A1a[e] = (s_ < r16) ? A1a[e] : 0.f; A2a[e] = (s_ < r16) ? A2a[e] : 0.f; A1c[e] = (r16 < s_) ? A1c[e] : 0.f;
            B1a[e] = (s_ <= r16) ? B1a[e] : 0.f; B2a[e] = (s_ <= r16) ? B2a[e] : 0.f; }
        const s16x4 a1a = pk4(A1a), a1c = pk4(A1c);
        const f32x4 M2a = M16K16(a1c, a1a, Z), M2c = M16K16(a1a, a1c, Z);
        const s16x4 m2a = pk4(M2a), m2c = pk4(M2c);
        const f32x4 M4a = M16K16(m2c, m2a, Z), M4c = M16K16(m2a, m2c, Z);
        const s16x4 m4a = pk4(M4a), m4c = pk4(M4c);
        const s16x4 m8a = pk4(M16K16(m4c, m4a, Z));
        s16x4 stb[4];
#pragma unroll
        for (int sg = 0; sg < 4; ++sg) stb[sg] = pk4(ST[sg]);
        f32x4 G = Z, G2 = Z;
#pragma unroll
        for (int sg = 0; sg < 4; ++sg) {
            const s16x4 kf_ = (sg & 1) ? __builtin_shufflevector(ktp[sg >> 1], ktp[sg >> 1], 4, 5, 6, 7) : __builtin_shufflevector(ktp[sg >> 1], ktp[sg >> 1], 0, 1, 2, 3);
            const s16x4 rf_ = (sg & 1) ? __builtin_shufflevector(rtp[sg >> 1], rtp[sg >> 1], 4, 5, 6, 7) : __builtin_shufflevector(rtp[sg >> 1], rtp[sg >> 1], 0, 1, 2, 3);
            G = M16K16(kf_, stb[sg], G); G2 = M16K16(rf_, stb[sg], G2); }
        const f32x4 RHS = M16K16(pk4(A2a), Vb, G);
        const f32x4 X1 = M16K16(m8a, pk4(RHS), RHS);
        const f32x4 X2 = M16K16(m4a, pk4(X1), X1);
        const f32x4 X3 = M16K16(m2a, pk4(X2), X2);
        const f32x4 U = M16K16(pk4(-A1a), pk4(X3), X3);
        const s16x4 un = pk4(-U);
        f32x4 O = M16K16(pk4(B2a), Vb, G2);
        O = M16K16(pk4(B1a), un, O);
        { float* op = outb + eo + (size_t)blk * 16 * 512;
#pragma unroll
          for (int e = 0; e < 4; ++e) op[(size_t)e * 512] = O[e]; }
#pragma unroll
        for (int sg = 0; sg < 4; ++sg) {
#pragma unroll
            for (int e = 0; e < 4; ++e) ST[sg][e] *= P16[8 * (sg >> 1) + 4 * (sg & 1) + e];
            const int toff = (4 * g + (r16 >> 2)) * 128 + 32 * sg + 8 * (r16 & 3);
            const s16x4 kh = __builtin_amdgcn_ds_read_tr16_b64_v4i16((LAS s16x4*)(wl + toff));
            const s16x4 bh_ = __builtin_amdgcn_ds_read_tr16_b64_v4i16((LAS s16x4*)(wl + 2048 + toff));
            ST[sg] = M16K16(kh, Vb, ST[sg]);
            ST[sg] = M16K16(bh_, un, ST[sg]);
        }
    }
#undef CS_LOAD
    if (dummy) return;
#pragma unroll
    for (int sg = 0; sg < 4; ++sg) *(f32x4*)(stp + 32 * (sg >> 1) + 4 * (sg & 1)) = ST[sg];
}
DI float sum8(float v) {
    v += __uint_as_float(__builtin_amdgcn_update_dpp(0, __float_as_uint(v), 0xB1, 0xf, 0xf, false));
    v += __uint_as_float(__builtin_amdgcn_update_dpp(0, __float_as_uint(v), 0x4E, 0xf, 0xf, false));
    v += __uint_as_float(__builtin_amdgcn_update_dpp(0, __float_as_uint(v), 0x141, 0xf, 0xf, false));
    return v;
}
DI void unpk8(const u32x4 u, float* f) {
#pragma unroll
    for (int q = 0; q < 4; ++q) { f[2 * q] = bflo(u[q]); f[2 * q + 1] = bfhi(u[q]); }
}
DI void phase_rwkv_post(int l, int par) {
    const int lane = TID() & 63, gw = BID() * 8 + (TID() >> 6), nw = gridDim.x * 8;
    const float* outb = wsp<float>(WS_OUT); const bf16_t* rrb = wsp<bf16_t>(WS_RR); const bf16_t* kfb = wsp<bf16_t>(WS_KF);
    const bf16_t* vsb = wsp<bf16_t>(l == 0 ? WS_VV : WS_V2); const bf16_t* ggb = wsp<bf16_t>(WS_GG); bf16_t* orw = wsp<bf16_t>(WS_ORW + par * PAR_O);
    float lw[8], lb[8], rkc[8];
    { const float* lnw = KP()->in[I_LNW] + l * 512 + 8 * lane; const float* lnb = KP()->in[I_LNB] + l * 512 + 8 * lane; const float* rk = KP()->in[I_RK] + l * 512 + 8 * lane;
#pragma unroll
      for (int e = 0; e < 8; ++e) { lw[e] = lnw[e]; lb[e] = lnb[e]; rkc[e] = rk[e]; } }
    for (int row = gw; row < TC; row += nw) {
        const size_t e0 = (size_t)row * 512 + 8 * lane;
        const f32x4 o0 = *(const f32x4*)(outb + e0), o1 = *(const f32x4*)(outb + e0 + 4);
        float o[8] = {o0[0], o0[1], o0[2], o0[3], o1[0], o1[1], o1[2], o1[3]}, r[8], k[8], v[8], g[8];
        unpk8(*(const u32x4*)(rrb + e0), r); unpk8(*(const u32x4*)(kfb + e0), k); unpk8(*(const u32x4*)(vsb + e0), v); unpk8(*(const u32x4*)(ggb + e0), g);
        float s = 0.f, bo = 0.f;
#pragma unroll
        for (int e = 0; e < 8; ++e) { s += o[e]; bo += r[e] * k[e] * rkc[e]; }
        const float mean = sum8(s) * (1.f / 64.f); const float bonus = sum8(bo);
        float q = 0.f;
#pragma unroll
        for (int e = 0; e < 8; ++e) { o[e] -= mean; q += o[e] * o[e]; }
        const float rs = __builtin_amdgcn_rsqf(sum8(q) * (1.f / 64.f) + 64e-5f);
        u32x4 w;
#pragma unroll
        for (int p = 0; p < 4; ++p) { float y0 = (o[2 * p] * rs * lw[2 * p] + lb[2 * p] + bonus * v[2 * p]) * g[2 * p], y1 = (o[2 * p + 1] * rs * lw[2 * p + 1] + lb[2 * p + 1] + bonus * v[2 * p + 1]) * g[2 * p + 1]; w[p] = pk2(y0, y1); }
        *(u32x4*)(orw + e0) = w;
    }
}

#define MFMA32(a, b, c) __builtin_amdgcn_mfma_f32_32x32x16_bf16((a), (b), (c), 0, 0, 0)
DI unsigned fkey(float v) { v = v + 0.f; const unsigned u = __float_as_uint(v); return (u & 0x80000000u) ? ~u : (u | 0x80000000u); }
DI int half_sum(int x) {
    x += __builtin_amdgcn_update_dpp(0, x, 0x128, 0xf, 0xf, false);
    x += __builtin_amdgcn_update_dpp(0, x, 0x124, 0xf, 0xf, false);
    x += __builtin_amdgcn_update_dpp(0, x, 0x122, 0xf, 0xf, false);
    x += __builtin_amdgcn_update_dpp(0, x, 0x121, 0xf, 0xf, false);
    auto r = __builtin_amdgcn_permlane16_swap((unsigned)x, (unsigned)x, false, false);
    return (int)(r[0] + r[1]);
}
DI void dsa_select_half(int c, int item4, int set, int lane) {
    int lz = lane; asm volatile("" : "+v"(lz));
    const int hh = lz >> 5, r5 = lz & 31;
    const int rc0 = item4 * 4, b = rc0 >> 9, t0 = c * SC + (rc0 & 511);
    const int qq = ((r5 >> 2) & 1) + 2 * ((r5 >> 4) ^ set), hd = (r5 & 3) + 4 * ((r5 >> 3) & 1);
    const bf16_t* qp = wsp<bf16_t>(WS_IDXQ) + (size_t)(rc0 + qq) * 256 + hd * 32 + 8 * hh;
    const bf16x8 Af0 = *(const bf16x8*)qp, Af1 = *(const bf16x8*)(qp + 16);
    const int tA = t0 + hh + 2 * set;
    const float* wp = wsp<float>(WS_IDXW) + ((size_t)b * SEQ + tA) * 8;
    const f32x4 wa0 = *(const f32x4*)wp, wa1 = *(const f32x4*)(wp + 4);
    const int ngrp = ((t0 + 2 * set + 1) >> 9) + 1;
    unsigned keyA[64];
    const bf16_t* kbase = wsp<bf16_t>(WS_IDXK) + ((size_t)b * SEQ + r5) * 32 + 8 * hh;
    int keyv = r5; unsigned kofs = 0u;
    bf16x8 Bn0 = *(const bf16x8*)kbase, Bn1 = *(const bf16x8*)(kbase + 16);
#pragma unroll
    for (int g = 0; g < 4; ++g) {
        if (g < ngrp) {
#pragma unroll
            for (int j = 0; j < 16; ++j) {
                const int kt = g * 16 + j;
                const bf16x8 Bf0 = Bn0, Bf1 = Bn1;
                { const unsigned nofs = (kt < 63) ? kofs + 32 * 32 : kofs; const bf16_t* kp = kbase + nofs; Bn0 = *(const bf16x8*)kp; Bn1 = *(const bf16x8*)(kp + 16); }
                f32x16 C = {0.f, 0.f, 0.f, 0.f, 0.f, 0.f, 0.f, 0.f, 0.f, 0.f, 0.f, 0.f, 0.f, 0.f, 0.f, 0.f};
                C = MFMA32(Af0, Bf0, C); C = MFMA32(Af1, Bf1, C);
                float va = 0.f;
#pragma unroll
                for (int i = 0; i < 4; ++i) va = __builtin_fmaf(__builtin_amdgcn_fmed3f(C[i], 0.f, 3.0e38f), wa0[i], va);
#pragma unroll
                for (int i = 0; i < 4; ++i) va = __builtin_fmaf(__builtin_amdgcn_fmed3f(C[4 + i], 0.f, 3.0e38f), wa1[i], va);
                unsigned ka = (keyv <= tA) ? fkey(va) : 0u;
                asm volatile("" : "+v"(ka), "+v"(keyv), "+v"(kofs));
                keyA[kt] = ka;
                keyv += 32; kofs += 32 * 32;
            }
        } else {
#pragma unroll
            for (int j = 0; j < 16; ++j) keyA[g * 16 + j] = 0u;
        }
    }
    unsigned KA = 0u;
    if (t0 + 2 * set + 1 >= 256) {
        bool dA = tA < 255;
        for (int bit = 31; bit >= 0; --bit) {
            const unsigned cA = KA | (1u << bit);
            int nA = 0;
#pragma unroll
            for (int g = 0; g < 4; ++g) {
                if (g < ngrp) {
#pragma unroll
                    for (int j = 0; j < 16; ++j) nA += (keyA[g * 16 + j] >= cA) ? 1 : 0;
                }
            }
            nA = half_sum(nA);
            if (!dA && nA >= 256) KA = cA;
            dA = dA || (nA == 256);
            if (__ballot(dA) == ~0ull) break;
        }
    }
    int gA = 0;
#pragma unroll
    for (int kt = 0; kt < 64; ++kt) gA += (keyA[kt] > KA) ? 1 : 0;
    gA = half_sum(gA);
    const int needA = (KA == 0u) ? 0 : 256 - gA;
    asm volatile("" : "+v"(KA));
    int runA = 0, lsel = lz;
    unsigned w0 = 0u, w1 = 0u;
#pragma unroll
    for (int kt = 0; kt < 64; ++kt) {
        const bool eqA = keyA[kt] == KA;
        const unsigned long long ea = __ballot(eqA);
        const int rkA = runA + (hh ? (int)__builtin_amdgcn_mbcnt_hi((unsigned)(ea >> 32), 0u) : (int)__builtin_amdgcn_mbcnt_lo((unsigned)ea, 0u));
        const bool sA = (keyA[kt] > KA) || (eqA && rkA < needA);
        runA += hh ? __builtin_popcount((unsigned)(ea >> 32)) : __builtin_popcount((unsigned)ea);
        const unsigned long long sa = __ballot(sA);
        if (lsel == 0) { w0 = (unsigned)sa; w1 = (unsigned)(sa >> 32); }
        lsel -= 1; asm volatile("" : "+v"(lsel));
        __builtin_amdgcn_sched_barrier(0);
    }
    unsigned* sp = wsp<unsigned>(WS_SELB) + (size_t)(rc0 + 2 * set) * 64 + lz;
    sp[0] = w0; sp[64] = w1;
}
DI void dsa_select_full(int c, int item, int lane) {
    {
        int lz = lane; asm volatile("" : "+v"(lz));
        const int hh = lz >> 5, r5 = lz & 31;
        const int rc0 = item * 4, b = rc0 >> 9, t0 = c * SC + (rc0 & 511);
        const int qq = ((r5 >> 2) & 1) + 2 * (r5 >> 4), hd = (r5 & 3) + 4 * ((r5 >> 3) & 1);
        const bf16_t* qp = wsp<bf16_t>(WS_IDXQ) + (size_t)(rc0 + qq) * 256 + hd * 32 + 8 * hh;
        const bf16x8 Af0 = *(const bf16x8*)qp, Af1 = *(const bf16x8*)(qp + 16);
        const float* wp = wsp<float>(WS_IDXW) + ((size_t)b * SEQ + t0 + hh) * 8;
        const f32x4 wa0 = *(const f32x4*)wp, wa1 = *(const f32x4*)(wp + 4), wb0 = *(const f32x4*)(wp + 16), wb1 = *(const f32x4*)(wp + 20);
        const int tA = t0 + hh, tB = t0 + hh + 2;
        const int ngrp = ((t0 + 3) >> 9) + 1;
        unsigned keyA[64], keyB[64];
        const bf16_t* kbase = wsp<bf16_t>(WS_IDXK) + ((size_t)b * SEQ + r5) * 32 + 8 * hh;
        int keyv = r5;
        unsigned kofs = 0u;
        bf16x8 Bn0 = *(const bf16x8*)kbase, Bn1 = *(const bf16x8*)(kbase + 16);
#pragma unroll
        for (int g = 0; g < 4; ++g) {
            if (g < ngrp) {
#pragma unroll
                for (int j = 0; j < 16; ++j) {
                    const int kt = g * 16 + j;
                    const bf16x8 Bf0 = Bn0, Bf1 = Bn1;
                    { const unsigned nofs = (kt < 63) ? kofs + 32 * 32 : kofs; const bf16_t* kp = kbase + nofs; Bn0 = *(const bf16x8*)kp; Bn1 = *(const bf16x8*)(kp + 16); }
                    f32x16 C = {0.f, 0.f, 0.f, 0.f, 0.f, 0.f, 0.f, 0.f, 0.f, 0.f, 0.f, 0.f, 0.f, 0.f, 0.f, 0.f};
                    C = MFMA32(Af0, Bf0, C); C = MFMA32(Af1, Bf1, C);
                    float va = 0.f, vb = 0.f;
#pragma unroll
                    for (int i = 0; i < 4; ++i) { va = __builtin_fmaf(__builtin_amdgcn_fmed3f(C[i], 0.f, 3.0e38f), wa0[i], va); vb = __builtin_fmaf(__builtin_amdgcn_fmed3f(C[8 + i], 0.f, 3.0e38f), wb0[i], vb); }
#pragma unroll
                    for (int i = 0; i < 4; ++i) { va = __builtin_fmaf(__builtin_amdgcn_fmed3f(C[4 + i], 0.f, 3.0e38f), wa1[i], va); vb = __builtin_fmaf(__builtin_amdgcn_fmed3f(C[12 + i], 0.f, 3.0e38f), wb1[i], vb); }
                    unsigned ka = (keyv <= tA) ? fkey(va) : 0u, kb = (keyv <= tB) ? fkey(vb) : 0u;
                    asm volatile("" : "+v"(ka), "+v"(kb), "+v"(keyv), "+v"(kofs));
                    keyA[kt] = ka; keyB[kt] = kb;
                    keyv += 32; kofs += 32 * 32;
                }
            } else {
#pragma unroll
                for (int j = 0; j < 16; ++j) { keyA[g * 16 + j] = 0u; keyB[g * 16 + j] = 0u; }
            }
        }
        unsigned KA = 0u, KB = 0u;
        if (t0 + 3 >= 256) {
            bool dA = false, dB = false;
            for (int bit = 31; bit >= 0; --bit) {
                const unsigned bm = 1u << bit;
                const unsigned cA = KA | bm, cB = KB | bm;
                int nA = 0, nB = 0;
#pragma unroll
                for (int g = 0; g < 4; ++g) {
                    if (g < ngrp) {
#pragma unroll
                        for (int j = 0; j < 16; ++j) { nA += (keyA[g * 16 + j] >= cA) ? 1 : 0; nB += (keyB[g * 16 + j] >= cB) ? 1 : 0; }
                    }
                }
                nA = half_sum(nA); nB = half_sum(nB);
                if (!dA && nA >= 256) KA = cA;
                if (!dB && nB >= 256) KB = cB;
                dA = dA || (nA == 256); dB = dB || (nB == 256);
                if (__ballot(dA && dB) == ~0ull) break;
            }
        }
        int gA = 0, gB = 0;
#pragma unroll
        for (int kt = 0; kt < 64; ++kt) { gA += (keyA[kt] > KA) ? 1 : 0; gB += (keyB[kt] > KB) ? 1 : 0; }
        gA = half_sum(gA); gB = half_sum(gB);
        const int needA = (KA == 0u) ? 0 : 256 - gA, needB = (KB == 0u) ? 0 : 256 - gB;
        asm volatile("" : "+v"(KA), "+v"(KB));
        int runA = 0, runB = 0, lsel = lz;
        unsigned w0 = 0u, w1 = 0u, w2 = 0u, w3 = 0u;
#pragma unroll
        for (int kt = 0; kt < 64; ++kt) {
            const bool eqA = keyA[kt] == KA, eqB = keyB[kt] == KB;
            const unsigned long long ea = __ballot(eqA), eb = __ballot(eqB);
            const int rkA = runA + (hh ? (int)__builtin_amdgcn_mbcnt_hi((unsigned)(ea >> 32), 0u) : (int)__builtin_amdgcn_mbcnt_lo((unsigned)ea, 0u));
            const int rkB = runB + (hh ? (int)__builtin_amdgcn_mbcnt_hi((unsigned)(eb >> 32), 0u) : (int)__builtin_amdgcn_mbcnt_lo((unsigned)eb, 0u));
            const bool sA = (keyA[kt] > KA) || (eqA && rkA < needA), sB = (keyB[kt] > KB) || (eqB && rkB < needB);
            runA += hh ? __builtin_popcount((unsigned)(ea >> 32)) : __builtin_popcount((unsigned)ea);
            runB += hh ? __builtin_popcount((unsigned)(eb >> 32)) : __builtin_popcount((unsigned)eb);
            const unsigned long long sa = __ballot(sA), sb = __ballot(sB);
            if (lsel == 0) { w0 = (unsigned)sa; w1 = (unsigned)(sa >> 32); w2 = (unsigned)sb; w3 = (unsigned)(sb >> 32); }
            lsel -= 1; asm volatile("" : "+v"(lsel));
            __builtin_amdgcn_sched_barrier(0);
        }
        unsigned* sp = wsp<unsigned>(WS_SELB) + (size_t)rc0 * 64 + lz;
        sp[0] = w0; sp[64] = w1; sp[128] = w2; sp[192] = w3;
    }
}

DI void phase_dsa_select_queue(int c, LAS unsigned* ctr) {
    const int lane = TID() & 63;
    const int base = BID() * 8;
    for (;;) {
        unsigned idx = 0u;
        if (lane == 0) idx = __hip_atomic_fetch_add(ctr, 1u, __ATOMIC_RELAXED, __HIP_MEMORY_SCOPE_WORKGROUP);
        idx = (unsigned)__builtin_amdgcn_readfirstlane((int)idx);
        if (idx >= 12u) break;
        if (idx < 4u) { const int item4 = base + (int)idx; if (item4 < TC / 4) dsa_select_full(c, item4, lane); }
        else { const int item4 = base + 4 + (int)((idx - 4u) >> 1); if (item4 < TC / 4) dsa_select_half(c, item4, (int)((idx - 4u) & 1u), lane); }
    }
}

struct AttnSt { f32x16 O0, O1; float m, l; };
constexpr float C2 = 0.125f * LOG2E;
DI void attn_load_kv(bf16x8 (&Kf)[4], bf16x8 (&Vf)[2][2], const bf16_t* kbase, const bf16_t* vtbase, int key0, int lane) {
    const int r5 = lane & 31;
    const int prow = (r5 & 19) | ((r5 & 4) << 1) | ((r5 & 8) >> 1);
    const bf16_t* kp = kbase + (size_t)(key0 + prow) * 512;
#pragma unroll
    for (int s = 0; s < 4; ++s) Kf[s] = *(const bf16x8*)(kp + 16 * s);
#pragma unroll
    for (int n = 0; n < 2; ++n)
#pragma unroll
        for (int s = 0; s < 2; ++s) Vf[n][s] = *(const bf16x8*)(vtbase + (size_t)(32 * n) * SEQ + key0 + 16 * s);
}
constexpr int BT_N = 192;
template <int MODE, bool FAR>
DI void attn_tile(AttnSt& st, const bf16x8 (&Qf)[4], const bf16x8 (&Kf)[4], const bf16x8 (&Vf)[2][2], int key0, int tq, bool allowed, unsigned word, LAS const float* bt, float ub, int lane) {
    const int hh = lane >> 5;
    const float c0 = (MODE == 0 && !allowed) ? -INFINITY : -ub;
    f32x16 S;
#pragma unroll
    for (int i = 0; i < 16; ++i) S[i] = c0;
#pragma unroll
    for (int s = 0; s < 4; ++s) S = MFMA32(Kf[s], Qf[s], S);
    const unsigned wsh = word >> (8 * hh);
    float ps = 0.f; float pv[16];
    if (FAR) {
        const float cb = bt[BT_N - 1];
#pragma unroll
        for (int i = 0; i < 16; ++i) {
            float p = fexp2(S[i] + cb);
            if (MODE == 1) p = __uint_as_float(__float_as_uint(p) & (unsigned)__builtin_amdgcn_sbfe((int)wsh, 16 * (i >> 3) + (i & 7), 1));
            pv[i] = p; ps += p;
        }
    } else {
        LAS const float* tb_ = bt + (tq - key0 + 32 - 8 * hh - 23);
#pragma unroll
        for (int i = 0; i < 16; ++i) {
            float p = fexp2(S[i] + tb_[23 - (16 * (i >> 3) + (i & 7))]);
            if (MODE == 1) p = __uint_as_float(__float_as_uint(p) & (unsigned)__builtin_amdgcn_sbfe((int)wsh, 16 * (i >> 3) + (i & 7), 1));
            pv[i] = p; ps += p;
        }
    }
    st.l += ps;
#pragma unroll
    for (int s = 0; s < 2; ++s) {
        u32x4 pw; pw[0] = pk2(pv[8 * s], pv[8 * s + 1]); pw[1] = pk2(pv[8 * s + 2], pv[8 * s + 3]); pw[2] = pk2(pv[8 * s + 4], pv[8 * s + 5]); pw[3] = pk2(pv[8 * s + 6], pv[8 * s + 7]);
        const bf16x8 Pf = __builtin_bit_cast(bf16x8, pw);
        st.O0 = MFMA32(Vf[0][s], Pf, st.O0); st.O1 = MFMA32(Vf[1][s], Pf, st.O1);
    }
}
constexpr int AT_KEYS = 128, AT_ROW = 144, AT_VROW = 2 * AT_KEYS + 16, AT_KV = AT_KEYS * AT_ROW, AT_STAGE = AT_KV + 64 * AT_VROW;
template <int MODE>
DI void attn_pair_far(AttnSt& st, const bf16x8 (&Qf)[4], LAS const unsigned char* ks, LAS const unsigned char* vs, int kofs, int vofs, unsigned w0, unsigned w1, const f32x16& CBv, int lane) {
    const int hh = lane >> 5;
    bf16x8 K0[4], K1[4], V0[2][2], V1[2][2];
#pragma unroll
    for (int s = 0; s < 4; ++s) { K0[s] = *(LAS const bf16x8*)(ks + kofs + 32 * s); K1[s] = *(LAS const bf16x8*)(ks + 32 * AT_ROW + kofs + 32 * s); }
#pragma unroll
    for (int n = 0; n < 2; ++n)
#pragma unroll
        for (int s = 0; s < 2; ++s) { V0[n][s] = *(LAS const bf16x8*)(vs + 32 * n * AT_VROW + vofs + 32 * s); V1[n][s] = *(LAS const bf16x8*)(vs + 32 * n * AT_VROW + vofs + 64 + 32 * s); }
    f32x16 S0 = MFMA32(K0[0], Qf[0], CBv), S1 = MFMA32(K1[0], Qf[0], CBv);
#pragma unroll
    for (int s = 1; s < 4; ++s) { S0 = MFMA32(K0[s], Qf[s], S0); S1 = MFMA32(K1[s], Qf[s], S1); }
    const unsigned wa = w0 >> (8 * hh), wb = w1 >> (8 * hh);
    float ps = 0.f; float p0[16], p1[16];
#pragma unroll
    for (int i = 0; i < 16; ++i) {
        float a = fexp2(S0[i]), b = fexp2(S1[i]);
        if (MODE == 1) { a = __uint_as_float(__float_as_uint(a) & (unsigned)__builtin_amdgcn_sbfe((int)wa, 16 * (i >> 3) + (i & 7), 1));
                         b = __uint_as_float(__float_as_uint(b) & (unsigned)__builtin_amdgcn_sbfe((int)wb, 16 * (i >> 3) + (i & 7), 1)); }
        p0[i] = a; p1[i] = b; ps += a + b;
    }
    st.l += ps;
#pragma unroll
    for (int s = 0; s < 2; ++s) {
        u32x4 pw; pw[0] = pk2(p0[8 * s], p0[8 * s + 1]); pw[1] = pk2(p0[8 * s + 2], p0[8 * s + 3]); pw[2] = pk2(p0[8 * s + 4], p0[8 * s + 5]); pw[3] = pk2(p0[8 * s + 6], p0[8 * s + 7]);
        const bf16x8 Pf = __builtin_bit_cast(bf16x8, pw);
        st.O0 = MFMA32(V0[0][s], Pf, st.O0); st.O1 = MFMA32(V0[1][s], Pf, st.O1);
    }
#pragma unroll
    for (int s = 0; s < 2; ++s) {
        u32x4 pw; pw[0] = pk2(p1[8 * s], p1[8 * s + 1]); pw[1] = pk2(p1[8 * s + 2], p1[8 * s + 3]); pw[2] = pk2(p1[8 * s + 4], p1[8 * s + 5]); pw[3] = pk2(p1[8 * s + 6], p1[8 * s + 7]);
        const bf16x8 Pf = __builtin_bit_cast(bf16x8, pw);
        st.O0 = MFMA32(V1[0][s], Pf, st.O0); st.O1 = MFMA32(V1[1][s], Pf, st.O1);
    }
}
template <int MODE>
DI void attn_block(int c, int b, int h, int half, LAS unsigned char* stg, LAS unsigned* uni, LAS const float* bt, float kbound, float bmax, bool dummy) {
    const int tid = TID(), lane = tid & 63, wave = tid >> 6, r5 = lane & 31, hh = lane >> 5;
    bf16_t* qbuf = wsp<bf16_t>((MODE == 0 ? WS_MQ : WS_DQ) + (c & 1) * PAR_O);
    const int tb = c * SC + 256 * half, t0 = tb + 32 * wave, tq = t0 + r5, rowc0 = b * SC + 256 * half + 32 * wave;
    bf16_t* qp = qbuf + (size_t)(rowc0 + r5) * 512 + h * 64;
    bf16x8 Qf[4];
#pragma unroll
    for (int s = 0; s < 4; ++s) Qf[s] = *(const bf16x8*)(qp + 16 * s + 8 * hh);
    AttnSt st; st.m = 0.f; st.l = 0.f;
#pragma unroll
    for (int i = 0; i < 16; ++i) { st.O0[i] = 0.f; st.O1[i] = 0.f; }
    float ub;
    { float q2 = 0.f;
#pragma unroll
      for (int s = 0; s < 4; ++s)
#pragma unroll
          for (int j = 0; j < 8; ++j) { const float v = bf2f((bf16_t)Qf[s][j]); q2 += v * v; }
      q2 += __shfl_xor(q2, 32);
      ub = sqrtf(q2) * kbound + bmax; }
    const int ktl = (t0 + 31) >> 5;
    const int own = tb >> 8;
    unsigned bm = 0u, anyw = 0xffu;
    if (MODE == 0) {
        if (own > 0) {
            const float* km = wsp<float>(WS_KMEAN) + ((size_t)(b * 8 + h) * 8) * 64 + 8 * hh;
            float g[8];
#pragma unroll
            for (int n = 0; n < 8; ++n) {
                g[n] = -INFINITY;
                if (n < own) {
                    float part = 0.f;
#pragma unroll
                    for (int s = 0; s < 4; ++s) { const f32x4 k0 = *(const f32x4*)(km + n * 64 + 16 * s), k1 = *(const f32x4*)(km + n * 64 + 16 * s + 4);
#pragma unroll
                        for (int j = 0; j < 4; ++j) part += bf2f((bf16_t)Qf[s][j]) * k0[j] + bf2f((bf16_t)Qf[s][4 + j]) * k1[j]; }
                    g[n] = part + __shfl_xor(part, 32);
                }
            }
#pragma unroll
            for (int n = 0; n < 8; ++n) {
                if (n < own) { int rank = 0;
#pragma unroll
                    for (int m2 = 0; m2 < 8; ++m2) if (m2 != n && m2 < own) rank += ((g[m2] > g[n]) || (g[m2] == g[n] && m2 < n)) ? 1 : 0;
                    if (rank < 3) bm |= 1u << n; }
            }
        }
        anyw = 1u << own;
#pragma unroll
        for (int n = 0; n < 8; ++n) if (n < own && __ballot((bm >> n) & 1u) != 0ull) anyw |= 1u << n;
    }
    if (tid == 0) uni[0] = 0u;
    __syncthreads();
    if (lane == 0) __hip_atomic_fetch_or(uni, anyw, __ATOMIC_RELAXED, __HIP_MEMORY_SCOPE_WORKGROUP);
    __syncthreads();
    const unsigned anyb = MODE == 0 ? uni[0] : 0xffu;
    const bf16_t* kg[2]; const bf16_t* vg[2]; int klofs[2], vlofs[2];
#pragma unroll
    for (int i = 0; i < 2; ++i) { const int pc_ = tid + 512 * i;
        kg[i] = wsp<bf16_t>(MODE == 0 ? WS_MK : WS_DK) + ((size_t)b * SEQ + (pc_ >> 3)) * 512 + h * 64 + (pc_ & 7) * 8;
        vg[i] = wsp<bf16_t>(MODE == 0 ? WS_MVT : WS_DVT) + ((size_t)b * 512 + h * 64 + (pc_ >> 4)) * SEQ + (pc_ & 15) * 8;
        klofs[i] = (pc_ >> 3) * AT_ROW + (pc_ & 7) * 16; vlofs[i] = AT_KV + (pc_ >> 4) * AT_VROW + (pc_ & 15) * 16; }
    const int prow = (r5 & 19) | ((r5 & 4) << 1) | ((r5 & 8) >> 1);
    const int kofs = prow * AT_ROW + 16 * hh, vofs = r5 * AT_VROW + 16 * hh;
    const unsigned* sp = wsp<unsigned>(WS_SELB) + (size_t)(rowc0 + r5) * 64;
    const int nst = (tb + 256) >> 7;
    int stp = 0;
    if (MODE == 0) { while (!((anyb >> (stp >> 1)) & 1u)) stp += 2; }
    u32x4 kreg[2], vreg[2];
#pragma unroll
    for (int i = 0; i < 2; ++i) { kreg[i] = *(const u32x4*)(kg[i] + (size_t)(stp * AT_KEYS) * 512); vreg[i] = *(const u32x4*)(vg[i] + stp * AT_KEYS);
        *(LAS u32x4*)(stg + klofs[i]) = kreg[i]; *(LAS u32x4*)(stg + vlofs[i]) = vreg[i]; }
    u32x4 wcur = {0u, 0u, 0u, 0u}, wnxt = {0u, 0u, 0u, 0u};
    if (MODE == 1) wcur = *(const u32x4*)(sp + 4 * stp);
    __syncthreads();
    int cur = 0;
    f32x16 CBv; int cbblk = -1;
    while (stp < nst) {
        int nx = stp + 1;
        if (MODE == 0) { while (nx < nst && !((anyb >> (nx >> 1)) & 1u)) nx += 2 - (nx & 1); }
        const bool more = nx < nst;
        if (more) {
#pragma unroll
            for (int i = 0; i < 2; ++i) { kreg[i] = *(const u32x4*)(kg[i] + (size_t)(nx * AT_KEYS) * 512); vreg[i] = *(const u32x4*)(vg[i] + nx * AT_KEYS); }
            if (MODE == 1) wnxt = *(const u32x4*)(sp + 4 * nx); }
        LAS const unsigned char* ks = stg + cur * AT_STAGE; LAS const unsigned char* vs = ks + AT_KV;
        const int nbs = stp >> 1;
        const bool won = (MODE == 1) || (((anyw >> nbs) & 1u) != 0u);
#pragma unroll
        for (int pr = 0; pr < 2; ++pr) {
            const int ktp = 4 * stp + 2 * pr;
            if (won && (ktp + 1 <= ktl) && (t0 - (ktp * 32 + 63) >= 113)) {
                if (cbblk != (MODE == 0 ? nbs : 0)) { cbblk = (MODE == 0 ? nbs : 0);
                    const bool allowed = (MODE == 0) ? ((nbs == own) || (((bm >> nbs) & 1u) != 0u)) : true;
                    const float cb = allowed ? (bt[BT_N - 1] - ub) : -INFINITY;
#pragma unroll
                    for (int i = 0; i < 16; ++i) CBv[i] = cb; }
                attn_pair_far<MODE>(st, Qf, ks + 64 * pr * AT_ROW, vs + 128 * pr, kofs, vofs, wcur[2 * pr], wcur[2 * pr + 1], CBv, lane);
            } else {
#pragma unroll
                for (int uu = 0; uu < 2; ++uu) {
                    const int u = 2 * pr + uu, kt = 4 * stp + u, key0 = kt * 32, nb = kt >> 3;
                    const bool waveon = (kt <= ktl) && (MODE == 1 || ((anyw >> nb) & 1u));
                    if (waveon) {
                        bf16x8 Kf[4], Vf[2][2];
#pragma unroll
                        for (int s = 0; s < 4; ++s) Kf[s] = *(LAS const bf16x8*)(ks + 32 * u * AT_ROW + kofs + 32 * s);
#pragma unroll
                        for (int n = 0; n < 2; ++n)
#pragma unroll
                            for (int s = 0; s < 2; ++s) Vf[n][s] = *(LAS const bf16x8*)(vs + 32 * n * AT_VROW + vofs + 64 * u + 32 * s);
                        const unsigned word = (MODE == 1) ? wcur[u] : 0u;
                        const bool allowed = (MODE == 0) ? ((nb == own) || (((bm >> nb) & 1u) != 0u)) : true;
                        if (t0 - (key0 + 31) >= 113) attn_tile<MODE, true>(st, Qf, Kf, Vf, key0, tq, allowed, word, bt, ub, lane);
                        else attn_tile<MODE, false>(st, Qf, Kf, Vf, key0, tq, allowed, word, bt, ub, lane);
                    }
                }
            }
        }
        if (more) { LAS unsigned char* ws_ = stg + (cur ^ 1) * AT_STAGE;
#pragma unroll
            for (int i = 0; i < 2; ++i) { *(LAS u32x4*)(ws_ + klofs[i]) = kreg[i]; *(LAS u32x4*)(ws_ + vlofs[i]) = vreg[i]; } }
        __syncthreads();
        cur ^= 1; stp = nx; wcur = wnxt;
    }
    const float lt = st.l + __shfl_xor(st.l, 32);
    const float inv = 1.f / lt;
    if (dummy) qp = wsp<bf16_t>(WS_RAW + (MODE ? 8 * MiB : 0)) + (size_t)(rowc0 + r5) * 512 + h * 64;
#pragma unroll
    for (int g4 = 0; g4 < 4; ++g4) {
        st_bf4(qp + 8 * g4 + 4 * hh, (f32x4){st.O0[4 * g4] * inv, st.O0[4 * g4 + 1] * inv, st.O0[4 * g4 + 2] * inv, st.O0[4 * g4 + 3] * inv});
        st_bf4(qp + 32 + 8 * g4 + 4 * hh, (f32x4){st.O1[4 * g4] * inv, st.O1[4 * g4 + 1] * inv, st.O1[4 * g4 + 2] * inv, st.O1[4 * g4 + 3] * inv});
    }
    __syncthreads();
}
__device__ const unsigned char kBucket[128] = {0,1,2,3,4,5,6,7,8,9,10,11,12,13,14,15,16,16,16,17,17,18,18,18,19,19,19,20,20,20,20,21,21,21,21,22,22,22,22,22,23,23,23,23,23,23,24,24,24,24,24,24,25,25,25,25,25,25,25,26,26,26,26,26,26,26,26,27,27,27,27,27,27,27,27,27,27,28,28,28,28,28,28,28,28,28,28,29,29,29,29,29,29,29,29,29,29,29,29,30,30,30,30,30,30,30,30,30,30,30,30,30,30,31,31,31,31,31,31,31,31,31,31,31,31,31,31,31};
DI void phase_attn(int l, int c, LAS float* lds, bool dummy = false) {
    const int tid = TID();
    for (int e = tid; e < 2 * 8 * BT_N; e += 512) { const int j = e % BT_N, h = (e / BT_N) & 7, mx = e / (8 * BT_N); const int d = j - 32;
        lds[e] = (d < 0) ? -INFINITY : KP()->in[I_REL][kBucket[d < 127 ? d : 127] * 16 + mx * 8 + h] * LOG2E; }
    if (tid < 2) { const float* g = KP()->in[I_QKN] + l * 256 + (tid == 0 ? 64 : 192); float m = 0.f; for (int i = 0; i < 64; ++i) m = fmaxf(m, fabsf(g[i])); lds[3072 + tid] = 8.1f * m; }
    if (tid >= 64 && tid < 80) { const int mx = (tid - 64) >> 3, h = (tid - 64) & 7; float m = 0.f; for (int k = 0; k < 32; ++k) m = fmaxf(m, fabsf(KP()->in[I_REL][k * 16 + mx * 8 + h])); lds[3088 + (tid - 64)] = m * LOG2E; }
    __syncthreads();
    LAS unsigned char* stg = (LAS unsigned char*)lds + 16384; LAS unsigned* uni = (LAS unsigned*)((LAS unsigned char*)lds + 12544);
    for (int it = BID(); it < NB * NH * 2; it += gridDim.x) {
        const int bh = it >> 1, b = bh >> 3, h = bh & 7, hf = it & 1;
        attn_block<0>(c, b, h, hf, stg, uni, lds + h * BT_N, lds[3072], lds[3088 + h], dummy);
        attn_block<1>(c, b, h, hf ^ 1, stg, uni, lds + (8 + h) * BT_N, lds[3073], lds[3096 + h], dummy);
    }
    if (!dummy) { phase_rwkv_post(l, c & 1); if (DBL_PHASE == 24) phase_rwkv_post(l, c & 1); }
}

constexpr int LDS_BYTES = pg8::STAGE_BYTES + 256 + XS_BYTES;
constexpr int PH_PER_LAYER = 32, N_PHASES = 2 * PH_PER_LAYER;
#ifndef DBL_PHASE
#define DBL_PHASE 0
#endif
#ifndef MK_ONE_LAUNCH
#define MK_ONE_LAUNCH 1
#endif
__global__ void __launch_bounds__(512, 2) mega(Params p) {
    extern __shared__ __attribute__((aligned(16))) unsigned char lds_raw[];
    LAS unsigned char* lds = (LAS unsigned char*)lds_raw;
    volatile LAS unsigned* bst = (volatile LAS unsigned*)(lds + pg8::STAGE_BYTES);
    if (TID() < 4) bst[TID()] = 0u;
    __syncthreads();
    if (p.ph_hi - p.ph_lo > 1) (void)xcd_barrier_post((unsigned*)(KP()->ws + WS_CTL), bst);
#ifndef PH_ONLY
#define PH_ONLY -1
#endif
#define IN(k) (KP()->ph_lo <= (k) && (k) < KP()->ph_hi)
#define INT(tag, k) ((PH_ONLY < 0 || PH_ONLY == (tag)) && IN(k))
#define SEAM(k) do { if (IN(k) && IN((k) + 1)) { XcdBarrier bar_; bar_.bar = (unsigned*)(KP()->ws + WS_CTL); bar_.x = xb_xcc_id(); bar_.st = (volatile LAS unsigned*)(lds + pg8::STAGE_BYTES); xcd_barrier(bar_); if (DBL_PHASE == 20) xcd_barrier(bar_); } } while (0)
    for (int l = 0; l < 2; ++l) {
        const int pb = PH_PER_LAYER * l;
        if (INT(0, pb + 0)) {
#if DBL_PHASE == 6
            phase_conv(l, (LAS float*)lds);
#endif
            phase_conv(l, (LAS float*)lds);
#if DBL_PHASE == 7
            phase_norm(l == 0 ? KP()->in[I_X] : (const float*)KP()->out, KP()->in[I_NMIX] + l * DM, wsp<bf16_t>(WS_H));
#endif
            phase_norm(l == 0 ? KP()->in[I_X] : (const float*)KP()->out, KP()->in[I_NMIX] + l * DM, wsp<bf16_t>(WS_H)); }
        SEAM(pb + 1);
        if (INT(2, pb + 2)) {
            { const SchedLin S = mk_sched(128, 4, WS_H, WS_WB, 1024); const EpiB E{l}; pg8::gemm_phase(lds, 1024, S, E); }
            { const SchedLin S = mk_sched(2, 128, WS_WV, WS_H, 1024); const EpiVt E{(unsigned)WS_MVT}; pg8::gemm_phase(lds, 1024, S, E); }
#if DBL_PHASE == 9
            { const SchedLin S = mk_sched(128, 4, WS_H, WS_WB, 1024); const EpiB E{l}; pg8::gemm_phase(lds, 1024, S, E); }
            { const SchedLin S = mk_sched(2, 128, WS_WV, WS_H, 1024); const EpiVt E{(unsigned)WS_MVT}; pg8::gemm_phase(lds, 1024, S, E); }
#endif
        }
        SEAM(pb + 2);
        if (INT(4, pb + 4)) {
            { const SchedLin S = mk_sched(128, 2, WS_DCN, WS_WKVK, 256); const EpiHN E{l}; pg8::gemm_phase(lds, 256, S, E); }
            { const SchedLin S = mk_sched(2, 128, WS_WKVV, WS_DCN, 256); const EpiVt E{(unsigned)WS_DVT}; pg8::gemm_phase(lds, 256, S, E); }
#if DBL_PHASE == 13
            { const SchedLin S = mk_sched(128, 2, WS_DCN, WS_WKVK, 256); const EpiHN E{l}; pg8::gemm_phase(lds, 256, S, E); }
            { const SchedLin S = mk_sched(2, 128, WS_WKVV, WS_DCN, 256); const EpiVt E{(unsigned)WS_DVT}; pg8::gemm_phase(lds, 256, S, E); }
#endif
        }
        SEAM(pb + 4);
        for (int c = 0; c < NCH; ++c) {
            const int pc = pb + 5 + 5 * c + 2 * (c >> 1), cbase = c * SC;
            if (INT(5, pc + 0)) { const SchedLin S = mk_sched(32, 24, WS_H, WS_WD1, 1024, 1, cbase); const EpiD1 E{l, c & 1}; pg8::gemm_phase(lds, 1024, S, E);
#if DBL_PHASE == 5
                pg8::gemm_phase(lds, 1024, S, E);
#endif
#if DBL_PHASE == 27
                { const EpiNull E0{}; pg8::gemm_phase(lds, 1024, S, E0); }
#endif
            }
            SEAM(pc + 0);
            if (INT(6, pc + 1)) {
#if DBL_PHASE == 4
                phase_rwkv_prep(l, c);
#endif

                phase_rwkv_prep(l, c); }
            SEAM(pc + 1);
            if (INT(7, pc + 2)) { const SchedLin S = mk_sched(32, l == 0 ? 6 : 8, WS_LORAA, WS_WL, 512, 0, 0, WS_VV, 6); const EpiLora E{l, cbase}; pg8::gemm_phase(lds, 512, S, E); }
            SEAM(pc + 2);
            if (INT(8, pc + 3)) {
#if DBL_PHASE == 2
                phase_scan_chunked(l, c, lds, true);
#endif
#if DBL_PHASE == 22
                phase_scan_chunked(l, c, lds, true);
#endif

#if DBL_PHASE == 11
                phase_scan(l, c, 2);
#endif
#if DBL_PHASE == 12
                phase_scan(l, c, 3);
#endif
#if DBL_PHASE == 25
                if (TID() == 0) *(LAS unsigned*)(lds + 8192) = 0u;
                __syncthreads();
                phase_scan_chunked(l, c, lds, true); phase_dsa_select_queue(c, (LAS unsigned*)(lds + 8192));
                __syncthreads();
#endif
#if DBL_PHASE == 26
                if (TID() == 0) *(LAS unsigned*)(lds + 8192) = 0u;
                __syncthreads();
                phase_dsa_select_queue(c, (LAS unsigned*)(lds + 8192));
                __syncthreads();
#endif
                if (TID() == 0) *(LAS unsigned*)(lds + 8192) = 0u;
                __syncthreads();
                phase_scan_chunked(l, c, lds);
                phase_dsa_select_queue(c, (LAS unsigned*)(lds + 8192)); }
            SEAM(pc + 3);
            if (INT(9, pc + 4)) {
#if DBL_PHASE == 1
                phase_attn(l, c, (LAS float*)lds, true); __syncthreads();
#endif
                phase_attn(l, c, (LAS float*)lds); }
            SEAM(pc + 4);
            if (c & 1) {
                if (INT(10, pc + 5)) { const SchedMerge S{(int)gridDim.x, (int)BID()}; const EpiMerge E{}; pg8::gemm_phase(lds, 512, S, E);
#if DBL_PHASE == 10
                    pg8::gemm_phase(lds, 512, S, E);
#endif
                }
                SEAM(pc + 5);
                if (INT(11, pc + 6)) { const SchedLin S = mk_sched(64, 4, WS_Y, WS_WO, 1024); const EpiRes E{l == 0 ? 1 : 0, 2, cbase - SC, 0u}; pg8::gemm_phase(lds, 1024, S, E); }
                SEAM(pc + 6);
            }
        }
        if (INT(33, pb + 29)) phase_norm(KP()->out, KP()->in[I_NFFN] + l * DM, wsp<bf16_t>(WS_H));
        SEAM(pb + 29);
        if (INT(34, pb + 30)) { const SchedLin S = mk_sched(128, 22, WS_H, WS_WF1, 1024); const EpiSwiglu E{}; pg8::gemm_phase(lds, 1024, S, E);
#if DBL_PHASE == 8
            pg8::gemm_phase(lds, 1024, S, E);
#endif
        }
        SEAM(pb + 30);
        if (INT(35, pb + 31)) { const SchedLin S = mk_sched(128, 4, WS_ACT, WS_WF2, DFF); const EpiRes E{0, 0, 0, 0u};
#if DBL_PHASE == 16
            { const EpiRes E2{0, 0, 0, (unsigned)(WS_ACT + 176 * MiB)}; pg8::gemm_phase(lds, DFF, S, E2); }
#endif
            pg8::gemm_phase(lds, DFF, S, E); }
        SEAM(pb + 31);
    }
#undef IN
#undef INT
#undef SEAM
}

extern "C" void kernel_launch(void* const* d_in, const int* in_sizes, int n_in, void* d_out, int out_size, void* d_ws, size_t ws_size, hipStream_t stream) {
    static int grid = 0;
    if (grid == 0) {
        if (n_in != 26 || ws_size < WS_END) { grid = -1; return; }
        int dev = 0, cus = 0;
        if (hipGetDevice(&dev) != hipSuccess || hipDeviceGetAttribute(&cus, hipDeviceAttributeMultiprocessorCount, dev) != hipSuccess) { grid = -1; return; }
        if (hipFuncSetAttribute((const void*)mega, hipFuncAttributeMaxDynamicSharedMemorySize, LDS_BYTES) != hipSuccess) { grid = -1; return; }
        grid = cus;
    }
    if (grid < 0) return;
    (void)hipMemsetAsync((char*)d_ws + WS_CTL, 0, 64 * 1024, stream);
    Params p{};
    for (int i = 0; i < 26; ++i) p.in[i] = (const float*)d_in[i];
    p.out = (float*)d_out; p.ws = (unsigned char*)d_ws;
#if MK_ONE_LAUNCH
    p.ph_lo = 0; p.ph_hi = N_PHASES;
    hipLaunchKernelGGL(mega, dim3(grid), dim3(512), LDS_BYTES, stream, p);
#else
    for (int ph = 0; ph < N_PHASES; ++ph) { p.ph_lo = ph; p.ph_hi = ph + 1; hipLaunchKernelGGL(mega, dim3(grid), dim3(512), LDS_BYTES, stream, p); }
#endif
}
```
